# Optimizing an MI355X kernel written in HIP

```python
import math
import jax, jax.numpy as jnp
from jax import lax
import numpy as np

D_MODEL = 2048
BATCH = 2
SEQ = 8192
DEPTH = 4

EPS = 1e-6
CONV_K = 4
D_FF = ((8 * D_MODEL // 3 + 127) // 128) * 128

GDN_HEADS = 4
GDN_DK = 128
GDN_DV = 128
GDN_CHUNK = 64
GDN_CONV_CH = GDN_HEADS * (2 * GDN_DK + GDN_DV)

NSA_HEADS = 4
NSA_KV_GROUPS = 2
NSA_DK = 128
NSA_DV = 128
CMP_BLOCK = 32
CMP_STRIDE = 16
SEL_BLOCK = 64
N_SELECT = 16
WINDOW = 512
Q_BLOCK = 128
SEL_OVERLAP_WEIGHTS = (1.0, 2.0, 2.0, 2.0, 1.0)
FORCE_SCORE = 1e4
NEG = -1e30

SSM_HEADS = 16
SSM_HEAD_DIM = 64
SSM_GROUPS = 2
SSM_STATE = 128
SSM_CHUNK = 128
SSM_INNER = SSM_HEADS * SSM_HEAD_DIM
SSM_CONV_CH = SSM_INNER + 2 * SSM_GROUPS * SSM_STATE

REL_BUCKETS = 32
REL_MAX_EXACT = 16
REL_MAX_DIST = 1024

IN_SIZES = (GDN_HEADS * GDN_DK, GDN_HEADS * GDN_DK, GDN_HEADS * GDN_DV, GDN_HEADS * GDN_DV, GDN_HEADS, GDN_HEADS,
            NSA_HEADS * NSA_DK, NSA_KV_GROUPS * NSA_DK, NSA_KV_GROUPS * NSA_DV, NSA_KV_GROUPS * NSA_DK,
            NSA_KV_GROUPS * NSA_DV, NSA_KV_GROUPS * NSA_DK, NSA_KV_GROUPS * NSA_DV, 3 * NSA_HEADS,
            SSM_INNER, SSM_CONV_CH, SSM_HEADS,
            3 * D_MODEL)
N_IN = sum(IN_SIZES)

kernel_name = "hybrid_gdn_nsa_ssd_macaron"


def rmsnorm(x, g):
    xf = x.astype(jnp.float32)
    y = xf * lax.rsqrt(jnp.mean(xf * xf, axis=-1, keepdims=True) + EPS)
    return (y * g.astype(jnp.float32)).astype(x.dtype)


def l2norm(t):
    return t * lax.rsqrt(jnp.sum(t * t, axis=-1, keepdims=True) + EPS)


def swiglu(h, w_up, w_down):
    a, b = jnp.split(h @ w_up, 2, axis=-1)
    return (jax.nn.silu(a) * b) @ w_down


def causal_dwconv(x, w):
    return lax.conv_general_dilated(x, w[:, None, :], window_strides=(1,), padding=[(CONV_K - 1, 0)],
                                    dimension_numbers=('NWC', 'WIO', 'NWC'), feature_group_count=x.shape[-1])


def rel_bucket(dist):
    n = jnp.maximum(dist, 0)
    nf = jnp.maximum(n, 1).astype(jnp.float32)
    large = REL_MAX_EXACT + (jnp.log(nf / REL_MAX_EXACT) / math.log(REL_MAX_DIST / REL_MAX_EXACT)
                             * (REL_BUCKETS - REL_MAX_EXACT)).astype(jnp.int32)
    large = jnp.minimum(large, REL_BUCKETS - 1)
    return jnp.where(n < REL_MAX_EXACT, n, large)


def gated_deltanet(q, k, v, z, a, b, conv_w, a_log, dt_bias, norm_g):
    f32 = jnp.float32
    Bsz, T, _ = q.shape
    H, C = GDN_HEADS, GDN_CHUNK
    n_c = T // C
    qk_w = H * GDN_DK
    qkv = jax.nn.silu(causal_dwconv(jnp.concatenate([q, k, v], axis=-1), conv_w)).astype(f32)

    def heads(t):
        return t.reshape(Bsz, n_c, C, H, -1).transpose(0, 3, 1, 2, 4)

    qh = l2norm(heads(qkv[..., :qk_w])) * GDN_DK ** -0.5
    kh = l2norm(heads(qkv[..., qk_w:2 * qk_w]))
    vh = heads(qkv[..., 2 * qk_w:])
    beta = jax.nn.sigmoid(b.astype(f32)).reshape(Bsz, n_c, C, H).transpose(0, 3, 1, 2)
    g = -jnp.exp(a_log.astype(f32)) * jax.nn.softplus(a.astype(f32) + dt_bias.astype(f32))
    gc = jnp.cumsum(g.reshape(Bsz, n_c, C, H).transpose(0, 3, 1, 2), axis=-1)
    causal = jnp.tril(jnp.ones((C, C), bool))
    strict = jnp.tril(jnp.ones((C, C), bool), -1)
    diff = gc[..., :, None] - gc[..., None, :]
    decay = jnp.where(causal, jnp.exp(jnp.where(causal, diff, 0.0)), 0.0)
    kb = kh * beta[..., None]
    m = jnp.where(strict, jnp.einsum('bhncd,bhnsd->bhncs', kb, kh) * decay, 0.0) + jnp.eye(C, dtype=f32)
    rhs = jnp.concatenate([vh * beta[..., None], kb * jnp.exp(gc)[..., None]], axis=-1)
    sol = lax.linalg.triangular_solve(m, rhs, left_side=True, lower=True, unit_diagonal=True)
    u, w = sol[..., :GDN_DV], sol[..., GDN_DV:]
    attn = jnp.einsum('bhncd,bhnsd->bhncs', qh, kh) * decay
    q_dec = qh * jnp.exp(gc)[..., None]
    k_dec = kh * jnp.exp(gc[..., -1:] - gc)[..., None]
    g_last = jnp.exp(gc[..., -1])

    def step(state, inp):
        u_c, w_c, a_c, qd_c, kd_c, gl_c = inp
        v_new = u_c - jnp.einsum('bhck,bhkv->bhcv', w_c, state)
        o_c = jnp.einsum('bhck,bhkv->bhcv', qd_c, state) + jnp.einsum('bhcs,bhsv->bhcv', a_c, v_new)
        state = state * gl_c[..., None, None] + jnp.einsum('bhck,bhcv->bhkv', kd_c, v_new)
        return state, o_c

    xs = (jnp.moveaxis(u, 2, 0), jnp.moveaxis(w, 2, 0), jnp.moveaxis(attn, 2, 0),
          jnp.moveaxis(q_dec, 2, 0), jnp.moveaxis(k_dec, 2, 0), jnp.moveaxis(g_last, 2, 0))
    _, o = lax.scan(step, jnp.zeros((Bsz, H, GDN_DK, GDN_DV), f32), xs)
    o = o.transpose(1, 0, 3, 2, 4).reshape(Bsz, T, H, GDN_DV)
    o = rmsnorm(o, norm_g) * jax.nn.silu(z.astype(f32).reshape(Bsz, T, H, GDN_DV))
    return o.reshape(Bsz, T, H * GDN_DV).astype(z.dtype)


def nsa_attention(q_in, kc, vc, ks, vs, kw, vw, gate_logits, q_norm, k_norm, pe_k, pe_v, w_ck, w_cv, rel_table):
    f32 = jnp.float32
    Bsz, T, _ = q_in.shape
    G, Hg = NSA_KV_GROUPS, NSA_HEADS // NSA_KV_GROUPS
    n_cmp = T // CMP_STRIDE - 1
    n_sel = T // SEL_BLOCK
    n_top = min(N_SELECT, n_sel)
    n_qb = T // Q_BLOCK
    ratio = SEL_BLOCK // CMP_STRIDE

    q = rmsnorm(q_in.reshape(Bsz, T, NSA_HEADS, NSA_DK), q_norm).astype(f32) * NSA_DK ** -0.5
    q_blocks = q.reshape(Bsz, n_qb, Q_BLOCK, G, Hg, NSA_DK).transpose(1, 0, 3, 4, 2, 5)

    def groups(t):
        return t.reshape(Bsz, T, G, -1).astype(f32)

    def compress(t, pe, w):
        c = groups(t).reshape(Bsz, T // CMP_STRIDE, CMP_STRIDE, G, -1)
        blocks = jnp.concatenate([c[:, :-1], c[:, 1:]], axis=2)
        return jnp.einsum('bnlgd,lde->bgne', blocks + pe.astype(f32)[:, None, :], w.astype(f32))

    k_cmp = rmsnorm(compress(kc, pe_k, w_ck), k_norm)
    v_cmp = compress(vc, pe_v, w_cv)
    k_sel = rmsnorm(groups(ks), k_norm).reshape(Bsz, n_sel, SEL_BLOCK, G, NSA_DK).transpose(0, 3, 1, 2, 4)
    v_sel = groups(vs).reshape(Bsz, n_sel, SEL_BLOCK, G, NSA_DV).transpose(0, 3, 1, 2, 4)
    pad = ((0, 0), (0, 0), (WINDOW, 0), (0, 0))
    k_win = jnp.pad(rmsnorm(groups(kw), k_norm).transpose(0, 2, 1, 3), pad)
    v_win = jnp.pad(groups(vw).transpose(0, 2, 1, 3), pad)

    table = rel_table.astype(f32).T.reshape(G, Hg, REL_BUCKETS)
    cmp_end = jnp.arange(n_cmp) * CMP_STRIDE + CMP_BLOCK - 1
    blk = jnp.arange(n_sel)
    bi = jnp.arange(Bsz)[:, None, None, None]
    gi = jnp.arange(G)[None, :, None, None]
    gi6 = jnp.arange(G)[None, :, None, None, None, None]
    hi6 = jnp.arange(Hg)[None, None, :, None, None, None]

    def block(args):
        qb, qi = args
        t = qi * Q_BLOCK + jnp.arange(Q_BLOCK)
        dist = t[:, None] - cmp_end[None, :]
        ok = dist >= 0
        s = jnp.einsum('bghqd,bgnd->bghqn', qb, k_cmp) + table[:, :, rel_bucket(dist)]
        p_cmp = jnp.where(ok, jax.nn.softmax(jnp.where(ok, s, NEG), axis=-1), 0.0)
        o_cmp = jnp.einsum('bghqn,bgnd->bghqd', p_cmp, v_cmp)
        imp_c = jnp.pad(p_cmp.sum(axis=2), ((0, 0), (0, 0), (0, 0), (1, ratio * n_sel - n_cmp)))
        imp = sum(wt * imp_c[..., j:j + ratio * n_sel:ratio] for j, wt in enumerate(SEL_OVERLAP_WEIGHTS))
        cur = t // SEL_BLOCK
        ok_s = blk[None, :] <= cur[:, None]
        forced = ok_s & ((blk[None, :] == 0) | (blk[None, :] >= cur[:, None] - 1))
        score = jnp.where(forced, FORCE_SCORE, jnp.where(ok_s, imp, -FORCE_SCORE))
        _, idx = lax.top_k(score, n_top)
        kg = k_sel[bi, gi, idx]
        vg = v_sel[bi, gi, idx]
        dist = t[:, None, None] - (idx[..., None] * SEL_BLOCK + jnp.arange(SEL_BLOCK))
        ok = (dist >= 0)[:, :, None]
        s = jnp.einsum('bghqd,bgqkld->bghqkl', qb, kg) + table[gi6, hi6, rel_bucket(dist)[:, :, None]]
        s = jnp.where(ok, s, NEG).reshape(Bsz, G, Hg, Q_BLOCK, n_top * SEL_BLOCK)
        p = jax.nn.softmax(s, axis=-1).reshape(Bsz, G, Hg, Q_BLOCK, n_top, SEL_BLOCK)
        o_sel = jnp.einsum('bghqkl,bgqkld->bghqd', p, vg)
        kwb = lax.dynamic_slice_in_dim(k_win, qi * Q_BLOCK, Q_BLOCK + WINDOW, axis=2)
        vwb = lax.dynamic_slice_in_dim(v_win, qi * Q_BLOCK, Q_BLOCK + WINDOW, axis=2)
        pos = qi * Q_BLOCK - WINDOW + jnp.arange(Q_BLOCK + WINDOW)
        dist = t[:, None] - pos[None, :]
        ok = (dist >= 0) & (dist < WINDOW) & (pos >= 0)[None, :]
        s = jnp.einsum('bghqd,bgkd->bghqk', qb, kwb) + table[:, :, rel_bucket(dist)]
        p = jax.nn.softmax(jnp.where(ok, s, NEG), axis=-1)
        o_win = jnp.einsum('bghqk,bgkd->bghqd', p, vwb)
        return jnp.stack([o_cmp, o_sel, o_win], axis=-2)

    out = lax.map(block, (q_blocks, jnp.arange(n_qb)))
    out = out.transpose(1, 0, 4, 2, 3, 5, 6).reshape(Bsz, T, NSA_HEADS, 3, NSA_DV)
    gates = jax.nn.sigmoid(gate_logits.astype(f32)).reshape(Bsz, T, NSA_HEADS, 3)
    o = jnp.einsum('bthr,bthrd->bthd', gates, out)
    return o.reshape(Bsz, T, NSA_HEADS * NSA_DV).astype(q_in.dtype)


def mamba2_ssd(z, xbc, dt, conv_w, conv_b, dt_bias, a_log, d_skip, norm_g):
    f32 = jnp.float32
    Bsz, T, _ = z.shape
    H, P, G, N, L = SSM_HEADS, SSM_HEAD_DIM, SSM_GROUPS, SSM_STATE, SSM_CHUNK
    n_c = T // L
    xbc = jax.nn.silu(causal_dwconv(xbc, conv_w) + conv_b).astype(f32)
    xs = xbc[..., :SSM_INNER].reshape(Bsz, n_c, L, H, P)
    bm = jnp.repeat(xbc[..., SSM_INNER:SSM_INNER + G * N].reshape(Bsz, n_c, L, G, N), H // G, axis=3)
    cm = jnp.repeat(xbc[..., SSM_INNER + G * N:].reshape(Bsz, n_c, L, G, N), H // G, axis=3)
    dt = jax.nn.softplus(dt.astype(f32) + dt_bias.astype(f32)).reshape(Bsz, n_c, L, H)
    ac = jnp.cumsum(dt * (-jnp.exp(a_log.astype(f32))), axis=2)
    xdt = xs * dt[..., None]
    ach = jnp.swapaxes(ac, 2, 3)
    causal = jnp.tril(jnp.ones((L, L), bool))
    seg = ach[..., :, None] - ach[..., None, :]
    decay = jnp.where(causal, jnp.exp(jnp.where(causal, seg, 0.0)), 0.0)
    scores = jnp.einsum('bclhn,bcshn->bchls', cm, bm) * decay
    y = jnp.einsum('bchls,bcshp->bclhp', scores, xdt)
    states = jnp.einsum('bclhn,bclhp->bchpn', bm * jnp.exp(ac[:, :, -1:, :] - ac)[..., None], xdt)
    chunk_decay = jnp.exp(ac[:, :, -1, :])

    def step(s, inp):
        st, cd = inp
        return s * cd[..., None, None] + st, s

    _, s_in = lax.scan(step, jnp.zeros((Bsz, H, P, N), f32),
                       (jnp.moveaxis(states, 1, 0), jnp.moveaxis(chunk_decay, 1, 0)))
    s_in = jnp.moveaxis(s_in, 0, 1)
    y = y + jnp.einsum('bclhn,bchpn->bclhp', cm * jnp.exp(ac)[..., None], s_in) + xs * d_skip.astype(f32)[:, None]
    y = y.reshape(Bsz, T, SSM_INNER) * jax.nn.silu(z.astype(f32))
    y = y.reshape(Bsz, T, G, SSM_INNER // G)
    y = y * lax.rsqrt(jnp.mean(y * y, axis=-1, keepdims=True) + EPS)
    return (y.reshape(Bsz, T, SSM_INNER) * norm_g.astype(f32)).astype(z.dtype)


def setup_inputs(seed: int = 0) -> dict:
    key = jax.random.key(seed)
    keys = iter(jax.random.split(key, 40))
    f32 = jnp.float32
    Ld = DEPTH

    def nrm(shape, scale):
        return scale * jax.random.normal(next(keys), shape, f32)

    def gain(shape):
        return 1.0 + 0.02 * jax.random.normal(next(keys), shape, f32)

    def a_log(n):
        return jnp.log(jax.random.uniform(next(keys), (Ld, n), f32, 1.0, 16.0))

    def dt_bias(n):
        dtv = jnp.exp(jax.random.uniform(next(keys), (Ld, n), f32, math.log(1e-3), math.log(1e-1)))
        return dtv + jnp.log(-jnp.expm1(-dtv))

    return {
        "x": nrm((BATCH, SEQ, D_MODEL), 1.0),
        "rel_table": nrm((REL_BUCKETS, NSA_HEADS), 0.5),
        "g_ffn1": gain((Ld, D_MODEL)),
        "w_up1": nrm((Ld, D_MODEL, 2 * D_FF), D_MODEL ** -0.5),
        "w_down1": nrm((Ld, D_FF, D_MODEL), D_FF ** -0.5),
        "g_mix": gain((Ld, D_MODEL)),
        "w_in": nrm((Ld, D_MODEL, N_IN), D_MODEL ** -0.5),
        "gdn_conv": nrm((Ld, CONV_K, GDN_CONV_CH), CONV_K ** -0.5),
        "gdn_a_log": a_log(GDN_HEADS),
        "gdn_dt_bias": dt_bias(GDN_HEADS),
        "gdn_norm": gain((Ld, GDN_DV)),
        "nsa_q_norm": gain((Ld, NSA_DK)),
        "nsa_k_norm": gain((Ld, NSA_DK)),
        "nsa_pe_k": nrm((Ld, CMP_BLOCK, NSA_DK), 0.1),
        "nsa_pe_v": nrm((Ld, CMP_BLOCK, NSA_DV), 0.1),
        "nsa_w_ck": nrm((Ld, CMP_BLOCK, NSA_DK, NSA_DK), (CMP_BLOCK * NSA_DK) ** -0.5),
        "nsa_w_cv": nrm((Ld, CMP_BLOCK, NSA_DV, NSA_DV), (CMP_BLOCK * NSA_DV) ** -0.5),
        "ssm_conv_w": nrm((Ld, CONV_K, SSM_CONV_CH), CONV_K ** -0.5),
        "ssm_conv_b": nrm((Ld, SSM_CONV_CH), 0.02),
        "ssm_dt_bias": dt_bias(SSM_HEADS),
        "ssm_a_log": a_log(SSM_HEADS),
        "ssm_d": 1.0 + 0.1 * jax.random.normal(next(keys), (Ld, SSM_HEADS), f32),
        "ssm_norm": gain((Ld, SSM_INNER)),
        "p_a": nrm((Ld, GDN_HEADS * GDN_DV, D_MODEL), (GDN_HEADS * GDN_DV) ** -0.5),
        "p_b": nrm((Ld, NSA_HEADS * NSA_DV, D_MODEL), (NSA_HEADS * NSA_DV) ** -0.5),
        "p_c": nrm((Ld, SSM_INNER, D_MODEL), SSM_INNER ** -0.5),
        "w_o": nrm((Ld, D_MODEL, D_MODEL), D_MODEL ** -0.5),
        "g_ffn2": gain((Ld, D_MODEL)),
        "w_up2": nrm((Ld, D_MODEL, 2 * D_FF), D_MODEL ** -0.5),
        "w_down2": nrm((Ld, D_FF, D_MODEL), D_FF ** -0.5),
    }


def reference(x, rel_table, g_ffn1, w_up1, w_down1, g_mix, w_in, gdn_conv, gdn_a_log, gdn_dt_bias, gdn_norm,
              nsa_q_norm, nsa_k_norm, nsa_pe_k, nsa_pe_v, nsa_w_ck, nsa_w_cv, ssm_conv_w, ssm_conv_b,
              ssm_dt_bias, ssm_a_log, ssm_d, ssm_norm, p_a, p_b, p_c, w_o, g_ffn2, w_up2, w_down2):
    Bsz, T, _ = x.shape
    split_at = np.cumsum(IN_SIZES)[:-1].tolist()
    for l in range(DEPTH):
        x = x + 0.5 * swiglu(rmsnorm(x, g_ffn1[l]), w_up1[l], w_down1[l])
        h = rmsnorm(x, g_mix[l])
        (a_q, a_k, a_v, a_z, a_a, a_b, b_q, b_kc, b_vc, b_ks, b_vs, b_kw, b_vw, b_g,
         c_z, c_xbc, c_dt, m_gate) = jnp.split(h @ w_in[l], split_at, axis=-1)
        y_a = gated_deltanet(a_q, a_k, a_v, a_z, a_a, a_b, gdn_conv[l], gdn_a_log[l], gdn_dt_bias[l], gdn_norm[l])
        y_b = nsa_attention(b_q, b_kc, b_vc, b_ks, b_vs, b_kw, b_vw, b_g, nsa_q_norm[l], nsa_k_norm[l],
                            nsa_pe_k[l], nsa_pe_v[l], nsa_w_ck[l], nsa_w_cv[l], rel_table)
        y_c = mamba2_ssd(c_z, c_xbc, c_dt, ssm_conv_w[l], ssm_conv_b[l], ssm_dt_bias[l], ssm_a_log[l],
                         ssm_d[l], ssm_norm[l])
        gates = jax.nn.sigmoid(m_gate).reshape(Bsz, T, 3, D_MODEL)
        merged = (gates[:, :, 0] * (y_a @ p_a[l]) + gates[:, :, 1] * (y_b @ p_b[l])
                  + gates[:, :, 2] * (y_c @ p_c[l]))
        x = x + merged @ w_o[l]
        x = x + 0.5 * swiglu(rmsnorm(x, g_ffn2[l]), w_up2[l], w_down2[l])
    return x
```

```cpp
#include <hip/hip_runtime.h>
#include <cstdio>
#include <cstdint>

#ifndef CPU_EMU
#define DEV __device__ __forceinline__
#define LAS __attribute__((address_space(3)))
#define VM_WAIT() asm volatile("s_waitcnt vmcnt(0)" ::: "memory")
#define LDS_WAIT() asm volatile("s_waitcnt lgkmcnt(0)" ::: "memory")
#define CFENCE() asm volatile("" ::: "memory")
#define WAVE_SYNC() do { asm volatile("" ::: "memory"); __builtin_amdgcn_wave_barrier(); asm volatile("" ::: "memory"); } while (0)
#endif

#define DBG_DUMP 0
#define DBG_STOP 48
#ifndef DBG_ZERO
#define DBG_ZERO 0
#endif
typedef unsigned short bf16;
typedef short bf16x8 __attribute__((ext_vector_type(8)));
typedef float f32x4 __attribute__((ext_vector_type(4)));
typedef float f32x2 __attribute__((ext_vector_type(2)));
typedef unsigned u32x4 __attribute__((ext_vector_type(4)));
typedef unsigned u32x2 __attribute__((ext_vector_type(2)));

constexpr int BATCH = 2, SEQ = 8192, DM = 2048, DEPTH = 4, DFF = 5504, NUP = 2 * DFF;
constexpr int MTOK = BATCH * SEQ;
constexpr int NIN = 12836, NINP = 13056;
constexpr int P1W = 6656;
constexpr int SM0 = 6656;
constexpr int GT0 = 6912;
constexpr float EPS = 1e-6f;
constexpr int C_AQ = 0, C_AK = 512, C_AV = 1024, C_AZ = 1536, C_BQ = 2048, C_BKC = 2560, C_BVC = 2816, C_BKS = 3072, C_BVS = 3328, C_BKW = 3584, C_BVW = 3840, C_CZ = 4096, C_CX = 5120;
constexpr int S_AA = 0, S_AB = 4, S_BG = 8, S_DT = 20, SMW = 64;

constexpr size_t MiB = 1u << 20;
constexpr size_t WS_CTL = 0, CTL_BYTES = 2 * MiB;
constexpr size_t WS_WUP1 = 2 * MiB;
constexpr size_t WS_WDN1 = WS_WUP1 + (size_t)NUP * DM * 2;
constexpr size_t WS_WIN = WS_WDN1 + (size_t)DM * DFF * 2;
constexpr size_t WS_WPM = WS_WIN + (size_t)NINP * DM * 2;
constexpr size_t WS_WO = WS_WPM + (size_t)DM * DM * 2;
constexpr size_t WS_WUP2 = WS_WO + (size_t)DM * DM * 2;
constexpr size_t WS_WDN2 = WS_WUP2 + (size_t)NUP * DM * 2;
constexpr size_t WS_WCK = WS_WDN2 + (size_t)DM * DFF * 2;
constexpr size_t WS_WCV = WS_WCK + 128 * 4096 * 2;
constexpr size_t WS_CONST = WS_WCV + 128 * 4096 * 2;
constexpr size_t WS_WEND = WS_CONST + 4096;
static_assert(WS_WEND <= 212 * MiB, "weights region");
constexpr size_t WS_XB = 212 * MiB;
constexpr size_t WS_P1 = 276 * MiB;
constexpr size_t WS_ACT = WS_P1;
constexpr size_t WS_GATE = 484 * MiB;
constexpr size_t WS_SMALL = 676 * MiB;
constexpr size_t WS_MERGED = 680 * MiB;
constexpr size_t WS_YCAT = 744 * MiB;
constexpr size_t WS_GW = 808 * MiB;
constexpr size_t GDN_CH_BYTES = 73728;
constexpr size_t WS_GL = 880 * MiB;
constexpr size_t WS_GO = 881 * MiB;
constexpr size_t WS_SX = 913 * MiB;
constexpr size_t WS_SDT = 961 * MiB;
constexpr size_t WS_SAC = 962 * MiB;
constexpr size_t WS_SST = 963 * MiB;
constexpr size_t WS_SCD = 1027 * MiB;
constexpr size_t WS_SRC = 1028 * MiB;
constexpr size_t WS_QN = 1029 * MiB;
constexpr size_t WS_KS = 1045 * MiB;
constexpr size_t WS_KW = 1053 * MiB;
constexpr size_t WS_VST = 1061 * MiB;
constexpr size_t WS_VWT = 1069 * MiB;
constexpr size_t WS_KCMP = 1077 * MiB;
constexpr size_t WS_VCMPT = 1078 * MiB;
constexpr size_t WS_SELM = 1079 * MiB;
constexpr size_t WS_YB = 1080 * MiB;
constexpr size_t WS_MTMP = 1112 * MiB;
constexpr size_t WS_END = 1240 * MiB;
static_assert(WS_P1 + (size_t)MTOK * P1W * 2 <= WS_GATE && WS_GATE + (size_t)MTOK * 6144 * 2 <= WS_SMALL && WS_SMALL + (size_t)MTOK * SMW * 4 <= WS_MERGED && WS_MERGED + (size_t)MTOK * DM * 2 <= WS_YCAT && WS_YCAT + (size_t)MTOK * 2048 * 2 <= WS_GW, "ws map 1");
static_assert(WS_GW + 1024 * GDN_CH_BYTES <= WS_GL && WS_GO + (size_t)MTOK * 512 * 4 <= WS_SX && WS_SX + (size_t)MTOK * 1536 * 2 <= WS_SDT && WS_SDT + (size_t)MTOK * 16 * 4 <= WS_SAC && WS_SAC + (size_t)MTOK * 16 * 4 <= WS_SST && WS_SST + (size_t)2 * 64 * 16 * 64 * 128 * 4 <= WS_SCD, "ws map 2");
static_assert(WS_SRC + (size_t)MTOK * 2 * 4 <= WS_QN && WS_QN + (size_t)4 * SEQ * 256 * 2 <= WS_KS && WS_KS + (size_t)4 * SEQ * 128 * 2 <= WS_KW && WS_KW + (size_t)4 * SEQ * 128 * 2 <= WS_VST && WS_VST + (size_t)4 * SEQ * 128 * 2 <= WS_VWT && WS_VWT + (size_t)4 * SEQ * 128 * 2 <= WS_KCMP, "ws map 3");
static_assert(WS_KCMP + 4 * 512 * 128 * 2 <= WS_VCMPT && WS_VCMPT + 4 * 512 * 128 * 2 <= WS_SELM && WS_SELM + (size_t)4 * SEQ * 16 <= WS_YB && WS_YB + (size_t)MTOK * 512 * 4 <= WS_END && WS_XB + (size_t)MTOK * DM * 2 <= WS_P1 && (size_t)MTOK * DFF * 2 <= (size_t)MTOK * P1W * 2, "ws map 4");

constexpr int CW_BAR = 1024;
constexpr int CW_RS = 16384;
constexpr int NRS = 13;
static_assert(CW_RS * 4 + NRS * MTOK * 8 <= (int)CTL_BYTES, "ctl");

constexpr int RING_BYTES = 131072;
constexpr int MISC_OFF = RING_BYTES + 12288;
constexpr int LDS_BYTES = 147456;

DEV unsigned f2bf(float f) { unsigned u = __builtin_bit_cast(unsigned, f); return (u + 0x7fffu + ((u >> 16) & 1u)) >> 16; }
DEV float bf2f(unsigned b) { return __builtin_bit_cast(float, (b & 0xffffu) << 16); }
DEV unsigned pk2(float lo, float hi) { return f2bf(lo) | (f2bf(hi) << 16); }
DEV float bflo(unsigned w) { return __builtin_bit_cast(float, w << 16); }
DEV float bfhi(unsigned w) { return __builtin_bit_cast(float, w & 0xffff0000u); }
DEV float sigmoidf_(float x) { return 1.0f / (1.0f + __expf(-x)); }
DEV float siluf_(float x) { return x / (1.0f + __expf(-x)); }
DEV float softplusf_(float x) {
    const float e = __expf(-fabsf(x)), u = 1.0f + e, d = u - 1.0f;
    const float lp = d == 0.f ? e : __logf(u) * (e / d);
    return fmaxf(x, 0.f) + lp;
}
#ifndef CPU_EMU
template <int M, class T> DEV T shx(T v) {
    static_assert(sizeof(T) == 4, "shx: 32-bit values");
    const int iv = __builtin_bit_cast(int, v);
    if constexpr (M < 32) return __builtin_bit_cast(T, __builtin_amdgcn_ds_swizzle(iv, 0x1f | (M << 10)));
    else { unsigned z = 0u; asm volatile("" : "+v"(z)); const unsigned ln = __builtin_amdgcn_mbcnt_hi(~0u, __builtin_amdgcn_mbcnt_lo(~0u, z));
        return __builtin_bit_cast(T, __builtin_amdgcn_ds_bpermute((int)((ln ^ 32u) << 2), iv)); }
}
#endif
DEV float wave_sum(float v) { v += shx<1>(v); v += shx<2>(v); v += shx<4>(v); v += shx<8>(v); v += shx<16>(v); v += shx<32>(v); return v; }
DEV float sum16(float v) { v += shx<1>(v); v += shx<2>(v); v += shx<4>(v); v += shx<8>(v); return v; }
DEV float max16(float v) { v = fmaxf(v, shx<1>(v)); v = fmaxf(v, shx<2>(v)); v = fmaxf(v, shx<4>(v)); v = fmaxf(v, shx<8>(v)); return v; }
#ifndef CPU_EMU
DEV float opaque_zero() { float z = 0.f; asm volatile("" : "+v"(z)); return z; }
#endif
#define ZERO4 ((f32x4){zf_, zf_, zf_, zf_})
DEV f32x4 mfma16(bf16x8 a, bf16x8 b, f32x4 c) { return __builtin_amdgcn_mfma_f32_16x16x32_bf16(a, b, c, 0, 0, 0); }
DEV bf16x8 frag_g(const bf16* base, int pitch, int row0, int k0, int lane) { return *(const bf16x8*)(base + (size_t)(row0 + (lane & 15)) * pitch + k0 + 8 * (lane >> 4)); }
DEV bf16x8 frag_l(const LAS bf16* base, int pitch, int row0, int k0, int lane) { return *(const LAS bf16x8*)(base + (row0 + (lane & 15)) * pitch + k0 + 8 * (lane >> 4)); }
#ifndef CPU_EMU
DEV const LAS void* lds_vbase(const LAS void* p) { unsigned a = (unsigned)(size_t)p; asm volatile("" : "+v"(a)); return (const LAS void*)(size_t)a; }
#endif

struct Params {
    const float* in[30];
    float* out;
    unsigned char* ws;
    int lo, hi;
    int use_bar, pad;
};
enum { I_X = 0, I_REL, I_GF1, I_WUP1, I_WDN1, I_GMIX, I_WIN, I_GCONV, I_GALOG, I_GDTB, I_GNORM, I_NQN, I_NKN, I_NPEK, I_NPEV, I_NWCK, I_NWCV,
       I_SCW, I_SCB, I_SDTB, I_SALOG, I_SD, I_SNORM, I_PA, I_PB, I_PC, I_WO, I_GF2, I_WUP2, I_WDN2 };

#define XB_TMO      128
#define XB_XCNT(j)  (256  + 64 * (j))
#define XB_XSUB(j)  (1280 + 64 * (j))
#define XB_XGEN(j)  (2304 + 64 * (j))
#define XB_TOP      3328
#define XB_TOPGEN   3392
#define XCD_BAR_WORDS 3456
#define XB_SPIN_CAP (1u << 22)
#ifndef CPU_EMU
DEV unsigned xb_ld(unsigned* p)              { return __hip_atomic_load(p, __ATOMIC_RELAXED, __HIP_MEMORY_SCOPE_AGENT); }
DEV unsigned xb_add(unsigned* p, unsigned v) { return __hip_atomic_fetch_add(p, v, __ATOMIC_RELAXED, __HIP_MEMORY_SCOPE_AGENT); }
DEV unsigned xb_xcc_id() { return (unsigned)__builtin_amdgcn_s_getreg((3 << 11) | 20) & 0xFu; }
#define XB_SPIN(cond, bar) do { unsigned _sp = 0; while (cond) { __builtin_amdgcn_s_sleep(1); \
    if ((++_sp & 255u) == 0u) { if (xb_ld(&(bar)[XB_TMO])) break; if (_sp > XB_SPIN_CAP) { atomicAdd(&(bar)[XB_TMO], 1u); break; } } } } while (0)
struct XcdBarrier { unsigned* bar; unsigned x; volatile LAS unsigned* st; };
DEV XcdBarrier xcd_barrier_post(unsigned* bar, volatile LAS unsigned* st) {
    XcdBarrier b; b.bar = bar; b.x = xb_xcc_id(); b.st = st;
    if (threadIdx.x == 0) (void)xb_add(&bar[XB_XCNT(b.x)], 1u);
    return b;
}
DEV void xcd_barrier_complete(unsigned* bar, unsigned x, unsigned& nloc, unsigned& nx) {
    const unsigned G = gridDim.x * gridDim.y * gridDim.z;
    unsigned sum, cnt, mine, sp = 0u;
    for (;;) {
        sum = 0u; cnt = 0u; mine = 0u;
#pragma unroll
        for (unsigned j = 0; j < 16; ++j) { const unsigned c = xb_ld(&bar[XB_XCNT(j)]); sum += c; cnt += (c > 0u) ? 1u : 0u; mine = (j == x) ? c : mine; }
        if (sum == G) break;
        __builtin_amdgcn_s_sleep(1);
        if ((++sp & 255u) == 0u) { if (xb_ld(&bar[XB_TMO])) break; if (sp > XB_SPIN_CAP) { atomicAdd(&bar[XB_TMO], 1u); break; } }
    }
    nloc = mine > 0u ? mine : 1u; nx = cnt > 0u ? cnt : 1u;
}
DEV void xcd_barrier(const XcdBarrier& b) {
    asm volatile("s_waitcnt vmcnt(0)" ::: "memory");
    __syncthreads();
    if (threadIdx.x == 0) {
        unsigned* bar = b.bar;
        __builtin_amdgcn_s_waitcnt(0);
        unsigned nloc = b.st[0], nx = b.st[1];
        if (nloc == 0u) { xcd_barrier_complete(bar, b.x, nloc, nx); b.st[0] = nloc; b.st[1] = nx; }
        const unsigned old = xb_add(&bar[XB_XSUB(b.x)], 1u);
        const unsigned gen = old / nloc;
        if (old + 1u == (gen + 1u) * nloc) {
            __builtin_amdgcn_fence(__ATOMIC_RELEASE, "agent");
            asm volatile("s_waitcnt vmcnt(0)" ::: "memory");
            const unsigned og = xb_add(&bar[XB_TOP], 1u);
            const unsigned tg = og / nx;
            if (og + 1u == (tg + 1u) * nx) xb_add(&bar[XB_TOPGEN], 1u);
            else XB_SPIN(xb_ld(&bar[XB_TOPGEN]) == tg, bar);
            __builtin_amdgcn_fence(__ATOMIC_ACQUIRE, "agent");
            xb_add(&bar[XB_XGEN(b.x)], 1u);
            asm volatile("s_waitcnt vmcnt(0)" ::: "memory");
        } else {
            XB_SPIN(xb_ld(&bar[XB_XGEN(b.x)]) == gen, bar);
            __builtin_amdgcn_fence(__ATOMIC_ACQUIRE, "agent");
            asm volatile("s_waitcnt vmcnt(0)" ::: "memory");
        }
    }
    __syncthreads();
}
#endif

namespace pg8 {
constexpr int BM = 256, BK = 64, HALF = 128, HTB = HALF * BK * 2, STAGE_BYTES = 8 * HTB, NXCD = 8, WGM = 8;
__host__ __device__ __forceinline__ int lds_byte(int r, int c) { const int st = (r >> 4) * 2 + (c >> 5), rr = r & 15, cc = c & 31, ob = rr * 64 + cc * 2; return st * 1024 + (ob ^ (((ob >> 9) & 1) << 5)); }
__host__ __device__ __forceinline__ void stage_rc(int b, int& R, int& C) { const int st = b / 1024, sb = b % 1024, swz = sb ^ (((sb >> 9) & 1) << 5); R = (st >> 1) * 16 + swz / 64; C = (st & 1) * 32 + (swz % 64) / 2; }
__host__ __device__ __forceinline__ int perm32(int rho) { const int n = rho >> 4, i = rho & 15; return 8 * (i >> 2) + 4 * n + (i & 3); }
struct Unit { int pm, pn, koff, seg; };
struct Gemm { const bf16* A; const bf16* Bt; int M, N, K, lda, ldb; };
struct StaticOrder {
    int nM, nN, nwg, G, c;
    __host__ __device__ void init(int M, int N, int G_, int c_) { nM = M / BM; nN = N / BM; nwg = nM * nN; G = G_; c = c_; }
    __host__ __device__ bool next(int i, Unit& u) const {
        const long L = (long)i * G + c; if (L >= nwg) return false;
        int wgid = (int)L; { const int q = nwg / NXCD, r = nwg % NXCD, xcd = wgid % NXCD, off = wgid / NXCD; wgid = (xcd < r ? xcd * (q + 1) : r * (q + 1) + (xcd - r) * q) + off; }
        const int nig = WGM * nN, gid = wgid / nig, fm = gid * WGM, gsz = (nM - fm) < WGM ? (nM - fm) : WGM;
        u.pm = fm + ((wgid % nig) % gsz); u.pn = (wgid % nig) / gsz; u.koff = 0; u.seg = 0; return true;
    }
};
struct SegOrder {
    StaticOrder S; int kseg;
    __host__ __device__ void init(int M, int N, int G_, int c_, int kseg_) { S.init(M, N, G_, c_); kseg = kseg_; }
    __host__ __device__ bool next(int i, Unit& u) const { if (!S.next(i >> 2, u)) return false; u.seg = i & 3; u.koff = u.seg * kseg; return true; }
};
#ifndef CPU_EMU
DEV unsigned cvt_pk_bf16(float lo, float hi) { unsigned r; asm volatile("v_cvt_pk_bf16_f32 %0, %1, %2" : "=v"(r) : "v"(lo), "v"(hi)); return r; }
#endif
DEV unsigned long long rss_fix(float ss) { return (unsigned long long)(ss * 16777216.0f + 0.5f); }
DEV float rss_val(unsigned long long v) { return (float)v * (1.0f / 16777216.0f); }

struct EpiSwiGLU {
    static constexpr bool PERM = true;
    bf16* act; const unsigned long long* rss;
    DEV void operator()(const f32x4 (&acc)[2][2][4][2], const Unit& u, int wr, int wc, int fr, int fq) const {
        const int row0 = u.pm * BM + wr * 64 + fr, col0 = u.pn * HALF + wc * 32 + 8 * fq;
#pragma unroll
        for (int ai = 0; ai < 2; ++ai)
#pragma unroll
            for (int m = 0; m < 4; ++m) {
                const int row = row0 + ai * HALF + m * 16;
                const float rs = rsqrtf(rss_val(rss[row]) * (1.0f / DM) + EPS);
                float o[8];
#pragma unroll
                for (int n = 0; n < 2; ++n)
#pragma unroll
                    for (int j = 0; j < 4; ++j) { const float a = acc[ai][0][m][n][j] * rs, b = acc[ai][1][m][n][j] * rs; o[4 * n + j] = a * b * __builtin_amdgcn_rcpf(1.0f + __expf(-a)); }
                u32x4 w; w.x = cvt_pk_bf16(o[0], o[1]); w.y = cvt_pk_bf16(o[2], o[3]); w.z = cvt_pk_bf16(o[4], o[5]); w.w = cvt_pk_bf16(o[6], o[7]);
                *(u32x4*)(act + (size_t)row * DFF + col0) = w;
            }
    }
};
struct EpiResidual {
    static constexpr bool PERM = true;
    float* x; bf16* xb; unsigned long long* rss_out; float alpha;
    DEV void operator()(const f32x4 (&acc)[2][2][4][2], const Unit& u, int wr, int wc, int fr, int fq) const {
        const int row0 = u.pm * BM + wr * 64 + fr, col0 = u.pn * BM + wc * 32 + 8 * fq;
#pragma unroll
        for (int ai = 0; ai < 2; ++ai)
#pragma unroll
            for (int m = 0; m < 4; ++m) {
                const int row = row0 + ai * HALF + m * 16; float ss = 0.f;
#pragma unroll
                for (int bj = 0; bj < 2; ++bj) {
                    float* xp = x + (size_t)row * DM + col0 + bj * HALF;
                    f32x4 x0 = *(const f32x4*)xp, x1 = *(const f32x4*)(xp + 4);
                    x0 = x0 + acc[ai][bj][m][0] * alpha; x1 = x1 + acc[ai][bj][m][1] * alpha;
                    *(f32x4*)xp = x0; *(f32x4*)(xp + 4) = x1;
                    ss += (x0[0] * x0[0] + x0[1] * x0[1]) + (x0[2] * x0[2] + x0[3] * x0[3]) + (x1[0] * x1[0] + x1[1] * x1[1]) + (x1[2] * x1[2] + x1[3] * x1[3]);
                    u32x4 w; w.x = cvt_pk_bf16(x0[0], x0[1]); w.y = cvt_pk_bf16(x0[2], x0[3]); w.z = cvt_pk_bf16(x1[0], x1[1]); w.w = cvt_pk_bf16(x1[2], x1[3]);
                    *(u32x4*)(xb + (size_t)row * DM + col0 + bj * HALF) = w;
                }
                ss += shx<16>(ss); ss += shx<32>(ss);
                if (fq == 0) atomicAdd(rss_out + row, rss_fix(ss));
            }
    }
};
struct EpiWin {
    static constexpr bool PERM = true;
    bf16* p1; float* small; bf16* gate; const unsigned long long* rss;
    DEV void operator()(const f32x4 (&acc)[2][2][4][2], const Unit& u, int wr, int wc, int fr, int fq) const {
        const int row0 = u.pm * BM + wr * 64 + fr, cl0 = wc * 32 + 8 * fq;
#pragma unroll
        for (int ai = 0; ai < 2; ++ai)
#pragma unroll
            for (int m = 0; m < 4; ++m) {
                const int row = row0 + ai * HALF + m * 16;
                const float rs = rsqrtf(rss_val(rss[row]) * (1.0f / DM) + EPS);
#pragma unroll
                for (int bj = 0; bj < 2; ++bj) {
                    f32x4 v0 = acc[ai][bj][m][0] * rs, v1 = acc[ai][bj][m][1] * rs;
                    const int cl = cl0 + bj * HALF;
                    if (u.pn < 26) {
                        u32x4 w; w.x = cvt_pk_bf16(v0[0], v0[1]); w.y = cvt_pk_bf16(v0[2], v0[3]); w.z = cvt_pk_bf16(v1[0], v1[1]); w.w = cvt_pk_bf16(v1[2], v1[3]);
                        *(u32x4*)(p1 + (size_t)row * P1W + u.pn * BM + cl) = w;
                    } else if (u.pn == 26) {
                        if (cl < SMW) { float* sp = small + (size_t)row * SMW + cl; *(f32x4*)sp = v0; *(f32x4*)(sp + 4) = v1; }
                    } else {
#pragma unroll
                        for (int j = 0; j < 4; ++j) { v0[j] = fminf(__builtin_amdgcn_rcpf(1.0f + __expf(-v0[j])), 1.0f); v1[j] = fminf(__builtin_amdgcn_rcpf(1.0f + __expf(-v1[j])), 1.0f); }
                        u32x4 w; w.x = cvt_pk_bf16(v0[0], v0[1]); w.y = cvt_pk_bf16(v0[2], v0[3]); w.z = cvt_pk_bf16(v1[0], v1[1]); w.w = cvt_pk_bf16(v1[2], v1[3]);
                        *(u32x4*)(gate + (size_t)row * 6144 + (u.pn - 27) * BM + cl) = w;
                    }
                }
            }
    }
};
struct EpiMergeSeg {
    static constexpr bool PERM = true;
    bf16* merged; float* tmp; const bf16* gate; const float* rc;
    DEV void operator()(const f32x4 (&acc)[2][2][4][2], const Unit& u, int wr, int wc, int fr, int fq) const {
        const int row0 = u.pm * BM + wr * 64 + fr, col0 = u.pn * BM + wc * 32 + 8 * fq, seg = u.seg, gi = seg < 2 ? seg : 2;
#pragma unroll
        for (int ai = 0; ai < 2; ++ai)
#pragma unroll
            for (int m = 0; m < 4; ++m) {
                const int row = row0 + ai * HALF + m * 16;
                const float r = seg >= 2 ? rc[(size_t)row * 2 + (seg - 2)] : 1.0f;
#pragma unroll
                for (int bj = 0; bj < 2; ++bj) {
                    const int col = col0 + bj * HALF;
                    const u32x4 w = *(const u32x4*)(gate + (size_t)row * 6144 + gi * DM + col);
                    f32x4 s0 = (f32x4){bflo(w.x), bfhi(w.x), bflo(w.y), bfhi(w.y)} * r, s1 = (f32x4){bflo(w.z), bfhi(w.z), bflo(w.w), bfhi(w.w)} * r;
                    f32x4 v0 = acc[ai][bj][m][0] * s0, v1 = acc[ai][bj][m][1] * s1;
                    float* tp = tmp + (size_t)row * DM + col;
                    if (seg > 0) { v0 = v0 + *(const f32x4*)tp; v1 = v1 + *(const f32x4*)(tp + 4); }
                    if (seg < 3) { *(f32x4*)tp = v0; *(f32x4*)(tp + 4) = v1; }
                    else { u32x4 o; o.x = cvt_pk_bf16(v0[0], v0[1]); o.y = cvt_pk_bf16(v0[2], v0[3]); o.z = cvt_pk_bf16(v1[0], v1[1]); o.w = cvt_pk_bf16(v1[2], v1[3]);
                        *(u32x4*)(merged + (size_t)row * DM + col) = o; }
                }
            }
    }
};

#ifndef CPU_EMU
template <class Epi, class Sched>
DEV void gemm_phase(LAS unsigned char* lds, const int tid, const Gemm g, const Sched& S, const Epi& E) {
    const int wid = __builtin_amdgcn_readfirstlane(tid >> 6), lane = tid & 63, wr = wid >> 2, wc = wid & 3, fr = lane & 15, fq = lane >> 4;
    const int K = g.K, nt = K / BK;
    const float zf_ = opaque_zero();
    unsigned voffA[2], voffB[2];
#pragma unroll
    for (int i = 0; i < 2; ++i) { int R, C; stage_rc(tid * 16 + i * 8192, R, C); const int Rb = Epi::PERM ? ((R & ~31) + perm32(R & 31)) : R;
        voffA[i] = (unsigned)(R * g.lda + C) * 2u; voffB[i] = (unsigned)(Rb * g.ldb + C) * 2u; }
    const size_t kstep = (size_t)(BK * 2);
    const size_t hA = (size_t)HALF * g.lda * 2, hB = (size_t)HALF * g.ldb * 2;
    const size_t tA = 2 * hA, tB = 2 * hB;
    const unsigned ldsw = (unsigned)wid * 1024u;
    const int aoff = lds_byte(wr * 64 + fr, fq * 8), boff = lds_byte(wc * 32 + fr, fq * 8);
#define PG8_SA(b, h) (((b) * 2 + (h)) * HTB)
#define PG8_SB(b, h) ((4 + (b) * 2 + (h)) * HTB)
#define PG8_STAGE(bufoff, gbase, voff) do { _Pragma("unroll") for (int _i = 0; _i < 2; ++_i) \
        __builtin_amdgcn_global_load_lds((const unsigned*)((const char*)(gbase) + (voff)[_i]), (LAS unsigned*)(lds + (bufoff) + ldsw + _i * 8192), 16, 0, 0); } while (0)
#define PG8_LDA(dst, b, h) do { _Pragma("unroll") for (int m = 0; m < 4; ++m) _Pragma("unroll") for (int k = 0; k < 2; ++k) dst[m][k] = *(const LAS bf16x8*)(lds + PG8_SA(b, h) + aoff + m * 2048 + k * 1024); } while (0)
#define PG8_LDB(dst, b, h) do { _Pragma("unroll") for (int n = 0; n < 2; ++n) _Pragma("unroll") for (int k = 0; k < 2; ++k) dst[n][k] = *(const LAS bf16x8*)(lds + PG8_SB(b, h) + boff + n * 2048 + k * 1024); } while (0)
#define PG8_MMA(ai, bj, At, Bt) do { __builtin_amdgcn_s_setprio(1); _Pragma("unroll") for (int m = 0; m < 4; ++m) _Pragma("unroll") for (int n = 0; n < 2; ++n) _Pragma("unroll") for (int k = 0; k < 2; ++k) \
        acc[ai][bj][m][n] = __builtin_amdgcn_mfma_f32_16x16x32_bf16(Bt[n][k], At[m][k], acc[ai][bj][m][n], 0, 0, 0); __builtin_amdgcn_s_setprio(0); } while (0)
#define PG8_WAIT_V(n) asm volatile("s_waitcnt vmcnt(" #n ")" ::: "memory")
#define PG8_WAIT_L(n) asm volatile("s_waitcnt lgkmcnt(" #n ")" ::: "memory")
#define PG8_BAR __builtin_amdgcn_s_barrier()
#define PG8_SCHED __builtin_amdgcn_sched_barrier(0)
    Unit cur, nxt; int ui = 0;
    if (!S.next(0, cur)) return;
    f32x4 acc[2][2][4][2];
#pragma unroll
    for (int a = 0; a < 2; ++a)
#pragma unroll
        for (int b = 0; b < 2; ++b)
#pragma unroll
            for (int m = 0; m < 4; ++m)
#pragma unroll
                for (int n = 0; n < 2; ++n) acc[a][b][m][n] = ZERO4;
    bf16x8 At[4][2], B0[2][2], B1[2][2];
    const char* cA = (const char*)g.A + (size_t)cur.pm * tA + (size_t)cur.koff * 2; const char* cB = (const char*)g.Bt + (size_t)cur.pn * tB + (size_t)cur.koff * 2;
    PG8_STAGE(PG8_SB(0, 0), cB, voffB); PG8_STAGE(PG8_SB(0, 1), cB + hB, voffB); PG8_STAGE(PG8_SA(0, 0), cA, voffA); PG8_STAGE(PG8_SA(0, 1), cA + hA, voffA);
    if (wr == 1) PG8_BAR;
    PG8_WAIT_V(2); PG8_BAR;
    PG8_STAGE(PG8_SB(1, 0), cB + kstep, voffB); PG8_STAGE(PG8_SA(1, 0), cA + kstep, voffA); PG8_STAGE(PG8_SB(1, 1), cB + hB + kstep, voffB);
    PG8_WAIT_V(6); PG8_BAR;
    for (;;) {
        const bool has_next = S.next(ui + 1, nxt);
        const char* nA = has_next ? (const char*)g.A + (size_t)nxt.pm * tA + (size_t)nxt.koff * 2 : cA; const char* nB = has_next ? (const char*)g.Bt + (size_t)nxt.pn * tB + (size_t)nxt.koff * 2 : cB;
        for (int t = 0; t < nt; t += 2) {
            const bool last = (t == nt - 2);
            const char* a1 = cA + (size_t)(t + 1) * kstep;
            const char* a2 = last ? nA : cA + (size_t)(t + 2) * kstep; const char* b2 = last ? nB : cB + (size_t)(t + 2) * kstep;
            const char* a3 = a2 + kstep; const char* b3 = b2 + kstep;
            PG8_LDB(B0, 0, 0); PG8_LDB(B1, 0, 1); PG8_SCHED; PG8_LDA(At, 0, 0); PG8_STAGE(PG8_SA(1, 1), a1 + hA, voffA);
            PG8_WAIT_V(8); PG8_WAIT_L(0); PG8_BAR; PG8_MMA(0, 0, At, B0); PG8_MMA(0, 1, At, B1); PG8_BAR; PG8_SCHED;
            PG8_LDA(At, 0, 1); PG8_STAGE(PG8_SB(0, 0), b2, voffB); PG8_STAGE(PG8_SB(0, 1), b2 + hB, voffB); PG8_STAGE(PG8_SA(0, 0), a2, voffA);
            PG8_WAIT_V(8); PG8_WAIT_L(0); PG8_BAR; PG8_MMA(1, 0, At, B0); PG8_MMA(1, 1, At, B1); PG8_BAR; PG8_SCHED;
            PG8_LDB(B0, 1, 0); PG8_LDB(B1, 1, 1); PG8_SCHED; PG8_LDA(At, 1, 0); PG8_STAGE(PG8_SA(0, 1), a2 + hA, voffA);
            PG8_WAIT_V(8); PG8_WAIT_L(0); PG8_BAR; PG8_MMA(0, 0, At, B0); PG8_MMA(0, 1, At, B1); PG8_BAR; PG8_SCHED;
            PG8_LDA(At, 1, 1); PG8_STAGE(PG8_SB(1, 0), b3, voffB); PG8_STAGE(PG8_SB(1, 1), b3 + hB, voffB); PG8_STAGE(PG8_SA(1, 0), a3, voffA);
            PG8_WAIT_V(8); PG8_WAIT_L(0); PG8_BAR; PG8_MMA(1, 0, At, B0); PG8_MMA(1, 1, At, B1); PG8_BAR; PG8_SCHED;
        }
        if (wr == 0) PG8_BAR;
        E(acc, cur, wr, wc, fr, fq);
        if (!has_next) break;
#pragma unroll
        for (int a = 0; a < 2; ++a)
#pragma unroll
            for (int b = 0; b < 2; ++b)
#pragma unroll
                for (int m = 0; m < 4; ++m)
#pragma unroll
                    for (int n = 0; n < 2; ++n) acc[a][b][m][n] = ZERO4;
        cur = nxt; cA = nA; cB = nB; ++ui;
        if (wr == 1) PG8_BAR;
    }
    PG8_WAIT_V(0);
    PG8_BAR;
#undef PG8_SA
#undef PG8_SB
#undef PG8_STAGE
#undef PG8_LDA
#undef PG8_LDB
#undef PG8_MMA
#undef PG8_WAIT_V
#undef PG8_WAIT_L
#undef PG8_BAR
#undef PG8_SCHED
}
#endif
}

#ifndef CPU_EMU
typedef const __attribute__((address_space(4))) Params* KParams;
#else
typedef const Params* KParams;
#endif
struct Frame {
    LAS unsigned char* lds;
    int tid, lane, wave, G, bid;
    KParams p;
    unsigned char* ws;
};
DEV const float* lin(const Frame& F, int idx, int layer, size_t per_layer) { return F.p->in[idx] + (size_t)layer * per_layer; }
#define WSP(T, off) ((T*)(F.ws + (off)))

DEV int up_dest(int n) { return n < DFF ? (n >> 7) * 256 + (n & 127) : ((n - DFF) >> 7) * 256 + 128 + ((n - DFF) & 127); }
DEV int win_dest(int n) {
    if (n < 2048) return n;
    if (n < 2052) return SM0 + S_AA + (n - 2048);
    if (n < 2056) return SM0 + S_AB + (n - 2052);
    if (n < 4104) return C_BQ + (n - 2056);
    if (n < 4116) return SM0 + S_BG + (n - 4104);
    if (n < 6676) return C_CZ + (n - 4116);
    if (n < 6692) return SM0 + S_DT + (n - 6676);
    return GT0 + (n - 6692);
}
DEV void transpose_item(const float* W, int K, int N, bf16* WT, int ldt, int koff, const float* kscale, int mode, LAS float* scr, int item, int lane) {
    const int nblk = (N + 31) / 32, kb = item / nblk, nb = item % nblk, k0 = 64 * kb, n0 = 32 * nb;
    const int nn = n0 + (lane & 31);
#pragma unroll 8
    for (int i = 0; i < 32; ++i) { const int kk = 2 * i + (lane >> 5); float v = 0.f; if (nn < N) v = W[(size_t)(k0 + kk) * N + nn]; if (kscale) v *= kscale[k0 + kk]; scr[kk * 33 + (lane & 31)] = v; }
    LDS_WAIT(); CFENCE();
    const int c = lane & 7;
#pragma unroll
    for (int j = 0; j < 4; ++j) { const int n = (lane >> 3) + 8 * j; const LAS float* s = scr + (8 * c) * 33 + n;
        u32x4 o; o.x = pk2(s[0 * 33], s[1 * 33]); o.y = pk2(s[2 * 33], s[3 * 33]); o.z = pk2(s[4 * 33], s[5 * 33]); o.w = pk2(s[6 * 33], s[7 * 33]);
        const int ng = n0 + n;
        if (ng < N) { const int dr = mode == 0 ? ng : (mode == 1 ? up_dest(ng) : win_dest(ng)); *(u32x4*)(WT + (size_t)dr * ldt + koff + k0 + 8 * c) = o; } }
    LDS_WAIT(); CFENCE();
}
DEV void phase_convert(Frame& F, int l) {
    LAS float* scr = (LAS float*)(F.lds + F.wave * 16384);
    const int gw = F.bid * 8 + F.wave, NGW = F.G * 8;
    constexpr int I_UP = (DM / 64) * (NUP / 32), I_DN = (DFF / 64) * (DM / 32), I_IN = (DM / 64) * ((NIN + 31) / 32), I_P5 = (512 / 64) * (DM / 32), I_P10 = (1024 / 64) * (DM / 32), I_OO = (DM / 64) * (DM / 32), I_CK = (4096 / 64) * (128 / 32);
    constexpr int NITEMS = 2 * I_UP + 2 * I_DN + I_IN + 2 * I_P5 + I_P10 + I_OO + 2 * I_CK;
    for (int it = gw; it < NITEMS; it += NGW) {
        int r = it; const float* W; const float* ks = nullptr; bf16* WT; int K, N, ldt, koff = 0, mode = 0;
        if (r < I_UP) { W = lin(F, I_WUP1, l, (size_t)DM * NUP); K = DM; N = NUP; WT = WSP(bf16, WS_WUP1); ldt = DM; ks = lin(F, I_GF1, l, DM); mode = 1; }
        else if ((r -= I_UP) < I_UP) { W = lin(F, I_WUP2, l, (size_t)DM * NUP); K = DM; N = NUP; WT = WSP(bf16, WS_WUP2); ldt = DM; ks = lin(F, I_GF2, l, DM); mode = 1; }
        else if ((r -= I_UP) < I_DN) { W = lin(F, I_WDN1, l, (size_t)DFF * DM); K = DFF; N = DM; WT = WSP(bf16, WS_WDN1); ldt = DFF; }
        else if ((r -= I_DN) < I_DN) { W = lin(F, I_WDN2, l, (size_t)DFF * DM); K = DFF; N = DM; WT = WSP(bf16, WS_WDN2); ldt = DFF; }
        else if ((r -= I_DN) < I_IN) { W = lin(F, I_WIN, l, (size_t)DM * NIN); K = DM; N = NIN; WT = WSP(bf16, WS_WIN); ldt = DM; ks = lin(F, I_GMIX, l, DM); mode = 2; }
        else if ((r -= I_IN) < I_P5) { W = lin(F, I_PA, l, (size_t)512 * DM); K = 512; N = DM; WT = WSP(bf16, WS_WPM); ldt = DM; }
        else if ((r -= I_P5) < I_P5) { W = lin(F, I_PB, l, (size_t)512 * DM); K = 512; N = DM; WT = WSP(bf16, WS_WPM); ldt = DM; koff = 512; }
        else if ((r -= I_P5) < I_P10) { W = lin(F, I_PC, l, (size_t)1024 * DM); K = 1024; N = DM; WT = WSP(bf16, WS_WPM); ldt = DM; koff = 1024; ks = lin(F, I_SNORM, l, 1024); }
        else if ((r -= I_P10) < I_OO) { W = lin(F, I_WO, l, (size_t)DM * DM); K = DM; N = DM; WT = WSP(bf16, WS_WO); ldt = DM; }
        else if ((r -= I_OO) < I_CK) { W = lin(F, I_NWCK, l, (size_t)4096 * 128); K = 4096; N = 128; WT = WSP(bf16, WS_WCK); ldt = 4096; }
        else { r -= I_CK; W = lin(F, I_NWCV, l, (size_t)4096 * 128); K = 4096; N = 128; WT = WSP(bf16, WS_WCV); ldt = 4096; }
        transpose_item(W, K, N, WT, ldt, koff, ks, mode, scr, r, F.lane);
    }
    { bf16* w = WSP(bf16, WS_WIN) + (size_t)(SM0 + 36) * DM; const int n16 = (GT0 - SM0 - 36) * DM / 8;
      const unsigned zu = __builtin_bit_cast(unsigned, opaque_zero());
      for (int i = F.bid * 512 + F.tid; i < n16; i += F.G * 512) ((u32x4*)w)[i] = (u32x4){zu, zu, zu, zu}; }
    { const float* pek = lin(F, I_NPEK, l, 4096); const float* pev = lin(F, I_NPEV, l, 4096); float* cst = WSP(float, WS_CONST);
      for (int it = gw; it < 256; it += NGW) { const int e = it & 127; const float* pe = it < 128 ? pek : pev; const float* w = it < 128 ? lin(F, I_NWCK, l, (size_t)4096 * 128) : lin(F, I_NWCV, l, (size_t)4096 * 128); float s = 0.f;
          for (int k = F.lane; k < 4096; k += 64) s += pe[k] * w[(size_t)k * 128 + e];
          s = wave_sum(s); if (F.lane == 0) cst[it] = s; } }
    if (l == 0) {
        const float* x = F.p->in[I_X]; float* out = F.p->out; bf16* xb = WSP(bf16, WS_XB); unsigned long long* rss = WSP(unsigned long long, WS_CTL) + CW_RS / 2;
        for (int m = gw; m < MTOK; m += NGW) {
            const f32x4* xr = (const f32x4*)(x + (size_t)m * DM) + F.lane; f32x4* orow = (f32x4*)(out + (size_t)m * DM) + F.lane; u32x2* br = (u32x2*)(xb + (size_t)m * DM) + F.lane; float ss = 0.f;
#pragma unroll
            for (int j = 0; j < 8; ++j) { const f32x4 v = xr[64 * j]; orow[64 * j] = v; ss += (v[0] * v[0] + v[1] * v[1]) + (v[2] * v[2] + v[3] * v[3]); u32x2 w; w.x = pk2(v[0], v[1]); w.y = pk2(v[2], v[3]); br[64 * j] = w; }
            ss = wave_sum(ss); if (F.lane == 0) rss[m] = pg8::rss_fix(ss);
        }
    }
}

DEV void nsa_prep_job(Frame& F, int l, int job) {
    const int b = job >> 8, g = (job >> 7) & 1, j = job & 127, bg = b * 2 + g, t0 = 64 * j;
    const bf16* p1 = WSP(bf16, WS_P1);
    const float* qn = lin(F, I_NQN, l, 128); const float* kn = lin(F, I_NKN, l, 128);
    bf16* QN = WSP(bf16, WS_QN); bf16* KS = WSP(bf16, WS_KS); bf16* KW = WSP(bf16, WS_KW); bf16* VST = WSP(bf16, WS_VST); bf16* VWT = WSP(bf16, WS_VWT);
    const float gq0 = qn[2 * F.lane], gq1 = qn[2 * F.lane + 1], gk0 = kn[2 * F.lane], gk1 = kn[2 * F.lane + 1];
    for (int i = 0; i < 8; ++i) {
        const int t = t0 + 8 * F.wave + i; const size_t row = (size_t)(b * SEQ + t) * P1W;
#pragma unroll
        for (int v = 0; v < 4; ++v) {
            const int col = v < 2 ? C_BQ + (g * 2 + v) * 128 : (v == 2 ? C_BKS + g * 128 : C_BKW + g * 128);
            const unsigned w = *(const unsigned*)(p1 + row + col + 2 * F.lane);
            const float x0 = bflo(w), x1 = bfhi(w);
            const float ss = wave_sum(x0 * x0 + x1 * x1);
            float r = rsqrtf(ss * (1.0f / 128.0f) + EPS);
            unsigned o;
            if (v < 2) { r *= 0.08838834764831845f; o = pk2(x0 * r * gq0, x1 * r * gq1); *(unsigned*)(QN + ((size_t)(bg * SEQ + t) * 2 + v) * 128 + 2 * F.lane) = o; }
            else { o = pk2(x0 * r * gk0, x1 * r * gk1); *(unsigned*)((v == 2 ? KS : KW) + (size_t)(bg * SEQ + t) * 128 + 2 * F.lane) = o; }
        }
    }
    LAS bf16* tl = (LAS bf16*)F.lds;
    for (int i = F.tid; i < 2 * 64 * 64; i += 512) {
        const int v = i >> 12, r = (i >> 6) & 63, c2 = i & 63;
        const unsigned w = *(const unsigned*)(p1 + (size_t)(b * SEQ + t0 + r) * P1W + (v ? C_BVW : C_BVS) + g * 128 + 2 * c2);
        *(LAS unsigned*)(tl + (v * 64 + r) * 130 + 2 * c2) = w;
    }
    __syncthreads();
    for (int i = F.tid; i < 2 * 128 * 8; i += 512) {
        const int v = i >> 10, d = i & 127, tc = (i >> 7) & 7;
        const LAS bf16* s = tl + (v * 64 + 8 * tc) * 130 + d;
        u32x4 o; o.x = s[0] | ((unsigned)s[130] << 16); o.y = s[260] | ((unsigned)s[390] << 16); o.z = s[520] | ((unsigned)s[650] << 16); o.w = s[780] | ((unsigned)s[910] << 16);
        *(u32x4*)((v ? VWT : VST) + ((size_t)(bg * 128 + j) * 128 + d) * 64 + 8 * tc) = o;
    }
    __syncthreads();
}

DEV void gdn_prep_job(Frame& F, int l, int job) {
    const int b = job >> 9, h = (job >> 7) & 3, c = job & 127, t0 = 64 * c;
    const bf16* p1 = WSP(bf16, WS_P1); const float* small = WSP(float, WS_SMALL);
    const float* convw = lin(F, I_GCONV, l, 4 * 1536);
    LAS float* Qs = (LAS float*)F.lds;
    LAS float* Ks = Qs + 64 * 132;
    LAS float* Vs = Ks + 64 * 132;
    LAS float* Mm = Vs + 64 * 132;
    LAS float* At = Mm + 64 * 68;
    LAS float* beta = At + 64 * 68;
    LAS float* gc = beta + 64;
    LAS float* eg = gc + 64;
    const int tid = F.tid;
    {
        const int ch = tid & 127, tg = tid >> 7;
#pragma unroll
        for (int v = 0; v < 3; ++v) {
            const int cc = v * 512 + h * 128 + ch;
            const float w0 = convw[cc], w1 = convw[1536 + cc], w2 = convw[2 * 1536 + cc], w3 = convw[3 * 1536 + cc];
            const int col = (v == 0 ? C_AQ : (v == 1 ? C_AK : C_AV)) + h * 128 + ch;
            float xm3, xm2, xm1;
            { const int tt = t0 + 16 * tg; xm3 = tt >= 3 ? bf2f(p1[(size_t)(b * SEQ + tt - 3) * P1W + col]) : 0.f; xm2 = tt >= 2 ? bf2f(p1[(size_t)(b * SEQ + tt - 2) * P1W + col]) : 0.f; xm1 = tt >= 1 ? bf2f(p1[(size_t)(b * SEQ + tt - 1) * P1W + col]) : 0.f; }
            LAS float* dst = v == 0 ? Qs : (v == 1 ? Ks : Vs);
            for (int i = 0; i < 16; ++i) {
                const int tl = 16 * tg + i; const float x0 = bf2f(p1[(size_t)(b * SEQ + t0 + tl) * P1W + col]);
                const float y = w0 * xm3 + w1 * xm2 + w2 * xm1 + w3 * x0;
                dst[tl * 132 + ch] = siluf_(y);
                xm3 = xm2; xm2 = xm1; xm1 = x0;
            }
        }
        if (tid < 64) {
            const size_t row = (size_t)(b * SEQ + t0 + tid);
            const float a = small[row * SMW + S_AA + h], bb = small[row * SMW + S_AB + h];
            beta[tid] = sigmoidf_(bb);
            gc[tid] = -__expf(lin(F, I_GALOG, l, 4)[h]) * softplusf_(a + lin(F, I_GDTB, l, 4)[h]);
        }
    }
    __syncthreads();
    for (int i = 0; i < 16; ++i) {
        const int r = F.wave * 16 + i;
        LAS float* p = (r < 64 ? Qs + r * 132 : Ks + (r - 64) * 132);
        const float x0 = p[F.lane], x1 = p[F.lane + 64];
        const float ss = wave_sum(x0 * x0 + x1 * x1);
        float sc = rsqrtf(ss + EPS); if (r < 64) sc *= 0.08838834764831845f;
        p[F.lane] = x0 * sc; p[F.lane + 64] = x1 * sc;
    }
    if (tid == 0) { float s = 0.f; for (int i = 0; i < 64; ++i) { s += gc[i]; gc[i] = s; eg[i] = __expf(s); } }
    __syncthreads();
    {
        const int i = tid >> 3, jg = tid & 7;
        float kk[8], qk[8];
#pragma unroll
        for (int jj = 0; jj < 8; ++jj) { kk[jj] = 0.f; qk[jj] = 0.f; }
        const LAS f32x4* ki4 = (const LAS f32x4*)(Ks + i * 132); const LAS f32x4* qi4 = (const LAS f32x4*)(Qs + i * 132);
        for (int d4 = 0; d4 < 32; ++d4) {
            const f32x4 ki = ki4[d4], qi = qi4[d4];
#pragma unroll
            for (int jj = 0; jj < 8; ++jj) { const f32x4 kj = ((const LAS f32x4*)(Ks + (jg + 8 * jj) * 132))[d4];
                kk[jj] += (ki[0] * kj[0] + ki[1] * kj[1]) + (ki[2] * kj[2] + ki[3] * kj[3]); qk[jj] += (qi[0] * kj[0] + qi[1] * kj[1]) + (qi[2] * kj[2] + qi[3] * kj[3]); }
        }
        const float gi = gc[i], bi = beta[i];
#pragma unroll
        for (int jj = 0; jj < 8; ++jj) { const int j = jg + 8 * jj; const float dec = j <= i ? __expf(gi - gc[j]) : 0.f;
            Mm[i * 68 + j] = j < i ? bi * kk[jj] * dec : 0.f; At[i * 68 + j] = qk[jj] * dec; }
    }
    __syncthreads();
    unsigned char* cb = F.ws + WS_GW + (size_t)job * GDN_CH_BYTES;
    bf16* gW = (bf16*)cb; bf16* gQD = (bf16*)(cb + 16384); bf16* gKDT = (bf16*)(cb + 32768); bf16* gUT = (bf16*)(cb + 49152); bf16* gAT = (bf16*)(cb + 65536);
    float sol[64];
    if (tid < 256) {
        const int cidx = tid & 127; const bool isw = tid >= 128;
        const LAS float* src = (isw ? Ks : Vs) + cidx;
        const LAS float* MmL = (const LAS float*)lds_vbase(Mm); const LAS float* betaL = (const LAS float*)lds_vbase(beta); const LAS float* egL = (const LAS float*)lds_vbase(eg);
#pragma unroll
        for (int i = 0; i < 64; ++i) sol[i] = 0.f;
#pragma unroll
        for (int i = 0; i < 64; ++i) {
            float r = src[i * 132] * betaL[i] * (isw ? egL[i] : 1.0f);
#pragma unroll
            for (int j4 = 0; j4 < (i + 3) / 4; ++j4) { const f32x4 mv = *(const LAS f32x4*)(MmL + i * 68 + 4 * j4);
                r -= mv[0] * sol[4 * j4]; r -= mv[1] * sol[4 * j4 + 1]; r -= mv[2] * sol[4 * j4 + 2]; r -= mv[3] * sol[4 * j4 + 3]; }
            sol[i] = r;
            asm volatile("" : "+v"(sol[i]) :: "memory");
        }
    } else {
        const int t2 = tid - 256;
        const float gl = gc[63];
        for (int i = t2; i < 64 * 16; i += 256) { const int r = i >> 4, c8 = (i & 15) * 8; const float e = eg[r]; const LAS float* s = Qs + r * 132 + c8;
            u32x4 o; o.x = pk2(s[0] * e, s[1] * e); o.y = pk2(s[2] * e, s[3] * e); o.z = pk2(s[4] * e, s[5] * e); o.w = pk2(s[6] * e, s[7] * e); *(u32x4*)(gQD + r * 128 + c8) = o; }
        for (int i = t2; i < 128 * 8; i += 256) { const int dk = i & 127, i8 = (i >> 7) * 8; float v[8];
#pragma unroll
            for (int q = 0; q < 8; ++q) v[q] = Ks[(i8 + q) * 132 + dk] * __expf(gl - gc[i8 + q]);
            u32x4 o; o.x = pk2(v[0], v[1]); o.y = pk2(v[2], v[3]); o.z = pk2(v[4], v[5]); o.w = pk2(v[6], v[7]); *(u32x4*)(gKDT + dk * 64 + i8) = o; }
        for (int i = t2; i < 64 * 8; i += 256) { const int r = i >> 3, c8 = (i & 7) * 8; const LAS float* s = At + r * 68 + c8;
            u32x4 o; o.x = pk2(s[0], s[1]); o.y = pk2(s[2], s[3]); o.z = pk2(s[4], s[5]); o.w = pk2(s[6], s[7]); *(u32x4*)(gAT + r * 64 + c8) = o; }
        if (t2 == 0) WSP(float, WS_GL)[job] = __expf(gl);
    }
    __syncthreads();
    LAS bf16* Wl = (LAS bf16*)Qs;
    if (tid < 128) {
#pragma unroll
        for (int q = 0; q < 8; ++q) { u32x4 o; o.x = pk2(sol[8 * q], sol[8 * q + 1]); o.y = pk2(sol[8 * q + 2], sol[8 * q + 3]); o.z = pk2(sol[8 * q + 4], sol[8 * q + 5]); o.w = pk2(sol[8 * q + 6], sol[8 * q + 7]);
            *(u32x4*)(gUT + tid * 64 + 8 * q) = o; }
    } else if (tid < 256) {
#pragma unroll
        for (int i = 0; i < 64; ++i) Wl[i * 136 + (tid - 128)] = (bf16)f2bf(sol[i]);
    }
    __syncthreads();
    for (int i = tid; i < 64 * 16; i += 512) { const int r = i >> 4, c8 = (i & 15) * 8; *(u32x4*)(gW + r * 128 + c8) = *(const LAS u32x4*)(Wl + r * 136 + c8); }
    __syncthreads();
}

DEV void ssd_prep_job(Frame& F, int l, int job) {
    const int b = job >> 7, c = (job >> 1) & 63, g = job & 1, t0 = 128 * c;
    const float zf_ = opaque_zero();
    const bf16* p1 = WSP(bf16, WS_P1); const float* small = WSP(float, WS_SMALL);
    const float* cw = lin(F, I_SCW, l, 4 * 1536); const float* cbias = lin(F, I_SCB, l, 1536);
    bf16* SX = WSP(bf16, WS_SX); float* SDT = WSP(float, WS_SDT); float* SAC = WSP(float, WS_SAC); float* SST = WSP(float, WS_SST); float* SCD = WSP(float, WS_SCD);
    LAS bf16* BT = (LAS bf16*)F.lds;
    LAS bf16* XT = BT + 128 * 136;
    LAS float* dts = (LAS float*)(XT + 64 * 136);
    LAS float* acs = dts + 128 * 8;
    const int tid = F.tid;
    for (int i = tid; i < 1024; i += 512) { const int tl = i >> 3, hh = i & 7, h = 8 * g + hh; const size_t row = (size_t)(b * SEQ + t0 + tl);
        const float dt = softplusf_(small[row * SMW + S_DT + h] + lin(F, I_SDTB, l, 16)[h]);
        dts[i] = dt; acs[i] = dt * (-__expf(lin(F, I_SALOG, l, 16)[h])); }
    __syncthreads();
    if (tid < 8) { float s = 0.f; for (int tl = 0; tl < 128; ++tl) { s += acs[tl * 8 + tid]; acs[tl * 8 + tid] = s; } }
    __syncthreads();
    for (int i = tid; i < 1024; i += 512) { const int tl = i >> 3, hh = i & 7; const size_t row = (size_t)(b * SEQ + t0 + tl); SDT[row * 16 + 8 * g + hh] = dts[i]; SAC[row * 16 + 8 * g + hh] = acs[i]; }
    if (tid < 8) SCD[(size_t)(b * 64 + c) * 16 + 8 * g + tid] = __expf(acs[127 * 8 + tid]);
    {
        const int ch = tid & 255, half = tid >> 8; const int cc = 1024 + (ch < 128 ? g * 128 + ch : 256 + g * 128 + (ch - 128));
        const float w0 = cw[cc], w1 = cw[1536 + cc], w2 = cw[2 * 1536 + cc], w3 = cw[3 * 1536 + cc], bs = cbias[cc];
        const int col = C_CX + cc; const int ts = t0 + 64 * half;
        float xm3 = ts >= 3 ? bf2f(p1[(size_t)(b * SEQ + ts - 3) * P1W + col]) : 0.f, xm2 = ts >= 2 ? bf2f(p1[(size_t)(b * SEQ + ts - 2) * P1W + col]) : 0.f, xm1 = ts >= 1 ? bf2f(p1[(size_t)(b * SEQ + ts - 1) * P1W + col]) : 0.f;
        for (int i = 0; i < 64; ++i) { const int tl = 64 * half + i; const size_t row = (size_t)(b * SEQ + t0 + tl); const float x0 = bf2f(p1[row * P1W + col]);
            const float y = siluf_(w0 * xm3 + w1 * xm2 + w2 * xm1 + w3 * x0 + bs); const bf16 yb = (bf16)f2bf(y);
            SX[row * 1536 + cc] = yb; if (ch < 128) BT[ch * 136 + tl] = yb;
            xm3 = xm2; xm2 = xm1; xm1 = x0; }
    }
    for (int hh = 0; hh < 8; ++hh) {
        const int h = 8 * g + hh;
        __syncthreads();
        {
            const int ch = tid & 63, tg = tid >> 6; const int cc = h * 64 + ch;
            const float w0 = cw[cc], w1 = cw[1536 + cc], w2 = cw[2 * 1536 + cc], w3 = cw[3 * 1536 + cc], bs = cbias[cc];
            const int col = C_CX + cc; const int ts = t0 + 16 * tg;
            float xm3 = ts >= 3 ? bf2f(p1[(size_t)(b * SEQ + ts - 3) * P1W + col]) : 0.f, xm2 = ts >= 2 ? bf2f(p1[(size_t)(b * SEQ + ts - 2) * P1W + col]) : 0.f, xm1 = ts >= 1 ? bf2f(p1[(size_t)(b * SEQ + ts - 1) * P1W + col]) : 0.f;
            const float al = acs[127 * 8 + hh];
            for (int i = 0; i < 16; ++i) { const int tl = 16 * tg + i; const size_t row = (size_t)(b * SEQ + t0 + tl); const float x0 = bf2f(p1[row * P1W + col]);
                const float y = siluf_(w0 * xm3 + w1 * xm2 + w2 * xm1 + w3 * x0 + bs); const bf16 yb = (bf16)f2bf(y);
                SX[row * 1536 + cc] = yb;
                XT[ch * 136 + tl] = (bf16)f2bf(bf2f(yb) * dts[tl * 8 + hh] * __expf(al - acs[tl * 8 + hh]));
                xm3 = xm2; xm2 = xm1; xm1 = x0; }
        }
        __syncthreads();
        {
            const int mt = F.wave & 3, nb = (F.wave >> 2) * 4;
            bf16x8 a[4];
#pragma unroll
            for (int ks = 0; ks < 4; ++ks) a[ks] = frag_l(XT, 136, 16 * mt, 32 * ks, F.lane);
            float* dst = SST + ((size_t)((b * 64 + c) * 16 + h) * 64) * 128;
#pragma unroll
            for (int q = 0; q < 4; ++q) { f32x4 acc = ZERO4;
#pragma unroll
                for (int ks = 0; ks < 4; ++ks) acc = mfma16(a[ks], frag_l(BT, 136, 16 * (nb + q), 32 * ks, F.lane), acc);
#pragma unroll
                for (int r = 0; r < 4; ++r) dst[(size_t)(16 * mt + 4 * (F.lane >> 4) + r) * 128 + 16 * (nb + q) + (F.lane & 15)] = acc[r]; }
        }
    }
    __syncthreads();
}

DEV void nsa_compress_job(Frame& F, int l, int job) {
    const int kv = job >> 4, bg = (job >> 2) & 3, rt = job & 3, b = bg >> 1, g = bg & 1, i0 = 128 * rt;
    const float zf_ = opaque_zero();
    const bf16* p1 = WSP(bf16, WS_P1); const bf16* Wt = WSP(bf16, kv ? WS_WCV : WS_WCK); const float* cst = WSP(float, WS_CONST) + kv * 128;
    const int col0 = (kv ? C_BVC : C_BKC) + g * 128;
    LAS bf16* As = (LAS bf16*)F.lds;
    LAS bf16* Bs = As + 128 * 72;
    LAS float* Cs = (LAS float*)(Bs + 128 * 72);
    const int tid = F.tid, wm = F.wave >> 1, wn = F.wave & 1;
    f32x4 acc[2][4];
#pragma unroll
    for (int i = 0; i < 2; ++i)
#pragma unroll
        for (int j = 0; j < 4; ++j) acc[i][j] = ZERO4;
    u32x4 ra[2], rb[2];
#define LOADK(ks_) do { _Pragma("unroll") for (int q = 0; q < 2; ++q) { const int ch = tid + 512 * q, r = ch >> 3, c8 = (ch & 7) * 8; \
            int t = 16 * (i0 + r) + ((ks_) >> 1); if (t > SEQ - 1) t = SEQ - 1;     \
            ra[q] = *(const u32x4*)(p1 + (size_t)(b * SEQ + t) * P1W + col0 + ((ks_) & 1) * 64 + c8); \
            rb[q] = *(const u32x4*)(Wt + (size_t)r * 4096 + 64 * (ks_) + c8); } } while (0)
    LOADK(0);
    for (int ks = 0; ks < 64; ++ks) {
        __syncthreads();
#pragma unroll
        for (int q = 0; q < 2; ++q) { const int ch = tid + 512 * q, r = ch >> 3, c8 = (ch & 7) * 8; *(LAS u32x4*)(As + r * 72 + c8) = ra[q]; *(LAS u32x4*)(Bs + r * 72 + c8) = rb[q]; }
        __syncthreads();
        if (ks + 1 < 64) LOADK(ks + 1);
#pragma unroll
        for (int k2 = 0; k2 < 2; ++k2) {
            bf16x8 a0 = frag_l(As, 72, 32 * wm, 32 * k2, F.lane), a1 = frag_l(As, 72, 32 * wm + 16, 32 * k2, F.lane);
#pragma unroll
            for (int j = 0; j < 4; ++j) { const bf16x8 bb = frag_l(Bs, 72, 64 * wn + 16 * j, 32 * k2, F.lane); acc[0][j] = mfma16(a0, bb, acc[0][j]); acc[1][j] = mfma16(a1, bb, acc[1][j]); }
        }
    }
    __syncthreads();
#pragma unroll
    for (int i = 0; i < 2; ++i)
#pragma unroll
        for (int j = 0; j < 4; ++j)
#pragma unroll
            for (int r = 0; r < 4; ++r) { const int col = 64 * wn + 16 * j + (F.lane & 15); Cs[(32 * wm + 16 * i + 4 * (F.lane >> 4) + r) * 132 + col] = acc[i][j][r] + cst[col]; }
    __syncthreads();
    if (kv == 0) {
        const float* kn = lin(F, I_NKN, l, 128); bf16* KC = WSP(bf16, WS_KCMP);
        const int r = tid >> 2, q = tid & 3; const LAS float* s = Cs + r * 132 + 32 * q; float ss = 0.f;
#pragma unroll
        for (int e = 0; e < 32; ++e) ss += s[e] * s[e];
        ss += shx<1>(ss); ss += shx<2>(ss);
        const float rs = rsqrtf(ss * (1.0f / 128.0f) + EPS);
        bf16* dst = KC + ((size_t)bg * 512 + i0 + r) * 128 + 32 * q;
#pragma unroll
        for (int e = 0; e < 32; e += 2) *(unsigned*)(dst + e) = pk2(s[e] * rs * kn[32 * q + e], s[e + 1] * rs * kn[32 * q + e + 1]);
    } else {
        bf16* VC = WSP(bf16, WS_VCMPT); const int e = tid & 127, q = tid >> 7;
#pragma unroll
        for (int i8 = 0; i8 < 4; ++i8) { const LAS float* s = Cs + (32 * q + 8 * i8) * 132 + e;
            u32x4 o; o.x = pk2(s[0], s[132]); o.y = pk2(s[264], s[396]); o.z = pk2(s[528], s[660]); o.w = pk2(s[792], s[924]);
            *(u32x4*)(VC + ((size_t)bg * 128 + e) * 512 + i0 + 32 * q + 8 * i8) = o; }
    }
    __syncthreads();
}
#undef LOADK

constexpr int AL_KT = 0, AL_VT = 17408, AL_PW = 35840, AL_TB = 54272, AL_SM = 60608, AL_UM = 61632, AL_PS = 61696, AL_IMP = 78336, AL_END = 111104;
DEV int rel_bucket_dev(int n) {
    if (n < 16) return n;
    int k = 16;
    k += (n >= 21); k += (n >= 27); k += (n >= 35); k += (n >= 46); k += (n >= 59); k += (n >= 77); k += (n >= 99); k += (n >= 128);
    k += (n >= 166); k += (n >= 216); k += (n >= 280); k += (n >= 363); k += (n >= 470); k += (n >= 609); k += (n >= 790);
    return k;
}
DEV void attn_fill_bias(Frame& F, int g) {
    LAS float* tb = (LAS float*)(F.lds + AL_TB); const float* rt = F.p->in[I_REL];
    for (int i = F.tid; i < 2 * 792; i += 512) { const int hg = i / 792, d = i - hg * 792; tb[i] = rt[rel_bucket_dev(d) * 4 + 2 * g + hg]; }
}
DEV void attn_load_tile(u32x4 (&rk)[2], u32x4 (&rv)[2], const bf16* ksrc, const bf16* vsrc, int vpitch, int tid) {
#pragma unroll
    for (int q = 0; q < 2; ++q) { const int ch = tid + 512 * q; rk[q] = *(const u32x4*)(ksrc + (size_t)ch * 8); rv[q] = *(const u32x4*)(vsrc + (size_t)(ch >> 3) * vpitch + (ch & 7) * 8); }
}
DEV void attn_store_tile(LAS unsigned char* lds, const u32x4 (&rk)[2], const u32x4 (&rv)[2], int tid) {
    LAS bf16* Kt = (LAS bf16*)(lds + AL_KT); LAS bf16* Vt = (LAS bf16*)(lds + AL_VT);
#pragma unroll
    for (int q = 0; q < 2; ++q) { const int ch = tid + 512 * q; *(LAS u32x4*)(Kt + (ch >> 4) * 136 + (ch & 15) * 8) = rk[q]; *(LAS u32x4*)(Vt + (ch >> 3) * 72 + (ch & 7) * 8) = rv[q]; }
}
template <int MODE>
DEV unsigned attn_scores(LAS unsigned char* lds, const bf16x8 (&qf)[4], int lane, int n0, int tok_base, int hg, const unsigned (&selbit)[4], f32x4 (&s)[4]) {
    const float zf_ = opaque_zero();
    const LAS bf16* Kt = (const LAS bf16*)(lds + AL_KT); const LAS float* tb = (const LAS float*)(lds + AL_TB) + hg * 792;
#pragma unroll
    for (int nt = 0; nt < 4; ++nt) { s[nt] = ZERO4;
#pragma unroll
        for (int ks = 0; ks < 4; ++ks) s[nt] = mfma16(qf[ks], frag_l(Kt, 136, 16 * nt, 32 * ks, lane), s[nt]); }
    unsigned vm = 0u;
#pragma unroll
    for (int nt = 0; nt < 4; ++nt) { const int n = n0 + 16 * nt + (lane & 15);
#pragma unroll
        for (int r = 0; r < 4; ++r) { const int t = tok_base + r; int dist; bool ok;
            if (MODE == 0) { dist = t - (16 * n + 31); ok = dist >= 0 && n < 511; }
            else if (MODE == 1) { dist = t - n; ok = dist >= 0 && selbit[r] != 0u; }
            else { dist = t - n; ok = dist >= 0 && dist < 512; }
            int di = dist < 0 ? 0 : dist; di = di > 790 ? 790 : di;
            s[nt][r] = ok ? s[nt][r] + tb[di] : -1e30f;
            vm |= (ok ? 1u : 0u) << (4 * nt + r); } }
    return vm;
}
DEV void attn_online(const f32x4 (&s)[4], unsigned vm, float (&m)[4], float (&l)[4], f32x4 (&p)[4], float (&sc)[4]) {
#pragma unroll
    for (int r = 0; r < 4; ++r) {
        float mx = fmaxf(fmaxf(s[0][r], s[1][r]), fmaxf(s[2][r], s[3][r])); mx = max16(mx);
        const float mn = fmaxf(m[r], mx); sc[r] = __expf(m[r] - mn); float rs = 0.f;
#pragma unroll
        for (int nt = 0; nt < 4; ++nt) { const float pv = ((vm >> (4 * nt + r)) & 1u) ? __expf(s[nt][r] - mn) : 0.f; p[nt][r] = pv; rs += pv; }
        rs = sum16(rs); l[r] = l[r] * sc[r] + rs; m[r] = mn;
    }
}
DEV void attn_pv(LAS unsigned char* lds, int wave, int lane, const f32x4 (&p)[4], f32x4 (&o)[8]) {
    LAS bf16* Pw = (LAS bf16*)(lds + AL_PW) + wave * (16 * 72); const LAS bf16* Vt = (const LAS bf16*)(lds + AL_VT);
#pragma unroll
    for (int nt = 0; nt < 4; ++nt)
#pragma unroll
        for (int r = 0; r < 4; ++r) Pw[(4 * (lane >> 4) + r) * 72 + 16 * nt + (lane & 15)] = (bf16)f2bf(p[nt][r]);
    WAVE_SYNC();
#pragma unroll
    for (int ks = 0; ks < 2; ++ks) { const bf16x8 pa = frag_l(Pw, 72, 0, 32 * ks, lane);
#pragma unroll
        for (int dt = 0; dt < 8; ++dt) o[dt] = mfma16(pa, frag_l(Vt, 72, 16 * dt, 32 * ks, lane), o[dt]); }
    WAVE_SYNC();
}
DEV void attn_load_q(Frame& F, int bg, int t0, bf16x8 (&qf)[4]) {
    const bf16* QN = WSP(bf16, WS_QN); const int rho = F.lane & 15;
    const bf16* src = QN + ((size_t)(bg * SEQ + t0 + 8 * F.wave + (rho & 7)) * 2 + (rho >> 3)) * 128 + 8 * (F.lane >> 4);
#pragma unroll
    for (int ks = 0; ks < 4; ++ks) qf[ks] = *(const bf16x8*)(src + 32 * ks);
}

DEV void nsa_cmp_job(Frame& F, int job) {
    const int bg = job >> 7, qt = job & 127, b = bg >> 1, g = bg & 1, t0 = 64 * qt, tid = F.tid, lane = F.lane, wave = F.wave;
    const int ntiles = (4 * qt + 2) / 64 + 1;
    const float zf_ = opaque_zero();
    const bf16* KC = WSP(bf16, WS_KCMP) + (size_t)bg * 512 * 128; const bf16* VC = WSP(bf16, WS_VCMPT) + (size_t)bg * 128 * 512;
    LAS float* PS = (LAS float*)(F.lds + AL_PS) + wave * (8 * 65); LAS float* IMP = (LAS float*)(F.lds + AL_IMP);
    __syncthreads();
    attn_fill_bias(F, g);
    for (int i = tid; i < 64 * 128; i += 512) IMP[i] = 0.f;
    if (lane < 8) PS[lane * 65] = 0.f;
    bf16x8 qf[4]; attn_load_q(F, bg, t0, qf);
    const int fq = lane >> 4, hg = fq >> 1, tok_base = t0 + 8 * wave + 4 * (fq & 1);
    const unsigned nosel[4] = {0u, 0u, 0u, 0u};
    float m[4] = {-1e30f, -1e30f, -1e30f, -1e30f}, l[4] = {0.f, 0.f, 0.f, 0.f};
    u32x4 rk[2], rv[2];
    attn_load_tile(rk, rv, KC, VC, 512, tid);
    for (int j = 0; j < ntiles; ++j) {
        __syncthreads(); attn_store_tile(F.lds, rk, rv, tid); __syncthreads();
        if (j + 1 < ntiles) attn_load_tile(rk, rv, KC + (size_t)(j + 1) * 64 * 128, VC + (j + 1) * 64, 512, tid);
        f32x4 s[4], p[4]; float sc[4];
        const unsigned vm = attn_scores<0>(F.lds, qf, lane, 64 * j, tok_base, hg, nosel, s);
        attn_online(s, vm, m, l, p, sc);
    }
    float il[4];
#pragma unroll
    for (int r = 0; r < 4; ++r) il[r] = l[r] > 0.f ? 1.0f / l[r] : 0.f;
    f32x4 o[8];
#pragma unroll
    for (int dt = 0; dt < 8; ++dt) o[dt] = ZERO4;
    attn_load_tile(rk, rv, KC, VC, 512, tid);
    for (int j = 0; j < ntiles; ++j) {
        __syncthreads(); attn_store_tile(F.lds, rk, rv, tid); __syncthreads();
        if (j + 1 < ntiles) attn_load_tile(rk, rv, KC + (size_t)(j + 1) * 64 * 128, VC + (j + 1) * 64, 512, tid);
        f32x4 s[4], p[4];
        const unsigned vm = attn_scores<0>(F.lds, qf, lane, 64 * j, tok_base, hg, nosel, s);
#pragma unroll
        for (int nt = 0; nt < 4; ++nt)
#pragma unroll
            for (int r = 0; r < 4; ++r) {
                const float pv = ((vm >> (4 * nt + r)) & 1u) ? __expf(s[nt][r] - m[r]) * il[r] : 0.f; p[nt][r] = pv;
                const float ps = pv + shx<32>(pv);
                if (fq < 2) PS[(4 * (fq & 1) + r) * 65 + 1 + 16 * nt + (lane & 15)] = ps;
            }
        WAVE_SYNC();
#pragma unroll
        for (int q = 0; q < 2; ++q) { const int idx = lane + 64 * q, tk = idx >> 4, bl = idx & 15; const LAS float* ps = PS + tk * 65 + 4 * bl;
            IMP[(8 * wave + tk) * 128 + 16 * j + bl] = ps[0] + 2.0f * ps[1] + 2.0f * ps[2] + 2.0f * ps[3] + ps[4]; }
        WAVE_SYNC();
        if (lane < 8) PS[lane * 65] = PS[lane * 65 + 64];
        WAVE_SYNC();
        attn_pv(F.lds, wave, lane, p, o);
    }
    {
        const float* small = WSP(float, WS_SMALL); float* YB = WSP(float, WS_YB);
#pragma unroll
        for (int r = 0; r < 4; ++r) { const size_t row = (size_t)(b * SEQ + tok_base + r); const float gt = sigmoidf_(small[row * SMW + S_BG + (2 * g + hg) * 3 + 0]);
#pragma unroll
            for (int dt = 0; dt < 8; ++dt) YB[row * 512 + (2 * g + hg) * 128 + 16 * dt + (lane & 15)] = gt * o[dt][r]; }
    }
    {
        unsigned* SELM = WSP(unsigned, WS_SELM); const int cur = qt;
        for (int tk = 0; tk < 8; ++tk) {
            const LAS float* row = IMP + (8 * wave + tk) * 128;
            const int b0 = lane, b1 = lane + 64;
            const float s0 = b0 > cur ? -1e4f : ((b0 == 0 || b0 >= cur - 1) ? 1e4f : row[b0]);
            const float s1 = b1 > cur ? -1e4f : ((b1 == 0 || b1 >= cur - 1) ? 1e4f : row[b1]);
            int c0 = 0, c1 = 0;
            for (int jb = 0; jb < 128; ++jb) { const float sj = jb > cur ? -1e4f : ((jb == 0 || jb >= cur - 1) ? 1e4f : row[jb]);
                c0 += (sj > s0 || (sj == s0 && jb < b0)) ? 1 : 0; c1 += (sj > s1 || (sj == s1 && jb < b1)) ? 1 : 0; }
            const unsigned long long m0 = __ballot(c0 < 16), m1 = __ballot(c1 < 16);
            if (lane == 0) { u32x4 w; w.x = (unsigned)m0; w.y = (unsigned)(m0 >> 32); w.z = (unsigned)m1; w.w = (unsigned)(m1 >> 32);
                *(u32x4*)(SELM + ((size_t)bg * SEQ + t0 + 8 * wave + tk) * 4) = w; }
        }
    }
    __syncthreads();
}

DEV void nsa_selwin_job(Frame& F, int job) {
    const int bg = job >> 7, qt = job & 127, b = bg >> 1, g = bg & 1, t0 = 64 * qt, tid = F.tid, lane = F.lane, wave = F.wave;
    LAS unsigned* SM = (LAS unsigned*)(F.lds + AL_SM); LAS unsigned* UMW = (LAS unsigned*)(F.lds + AL_UM);
    LAS unsigned* UW = (LAS unsigned*)(F.lds + AL_PS);
    const float zf_ = opaque_zero();
    const unsigned* SELM = WSP(unsigned, WS_SELM);
    __syncthreads();
    attn_fill_bias(F, g);
    {
        unsigned v = 0u; if (lane < 32) { v = SELM[((size_t)bg * SEQ + t0 + 8 * wave + (lane >> 2)) * 4 + (lane & 3)]; SM[(8 * wave + (lane >> 2)) * 4 + (lane & 3)] = v; }
        v |= shx<4>(v); v |= shx<8>(v); v |= shx<16>(v);
        if (lane < 4) UW[wave * 4 + lane] = v;
    }
    (void)UMW;
    bf16x8 qf[4]; attn_load_q(F, bg, t0, qf);
    const int fq = lane >> 4, hg = fq >> 1, tok_base = t0 + 8 * wave + 4 * (fq & 1);
    __syncthreads();
    unsigned um[4];
#pragma unroll
    for (int w = 0; w < 4; ++w) { unsigned v = 0u;
#pragma unroll
        for (int q = 0; q < 8; ++q) v |= UW[q * 4 + w];
        um[w] = __builtin_amdgcn_readfirstlane(v); }
    unsigned smw[4][4];
#pragma unroll
    for (int r = 0; r < 4; ++r)
#pragma unroll
        for (int w = 0; w < 4; ++w) smw[r][w] = SM[(8 * wave + 4 * (fq & 1) + r) * 4 + w];
    const float* small = WSP(float, WS_SMALL);
    const bf16* KS = WSP(bf16, WS_KS) + (size_t)bg * SEQ * 128; const bf16* VS = WSP(bf16, WS_VST) + (size_t)bg * 128 * 8192;
    const bf16* KW = WSP(bf16, WS_KW) + (size_t)bg * SEQ * 128; const bf16* VW = WSP(bf16, WS_VWT) + (size_t)bg * 128 * 8192;
    f32x4 tot[8];
    u32x4 rk[2], rv[2];
    {
        float m[4] = {-1e30f, -1e30f, -1e30f, -1e30f}, l[4] = {0.f, 0.f, 0.f, 0.f}; f32x4 o[8];
#pragma unroll
        for (int dt = 0; dt < 8; ++dt) o[dt] = ZERO4;
        int j = 0;
        attn_load_tile(rk, rv, KS, VS, 64, tid);
        while (j <= qt) {
            int jn = j + 1;
            while (jn <= qt) { const unsigned w = jn < 32 ? um[0] : (jn < 64 ? um[1] : (jn < 96 ? um[2] : um[3])); if ((w >> (jn & 31)) & 1u) break; ++jn; }
            __syncthreads(); attn_store_tile(F.lds, rk, rv, tid); __syncthreads();
            if (jn <= qt) attn_load_tile(rk, rv, KS + (size_t)jn * 64 * 128, VS + (size_t)jn * 128 * 64, 64, tid);
            unsigned selbit[4];
#pragma unroll
            for (int r = 0; r < 4; ++r) { const unsigned w = j < 32 ? smw[r][0] : (j < 64 ? smw[r][1] : (j < 96 ? smw[r][2] : smw[r][3])); selbit[r] = (w >> (j & 31)) & 1u; }
            f32x4 s[4], p[4]; float sc[4];
            const unsigned vm = attn_scores<1>(F.lds, qf, lane, 64 * j, tok_base, hg, selbit, s);
            attn_online(s, vm, m, l, p, sc);
#pragma unroll
            for (int dt = 0; dt < 8; ++dt)
#pragma unroll
                for (int r = 0; r < 4; ++r) o[dt][r] *= sc[r];
            attn_pv(F.lds, wave, lane, p, o);
            j = jn;
        }
#pragma unroll
        for (int r = 0; r < 4; ++r) { const size_t row = (size_t)(b * SEQ + tok_base + r); const float gt = sigmoidf_(small[row * SMW + S_BG + (2 * g + hg) * 3 + 1]) / l[r];
#pragma unroll
            for (int dt = 0; dt < 8; ++dt) tot[dt][r] = gt * o[dt][r]; }
    }
    {
        float m[4] = {-1e30f, -1e30f, -1e30f, -1e30f}, l[4] = {0.f, 0.f, 0.f, 0.f}; f32x4 o[8];
#pragma unroll
        for (int dt = 0; dt < 8; ++dt) o[dt] = ZERO4;
        const int j0 = qt >= 8 ? qt - 8 : 0;
        const unsigned nosel[4] = {0u, 0u, 0u, 0u};
        attn_load_tile(rk, rv, KW + (size_t)j0 * 64 * 128, VW + (size_t)j0 * 128 * 64, 64, tid);
        for (int j = j0; j <= qt; ++j) {
            __syncthreads(); attn_store_tile(F.lds, rk, rv, tid); __syncthreads();
            if (j + 1 <= qt) attn_load_tile(rk, rv, KW + (size_t)(j + 1) * 64 * 128, VW + (size_t)(j + 1) * 128 * 64, 64, tid);
            f32x4 s[4], p[4]; float sc[4];
            const unsigned vm = attn_scores<2>(F.lds, qf, lane, 64 * j, tok_base, hg, nosel, s);
            attn_online(s, vm, m, l, p, sc);
#pragma unroll
            for (int dt = 0; dt < 8; ++dt)
#pragma unroll
                for (int r = 0; r < 4; ++r) o[dt][r] *= sc[r];
            attn_pv(F.lds, wave, lane, p, o);
        }
#pragma unroll
        for (int r = 0; r < 4; ++r) { const size_t row = (size_t)(b * SEQ + tok_base + r); const float gt = sigmoidf_(small[row * SMW + S_BG + (2 * g + hg) * 3 + 2]) / l[r];
#pragma unroll
            for (int dt = 0; dt < 8; ++dt) tot[dt][r] += gt * o[dt][r]; }
    }
    {
        const float* YB = WSP(float, WS_YB); bf16* YC = WSP(bf16, WS_YCAT);
#pragma unroll
        for (int r = 0; r < 4; ++r) { const size_t row = (size_t)(b * SEQ + tok_base + r);
#pragma unroll
            for (int dt = 0; dt < 8; ++dt) { const int cidx = (2 * g + hg) * 128 + 16 * dt + (lane & 15); YC[row * 2048 + 512 + cidx] = (bf16)f2bf((DBG_ZERO & 2) ? zf_ : YB[row * 512 + cidx] + tot[dt][r]); } }
    }
    __syncthreads();
}

DEV void gdn_scan_job(Frame& F, int job) {
    const int bh = job >> 3, sl = job & 7, b = bh >> 2, h = bh & 3, lane = F.lane, wave = F.wave, fq = lane >> 4, fr = lane & 15;
    LAS bf16* St = (LAS bf16*)F.lds;
    LAS bf16* Vn = St + 16 * 136;
    const float* GL = WSP(float, WS_GL); float* GO = WSP(float, WS_GO);
    const float zf_ = opaque_zero();
    __syncthreads();
    for (int i = F.tid; i < 16 * 136 / 2; i += 512) ((LAS unsigned*)St)[i] = 0u;
    f32x4 S = ZERO4;
    const int mt = wave & 3;
    __syncthreads();
    for (int c = 0; c < 128; ++c) {
        const unsigned char* cb = F.ws + WS_GW + (size_t)(bh * 128 + c) * GDN_CH_BYTES;
        const bf16* gW = (const bf16*)cb; const bf16* gQD = (const bf16*)(cb + 16384); const bf16* gKDT = (const bf16*)(cb + 32768); const bf16* gUT = (const bf16*)(cb + 49152); const bf16* gAT = (const bf16*)(cb + 65536);
        bf16x8 a1[4], aA[2], aK[2];
        { const bf16* src1 = wave < 4 ? gW : gQD;
#pragma unroll
          for (int ks = 0; ks < 4; ++ks) a1[ks] = frag_g(src1, 128, 16 * mt, 32 * ks, lane); }
        const u32x2 uu = *(const u32x2*)(gUT + (16 * sl + fr) * 64 + 16 * mt + 4 * fq);
        aA[0] = frag_g(gAT, 64, 16 * mt, 0, lane); aA[1] = frag_g(gAT, 64, 16 * mt, 32, lane);
        aK[0] = frag_g(gKDT, 64, 16 * wave, 0, lane); aK[1] = frag_g(gKDT, 64, 16 * wave, 32, lane);
        const float gl = GL[bh * 128 + c];
        f32x4 d1 = ZERO4;
#pragma unroll
        for (int ks = 0; ks < 4; ++ks) d1 = mfma16(a1[ks], frag_l(St, 136, 0, 32 * ks, lane), d1);
        if (wave < 4) {
            const float v0 = bflo(uu.x) - d1[0], v1 = bfhi(uu.x) - d1[1], v2 = bflo(uu.y) - d1[2], v3 = bfhi(uu.y) - d1[3];
            u32x2 w; w.x = pk2(v0, v1); w.y = pk2(v2, v3);
            *(LAS u32x2*)(Vn + fr * 72 + 16 * mt + 4 * fq) = w;
        }
        __syncthreads();
        const bf16x8 bv0 = frag_l(Vn, 72, 0, 0, lane), bv1 = frag_l(Vn, 72, 0, 32, lane);
        if (wave >= 4) {
            d1 = mfma16(aA[0], bv0, d1); d1 = mfma16(aA[1], bv1, d1);
#pragma unroll
            for (int r = 0; r < 4; ++r) GO[(size_t)(b * SEQ + 64 * c + 16 * mt + 4 * fq + r) * 512 + h * 128 + 16 * sl + fr] = d1[r];
        }
        f32x4 dk = ZERO4;
        dk = mfma16(aK[0], bv0, dk); dk = mfma16(aK[1], bv1, dk);
        S = S * gl + dk;
        { u32x2 w; w.x = pk2(S[0], S[1]); w.y = pk2(S[2], S[3]); *(LAS u32x2*)(St + fr * 136 + 16 * wave + 4 * fq) = w; }
        __syncthreads();
    }
}

DEV void ssd_scan_part(Frame& F, int part, int nparts) {
    float* SST = WSP(float, WS_SST); const float* SCD = WSP(float, WS_SCD);
    constexpr int PER_B = 16 * 64 * 128;
    for (int e = part * 512 + F.tid; e < 2 * PER_B; e += nparts * 512) {
        const int b = e / PER_B, r = e - b * PER_B, h = r >> 13;
        float s = 0.f;
        for (int c = 0; c < 64; ++c) { const size_t idx = (size_t)(b * 64 + c) * PER_B + r; const float st = SST[idx]; SST[idx] = s; s = s * SCD[(b * 64 + c) * 16 + h] + st; }
    }
}

DEV void gdn_final_rows(Frame& F, int l, int w0, int nw) {
    const float* GO = WSP(float, WS_GO); const bf16* p1 = WSP(bf16, WS_P1); bf16* YC = WSP(bf16, WS_YCAT); const float* gn = lin(F, I_GNORM, l, 128);
    const int lane = F.lane, dv0 = (lane & 15) * 8;
    float gv[8];
#pragma unroll
    for (int j = 0; j < 8; ++j) gv[j] = gn[dv0 + j];
    for (int row = w0; row < MTOK; row += nw) {
        const f32x4 a = *(const f32x4*)(GO + (size_t)row * 512 + lane * 8), bq = *(const f32x4*)(GO + (size_t)row * 512 + lane * 8 + 4);
        float ss = (a[0] * a[0] + a[1] * a[1]) + (a[2] * a[2] + a[3] * a[3]) + (bq[0] * bq[0] + bq[1] * bq[1]) + (bq[2] * bq[2] + bq[3] * bq[3]);
        ss = sum16(ss);
        const float rs = rsqrtf(ss * (1.0f / 128.0f) + EPS);
        const u32x4 zw = *(const u32x4*)(p1 + (size_t)row * P1W + C_AZ + lane * 8);
        const float z[8] = {bflo(zw.x), bfhi(zw.x), bflo(zw.y), bfhi(zw.y), bflo(zw.z), bfhi(zw.z), bflo(zw.w), bfhi(zw.w)};
        const float o[8] = {a[0], a[1], a[2], a[3], bq[0], bq[1], bq[2], bq[3]};
        float y[8];
#pragma unroll
        for (int j = 0; j < 8; ++j) y[j] = (DBG_ZERO & 1) ? opaque_zero() : o[j] * rs * gv[j] * siluf_(z[j]);
        u32x4 w; w.x = pk2(y[0], y[1]); w.y = pk2(y[2], y[3]); w.z = pk2(y[4], y[5]); w.w = pk2(y[6], y[7]);
        *(u32x4*)(YC + (size_t)row * 2048 + lane * 8) = w;
    }
}

DEV void ssd_out_job(Frame& F, int l, int job) {
    const int b = job >> 7, c = (job >> 1) & 63, g = job & 1, t0 = 128 * c, tid = F.tid, lane = F.lane, wave = F.wave, fq = lane >> 4, fr = lane & 15;
    const bf16* SX = WSP(bf16, WS_SX); const bf16* p1 = WSP(bf16, WS_P1); const float* SDT = WSP(float, WS_SDT); const float* SAC = WSP(float, WS_SAC); const float* SST = WSP(float, WS_SST);
    bf16* YC = WSP(bf16, WS_YCAT); float* RC = WSP(float, WS_SRC);
    const float zf_ = opaque_zero();
    LAS bf16* Cs = (LAS bf16*)F.lds;
    LAS bf16* Bs = Cs + 128 * 136;
    LAS bf16* XdT = Bs + 128 * 136;
    LAS bf16* SiT = XdT + 64 * 136;
    LAS bf16* Pw = SiT + 64 * 136;
    LAS float* acs = (LAS float*)(Pw + 8 * 16 * 136);
    __syncthreads();
    for (int i = tid; i < 2 * 128 * 16; i += 512) { const int v = i >> 11, r = (i >> 4) & 127, c8 = (i & 15) * 8;
        const u32x4 w = *(const u32x4*)(SX + (size_t)(b * SEQ + t0 + r) * 1536 + 1024 + (v ? 256 : 0) + g * 128 + c8);
        *(LAS u32x4*)((v ? Cs : Bs) + r * 136 + c8) = w; }
    for (int i = tid; i < 1024; i += 512) { const size_t row = (size_t)(b * SEQ + t0 + (i >> 3)); acs[i] = SAC[row * 16 + 8 * g + (i & 7)]; }
    __syncthreads();
    f32x4 cb[8];
    {
        bf16x8 ca[4];
#pragma unroll
        for (int ks = 0; ks < 4; ++ks) ca[ks] = frag_l(Cs, 136, 16 * wave, 32 * ks, lane);
#pragma unroll
        for (int nt = 0; nt < 8; ++nt) { cb[nt] = ZERO4;
#pragma unroll
            for (int ks = 0; ks < 4; ++ks) cb[nt] = mfma16(ca[ks], frag_l(Bs, 136, 16 * nt, 32 * ks, lane), cb[nt]); }
    }
    float ssq[4] = {0.f, 0.f, 0.f, 0.f};
    LAS bf16* pw = Pw + wave * 16 * 136;
    const float* dsk = lin(F, I_SD, l, 16);
    for (int hh = 0; hh < 8; ++hh) {
        const int h = 8 * g + hh;
        __syncthreads();
        for (int i = tid; i < 64 * 128; i += 512) { const int p = i & 63, s = i >> 6;
            XdT[p * 136 + s] = (bf16)f2bf(bf2f(SX[(size_t)(b * SEQ + t0 + s) * 1536 + h * 64 + p]) * SDT[(size_t)(b * SEQ + t0 + s) * 16 + h]); }
        { const float* sin = SST + ((size_t)((b * 64 + c) * 16 + h) * 64) * 128;
          for (int i = tid; i < 64 * 32; i += 512) { const int p = i >> 5, n4 = (i & 31) * 4; const f32x4 v = *(const f32x4*)(sin + p * 128 + n4);
              u32x2 w; w.x = pk2(v[0], v[1]); w.y = pk2(v[2], v[3]); *(LAS u32x2*)(SiT + p * 136 + n4) = w; } }
        float al[4];
#pragma unroll
        for (int r = 0; r < 4; ++r) al[r] = acs[(16 * wave + 4 * fq + r) * 8 + hh];
#pragma unroll
        for (int nt = 0; nt < 8; ++nt) { const int s = 16 * nt + fr; const float as = acs[s * 8 + hh];
#pragma unroll
            for (int r = 0; r < 4; ++r) { const int li = 16 * wave + 4 * fq + r; const float v = s <= li ? cb[nt][r] * __expf(al[r] - as) : 0.f; pw[(4 * fq + r) * 136 + s] = (bf16)f2bf(v); } }
        __syncthreads();
        f32x4 y[4], ys[4];
#pragma unroll
        for (int nt = 0; nt < 4; ++nt) { y[nt] = ZERO4; ys[nt] = ZERO4; }
#pragma unroll
        for (int ks = 0; ks < 4; ++ks) { const bf16x8 pa = frag_l(pw, 136, 0, 32 * ks, lane), cc = frag_l(Cs, 136, 16 * wave, 32 * ks, lane);
#pragma unroll
            for (int nt = 0; nt < 4; ++nt) { y[nt] = mfma16(pa, frag_l(XdT, 136, 16 * nt, 32 * ks, lane), y[nt]); ys[nt] = mfma16(cc, frag_l(SiT, 136, 16 * nt, 32 * ks, lane), ys[nt]); } }
        const float dh = dsk[h];
#pragma unroll
        for (int r = 0; r < 4; ++r) { const size_t row = (size_t)(b * SEQ + t0 + 16 * wave + 4 * fq + r); const float ea = __expf(al[r]);
#pragma unroll
            for (int nt = 0; nt < 4; ++nt) { const int p = 16 * nt + fr;
                const float xs = bf2f(SX[row * 1536 + h * 64 + p]); const float z = bf2f(p1[row * P1W + C_CZ + h * 64 + p]);
                const float v = (DBG_ZERO & 4) ? zf_ : (y[nt][r] + ea * ys[nt][r] + xs * dh) * siluf_(z);
                ssq[r] += v * v; YC[row * 2048 + 1024 + h * 64 + p] = (bf16)f2bf(v); } }
    }
#pragma unroll
    for (int r = 0; r < 4; ++r) { const float s = sum16(ssq[r]); if (fr == 0) RC[(size_t)(b * SEQ + t0 + 16 * wave + 4 * fq + r) * 2 + g] = rsqrtf(s * (1.0f / 512.0f) + EPS); }
    __syncthreads();
}

constexpr int NPH = 12;
#ifndef CPU_EMU
DEV unsigned long long launder64(unsigned long long v) {
    unsigned lo = __builtin_amdgcn_readfirstlane((unsigned)v), hi = __builtin_amdgcn_readfirstlane((unsigned)(v >> 32));
    asm volatile("" : "+s"(lo), "+s"(hi));
    return ((unsigned long long)hi << 32) | lo;
}
DEV bool phase_begin(Frame& F, const Params& prm, int wave0) {
    F.ws = (unsigned char*)launder64((unsigned long long)prm.ws);
    F.p = (KParams)launder64((unsigned long long)__builtin_amdgcn_kernarg_segment_ptr());
    unsigned z = 0u; asm volatile("" : "+v"(z)); const int ln = (int)__builtin_amdgcn_mbcnt_hi(~0u, __builtin_amdgcn_mbcnt_lo(~0u, z));
    int wv = wave0; asm volatile("" : "+s"(wv)); F.wave = wv; F.lane = ln; F.tid = wv * 64 + ln;
    int bi = __builtin_amdgcn_readfirstlane(blockIdx.x); asm volatile("" : "+s"(bi)); F.bid = bi;
    int gg = __builtin_amdgcn_readfirstlane(gridDim.x); asm volatile("" : "+s"(gg)); F.G = gg;
    unsigned la = __builtin_amdgcn_readfirstlane((unsigned)(size_t)F.lds); asm volatile("" : "+s"(la)); F.lds = (LAS unsigned char*)(size_t)la;
    return true;
}
__global__ void __launch_bounds__(512, 2) hybrid_fwd(Params prm) {
    extern __shared__ __attribute__((aligned(16))) unsigned char lds_raw[];
    Frame F;
    F.lds = (LAS unsigned char*)lds_raw; F.tid = threadIdx.x; F.lane = F.tid & 63; F.wave = __builtin_amdgcn_readfirstlane(F.tid >> 6);
    const int wave0 = F.wave;
    F.G = gridDim.x; F.bid = blockIdx.x; F.p = (KParams)__builtin_amdgcn_kernarg_segment_ptr(); F.ws = prm.ws;
    volatile LAS unsigned* MISC = (volatile LAS unsigned*)(F.lds + MISC_OFF);
    if (F.tid < 64) MISC[F.tid] = 0u;
    __syncthreads();
    unsigned* ctl = (unsigned*)(F.ws + WS_CTL);
    XcdBarrier bar; bar.bar = ctl + CW_BAR; bar.x = 0; bar.st = nullptr;
    if (prm.use_bar) bar = xcd_barrier_post(ctl + CW_BAR, MISC + 8);
    const int lo = prm.lo, hi = prm.hi;
    for (int l = 0; l < DEPTH; ++l) {
#define IN(k) (lo <= l * NPH + (k) && l * NPH + (k) < hi && phase_begin(F, prm, wave0))
#define SEAM(k) do { if (l * NPH + (k) + 1 < hi && prm.use_bar) { XcdBarrier bb_ = bar; bb_.bar = (unsigned*)launder64((unsigned long long)bar.bar); { unsigned x_ = __builtin_amdgcn_readfirstlane(bar.x); asm volatile("" : "+s"(x_)); bb_.x = x_; } xcd_barrier(bb_); } } while (0)
#define RSB(i) (WSP(unsigned long long, WS_CTL) + CW_RS / 2 + (size_t)(3 * l + (i)) * MTOK)
#define XB WSP(bf16, WS_XB)
#define ACT WSP(bf16, WS_ACT)
        if (IN(0)) { phase_convert(F, l); SEAM(0); }
        if (IN(1)) { pg8::Gemm g{XB, WSP(bf16, WS_WUP1), MTOK, NUP, DM, DM, DM}; pg8::StaticOrder S; S.init(MTOK, NUP, F.G, F.bid);
            pg8::EpiSwiGLU E{ACT, RSB(0)}; pg8::gemm_phase<pg8::EpiSwiGLU, pg8::StaticOrder>(F.lds, F.tid, g, S, E); SEAM(1); }
        if (IN(2)) { pg8::Gemm g{ACT, WSP(bf16, WS_WDN1), MTOK, DM, DFF, DFF, DFF}; pg8::StaticOrder S; S.init(MTOK, DM, F.G, F.bid);
            pg8::EpiResidual E{prm.out, XB, RSB(1), 0.5f}; pg8::gemm_phase<pg8::EpiResidual, pg8::StaticOrder>(F.lds, F.tid, g, S, E); SEAM(2); }
        if (IN(3)) { pg8::Gemm g{XB, WSP(bf16, WS_WIN), MTOK, NINP, DM, DM, DM}; pg8::StaticOrder S; S.init(MTOK, NINP, F.G, F.bid);
            pg8::EpiWin E{WSP(bf16, WS_P1), WSP(float, WS_SMALL), WSP(bf16, WS_GATE), RSB(1)}; pg8::gemm_phase<pg8::EpiWin, pg8::StaticOrder>(F.lds, F.tid, g, S, E); SEAM(3); }
        if (IN(4)) {
            for (int j = F.bid; j < 32 + 1024 + 256 + 512; j += F.G) {
                if (j < 32) nsa_compress_job(F, l, j);
                else if (j < 32 + 1024) gdn_prep_job(F, l, j - 32);
                else if (j < 32 + 1024 + 256) ssd_prep_job(F, l, j - 32 - 1024);
                else nsa_prep_job(F, l, j - 32 - 1024 - 256);
            }
            SEAM(4);
        }
        if (IN(5)) {
            if (F.bid < 64) gdn_scan_job(F, F.bid);
            else { const int nb = F.G - 64, me = F.bid - 64;
                for (int j = me; j < 512; j += nb) nsa_cmp_job(F, j);
                ssd_scan_part(F, me, nb); }
            SEAM(5);
        }
        if (IN(6)) {
            for (int i = F.bid; i < 512; i += F.G) { const int k = i < 256 ? i : 767 - i;
                const int qt = 127 - (k >> 2), bg = k & 3; nsa_selwin_job(F, bg * 128 + qt); }
            SEAM(6);
        }
        if (IN(7)) {
            for (int j = F.bid; j < 256; j += F.G) ssd_out_job(F, l, j);
            gdn_final_rows(F, l, F.bid * 8 + F.wave, F.G * 8);
            SEAM(7);
        }
        if (IN(8)) { pg8::Gemm g{WSP(bf16, WS_YCAT), WSP(bf16, WS_WPM), MTOK, DM, 512, DM, DM}; pg8::SegOrder S; S.init(MTOK, DM, F.G, F.bid, 512);
            pg8::EpiMergeSeg E{WSP(bf16, WS_MERGED), WSP(float, WS_MTMP), WSP(bf16, WS_GATE), WSP(float, WS_SRC)}; pg8::gemm_phase<pg8::EpiMergeSeg, pg8::SegOrder>(F.lds, F.tid, g, S, E); SEAM(8); }
        if (IN(9)) { pg8::Gemm g{WSP(bf16, WS_MERGED), WSP(bf16, WS_WO), MTOK, DM, DM, DM, DM}; pg8::StaticOrder S; S.init(MTOK, DM, F.G, F.bid);
            pg8::EpiResidual E{prm.out, XB, RSB(2), 1.0f}; pg8::gemm_phase<pg8::EpiResidual, pg8::StaticOrder>(F.lds, F.tid, g, S, E); SEAM(9); }
        if (IN(10)) { pg8::Gemm g{XB, WSP(bf16, WS_WUP2), MTOK, NUP, DM, DM, DM}; pg8::StaticOrder S; S.init(MTOK, NUP, F.G, F.bid);
            pg8::EpiSwiGLU E{ACT, RSB(2)}; pg8::gemm_phase<pg8::EpiSwiGLU, pg8::StaticOrder>(F.lds, F.tid, g, S, E); SEAM(10); }
        if (IN(11)) { pg8::Gemm g{ACT, WSP(bf16, WS_WDN2), MTOK, DM, DFF, DFF, DFF}; pg8::StaticOrder S; S.init(MTOK, DM, F.G, F.bid);
            pg8::EpiResidual E{prm.out, XB, RSB(3), 0.5f}; pg8::gemm_phase<pg8::EpiResidual, pg8::StaticOrder>(F.lds, F.tid, g, S, E); SEAM(11); }
#undef IN
#undef SEAM
#undef RSB
#undef XB
#undef ACT
    }
}

#ifndef DBG_DUMP
#define DBG_DUMP 0
#endif
#ifndef DBG_STOP
#define DBG_STOP 48
#endif
__global__ void dbg_dump_bf16(const unsigned short* src, size_t n, float* out, size_t nout) {
    for (size_t i = (size_t)blockIdx.x * blockDim.x + threadIdx.x; i < nout; i += (size_t)gridDim.x * blockDim.x) { float s = 0.f; for (size_t k = i; k < n; k += nout) s += __builtin_bit_cast(float, (unsigned)src[k] << 16); out[i] = s; }
}
__global__ void dbg_dump_f32(const float* src, size_t n, float* out, size_t nout) {
    for (size_t i = (size_t)blockIdx.x * blockDim.x + threadIdx.x; i < nout; i += (size_t)gridDim.x * blockDim.x) { float s = 0.f; for (size_t k = i; k < n; k += nout) s += src[k]; out[i] = s; }
}
#ifndef N_LAUNCH_MODE
#define N_LAUNCH_MODE 0
#endif
extern "C" void kernel_launch(void* const* d_in, const int* in_sizes, int n_in, void* d_out, int out_size, void* d_ws, size_t ws_size, hipStream_t stream) {
    static int grid = 0;
    if (grid == 0) {
        if (n_in != 30 || out_size != MTOK * DM || ws_size < WS_END) { fprintf(stderr, "kernel_launch: unexpected shapes (n_in %d out %d ws %zu, need %zu)\n", n_in, out_size, ws_size, (size_t)WS_END); grid = -1; return; }
        int dev = 0, cus = 0, per_cu = 0;
        if (hipGetDevice(&dev) != hipSuccess || hipDeviceGetAttribute(&cus, hipDeviceAttributeMultiprocessorCount, dev) != hipSuccess) { grid = -1; return; }
        if (hipFuncSetAttribute((const void*)hybrid_fwd, hipFuncAttributeMaxDynamicSharedMemorySize, LDS_BYTES) != hipSuccess) { fprintf(stderr, "kernel_launch: hipFuncSetAttribute failed\n"); grid = -1; return; }
        if (hipOccupancyMaxActiveBlocksPerMultiprocessor(&per_cu, (const void*)hybrid_fwd, 512, LDS_BYTES) != hipSuccess || per_cu < 1) { fprintf(stderr, "kernel_launch: occupancy query says %d\n", per_cu); }
        (void)hipGetLastError();
        grid = cus;
    }
    if (grid < 0) return;
    (void)hipMemsetAsync((char*)d_ws + WS_CTL, 0, CTL_BYTES, stream);
    Params p{};
    for (int i = 0; i < 30; ++i) p.in[i] = (const float*)d_in[i];
    p.out = (float*)d_out; p.ws = (unsigned char*)d_ws; p.pad = 0;
    if (N_LAUNCH_MODE == 0) { p.lo = 0; p.hi = DEPTH * NPH; p.use_bar = 1; hipLaunchKernelGGL(hybrid_fwd, dim3(grid), dim3(512), LDS_BYTES, stream, p); }
    else { for (int ph = 0; ph < (DBG_DUMP ? DBG_STOP : DEPTH * NPH); ++ph) { p.lo = ph; p.hi = ph + 1; p.use_bar = 0; hipLaunchKernelGGL(hybrid_fwd, dim3(grid), dim3(512), LDS_BYTES, stream, p); } }
    if (DBG_DUMP) {
        const size_t nout = (size_t)MTOK * DM; char* w = (char*)d_ws;
        if (DBG_DUMP == 1) hipLaunchKernelGGL(dbg_dump_bf16, dim3(2048), dim3(256), 0, stream, (const unsigned short*)(w + WS_P1), (size_t)MTOK * P1W, (float*)d_out, nout);
        if (DBG_DUMP == 2) hipLaunchKernelGGL(dbg_dump_f32, dim3(2048), dim3(256), 0, stream, (const float*)(w + WS_SMALL), (size_t)MTOK * SMW, (float*)d_out, nout);
        if (DBG_DUMP == 3) hipLaunchKernelGGL(dbg_dump_bf16, dim3(2048), dim3(256), 0, stream, (const unsigned short*)(w + WS_GW), (size_t)1024 * GDN_CH_BYTES / 2, (float*)d_out, nout);
        if (DBG_DUMP == 4) hipLaunchKernelGGL(dbg_dump_f32, dim3(2048), dim3(256), 0, stream, (const float*)(w + WS_SST), (size_t)2 * 64 * 16 * 64 * 128, (float*)d_out, nout);
        if (DBG_DUMP == 5) hipLaunchKernelGGL(dbg_dump_f32, dim3(2048), dim3(256), 0, stream, (const float*)(w + WS_GO), (size_t)MTOK * 512, (float*)d_out, nout);
        if (DBG_DUMP == 6) hipLaunchKernelGGL(dbg_dump_bf16, dim3(2048), dim3(256), 0, stream, (const unsigned short*)(w + WS_YCAT), (size_t)MTOK * 2048, (float*)d_out, nout);
        if (DBG_DUMP == 7) hipLaunchKernelGGL(dbg_dump_bf16, dim3(2048), dim3(256), 0, stream, (const unsigned short*)(w + WS_MERGED), (size_t)MTOK * 2048, (float*)d_out, nout);
        if (DBG_DUMP == 8) hipLaunchKernelGGL(dbg_dump_bf16, dim3(2048), dim3(256), 0, stream, (const unsigned short*)(w + WS_SX), (size_t)MTOK * 1536, (float*)d_out, nout);
        if (DBG_DUMP == 9) hipLaunchKernelGGL(dbg_dump_bf16, dim3(2048), dim3(256), 0, stream, (const unsigned short*)(w + WS_GATE), (size_t)MTOK * 6144, (float*)d_out, nout);
        if (DBG_DUMP == 11) hipLaunchKernelGGL(dbg_dump_f32, dim3(2048), dim3(256), 0, stream, (const float*)(w + WS_SRC), (size_t)MTOK * 2, (float*)d_out, nout);
        if (DBG_DUMP == 12) hipLaunchKernelGGL(dbg_dump_bf16, dim3(2048), dim3(256), 0, stream, (const unsigned short*)(w + WS_WPM), (size_t)DM * DM, (float*)d_out, nout);
        if (DBG_DUMP == 13) hipLaunchKernelGGL(dbg_dump_f32, dim3(2048), dim3(256), 0, stream, (const float*)(w + WS_MTMP), (size_t)MTOK * DM, (float*)d_out, nout);
        if (DBG_DUMP == 15) hipLaunchKernelGGL(dbg_dump_bf16, dim3(2048), dim3(256), 0, stream, (const unsigned short*)(w + WS_ACT), (size_t)MTOK * DFF, (float*)d_out, nout);
        if (DBG_DUMP == 16) hipLaunchKernelGGL(dbg_dump_bf16, dim3(2048), dim3(256), 0, stream, (const unsigned short*)(w + WS_XB), (size_t)MTOK * DM, (float*)d_out, nout);
        if (DBG_DUMP == 17) hipLaunchKernelGGL(dbg_dump_bf16, dim3(2048), dim3(256), 0, stream, (const unsigned short*)(w + WS_WIN), (size_t)NINP * DM, (float*)d_out, nout);
        if (DBG_DUMP == 18) hipLaunchKernelGGL(dbg_dump_f32, dim3(2048), dim3(256), 0, stream, (const float*)(w + WS_CTL) + CW_RS, (size_t)NRS * MTOK, (float*)d_out, nout);
        if (DBG_DUMP == 10) hipLaunchKernelGGL(dbg_dump_f32, dim3(2048), dim3(256), 0, stream, (const float*)(w + WS_YB), (size_t)MTOK * 512, (float*)d_out, nout);
    }
}
#endif
```

```cpp
#include <hip/hip_runtime.h>
#include <cstdio>
#include <cstdint>

#ifndef CPU_EMU
#define DEV __device__ __forceinline__
#define LAS __attribute__((address_space(3)))
#define VM_WAIT() asm volatile("s_waitcnt vmcnt(0)" ::: "memory")
#define LDS_WAIT() asm volatile("s_waitcnt lgkmcnt(0)" ::: "memory")
#define CFENCE() asm volatile("" ::: "memory")
#define WAVE_SYNC() do { asm volatile("" ::: "memory"); __builtin_amdgcn_wave_barrier(); asm volatile("" ::: "memory"); } while (0)
#endif

#define DBG_DUMP 0
#define DBG_REP (-1)
#define DBG_STOP 48
#ifndef DBG_ZERO
#define DBG_ZERO 0
#endif
typedef unsigned short bf16;
typedef short bf16x8 __attribute__((ext_vector_type(8)));
typedef float f32x4 __attribute__((ext_vector_type(4)));
typedef float f32x2 __attribute__((ext_vector_type(2)));
typedef unsigned u32x4 __attribute__((ext_vector_type(4)));
typedef unsigned u32x2 __attribute__((ext_vector_type(2)));

constexpr int BATCH = 2, SEQ = 8192, DM = 2048, DEPTH = 4, DFF = 5504, NUP = 2 * DFF;
constexpr int MTOK = BATCH * SEQ;
constexpr int NIN = 12836, NINP = 13056;
constexpr int P1W = 6656;
constexpr int SM0 = 6656;
constexpr int GT0 = 6912;
constexpr float EPS = 1e-6f;
constexpr int C_AQ = 0, C_AK = 512, C_AV = 1024, C_AZ = 1536, C_BQ = 2048, C_BKC = 2560, C_BVC = 2816, C_BKS = 3072, C_BVS = 3328, C_BKW = 3584, C_BVW = 3840, C_CZ = 4096, C_CX = 5120;
constexpr int S_AA = 0, S_AB = 4, S_BG = 8, S_DT = 20, SMW = 64;

constexpr size_t MiB = 1u << 20;
constexpr size_t WS_CTL = 0, CTL_BYTES = 2 * MiB;
constexpr size_t WS_WUP1 = 2 * MiB;
constexpr size_t WS_WDN1 = WS_WUP1 + (size_t)NUP * DM * 2;
constexpr size_t WS_WIN = WS_WDN1 + (size_t)DM * DFF * 2;
constexpr size_t WS_WPM = WS_WIN + (size_t)NINP * DM * 2;
constexpr size_t WS_WO = WS_WPM + (size_t)DM * DM * 2;
constexpr size_t WS_WUP2 = WS_WO + (size_t)DM * DM * 2;
constexpr size_t WS_WDN2 = WS_WUP2 + (size_t)NUP * DM * 2;
constexpr size_t WS_WCK = WS_WDN2 + (size_t)DM * DFF * 2;
constexpr size_t WS_WCV = WS_WCK + 128 * 4096 * 2;
constexpr size_t WS_CONST = WS_WCV + 128 * 4096 * 2;
constexpr size_t WS_WEND = WS_CONST + 4096;
static_assert(WS_WEND <= 212 * MiB, "weights region");
constexpr size_t WS_XB = 212 * MiB;
constexpr size_t WS_P1 = 276 * MiB;
constexpr size_t WS_ACT = WS_P1;
constexpr size_t WS_GATE = 484 * MiB;
constexpr size_t WS_SMALL = 676 * MiB;
constexpr size_t WS_MERGED = 680 * MiB;
constexpr size_t WS_YCAT = 744 * MiB;
constexpr size_t WS_GW = 808 * MiB;
constexpr size_t GDN_CH_BYTES = 73728;
constexpr size_t WS_GL = 880 * MiB;
constexpr size_t WS_GO = 881 * MiB;
constexpr size_t WS_SX = 913 * MiB;
constexpr size_t WS_SDT = 961 * MiB;
constexpr size_t WS_SAC = 962 * MiB;
constexpr size_t WS_SST = 963 * MiB;
constexpr size_t WS_SCD = 1027 * MiB;
constexpr size_t WS_SRC = 1028 * MiB;
constexpr size_t WS_QN = 1029 * MiB;
constexpr size_t WS_KS = 1045 * MiB;
constexpr size_t WS_KW = 1053 * MiB;
constexpr size_t WS_VST = 1061 * MiB;
constexpr size_t WS_VWT = 1069 * MiB;
constexpr size_t WS_KCMP = 1077 * MiB;
constexpr size_t WS_VCMPT = 1078 * MiB;
constexpr size_t WS_SELM = 1079 * MiB;
constexpr size_t WS_YB = 1080 * MiB;
constexpr size_t WS_MTMP = 1112 * MiB;
constexpr size_t WS_END = 1240 * MiB;
static_assert(WS_P1 + (size_t)MTOK * P1W * 2 <= WS_GATE && WS_GATE + (size_t)MTOK * 6144 * 2 <= WS_SMALL && WS_SMALL + (size_t)MTOK * SMW * 4 <= WS_MERGED && WS_MERGED + (size_t)MTOK * DM * 2 <= WS_YCAT && WS_YCAT + (size_t)MTOK * 2048 * 2 <= WS_GW, "ws map 1");
static_assert(WS_GW + 1024 * GDN_CH_BYTES <= WS_GL && WS_GO + (size_t)MTOK * 512 * 4 <= WS_SX && WS_SX + (size_t)MTOK * 1536 * 2 <= WS_SDT && WS_SDT + (size_t)MTOK * 16 * 4 <= WS_SAC && WS_SAC + (size_t)MTOK * 16 * 4 <= WS_SST && WS_SST + (size_t)2 * 64 * 16 * 64 * 128 * 4 <= WS_SCD, "ws map 2");
static_assert(WS_SRC + (size_t)MTOK * 2 * 4 <= WS_QN && WS_QN + (size_t)4 * SEQ * 256 * 2 <= WS_KS && WS_KS + (size_t)4 * SEQ * 128 * 2 <= WS_KW && WS_KW + (size_t)4 * SEQ * 128 * 2 <= WS_VST && WS_VST + (size_t)4 * SEQ * 128 * 2 <= WS_VWT && WS_VWT + (size_t)4 * SEQ * 128 * 2 <= WS_KCMP, "ws map 3");
static_assert(WS_KCMP + 4 * 512 * 128 * 2 <= WS_VCMPT && WS_VCMPT + 4 * 512 * 128 * 2 <= WS_SELM && WS_SELM + (size_t)4 * SEQ * 16 <= WS_YB && WS_YB + (size_t)MTOK * 512 * 4 <= WS_END && WS_XB + (size_t)MTOK * DM * 2 <= WS_P1 && (size_t)MTOK * DFF * 2 <= (size_t)MTOK * P1W * 2, "ws map 4");

constexpr int CW_BAR = 1024;
constexpr int CW_RS = 16384;
constexpr int NRS = 13;
constexpr int CW_WQ = 8192;
static_assert(CW_RS * 4 + NRS * MTOK * 8 <= (int)CTL_BYTES, "ctl");

constexpr int RING_BYTES = 131072;
constexpr int MISC_OFF = RING_BYTES + 12288;
constexpr int LDS_BYTES = 147456;

DEV unsigned f2bf(float f) { unsigned u = __builtin_bit_cast(unsigned, f); return (u + 0x7fffu + ((u >> 16) & 1u)) >> 16; }
DEV float bf2f(unsigned b) { return __builtin_bit_cast(float, (b & 0xffffu) << 16); }
DEV unsigned pk2(float lo, float hi) { return f2bf(lo) | (f2bf(hi) << 16); }
DEV float bflo(unsigned w) { return __builtin_bit_cast(float, w << 16); }
DEV float bfhi(unsigned w) { return __builtin_bit_cast(float, w & 0xffff0000u); }
DEV float sigmoidf_(float x) { return 1.0f / (1.0f + __expf(-x)); }
DEV float siluf_(float x) { return x / (1.0f + __expf(-x)); }
DEV float softplusf_(float x) {
    const float e = __expf(-fabsf(x)), u = 1.0f + e, d = u - 1.0f;
    const float lp = d == 0.f ? e : __logf(u) * (e / d);
    return fmaxf(x, 0.f) + lp;
}
#ifndef CPU_EMU
template <int M, class T> DEV T shx(T v) {
    static_assert(sizeof(T) == 4, "shx: 32-bit values");
    const int iv = __builtin_bit_cast(int, v);
    if constexpr (M < 32) return __builtin_bit_cast(T, __builtin_amdgcn_ds_swizzle(iv, 0x1f | (M << 10)));
    else { unsigned z = 0u; asm volatile("" : "+v"(z)); const unsigned ln = __builtin_amdgcn_mbcnt_hi(~0u, __builtin_amdgcn_mbcnt_lo(~0u, z));
        return __builtin_bit_cast(T, __builtin_amdgcn_ds_bpermute((int)((ln ^ 32u) << 2), iv)); }
}
#endif
DEV float wave_sum(float v) { v += shx<1>(v); v += shx<2>(v); v += shx<4>(v); v += shx<8>(v); v += shx<16>(v); v += shx<32>(v); return v; }
DEV float sum16(float v) { v += shx<1>(v); v += shx<2>(v); v += shx<4>(v); v += shx<8>(v); return v; }
DEV float max16(float v) { v = fmaxf(v, shx<1>(v)); v = fmaxf(v, shx<2>(v)); v = fmaxf(v, shx<4>(v)); v = fmaxf(v, shx<8>(v)); return v; }
#ifndef CPU_EMU
DEV float opaque_zero() { float z = 0.f; asm volatile("" : "+v"(z)); return z; }
#endif
#define ZERO4 ((f32x4){zf_, zf_, zf_, zf_})
DEV f32x4 mfma16(bf16x8 a, bf16x8 b, f32x4 c) { return __builtin_amdgcn_mfma_f32_16x16x32_bf16(a, b, c, 0, 0, 0); }
DEV bf16x8 frag_g(const bf16* base, int pitch, int row0, int k0, int lane) { return *(const bf16x8*)(base + (size_t)(row0 + (lane & 15)) * pitch + k0 + 8 * (lane >> 4)); }
DEV bf16x8 frag_l(const LAS bf16* base, int pitch, int row0, int k0, int lane) { return *(const LAS bf16x8*)(base + (row0 + (lane & 15)) * pitch + k0 + 8 * (lane >> 4)); }
#ifndef CPU_EMU
DEV const LAS void* lds_vbase(const LAS void* p) { unsigned a = (unsigned)(size_t)p; asm volatile("" : "+v"(a)); return (const LAS void*)(size_t)a; }
#endif

struct Params {
    const float* in[30];
    float* out;
    unsigned char* ws;
    int lo, hi;
    int use_bar, pad;
};
enum { I_X = 0, I_REL, I_GF1, I_WUP1, I_WDN1, I_GMIX, I_WIN, I_GCONV, I_GALOG, I_GDTB, I_GNORM, I_NQN, I_NKN, I_NPEK, I_NPEV, I_NWCK, I_NWCV,
       I_SCW, I_SCB, I_SDTB, I_SALOG, I_SD, I_SNORM, I_PA, I_PB, I_PC, I_WO, I_GF2, I_WUP2, I_WDN2 };

#define XB_TMO      128
#define XB_XCNT(j)  (256  + 64 * (j))
#define XB_XSUB(j)  (1280 + 64 * (j))
#define XB_XGEN(j)  (2304 + 64 * (j))
#define XB_TOP      3328
#define XB_TOPGEN   3392
#define XCD_BAR_WORDS 3456
#define XB_SPIN_CAP (1u << 22)
#ifndef CPU_EMU
DEV unsigned xb_ld(unsigned* p)              { return __hip_atomic_load(p, __ATOMIC_RELAXED, __HIP_MEMORY_SCOPE_AGENT); }
DEV unsigned xb_add(unsigned* p, unsigned v) { return __hip_atomic_fetch_add(p, v, __ATOMIC_RELAXED, __HIP_MEMORY_SCOPE_AGENT); }
DEV unsigned xb_xcc_id() { return (unsigned)__builtin_amdgcn_s_getreg((3 << 11) | 20) & 0xFu; }
#define XB_SPIN(cond, bar) do { unsigned _sp = 0; while (cond) { __builtin_amdgcn_s_sleep(1); \
    if ((++_sp & 255u) == 0u) { if (xb_ld(&(bar)[XB_TMO])) break; if (_sp > XB_SPIN_CAP) { atomicAdd(&(bar)[XB_TMO], 1u); break; } } } } while (0)
struct XcdBarrier { unsigned* bar; unsigned x; volatile LAS unsigned* st; };
DEV XcdBarrier xcd_barrier_post(unsigned* bar, volatile LAS unsigned* st) {
    XcdBarrier b; b.bar = bar; b.x = xb_xcc_id(); b.st = st;
    if (threadIdx.x == 0) (void)xb_add(&bar[XB_XCNT(b.x)], 1u);
    return b;
}
DEV void xcd_barrier_complete(unsigned* bar, unsigned x, unsigned& nloc, unsigned& nx) {
    const unsigned G = gridDim.x * gridDim.y * gridDim.z;
    unsigned sum, cnt, mine, sp = 0u;
    for (;;) {
        sum = 0u; cnt = 0u; mine = 0u;
#pragma unroll
        for (unsigned j = 0; j < 16; ++j) { const unsigned c = xb_ld(&bar[XB_XCNT(j)]); sum += c; cnt += (c > 0u) ? 1u : 0u; mine = (j == x) ? c : mine; }
        if (sum == G) break;
        __builtin_amdgcn_s_sleep(1);
        if ((++sp & 255u) == 0u) { if (xb_ld(&bar[XB_TMO])) break; if (sp > XB_SPIN_CAP) { atomicAdd(&bar[XB_TMO], 1u); break; } }
    }
    nloc = mine > 0u ? mine : 1u; nx = cnt > 0u ? cnt : 1u;
}
DEV void xcd_barrier(const XcdBarrier& b) {
    asm volatile("s_waitcnt vmcnt(0)" ::: "memory");
    __syncthreads();
    if (threadIdx.x == 0) {
        unsigned* bar = b.bar;
        __builtin_amdgcn_s_waitcnt(0);
        unsigned nloc = b.st[0], nx = b.st[1];
        if (nloc == 0u) { xcd_barrier_complete(bar, b.x, nloc, nx); b.st[0] = nloc; b.st[1] = nx; }
        const unsigned old = xb_add(&bar[XB_XSUB(b.x)], 1u);
        const unsigned gen = old / nloc;
        if (old + 1u == (gen + 1u) * nloc) {
            __builtin_amdgcn_fence(__ATOMIC_RELEASE, "agent");
            asm volatile("s_waitcnt vmcnt(0)" ::: "memory");
            const unsigned og = xb_add(&bar[XB_TOP], 1u);
            const unsigned tg = og / nx;
            if (og + 1u == (tg + 1u) * nx) xb_add(&bar[XB_TOPGEN], 1u);
            else XB_SPIN(xb_ld(&bar[XB_TOPGEN]) == tg, bar);
            __builtin_amdgcn_fence(__ATOMIC_ACQUIRE, "agent");
            xb_add(&bar[XB_XGEN(b.x)], 1u);
            asm volatile("s_waitcnt vmcnt(0)" ::: "memory");
        } else {
            XB_SPIN(xb_ld(&bar[XB_XGEN(b.x)]) == gen, bar);
            __builtin_amdgcn_fence(__ATOMIC_ACQUIRE, "agent");
            asm volatile("s_waitcnt vmcnt(0)" ::: "memory");
        }
    }
    __syncthreads();
}
#endif

namespace pg8 {
constexpr int BM = 256, BK = 64, HALF = 128, HTB = HALF * BK * 2, STAGE_BYTES = 8 * HTB, NXCD = 8, WGM = 8;
__host__ __device__ __forceinline__ int lds_byte(int r, int c) { const int st = (r >> 4) * 2 + (c >> 5), rr = r & 15, cc = c & 31, ob = rr * 64 + cc * 2; return st * 1024 + (ob ^ (((ob >> 9) & 1) << 5)); }
__host__ __device__ __forceinline__ void stage_rc(int b, int& R, int& C) { const int st = b / 1024, sb = b % 1024, swz = sb ^ (((sb >> 9) & 1) << 5); R = (st >> 1) * 16 + swz / 64; C = (st & 1) * 32 + (swz % 64) / 2; }
__host__ __device__ __forceinline__ int perm32(int rho) { const int n = rho >> 4, i = rho & 15; return 8 * (i >> 2) + 4 * n + (i & 3); }
struct Unit { int pm, pn, koff, seg; };
struct Gemm { const bf16* A; const bf16* Bt; int M, N, K, lda, ldb; };
struct StaticOrder {
    int nM, nN, nwg, G, c;
    __host__ __device__ void init(int M, int N, int G_, int c_) { nM = M / BM; nN = N / BM; nwg = nM * nN; G = G_; c = c_; }
    __host__ __device__ bool next(int i, Unit& u) const {
        const long L = (long)i * G + c; if (L >= nwg) return false;
        int wgid = (int)L; { const int q = nwg / NXCD, r = nwg % NXCD, xcd = wgid % NXCD, off = wgid / NXCD; wgid = (xcd < r ? xcd * (q + 1) : r * (q + 1) + (xcd - r) * q) + off; }
        const int nig = WGM * nN, gid = wgid / nig, fm = gid * WGM, gsz = (nM - fm) < WGM ? (nM - fm) : WGM;
        u.pm = fm + ((wgid % nig) % gsz); u.pn = (wgid % nig) / gsz; u.koff = 0; u.seg = 0; return true;
    }
};
struct SegOrder {
    StaticOrder S; int kseg;
    __host__ __device__ void init(int M, int N, int G_, int c_, int kseg_) { S.init(M, N, G_, c_); kseg = kseg_; }
    __host__ __device__ bool next(int i, Unit& u) const { if (!S.next(i >> 2, u)) return false; u.seg = i & 3; u.koff = u.seg * kseg; return true; }
};
#ifndef CPU_EMU
DEV unsigned cvt_pk_bf16(float lo, float hi) { unsigned r; asm volatile("v_cvt_pk_bf16_f32 %0, %1, %2" : "=v"(r) : "v"(lo), "v"(hi)); return r; }
#endif
DEV unsigned long long rss_fix(float ss) { return (unsigned long long)(ss * 16777216.0f + 0.5f); }
DEV float rss_val(unsigned long long v) { return (float)v * (1.0f / 16777216.0f); }

struct EpiSwiGLU {
    static constexpr bool PERM = true, SEGACC = false;
    bf16* act; const unsigned long long* rss;
    DEV void operator()(const f32x4 (&acc)[2][2][4][2], const Unit& u, int wr, int wc, int fr, int fq) const {
        const int row0 = u.pm * BM + wr * 64 + fr, col0 = u.pn * HALF + wc * 32 + 8 * fq;
        unsigned long long rv[8];
#pragma unroll
        for (int i = 0; i < 8; ++i) rv[i] = rss[row0 + (i >> 2) * HALF + (i & 3) * 16];
        CFENCE();
#pragma unroll
        for (int ai = 0; ai < 2; ++ai)
#pragma unroll
            for (int m = 0; m < 4; ++m) {
                const int row = row0 + ai * HALF + m * 16;
                const float rs = rsqrtf(rss_val(rv[ai * 4 + m]) * (1.0f / DM) + EPS);
                float o[8];
#pragma unroll
                for (int n = 0; n < 2; ++n)
#pragma unroll
                    for (int j = 0; j < 4; ++j) { const float a = acc[ai][0][m][n][j] * rs, b = acc[ai][1][m][n][j] * rs; o[4 * n + j] = a * b * __builtin_amdgcn_rcpf(1.0f + __expf(-a)); }
                u32x4 w; w.x = cvt_pk_bf16(o[0], o[1]); w.y = cvt_pk_bf16(o[2], o[3]); w.z = cvt_pk_bf16(o[4], o[5]); w.w = cvt_pk_bf16(o[6], o[7]);
                *(u32x4*)(act + (size_t)row * DFF + col0) = w;
            }
    }
};
struct EpiResidual {
    static constexpr bool PERM = true, SEGACC = false;
    float* x; bf16* xb; unsigned long long* rss_out; float alpha;
    DEV void operator()(const f32x4 (&acc)[2][2][4][2], const Unit& u, int wr, int wc, int fr, int fq) const {
        const int row0 = u.pm * BM + wr * 64 + fr, col0 = u.pn * BM + wc * 32 + 8 * fq;
#pragma unroll
        for (int ai = 0; ai < 2; ++ai) {
            f32x4 xv[4][2][2];
#pragma unroll
            for (int m = 0; m < 4; ++m)
#pragma unroll
                for (int bj = 0; bj < 2; ++bj) { const float* xp = x + (size_t)(row0 + ai * HALF + m * 16) * DM + col0 + bj * HALF; xv[m][bj][0] = *(const f32x4*)xp; xv[m][bj][1] = *(const f32x4*)(xp + 4); }
            CFENCE();
#pragma unroll
            for (int m = 0; m < 4; ++m) {
                const int row = row0 + ai * HALF + m * 16; float ss = 0.f;
#pragma unroll
                for (int bj = 0; bj < 2; ++bj) {
                    float* xp = x + (size_t)row * DM + col0 + bj * HALF;
                    const f32x4 x0 = xv[m][bj][0] + acc[ai][bj][m][0] * alpha, x1 = xv[m][bj][1] + acc[ai][bj][m][1] * alpha;
                    *(f32x4*)xp = x0; *(f32x4*)(xp + 4) = x1;
                    ss += (x0[0] * x0[0] + x0[1] * x0[1]) + (x0[2] * x0[2] + x0[3] * x0[3]) + (x1[0] * x1[0] + x1[1] * x1[1]) + (x1[2] * x1[2] + x1[3] * x1[3]);
                    u32x4 w; w.x = cvt_pk_bf16(x0[0], x0[1]); w.y = cvt_pk_bf16(x0[2], x0[3]); w.z = cvt_pk_bf16(x1[0], x1[1]); w.w = cvt_pk_bf16(x1[2], x1[3]);
                    *(u32x4*)(xb + (size_t)row * DM + col0 + bj * HALF) = w;
                }
                ss += shx<16>(ss); ss += shx<32>(ss);
                if (fq == 0) atomicAdd(rss_out + row, rss_fix(ss));
            }
            CFENCE();
        }
    }
};
struct EpiWin {
    static constexpr bool PERM = true, SEGACC = false;
    bf16* p1; float* small; bf16* gate; const unsigned long long* rss;
    DEV void operator()(const f32x4 (&acc)[2][2][4][2], const Unit& u, int wr, int wc, int fr, int fq) const {
        const int row0 = u.pm * BM + wr * 64 + fr, cl0 = wc * 32 + 8 * fq;
        unsigned long long rv[8];
#pragma unroll
        for (int i = 0; i < 8; ++i) rv[i] = rss[row0 + (i >> 2) * HALF + (i & 3) * 16];
        CFENCE();
#pragma unroll
        for (int ai = 0; ai < 2; ++ai)
#pragma unroll
            for (int m = 0; m < 4; ++m) {
                const int row = row0 + ai * HALF + m * 16;
                const float rs = rsqrtf(rss_val(rv[ai * 4 + m]) * (1.0f / DM) + EPS);
#pragma unroll
                for (int bj = 0; bj < 2; ++bj) {
                    f32x4 v0 = acc[ai][bj][m][0] * rs, v1 = acc[ai][bj][m][1] * rs;
                    const int cl = cl0 + bj * HALF;
                    if (u.pn < 26) {
                        u32x4 w; w.x = cvt_pk_bf16(v0[0], v0[1]); w.y = cvt_pk_bf16(v0[2], v0[3]); w.z = cvt_pk_bf16(v1[0], v1[1]); w.w = cvt_pk_bf16(v1[2], v1[3]);
                        *(u32x4*)(p1 + (size_t)row * P1W + u.pn * BM + cl) = w;
                    } else if (u.pn == 26) {
                        if (cl < SMW) { float* sp = small + (size_t)row * SMW + cl; *(f32x4*)sp = v0; *(f32x4*)(sp + 4) = v1; }
                    } else {
#pragma unroll
                        for (int j = 0; j < 4; ++j) { v0[j] = fminf(__builtin_amdgcn_rcpf(1.0f + __expf(-v0[j])), 1.0f); v1[j] = fminf(__builtin_amdgcn_rcpf(1.0f + __expf(-v1[j])), 1.0f); }
                        u32x4 w; w.x = cvt_pk_bf16(v0[0], v0[1]); w.y = cvt_pk_bf16(v0[2], v0[3]); w.z = cvt_pk_bf16(v1[0], v1[1]); w.w = cvt_pk_bf16(v1[2], v1[3]);
                        *(u32x4*)(gate + (size_t)row * 6144 + (u.pn - 27) * BM + cl) = w;
                    }
                }
            }
    }
};
struct EpiMergeSeg {
    static constexpr bool PERM = true, SEGACC = true;
    bf16* merged; const bf16* gate; const float* rc;
    DEV void seg(f32x4 (&acc)[2][2][4][2], const Unit& u, int wr, int wc, int fr, int fq) const {
        const int row0 = u.pm * BM + wr * 64 + fr, col0 = u.pn * BM + wc * 32 + 8 * fq, sg = u.seg;
        f32x2 rcv[8];
#pragma unroll
        for (int i = 0; i < 8; ++i) rcv[i] = *(const f32x2*)(rc + (size_t)(row0 + (i >> 2) * HALF + (i & 3) * 16) * 2);
        const int offa = sg == 0 ? 0 : (sg == 1 ? DM : 2 * DM), offb = sg == 0 ? DM : 2 * DM;
#pragma unroll
        for (int aim = 0; aim < 4; ++aim) {
            const int ai = aim >> 1, m0 = (aim & 1) * 2;
            u32x4 wa[2][2], wb[2][2];
            if (sg != 2) {
#pragma unroll
                for (int mm = 0; mm < 2; ++mm)
#pragma unroll
                    for (int bj = 0; bj < 2; ++bj) { const bf16* gp = gate + (size_t)(row0 + ai * HALF + (m0 + mm) * 16) * 6144 + col0 + bj * HALF; wa[mm][bj] = *(const u32x4*)(gp + offa); wb[mm][bj] = *(const u32x4*)(gp + offb); }
            }
            CFENCE();
#pragma unroll
            for (int mm = 0; mm < 2; ++mm) {
                const int m = m0 + mm, row = row0 + ai * HALF + m * 16;
                const float r0 = rcv[ai * 4 + m][0], r1 = rcv[ai * 4 + m][1];
#pragma unroll
                for (int bj = 0; bj < 2; ++bj) {
                    float f[8];
                    if (sg == 2) { const float q = fmaxf(r0, 1e-20f) / fmaxf(r1, 1e-20f);
#pragma unroll
                        for (int j = 0; j < 8; ++j) f[j] = q; }
                    else {
                        const u32x4 a4 = wa[mm][bj], b4 = wb[mm][bj];
                        const float na[8] = {bflo(a4.x), bfhi(a4.x), bflo(a4.y), bfhi(a4.y), bflo(a4.z), bfhi(a4.z), bflo(a4.w), bfhi(a4.w)};
                        const float nb[8] = {bflo(b4.x), bfhi(b4.x), bflo(b4.y), bfhi(b4.y), bflo(b4.z), bfhi(b4.z), bflo(b4.w), bfhi(b4.w)};
#pragma unroll
                        for (int j = 0; j < 8; ++j) {
                            if (sg == 0) f[j] = fmaxf(na[j], 1e-20f) * __builtin_amdgcn_rcpf(fmaxf(nb[j], 1e-20f));
                            else if (sg == 1) f[j] = fmaxf(na[j], 1e-20f) * __builtin_amdgcn_rcpf(fmaxf(nb[j] * r0, 1e-20f));
                            else f[j] = fmaxf(na[j] * r1, 1e-20f); }
                    }
                    f32x4 v0 = acc[ai][bj][m][0], v1 = acc[ai][bj][m][1];
#pragma unroll
                    for (int j = 0; j < 4; ++j) { v0[j] *= f[j]; v1[j] *= f[4 + j]; }
                    if (sg < 3) { acc[ai][bj][m][0] = v0; acc[ai][bj][m][1] = v1; }
                    else { u32x4 o; o.x = cvt_pk_bf16(v0[0], v0[1]); o.y = cvt_pk_bf16(v0[2], v0[3]); o.z = cvt_pk_bf16(v1[0], v1[1]); o.w = cvt_pk_bf16(v1[2], v1[3]);
                        *(u32x4*)(merged + (size_t)row * DM + col0 + bj * HALF) = o; }
                }
            }
            CFENCE();
        }
    }
};

#ifndef CPU_EMU
template <class Epi, class Sched>
DEV void gemm_phase(LAS unsigned char* lds, const int tid, const Gemm g, const Sched& S, const Epi& E) {
    const int wid = __builtin_amdgcn_readfirstlane(tid >> 6), lane = tid & 63, wr = wid >> 2, wc = wid & 3, fr = lane & 15, fq = lane >> 4;
    const int K = g.K, nt = K / BK;
    const float zf_ = opaque_zero();
    unsigned voffA[2], voffB[2];
#pragma unroll
    for (int i = 0; i < 2; ++i) { int R, C; stage_rc(tid * 16 + i * 8192, R, C); const int Rb = Epi::PERM ? ((R & ~31) + perm32(R & 31)) : R;
        voffA[i] = (unsigned)(R * g.lda + C) * 2u; voffB[i] = (unsigned)(Rb * g.ldb + C) * 2u; }
    const size_t kstep = (size_t)(BK * 2);
    const size_t hA = (size_t)HALF * g.lda * 2, hB = (size_t)HALF * g.ldb * 2;
    const size_t tA = 2 * hA, tB = 2 * hB;
    const unsigned ldsw = (unsigned)wid * 1024u;
    const int aoff = lds_byte(wr * 64 + fr, fq * 8), boff = lds_byte(wc * 32 + fr, fq * 8);
#define PG8_SA(b, h) (((b) * 2 + (h)) * HTB)
#define PG8_SB(b, h) ((4 + (b) * 2 + (h)) * HTB)
#define PG8_STAGE(bufoff, gbase, voff) do { _Pragma("unroll") for (int _i = 0; _i < 2; ++_i) \
        __builtin_amdgcn_global_load_lds((const unsigned*)((const char*)(gbase) + (voff)[_i]), (LAS unsigned*)(lds + (bufoff) + ldsw + _i * 8192), 16, 0, 0); } while (0)
#define PG8_LDA(dst, b, h) do { _Pragma("unroll") for (int m = 0; m < 4; ++m) _Pragma("unroll") for (int k = 0; k < 2; ++k) dst[m][k] = *(const LAS bf16x8*)(lds + PG8_SA(b, h) + aoff + m * 2048 + k * 1024); } while (0)
#define PG8_LDB(dst, b, h) do { _Pragma("unroll") for (int n = 0; n < 2; ++n) _Pragma("unroll") for (int k = 0; k < 2; ++k) dst[n][k] = *(const LAS bf16x8*)(lds + PG8_SB(b, h) + boff + n * 2048 + k * 1024); } while (0)
#define PG8_MMA(ai, bj, At, Bt) do { __builtin_amdgcn_s_setprio(1); _Pragma("unroll") for (int m = 0; m < 4; ++m) _Pragma("unroll") for (int n = 0; n < 2; ++n) _Pragma("unroll") for (int k = 0; k < 2; ++k) \
        acc[ai][bj][m][n] = __builtin_amdgcn_mfma_f32_16x16x32_bf16(Bt[n][k], At[m][k], acc[ai][bj][m][n], 0, 0, 0); __builtin_amdgcn_s_setprio(0); } while (0)
#define PG8_WAIT_V(n) asm volatile("s_waitcnt vmcnt(" #n ")" ::: "memory")
#define PG8_WAIT_L(n) asm volatile("s_waitcnt lgkmcnt(" #n ")" ::: "memory")
#define PG8_BAR __builtin_amdgcn_s_barrier()
#define PG8_SCHED __builtin_amdgcn_sched_barrier(0)
    Unit cur, nxt; int ui = 0;
    if (!S.next(0, cur)) return;
    f32x4 acc[2][2][4][2];
#pragma unroll
    for (int a = 0; a < 2; ++a)
#pragma unroll
        for (int b = 0; b < 2; ++b)
#pragma unroll
            for (int m = 0; m < 4; ++m)
#pragma unroll
                for (int n = 0; n < 2; ++n) acc[a][b][m][n] = ZERO4;
    bf16x8 At[4][2], B0[2][2], B1[2][2];
    const char* cA = (const char*)g.A + (size_t)cur.pm * tA + (size_t)cur.koff * 2; const char* cB = (const char*)g.Bt + (size_t)cur.pn * tB + (size_t)cur.koff * 2;
    PG8_STAGE(PG8_SB(0, 0), cB, voffB); PG8_STAGE(PG8_SB(0, 1), cB + hB, voffB); PG8_STAGE(PG8_SA(0, 0), cA, voffA); PG8_STAGE(PG8_SA(0, 1), cA + hA, voffA);
    if (wr == 1) PG8_BAR;
    PG8_WAIT_V(2); PG8_BAR;
    PG8_STAGE(PG8_SB(1, 0), cB + kstep, voffB); PG8_STAGE(PG8_SA(1, 0), cA + kstep, voffA); PG8_STAGE(PG8_SB(1, 1), cB + hB + kstep, voffB);
    PG8_WAIT_V(6); PG8_BAR;
    for (;;) {
        const bool has_next = S.next(ui + 1, nxt);
        const char* nA = has_next ? (const char*)g.A + (size_t)nxt.pm * tA + (size_t)nxt.koff * 2 : cA; const char* nB = has_next ? (const char*)g.Bt + (size_t)nxt.pn * tB + (size_t)nxt.koff * 2 : cB;
        for (int t = 0; t < nt; t += 2) {
            const bool last = (t == nt - 2);
            const char* a1 = cA + (size_t)(t + 1) * kstep;
            const char* a2 = last ? nA : cA + (size_t)(t + 2) * kstep; const char* b2 = last ? nB : cB + (size_t)(t + 2) * kstep;
            const char* a3 = a2 + kstep; const char* b3 = b2 + kstep;
            PG8_LDB(B0, 0, 0); PG8_LDB(B1, 0, 1); PG8_SCHED; PG8_LDA(At, 0, 0); PG8_STAGE(PG8_SA(1, 1), a1 + hA, voffA);
            PG8_WAIT_V(8); PG8_WAIT_L(0); PG8_BAR; PG8_MMA(0, 0, At, B0); PG8_MMA(0, 1, At, B1); PG8_BAR; PG8_SCHED;
            PG8_LDA(At, 0, 1); PG8_STAGE(PG8_SB(0, 0), b2, voffB); PG8_STAGE(PG8_SB(0, 1), b2 + hB, voffB); PG8_STAGE(PG8_SA(0, 0), a2, voffA);
            PG8_WAIT_V(8); PG8_WAIT_L(0); PG8_BAR; PG8_MMA(1, 0, At, B0); PG8_MMA(1, 1, At, B1); PG8_BAR; PG8_SCHED;
            PG8_LDB(B0, 1, 0); PG8_LDB(B1, 1, 1); PG8_SCHED; PG8_LDA(At, 1, 0); PG8_STAGE(PG8_SA(0, 1), a2 + hA, voffA);
            PG8_WAIT_V(8); PG8_WAIT_L(0); PG8_BAR; PG8_MMA(0, 0, At, B0); PG8_MMA(0, 1, At, B1); PG8_BAR; PG8_SCHED;
            PG8_LDA(At, 1, 1); PG8_STAGE(PG8_SB(1, 0), b3, voffB); PG8_STAGE(PG8_SB(1, 1), b3 + hB, voffB); PG8_STAGE(PG8_SA(1, 0), a3, voffA);
            PG8_WAIT_V(8); PG8_WAIT_L(0); PG8_BAR; PG8_MMA(1, 0, At, B0); PG8_MMA(1, 1, At, B1); PG8_BAR; PG8_SCHED;
        }
        if (wr == 0) PG8_BAR;
        if constexpr (Epi::SEGACC) E.seg(acc, cur, wr, wc, fr, fq); else E(acc, cur, wr, wc, fr, fq);
        if (!has_next) break;
        if (!(Epi::SEGACC && nxt.seg != 0)) {
#pragma unroll
        for (int a = 0; a < 2; ++a)
#pragma unroll
            for (int b = 0; b < 2; ++b)
#pragma unroll
                for (int m = 0; m < 4; ++m)
#pragma unroll
                    for (int n = 0; n < 2; ++n) acc[a][b][m][n] = ZERO4;
        }
        cur = nxt; cA = nA; cB = nB; ++ui;
        if (wr == 1) PG8_BAR;
    }
    PG8_WAIT_V(0);
    PG8_BAR;
#undef PG8_SA
#undef PG8_SB
#undef PG8_STAGE
#undef PG8_LDA
#undef PG8_LDB
#undef PG8_MMA
#undef PG8_WAIT_V
#undef PG8_WAIT_L
#undef PG8_BAR
#undef PG8_SCHED
}
#endif
}

#ifndef CPU_EMU
typedef const __attribute__((address_space(4))) Params* KParams;
#else
typedef const Params* KParams;
#endif
struct Frame {
    LAS unsigned char* lds;
    int tid, lane, wave, G, bid;
    KParams p;
    unsigned char* ws;
};
DEV const float* lin(const Frame& F, int idx, int layer, size_t per_layer) { return F.p->in[idx] + (size_t)layer * per_layer; }
#define WSP(T, off) ((T*)(F.ws + (off)))

DEV int up_dest(int n) { return n < DFF ? (n >> 7) * 256 + (n & 127) : ((n - DFF) >> 7) * 256 + 128 + ((n - DFF) & 127); }
DEV int win_dest(int n) {
    if (n < 2048) return n;
    if (n < 2052) return SM0 + S_AA + (n - 2048);
    if (n < 2056) return SM0 + S_AB + (n - 2052);
    if (n < 4104) return C_BQ + (n - 2056);
    if (n < 4116) return SM0 + S_BG + (n - 4104);
    if (n < 6676) return C_CZ + (n - 4116);
    if (n < 6692) return SM0 + S_DT + (n - 6676);
    return GT0 + (n - 6692);
}
DEV void transpose_item(const float* W, int K, int N, bf16* WT, int ldt, int koff, const float* kscale, int mode, LAS float* scr, int item, int lane) {
    const int nblk = (N + 31) / 32, kb = item / nblk, nb = item % nblk, k0 = 64 * kb, n0 = 32 * nb;
    const int nn = n0 + (lane & 31);
    const float* src = W + (size_t)(k0 + (lane >> 5)) * N + (nn < N ? nn : N - 1);
    float v[32];
#pragma unroll
    for (int i = 0; i < 32; ++i) v[i] = src[(size_t)(2 * i) * N];
#pragma unroll
    for (int i = 0; i < 32; ++i) scr[(2 * i + (lane >> 5)) * 33 + (lane & 31)] = v[i];
    LDS_WAIT(); CFENCE();
    const int c = lane & 7;
    f32x4 ks0 = (f32x4){1.f, 1.f, 1.f, 1.f}, ks1 = ks0;
    if (kscale) { ks0 = *(const f32x4*)(kscale + k0 + 8 * c); ks1 = *(const f32x4*)(kscale + k0 + 8 * c + 4); }
#pragma unroll
    for (int j = 0; j < 4; ++j) { const int n = (lane >> 3) + 8 * j; const LAS float* s = scr + (8 * c) * 33 + n;
        u32x4 o; o.x = pk2(s[0 * 33] * ks0[0], s[1 * 33] * ks0[1]); o.y = pk2(s[2 * 33] * ks0[2], s[3 * 33] * ks0[3]); o.z = pk2(s[4 * 33] * ks1[0], s[5 * 33] * ks1[1]); o.w = pk2(s[6 * 33] * ks1[2], s[7 * 33] * ks1[3]);
        const int ng = n0 + n;
        if (ng < N) { const int dr = mode == 0 ? ng : (mode == 1 ? up_dest(ng) : win_dest(ng)); *(u32x4*)(WT + (size_t)dr * ldt + koff + k0 + 8 * c) = o; } }
    LDS_WAIT(); CFENCE();
}
DEV void phase_convert(Frame& F, int l) {
    LAS float* scr = (LAS float*)(F.lds + F.wave * 16384);
    const int gw = F.bid * 8 + F.wave, NGW = F.G * 8;
    constexpr int I_UP = (DM / 64) * (NUP / 32), I_DN = (DFF / 64) * (DM / 32), I_IN = (DM / 64) * ((NIN + 31) / 32), I_P5 = (512 / 64) * (DM / 32), I_P10 = (1024 / 64) * (DM / 32), I_OO = (DM / 64) * (DM / 32), I_CK = (4096 / 64) * (128 / 32);
    constexpr int NITEMS = 2 * I_UP + 2 * I_DN + I_IN + 2 * I_P5 + I_P10 + I_OO + 2 * I_CK;
    for (int it = gw; it < NITEMS; it += NGW) {
        int r = it; const float* W; const float* ks = nullptr; bf16* WT; int K, N, ldt, koff = 0, mode = 0;
        if (r < I_UP) { W = lin(F, I_WUP1, l, (size_t)DM * NUP); K = DM; N = NUP; WT = WSP(bf16, WS_WUP1); ldt = DM; ks = lin(F, I_GF1, l, DM); mode = 1; }
        else if ((r -= I_UP) < I_UP) { W = lin(F, I_WUP2, l, (size_t)DM * NUP); K = DM; N = NUP; WT = WSP(bf16, WS_WUP2); ldt = DM; ks = lin(F, I_GF2, l, DM); mode = 1; }
        else if ((r -= I_UP) < I_DN) { W = lin(F, I_WDN1, l, (size_t)DFF * DM); K = DFF; N = DM; WT = WSP(bf16, WS_WDN1); ldt = DFF; }
        else if ((r -= I_DN) < I_DN) { W = lin(F, I_WDN2, l, (size_t)DFF * DM); K = DFF; N = DM; WT = WSP(bf16, WS_WDN2); ldt = DFF; }
        else if ((r -= I_DN) < I_IN) { W = lin(F, I_WIN, l, (size_t)DM * NIN); K = DM; N = NIN; WT = WSP(bf16, WS_WIN); ldt = DM; ks = lin(F, I_GMIX, l, DM); mode = 2; }
        else if ((r -= I_IN) < I_P5) { W = lin(F, I_PA, l, (size_t)512 * DM); K = 512; N = DM; WT = WSP(bf16, WS_WPM); ldt = DM; }
        else if ((r -= I_P5) < I_P5) { W = lin(F, I_PB, l, (size_t)512 * DM); K = 512; N = DM; WT = WSP(bf16, WS_WPM); ldt = DM; koff = 512; }
        else if ((r -= I_P5) < I_P10) { W = lin(F, I_PC, l, (size_t)1024 * DM); K = 1024; N = DM; WT = WSP(bf16, WS_WPM); ldt = DM; koff = 1024; ks = lin(F, I_SNORM, l, 1024); }
        else if ((r -= I_P10) < I_OO) { W = lin(F, I_WO, l, (size_t)DM * DM); K = DM; N = DM; WT = WSP(bf16, WS_WO); ldt = DM; }
        else if ((r -= I_OO) < I_CK) { W = lin(F, I_NWCK, l, (size_t)4096 * 128); K = 4096; N = 128; WT = WSP(bf16, WS_WCK); ldt = 4096; }
        else { r -= I_CK; W = lin(F, I_NWCV, l, (size_t)4096 * 128); K = 4096; N = 128; WT = WSP(bf16, WS_WCV); ldt = 4096; }
        transpose_item(W, K, N, WT, ldt, koff, ks, mode, scr, r, F.lane);
    }
    { bf16* w = WSP(bf16, WS_WIN) + (size_t)(SM0 + 36) * DM; const int n16 = (GT0 - SM0 - 36) * DM / 8;
      const unsigned zu = __builtin_bit_cast(unsigned, opaque_zero());
      for (int i = F.bid * 512 + F.tid; i < n16; i += F.G * 512) ((u32x4*)w)[i] = (u32x4){zu, zu, zu, zu}; }
    { const float* pek = lin(F, I_NPEK, l, 4096); const float* pev = lin(F, I_NPEV, l, 4096); float* cst = WSP(float, WS_CONST);
      for (int it = gw; it < 256; it += NGW) { const int e = it & 127; const float* pe = it < 128 ? pek : pev; const float* w = it < 128 ? lin(F, I_NWCK, l, (size_t)4096 * 128) : lin(F, I_NWCV, l, (size_t)4096 * 128); float s = 0.f;
          for (int k = F.lane; k < 4096; k += 64) s += pe[k] * w[(size_t)k * 128 + e];
          s = wave_sum(s); if (F.lane == 0) cst[it] = s; } }
    if (l == 0) {
        const float* x = F.p->in[I_X]; float* out = F.p->out; bf16* xb = WSP(bf16, WS_XB); unsigned long long* rss = WSP(unsigned long long, WS_CTL) + CW_RS / 2;
        for (int m = gw; m < MTOK; m += NGW) {
            const f32x4* xr = (const f32x4*)(x + (size_t)m * DM) + F.lane; f32x4* orow = (f32x4*)(out + (size_t)m * DM) + F.lane; u32x2* br = (u32x2*)(xb + (size_t)m * DM) + F.lane; float ss = 0.f;
#pragma unroll
            for (int j = 0; j < 8; ++j) { const f32x4 v = xr[64 * j]; orow[64 * j] = v; ss += (v[0] * v[0] + v[1] * v[1]) + (v[2] * v[2] + v[3] * v[3]); u32x2 w; w.x = pk2(v[0], v[1]); w.y = pk2(v[2], v[3]); br[64 * j] = w; }
            ss = wave_sum(ss); if (F.lane == 0) rss[m] = pg8::rss_fix(ss);
        }
    }
}

DEV void nsa_prep_job(Frame& F, int l, int job) {
    const int b = job >> 8, g = (job >> 7) & 1, j = job & 127, bg = b * 2 + g, t0 = 64 * j;
    const bf16* p1 = WSP(bf16, WS_P1);
    const float* qn = lin(F, I_NQN, l, 128); const float* kn = lin(F, I_NKN, l, 128);
    bf16* QN = WSP(bf16, WS_QN); bf16* KS = WSP(bf16, WS_KS); bf16* KW = WSP(bf16, WS_KW); bf16* VST = WSP(bf16, WS_VST); bf16* VWT = WSP(bf16, WS_VWT);
    const float gq0 = qn[2 * F.lane], gq1 = qn[2 * F.lane + 1], gk0 = kn[2 * F.lane], gk1 = kn[2 * F.lane + 1];
    for (int i = 0; i < 8; ++i) {
        const int t = t0 + 8 * F.wave + i; const size_t row = (size_t)(b * SEQ + t) * P1W;
#pragma unroll
        for (int v = 0; v < 4; ++v) {
            const int col = v < 2 ? C_BQ + (g * 2 + v) * 128 : (v == 2 ? C_BKS + g * 128 : C_BKW + g * 128);
            const unsigned w = *(const unsigned*)(p1 + row + col + 2 * F.lane);
            const float x0 = bflo(w), x1 = bfhi(w);
            const float ss = wave_sum(x0 * x0 + x1 * x1);
            float r = rsqrtf(ss * (1.0f / 128.0f) + EPS);
            unsigned o;
            if (v < 2) { r *= 0.08838834764831845f; o = pk2(x0 * r * gq0, x1 * r * gq1); *(unsigned*)(QN + ((size_t)(bg * SEQ + t) * 2 + v) * 128 + 2 * F.lane) = o; }
            else { o = pk2(x0 * r * gk0, x1 * r * gk1); *(unsigned*)((v == 2 ? KS : KW) + (size_t)(bg * SEQ + t) * 128 + 2 * F.lane) = o; }
        }
    }
    LAS bf16* tl = (LAS bf16*)F.lds;
    for (int i = F.tid; i < 2 * 64 * 64; i += 512) {
        const int v = i >> 12, r = (i >> 6) & 63, c2 = i & 63;
        const unsigned w = *(const unsigned*)(p1 + (size_t)(b * SEQ + t0 + r) * P1W + (v ? C_BVW : C_BVS) + g * 128 + 2 * c2);
        *(LAS unsigned*)(tl + (v * 64 + r) * 130 + 2 * c2) = w;
    }
    __syncthreads();
    for (int i = F.tid; i < 2 * 128 * 8; i += 512) {
        const int v = i >> 10, d = i & 127, tc = (i >> 7) & 7;
        const LAS bf16* s = tl + (v * 64 + 8 * tc) * 130 + d;
        u32x4 o; o.x = s[0] | ((unsigned)s[130] << 16); o.y = s[260] | ((unsigned)s[390] << 16); o.z = s[520] | ((unsigned)s[650] << 16); o.w = s[780] | ((unsigned)s[910] << 16);
        *(u32x4*)((v ? VWT : VST) + ((size_t)(bg * 128 + j) * 128 + d) * 64 + 8 * tc) = o;
    }
    __syncthreads();
}

DEV void gdn_prep_job(Frame& F, int l, int job) {
    const int b = job >> 9, h = (job >> 7) & 3, c = job & 127, t0 = 64 * c;
    const bf16* p1 = WSP(bf16, WS_P1); const float* small = WSP(float, WS_SMALL);
    const float* convw = lin(F, I_GCONV, l, 4 * 1536);
    LAS float* Qs = (LAS float*)F.lds;
    LAS float* Ks = Qs + 64 * 132;
    LAS float* Vs = Ks + 64 * 132;
    LAS float* Mm = Vs + 64 * 132;
    LAS float* At = Mm + 64 * 68;
    LAS float* beta = At + 64 * 68;
    LAS float* gc = beta + 64;
    LAS float* eg = gc + 64;
    const int tid = F.tid;
    {
        const int ch = tid & 127, tg = tid >> 7;
#pragma unroll
        for (int v = 0; v < 3; ++v) {
            const int cc = v * 512 + h * 128 + ch;
            const float w0 = convw[cc], w1 = convw[1536 + cc], w2 = convw[2 * 1536 + cc], w3 = convw[3 * 1536 + cc];
            const int col = (v == 0 ? C_AQ : (v == 1 ? C_AK : C_AV)) + h * 128 + ch;
            float xin[19];
            { const int tt = t0 + 16 * tg;
#pragma unroll
              for (int i = 0; i < 19; ++i) { const int t = tt - 3 + i; xin[i] = t >= 0 ? bf2f(p1[(size_t)(b * SEQ + t) * P1W + col]) : 0.f; } }
            LAS float* dst = v == 0 ? Qs : (v == 1 ? Ks : Vs);
#pragma unroll
            for (int i = 0; i < 16; ++i) {
                const float y = w0 * xin[i] + w1 * xin[i + 1] + w2 * xin[i + 2] + w3 * xin[i + 3];
                dst[(16 * tg + i) * 132 + ch] = siluf_(y);
            }
        }
        if (tid < 64) {
            const size_t row = (size_t)(b * SEQ + t0 + tid);
            const float a = small[row * SMW + S_AA + h], bb = small[row * SMW + S_AB + h];
            beta[tid] = sigmoidf_(bb);
            gc[tid] = -__expf(lin(F, I_GALOG, l, 4)[h]) * softplusf_(a + lin(F, I_GDTB, l, 4)[h]);
        }
    }
    __syncthreads();
    for (int i = 0; i < 16; ++i) {
        const int r = F.wave * 16 + i;
        LAS float* p = (r < 64 ? Qs + r * 132 : Ks + (r - 64) * 132);
        const float x0 = p[F.lane], x1 = p[F.lane + 64];
        const float ss = wave_sum(x0 * x0 + x1 * x1);
        float sc = rsqrtf(ss + EPS); if (r < 64) sc *= 0.08838834764831845f;
        p[F.lane] = x0 * sc; p[F.lane + 64] = x1 * sc;
    }
    if (tid == 0) { float s = 0.f; for (int i = 0; i < 64; ++i) { s += gc[i]; gc[i] = s; eg[i] = __expf(s); } }
    __syncthreads();
    {
        const int i = tid >> 3, jg = tid & 7;
        float kk[8], qk[8];
#pragma unroll
        for (int jj = 0; jj < 8; ++jj) { kk[jj] = 0.f; qk[jj] = 0.f; }
        const LAS f32x4* ki4 = (const LAS f32x4*)(Ks + i * 132); const LAS f32x4* qi4 = (const LAS f32x4*)(Qs + i * 132);
        for (int d4 = 0; d4 < 32; ++d4) {
            const f32x4 ki = ki4[d4], qi = qi4[d4];
#pragma unroll
            for (int jj = 0; jj < 8; ++jj) { const f32x4 kj = ((const LAS f32x4*)(Ks + (jg + 8 * jj) * 132))[d4];
                kk[jj] += (ki[0] * kj[0] + ki[1] * kj[1]) + (ki[2] * kj[2] + ki[3] * kj[3]); qk[jj] += (qi[0] * kj[0] + qi[1] * kj[1]) + (qi[2] * kj[2] + qi[3] * kj[3]); }
        }
        const float gi = gc[i], bi = beta[i];
#pragma unroll
        for (int jj = 0; jj < 8; ++jj) { const int j = jg + 8 * jj; const float dec = j <= i ? __expf(gi - gc[j]) : 0.f;
            Mm[i * 68 + j] = j < i ? bi * kk[jj] * dec : 0.f; At[i * 68 + j] = qk[jj] * dec; }
    }
    __syncthreads();
    unsigned char* cb = F.ws + WS_GW + (size_t)job * GDN_CH_BYTES;
    bf16* gW = (bf16*)cb; bf16* gQD = (bf16*)(cb + 16384); bf16* gKDT = (bf16*)(cb + 32768); bf16* gUT = (bf16*)(cb + 49152); bf16* gAT = (bf16*)(cb + 65536);
    float sol[64];
    if (tid < 256) {
        const int cidx = tid & 127; const bool isw = tid >= 128;
        const LAS float* src = (isw ? Ks : Vs) + cidx;
        const LAS float* MmL = (const LAS float*)lds_vbase(Mm); const LAS float* betaL = (const LAS float*)lds_vbase(beta); const LAS float* egL = (const LAS float*)lds_vbase(eg);
#pragma unroll
        for (int i = 0; i < 64; ++i) sol[i] = 0.f;
#pragma unroll
        for (int i = 0; i < 64; ++i) {
            float r = src[i * 132] * betaL[i] * (isw ? egL[i] : 1.0f), r1 = 0.f, r2 = 0.f, r3 = 0.f;
#pragma unroll
            for (int j4 = 0; j4 < (i + 3) / 4; ++j4) { const f32x4 mv = *(const LAS f32x4*)(MmL + i * 68 + 4 * j4);
                r -= mv[0] * sol[4 * j4]; r1 -= mv[1] * sol[4 * j4 + 1]; r2 -= mv[2] * sol[4 * j4 + 2]; r3 -= mv[3] * sol[4 * j4 + 3]; }
            r = (r + r1) + (r2 + r3);
            sol[i] = r;
            asm volatile("" : "+v"(sol[i]) :: "memory");
        }
    } else {
        const int t2 = tid - 256;
        const float gl = gc[63];
        for (int i = t2; i < 64 * 16; i += 256) { const int r = i >> 4, c8 = (i & 15) * 8; const float e = eg[r]; const LAS float* s = Qs + r * 132 + c8;
            u32x4 o; o.x = pk2(s[0] * e, s[1] * e); o.y = pk2(s[2] * e, s[3] * e); o.z = pk2(s[4] * e, s[5] * e); o.w = pk2(s[6] * e, s[7] * e); *(u32x4*)(gQD + r * 128 + c8) = o; }
        for (int i = t2; i < 128 * 8; i += 256) { const int dk = i & 127, i8 = (i >> 7) * 8; float v[8];
#pragma unroll
            for (int q = 0; q < 8; ++q) v[q] = Ks[(i8 + q) * 132 + dk] * __expf(gl - gc[i8 + q]);
            u32x4 o; o.x = pk2(v[0], v[1]); o.y = pk2(v[2], v[3]); o.z = pk2(v[4], v[5]); o.w = pk2(v[6], v[7]); *(u32x4*)(gKDT + dk * 64 + i8) = o; }
        for (int i = t2; i < 64 * 8; i += 256) { const int r = i >> 3, c8 = (i & 7) * 8; const LAS float* s = At + r * 68 + c8;
            u32x4 o; o.x = pk2(s[0], s[1]); o.y = pk2(s[2], s[3]); o.z = pk2(s[4], s[5]); o.w = pk2(s[6], s[7]); *(u32x4*)(gAT + r * 64 + c8) = o; }
        if (t2 == 0) WSP(float, WS_GL)[job] = __expf(gl);
    }
    __syncthreads();
    LAS bf16* Wl = (LAS bf16*)Qs;
    if (tid < 128) {
#pragma unroll
        for (int q = 0; q < 8; ++q) { u32x4 o; o.x = pk2(sol[8 * q], sol[8 * q + 1]); o.y = pk2(sol[8 * q + 2], sol[8 * q + 3]); o.z = pk2(sol[8 * q + 4], sol[8 * q + 5]); o.w = pk2(sol[8 * q + 6], sol[8 * q + 7]);
            *(u32x4*)(gUT + tid * 64 + 8 * q) = o; }
    } else if (tid < 256) {
#pragma unroll
        for (int i = 0; i < 64; ++i) Wl[i * 136 + (tid - 128)] = (bf16)f2bf(sol[i]);
    }
    __syncthreads();
    for (int i = tid; i < 64 * 16; i += 512) { const int r = i >> 4, c8 = (i & 15) * 8; *(u32x4*)(gW + r * 128 + c8) = *(const LAS u32x4*)(Wl + r * 136 + c8); }
    __syncthreads();
}

DEV void ssd_prep_job(Frame& F, int l, int job) {
    const int b = job >> 7, c = (job >> 1) & 63, g = job & 1, t0 = 128 * c;
    const float zf_ = opaque_zero();
    const bf16* p1 = WSP(bf16, WS_P1); const float* small = WSP(float, WS_SMALL);
    const float* cw = lin(F, I_SCW, l, 4 * 1536); const float* cbias = lin(F, I_SCB, l, 1536);
    bf16* SX = WSP(bf16, WS_SX); float* SDT = WSP(float, WS_SDT); float* SAC = WSP(float, WS_SAC); float* SST = WSP(float, WS_SST); float* SCD = WSP(float, WS_SCD);
    LAS bf16* BT = (LAS bf16*)F.lds;
    LAS bf16* XT = BT + 128 * 136;
    LAS float* dts = (LAS float*)(XT + 64 * 136);
    LAS float* acs = dts + 128 * 8;
    const int tid = F.tid;
    for (int i = tid; i < 1024; i += 512) { const int tl = i >> 3, hh = i & 7, h = 8 * g + hh; const size_t row = (size_t)(b * SEQ + t0 + tl);
        const float dt = softplusf_(small[row * SMW + S_DT + h] + lin(F, I_SDTB, l, 16)[h]);
        dts[i] = dt; acs[i] = dt * (-__expf(lin(F, I_SALOG, l, 16)[h])); }
    __syncthreads();
    if (tid < 8) { float s = 0.f; for (int tl = 0; tl < 128; ++tl) { s += acs[tl * 8 + tid]; acs[tl * 8 + tid] = s; } }
    __syncthreads();
    for (int i = tid; i < 1024; i += 512) { const int tl = i >> 3, hh = i & 7; const size_t row = (size_t)(b * SEQ + t0 + tl); SDT[row * 16 + 8 * g + hh] = dts[i]; SAC[row * 16 + 8 * g + hh] = acs[i]; }
    if (tid < 8) SCD[(size_t)(b * 64 + c) * 16 + 8 * g + tid] = __expf(acs[127 * 8 + tid]);
    {
        const int ch = tid & 255, half = tid >> 8; const int cc = 1024 + (ch < 128 ? g * 128 + ch : 256 + g * 128 + (ch - 128));
        const float w0 = cw[cc], w1 = cw[1536 + cc], w2 = cw[2 * 1536 + cc], w3 = cw[3 * 1536 + cc], bs = cbias[cc];
        const int col = C_CX + cc;
        for (int q = 0; q < 4; ++q) {
            const int ts = t0 + 64 * half + 16 * q; float xin[19];
#pragma unroll
            for (int i = 0; i < 19; ++i) { const int t = ts - 3 + i; xin[i] = t >= 0 ? bf2f(p1[(size_t)(b * SEQ + t) * P1W + col]) : 0.f; }
#pragma unroll
            for (int i = 0; i < 16; ++i) { const int tl = 64 * half + 16 * q + i; const size_t row = (size_t)(b * SEQ + t0 + tl);
                const float y = siluf_(w0 * xin[i] + w1 * xin[i + 1] + w2 * xin[i + 2] + w3 * xin[i + 3] + bs); const bf16 yb = (bf16)f2bf(y);
                SX[row * 1536 + cc] = yb; if (ch < 128) BT[ch * 136 + tl] = yb; }
        }
    }
    for (int hh = 0; hh < 8; ++hh) {
        const int h = 8 * g + hh;
        __syncthreads();
        {
            const int ch = tid & 63, tg = tid >> 6; const int cc = h * 64 + ch;
            const float w0 = cw[cc], w1 = cw[1536 + cc], w2 = cw[2 * 1536 + cc], w3 = cw[3 * 1536 + cc], bs = cbias[cc];
            const int col = C_CX + cc; const int ts = t0 + 16 * tg;
            float xin[19];
#pragma unroll
            for (int i = 0; i < 19; ++i) { const int t = ts - 3 + i; xin[i] = t >= 0 ? bf2f(p1[(size_t)(b * SEQ + t) * P1W + col]) : 0.f; }
            const float al = acs[127 * 8 + hh];
#pragma unroll
            for (int i = 0; i < 16; ++i) { const int tl = 16 * tg + i; const size_t row = (size_t)(b * SEQ + t0 + tl);
                const float y = siluf_(w0 * xin[i] + w1 * xin[i + 1] + w2 * xin[i + 2] + w3 * xin[i + 3] + bs); const bf16 yb = (bf16)f2bf(y);
                SX[row * 1536 + cc] = yb;
                XT[ch * 136 + tl] = (bf16)f2bf(bf2f(yb) * dts[tl * 8 + hh] * __expf(al - acs[tl * 8 + hh])); }
        }
        __syncthreads();
        {
            const int mt = F.wave & 3, nb = (F.wave >> 2) * 4;
            bf16x8 a[4];
#pragma unroll
            for (int ks = 0; ks < 4; ++ks) a[ks] = frag_l(XT, 136, 16 * mt, 32 * ks, F.lane);
            float* dst = SST + ((size_t)((b * 64 + c) * 16 + h) * 64) * 128;
#pragma unroll
            for (int q = 0; q < 4; ++q) { f32x4 acc = ZERO4;
#pragma unroll
                for (int ks = 0; ks < 4; ++ks) acc = mfma16(a[ks], frag_l(BT, 136, 16 * (nb + q), 32 * ks, F.lane), acc);
#pragma unroll
                for (int r = 0; r < 4; ++r) dst[(size_t)(16 * mt + 4 * (F.lane >> 4) + r) * 128 + 16 * (nb + q) + (F.lane & 15)] = acc[r]; }
        }
    }
    __syncthreads();
}

DEV void nsa_compress_job(Frame& F, int l, int job) {
    const int kv = job >> 4, bg = (job >> 2) & 3, rt = job & 3, b = bg >> 1, g = bg & 1, i0 = 128 * rt;
    const float zf_ = opaque_zero();
    const bf16* p1 = WSP(bf16, WS_P1); const bf16* Wt = WSP(bf16, kv ? WS_WCV : WS_WCK); const float* cst = WSP(float, WS_CONST) + kv * 128;
    const int col0 = (kv ? C_BVC : C_BKC) + g * 128;
    LAS bf16* As = (LAS bf16*)F.lds;
    LAS bf16* Bs = As + 128 * 72;
    LAS float* Cs = (LAS float*)(Bs + 128 * 72);
    const int tid = F.tid, wm = F.wave >> 1, wn = F.wave & 1;
    f32x4 acc[2][4];
#pragma unroll
    for (int i = 0; i < 2; ++i)
#pragma unroll
        for (int j = 0; j < 4; ++j) acc[i][j] = ZERO4;
    u32x4 ra[2], rb[2];
#define LOADK(ks_) do { _Pragma("unroll") for (int q = 0; q < 2; ++q) { const int ch = tid + 512 * q, r = ch >> 3, c8 = (ch & 7) * 8; \
            int t = 16 * (i0 + r) + ((ks_) >> 1); if (t > SEQ - 1) t = SEQ - 1;     \
            ra[q] = *(const u32x4*)(p1 + (size_t)(b * SEQ + t) * P1W + col0 + ((ks_) & 1) * 64 + c8); \
            rb[q] = *(const u32x4*)(Wt + (size_t)r * 4096 + 64 * (ks_) + c8); } } while (0)
    LOADK(0);
    for (int ks = 0; ks < 64; ++ks) {
        __syncthreads();
#pragma unroll
        for (int q = 0; q < 2; ++q) { const int ch = tid + 512 * q, r = ch >> 3, c8 = (ch & 7) * 8; *(LAS u32x4*)(As + r * 72 + c8) = ra[q]; *(LAS u32x4*)(Bs + r * 72 + c8) = rb[q]; }
        __syncthreads();
        if (ks + 1 < 64) LOADK(ks + 1);
#pragma unroll
        for (int k2 = 0; k2 < 2; ++k2) {
            bf16x8 a0 = frag_l(As, 72, 32 * wm, 32 * k2, F.lane), a1 = frag_l(As, 72, 32 * wm + 16, 32 * k2, F.lane);
#pragma unroll
            for (int j = 0; j < 4; ++j) { const bf16x8 bb = frag_l(Bs, 72, 64 * wn + 16 * j, 32 * k2, F.lane); acc[0][j] = mfma16(a0, bb, acc[0][j]); acc[1][j] = mfma16(a1, bb, acc[1][j]); }
        }
    }
    __syncthreads();
#pragma unroll
    for (int i = 0; i < 2; ++i)
#pragma unroll
        for (int j = 0; j < 4; ++j)
#pragma unroll
            for (int r = 0; r < 4; ++r) { const int col = 64 * wn + 16 * j + (F.lane & 15); Cs[(32 * wm + 16 * i + 4 * (F.lane >> 4) + r) * 132 + col] = acc[i][j][r] + cst[col]; }
    __syncthreads();
    if (kv == 0) {
        const float* kn = lin(F, I_NKN, l, 128); bf16* KC = WSP(bf16, WS_KCMP);
        const int r = tid >> 2, q = tid & 3; const LAS float* s = Cs + r * 132 + 32 * q; float ss = 0.f;
#pragma unroll
        for (int e = 0; e < 32; ++e) ss += s[e] * s[e];
        ss += shx<1>(ss); ss += shx<2>(ss);
        const float rs = rsqrtf(ss * (1.0f / 128.0f) + EPS);
        bf16* dst = KC + ((size_t)bg * 512 + i0 + r) * 128 + 32 * q;
#pragma unroll
        for (int e = 0; e < 32; e += 2) *(unsigned*)(dst + e) = pk2(s[e] * rs * kn[32 * q + e], s[e + 1] * rs * kn[32 * q + e + 1]);
    } else {
        bf16* VC = WSP(bf16, WS_VCMPT); const int e = tid & 127, q = tid >> 7;
#pragma unroll
        for (int i8 = 0; i8 < 4; ++i8) { const LAS float* s = Cs + (32 * q + 8 * i8) * 132 + e;
            u32x4 o; o.x = pk2(s[0], s[132]); o.y = pk2(s[264], s[396]); o.z = pk2(s[528], s[660]); o.w = pk2(s[792], s[924]);
            *(u32x4*)(VC + ((size_t)bg * 128 + e) * 512 + i0 + 32 * q + 8 * i8) = o; }
    }
    __syncthreads();
}
#undef LOADK

constexpr int AL_KT = 0, AL_VT = 17408, AL_PW = 35840, AL_TB = 54272, AL_SM = 60608, AL_UM = 61632, AL_PS = 61696, AL_IMP = 78336, AL_END = 111104;
DEV int rel_bucket_dev(int n) {
    if (n < 16) return n;
    int k = 16;
    k += (n >= 21); k += (n >= 27); k += (n >= 35); k += (n >= 46); k += (n >= 59); k += (n >= 77); k += (n >= 99); k += (n >= 128);
    k += (n >= 166); k += (n >= 216); k += (n >= 280); k += (n >= 363); k += (n >= 470); k += (n >= 609); k += (n >= 790);
    return k;
}
DEV void attn_fill_bias(Frame& F, int g) {
    LAS float* tb = (LAS float*)(F.lds + AL_TB); const float* rt = F.p->in[I_REL];
    for (int i = F.tid; i < 2 * 792; i += 512) { const int hg = i / 792, d = i - hg * 792; tb[i] = rt[rel_bucket_dev(d) * 4 + 2 * g + hg]; }
}
DEV void attn_load_tile(u32x4 (&rk)[2], u32x4 (&rv)[2], const bf16* ksrc, const bf16* vsrc, int vpitch, int tid) {
#pragma unroll
    for (int q = 0; q < 2; ++q) { const int ch = tid + 512 * q; rk[q] = *(const u32x4*)(ksrc + (size_t)ch * 8); rv[q] = *(const u32x4*)(vsrc + (size_t)(ch >> 3) * vpitch + (ch & 7) * 8); }
}
DEV void attn_store_tile(LAS unsigned char* lds, const u32x4 (&rk)[2], const u32x4 (&rv)[2], int tid) {
    LAS bf16* Kt = (LAS bf16*)(lds + AL_KT); LAS bf16* Vt = (LAS bf16*)(lds + AL_VT);
#pragma unroll
    for (int q = 0; q < 2; ++q) { const int ch = tid + 512 * q; *(LAS u32x4*)(Kt + (ch >> 4) * 136 + (ch & 15) * 8) = rk[q]; *(LAS u32x4*)(Vt + (ch >> 3) * 72 + (ch & 7) * 8) = rv[q]; }
}
template <int MODE, int PATH = 0>
DEV unsigned attn_scores(LAS unsigned char* lds, const bf16x8 (&qf)[4], int lane, int n0, int tok, int hg, unsigned selbit, f32x4 (&s)[4]) {
    const float zf_ = opaque_zero();
    const LAS bf16* Kt = (const LAS bf16*)(lds + AL_KT); const LAS float* tb = (const LAS float*)(lds + AL_TB) + hg * 792;
#pragma unroll
    for (int nt = 0; nt < 4; ++nt) { s[nt] = ZERO4;
#pragma unroll
        for (int ks = 0; ks < 4; ++ks) s[nt] = mfma16(frag_l(Kt, 136, 16 * nt, 32 * ks, lane), qf[ks], s[nt]); }
    if (PATH == 1) {
        const float bf = tb[790]; const bool ok = selbit != 0u;
#pragma unroll
        for (int nt = 0; nt < 4; ++nt)
#pragma unroll
            for (int r = 0; r < 4; ++r) s[nt][r] = ok ? s[nt][r] + bf : -1e30f;
        return ok ? 0xffffu : 0u;
    }
    if (PATH == 2) {
        const bool ok = MODE == 2 ? true : (selbit != 0u);
        const LAS float* tp = tb + (tok - n0 - 4 * (lane >> 4));
#pragma unroll
        for (int nt = 0; nt < 4; ++nt)
#pragma unroll
            for (int r = 0; r < 4; ++r) s[nt][r] = ok ? s[nt][r] + tp[-16 * nt - r] : -1e30f;
        return ok ? 0xffffu : 0u;
    }
    unsigned vm = 0u;
#pragma unroll
    for (int nt = 0; nt < 4; ++nt)
#pragma unroll
        for (int r = 0; r < 4; ++r) { const int n = n0 + 16 * nt + 4 * (lane >> 4) + r; int dist; bool ok;
            if (MODE == 0) { dist = tok - (16 * n + 31); ok = dist >= 0 && n < 511; }
            else if (MODE == 1) { dist = tok - n; ok = dist >= 0 && selbit != 0u; }
            else { dist = tok - n; ok = dist >= 0 && dist < 512; }
            int di = dist < 0 ? 0 : dist; di = di > 790 ? 790 : di;
            s[nt][r] = ok ? s[nt][r] + tb[di] : -1e30f;
            vm |= (ok ? 1u : 0u) << (4 * nt + r); }
    return vm;
}
DEV float attn_online(const f32x4 (&s)[4], unsigned vm, float& m, float& l, f32x4 (&p)[4]) {
    float mx = fmaxf(fmaxf(fmaxf(s[0][0], s[0][1]), fmaxf(s[0][2], s[0][3])), fmaxf(fmaxf(s[1][0], s[1][1]), fmaxf(s[1][2], s[1][3])));
    mx = fmaxf(mx, fmaxf(fmaxf(fmaxf(s[2][0], s[2][1]), fmaxf(s[2][2], s[2][3])), fmaxf(fmaxf(s[3][0], s[3][1]), fmaxf(s[3][2], s[3][3]))));
    mx = fmaxf(mx, shx<16>(mx)); mx = fmaxf(mx, shx<32>(mx));
    const float mn = fmaxf(m, mx), sc = __expf(m - mn); float rs = 0.f;
#pragma unroll
    for (int nt = 0; nt < 4; ++nt)
#pragma unroll
        for (int r = 0; r < 4; ++r) { const float pv = ((vm >> (4 * nt + r)) & 1u) ? __expf(s[nt][r] - mn) : 0.f; p[nt][r] = pv; rs += pv; }
    rs += shx<16>(rs); rs += shx<32>(rs);
    l = l * sc + rs; m = mn;
    return sc;
}
DEV void attn_pv(LAS unsigned char* lds, int lane, const f32x4 (&p)[4], f32x4 (&o)[8]) {
    const LAS bf16* Vt = (const LAS bf16*)(lds + AL_VT) + (lane & 15) * 72 + 4 * (lane >> 4);
#pragma unroll
    for (int ks = 0; ks < 2; ++ks) {
        u32x4 pw; pw.x = pk2(p[2 * ks][0], p[2 * ks][1]); pw.y = pk2(p[2 * ks][2], p[2 * ks][3]); pw.z = pk2(p[2 * ks + 1][0], p[2 * ks + 1][1]); pw.w = pk2(p[2 * ks + 1][2], p[2 * ks + 1][3]);
        const bf16x8 pb = __builtin_bit_cast(bf16x8, pw);
#pragma unroll
        for (int dt = 0; dt < 8; ++dt) {
            const u32x2 v0 = *(const LAS u32x2*)(Vt + 16 * dt * 72 + 32 * ks), v1 = *(const LAS u32x2*)(Vt + 16 * dt * 72 + 32 * ks + 16);
            u32x4 vw; vw.x = v0.x; vw.y = v0.y; vw.z = v1.x; vw.w = v1.y;
            o[dt] = mfma16(__builtin_bit_cast(bf16x8, vw), pb, o[dt]); }
    }
}
DEV void attn_load_q(Frame& F, int bg, int t0, bf16x8 (&qf)[4]) {
    const bf16* QN = WSP(bf16, WS_QN); const int rho = F.lane & 15;
    const bf16* src = QN + ((size_t)(bg * SEQ + t0 + 8 * F.wave + (rho & 7)) * 2 + (rho >> 3)) * 128 + 8 * (F.lane >> 4);
#pragma unroll
    for (int ks = 0; ks < 4; ++ks) qf[ks] = *(const bf16x8*)(src + 32 * ks);
}

DEV void nsa_job(Frame& F, int job) {
    const int bg = job >> 7, qt = job & 127, b = bg >> 1, g = bg & 1, t0 = 64 * qt, tid = F.tid, lane = F.lane, wave = F.wave;
    const float zf_ = opaque_zero();
    const int fq = lane >> 4, fr = lane & 15, hg = fr >> 3, tok = t0 + 8 * wave + (fr & 7);
    const float* small = WSP(float, WS_SMALL); const size_t row = (size_t)(b * SEQ + tok);
    LAS float* PS = (LAS float*)(F.lds + AL_PS) + wave * (8 * 65); LAS float* IMP = (LAS float*)(F.lds + AL_IMP);
    LAS unsigned* SM = (LAS unsigned*)(F.lds + AL_SM);
    LAS unsigned* UW = (LAS unsigned*)(F.lds + AL_PW);
    __syncthreads();
    attn_fill_bias(F, g);
    for (int i = tid; i < 64 * 128; i += 512) IMP[i] = 0.f;
    if (lane < 8) PS[lane * 65] = 0.f;
    bf16x8 qf[4]; attn_load_q(F, bg, t0, qf);
    f32x4 tot[8];
    u32x4 rk[2], rv[2];
    {
        const int ntiles = (4 * qt + 2) / 64 + 1;
        const bf16* KC = WSP(bf16, WS_KCMP) + (size_t)bg * 512 * 128; const bf16* VC = WSP(bf16, WS_VCMPT) + (size_t)bg * 128 * 512;
        float m = -1e30f, l = 0.f;
        attn_load_tile(rk, rv, KC, VC, 512, tid);
        for (int j = 0; j < ntiles; ++j) {
            __syncthreads(); attn_store_tile(F.lds, rk, rv, tid); __syncthreads();
            if (j + 1 < ntiles) attn_load_tile(rk, rv, KC + (size_t)(j + 1) * 64 * 128, VC + (j + 1) * 64, 512, tid);
            f32x4 s[4], p[4];
            const unsigned vm = attn_scores<0>(F.lds, qf, lane, 64 * j, tok, hg, 0u, s);
            (void)attn_online(s, vm, m, l, p);
        }
        const float il = l > 0.f ? 1.0f / l : 0.f;
        f32x4 o[8];
#pragma unroll
        for (int dt = 0; dt < 8; ++dt) o[dt] = ZERO4;
        attn_load_tile(rk, rv, KC, VC, 512, tid);
        for (int j = 0; j < ntiles; ++j) {
            __syncthreads(); attn_store_tile(F.lds, rk, rv, tid); __syncthreads();
            if (j + 1 < ntiles) attn_load_tile(rk, rv, KC + (size_t)(j + 1) * 64 * 128, VC + (j + 1) * 64, 512, tid);
            f32x4 s[4], p[4];
            const unsigned vm = attn_scores<0>(F.lds, qf, lane, 64 * j, tok, hg, 0u, s);
#pragma unroll
            for (int nt = 0; nt < 4; ++nt)
#pragma unroll
                for (int r = 0; r < 4; ++r) {
                    const float pv = ((vm >> (4 * nt + r)) & 1u) ? __expf(s[nt][r] - m) * il : 0.f; p[nt][r] = pv;
                    const float ps = pv + shx<8>(pv);
                    if (fr < 8) PS[fr * 65 + 1 + 16 * nt + 4 * fq + r] = ps;
                }
            WAVE_SYNC();
#pragma unroll
            for (int q = 0; q < 2; ++q) { const int idx = lane + 64 * q, tk = idx >> 4, bl = idx & 15; const LAS float* ps = PS + tk * 65 + 4 * bl;
                IMP[(8 * wave + tk) * 128 + 16 * j + bl] = ps[0] + 2.0f * ps[1] + 2.0f * ps[2] + 2.0f * ps[3] + ps[4]; }
            WAVE_SYNC();
            if (lane < 8) PS[lane * 65] = PS[lane * 65 + 64];
            WAVE_SYNC();
            attn_pv(F.lds, lane, p, o);
        }
        const float gt = sigmoidf_(small[row * SMW + S_BG + (2 * g + hg) * 3 + 0]);
#pragma unroll
        for (int dt = 0; dt < 8; ++dt) tot[dt] = o[dt] * gt;
    }
    unsigned wum[4] = {0u, 0u, 0u, 0u};
    {
        const int cur = qt;
        for (int tk = 0; tk < 8; ++tk) {
            const LAS float* rowp = IMP + (8 * wave + tk) * 128;
            const int b0 = lane, b1 = lane + 64;
            const float s0 = b0 > cur ? -1e4f : ((b0 == 0 || b0 >= cur - 1) ? 1e4f : rowp[b0]);
            const float s1 = b1 > cur ? -1e4f : ((b1 == 0 || b1 >= cur - 1) ? 1e4f : rowp[b1]);
            int c0 = 0, c1 = 0;
#pragma unroll 16
            for (int jb = 0; jb < 64; ++jb) {
                const float u0 = __builtin_bit_cast(float, __builtin_amdgcn_readlane(__builtin_bit_cast(int, s0), jb));
                const float u1 = __builtin_bit_cast(float, __builtin_amdgcn_readlane(__builtin_bit_cast(int, s1), jb));
                c0 += (u0 > s0 || (u0 == s0 && jb < b0)) ? 1 : 0;
                c0 += (u1 > s0) ? 1 : 0;
                c1 += (u0 >= s1) ? 1 : 0;
                c1 += (u1 > s1 || (u1 == s1 && jb < b0)) ? 1 : 0;
            }
            const unsigned long long m0 = __ballot(c0 < 16), m1 = __ballot(c1 < 16);
            const unsigned w0 = (unsigned)m0, w1 = (unsigned)(m0 >> 32), w2 = (unsigned)m1, w3 = (unsigned)(m1 >> 32);
            wum[0] |= w0; wum[1] |= w1; wum[2] |= w2; wum[3] |= w3;
            if (lane == 0) { SM[(8 * wave + tk) * 4 + 0] = w0; SM[(8 * wave + tk) * 4 + 1] = w1; SM[(8 * wave + tk) * 4 + 2] = w2; SM[(8 * wave + tk) * 4 + 3] = w3; }
        }
        if (lane == 0) { UW[wave * 4 + 0] = wum[0]; UW[wave * 4 + 1] = wum[1]; UW[wave * 4 + 2] = wum[2]; UW[wave * 4 + 3] = wum[3]; }
    }
    __syncthreads();
    const u32x4 smw = *(const LAS u32x4*)(SM + (8 * wave + (fr & 7)) * 4);
    unsigned um[4];
#pragma unroll
    for (int w = 0; w < 4; ++w) { unsigned v = 0u;
#pragma unroll
        for (int q = 0; q < 8; ++q) v |= UW[q * 4 + w];
        um[w] = __builtin_amdgcn_readfirstlane(v); }
    const bf16* KS = WSP(bf16, WS_KS) + (size_t)bg * SEQ * 128; const bf16* VS = WSP(bf16, WS_VST) + (size_t)bg * 128 * 8192;
    const bf16* KW = WSP(bf16, WS_KW) + (size_t)bg * SEQ * 128; const bf16* VW = WSP(bf16, WS_VWT) + (size_t)bg * 128 * 8192;
    {
        float m = -1e30f, l = 0.f; f32x4 o[8];
#pragma unroll
        for (int dt = 0; dt < 8; ++dt) o[dt] = ZERO4;
        int j = 0;
        attn_load_tile(rk, rv, KS, VS, 64, tid);
        while (j <= qt) {
            int jn = j + 1;
            while (jn <= qt) { const unsigned w = jn < 32 ? um[0] : (jn < 64 ? um[1] : (jn < 96 ? um[2] : um[3])); if ((w >> (jn & 31)) & 1u) break; ++jn; }
            __syncthreads(); attn_store_tile(F.lds, rk, rv, tid); __syncthreads();
            if (jn <= qt) attn_load_tile(rk, rv, KS + (size_t)jn * 64 * 128, VS + (size_t)jn * 128 * 64, 64, tid);
            const unsigned wsel = j < 32 ? wum[0] : (j < 64 ? wum[1] : (j < 96 ? wum[2] : wum[3]));
            if ((wsel >> (j & 31)) & 1u) {
                const unsigned w = j < 32 ? smw.x : (j < 64 ? smw.y : (j < 96 ? smw.z : smw.w)); const unsigned selbit = (w >> (j & 31)) & 1u;
                f32x4 s[4], p[4];
                const unsigned vm = (j <= qt - 14) ? attn_scores<1, 1>(F.lds, qf, lane, 64 * j, tok, hg, selbit, s) : ((j >= qt - 11 && j < qt) ? attn_scores<1, 2>(F.lds, qf, lane, 64 * j, tok, hg, selbit, s) : attn_scores<1, 0>(F.lds, qf, lane, 64 * j, tok, hg, selbit, s));
                const float sc = attn_online(s, vm, m, l, p);
#pragma unroll
                for (int dt = 0; dt < 8; ++dt) o[dt] = o[dt] * sc;
                attn_pv(F.lds, lane, p, o);
            }
            j = jn;
        }
        const float gt = sigmoidf_(small[row * SMW + S_BG + (2 * g + hg) * 3 + 1]) / l;
#pragma unroll
        for (int dt = 0; dt < 8; ++dt) tot[dt] = tot[dt] + o[dt] * gt;
    }
    {
        float m = -1e30f, l = 0.f; f32x4 o[8];
#pragma unroll
        for (int dt = 0; dt < 8; ++dt) o[dt] = ZERO4;
        const int j0 = qt >= 8 ? qt - 8 : 0;
        attn_load_tile(rk, rv, KW + (size_t)j0 * 64 * 128, VW + (size_t)j0 * 128 * 64, 64, tid);
        for (int j = j0; j <= qt; ++j) {
            __syncthreads(); attn_store_tile(F.lds, rk, rv, tid); __syncthreads();
            if (j + 1 <= qt) attn_load_tile(rk, rv, KW + (size_t)(j + 1) * 64 * 128, VW + (size_t)(j + 1) * 128 * 64, 64, tid);
            f32x4 s[4], p[4];
            const unsigned vm = (j >= qt - 7 && j < qt) ? attn_scores<2, 2>(F.lds, qf, lane, 64 * j, tok, hg, 0u, s) : attn_scores<2, 0>(F.lds, qf, lane, 64 * j, tok, hg, 0u, s);
            const float sc = attn_online(s, vm, m, l, p);
#pragma unroll
            for (int dt = 0; dt < 8; ++dt) o[dt] = o[dt] * sc;
            attn_pv(F.lds, lane, p, o);
        }
        const float gt = sigmoidf_(small[row * SMW + S_BG + (2 * g + hg) * 3 + 2]) / l;
#pragma unroll
        for (int dt = 0; dt < 8; ++dt) tot[dt] = tot[dt] + o[dt] * gt;
    }
    {
        bf16* YC = WSP(bf16, WS_YCAT);
#pragma unroll
        for (int dt = 0; dt < 8; ++dt) { const int cidx = (2 * g + hg) * 128 + 16 * dt + 4 * fq;
            f32x4 y = tot[dt]; if (DBG_ZERO & 2) y = ZERO4;
            u32x2 w; w.x = pk2(y[0], y[1]); w.y = pk2(y[2], y[3]); *(u32x2*)(YC + row * 2048 + 512 + cidx) = w; }
    }
    __syncthreads();
}

DEV void gdn_scan_job(Frame& F, int job) {
    const int bh = job >> 3, sl = job & 7, b = bh >> 2, h = bh & 3, lane = F.lane, wave = F.wave, fq = lane >> 4, fr = lane & 15;
    LAS bf16* St = (LAS bf16*)F.lds;
    LAS bf16* Vn = St + 16 * 136;
    const float* GL = WSP(float, WS_GL); float* GO = WSP(float, WS_GO);
    const float zf_ = opaque_zero();
    __syncthreads();
    for (int i = F.tid; i < 16 * 136 / 2; i += 512) ((LAS unsigned*)St)[i] = 0u;
    f32x4 S = ZERO4;
    const int mt = wave & 3;
    __syncthreads();
    const int o1 = (wave < 4 ? 0 : 8192) + (16 * mt + fr) * 128 + 8 * fq;
    const int oA = 32768 + (16 * mt + fr) * 64 + 8 * fq;
    const int oK = 16384 + (16 * wave + fr) * 64 + 8 * fq;
    const int oU = 24576 + (16 * sl + fr) * 64 + 16 * mt + 4 * fq;
    const bf16* rec = (const bf16*)(F.ws + WS_GW + (size_t)(bh * 128) * GDN_CH_BYTES);
    bf16x8 a1[4], aA[2], aK[2], n1[4], nA[2], nK[2]; u32x2 uu, nu; float gl, ngl;
#define GLOAD(A1, AA, AK, UU, G, c_) do { const bf16* r_ = rec + (size_t)(c_) * (GDN_CH_BYTES / 2); \
        _Pragma("unroll") for (int ks = 0; ks < 4; ++ks) A1[ks] = *(const bf16x8*)(r_ + o1 + 32 * ks); \
        AA[0] = *(const bf16x8*)(r_ + oA); AA[1] = *(const bf16x8*)(r_ + oA + 32); AK[0] = *(const bf16x8*)(r_ + oK); AK[1] = *(const bf16x8*)(r_ + oK + 32); \
        UU = *(const u32x2*)(r_ + oU); G = GL[bh * 128 + (c_)]; } while (0)
    GLOAD(a1, aA, aK, uu, gl, 0);
    for (int c = 0; c < 128; ++c) {
        const int cn = c + 1 < 128 ? c + 1 : c;
        GLOAD(n1, nA, nK, nu, ngl, cn);
        f32x4 d1 = ZERO4;
#pragma unroll
        for (int ks = 0; ks < 4; ++ks) d1 = mfma16(a1[ks], frag_l(St, 136, 0, 32 * ks, lane), d1);
        if (wave < 4) {
            const float v0 = bflo(uu.x) - d1[0], v1 = bfhi(uu.x) - d1[1], v2 = bflo(uu.y) - d1[2], v3 = bfhi(uu.y) - d1[3];
            u32x2 w; w.x = pk2(v0, v1); w.y = pk2(v2, v3);
            *(LAS u32x2*)(Vn + fr * 72 + 16 * mt + 4 * fq) = w;
        }
        LDS_WAIT(); __builtin_amdgcn_s_barrier(); CFENCE();
        const bf16x8 bv0 = frag_l(Vn, 72, 0, 0, lane), bv1 = frag_l(Vn, 72, 0, 32, lane);
        if (wave >= 4) {
            d1 = mfma16(aA[0], bv0, d1); d1 = mfma16(aA[1], bv1, d1);
#pragma unroll
            for (int r = 0; r < 4; ++r) GO[(size_t)(b * SEQ + 64 * c + 16 * mt + 4 * fq + r) * 512 + h * 128 + 16 * sl + fr] = d1[r];
        }
        f32x4 dk = ZERO4;
        dk = mfma16(aK[0], bv0, dk); dk = mfma16(aK[1], bv1, dk);
        S = S * gl + dk;
        { u32x2 w; w.x = pk2(S[0], S[1]); w.y = pk2(S[2], S[3]); *(LAS u32x2*)(St + fr * 136 + 16 * wave + 4 * fq) = w; }
        LDS_WAIT(); __builtin_amdgcn_s_barrier(); CFENCE();
#pragma unroll
        for (int ks = 0; ks < 4; ++ks) a1[ks] = n1[ks];
        aA[0] = nA[0]; aA[1] = nA[1]; aK[0] = nK[0]; aK[1] = nK[1]; uu = nu; gl = ngl;
    }
#undef GLOAD
    __syncthreads();
}

DEV void ssd_scan_part(Frame& F, int part, int nparts) {
    float* SST = WSP(float, WS_SST); const float* SCD = WSP(float, WS_SCD);
    constexpr int PER_B = 16 * 64 * 128;
    for (int e = part * 512 + F.tid; e < 2 * PER_B; e += nparts * 512) {
        const int b = e / PER_B, r = e - b * PER_B, h = r >> 13;
        float s = 0.f;
        for (int c = 0; c < 64; ++c) { const size_t idx = (size_t)(b * 64 + c) * PER_B + r; const float st = SST[idx]; SST[idx] = s; s = s * SCD[(b * 64 + c) * 16 + h] + st; }
    }
}

DEV void gdn_final_rows(Frame& F, int l, int w0, int nw) {
    const float* GO = WSP(float, WS_GO); const bf16* p1 = WSP(bf16, WS_P1); bf16* YC = WSP(bf16, WS_YCAT); const float* gn = lin(F, I_GNORM, l, 128);
    const int lane = F.lane, dv0 = (lane & 15) * 8;
    float gv[8];
#pragma unroll
    for (int j = 0; j < 8; ++j) gv[j] = gn[dv0 + j];
    for (int row = w0; row < MTOK; row += nw) {
        const f32x4 a = *(const f32x4*)(GO + (size_t)row * 512 + lane * 8), bq = *(const f32x4*)(GO + (size_t)row * 512 + lane * 8 + 4);
        float ss = (a[0] * a[0] + a[1] * a[1]) + (a[2] * a[2] + a[3] * a[3]) + (bq[0] * bq[0] + bq[1] * bq[1]) + (bq[2] * bq[2] + bq[3] * bq[3]);
        ss = sum16(ss);
        const float rs = rsqrtf(ss * (1.0f / 128.0f) + EPS);
        const u32x4 zw = *(const u32x4*)(p1 + (size_t)row * P1W + C_AZ + lane * 8);
        const float z[8] = {bflo(zw.x), bfhi(zw.x), bflo(zw.y), bfhi(zw.y), bflo(zw.z), bfhi(zw.z), bflo(zw.w), bfhi(zw.w)};
        const float o[8] = {a[0], a[1], a[2], a[3], bq[0], bq[1], bq[2], bq[3]};
        float y[8];
#pragma unroll
        for (int j = 0; j < 8; ++j) y[j] = (DBG_ZERO & 1) ? opaque_zero() : o[j] * rs * gv[j] * siluf_(z[j]);
        u32x4 w; w.x = pk2(y[0], y[1]); w.y = pk2(y[2], y[3]); w.z = pk2(y[4], y[5]); w.w = pk2(y[6], y[7]);
        *(u32x4*)(YC + (size_t)row * 2048 + lane * 8) = w;
    }
}

DEV void ssd_out_job(Frame& F, int l, int job) {
    const int b = job >> 7, c = (job >> 1) & 63, g = job & 1, t0 = 128 * c, tid = F.tid, lane = F.lane, wave = F.wave, fq = lane >> 4, fr = lane & 15;
    const bf16* SX = WSP(bf16, WS_SX); const bf16* p1 = WSP(bf16, WS_P1); const float* SDT = WSP(float, WS_SDT); const float* SAC = WSP(float, WS_SAC); const float* SST = WSP(float, WS_SST);
    bf16* YC = WSP(bf16, WS_YCAT); float* RC = WSP(float, WS_SRC);
    const float zf_ = opaque_zero();
    LAS bf16* Cs = (LAS bf16*)F.lds;
    LAS bf16* Bs = Cs + 128 * 136;
    LAS bf16* XdT = Bs + 128 * 136;
    LAS bf16* SiT = XdT + 64 * 136;
    LAS bf16* Pw = SiT + 64 * 136;
    LAS float* acs = (LAS float*)(Pw + 8 * 16 * 136);
    __syncthreads();
    for (int i = tid; i < 2 * 128 * 16; i += 512) { const int v = i >> 11, r = (i >> 4) & 127, c8 = (i & 15) * 8;
        const u32x4 w = *(const u32x4*)(SX + (size_t)(b * SEQ + t0 + r) * 1536 + 1024 + (v ? 256 : 0) + g * 128 + c8);
        *(LAS u32x4*)((v ? Cs : Bs) + r * 136 + c8) = w; }
    for (int i = tid; i < 1024; i += 512) { const size_t row = (size_t)(b * SEQ + t0 + (i >> 3)); acs[i] = SAC[row * 16 + 8 * g + (i & 7)]; }
    __syncthreads();
    f32x4 cb[8];
    {
        bf16x8 ca[4];
#pragma unroll
        for (int ks = 0; ks < 4; ++ks) ca[ks] = frag_l(Cs, 136, 16 * wave, 32 * ks, lane);
#pragma unroll
        for (int nt = 0; nt < 8; ++nt) { cb[nt] = ZERO4;
#pragma unroll
            for (int ks = 0; ks < 4; ++ks) cb[nt] = mfma16(ca[ks], frag_l(Bs, 136, 16 * nt, 32 * ks, lane), cb[nt]); }
    }
    float ssq[4] = {0.f, 0.f, 0.f, 0.f};
    LAS bf16* pw = Pw + wave * 16 * 136;
    const float* dsk = lin(F, I_SD, l, 16);
    for (int hh = 0; hh < 8; ++hh) {
        const int h = 8 * g + hh;
        __syncthreads();
        for (int i = tid; i < 64 * 128; i += 512) { const int p = i & 63, s = i >> 6;
            XdT[p * 136 + s] = (bf16)f2bf(bf2f(SX[(size_t)(b * SEQ + t0 + s) * 1536 + h * 64 + p]) * SDT[(size_t)(b * SEQ + t0 + s) * 16 + h]); }
        { const float* sin = SST + ((size_t)((b * 64 + c) * 16 + h) * 64) * 128;
          for (int i = tid; i < 64 * 32; i += 512) { const int p = i >> 5, n4 = (i & 31) * 4; const f32x4 v = *(const f32x4*)(sin + p * 128 + n4);
              u32x2 w; w.x = pk2(v[0], v[1]); w.y = pk2(v[2], v[3]); *(LAS u32x2*)(SiT + p * 136 + n4) = w; } }
        float al[4];
#pragma unroll
        for (int r = 0; r < 4; ++r) al[r] = acs[(16 * wave + 4 * fq + r) * 8 + hh];
#pragma unroll
        for (int nt = 0; nt < 8; ++nt) { const int s = 16 * nt + fr; const float as = acs[s * 8 + hh];
#pragma unroll
            for (int r = 0; r < 4; ++r) { const int li = 16 * wave + 4 * fq + r; const float v = s <= li ? cb[nt][r] * __expf(al[r] - as) : 0.f; pw[(4 * fq + r) * 136 + s] = (bf16)f2bf(v); } }
        __syncthreads();
        f32x4 y[4], ys[4];
#pragma unroll
        for (int nt = 0; nt < 4; ++nt) { y[nt] = ZERO4; ys[nt] = ZERO4; }
#pragma unroll
        for (int ks = 0; ks < 4; ++ks) { const bf16x8 pa = frag_l(pw, 136, 0, 32 * ks, lane), cc = frag_l(Cs, 136, 16 * wave, 32 * ks, lane);
#pragma unroll
            for (int nt = 0; nt < 4; ++nt) { y[nt] = mfma16(pa, frag_l(XdT, 136, 16 * nt, 32 * ks, lane), y[nt]); ys[nt] = mfma16(cc, frag_l(SiT, 136, 16 * nt, 32 * ks, lane), ys[nt]); } }
        const float dh = dsk[h];
#pragma unroll
        for (int r = 0; r < 4; ++r) { const size_t row = (size_t)(b * SEQ + t0 + 16 * wave + 4 * fq + r); const float ea = __expf(al[r]);
#pragma unroll
            for (int nt = 0; nt < 4; ++nt) { const int p = 16 * nt + fr;
                const float xs = bf2f(SX[row * 1536 + h * 64 + p]); const float z = bf2f(p1[row * P1W + C_CZ + h * 64 + p]);
                const float v = (DBG_ZERO & 4) ? zf_ : (y[nt][r] + ea * ys[nt][r] + xs * dh) * siluf_(z);
                ssq[r] += v * v; YC[row * 2048 + 1024 + h * 64 + p] = (bf16)f2bf(v); } }
    }
#pragma unroll
    for (int r = 0; r < 4; ++r) { const float s = sum16(ssq[r]); if (fr == 0) RC[(size_t)(b * SEQ + t0 + 16 * wave + 4 * fq + r) * 2 + g] = rsqrtf(s * (1.0f / 512.0f) + EPS); }
    __syncthreads();
}

constexpr int NPH = 12;
#ifndef CPU_EMU
DEV unsigned long long launder64(unsigned long long v) {
    unsigned lo = __builtin_amdgcn_readfirstlane((unsigned)v), hi = __builtin_amdgcn_readfirstlane((unsigned)(v >> 32));
    asm volatile("" : "+s"(lo), "+s"(hi));
    return ((unsigned long long)hi << 32) | lo;
}
DEV bool phase_begin(Frame& F, const Params& prm, int wave0) {
    F.ws = (unsigned char*)launder64((unsigned long long)prm.ws);
    F.p = (KParams)launder64((unsigned long long)__builtin_amdgcn_kernarg_segment_ptr());
    unsigned z = 0u; asm volatile("" : "+v"(z)); const int ln = (int)__builtin_amdgcn_mbcnt_hi(~0u, __builtin_amdgcn_mbcnt_lo(~0u, z));
    int wv = wave0; asm volatile("" : "+s"(wv)); F.wave = wv; F.lane = ln; F.tid = wv * 64 + ln;
    int bi = __builtin_amdgcn_readfirstlane(blockIdx.x); asm volatile("" : "+s"(bi)); F.bid = bi;
    int gg = __builtin_amdgcn_readfirstlane(gridDim.x); asm volatile("" : "+s"(gg)); F.G = gg;
    unsigned la = __builtin_amdgcn_readfirstlane((unsigned)(size_t)F.lds); asm volatile("" : "+s"(la)); F.lds = (LAS unsigned char*)(size_t)la;
    return true;
}
DEV void job_begin(Frame& F) { int t = F.tid; asm volatile("" : "+v"(t)); F.tid = t; F.lane = t & 63; }
__global__ void __launch_bounds__(512, 2) hybrid_fwd(Params prm) {
    extern __shared__ __attribute__((aligned(16))) unsigned char lds_raw[];
    Frame F;
    F.lds = (LAS unsigned char*)lds_raw; F.tid = threadIdx.x; F.lane = F.tid & 63; F.wave = __builtin_amdgcn_readfirstlane(F.tid >> 6);
    const int wave0 = F.wave;
    F.G = gridDim.x; F.bid = blockIdx.x; F.p = (KParams)__builtin_amdgcn_kernarg_segment_ptr(); F.ws = prm.ws;
    volatile LAS unsigned* MISC = (volatile LAS unsigned*)(F.lds + MISC_OFF);
    if (F.tid < 64) MISC[F.tid] = 0u;
    __syncthreads();
    unsigned* ctl = (unsigned*)(F.ws + WS_CTL);
    XcdBarrier bar; bar.bar = ctl + CW_BAR; bar.x = 0; bar.st = nullptr;
    if (prm.use_bar) bar = xcd_barrier_post(ctl + CW_BAR, MISC + 8);
    const int lo = prm.lo, hi = prm.hi;
    for (int l = 0; l < DEPTH; ++l) {
#define IN(k) (lo <= l * NPH + (k) && l * NPH + (k) < hi && phase_begin(F, prm, wave0))
#define REP_BEGIN(k) for (int rep_ = 0; rep_ < ((DBG_REP == (k)) ? 2 : 1); ++rep_) {
#define REP_END(k) if (DBG_REP == (k) && rep_ == 0) { XcdBarrier bb_ = bar; bb_.bar = (unsigned*)launder64((unsigned long long)bar.bar); xcd_barrier(bb_); } }
#define SEAM(k) do { if (l * NPH + (k) + 1 < hi && prm.use_bar) { XcdBarrier bb_ = bar; bb_.bar = (unsigned*)launder64((unsigned long long)bar.bar); { unsigned x_ = __builtin_amdgcn_readfirstlane(bar.x); asm volatile("" : "+s"(x_)); bb_.x = x_; } xcd_barrier(bb_); } } while (0)
#define RSB(i) (WSP(unsigned long long, WS_CTL) + CW_RS / 2 + (size_t)(3 * l + (i)) * MTOK)
#define XB WSP(bf16, WS_XB)
#define ACT WSP(bf16, WS_ACT)
        if (IN(0)) { REP_BEGIN(0) phase_convert(F, l); REP_END(0) SEAM(0); }
        if (IN(1)) { REP_BEGIN(1) pg8::Gemm g{XB, WSP(bf16, WS_WUP1), MTOK, NUP, DM, DM, DM}; pg8::StaticOrder S; S.init(MTOK, NUP, F.G, F.bid);
            pg8::EpiSwiGLU E{ACT, RSB(0)}; pg8::gemm_phase<pg8::EpiSwiGLU, pg8::StaticOrder>(F.lds, F.tid, g, S, E); REP_END(1) SEAM(1); }
        if (IN(2)) { pg8::Gemm g{ACT, WSP(bf16, WS_WDN1), MTOK, DM, DFF, DFF, DFF}; pg8::StaticOrder S; S.init(MTOK, DM, F.G, F.bid);
            pg8::EpiResidual E{prm.out, XB, RSB(1), 0.5f}; pg8::gemm_phase<pg8::EpiResidual, pg8::StaticOrder>(F.lds, F.tid, g, S, E); SEAM(2); }
        if (IN(3)) { REP_BEGIN(3) pg8::Gemm g{XB, WSP(bf16, WS_WIN), MTOK, NINP, DM, DM, DM}; pg8::StaticOrder S; S.init(MTOK, NINP, F.G, F.bid);
            pg8::EpiWin E{WSP(bf16, WS_P1), WSP(float, WS_SMALL), WSP(bf16, WS_GATE), RSB(1)}; pg8::gemm_phase<pg8::EpiWin, pg8::StaticOrder>(F.lds, F.tid, g, S, E); REP_END(3) SEAM(3); }
        if (IN(4)) {
            REP_BEGIN(4)
            for (int j = F.bid; j < 32 + 1024 + 256 + 512; j += F.G) {
                job_begin(F);
                if (j < 32) nsa_compress_job(F, l, j);
                else if (j < 32 + 1024) gdn_prep_job(F, l, j - 32);
                else if (j < 32 + 1024 + 256) ssd_prep_job(F, l, j - 32 - 1024);
                else nsa_prep_job(F, l, j - 32 - 1024 - 256);
            }
            REP_END(4)
            if (DBG_REP >= 41 && DBG_REP <= 44) { { XcdBarrier bb_ = bar; bb_.bar = (unsigned*)launder64((unsigned long long)bar.bar); xcd_barrier(bb_); }
                for (int j = F.bid; j < 32 + 1024 + 256 + 512; j += F.G) {
                    if (j < 32) { if (DBG_REP == 44) nsa_compress_job(F, l, j); }
                    else if (j < 32 + 1024) { if (DBG_REP == 41) gdn_prep_job(F, l, j - 32); }
                    else if (j < 32 + 1024 + 256) { if (DBG_REP == 42) ssd_prep_job(F, l, j - 32 - 1024); }
                    else { if (DBG_REP == 43) nsa_prep_job(F, l, j - 32 - 1024 - 256); } } }
            SEAM(4);
        }
        if (IN(5)) {
            REP_BEGIN(5)
            if (F.bid < 64) gdn_scan_job(F, (F.bid & 7) * 8 + (F.bid >> 3));
            else if (rep_ == 0) ssd_scan_part(F, F.bid - 64, F.G - 64);
            {
                unsigned* ctr = WSP(unsigned, WS_CTL) + CW_WQ + 64 * (l * 2 + rep_);
                LAS unsigned* jslot = (LAS unsigned*)(F.lds + MISC_OFF + 128);
                for (;;) {
                    __syncthreads();
                    if (F.tid == 0) *jslot = __hip_atomic_fetch_add(ctr, 1u, __ATOMIC_RELAXED, __HIP_MEMORY_SCOPE_AGENT);
                    __syncthreads();
                    const unsigned j = *jslot;
                    if (j >= 512u) break;
                    job_begin(F);
                    nsa_job(F, (int)((j & 3u) * 128u + (127u - (j >> 2))));
                }
            }
            REP_END(5)
            SEAM(5);
        }
        if (IN(7)) {
            REP_BEGIN(7)
            for (int j = F.bid; j < 256; j += F.G) { job_begin(F); ssd_out_job(F, l, j); }
            job_begin(F);
            gdn_final_rows(F, l, F.bid * 8 + F.wave, F.G * 8);
            REP_END(7)
            SEAM(7);
        }
        if (IN(8)) { REP_BEGIN(8) pg8::Gemm g{WSP(bf16, WS_YCAT), WSP(bf16, WS_WPM), MTOK, DM, 512, DM, DM}; pg8::SegOrder S; S.init(MTOK, DM, F.G, F.bid, 512);
            pg8::EpiMergeSeg E{WSP(bf16, WS_MERGED), WSP(bf16, WS_GATE), WSP(float, WS_SRC)}; pg8::gemm_phase<pg8::EpiMergeSeg, pg8::SegOrder>(F.lds, F.tid, g, S, E); REP_END(8) SEAM(8); }
        if (IN(9)) { pg8::Gemm g{WSP(bf16, WS_MERGED), WSP(bf16, WS_WO), MTOK, DM, DM, DM, DM}; pg8::StaticOrder S; S.init(MTOK, DM, F.G, F.bid);
            pg8::EpiResidual E{prm.out, XB, RSB(2), 1.0f}; pg8::gemm_phase<pg8::EpiResidual, pg8::StaticOrder>(F.lds, F.tid, g, S, E); SEAM(9); }
        if (IN(10)) { pg8::Gemm g{XB, WSP(bf16, WS_WUP2), MTOK, NUP, DM, DM, DM}; pg8::StaticOrder S; S.init(MTOK, NUP, F.G, F.bid);
            pg8::EpiSwiGLU E{ACT, RSB(2)}; pg8::gemm_phase<pg8::EpiSwiGLU, pg8::StaticOrder>(F.lds, F.tid, g, S, E); SEAM(10); }
        if (IN(11)) { pg8::Gemm g{ACT, WSP(bf16, WS_WDN2), MTOK, DM, DFF, DFF, DFF}; pg8::StaticOrder S; S.init(MTOK, DM, F.G, F.bid);
            pg8::EpiResidual E{prm.out, XB, RSB(3), 0.5f}; pg8::gemm_phase<pg8::EpiResidual, pg8::StaticOrder>(F.lds, F.tid, g, S, E); SEAM(11); }
#undef IN
#undef SEAM
#undef REP_BEGIN
#undef REP_END
#undef RSB
#undef XB
#undef ACT
    }
}

#ifndef DBG_DUMP
#define DBG_DUMP 0
#endif
#ifndef DBG_STOP
#define DBG_STOP 48
#endif
__global__ void dbg_dump_bf16(const unsigned short* src, size_t n, float* out, size_t nout) {
    for (size_t i = (size_t)blockIdx.x * blockDim.x + threadIdx.x; i < nout; i += (size_t)gridDim.x * blockDim.x) { float s = 0.f; for (size_t k = i; k < n; k += nout) s += __builtin_bit_cast(float, (unsigned)src[k] << 16); out[i] = s; }
}
__global__ void dbg_dump_f32(const float* src, size_t n, float* out, size_t nout) {
    for (size_t i = (size_t)blockIdx.x * blockDim.x + threadIdx.x; i < nout; i += (size_t)gridDim.x * blockDim.x) { float s = 0.f; for (size_t k = i; k < n; k += nout) s += src[k]; out[i] = s; }
}
#ifndef N_LAUNCH_MODE
#define N_LAUNCH_MODE 0
#endif
extern "C" void kernel_launch(void* const* d_in, const int* in_sizes, int n_in, void* d_out, int out_size, void* d_ws, size_t ws_size, hipStream_t stream) {
    static int grid = 0;
    if (grid == 0) {
        if (n_in != 30 || out_size != MTOK * DM || ws_size < WS_END) { fprintf(stderr, "kernel_launch: unexpected shapes (n_in %d out %d ws %zu, need %zu)\n", n_in, out_size, ws_size, (size_t)WS_END); grid = -1; return; }
        int dev = 0, cus = 0, per_cu = 0;
        if (hipGetDevice(&dev) != hipSuccess || hipDeviceGetAttribute(&cus, hipDeviceAttributeMultiprocessorCount, dev) != hipSuccess) { grid = -1; return; }
        if (hipFuncSetAttribute((const void*)hybrid_fwd, hipFuncAttributeMaxDynamicSharedMemorySize, LDS_BYTES) != hipSuccess) { fprintf(stderr, "kernel_launch: hipFuncSetAttribute failed\n"); grid = -1; return; }
        if (hipOccupancyMaxActiveBlocksPerMultiprocessor(&per_cu, (const void*)hybrid_fwd, 512, LDS_BYTES) != hipSuccess || per_cu < 1) { fprintf(stderr, "kernel_launch: occupancy query says %d\n", per_cu); }
        (void)hipGetLastError();
        grid = cus;
    }
    if (grid < 0) return;
    (void)hipMemsetAsync((char*)d_ws + WS_CTL, 0, CTL_BYTES, stream);
    Params p{};
    for (int i = 0; i < 30; ++i) p.in[i] = (const float*)d_in[i];
    p.out = (float*)d_out; p.ws = (unsigned char*)d_ws; p.pad = 0;
    if (N_LAUNCH_MODE == 0) { p.lo = 0; p.hi = DEPTH * NPH; p.use_bar = 1; hipLaunchKernelGGL(hybrid_fwd, dim3(grid), dim3(512), LDS_BYTES, stream, p); }
    else { for (int ph = 0; ph < (DBG_DUMP ? DBG_STOP : DEPTH * NPH); ++ph) { p.lo = ph; p.hi = ph + 1; p.use_bar = 0; hipLaunchKernelGGL(hybrid_fwd, dim3(grid), dim3(512), LDS_BYTES, stream, p); } }
    if (DBG_DUMP) {
        const size_t nout = (size_t)MTOK * DM; char* w = (char*)d_ws;
        if (DBG_DUMP == 1) hipLaunchKernelGGL(dbg_dump_bf16, dim3(2048), dim3(256), 0, stream, (const unsigned short*)(w + WS_P1), (size_t)MTOK * P1W, (float*)d_out, nout);
        if (DBG_DUMP == 2) hipLaunchKernelGGL(dbg_dump_f32, dim3(2048), dim3(256), 0, stream, (const float*)(w + WS_SMALL), (size_t)MTOK * SMW, (float*)d_out, nout);
        if (DBG_DUMP == 3) hipLaunchKernelGGL(dbg_dump_bf16, dim3(2048), dim3(256), 0, stream, (const unsigned short*)(w + WS_GW), (size_t)1024 * GDN_CH_BYTES / 2, (float*)d_out, nout);
        if (DBG_DUMP == 4) hipLaunchKernelGGL(dbg_dump_f32, dim3(2048), dim3(256), 0, stream, (const float*)(w + WS_SST), (size_t)2 * 64 * 16 * 64 * 128, (float*)d_out, nout);
        if (DBG_DUMP == 5) hipLaunchKernelGGL(dbg_dump_f32, dim3(2048), dim3(256), 0, stream, (const float*)(w + WS_GO), (size_t)MTOK * 512, (float*)d_out, nout);
        if (DBG_DUMP == 6) hipLaunchKernelGGL(dbg_dump_bf16, dim3(2048), dim3(256), 0, stream, (const unsigned short*)(w + WS_YCAT), (size_t)MTOK * 2048, (float*)d_out, nout);
        if (DBG_DUMP == 7) hipLaunchKernelGGL(dbg_dump_bf16, dim3(2048), dim3(256), 0, stream, (const unsigned short*)(w + WS_MERGED), (size_t)MTOK * 2048, (float*)d_out, nout);
        if (DBG_DUMP == 8) hipLaunchKernelGGL(dbg_dump_bf16, dim3(2048), dim3(256), 0, stream, (const unsigned short*)(w + WS_SX), (size_t)MTOK * 1536, (float*)d_out, nout);
        if (DBG_DUMP == 9) hipLaunchKernelGGL(dbg_dump_bf16, dim3(2048), dim3(256), 0, stream, (const unsigned short*)(w + WS_GATE), (size_t)MTOK * 6144, (float*)d_out, nout);
        if (DBG_DUMP == 11) hipLaunchKernelGGL(dbg_dump_f32, dim3(2048), dim3(256), 0, stream, (const float*)(w + WS_SRC), (size_t)MTOK * 2, (float*)d_out, nout);
        if (DBG_DUMP == 12) hipLaunchKernelGGL(dbg_dump_bf16, dim3(2048), dim3(256), 0, stream, (const unsigned short*)(w + WS_WPM), (size_t)DM * DM, (float*)d_out, nout);
        if (DBG_DUMP == 13) hipLaunchKernelGGL(dbg_dump_f32, dim3(2048), dim3(256), 0, stream, (const float*)(w + WS_MTMP), (size_t)MTOK * DM, (float*)d_out, nout);
        if (DBG_DUMP == 15) hipLaunchKernelGGL(dbg_dump_bf16, dim3(2048), dim3(256), 0, stream, (const unsigned short*)(w + WS_ACT), (size_t)MTOK * DFF, (float*)d_out, nout);
        if (DBG_DUMP == 16) hipLaunchKernelGGL(dbg_dump_bf16, dim3(2048), dim3(256), 0, stream, (const unsigned short*)(w + WS_XB), (size_t)MTOK * DM, (float*)d_out, nout);
        if (DBG_DUMP == 17) hipLaunchKernelGGL(dbg_dump_bf16, dim3(2048), dim3(256), 0, stream, (const unsigned short*)(w + WS_WIN), (size_t)NINP * DM, (float*)d_out, nout);
        if (DBG_DUMP == 18) hipLaunchKernelGGL(dbg_dump_f32, dim3(2048), dim3(256), 0, stream, (const float*)(w + WS_CTL) + CW_RS, (size_t)NRS * MTOK, (float*)d_out, nout);
        if (DBG_DUMP == 10) hipLaunchKernelGGL(dbg_dump_f32, dim3(2048), dim3(256), 0, stream, (const float*)(w + WS_YB), (size_t)MTOK * 512, (float*)d_out, nout);
    }
}
#endif
```

```cpp
#include <hip/hip_runtime.h>
#include <cstdio>
#include <cstdint>

#ifndef CPU_EMU
#define DEV __device__ __forceinline__
#define LAS __attribute__((address_space(3)))
#define VM_WAIT() asm volatile("s_waitcnt vmcnt(0)" ::: "memory")
#define LDS_WAIT() asm volatile("s_waitcnt lgkmcnt(0)" ::: "memory")
#define CFENCE() asm volatile("" ::: "memory")
#define WAVE_SYNC() do { asm volatile("" ::: "memory"); __builtin_amdgcn_wave_barrier(); asm volatile("" ::: "memory"); } while (0)
#endif

#define DBG_DUMP 0
#define DBG_NSA 0
#define DBG_REP (-1)
#define DBG_STOP 48
#ifndef DBG_ZERO
#define DBG_ZERO 0
#endif
typedef unsigned short bf16;
typedef short bf16x8 __attribute__((ext_vector_type(8)));
typedef float f32x4 __attribute__((ext_vector_type(4)));
typedef float f32x2 __attribute__((ext_vector_type(2)));
typedef unsigned u32x4 __attribute__((ext_vector_type(4)));
typedef unsigned u32x2 __attribute__((ext_vector_type(2)));

constexpr int BATCH = 2, SEQ = 8192, DM = 2048, DEPTH = 4, DFF = 5504, NUP = 2 * DFF;
constexpr int MTOK = BATCH * SEQ;
constexpr int NIN = 12836, NINP = 13056;
constexpr int P1W = 6656;
constexpr int SM0 = 6656;
constexpr int GT0 = 6912;
constexpr float EPS = 1e-6f;
constexpr int C_AQ = 0, C_AK = 512, C_AV = 1024, C_AZ = 1536, C_BQ = 2048, C_BKC = 2560, C_BVC = 2816, C_BKS = 3072, C_BVS = 3328, C_BKW = 3584, C_BVW = 3840, C_CZ = 4096, C_CX = 5120;
constexpr int S_AA = 0, S_AB = 4, S_BG = 8, S_DT = 20, SMW = 64;

constexpr size_t MiB = 1u << 20;
constexpr size_t WS_CTL = 0, CTL_BYTES = 2 * MiB;
constexpr size_t WS_WUP1 = 2 * MiB;
constexpr size_t WS_WDN1 = WS_WUP1 + (size_t)NUP * DM * 2;
constexpr size_t WS_WIN = WS_WDN1 + (size_t)DM * DFF * 2;
constexpr size_t WS_WPM = WS_WIN + (size_t)NINP * DM * 2;
constexpr size_t WS_WO = WS_WPM + (size_t)DM * DM * 2;
constexpr size_t WS_WUP2 = WS_WO + (size_t)DM * DM * 2;
constexpr size_t WS_WDN2 = WS_WUP2 + (size_t)NUP * DM * 2;
constexpr size_t WS_WCK = WS_WDN2 + (size_t)DM * DFF * 2;
constexpr size_t WS_WCV = WS_WCK + 128 * 4096 * 2;
constexpr size_t WS_CONST = WS_WCV + 128 * 4096 * 2;
constexpr size_t WS_WEND = WS_CONST + 4096;
static_assert(WS_WEND <= 212 * MiB, "weights region");
constexpr size_t WS_XB = 212 * MiB;
constexpr size_t WS_P1 = 276 * MiB;
constexpr size_t WS_ACT = WS_P1;
constexpr size_t WS_GATE = 484 * MiB;
constexpr size_t WS_SMALL = 676 * MiB;
constexpr size_t WS_MERGED = 680 * MiB;
constexpr size_t WS_YCAT = 744 * MiB;
constexpr size_t WS_GW = 808 * MiB;
constexpr size_t GDN_CH_BYTES = 73728;
constexpr size_t WS_GL = 880 * MiB;
constexpr size_t WS_GO = 881 * MiB;
constexpr size_t WS_SX = 913 * MiB;
constexpr size_t WS_SDT = 961 * MiB;
constexpr size_t WS_SAC = 962 * MiB;
constexpr size_t WS_SST = 963 * MiB;
constexpr size_t WS_SCD = 1027 * MiB;
constexpr size_t WS_SRC = 1028 * MiB;
constexpr size_t WS_QN = 1029 * MiB;
constexpr size_t WS_KS = 1045 * MiB;
constexpr size_t WS_KW = 1053 * MiB;
constexpr size_t WS_VST = 1061 * MiB;
constexpr size_t WS_VWT = 1069 * MiB;
constexpr size_t WS_KCMP = 1077 * MiB;
constexpr size_t WS_VCMPT = 1078 * MiB;
constexpr size_t WS_SELM = 1079 * MiB;
constexpr size_t WS_YB = 1080 * MiB;
constexpr size_t WS_MTMP = 1112 * MiB;
constexpr size_t WS_END = 1240 * MiB;
static_assert(WS_P1 + (size_t)MTOK * P1W * 2 <= WS_GATE && WS_GATE + (size_t)MTOK * 6144 * 2 <= WS_SMALL && WS_SMALL + (size_t)MTOK * SMW * 4 <= WS_MERGED && WS_MERGED + (size_t)MTOK * DM * 2 <= WS_YCAT && WS_YCAT + (size_t)MTOK * 2048 * 2 <= WS_GW, "ws map 1");
static_assert(WS_GW + 1024 * GDN_CH_BYTES <= WS_GL && WS_GO + (size_t)MTOK * 512 * 4 <= WS_SX && WS_SX + (size_t)MTOK * 1536 * 2 <= WS_SDT && WS_SDT + (size_t)MTOK * 16 * 4 <= WS_SAC && WS_SAC + (size_t)MTOK * 16 * 4 <= WS_SST && WS_SST + (size_t)2 * 64 * 16 * 64 * 128 * 4 <= WS_SCD, "ws map 2");
static_assert(WS_SRC + (size_t)MTOK * 2 * 4 <= WS_QN && WS_QN + (size_t)4 * SEQ * 256 * 2 <= WS_KS && WS_KS + (size_t)4 * SEQ * 128 * 2 <= WS_KW && WS_KW + (size_t)4 * SEQ * 128 * 2 <= WS_VST && WS_VST + (size_t)4 * SEQ * 128 * 2 <= WS_VWT && WS_VWT + (size_t)4 * SEQ * 128 * 2 <= WS_KCMP, "ws map 3");
static_assert(WS_KCMP + 4 * 512 * 128 * 2 <= WS_VCMPT && WS_VCMPT + 4 * 512 * 128 * 2 <= WS_SELM && WS_SELM + (size_t)4 * SEQ * 16 <= WS_YB && WS_YB + (size_t)MTOK * 512 * 4 <= WS_END && WS_XB + (size_t)MTOK * DM * 2 <= WS_P1 && (size_t)MTOK * DFF * 2 <= (size_t)MTOK * P1W * 2, "ws map 4");

constexpr int CW_BAR = 1024;
constexpr int CW_RS = 16384;
constexpr int NRS = 13;
constexpr int CW_WQ = 8192;
static_assert(CW_RS * 4 + NRS * MTOK * 8 <= (int)CTL_BYTES, "ctl");

constexpr int RING_BYTES = 131072;
constexpr int MISC_OFF = RING_BYTES + 12288;
constexpr int LDS_BYTES = 147456;

DEV unsigned f2bf(float f) { unsigned u = __builtin_bit_cast(unsigned, f); return (u + 0x7fffu + ((u >> 16) & 1u)) >> 16; }
DEV float bf2f(unsigned b) { return __builtin_bit_cast(float, (b & 0xffffu) << 16); }
DEV unsigned pk2(float lo, float hi) { return f2bf(lo) | (f2bf(hi) << 16); }
DEV float bflo(unsigned w) { return __builtin_bit_cast(float, w << 16); }
DEV float bfhi(unsigned w) { return __builtin_bit_cast(float, w & 0xffff0000u); }
DEV float sigmoidf_(float x) { return 1.0f / (1.0f + __expf(-x)); }
DEV float siluf_(float x) { return x / (1.0f + __expf(-x)); }
DEV float softplusf_(float x) {
    const float e = __expf(-fabsf(x)), u = 1.0f + e, d = u - 1.0f;
    const float lp = d == 0.f ? e : __logf(u) * (e / d);
    return fmaxf(x, 0.f) + lp;
}
#ifndef CPU_EMU
template <int M, class T> DEV T shx(T v) {
    static_assert(sizeof(T) == 4, "shx: 32-bit values");
    const int iv = __builtin_bit_cast(int, v);
    if constexpr (M < 32) return __builtin_bit_cast(T, __builtin_amdgcn_ds_swizzle(iv, 0x1f | (M << 10)));
    else { unsigned z = 0u; asm volatile("" : "+v"(z)); const unsigned ln = __builtin_amdgcn_mbcnt_hi(~0u, __builtin_amdgcn_mbcnt_lo(~0u, z));
        return __builtin_bit_cast(T, __builtin_amdgcn_ds_bpermute((int)((ln ^ 32u) << 2), iv)); }
}
#endif
DEV float wave_sum(float v) { v += shx<1>(v); v += shx<2>(v); v += shx<4>(v); v += shx<8>(v); v += shx<16>(v); v += shx<32>(v); return v; }
DEV float sum16(float v) { v += shx<1>(v); v += shx<2>(v); v += shx<4>(v); v += shx<8>(v); return v; }
DEV float max16(float v) { v = fmaxf(v, shx<1>(v)); v = fmaxf(v, shx<2>(v)); v = fmaxf(v, shx<4>(v)); v = fmaxf(v, shx<8>(v)); return v; }
#ifndef CPU_EMU
DEV float opaque_zero() { float z = 0.f; asm volatile("" : "+v"(z)); return z; }
#endif
#define ZERO4 ((f32x4){zf_, zf_, zf_, zf_})
DEV f32x4 mfma16(bf16x8 a, bf16x8 b, f32x4 c) { return __builtin_amdgcn_mfma_f32_16x16x32_bf16(a, b, c, 0, 0, 0); }
DEV bf16x8 frag_g(const bf16* base, int pitch, int row0, int k0, int lane) { return *(const bf16x8*)(base + (size_t)(row0 + (lane & 15)) * pitch + k0 + 8 * (lane >> 4)); }
DEV bf16x8 frag_l(const LAS bf16* base, int pitch, int row0, int k0, int lane) { return *(const LAS bf16x8*)(base + (row0 + (lane & 15)) * pitch + k0 + 8 * (lane >> 4)); }
#ifndef CPU_EMU
DEV const LAS void* lds_vbase(const LAS void* p) { unsigned a = (unsigned)(size_t)p; asm volatile("" : "+v"(a)); return (const LAS void*)(size_t)a; }
#endif

struct Params {
    const float* in[30];
    float* out;
    unsigned char* ws;
    int lo, hi;
    int use_bar, pad;
};
enum { I_X = 0, I_REL, I_GF1, I_WUP1, I_WDN1, I_GMIX, I_WIN, I_GCONV, I_GALOG, I_GDTB, I_GNORM, I_NQN, I_NKN, I_NPEK, I_NPEV, I_NWCK, I_NWCV,
       I_SCW, I_SCB, I_SDTB, I_SALOG, I_SD, I_SNORM, I_PA, I_PB, I_PC, I_WO, I_GF2, I_WUP2, I_WDN2 };

#define XB_TMO      128
#define XB_XCNT(j)  (256  + 64 * (j))
#define XB_XSUB(j)  (1280 + 64 * (j))
#define XB_XGEN(j)  (2304 + 64 * (j))
#define XB_TOP      3328
#define XB_TOPGEN   3392
#define XCD_BAR_WORDS 3456
#define XB_SPIN_CAP (1u << 22)
#ifndef CPU_EMU
DEV unsigned xb_ld(unsigned* p)              { return __hip_atomic_load(p, __ATOMIC_RELAXED, __HIP_MEMORY_SCOPE_AGENT); }
DEV unsigned xb_add(unsigned* p, unsigned v) { return __hip_atomic_fetch_add(p, v, __ATOMIC_RELAXED, __HIP_MEMORY_SCOPE_AGENT); }
DEV unsigned xb_xcc_id() { return (unsigned)__builtin_amdgcn_s_getreg((3 << 11) | 20) & 0xFu; }
#define XB_SPIN(cond, bar) do { unsigned _sp = 0; while (cond) { __builtin_amdgcn_s_sleep(1); \
    if ((++_sp & 255u) == 0u) { if (xb_ld(&(bar)[XB_TMO])) break; if (_sp > XB_SPIN_CAP) { atomicAdd(&(bar)[XB_TMO], 1u); break; } } } } while (0)
struct XcdBarrier { unsigned* bar; unsigned x; volatile LAS unsigned* st; };
DEV XcdBarrier xcd_barrier_post(unsigned* bar, volatile LAS unsigned* st) {
    XcdBarrier b; b.bar = bar; b.x = xb_xcc_id(); b.st = st;
    if (threadIdx.x == 0) (void)xb_add(&bar[XB_XCNT(b.x)], 1u);
    return b;
}
DEV void xcd_barrier_complete(unsigned* bar, unsigned x, unsigned& nloc, unsigned& nx) {
    const unsigned G = gridDim.x * gridDim.y * gridDim.z;
    unsigned sum, cnt, mine, sp = 0u;
    for (;;) {
        sum = 0u; cnt = 0u; mine = 0u;
#pragma unroll
        for (unsigned j = 0; j < 16; ++j) { const unsigned c = xb_ld(&bar[XB_XCNT(j)]); sum += c; cnt += (c > 0u) ? 1u : 0u; mine = (j == x) ? c : mine; }
        if (sum == G) break;
        __builtin_amdgcn_s_sleep(1);
        if ((++sp & 255u) == 0u) { if (xb_ld(&bar[XB_TMO])) break; if (sp > XB_SPIN_CAP) { atomicAdd(&bar[XB_TMO], 1u); break; } }
    }
    nloc = mine > 0u ? mine : 1u; nx = cnt > 0u ? cnt : 1u;
}
DEV void xcd_barrier(const XcdBarrier& b) {
    asm volatile("s_waitcnt vmcnt(0)" ::: "memory");
    __syncthreads();
    if (threadIdx.x == 0) {
        unsigned* bar = b.bar;
        __builtin_amdgcn_s_waitcnt(0);
        unsigned nloc = b.st[0], nx = b.st[1];
        if (nloc == 0u) { xcd_barrier_complete(bar, b.x, nloc, nx); b.st[0] = nloc; b.st[1] = nx; }
        const unsigned old = xb_add(&bar[XB_XSUB(b.x)], 1u);
        const unsigned gen = old / nloc;
        if (old + 1u == (gen + 1u) * nloc) {
            __builtin_amdgcn_fence(__ATOMIC_RELEASE, "agent");
            asm volatile("s_waitcnt vmcnt(0)" ::: "memory");
            const unsigned og = xb_add(&bar[XB_TOP], 1u);
            const unsigned tg = og / nx;
            if (og + 1u == (tg + 1u) * nx) xb_add(&bar[XB_TOPGEN], 1u);
            else XB_SPIN(xb_ld(&bar[XB_TOPGEN]) == tg, bar);
            __builtin_amdgcn_fence(__ATOMIC_ACQUIRE, "agent");
            xb_add(&bar[XB_XGEN(b.x)], 1u);
            asm volatile("s_waitcnt vmcnt(0)" ::: "memory");
        } else {
            XB_SPIN(xb_ld(&bar[XB_XGEN(b.x)]) == gen, bar);
            __builtin_amdgcn_fence(__ATOMIC_ACQUIRE, "agent");
            asm volatile("s_waitcnt vmcnt(0)" ::: "memory");
        }
    }
    __syncthreads();
}
#endif

namespace pg8 {
constexpr int BM = 256, BK = 64, HALF = 128, HTB = HALF * BK * 2, STAGE_BYTES = 8 * HTB, NXCD = 8, WGM = 8;
__host__ __device__ __forceinline__ int lds_byte(int r, int c) { const int st = (r >> 4) * 2 + (c >> 5), rr = r & 15, cc = c & 31, ob = rr * 64 + cc * 2; return st * 1024 + (ob ^ (((ob >> 9) & 1) << 5)); }
__host__ __device__ __forceinline__ void stage_rc(int b, int& R, int& C) { const int st = b / 1024, sb = b % 1024, swz = sb ^ (((sb >> 9) & 1) << 5); R = (st >> 1) * 16 + swz / 64; C = (st & 1) * 32 + (swz % 64) / 2; }
__host__ __device__ __forceinline__ int perm32(int rho) { const int n = rho >> 4, i = rho & 15; return 8 * (i >> 2) + 4 * n + (i & 3); }
struct Unit { int pm, pn, koff, seg; };
struct Gemm { const bf16* A; const bf16* Bt; int M, N, K, lda, ldb; };
struct StaticOrder {
    int nM, nN, nwg, G, c;
    __host__ __device__ void init(int M, int N, int G_, int c_) { nM = M / BM; nN = N / BM; nwg = nM * nN; G = G_; c = c_; }
    __host__ __device__ bool next(int i, Unit& u) const {
        const long L = (long)i * G + c; if (L >= nwg) return false;
        int wgid = (int)L; { const int q = nwg / NXCD, r = nwg % NXCD, xcd = wgid % NXCD, off = wgid / NXCD; wgid = (xcd < r ? xcd * (q + 1) : r * (q + 1) + (xcd - r) * q) + off; }
        const int nig = WGM * nN, gid = wgid / nig, fm = gid * WGM, gsz = (nM - fm) < WGM ? (nM - fm) : WGM;
        u.pm = fm + ((wgid % nig) % gsz); u.pn = (wgid % nig) / gsz; u.koff = 0; u.seg = 0; return true;
    }
};
struct SegOrder {
    StaticOrder S; int kseg;
    __host__ __device__ void init(int M, int N, int G_, int c_, int kseg_) { S.init(M, N, G_, c_); kseg = kseg_; }
    __host__ __device__ bool next(int i, Unit& u) const { if (!S.next(i >> 2, u)) return false; u.seg = i & 3; u.koff = u.seg * kseg; return true; }
};
#ifndef CPU_EMU
DEV unsigned cvt_pk_bf16(float lo, float hi) { unsigned r; asm volatile("s_nop 1\n\tv_cvt_pk_bf16_f32 %0, %1, %2" : "=v"(r) : "v"(lo), "v"(hi)); return r; }
#endif
DEV unsigned long long rss_fix(float ss) { return (unsigned long long)(ss * 16777216.0f + 0.5f); }
DEV float rss_val(unsigned long long v) { return (float)v * (1.0f / 16777216.0f); }

struct EpiSwiGLU {
    static constexpr bool PERM = true, SEGACC = false;
    bf16* act; const unsigned long long* rss;
    DEV void operator()(const f32x4 (&acc)[2][2][4][2], const Unit& u, int wr, int wc, int fr, int fq) const {
        const int row0 = u.pm * BM + wr * 64 + fr, col0 = u.pn * HALF + wc * 32 + 8 * fq;
        unsigned long long rv[8];
#pragma unroll
        for (int i = 0; i < 8; ++i) rv[i] = rss[row0 + (i >> 2) * HALF + (i & 3) * 16];
        CFENCE();
#pragma unroll
        for (int ai = 0; ai < 2; ++ai)
#pragma unroll
            for (int m = 0; m < 4; ++m) {
                const int row = row0 + ai * HALF + m * 16;
                const float rs = rsqrtf(rss_val(rv[ai * 4 + m]) * (1.0f / DM) + EPS);
                float o[8];
#pragma unroll
                for (int n = 0; n < 2; ++n)
#pragma unroll
                    for (int j = 0; j < 4; ++j) { const float a = acc[ai][0][m][n][j] * rs, b = acc[ai][1][m][n][j] * rs; o[4 * n + j] = a * b * __builtin_amdgcn_rcpf(1.0f + __expf(-a)); }
                u32x4 w; w.x = cvt_pk_bf16(o[0], o[1]); w.y = cvt_pk_bf16(o[2], o[3]); w.z = cvt_pk_bf16(o[4], o[5]); w.w = cvt_pk_bf16(o[6], o[7]);
                *(u32x4*)(act + (size_t)row * DFF + col0) = w;
            }
    }
};
struct EpiResidual {
    static constexpr bool PERM = true, SEGACC = false;
    float* x; bf16* xb; unsigned long long* rss_out; float alpha;
    DEV void operator()(const f32x4 (&acc)[2][2][4][2], const Unit& u, int wr, int wc, int fr, int fq) const {
        const int row0 = u.pm * BM + wr * 64 + fr, col0 = u.pn * BM + wc * 32 + 8 * fq;
#pragma unroll
        for (int ai = 0; ai < 2; ++ai) {
            f32x4 xv[4][2][2];
#pragma unroll
            for (int m = 0; m < 4; ++m)
#pragma unroll
                for (int bj = 0; bj < 2; ++bj) { const float* xp = x + (size_t)(row0 + ai * HALF + m * 16) * DM + col0 + bj * HALF; xv[m][bj][0] = *(const f32x4*)xp; xv[m][bj][1] = *(const f32x4*)(xp + 4); }
            CFENCE();
#pragma unroll
            for (int m = 0; m < 4; ++m) {
                const int row = row0 + ai * HALF + m * 16; float ss = 0.f;
#pragma unroll
                for (int bj = 0; bj < 2; ++bj) {
                    float* xp = x + (size_t)row * DM + col0 + bj * HALF;
                    const f32x4 x0 = xv[m][bj][0] + acc[ai][bj][m][0] * alpha, x1 = xv[m][bj][1] + acc[ai][bj][m][1] * alpha;
                    *(f32x4*)xp = x0; *(f32x4*)(xp + 4) = x1;
                    ss += (x0[0] * x0[0] + x0[1] * x0[1]) + (x0[2] * x0[2] + x0[3] * x0[3]) + (x1[0] * x1[0] + x1[1] * x1[1]) + (x1[2] * x1[2] + x1[3] * x1[3]);
                    u32x4 w; w.x = cvt_pk_bf16(x0[0], x0[1]); w.y = cvt_pk_bf16(x0[2], x0[3]); w.z = cvt_pk_bf16(x1[0], x1[1]); w.w = cvt_pk_bf16(x1[2], x1[3]);
                    *(u32x4*)(xb + (size_t)row * DM + col0 + bj * HALF) = w;
                }
                ss += shx<16>(ss); ss += shx<32>(ss);
                if (fq == 0) atomicAdd(rss_out + row, rss_fix(ss));
            }
            CFENCE();
        }
    }
};
struct EpiWin {
    static constexpr bool PERM = true, SEGACC = false;
    bf16* p1; float* small; bf16* gate; const unsigned long long* rss;
    DEV void operator()(const f32x4 (&acc)[2][2][4][2], const Unit& u, int wr, int wc, int fr, int fq) const {
        const int row0 = u.pm * BM + wr * 64 + fr, cl0 = wc * 32 + 8 * fq;
        unsigned long long rv[8];
#pragma unroll
        for (int i = 0; i < 8; ++i) rv[i] = rss[row0 + (i >> 2) * HALF + (i & 3) * 16];
        CFENCE();
#pragma unroll
        for (int ai = 0; ai < 2; ++ai)
#pragma unroll
            for (int m = 0; m < 4; ++m) {
                const int row = row0 + ai * HALF + m * 16;
                const float rs = rsqrtf(rss_val(rv[ai * 4 + m]) * (1.0f / DM) + EPS);
#pragma unroll
                for (int bj = 0; bj < 2; ++bj) {
                    f32x4 v0 = acc[ai][bj][m][0] * rs, v1 = acc[ai][bj][m][1] * rs;
                    const int cl = cl0 + bj * HALF;
                    if (u.pn < 26) {
                        u32x4 w; w.x = cvt_pk_bf16(v0[0], v0[1]); w.y = cvt_pk_bf16(v0[2], v0[3]); w.z = cvt_pk_bf16(v1[0], v1[1]); w.w = cvt_pk_bf16(v1[2], v1[3]);
                        *(u32x4*)(p1 + (size_t)row * P1W + u.pn * BM + cl) = w;
                    } else if (u.pn == 26) {
                        if (cl < SMW) { float* sp = small + (size_t)row * SMW + cl; *(f32x4*)sp = v0; *(f32x4*)(sp + 4) = v1; }
                    } else {
#pragma unroll
                        for (int j = 0; j < 4; ++j) { v0[j] = fminf(__builtin_amdgcn_rcpf(1.0f + __expf(-v0[j])), 1.0f); v1[j] = fminf(__builtin_amdgcn_rcpf(1.0f + __expf(-v1[j])), 1.0f); }
                        u32x4 w; w.x = cvt_pk_bf16(v0[0], v0[1]); w.y = cvt_pk_bf16(v0[2], v0[3]); w.z = cvt_pk_bf16(v1[0], v1[1]); w.w = cvt_pk_bf16(v1[2], v1[3]);
                        *(u32x4*)(gate + (size_t)row * 6144 + (u.pn - 27) * BM + cl) = w;
                    }
                }
            }
    }
};
struct EpiMergeSeg {
    static constexpr bool PERM = true, SEGACC = true;
    bf16* merged; const bf16* gate; const float* rc;
    DEV void seg(f32x4 (&acc)[2][2][4][2], const Unit& u, int wr, int wc, int fr, int fq) const {
        const int row0 = u.pm * BM + wr * 64 + fr, col0 = u.pn * BM + wc * 32 + 8 * fq, sg = u.seg;
        f32x2 rcv[8];
#pragma unroll
        for (int i = 0; i < 8; ++i) rcv[i] = *(const f32x2*)(rc + (size_t)(row0 + (i >> 2) * HALF + (i & 3) * 16) * 2);
        const int offa = sg == 0 ? 0 : (sg == 1 ? DM : 2 * DM), offb = sg == 0 ? DM : 2 * DM;
#pragma unroll
        for (int aim = 0; aim < 4; ++aim) {
            const int ai = aim >> 1, m0 = (aim & 1) * 2;
            u32x4 wa[2][2], wb[2][2];
            if (sg != 2) {
#pragma unroll
                for (int mm = 0; mm < 2; ++mm)
#pragma unroll
                    for (int bj = 0; bj < 2; ++bj) { const bf16* gp = gate + (size_t)(row0 + ai * HALF + (m0 + mm) * 16) * 6144 + col0 + bj * HALF; wa[mm][bj] = *(const u32x4*)(gp + offa); wb[mm][bj] = *(const u32x4*)(gp + offb); }
            }
            CFENCE();
#pragma unroll
            for (int mm = 0; mm < 2; ++mm) {
                const int m = m0 + mm, row = row0 + ai * HALF + m * 16;
                const float r0 = rcv[ai * 4 + m][0], r1 = rcv[ai * 4 + m][1];
#pragma unroll
                for (int bj = 0; bj < 2; ++bj) {
                    float f[8];
                    if (sg == 2) { const float q = fmaxf(r0, 1e-20f) / fmaxf(r1, 1e-20f);
#pragma unroll
                        for (int j = 0; j < 8; ++j) f[j] = q; }
                    else {
                        const u32x4 a4 = wa[mm][bj], b4 = wb[mm][bj];
                        const float na[8] = {bflo(a4.x), bfhi(a4.x), bflo(a4.y), bfhi(a4.y), bflo(a4.z), bfhi(a4.z), bflo(a4.w), bfhi(a4.w)};
                        const float nb[8] = {bflo(b4.x), bfhi(b4.x), bflo(b4.y), bfhi(b4.y), bflo(b4.z), bfhi(b4.z), bflo(b4.w), bfhi(b4.w)};
#pragma unroll
                        for (int j = 0; j < 8; ++j) {
                            if (sg == 0) f[j] = fmaxf(na[j], 1e-20f) * __builtin_amdgcn_rcpf(fmaxf(nb[j], 1e-20f));
                            else if (sg == 1) f[j] = fmaxf(na[j], 1e-20f) * __builtin_amdgcn_rcpf(fmaxf(nb[j] * r0, 1e-20f));
                            else f[j] = fmaxf(na[j] * r1, 1e-20f); }
                    }
                    f32x4 v0 = acc[ai][bj][m][0], v1 = acc[ai][bj][m][1];
#pragma unroll
                    for (int j = 0; j < 4; ++j) { v0[j] *= f[j]; v1[j] *= f[4 + j]; }
                    if (sg < 3) { acc[ai][bj][m][0] = v0; acc[ai][bj][m][1] = v1; }
                    else { u32x4 o; o.x = cvt_pk_bf16(v0[0], v0[1]); o.y = cvt_pk_bf16(v0[2], v0[3]); o.z = cvt_pk_bf16(v1[0], v1[1]); o.w = cvt_pk_bf16(v1[2], v1[3]);
                        *(u32x4*)(merged + (size_t)row * DM + col0 + bj * HALF) = o; }
                }
            }
            CFENCE();
        }
    }
};

#ifndef CPU_EMU
template <class Epi, class Sched>
DEV void gemm_phase(LAS unsigned char* lds, const int tid, const Gemm g, const Sched& S, const Epi& E) {
    const int wid = __builtin_amdgcn_readfirstlane(tid >> 6), lane = tid & 63, wr = wid >> 2, wc = wid & 3, fr = lane & 15, fq = lane >> 4;
    const int K = g.K, nt = K / BK;
    const float zf_ = opaque_zero();
    unsigned voffA[2], voffB[2];
#pragma unroll
    for (int i = 0; i < 2; ++i) { int R, C; stage_rc(tid * 16 + i * 8192, R, C); const int Rb = Epi::PERM ? ((R & ~31) + perm32(R & 31)) : R;
        voffA[i] = (unsigned)(R * g.lda + C) * 2u; voffB[i] = (unsigned)(Rb * g.ldb + C) * 2u; }
    const size_t kstep = (size_t)(BK * 2);
    const size_t hA = (size_t)HALF * g.lda * 2, hB = (size_t)HALF * g.ldb * 2;
    const size_t tA = 2 * hA, tB = 2 * hB;
    const unsigned ldsw = (unsigned)wid * 1024u;
    const int aoff = lds_byte(wr * 64 + fr, fq * 8), boff = lds_byte(wc * 32 + fr, fq * 8);
#define PG8_SA(b, h) (((b) * 2 + (h)) * HTB)
#define PG8_SB(b, h) ((4 + (b) * 2 + (h)) * HTB)
#define PG8_STAGE(bufoff, gbase, voff) do { _Pragma("unroll") for (int _i = 0; _i < 2; ++_i) \
        __builtin_amdgcn_global_load_lds((const unsigned*)((const char*)(gbase) + (voff)[_i]), (LAS unsigned*)(lds + (bufoff) + ldsw + _i * 8192), 16, 0, 0); } while (0)
#define PG8_LDA(dst, b, h) do { _Pragma("unroll") for (int m = 0; m < 4; ++m) _Pragma("unroll") for (int k = 0; k < 2; ++k) dst[m][k] = *(const LAS bf16x8*)(lds + PG8_SA(b, h) + aoff + m * 2048 + k * 1024); } while (0)
#define PG8_LDB(dst, b, h) do { _Pragma("unroll") for (int n = 0; n < 2; ++n) _Pragma("unroll") for (int k = 0; k < 2; ++k) dst[n][k] = *(const LAS bf16x8*)(lds + PG8_SB(b, h) + boff + n * 2048 + k * 1024); } while (0)
#define PG8_MMA(ai, bj, At, Bt) do { __builtin_amdgcn_s_setprio(1); _Pragma("unroll") for (int m = 0; m < 4; ++m) _Pragma("unroll") for (int n = 0; n < 2; ++n) _Pragma("unroll") for (int k = 0; k < 2; ++k) \
        acc[ai][bj][m][n] = __builtin_amdgcn_mfma_f32_16x16x32_bf16(Bt[n][k], At[m][k], acc[ai][bj][m][n], 0, 0, 0); __builtin_amdgcn_s_setprio(0); } while (0)
#define PG8_WAIT_V(n) asm volatile("s_waitcnt vmcnt(" #n ")" ::: "memory")
#define PG8_WAIT_L(n) asm volatile("s_waitcnt lgkmcnt(" #n ")" ::: "memory")
#define PG8_BAR __builtin_amdgcn_s_barrier()
#define PG8_SCHED __builtin_amdgcn_sched_barrier(0)
    Unit cur, nxt; int ui = 0;
    if (!S.next(0, cur)) return;
    f32x4 acc[2][2][4][2];
#pragma unroll
    for (int a = 0; a < 2; ++a)
#pragma unroll
        for (int b = 0; b < 2; ++b)
#pragma unroll
            for (int m = 0; m < 4; ++m)
#pragma unroll
                for (int n = 0; n < 2; ++n) acc[a][b][m][n] = ZERO4;
    bf16x8 At[4][2], B0[2][2], B1[2][2];
    const char* cA = (const char*)g.A + (size_t)cur.pm * tA + (size_t)cur.koff * 2; const char* cB = (const char*)g.Bt + (size_t)cur.pn * tB + (size_t)cur.koff * 2;
    PG8_STAGE(PG8_SB(0, 0), cB, voffB); PG8_STAGE(PG8_SB(0, 1), cB + hB, voffB); PG8_STAGE(PG8_SA(0, 0), cA, voffA); PG8_STAGE(PG8_SA(0, 1), cA + hA, voffA);
    if (wr == 1) PG8_BAR;
    PG8_WAIT_V(2); PG8_BAR;
    PG8_STAGE(PG8_SB(1, 0), cB + kstep, voffB); PG8_STAGE(PG8_SA(1, 0), cA + kstep, voffA); PG8_STAGE(PG8_SB(1, 1), cB + hB + kstep, voffB);
    PG8_WAIT_V(6); PG8_BAR;
    for (;;) {
        const bool has_next = S.next(ui + 1, nxt);
        const char* nA = has_next ? (const char*)g.A + (size_t)nxt.pm * tA + (size_t)nxt.koff * 2 : cA; const char* nB = has_next ? (const char*)g.Bt + (size_t)nxt.pn * tB + (size_t)nxt.koff * 2 : cB;
        for (int t = 0; t < nt; t += 2) {
            const bool last = (t == nt - 2);
            const char* a1 = cA + (size_t)(t + 1) * kstep;
            const char* a2 = last ? nA : cA + (size_t)(t + 2) * kstep; const char* b2 = last ? nB : cB + (size_t)(t + 2) * kstep;
            const char* a3 = a2 + kstep; const char* b3 = b2 + kstep;
            PG8_LDB(B0, 0, 0); PG8_LDB(B1, 0, 1); PG8_SCHED; PG8_LDA(At, 0, 0); PG8_STAGE(PG8_SA(1, 1), a1 + hA, voffA);
            PG8_WAIT_V(8); PG8_WAIT_L(0); PG8_BAR; PG8_MMA(0, 0, At, B0); PG8_MMA(0, 1, At, B1); PG8_BAR; PG8_SCHED;
            PG8_LDA(At, 0, 1); PG8_STAGE(PG8_SB(0, 0), b2, voffB); PG8_STAGE(PG8_SB(0, 1), b2 + hB, voffB); PG8_STAGE(PG8_SA(0, 0), a2, voffA);
            PG8_WAIT_V(8); PG8_WAIT_L(0); PG8_BAR; PG8_MMA(1, 0, At, B0); PG8_MMA(1, 1, At, B1); PG8_BAR; PG8_SCHED;
            PG8_LDB(B0, 1, 0); PG8_LDB(B1, 1, 1); PG8_SCHED; PG8_LDA(At, 1, 0); PG8_STAGE(PG8_SA(0, 1), a2 + hA, voffA);
            PG8_WAIT_V(8); PG8_WAIT_L(0); PG8_BAR; PG8_MMA(0, 0, At, B0); PG8_MMA(0, 1, At, B1); PG8_BAR; PG8_SCHED;
            PG8_LDA(At, 1, 1); PG8_STAGE(PG8_SB(1, 0), b3, voffB); PG8_STAGE(PG8_SB(1, 1), b3 + hB, voffB); PG8_STAGE(PG8_SA(1, 0), a3, voffA);
            PG8_WAIT_V(8); PG8_WAIT_L(0); PG8_BAR; PG8_MMA(1, 0, At, B0); PG8_MMA(1, 1, At, B1); PG8_BAR; PG8_SCHED;
        }
        if (wr == 0) PG8_BAR;
        if constexpr (Epi::SEGACC) E.seg(acc, cur, wr, wc, fr, fq); else E(acc, cur, wr, wc, fr, fq);
        if (!has_next) break;
        if (!(Epi::SEGACC && nxt.seg != 0)) {
#pragma unroll
        for (int a = 0; a < 2; ++a)
#pragma unroll
            for (int b = 0; b < 2; ++b)
#pragma unroll
                for (int m = 0; m < 4; ++m)
#pragma unroll
                    for (int n = 0; n < 2; ++n) acc[a][b][m][n] = ZERO4;
        }
        cur = nxt; cA = nA; cB = nB; ++ui;
        if (wr == 1) PG8_BAR;
    }
    PG8_WAIT_V(0);
    PG8_BAR;
#undef PG8_SA
#undef PG8_SB
#undef PG8_STAGE
#undef PG8_LDA
#undef PG8_LDB
#undef PG8_MMA
#undef PG8_WAIT_V
#undef PG8_WAIT_L
#undef PG8_BAR
#undef PG8_SCHED
}
#endif
}

#ifndef CPU_EMU
typedef const __attribute__((address_space(4))) Params* KParams;
#else
typedef const Params* KParams;
#endif
struct Frame {
    LAS unsigned char* lds;
    int tid, lane, wave, G, bid;
    KParams p;
    unsigned char* ws;
};
DEV const float* lin(const Frame& F, int idx, int layer, size_t per_layer) { return F.p->in[idx] + (size_t)layer * per_layer; }
#define WSP(T, off) ((T*)(F.ws + (off)))

DEV int up_dest(int n) { return n < DFF ? (n >> 7) * 256 + (n & 127) : ((n - DFF) >> 7) * 256 + 128 + ((n - DFF) & 127); }
DEV int win_dest(int n) {
    if (n < 2048) return n;
    if (n < 2052) return SM0 + S_AA + (n - 2048);
    if (n < 2056) return SM0 + S_AB + (n - 2052);
    if (n < 4104) return C_BQ + (n - 2056);
    if (n < 4116) return SM0 + S_BG + (n - 4104);
    if (n < 6676) return C_CZ + (n - 4116);
    if (n < 6692) return SM0 + S_DT + (n - 6676);
    return GT0 + (n - 6692);
}
struct XItem { const float* W; const float* ks; bf16* WT; int K, N, ldt, koff, mode, r; };
DEV void xitem_load(const XItem& it, int lane, float (&v)[32]) {
    const int nblk = (it.N + 31) / 32, kb = it.r / nblk, nb = it.r % nblk, k0 = 64 * kb, n0 = 32 * nb;
    const int nn = n0 + (lane & 31);
    const float* src = it.W + (size_t)(k0 + (lane >> 5)) * it.N + (nn < it.N ? nn : it.N - 1);
#pragma unroll
    for (int i = 0; i < 32; ++i) v[i] = src[(size_t)(2 * i) * it.N];
}
DEV void xitem_to_lds(LAS float* scr, int lane, const float (&v)[32]) {
#pragma unroll
    for (int i = 0; i < 32; ++i) scr[(2 * i + (lane >> 5)) * 33 + (lane & 31)] = v[i];
    LDS_WAIT(); CFENCE();
}
DEV void xitem_store(const XItem& it, LAS float* scr, int lane) {
    const int nblk = (it.N + 31) / 32, kb = it.r / nblk, nb = it.r % nblk, k0 = 64 * kb, n0 = 32 * nb;
    const int c = lane & 7;
    f32x4 ks0 = (f32x4){1.f, 1.f, 1.f, 1.f}, ks1 = ks0;
    if (it.ks) { ks0 = *(const f32x4*)(it.ks + k0 + 8 * c); ks1 = *(const f32x4*)(it.ks + k0 + 8 * c + 4); }
#pragma unroll
    for (int j = 0; j < 4; ++j) { const int n = (lane >> 3) + 8 * j; const LAS float* s = scr + (8 * c) * 33 + n;
        u32x4 o; o.x = pk2(s[0 * 33] * ks0[0], s[1 * 33] * ks0[1]); o.y = pk2(s[2 * 33] * ks0[2], s[3 * 33] * ks0[3]); o.z = pk2(s[4 * 33] * ks1[0], s[5 * 33] * ks1[1]); o.w = pk2(s[6 * 33] * ks1[2], s[7 * 33] * ks1[3]);
        const int ng = n0 + n;
        if (ng < it.N) { const int dr = it.mode == 0 ? ng : (it.mode == 1 ? up_dest(ng) : win_dest(ng)); *(u32x4*)(it.WT + (size_t)dr * it.ldt + it.koff + k0 + 8 * c) = o; } }
    LDS_WAIT(); CFENCE();
}
constexpr int XI_UP = (DM / 64) * (NUP / 32), XI_DN = (DFF / 64) * (DM / 32), XI_IN = (DM / 64) * ((NIN + 31) / 32), XI_P5 = (512 / 64) * (DM / 32), XI_P10 = (1024 / 64) * (DM / 32), XI_OO = (DM / 64) * (DM / 32), XI_CK = (4096 / 64) * (128 / 32);
constexpr int XI_TOTAL = 2 * XI_UP + 2 * XI_DN + XI_IN + 2 * XI_P5 + XI_P10 + XI_OO + 2 * XI_CK;
DEV XItem xitem_decode(Frame& F, int l, int idx) {
    XItem t; int r = idx; t.ks = nullptr; t.koff = 0; t.mode = 0;
    if (r < XI_UP) { t.W = lin(F, I_WUP1, l, (size_t)DM * NUP); t.K = DM; t.N = NUP; t.WT = WSP(bf16, WS_WUP1); t.ldt = DM; t.ks = lin(F, I_GF1, l, DM); t.mode = 1; }
    else if ((r -= XI_UP) < XI_UP) { t.W = lin(F, I_WUP2, l, (size_t)DM * NUP); t.K = DM; t.N = NUP; t.WT = WSP(bf16, WS_WUP2); t.ldt = DM; t.ks = lin(F, I_GF2, l, DM); t.mode = 1; }
    else if ((r -= XI_UP) < XI_DN) { t.W = lin(F, I_WDN1, l, (size_t)DFF * DM); t.K = DFF; t.N = DM; t.WT = WSP(bf16, WS_WDN1); t.ldt = DFF; }
    else if ((r -= XI_DN) < XI_DN) { t.W = lin(F, I_WDN2, l, (size_t)DFF * DM); t.K = DFF; t.N = DM; t.WT = WSP(bf16, WS_WDN2); t.ldt = DFF; }
    else if ((r -= XI_DN) < XI_IN) { t.W = lin(F, I_WIN, l, (size_t)DM * NIN); t.K = DM; t.N = NIN; t.WT = WSP(bf16, WS_WIN); t.ldt = DM; t.ks = lin(F, I_GMIX, l, DM); t.mode = 2; }
    else if ((r -= XI_IN) < XI_P5) { t.W = lin(F, I_PA, l, (size_t)512 * DM); t.K = 512; t.N = DM; t.WT = WSP(bf16, WS_WPM); t.ldt = DM; }
    else if ((r -= XI_P5) < XI_P5) { t.W = lin(F, I_PB, l, (size_t)512 * DM); t.K = 512; t.N = DM; t.WT = WSP(bf16, WS_WPM); t.ldt = DM; t.koff = 512; }
    else if ((r -= XI_P5) < XI_P10) { t.W = lin(F, I_PC, l, (size_t)1024 * DM); t.K = 1024; t.N = DM; t.WT = WSP(bf16, WS_WPM); t.ldt = DM; t.koff = 1024; t.ks = lin(F, I_SNORM, l, 1024); }
    else if ((r -= XI_P10) < XI_OO) { t.W = lin(F, I_WO, l, (size_t)DM * DM); t.K = DM; t.N = DM; t.WT = WSP(bf16, WS_WO); t.ldt = DM; }
    else if ((r -= XI_OO) < XI_CK) { t.W = lin(F, I_NWCK, l, (size_t)4096 * 128); t.K = 4096; t.N = 128; t.WT = WSP(bf16, WS_WCK); t.ldt = 4096; }
    else { r -= XI_CK; t.W = lin(F, I_NWCV, l, (size_t)4096 * 128); t.K = 4096; t.N = 128; t.WT = WSP(bf16, WS_WCV); t.ldt = 4096; }
    t.r = r; return t;
}
DEV void phase_convert(Frame& F, int l) {
    LAS float* scr = (LAS float*)(F.lds + F.wave * 16384);
    const int gw = F.bid * 8 + F.wave, NGW = F.G * 8;
    if (gw < XI_TOTAL) {
        float v[32]; XItem cur = xitem_decode(F, l, gw); xitem_load(cur, F.lane, v);
        for (int it = gw; it < XI_TOTAL; it += NGW) {
            xitem_to_lds(scr, F.lane, v);
            const bool has_next = it + NGW < XI_TOTAL; XItem nxt = cur;
            if (has_next) { nxt = xitem_decode(F, l, it + NGW); xitem_load(nxt, F.lane, v); }
            xitem_store(cur, scr, F.lane);
            cur = nxt;
        }
    }
    { bf16* w = WSP(bf16, WS_WIN) + (size_t)(SM0 + 36) * DM; const int n16 = (GT0 - SM0 - 36) * DM / 8;
      const unsigned zu = __builtin_bit_cast(unsigned, opaque_zero());
      for (int i = F.bid * 512 + F.tid; i < n16; i += F.G * 512) ((u32x4*)w)[i] = (u32x4){zu, zu, zu, zu}; }
    { const float* pek = lin(F, I_NPEK, l, 4096); const float* pev = lin(F, I_NPEV, l, 4096); float* cst = WSP(float, WS_CONST);
      for (int it = gw; it < 256; it += NGW) { const int e = it & 127; const float* pe = it < 128 ? pek : pev; const float* w = it < 128 ? lin(F, I_NWCK, l, (size_t)4096 * 128) : lin(F, I_NWCV, l, (size_t)4096 * 128); float s = 0.f;
          for (int k = F.lane; k < 4096; k += 64) s += pe[k] * w[(size_t)k * 128 + e];
          s = wave_sum(s); if (F.lane == 0) cst[it] = s; } }
    if (l == 0) {
        const float* x = F.p->in[I_X]; float* out = F.p->out; bf16* xb = WSP(bf16, WS_XB); unsigned long long* rss = WSP(unsigned long long, WS_CTL) + CW_RS / 2;
        for (int m = gw; m < MTOK; m += NGW) {
            const f32x4* xr = (const f32x4*)(x + (size_t)m * DM) + F.lane; f32x4* orow = (f32x4*)(out + (size_t)m * DM) + F.lane; u32x2* br = (u32x2*)(xb + (size_t)m * DM) + F.lane; float ss = 0.f;
#pragma unroll
            for (int j = 0; j < 8; ++j) { const f32x4 v = xr[64 * j]; orow[64 * j] = v; ss += (v[0] * v[0] + v[1] * v[1]) + (v[2] * v[2] + v[3] * v[3]); u32x2 w; w.x = pk2(v[0], v[1]); w.y = pk2(v[2], v[3]); br[64 * j] = w; }
            ss = wave_sum(ss); if (F.lane == 0) rss[m] = pg8::rss_fix(ss);
        }
    }
}

DEV void nsa_prep_job(Frame& F, int l, int job) {
    const int b = job >> 8, g = (job >> 7) & 1, j = job & 127, bg = b * 2 + g, t0 = 64 * j;
    const bf16* p1 = WSP(bf16, WS_P1);
    const float* qn = lin(F, I_NQN, l, 128); const float* kn = lin(F, I_NKN, l, 128);
    bf16* QN = WSP(bf16, WS_QN); bf16* KS = WSP(bf16, WS_KS); bf16* KW = WSP(bf16, WS_KW); bf16* VST = WSP(bf16, WS_VST); bf16* VWT = WSP(bf16, WS_VWT);
    const float gq0 = qn[2 * F.lane], gq1 = qn[2 * F.lane + 1], gk0 = kn[2 * F.lane], gk1 = kn[2 * F.lane + 1];
    unsigned wv[8][4];
#pragma unroll
    for (int i = 0; i < 8; ++i) { const size_t row = (size_t)(b * SEQ + t0 + 8 * F.wave + i) * P1W;
#pragma unroll
        for (int v = 0; v < 4; ++v) { const int col = v < 2 ? C_BQ + (g * 2 + v) * 128 : (v == 2 ? C_BKS + g * 128 : C_BKW + g * 128); wv[i][v] = *(const unsigned*)(p1 + row + col + 2 * F.lane); } }
    CFENCE();
#pragma unroll
    for (int i = 0; i < 8; ++i) {
        const int t = t0 + 8 * F.wave + i;
#pragma unroll
        for (int v = 0; v < 4; ++v) {
            const unsigned w = wv[i][v];
            const float x0 = bflo(w), x1 = bfhi(w);
            const float ss = wave_sum(x0 * x0 + x1 * x1);
            float r = rsqrtf(ss * (1.0f / 128.0f) + EPS);
            unsigned o;
            if (v < 2) { r *= 0.08838834764831845f; o = pk2(x0 * r * gq0, x1 * r * gq1); *(unsigned*)(QN + ((size_t)(bg * SEQ + t) * 2 + v) * 128 + 2 * F.lane) = o; }
            else { o = pk2(x0 * r * gk0, x1 * r * gk1); *(unsigned*)((v == 2 ? KS : KW) + (size_t)(bg * SEQ + t) * 128 + 2 * F.lane) = o; }
        }
    }
    LAS bf16* tl = (LAS bf16*)F.lds;
    for (int i = F.tid; i < 2 * 64 * 64; i += 512) {
        const int v = i >> 12, r = (i >> 6) & 63, c2 = i & 63;
        const unsigned w = *(const unsigned*)(p1 + (size_t)(b * SEQ + t0 + r) * P1W + (v ? C_BVW : C_BVS) + g * 128 + 2 * c2);
        *(LAS unsigned*)(tl + (v * 64 + r) * 130 + 2 * c2) = w;
    }
    __syncthreads();
    for (int i = F.tid; i < 2 * 128 * 8; i += 512) {
        const int v = i >> 10, d = i & 127, tc = (i >> 7) & 7;
        const LAS bf16* s = tl + (v * 64 + 8 * tc) * 130 + d;
        u32x4 o; o.x = s[0] | ((unsigned)s[130] << 16); o.y = s[260] | ((unsigned)s[390] << 16); o.z = s[520] | ((unsigned)s[650] << 16); o.w = s[780] | ((unsigned)s[910] << 16);
        *(u32x4*)((v ? VWT : VST) + ((size_t)(bg * 128 + j) * 128 + d) * 64 + 8 * tc) = o;
    }
    __syncthreads();
}

DEV void gdn_prep_job(Frame& F, int l, int job) {
    const int b = job >> 9, h = (job >> 7) & 3, c = job & 127, t0 = 64 * c;
    const bf16* p1 = WSP(bf16, WS_P1); const float* small = WSP(float, WS_SMALL);
    const float* convw = lin(F, I_GCONV, l, 4 * 1536);
    LAS float* Qs = (LAS float*)F.lds;
    LAS float* Ks = Qs + 64 * 132;
    LAS float* Vs = Ks + 64 * 132;
    LAS float* Mm = Vs + 64 * 132;
    LAS float* At = Mm + 64 * 68;
    LAS float* beta = At + 64 * 68;
    LAS float* gc = beta + 64;
    LAS float* eg = gc + 64;
    const int tid = F.tid;
    {
        const int ch = tid & 127, tg = tid >> 7;
#pragma unroll
        for (int v = 0; v < 3; ++v) {
            const int cc = v * 512 + h * 128 + ch;
            const float w0 = convw[cc], w1 = convw[1536 + cc], w2 = convw[2 * 1536 + cc], w3 = convw[3 * 1536 + cc];
            const int col = (v == 0 ? C_AQ : (v == 1 ? C_AK : C_AV)) + h * 128 + ch;
            float xin[19];
            { const int tt = t0 + 16 * tg;
#pragma unroll
              for (int i = 0; i < 19; ++i) { const int t = tt - 3 + i; xin[i] = t >= 0 ? bf2f(p1[(size_t)(b * SEQ + t) * P1W + col]) : 0.f; } }
            LAS float* dst = v == 0 ? Qs : (v == 1 ? Ks : Vs);
#pragma unroll
            for (int i = 0; i < 16; ++i) {
                const float y = w0 * xin[i] + w1 * xin[i + 1] + w2 * xin[i + 2] + w3 * xin[i + 3];
                dst[(16 * tg + i) * 132 + ch] = siluf_(y);
            }
        }
        if (tid < 64) {
            const size_t row = (size_t)(b * SEQ + t0 + tid);
            const float a = small[row * SMW + S_AA + h], bb = small[row * SMW + S_AB + h];
            beta[tid] = sigmoidf_(bb);
            gc[tid] = -__expf(lin(F, I_GALOG, l, 4)[h]) * softplusf_(a + lin(F, I_GDTB, l, 4)[h]);
        }
    }
    __syncthreads();
    for (int i = 0; i < 16; ++i) {
        const int r = F.wave * 16 + i;
        LAS float* p = (r < 64 ? Qs + r * 132 : Ks + (r - 64) * 132);
        const float x0 = p[F.lane], x1 = p[F.lane + 64];
        const float ss = wave_sum(x0 * x0 + x1 * x1);
        float sc = rsqrtf(ss + EPS); if (r < 64) sc *= 0.08838834764831845f;
        p[F.lane] = x0 * sc; p[F.lane + 64] = x1 * sc;
    }
    if (tid == 0) { float s = 0.f; for (int i = 0; i < 64; ++i) { s += gc[i]; gc[i] = s; eg[i] = __expf(s); } }
    __syncthreads();
    {
        const int i = tid >> 3, jg = tid & 7;
        float kk[8], qk[8];
#pragma unroll
        for (int jj = 0; jj < 8; ++jj) { kk[jj] = 0.f; qk[jj] = 0.f; }
        const LAS f32x4* ki4 = (const LAS f32x4*)(Ks + i * 132); const LAS f32x4* qi4 = (const LAS f32x4*)(Qs + i * 132);
        for (int d4 = 0; d4 < 32; ++d4) {
            const f32x4 ki = ki4[d4], qi = qi4[d4];
#pragma unroll
            for (int jj = 0; jj < 8; ++jj) { const f32x4 kj = ((const LAS f32x4*)(Ks + (jg + 8 * jj) * 132))[d4];
                kk[jj] += (ki[0] * kj[0] + ki[1] * kj[1]) + (ki[2] * kj[2] + ki[3] * kj[3]); qk[jj] += (qi[0] * kj[0] + qi[1] * kj[1]) + (qi[2] * kj[2] + qi[3] * kj[3]); }
        }
        const float gi = gc[i], bi = beta[i];
#pragma unroll
        for (int jj = 0; jj < 8; ++jj) { const int j = jg + 8 * jj; const float dec = j <= i ? __expf(gi - gc[j]) : 0.f;
            Mm[i * 68 + j] = j < i ? bi * kk[jj] * dec : 0.f; At[i * 68 + j] = qk[jj] * dec; }
    }
    __syncthreads();
    unsigned char* cb = F.ws + WS_GW + (size_t)job * GDN_CH_BYTES;
    bf16* gW = (bf16*)cb; bf16* gQD = (bf16*)(cb + 16384); bf16* gKDT = (bf16*)(cb + 32768); bf16* gUT = (bf16*)(cb + 49152); bf16* gAT = (bf16*)(cb + 65536);
    float sol[64];
    if (tid < 256) {
        const int cidx = tid & 127; const bool isw = tid >= 128;
        const LAS float* src = (isw ? Ks : Vs) + cidx;
        const LAS float* MmL = (const LAS float*)lds_vbase(Mm); const LAS float* betaL = (const LAS float*)lds_vbase(beta); const LAS float* egL = (const LAS float*)lds_vbase(eg);
#pragma unroll
        for (int i = 0; i < 64; ++i) sol[i] = 0.f;
#pragma unroll
        for (int i = 0; i < 64; ++i) {
            float r = src[i * 132] * betaL[i] * (isw ? egL[i] : 1.0f), r1 = 0.f, r2 = 0.f, r3 = 0.f;
#pragma unroll
            for (int j4 = 0; j4 < (i + 3) / 4; ++j4) { const f32x4 mv = *(const LAS f32x4*)(MmL + i * 68 + 4 * j4);
                r -= mv[0] * sol[4 * j4]; r1 -= mv[1] * sol[4 * j4 + 1]; r2 -= mv[2] * sol[4 * j4 + 2]; r3 -= mv[3] * sol[4 * j4 + 3]; }
            r = (r + r1) + (r2 + r3);
            sol[i] = r;
            asm volatile("" : "+v"(sol[i]) :: "memory");
        }
    } else {
        const int t2 = tid - 256;
        const float gl = gc[63];
        for (int i = t2; i < 64 * 16; i += 256) { const int r = i >> 4, c8 = (i & 15) * 8; const float e = eg[r]; const LAS float* s = Qs + r * 132 + c8;
            u32x4 o; o.x = pk2(s[0] * e, s[1] * e); o.y = pk2(s[2] * e, s[3] * e); o.z = pk2(s[4] * e, s[5] * e); o.w = pk2(s[6] * e, s[7] * e); *(u32x4*)(gQD + r * 128 + c8) = o; }
        for (int i = t2; i < 128 * 8; i += 256) { const int dk = i & 127, i8 = (i >> 7) * 8; float v[8];
#pragma unroll
            for (int q = 0; q < 8; ++q) v[q] = Ks[(i8 + q) * 132 + dk] * __expf(gl - gc[i8 + q]);
            u32x4 o; o.x = pk2(v[0], v[1]); o.y = pk2(v[2], v[3]); o.z = pk2(v[4], v[5]); o.w = pk2(v[6], v[7]); *(u32x4*)(gKDT + dk * 64 + i8) = o; }
        for (int i = t2; i < 64 * 8; i += 256) { const int r = i >> 3, c8 = (i & 7) * 8; const LAS float* s = At + r * 68 + c8;
            u32x4 o; o.x = pk2(s[0], s[1]); o.y = pk2(s[2], s[3]); o.z = pk2(s[4], s[5]); o.w = pk2(s[6], s[7]); *(u32x4*)(gAT + r * 64 + c8) = o; }
        if (t2 == 0) WSP(float, WS_GL)[job] = __expf(gl);
    }
    __syncthreads();
    LAS bf16* Wl = (LAS bf16*)Qs;
    if (tid < 128) {
#pragma unroll
        for (int q = 0; q < 8; ++q) { u32x4 o; o.x = pk2(sol[8 * q], sol[8 * q + 1]); o.y = pk2(sol[8 * q + 2], sol[8 * q + 3]); o.z = pk2(sol[8 * q + 4], sol[8 * q + 5]); o.w = pk2(sol[8 * q + 6], sol[8 * q + 7]);
            *(u32x4*)(gUT + tid * 64 + 8 * q) = o; }
    } else if (tid < 256) {
#pragma unroll
        for (int i = 0; i < 64; ++i) Wl[i * 136 + (tid - 128)] = (bf16)f2bf(sol[i]);
    }
    __syncthreads();
    for (int i = tid; i < 64 * 16; i += 512) { const int r = i >> 4, c8 = (i & 15) * 8; *(u32x4*)(gW + r * 128 + c8) = *(const LAS u32x4*)(Wl + r * 136 + c8); }
    __syncthreads();
}

DEV void ssd_prep_job(Frame& F, int l, int job) {
    const int b = job >> 7, c = (job >> 1) & 63, g = job & 1, t0 = 128 * c;
    const float zf_ = opaque_zero();
    const bf16* p1 = WSP(bf16, WS_P1); const float* small = WSP(float, WS_SMALL);
    const float* cw = lin(F, I_SCW, l, 4 * 1536); const float* cbias = lin(F, I_SCB, l, 1536);
    bf16* SX = WSP(bf16, WS_SX); float* SDT = WSP(float, WS_SDT); float* SAC = WSP(float, WS_SAC); float* SST = WSP(float, WS_SST); float* SCD = WSP(float, WS_SCD);
    LAS bf16* BT = (LAS bf16*)F.lds;
    LAS bf16* XT = BT + 128 * 136;
    LAS float* dts = (LAS float*)(XT + 64 * 136);
    LAS float* acs = dts + 128 * 8;
    const int tid = F.tid;
    for (int i = tid; i < 1024; i += 512) { const int tl = i >> 3, hh = i & 7, h = 8 * g + hh; const size_t row = (size_t)(b * SEQ + t0 + tl);
        const float dt = softplusf_(small[row * SMW + S_DT + h] + lin(F, I_SDTB, l, 16)[h]);
        dts[i] = dt; acs[i] = dt * (-__expf(lin(F, I_SALOG, l, 16)[h])); }
    __syncthreads();
    if (tid < 8) { float s = 0.f; for (int tl = 0; tl < 128; ++tl) { s += acs[tl * 8 + tid]; acs[tl * 8 + tid] = s; } }
    __syncthreads();
    for (int i = tid; i < 1024; i += 512) { const int tl = i >> 3, hh = i & 7; const size_t row = (size_t)(b * SEQ + t0 + tl); SDT[row * 16 + 8 * g + hh] = dts[i]; SAC[row * 16 + 8 * g + hh] = acs[i]; }
    if (tid < 8) SCD[(size_t)(b * 64 + c) * 16 + 8 * g + tid] = __expf(acs[127 * 8 + tid]);
    {
        const int ch = tid & 255, half = tid >> 8; const int cc = 1024 + (ch < 128 ? g * 128 + ch : 256 + g * 128 + (ch - 128));
        const float w0 = cw[cc], w1 = cw[1536 + cc], w2 = cw[2 * 1536 + cc], w3 = cw[3 * 1536 + cc], bs = cbias[cc];
        const int col = C_CX + cc;
        for (int q = 0; q < 4; ++q) {
            const int ts = t0 + 64 * half + 16 * q; float xin[19];
#pragma unroll
            for (int i = 0; i < 19; ++i) { const int t = ts - 3 + i; xin[i] = t >= 0 ? bf2f(p1[(size_t)(b * SEQ + t) * P1W + col]) : 0.f; }
#pragma unroll
            for (int i = 0; i < 16; ++i) { const int tl = 64 * half + 16 * q + i; const size_t row = (size_t)(b * SEQ + t0 + tl);
                const float y = siluf_(w0 * xin[i] + w1 * xin[i + 1] + w2 * xin[i + 2] + w3 * xin[i + 3] + bs); const bf16 yb = (bf16)f2bf(y);
                SX[row * 1536 + cc] = yb; if (ch < 128) BT[ch * 136 + tl] = yb; }
        }
    }
    for (int hh = 0; hh < 8; ++hh) {
        const int h = 8 * g + hh;
        __syncthreads();
        {
            const int ch = tid & 63, tg = tid >> 6; const int cc = h * 64 + ch;
            const float w0 = cw[cc], w1 = cw[1536 + cc], w2 = cw[2 * 1536 + cc], w3 = cw[3 * 1536 + cc], bs = cbias[cc];
            const int col = C_CX + cc; const int ts = t0 + 16 * tg;
            float xin[19];
#pragma unroll
            for (int i = 0; i < 19; ++i) { const int t = ts - 3 + i; xin[i] = t >= 0 ? bf2f(p1[(size_t)(b * SEQ + t) * P1W + col]) : 0.f; }
            const float al = acs[127 * 8 + hh];
#pragma unroll
            for (int i = 0; i < 16; ++i) { const int tl = 16 * tg + i; const size_t row = (size_t)(b * SEQ + t0 + tl);
                const float y = siluf_(w0 * xin[i] + w1 * xin[i + 1] + w2 * xin[i + 2] + w3 * xin[i + 3] + bs); const bf16 yb = (bf16)f2bf(y);
                SX[row * 1536 + cc] = yb;
                XT[ch * 136 + tl] = (bf16)f2bf(bf2f(yb) * dts[tl * 8 + hh] * __expf(al - acs[tl * 8 + hh])); }
        }
        __syncthreads();
        {
            const int mt = F.wave & 3, nb = (F.wave >> 2) * 4;
            bf16x8 a[4];
#pragma unroll
            for (int ks = 0; ks < 4; ++ks) a[ks] = frag_l(XT, 136, 16 * mt, 32 * ks, F.lane);
            float* dst = SST + ((size_t)((b * 64 + c) * 16 + h) * 64) * 128;
#pragma unroll
            for (int q = 0; q < 4; ++q) { f32x4 acc = ZERO4;
#pragma unroll
                for (int ks = 0; ks < 4; ++ks) acc = mfma16(a[ks], frag_l(BT, 136, 16 * (nb + q), 32 * ks, F.lane), acc);
#pragma unroll
                for (int r = 0; r < 4; ++r) dst[(size_t)(16 * mt + 4 * (F.lane >> 4) + r) * 128 + 16 * (nb + q) + (F.lane & 15)] = acc[r]; }
        }
    }
    __syncthreads();
}

DEV void nsa_compress_job(Frame& F, int l, int job) {
    const int kv = job >> 4, bg = (job >> 2) & 3, rt = job & 3, b = bg >> 1, g = bg & 1, i0 = 128 * rt;
    const float zf_ = opaque_zero();
    const bf16* p1 = WSP(bf16, WS_P1); const bf16* Wt = WSP(bf16, kv ? WS_WCV : WS_WCK); const float* cst = WSP(float, WS_CONST) + kv * 128;
    const int col0 = (kv ? C_BVC : C_BKC) + g * 128;
    LAS bf16* As = (LAS bf16*)F.lds;
    LAS bf16* Bs = As + 128 * 72;
    LAS float* Cs = (LAS float*)(Bs + 128 * 72);
    const int tid = F.tid, wm = F.wave >> 1, wn = F.wave & 1;
    f32x4 acc[2][4];
#pragma unroll
    for (int i = 0; i < 2; ++i)
#pragma unroll
        for (int j = 0; j < 4; ++j) acc[i][j] = ZERO4;
    u32x4 ra[2], rb[2];
#define LOADK(ks_) do { _Pragma("unroll") for (int q = 0; q < 2; ++q) { const int ch = tid + 512 * q, r = ch >> 3, c8 = (ch & 7) * 8; \
            int t = 16 * (i0 + r) + ((ks_) >> 1); if (t > SEQ - 1) t = SEQ - 1;     \
            ra[q] = *(const u32x4*)(p1 + (size_t)(b * SEQ + t) * P1W + col0 + ((ks_) & 1) * 64 + c8); \
            rb[q] = *(const u32x4*)(Wt + (size_t)r * 4096 + 64 * (ks_) + c8); } } while (0)
    LOADK(0);
    for (int ks = 0; ks < 64; ++ks) {
        __syncthreads();
#pragma unroll
        for (int q = 0; q < 2; ++q) { const int ch = tid + 512 * q, r = ch >> 3, c8 = (ch & 7) * 8; *(LAS u32x4*)(As + r * 72 + c8) = ra[q]; *(LAS u32x4*)(Bs + r * 72 + c8) = rb[q]; }
        __syncthreads();
        if (ks + 1 < 64) LOADK(ks + 1);
#pragma unroll
        for (int k2 = 0; k2 < 2; ++k2) {
            bf16x8 a0 = frag_l(As, 72, 32 * wm, 32 * k2, F.lane), a1 = frag_l(As, 72, 32 * wm + 16, 32 * k2, F.lane);
#pragma unroll
            for (int j = 0; j < 4; ++j) { const bf16x8 bb = frag_l(Bs, 72, 64 * wn + 16 * j, 32 * k2, F.lane); acc[0][j] = mfma16(a0, bb, acc[0][j]); acc[1][j] = mfma16(a1, bb, acc[1][j]); }
        }
    }
    __syncthreads();
#pragma unroll
    for (int i = 0; i < 2; ++i)
#pragma unroll
        for (int j = 0; j < 4; ++j)
#pragma unroll
            for (int r = 0; r < 4; ++r) { const int col = 64 * wn + 16 * j + (F.lane & 15); Cs[(32 * wm + 16 * i + 4 * (F.lane >> 4) + r) * 132 + col] = acc[i][j][r] + cst[col]; }
    __syncthreads();
    if (kv == 0) {
        const float* kn = lin(F, I_NKN, l, 128); bf16* KC = WSP(bf16, WS_KCMP);
        const int r = tid >> 2, q = tid & 3; const LAS float* s = Cs + r * 132 + 32 * q; float ss = 0.f;
#pragma unroll
        for (int e = 0; e < 32; ++e) ss += s[e] * s[e];
        ss += shx<1>(ss); ss += shx<2>(ss);
        const float rs = rsqrtf(ss * (1.0f / 128.0f) + EPS);
        bf16* dst = KC + ((size_t)bg * 512 + i0 + r) * 128 + 32 * q;
#pragma unroll
        for (int e = 0; e < 32; e += 2) *(unsigned*)(dst + e) = pk2(s[e] * rs * kn[32 * q + e], s[e + 1] * rs * kn[32 * q + e + 1]);
    } else {
        bf16* VC = WSP(bf16, WS_VCMPT); const int e = tid & 127, q = tid >> 7;
#pragma unroll
        for (int i8 = 0; i8 < 4; ++i8) { const LAS float* s = Cs + (32 * q + 8 * i8) * 132 + e;
            u32x4 o; o.x = pk2(s[0], s[132]); o.y = pk2(s[264], s[396]); o.z = pk2(s[528], s[660]); o.w = pk2(s[792], s[924]);
            *(u32x4*)(VC + ((size_t)bg * 128 + e) * 512 + i0 + 32 * q + 8 * i8) = o; }
    }
    __syncthreads();
}
#undef LOADK

constexpr int AL_KT = 0, AL_VT = 17408, AL_KT1 = 35840, AL_UW = 53248, AL_TB = 54272, AL_SM = 60608, AL_PS = 61696, AL_IMP = 78336, AL_VT1 = 111104, AL_END = 129536;
static_assert(AL_KT1 + 17408 <= AL_UW && AL_UW + 128 <= AL_TB && AL_END <= MISC_OFF, "attention LDS map");
DEV int rel_bucket_dev(int n) {
    if (n < 16) return n;
    int k = 16;
    k += (n >= 21); k += (n >= 27); k += (n >= 35); k += (n >= 46); k += (n >= 59); k += (n >= 77); k += (n >= 99); k += (n >= 128);
    k += (n >= 166); k += (n >= 216); k += (n >= 280); k += (n >= 363); k += (n >= 470); k += (n >= 609); k += (n >= 790);
    return k;
}
DEV void attn_fill_bias(Frame& F, int g) {
    LAS float* tb = (LAS float*)(F.lds + AL_TB); const float* rt = F.p->in[I_REL];
    for (int i = F.tid; i < 2 * 792; i += 512) { const int hg = i / 792, d = i - hg * 792; tb[i] = rt[rel_bucket_dev(d) * 4 + 2 * g + hg]; }
}
DEV void attn_load_tile(u32x4 (&rk)[2], u32x4 (&rv)[2], const bf16* ksrc, const bf16* vsrc, int vpitch, int tid) {
#pragma unroll
    for (int q = 0; q < 2; ++q) { const int ch = tid + 512 * q; rk[q] = *(const u32x4*)(ksrc + (size_t)ch * 8); rv[q] = *(const u32x4*)(vsrc + (size_t)(ch >> 3) * vpitch + (ch & 7) * 8); }
}
DEV void attn_store_tile(LAS unsigned char* lds, int buf, const u32x4 (&rk)[2], const u32x4 (&rv)[2], int tid) {
    LAS bf16* Kt = (LAS bf16*)(lds + (buf ? AL_KT1 : AL_KT)); LAS bf16* Vt = (LAS bf16*)(lds + (buf ? AL_VT1 : AL_VT));
#pragma unroll
    for (int q = 0; q < 2; ++q) { const int ch = tid + 512 * q; *(LAS u32x4*)(Kt + (ch >> 4) * 136 + (ch & 15) * 8) = rk[q]; *(LAS u32x4*)(Vt + (ch >> 3) * 72 + (ch & 7) * 8) = rv[q]; }
}
template <int MODE, int PATH = 0>
DEV unsigned attn_scores(LAS unsigned char* lds, int buf, const bf16x8 (&qf)[4], int lane, int n0, int tok, int hg, unsigned selbit, f32x4 (&s)[4]) {
    const float zf_ = opaque_zero();
    const LAS bf16* Kt = (const LAS bf16*)(lds + (buf ? AL_KT1 : AL_KT)); const LAS float* tb = (const LAS float*)(lds + AL_TB) + hg * 792;
#pragma unroll
    for (int nt = 0; nt < 4; ++nt) { s[nt] = ZERO4;
#pragma unroll
        for (int ks = 0; ks < 4; ++ks) s[nt] = mfma16(frag_l(Kt, 136, 16 * nt, 32 * ks, lane), qf[ks], s[nt]); }
    if (PATH == 1) {
        const float bf = tb[790]; const bool ok = selbit != 0u;
#pragma unroll
        for (int nt = 0; nt < 4; ++nt)
#pragma unroll
            for (int r = 0; r < 4; ++r) s[nt][r] = ok ? s[nt][r] + bf : -1e30f;
        return ok ? 0xffffu : 0u;
    }
    if (PATH == 2) {
        const bool ok = MODE == 2 ? true : (selbit != 0u);
        const LAS float* tp = tb + (tok - n0 - 4 * (lane >> 4));
#pragma unroll
        for (int nt = 0; nt < 4; ++nt)
#pragma unroll
            for (int r = 0; r < 4; ++r) s[nt][r] = ok ? s[nt][r] + tp[-16 * nt - r] : -1e30f;
        return ok ? 0xffffu : 0u;
    }
    unsigned vm = 0u;
#pragma unroll
    for (int nt = 0; nt < 4; ++nt)
#pragma unroll
        for (int r = 0; r < 4; ++r) { const int n = n0 + 16 * nt + 4 * (lane >> 4) + r; int dist; bool ok;
            if (MODE == 0) { dist = tok - (16 * n + 31); ok = dist >= 0 && n < 511; }
            else if (MODE == 1) { dist = tok - n; ok = dist >= 0 && selbit != 0u; }
            else { dist = tok - n; ok = dist >= 0 && dist < 512; }
            int di = dist < 0 ? 0 : dist; di = di > 790 ? 790 : di;
            s[nt][r] = ok ? s[nt][r] + tb[di] : -1e30f;
            vm |= (ok ? 1u : 0u) << (4 * nt + r); }
    return vm;
}
DEV float fq_max(float v) {
    const auto a = __builtin_amdgcn_permlane16_swap(__builtin_bit_cast(unsigned, v), __builtin_bit_cast(unsigned, v), false, false);
    const float m = fmaxf(__builtin_bit_cast(float, a[0]), __builtin_bit_cast(float, a[1]));
    const auto b = __builtin_amdgcn_permlane32_swap(__builtin_bit_cast(unsigned, m), __builtin_bit_cast(unsigned, m), false, false);
    return fmaxf(__builtin_bit_cast(float, b[0]), __builtin_bit_cast(float, b[1]));
}
DEV float fq_sum(float v) {
    const auto a = __builtin_amdgcn_permlane16_swap(__builtin_bit_cast(unsigned, v), __builtin_bit_cast(unsigned, v), false, false);
    const float m = __builtin_bit_cast(float, a[0]) + __builtin_bit_cast(float, a[1]);
    const auto b = __builtin_amdgcn_permlane32_swap(__builtin_bit_cast(unsigned, m), __builtin_bit_cast(unsigned, m), false, false);
    return __builtin_bit_cast(float, b[0]) + __builtin_bit_cast(float, b[1]);
}
DEV float attn_online(const f32x4 (&s)[4], unsigned vm, float& m, float& l, f32x4 (&p)[4]) {
    float mx = fmaxf(fmaxf(fmaxf(s[0][0], s[0][1]), fmaxf(s[0][2], s[0][3])), fmaxf(fmaxf(s[1][0], s[1][1]), fmaxf(s[1][2], s[1][3])));
    mx = fmaxf(mx, fmaxf(fmaxf(fmaxf(s[2][0], s[2][1]), fmaxf(s[2][2], s[2][3])), fmaxf(fmaxf(s[3][0], s[3][1]), fmaxf(s[3][2], s[3][3]))));
    mx = fmaxf(mx, shx<16>(mx)); mx = fmaxf(mx, shx<32>(mx));
    const float mn = fmaxf(m, mx), sc = __expf(m - mn); float rs = 0.f;
#pragma unroll
    for (int nt = 0; nt < 4; ++nt)
#pragma unroll
        for (int r = 0; r < 4; ++r) { const float pv = ((vm >> (4 * nt + r)) & 1u) ? __expf(s[nt][r] - mn) : 0.f; p[nt][r] = pv; rs += pv; }
    rs += shx<16>(rs); rs += shx<32>(rs);
    l = l * sc + rs; m = mn;
    return sc;
}
DEV void attn_pv(LAS unsigned char* lds, int buf, int lane, const f32x4 (&p)[4], f32x4 (&o)[8]) {
    const LAS bf16* Vt = (const LAS bf16*)(lds + (buf ? AL_VT1 : AL_VT)) + (lane & 15) * 72 + 4 * (lane >> 4);
#pragma unroll
    for (int ks = 0; ks < 2; ++ks) {
        u32x4 pw; pw.x = pg8::cvt_pk_bf16(p[2 * ks][0], p[2 * ks][1]); pw.y = pg8::cvt_pk_bf16(p[2 * ks][2], p[2 * ks][3]); pw.z = pg8::cvt_pk_bf16(p[2 * ks + 1][0], p[2 * ks + 1][1]); pw.w = pg8::cvt_pk_bf16(p[2 * ks + 1][2], p[2 * ks + 1][3]);
        const bf16x8 pb = __builtin_bit_cast(bf16x8, pw);
#pragma unroll
        for (int dt = 0; dt < 8; ++dt) {
            const u32x2 v0 = *(const LAS u32x2*)(Vt + 16 * dt * 72 + 32 * ks), v1 = *(const LAS u32x2*)(Vt + 16 * dt * 72 + 32 * ks + 16);
            u32x4 vw; vw.x = v0.x; vw.y = v0.y; vw.z = v1.x; vw.w = v1.y;
            o[dt] = mfma16(__builtin_bit_cast(bf16x8, vw), pb, o[dt]); }
    }
}
DEV void attn_load_q(Frame& F, int bg, int t0, bf16x8 (&qf)[4]) {
    const bf16* QN = WSP(bf16, WS_QN); const int rho = F.lane & 15;
    const bf16* src = QN + ((size_t)(bg * SEQ + t0 + 8 * F.wave + (rho & 7)) * 2 + (rho >> 3)) * 128 + 8 * (F.lane >> 4);
#pragma unroll
    for (int ks = 0; ks < 4; ++ks) qf[ks] = *(const bf16x8*)(src + 32 * ks);
}

DEV void nsa_job(Frame& F, int job) {
    const int bg = job >> 7, qt = job & 127, b = bg >> 1, g = bg & 1, t0 = 64 * qt, tid = F.tid, lane = F.lane, wave = F.wave;
    const float zf_ = opaque_zero();
    const int fq = lane >> 4, fr = lane & 15, hg = fr >> 3, tok = t0 + 8 * wave + (fr & 7);
    const float* small = WSP(float, WS_SMALL); const size_t row = (size_t)(b * SEQ + tok);
    LAS float* PS = (LAS float*)(F.lds + AL_PS) + wave * (8 * 65); LAS float* IMP = (LAS float*)(F.lds + AL_IMP);
    LAS unsigned* SM = (LAS unsigned*)(F.lds + AL_SM);
    LAS unsigned* UW = (LAS unsigned*)(F.lds + AL_UW);
    __syncthreads();
    attn_fill_bias(F, g);
    for (int i = tid; i < 64 * 128; i += 512) IMP[i] = 0.f;
    if (lane < 8) PS[lane * 65] = 0.f;
    bf16x8 qf[4]; attn_load_q(F, bg, t0, qf);
    f32x4 tot[8];
    u32x4 rk[2], rv[2];
    for (int dr_ = 0; dr_ < (DBG_NSA == 1 ? 2 : 1); ++dr_) {
        if (dr_ == 1) { WAVE_SYNC(); if (lane < 8) PS[lane * 65] = 0.f; WAVE_SYNC(); }
        const int ntiles = (4 * qt + 2) / 64 + 1;
        const bf16* KC = WSP(bf16, WS_KCMP) + (size_t)bg * 512 * 128; const bf16* VC = WSP(bf16, WS_VCMPT) + (size_t)bg * 128 * 512;
        float m = -1e30f, l = 0.f;
        attn_load_tile(rk, rv, KC, VC, 512, tid); attn_store_tile(F.lds, 0, rk, rv, tid); __syncthreads();
        for (int j = 0; j < ntiles; ++j) {
            if (j + 1 < ntiles) attn_load_tile(rk, rv, KC + (size_t)(j + 1) * 64 * 128, VC + (j + 1) * 64, 512, tid);
            f32x4 s[4], p[4];
            const unsigned vm = attn_scores<0>(F.lds, j & 1, qf, lane, 64 * j, tok, hg, 0u, s);
            (void)attn_online(s, vm, m, l, p);
            if (j + 1 < ntiles) attn_store_tile(F.lds, (j + 1) & 1, rk, rv, tid);
            __syncthreads();
        }
        const float il = l > 0.f ? 1.0f / l : 0.f;
        f32x4 o[8];
#pragma unroll
        for (int dt = 0; dt < 8; ++dt) o[dt] = ZERO4;
        attn_load_tile(rk, rv, KC, VC, 512, tid); attn_store_tile(F.lds, 0, rk, rv, tid); __syncthreads();
        for (int j = 0; j < ntiles; ++j) {
            if (j + 1 < ntiles) attn_load_tile(rk, rv, KC + (size_t)(j + 1) * 64 * 128, VC + (j + 1) * 64, 512, tid);
            f32x4 s[4], p[4];
            const unsigned vm = attn_scores<0>(F.lds, j & 1, qf, lane, 64 * j, tok, hg, 0u, s);
#pragma unroll
            for (int nt = 0; nt < 4; ++nt)
#pragma unroll
                for (int r = 0; r < 4; ++r) {
                    const float pv = ((vm >> (4 * nt + r)) & 1u) ? __expf(s[nt][r] - m) * il : 0.f; p[nt][r] = pv;
                    const float ps = pv + shx<8>(pv);
                    if (fr < 8) PS[fr * 65 + 1 + 16 * nt + 4 * fq + r] = ps;
                }
            WAVE_SYNC();
#pragma unroll
            for (int q = 0; q < 2; ++q) { const int idx = lane + 64 * q, tk = idx >> 4, bl = idx & 15; const LAS float* ps = PS + tk * 65 + 4 * bl;
                IMP[(8 * wave + tk) * 128 + 16 * j + bl] = ps[0] + 2.0f * ps[1] + 2.0f * ps[2] + 2.0f * ps[3] + ps[4]; }
            WAVE_SYNC();
            if (lane < 8) PS[lane * 65] = PS[lane * 65 + 64];
            WAVE_SYNC();
            attn_pv(F.lds, j & 1, lane, p, o);
            if (j + 1 < ntiles) attn_store_tile(F.lds, (j + 1) & 1, rk, rv, tid);
            __syncthreads();
        }
        const float gt = sigmoidf_(small[row * SMW + S_BG + (2 * g + hg) * 3 + 0]);
#pragma unroll
        for (int dt = 0; dt < 8; ++dt) tot[dt] = o[dt] * gt;
    }
    unsigned wum[4] = {0u, 0u, 0u, 0u};
    for (int dr_ = 0; dr_ < (DBG_NSA == 4 ? 2 : 1); ++dr_) {
        const int cur = qt;
        for (int tk = 0; tk < 8; ++tk) {
            const LAS float* rowp = IMP + (8 * wave + tk) * 128;
            const int b0 = lane, b1 = lane + 64;
            const float s0 = b0 > cur ? -1e4f : ((b0 == 0 || b0 >= cur - 1) ? 1e4f : rowp[b0]);
            const float s1 = b1 > cur ? -1e4f : ((b1 == 0 || b1 >= cur - 1) ? 1e4f : rowp[b1]);
            unsigned k0 = __builtin_bit_cast(unsigned, s0), k1 = __builtin_bit_cast(unsigned, s1);
            k0 = (k0 & 0x80000000u) ? ~k0 : (k0 | 0x80000000u); k1 = (k1 & 0x80000000u) ? ~k1 : (k1 | 0x80000000u);
            unsigned prefix = 0u; int need = 16;
            for (int bit = 31; bit >= 0; --bit) {
                const unsigned cand = (prefix | (1u << bit)) >> bit;
                const int cnt = __builtin_popcountll(__ballot((k0 >> bit) == cand)) + __builtin_popcountll(__ballot((k1 >> bit) == cand));
                if (cnt >= need) prefix |= (1u << bit); else need -= cnt;
            }
            const unsigned long long e0 = __ballot(k0 == prefix), e1 = __ballot(k1 == prefix);
            const int r0 = (int)__builtin_amdgcn_mbcnt_hi((unsigned)(e0 >> 32), __builtin_amdgcn_mbcnt_lo((unsigned)e0, 0u));
            const int r1 = __builtin_popcountll(e0) + (int)__builtin_amdgcn_mbcnt_hi((unsigned)(e1 >> 32), __builtin_amdgcn_mbcnt_lo((unsigned)e1, 0u));
            const bool sel0 = k0 > prefix || (k0 == prefix && r0 < need), sel1 = k1 > prefix || (k1 == prefix && r1 < need);
            const unsigned long long m0 = __ballot(sel0), m1 = __ballot(sel1);
            const unsigned w0 = (unsigned)m0, w1 = (unsigned)(m0 >> 32), w2 = (unsigned)m1, w3 = (unsigned)(m1 >> 32);
            wum[0] |= w0; wum[1] |= w1; wum[2] |= w2; wum[3] |= w3;
            if (lane == 0) { SM[(8 * wave + tk) * 4 + 0] = w0; SM[(8 * wave + tk) * 4 + 1] = w1; SM[(8 * wave + tk) * 4 + 2] = w2; SM[(8 * wave + tk) * 4 + 3] = w3; }
        }
        if (lane == 0) { UW[wave * 4 + 0] = wum[0]; UW[wave * 4 + 1] = wum[1]; UW[wave * 4 + 2] = wum[2]; UW[wave * 4 + 3] = wum[3]; }
    }
    __syncthreads();
    const u32x4 smw = *(const LAS u32x4*)(SM + (8 * wave + (fr & 7)) * 4);
    unsigned um[4];
#pragma unroll
    for (int w = 0; w < 4; ++w) { unsigned v = 0u;
#pragma unroll
        for (int q = 0; q < 8; ++q) v |= UW[q * 4 + w];
        um[w] = __builtin_amdgcn_readfirstlane(v); }
    const bf16* KS = WSP(bf16, WS_KS) + (size_t)bg * SEQ * 128; const bf16* VS = WSP(bf16, WS_VST) + (size_t)bg * 128 * 8192;
    const bf16* KW = WSP(bf16, WS_KW) + (size_t)bg * SEQ * 128; const bf16* VW = WSP(bf16, WS_VWT) + (size_t)bg * 128 * 8192;
    for (int dr_ = 0; dr_ < (DBG_NSA == 2 ? 2 : 1); ++dr_) {
        float m = -1e30f, l = 0.f; f32x4 o[8];
#pragma unroll
        for (int dt = 0; dt < 8; ++dt) o[dt] = ZERO4;
        int j = 0, cb = 0;
        attn_load_tile(rk, rv, KS, VS, 64, tid); attn_store_tile(F.lds, 0, rk, rv, tid); __syncthreads();
        while (j <= qt) {
            int jn = j + 1;
            while (jn <= qt) { const unsigned w = jn < 32 ? um[0] : (jn < 64 ? um[1] : (jn < 96 ? um[2] : um[3])); if ((w >> (jn & 31)) & 1u) break; ++jn; }
            if (jn <= qt) attn_load_tile(rk, rv, KS + (size_t)jn * 64 * 128, VS + (size_t)jn * 128 * 64, 64, tid);
            const unsigned wsel = j < 32 ? wum[0] : (j < 64 ? wum[1] : (j < 96 ? wum[2] : wum[3]));
            if ((wsel >> (j & 31)) & 1u) {
                const unsigned w = j < 32 ? smw.x : (j < 64 ? smw.y : (j < 96 ? smw.z : smw.w)); const unsigned selbit = (w >> (j & 31)) & 1u;
                f32x4 s[4], p[4];
                const unsigned vm = (j <= qt - 14) ? attn_scores<1, 1>(F.lds, cb, qf, lane, 64 * j, tok, hg, selbit, s) : ((j >= qt - 11 && j < qt) ? attn_scores<1, 2>(F.lds, cb, qf, lane, 64 * j, tok, hg, selbit, s) : attn_scores<1, 0>(F.lds, cb, qf, lane, 64 * j, tok, hg, selbit, s));
                const float sc = attn_online(s, vm, m, l, p);
#pragma unroll
                for (int dt = 0; dt < 8; ++dt) o[dt] = o[dt] * sc;
                attn_pv(F.lds, cb, lane, p, o);
            }
            if (jn <= qt) attn_store_tile(F.lds, cb ^ 1, rk, rv, tid);
            __syncthreads();
            cb ^= 1; j = jn;
        }
        const float gt = (DBG_NSA == 2 && dr_ == 0) ? zf_ * l : sigmoidf_(small[row * SMW + S_BG + (2 * g + hg) * 3 + 1]) / l;
#pragma unroll
        for (int dt = 0; dt < 8; ++dt) tot[dt] = tot[dt] + o[dt] * gt;
    }
    for (int dr_ = 0; dr_ < (DBG_NSA == 3 ? 2 : 1); ++dr_) {
        float m = -1e30f, l = 0.f; f32x4 o[8];
#pragma unroll
        for (int dt = 0; dt < 8; ++dt) o[dt] = ZERO4;
        const int j0 = qt >= 8 ? qt - 8 : 0;
        attn_load_tile(rk, rv, KW + (size_t)j0 * 64 * 128, VW + (size_t)j0 * 128 * 64, 64, tid); attn_store_tile(F.lds, 0, rk, rv, tid); __syncthreads();
        for (int j = j0; j <= qt; ++j) {
            const int cb = (j - j0) & 1;
            if (j + 1 <= qt) attn_load_tile(rk, rv, KW + (size_t)(j + 1) * 64 * 128, VW + (size_t)(j + 1) * 128 * 64, 64, tid);
            f32x4 s[4], p[4];
            const unsigned vm = (j >= qt - 7 && j < qt) ? attn_scores<2, 2>(F.lds, cb, qf, lane, 64 * j, tok, hg, 0u, s) : attn_scores<2, 0>(F.lds, cb, qf, lane, 64 * j, tok, hg, 0u, s);
            const float sc = attn_online(s, vm, m, l, p);
#pragma unroll
            for (int dt = 0; dt < 8; ++dt) o[dt] = o[dt] * sc;
            attn_pv(F.lds, cb, lane, p, o);
            if (j + 1 <= qt) attn_store_tile(F.lds, cb ^ 1, rk, rv, tid);
            __syncthreads();
        }
        const float gt = (DBG_NSA == 3 && dr_ == 0) ? zf_ * l : sigmoidf_(small[row * SMW + S_BG + (2 * g + hg) * 3 + 2]) / l;
#pragma unroll
        for (int dt = 0; dt < 8; ++dt) tot[dt] = tot[dt] + o[dt] * gt;
    }
    {
        bf16* YC = WSP(bf16, WS_YCAT);
#pragma unroll
        for (int dt = 0; dt < 8; ++dt) { const int cidx = (2 * g + hg) * 128 + 16 * dt + 4 * fq;
            f32x4 y = tot[dt]; if (DBG_ZERO & 2) y = ZERO4;
            u32x2 w; w.x = pk2(y[0], y[1]); w.y = pk2(y[2], y[3]); *(u32x2*)(YC + row * 2048 + 512 + cidx) = w; }
    }
    __syncthreads();
}

DEV void gdn_scan_job(Frame& F, int job) {
    const int bh = job >> 3, sl = job & 7, b = bh >> 2, h = bh & 3, lane = F.lane, wave = F.wave, fq = lane >> 4, fr = lane & 15;
    LAS bf16* St = (LAS bf16*)F.lds;
    LAS bf16* Vn = St + 16 * 136;
    const float* GL = WSP(float, WS_GL); float* GO = WSP(float, WS_GO);
    const float zf_ = opaque_zero();
    __syncthreads();
    for (int i = F.tid; i < 16 * 136 / 2; i += 512) ((LAS unsigned*)St)[i] = 0u;
    f32x4 S = ZERO4;
    const int mt = wave & 3;
    __syncthreads();
    const int o1 = (wave < 4 ? 0 : 8192) + (16 * mt + fr) * 128 + 8 * fq;
    const int oA = 32768 + (16 * mt + fr) * 64 + 8 * fq;
    const int oK = 16384 + (16 * wave + fr) * 64 + 8 * fq;
    const int oU = 24576 + (16 * sl + fr) * 64 + 16 * mt + 4 * fq;
    const bf16* rec = (const bf16*)(F.ws + WS_GW + (size_t)(bh * 128) * GDN_CH_BYTES);
    bf16x8 a1[4], aA[2], aK[2], n1[4], nA[2], nK[2]; u32x2 uu, nu; float gl, ngl;
#define GLOAD(A1, AA, AK, UU, G, c_) do { const bf16* r_ = rec + (size_t)(c_) * (GDN_CH_BYTES / 2); \
        _Pragma("unroll") for (int ks = 0; ks < 4; ++ks) A1[ks] = *(const bf16x8*)(r_ + o1 + 32 * ks); \
        AA[0] = *(const bf16x8*)(r_ + oA); AA[1] = *(const bf16x8*)(r_ + oA + 32); AK[0] = *(const bf16x8*)(r_ + oK); AK[1] = *(const bf16x8*)(r_ + oK + 32); \
        UU = *(const u32x2*)(r_ + oU); G = GL[bh * 128 + (c_)]; } while (0)
    GLOAD(a1, aA, aK, uu, gl, 0);
    for (int c = 0; c < 128; ++c) {
        const int cn = c + 1 < 128 ? c + 1 : c;
        GLOAD(n1, nA, nK, nu, ngl, cn);
        f32x4 d1 = ZERO4;
#pragma unroll
        for (int ks = 0; ks < 4; ++ks) d1 = mfma16(a1[ks], frag_l(St, 136, 0, 32 * ks, lane), d1);
        if (wave < 4) {
            const float v0 = bflo(uu.x) - d1[0], v1 = bfhi(uu.x) - d1[1], v2 = bflo(uu.y) - d1[2], v3 = bfhi(uu.y) - d1[3];
            u32x2 w; w.x = pk2(v0, v1); w.y = pk2(v2, v3);
            *(LAS u32x2*)(Vn + fr * 72 + 16 * mt + 4 * fq) = w;
        }
        LDS_WAIT(); __builtin_amdgcn_s_barrier(); CFENCE();
        const bf16x8 bv0 = frag_l(Vn, 72, 0, 0, lane), bv1 = frag_l(Vn, 72, 0, 32, lane);
        if (wave >= 4) {
            d1 = mfma16(aA[0], bv0, d1); d1 = mfma16(aA[1], bv1, d1);
#pragma unroll
            for (int r = 0; r < 4; ++r) GO[(size_t)(b * SEQ + 64 * c + 16 * mt + 4 * fq + r) * 512 + h * 128 + 16 * sl + fr] = d1[r];
        }
        f32x4 dk = ZERO4;
        dk = mfma16(aK[0], bv0, dk); dk = mfma16(aK[1], bv1, dk);
        S = S * gl + dk;
        { u32x2 w; w.x = pk2(S[0], S[1]); w.y = pk2(S[2], S[3]); *(LAS u32x2*)(St + fr * 136 + 16 * wave + 4 * fq) = w; }
        LDS_WAIT(); __builtin_amdgcn_s_barrier(); CFENCE();
#pragma unroll
        for (int ks = 0; ks < 4; ++ks) a1[ks] = n1[ks];
        aA[0] = nA[0]; aA[1] = nA[1]; aK[0] = nK[0]; aK[1] = nK[1]; uu = nu; gl = ngl;
    }
#undef GLOAD
    __syncthreads();
}

DEV void ssd_scan_part(Frame& F, int part, int nparts) {
    float* __restrict__ SST = WSP(float, WS_SST); const float* __restrict__ SCD = WSP(float, WS_SCD);
    constexpr int PER_B = 16 * 64 * 128;
    for (int e = part * 512 + F.tid; e < 2 * PER_B; e += nparts * 512) {
        const int b = e / PER_B, r = e - b * PER_B, h = r >> 13;
        float* p = SST + (size_t)(b * 64) * PER_B + r; const float* cdp = SCD + (b * 64) * 16 + h;
        float v[64], cd[64];
#pragma unroll
        for (int c = 0; c < 64; ++c) { v[c] = p[(size_t)c * PER_B]; cd[c] = cdp[c * 16]; }
        float s = 0.f;
#pragma unroll
        for (int c = 0; c < 64; ++c) { p[(size_t)c * PER_B] = s; s = s * cd[c] + v[c]; }
    }
}

DEV void gdn_final_rows(Frame& F, int l, int w0, int nw) {
    const float* GO = WSP(float, WS_GO); const bf16* p1 = WSP(bf16, WS_P1); bf16* YC = WSP(bf16, WS_YCAT); const float* gn = lin(F, I_GNORM, l, 128);
    const int lane = F.lane, dv0 = (lane & 15) * 8;
    float gv[8];
#pragma unroll
    for (int j = 0; j < 8; ++j) gv[j] = gn[dv0 + j];
    for (int row = w0; row < MTOK; row += nw) {
        const f32x4 a = *(const f32x4*)(GO + (size_t)row * 512 + lane * 8), bq = *(const f32x4*)(GO + (size_t)row * 512 + lane * 8 + 4);
        float ss = (a[0] * a[0] + a[1] * a[1]) + (a[2] * a[2] + a[3] * a[3]) + (bq[0] * bq[0] + bq[1] * bq[1]) + (bq[2] * bq[2] + bq[3] * bq[3]);
        ss = sum16(ss);
        const float rs = rsqrtf(ss * (1.0f / 128.0f) + EPS);
        const u32x4 zw = *(const u32x4*)(p1 + (size_t)row * P1W + C_AZ + lane * 8);
        const float z[8] = {bflo(zw.x), bfhi(zw.x), bflo(zw.y), bfhi(zw.y), bflo(zw.z), bfhi(zw.z), bflo(zw.w), bfhi(zw.w)};
        const float o[8] = {a[0], a[1], a[2], a[3], bq[0], bq[1], bq[2], bq[3]};
        float y[8];
#pragma unroll
        for (int j = 0; j < 8; ++j) y[j] = (DBG_ZERO & 1) ? opaque_zero() : o[j] * rs * gv[j] * siluf_(z[j]);
        u32x4 w; w.x = pk2(y[0], y[1]); w.y = pk2(y[2], y[3]); w.z = pk2(y[4], y[5]); w.w = pk2(y[6], y[7]);
        *(u32x4*)(YC + (size_t)row * 2048 + lane * 8) = w;
    }
}

DEV void ssd_out_job(Frame& F, int l, int job) {
    const int b = job >> 7, c = (job >> 1) & 63, g = job & 1, t0 = 128 * c, tid = F.tid, lane = F.lane, wave = F.wave, fq = lane >> 4, fr = lane & 15;
    const bf16* SX = WSP(bf16, WS_SX); const bf16* p1 = WSP(bf16, WS_P1); const float* SDT = WSP(float, WS_SDT); const float* SAC = WSP(float, WS_SAC); const float* SST = WSP(float, WS_SST);
    bf16* YC = WSP(bf16, WS_YCAT); float* RC = WSP(float, WS_SRC);
    const float zf_ = opaque_zero();
    LAS bf16* Cs = (LAS bf16*)F.lds;
    LAS bf16* Bs = Cs + 128 * 136;
    LAS bf16* XdT = Bs + 128 * 136;
    LAS bf16* SiT = XdT + 64 * 136;
    LAS bf16* Pw = SiT + 64 * 136;
    LAS float* acs = (LAS float*)(Pw + 8 * 16 * 136);
    __syncthreads();
    for (int i = tid; i < 2 * 128 * 16; i += 512) { const int v = i >> 11, r = (i >> 4) & 127, c8 = (i & 15) * 8;
        const u32x4 w = *(const u32x4*)(SX + (size_t)(b * SEQ + t0 + r) * 1536 + 1024 + (v ? 256 : 0) + g * 128 + c8);
        *(LAS u32x4*)((v ? Cs : Bs) + r * 136 + c8) = w; }
    for (int i = tid; i < 1024; i += 512) { const size_t row = (size_t)(b * SEQ + t0 + (i >> 3)); acs[i] = SAC[row * 16 + 8 * g + (i & 7)]; }
    __syncthreads();
    f32x4 cb[8];
    {
        bf16x8 ca[4];
#pragma unroll
        for (int ks = 0; ks < 4; ++ks) ca[ks] = frag_l(Cs, 136, 16 * wave, 32 * ks, lane);
#pragma unroll
        for (int nt = 0; nt < 8; ++nt) { cb[nt] = ZERO4;
#pragma unroll
            for (int ks = 0; ks < 4; ++ks) cb[nt] = mfma16(ca[ks], frag_l(Bs, 136, 16 * nt, 32 * ks, lane), cb[nt]); }
    }
    float ssq[4] = {0.f, 0.f, 0.f, 0.f};
    LAS bf16* pw = Pw + wave * 16 * 136;
    const float* dsk = lin(F, I_SD, l, 16);
    for (int hh = 0; hh < 8; ++hh) {
        const int h = 8 * g + hh;
        __syncthreads();
        for (int i = tid; i < 64 * 128; i += 512) { const int p = i & 63, s = i >> 6;
            XdT[p * 136 + s] = (bf16)f2bf(bf2f(SX[(size_t)(b * SEQ + t0 + s) * 1536 + h * 64 + p]) * SDT[(size_t)(b * SEQ + t0 + s) * 16 + h]); }
        { const float* sin = SST + ((size_t)((b * 64 + c) * 16 + h) * 64) * 128;
          for (int i = tid; i < 64 * 32; i += 512) { const int p = i >> 5, n4 = (i & 31) * 4; const f32x4 v = *(const f32x4*)(sin + p * 128 + n4);
              u32x2 w; w.x = pk2(v[0], v[1]); w.y = pk2(v[2], v[3]); *(LAS u32x2*)(SiT + p * 136 + n4) = w; } }
        float al[4];
#pragma unroll
        for (int r = 0; r < 4; ++r) al[r] = acs[(16 * wave + 4 * fq + r) * 8 + hh];
#pragma unroll
        for (int nt = 0; nt < 8; ++nt) { const int s = 16 * nt + fr; const float as = acs[s * 8 + hh];
#pragma unroll
            for (int r = 0; r < 4; ++r) { const int li = 16 * wave + 4 * fq + r; const float v = s <= li ? cb[nt][r] * __expf(al[r] - as) : 0.f; pw[(4 * fq + r) * 136 + s] = (bf16)f2bf(v); } }
        __syncthreads();
        f32x4 y[4], ys[4];
#pragma unroll
        for (int nt = 0; nt < 4; ++nt) { y[nt] = ZERO4; ys[nt] = ZERO4; }
#pragma unroll
        for (int ks = 0; ks < 4; ++ks) { const bf16x8 pa = frag_l(pw, 136, 0, 32 * ks, lane), cc = frag_l(Cs, 136, 16 * wave, 32 * ks, lane);
#pragma unroll
            for (int nt = 0; nt < 4; ++nt) { y[nt] = mfma16(pa, frag_l(XdT, 136, 16 * nt, 32 * ks, lane), y[nt]); ys[nt] = mfma16(cc, frag_l(SiT, 136, 16 * nt, 32 * ks, lane), ys[nt]); } }
        const float dh = dsk[h];
        unsigned short xv[4][4], zv[4][4];
#pragma unroll
        for (int r = 0; r < 4; ++r) { const size_t row = (size_t)(b * SEQ + t0 + 16 * wave + 4 * fq + r);
#pragma unroll
            for (int nt = 0; nt < 4; ++nt) { xv[r][nt] = SX[row * 1536 + h * 64 + 16 * nt + fr]; zv[r][nt] = p1[row * P1W + C_CZ + h * 64 + 16 * nt + fr]; } }
        CFENCE();
#pragma unroll
        for (int r = 0; r < 4; ++r) { const size_t row = (size_t)(b * SEQ + t0 + 16 * wave + 4 * fq + r); const float ea = __expf(al[r]);
#pragma unroll
            for (int nt = 0; nt < 4; ++nt) { const int p = 16 * nt + fr;
                const float xs = bf2f(xv[r][nt]); const float z = bf2f(zv[r][nt]);
                const float v = (DBG_ZERO & 4) ? zf_ : (y[nt][r] + ea * ys[nt][r] + xs * dh) * siluf_(z);
                ssq[r] += v * v; YC[row * 2048 + 1024 + h * 64 + p] = (bf16)f2bf(v); } }
    }
#pragma unroll
    for (int r = 0; r < 4; ++r) { const float s = sum16(ssq[r]); if (fr == 0) RC[(size_t)(b * SEQ + t0 + 16 * wave + 4 * fq + r) * 2 + g] = rsqrtf(s * (1.0f / 512.0f) + EPS); }
    __syncthreads();
}

constexpr int NPH = 12;
#ifndef CPU_EMU
DEV unsigned long long launder64(unsigned long long v) {
    unsigned lo = __builtin_amdgcn_readfirstlane((unsigned)v), hi = __builtin_amdgcn_readfirstlane((unsigned)(v >> 32));
    asm volatile("" : "+s"(lo), "+s"(hi));
    return ((unsigned long long)hi << 32) | lo;
}
DEV bool phase_begin(Frame& F, const Params& prm, int wave0) {
    F.ws = (unsigned char*)launder64((unsigned long long)prm.ws);
    F.p = (KParams)launder64((unsigned long long)__builtin_amdgcn_kernarg_segment_ptr());
    unsigned z = 0u; asm volatile("" : "+v"(z)); const int ln = (int)__builtin_amdgcn_mbcnt_hi(~0u, __builtin_amdgcn_mbcnt_lo(~0u, z));
    int wv = wave0; asm volatile("" : "+s"(wv)); F.wave = wv; F.lane = ln; F.tid = wv * 64 + ln;
    int bi = __builtin_amdgcn_readfirstlane(blockIdx.x); asm volatile("" : "+s"(bi)); F.bid = bi;
    int gg = __builtin_amdgcn_readfirstlane(gridDim.x); asm volatile("" : "+s"(gg)); F.G = gg;
    unsigned la = __builtin_amdgcn_readfirstlane((unsigned)(size_t)F.lds); asm volatile("" : "+s"(la)); F.lds = (LAS unsigned char*)(size_t)la;
    return true;
}
DEV void job_begin(Frame& F) { int t = F.tid; asm volatile("" : "+v"(t)); F.tid = t; F.lane = t & 63; }
__global__ void __launch_bounds__(512, 2) hybrid_fwd(Params prm) {
    extern __shared__ __attribute__((aligned(16))) unsigned char lds_raw[];
    Frame F;
    F.lds = (LAS unsigned char*)lds_raw; F.tid = threadIdx.x; F.lane = F.tid & 63; F.wave = __builtin_amdgcn_readfirstlane(F.tid >> 6);
    const int wave0 = F.wave;
    F.G = gridDim.x; F.bid = blockIdx.x; F.p = (KParams)__builtin_amdgcn_kernarg_segment_ptr(); F.ws = prm.ws;
    volatile LAS unsigned* MISC = (volatile LAS unsigned*)(F.lds + MISC_OFF);
    if (F.tid < 64) MISC[F.tid] = 0u;
    __syncthreads();
    unsigned* ctl = (unsigned*)(F.ws + WS_CTL);
    XcdBarrier bar; bar.bar = ctl + CW_BAR; bar.x = 0; bar.st = nullptr;
    if (prm.use_bar) bar = xcd_barrier_post(ctl + CW_BAR, MISC + 8);
    const int lo = prm.lo, hi = prm.hi;
    for (int l = 0; l < DEPTH; ++l) {
#define IN(k) (lo <= l * NPH + (k) && l * NPH + (k) < hi && phase_begin(F, prm, wave0))
#define REP_BEGIN(k) for (int rep_ = 0; rep_ < ((DBG_REP == (k)) ? 2 : 1); ++rep_) {
#define REP_END(k) if (DBG_REP == (k) && rep_ == 0) { XcdBarrier bb_ = bar; bb_.bar = (unsigned*)launder64((unsigned long long)bar.bar); xcd_barrier(bb_); } }
#define SEAM(k) do { if (l * NPH + (k) + 1 < hi && prm.use_bar) { XcdBarrier bb_ = bar; bb_.bar = (unsigned*)launder64((unsigned long long)bar.bar); { unsigned x_ = __builtin_amdgcn_readfirstlane(bar.x); asm volatile("" : "+s"(x_)); bb_.x = x_; } xcd_barrier(bb_); } } while (0)
#define RSB(i) (WSP(unsigned long long, WS_CTL) + CW_RS / 2 + (size_t)(3 * l + (i)) * MTOK)
#define XB WSP(bf16, WS_XB)
#define ACT WSP(bf16, WS_ACT)
        if (IN(0)) { REP_BEGIN(0) phase_convert(F, l); REP_END(0) SEAM(0); }
        if (IN(1)) { REP_BEGIN(1) pg8::Gemm g{XB, WSP(bf16, WS_WUP1), MTOK, NUP, DM, DM, DM}; pg8::StaticOrder S; S.init(MTOK, NUP, F.G, F.bid);
            pg8::EpiSwiGLU E{ACT, RSB(0)}; pg8::gemm_phase<pg8::EpiSwiGLU, pg8::StaticOrder>(F.lds, F.tid, g, S, E); REP_END(1) SEAM(1); }
        if (IN(2)) { pg8::Gemm g{ACT, WSP(bf16, WS_WDN1), MTOK, DM, DFF, DFF, DFF}; pg8::StaticOrder S; S.init(MTOK, DM, F.G, F.bid);
            pg8::EpiResidual E{prm.out, XB, RSB(1), 0.5f}; pg8::gemm_phase<pg8::EpiResidual, pg8::StaticOrder>(F.lds, F.tid, g, S, E); SEAM(2); }
        if (IN(3)) { REP_BEGIN(3) pg8::Gemm g{XB, WSP(bf16, WS_WIN), MTOK, NINP, DM, DM, DM}; pg8::StaticOrder S; S.init(MTOK, NINP, F.G, F.bid);
            pg8::EpiWin E{WSP(bf16, WS_P1), WSP(float, WS_SMALL), WSP(bf16, WS_GATE), RSB(1)}; pg8::gemm_phase<pg8::EpiWin, pg8::StaticOrder>(F.lds, F.tid, g, S, E); REP_END(3) SEAM(3); }
        if (IN(4)) {
            REP_BEGIN(4)
            {
                unsigned* ctr = WSP(unsigned, WS_CTL) + CW_WQ + 64 * (8 + l * 2 + rep_);
                LAS unsigned* jslot = (LAS unsigned*)(F.lds + MISC_OFF + 128);
                for (;;) {
                    __syncthreads();
                    if (F.tid == 0) *jslot = __hip_atomic_fetch_add(ctr, 1u, __ATOMIC_RELAXED, __HIP_MEMORY_SCOPE_AGENT);
                    __syncthreads();
                    const int j = (int)*jslot;
                    if (j >= 32 + 1024 + 256 + 512) break;
                    job_begin(F);
                    if (j < 32) nsa_compress_job(F, l, j);
                    else if (j < 32 + 256) ssd_prep_job(F, l, j - 32);
                    else if (j < 32 + 256 + 1024) gdn_prep_job(F, l, j - 32 - 256);
                    else nsa_prep_job(F, l, j - 32 - 256 - 1024);
                }
            }
            REP_END(4)
            SEAM(4);
        }
        if (IN(5)) {
            REP_BEGIN(5)
            if (F.bid < 64) gdn_scan_job(F, (F.bid & 7) * 8 + (F.bid >> 3));
            else if (rep_ == 0) ssd_scan_part(F, F.bid - 64, F.G - 64);
            {
                unsigned* ctr = WSP(unsigned, WS_CTL) + CW_WQ + 64 * (l * 2 + rep_);
                LAS unsigned* jslot = (LAS unsigned*)(F.lds + MISC_OFF + 128);
                for (;;) {
                    __syncthreads();
                    if (F.tid == 0) *jslot = __hip_atomic_fetch_add(ctr, 1u, __ATOMIC_RELAXED, __HIP_MEMORY_SCOPE_AGENT);
                    __syncthreads();
                    const unsigned j = *jslot;
                    if (j >= 512u) break;
                    job_begin(F);
                    nsa_job(F, (int)((j & 3u) * 128u + (127u - (j >> 2))));
                }
            }
            REP_END(5)
            SEAM(5);
        }
        if (IN(7)) {
            REP_BEGIN(7)
            for (int j = F.bid; j < 256; j += F.G) { job_begin(F); ssd_out_job(F, l, j); }
            job_begin(F);
            gdn_final_rows(F, l, F.bid * 8 + F.wave, F.G * 8);
            REP_END(7)
            SEAM(7);
        }
        if (IN(8)) { REP_BEGIN(8) pg8::Gemm g{WSP(bf16, WS_YCAT), WSP(bf16, WS_WPM), MTOK, DM, 512, DM, DM}; pg8::SegOrder S; S.init(MTOK, DM, F.G, F.bid, 512);
            pg8::EpiMergeSeg E{WSP(bf16, WS_MERGED), WSP(bf16, WS_GATE), WSP(float, WS_SRC)}; pg8::gemm_phase<pg8::EpiMergeSeg, pg8::SegOrder>(F.lds, F.tid, g, S, E); REP_END(8) SEAM(8); }
        if (IN(9)) { pg8::Gemm g{WSP(bf16, WS_MERGED), WSP(bf16, WS_WO), MTOK, DM, DM, DM, DM}; pg8::StaticOrder S; S.init(MTOK, DM, F.G, F.bid);
            pg8::EpiResidual E{prm.out, XB, RSB(2), 1.0f}; pg8::gemm_phase<pg8::EpiResidual, pg8::StaticOrder>(F.lds, F.tid, g, S, E); SEAM(9); }
        if (IN(10)) { pg8::Gemm g{XB, WSP(bf16, WS_WUP2), MTOK, NUP, DM, DM, DM}; pg8::StaticOrder S; S.init(MTOK, NUP, F.G, F.bid);
            pg8::EpiSwiGLU E{ACT, RSB(2)}; pg8::gemm_phase<pg8::EpiSwiGLU, pg8::StaticOrder>(F.lds, F.tid, g, S, E); SEAM(10); }
        if (IN(11)) { pg8::Gemm g{ACT, WSP(bf16, WS_WDN2), MTOK, DM, DFF, DFF, DFF}; pg8::StaticOrder S; S.init(MTOK, DM, F.G, F.bid);
            pg8::EpiResidual E{prm.out, XB, RSB(3), 0.5f}; pg8::gemm_phase<pg8::EpiResidual, pg8::StaticOrder>(F.lds, F.tid, g, S, E); SEAM(11); }
#undef IN
#undef SEAM
#undef REP_BEGIN
#undef REP_END
#undef RSB
#undef XB
#undef ACT
    }
}

#ifndef DBG_DUMP
#define DBG_DUMP 0
#endif
#ifndef DBG_STOP
#define DBG_STOP 48
#endif
__global__ void dbg_dump_bf16(const unsigned short* src, size_t n, float* out, size_t nout) {
    for (size_t i = (size_t)blockIdx.x * blockDim.x + threadIdx.x; i < nout; i += (size_t)gridDim.x * blockDim.x) { float s = 0.f; for (size_t k = i; k < n; k += nout) s += __builtin_bit_cast(float, (unsigned)src[k] << 16); out[i] = s; }
}
__global__ void dbg_dump_f32(const float* src, size_t n, float* out, size_t nout) {
    for (size_t i = (size_t)blockIdx.x * blockDim.x + threadIdx.x; i < nout; i += (size_t)gridDim.x * blockDim.x) { float s = 0.f; for (size_t k = i; k < n; k += nout) s += src[k]; out[i] = s; }
}
#ifndef N_LAUNCH_MODE
#define N_LAUNCH_MODE 0
#endif
extern "C" void kernel_launch(void* const* d_in, const int* in_sizes, int n_in, void* d_out, int out_size, void* d_ws, size_t ws_size, hipStream_t stream) {
    static int grid = 0;
    if (grid == 0) {
        if (n_in != 30 || out_size != MTOK * DM || ws_size < WS_END) { fprintf(stderr, "kernel_launch: unexpected shapes (n_in %d out %d ws %zu, need %zu)\n", n_in, out_size, ws_size, (size_t)WS_END); grid = -1; return; }
        int dev = 0, cus = 0, per_cu = 0;
        if (hipGetDevice(&dev) != hipSuccess || hipDeviceGetAttribute(&cus, hipDeviceAttributeMultiprocessorCount, dev) != hipSuccess) { grid = -1; return; }
        if (hipFuncSetAttribute((const void*)hybrid_fwd, hipFuncAttributeMaxDynamicSharedMemorySize, LDS_BYTES) != hipSuccess) { fprintf(stderr, "kernel_launch: hipFuncSetAttribute failed\n"); grid = -1; return; }
        if (hipOccupancyMaxActiveBlocksPerMultiprocessor(&per_cu, (const void*)hybrid_fwd, 512, LDS_BYTES) != hipSuccess || per_cu < 1) { fprintf(stderr, "kernel_launch: occupancy query says %d\n", per_cu); }
        (void)hipGetLastError();
        grid = cus;
    }
    if (grid < 0) return;
    (void)hipMemsetAsync((char*)d_ws + WS_CTL, 0, CTL_BYTES, stream);
    Params p{};
    for (int i = 0; i < 30; ++i) p.in[i] = (const float*)d_in[i];
    p.out = (float*)d_out; p.ws = (unsigned char*)d_ws; p.pad = 0;
    if (N_LAUNCH_MODE == 0) { p.lo = 0; p.hi = DEPTH * NPH; p.use_bar = 1; hipLaunchKernelGGL(hybrid_fwd, dim3(grid), dim3(512), LDS_BYTES, stream, p); }
    else { for (int ph = 0; ph < (DBG_DUMP ? DBG_STOP : DEPTH * NPH); ++ph) { p.lo = ph; p.hi = ph + 1; p.use_bar = 0; hipLaunchKernelGGL(hybrid_fwd, dim3(grid), dim3(512), LDS_BYTES, stream, p); } }
    if (DBG_DUMP) {
        const size_t nout = (size_t)MTOK * DM; char* w = (char*)d_ws;
        if (DBG_DUMP == 1) hipLaunchKernelGGL(dbg_dump_bf16, dim3(2048), dim3(256), 0, stream, (const unsigned short*)(w + WS_P1), (size_t)MTOK * P1W, (float*)d_out, nout);
        if (DBG_DUMP == 2) hipLaunchKernelGGL(dbg_dump_f32, dim3(2048), dim3(256), 0, stream, (const float*)(w + WS_SMALL), (size_t)MTOK * SMW, (float*)d_out, nout);
        if (DBG_DUMP == 3) hipLaunchKernelGGL(dbg_dump_bf16, dim3(2048), dim3(256), 0, stream, (const unsigned short*)(w + WS_GW), (size_t)1024 * GDN_CH_BYTES / 2, (float*)d_out, nout);
        if (DBG_DUMP == 4) hipLaunchKernelGGL(dbg_dump_f32, dim3(2048), dim3(256), 0, stream, (const float*)(w + WS_SST), (size_t)2 * 64 * 16 * 64 * 128, (float*)d_out, nout);
        if (DBG_DUMP == 5) hipLaunchKernelGGL(dbg_dump_f32, dim3(2048), dim3(256), 0, stream, (const float*)(w + WS_GO), (size_t)MTOK * 512, (float*)d_out, nout);
        if (DBG_DUMP == 6) hipLaunchKernelGGL(dbg_dump_bf16, dim3(2048), dim3(256), 0, stream, (const unsigned short*)(w + WS_YCAT), (size_t)MTOK * 2048, (float*)d_out, nout);
        if (DBG_DUMP == 7) hipLaunchKernelGGL(dbg_dump_bf16, dim3(2048), dim3(256), 0, stream, (const unsigned short*)(w + WS_MERGED), (size_t)MTOK * 2048, (float*)d_out, nout);
        if (DBG_DUMP == 8) hipLaunchKernelGGL(dbg_dump_bf16, dim3(2048), dim3(256), 0, stream, (const unsigned short*)(w + WS_SX), (size_t)MTOK * 1536, (float*)d_out, nout);
        if (DBG_DUMP == 9) hipLaunchKernelGGL(dbg_dump_bf16, dim3(2048), dim3(256), 0, stream, (const unsigned short*)(w + WS_GATE), (size_t)MTOK * 6144, (float*)d_out, nout);
        if (DBG_DUMP == 11) hipLaunchKernelGGL(dbg_dump_f32, dim3(2048), dim3(256), 0, stream, (const float*)(w + WS_SRC), (size_t)MTOK * 2, (float*)d_out, nout);
        if (DBG_DUMP == 12) hipLaunchKernelGGL(dbg_dump_bf16, dim3(2048), dim3(256), 0, stream, (const unsigned short*)(w + WS_WPM), (size_t)DM * DM, (float*)d_out, nout);
        if (DBG_DUMP == 13) hipLaunchKernelGGL(dbg_dump_f32, dim3(2048), dim3(256), 0, stream, (const float*)(w + WS_MTMP), (size_t)MTOK * DM, (float*)d_out, nout);
        if (DBG_DUMP == 15) hipLaunchKernelGGL(dbg_dump_bf16, dim3(2048), dim3(256), 0, stream, (const unsigned short*)(w + WS_ACT), (size_t)MTOK * DFF, (float*)d_out, nout);
        if (DBG_DUMP == 16) hipLaunchKernelGGL(dbg_dump_bf16, dim3(2048), dim3(256), 0, stream, (const unsigned short*)(w + WS_XB), (size_t)MTOK * DM, (float*)d_out, nout);
        if (DBG_DUMP == 17) hipLaunchKernelGGL(dbg_dump_bf16, dim3(2048), dim3(256), 0, stream, (const unsigned short*)(w + WS_WIN), (size_t)NINP * DM, (float*)d_out, nout);
        if (DBG_DUMP == 18) hipLaunchKernelGGL(dbg_dump_f32, dim3(2048), dim3(256), 0, stream, (const float*)(w + WS_CTL) + CW_RS, (size_t)NRS * MTOK, (float*)d_out, nout);
        if (DBG_DUMP == 10) hipLaunchKernelGGL(dbg_dump_f32, dim3(2048), dim3(256), 0, stream, (const float*)(w + WS_YB), (size_t)MTOK * 512, (float*)d_out, nout);
    }
}
#endif
```

```cpp
#include <hip/hip_runtime.h>
#include <cstdio>
#include <cstdint>

#ifndef CPU_EMU
#define DEV __device__ __forceinline__
#define LAS __attribute__((address_space(3)))
#define VM_WAIT() asm volatile("s_waitcnt vmcnt(0)" ::: "memory")
#define LDS_WAIT() asm volatile("s_waitcnt lgkmcnt(0)" ::: "memory")
#define CFENCE() asm volatile("" ::: "memory")
#define WAVE_SYNC() do { asm volatile("" ::: "memory"); __builtin_amdgcn_wave_barrier(); asm volatile("" ::: "memory"); } while (0)
#endif

#define DBG_DUMP 0
#define DBG_NSA 0
#define DBG_REP (-1)
#define DBG_STOP 48
#ifndef DBG_ZERO
#define DBG_ZERO 0
#endif
typedef unsigned short bf16;
typedef short bf16x8 __attribute__((ext_vector_type(8)));
typedef float f32x4 __attribute__((ext_vector_type(4)));
typedef float f32x2 __attribute__((ext_vector_type(2)));
typedef unsigned u32x4 __attribute__((ext_vector_type(4)));
typedef unsigned u32x2 __attribute__((ext_vector_type(2)));

constexpr int BATCH = 2, SEQ = 8192, DM = 2048, DEPTH = 4, DFF = 5504, NUP = 2 * DFF;
constexpr int MTOK = BATCH * SEQ;
constexpr int NIN = 12836, NINP = 13056;
constexpr int P1W = 6656;
constexpr int SM0 = 6656;
constexpr int GT0 = 6912;
constexpr float EPS = 1e-6f;
constexpr int C_AQ = 0, C_AK = 512, C_AV = 1024, C_AZ = 1536, C_BQ = 2048, C_BKC = 2560, C_BVC = 2816, C_BKS = 3072, C_BVS = 3328, C_BKW = 3584, C_BVW = 3840, C_CZ = 4096, C_CX = 5120;
constexpr int S_AA = 0, S_AB = 4, S_BG = 8, S_DT = 20, SMW = 64;

constexpr size_t MiB = 1u << 20;
constexpr size_t WS_CTL = 0, CTL_BYTES = 2 * MiB;
constexpr size_t WS_WUP1 = 2 * MiB;
constexpr size_t WS_WDN1 = WS_WUP1 + (size_t)NUP * DM * 2;
constexpr size_t WS_WIN = WS_WDN1 + (size_t)DM * DFF * 2;
constexpr size_t WS_WPM = WS_WIN + (size_t)NINP * DM * 2;
constexpr size_t WS_WO = WS_WPM + (size_t)DM * DM * 2;
constexpr size_t WS_WUP2 = WS_WO + (size_t)DM * DM * 2;
constexpr size_t WS_WDN2 = WS_WUP2 + (size_t)NUP * DM * 2;
constexpr size_t WS_WCK = WS_WDN2 + (size_t)DM * DFF * 2;
constexpr size_t WS_WCV = WS_WCK + 128 * 4096 * 2;
constexpr size_t WS_CONST = WS_WCV + 128 * 4096 * 2;
constexpr size_t WS_WEND = WS_CONST + 4096;
static_assert(WS_WEND <= 212 * MiB, "weights region");
constexpr size_t WS_XB = 212 * MiB;
constexpr size_t WS_P1 = 276 * MiB;
constexpr size_t WS_ACT = WS_P1;
constexpr size_t WS_GATE = 484 * MiB;
constexpr size_t WS_SMALL = 676 * MiB;
constexpr size_t WS_MERGED = 680 * MiB;
constexpr size_t WS_YCAT = 744 * MiB;
constexpr size_t WS_GW = 808 * MiB;
constexpr size_t GDN_CH_BYTES = 73728;
constexpr size_t WS_GL = 880 * MiB;
constexpr size_t WS_GO = 881 * MiB;
constexpr size_t WS_SX = 913 * MiB;
constexpr size_t WS_SDT = 961 * MiB;
constexpr size_t WS_SAC = 962 * MiB;
constexpr size_t WS_SST = 963 * MiB;
constexpr size_t WS_SCD = 1027 * MiB;
constexpr size_t WS_SRC = 1028 * MiB;
constexpr size_t WS_QN = 1029 * MiB;
constexpr size_t WS_KS = 1045 * MiB;
constexpr size_t WS_KW = 1053 * MiB;
constexpr size_t WS_VST = 1061 * MiB;
constexpr size_t WS_VWT = 1069 * MiB;
constexpr size_t WS_KCMP = 1077 * MiB;
constexpr size_t WS_VCMPT = 1078 * MiB;
constexpr size_t WS_SELM = 1079 * MiB;
constexpr size_t WS_YB = 1080 * MiB;
constexpr size_t WS_MTMP = 1112 * MiB;
constexpr size_t WS_END = 1240 * MiB;
static_assert(WS_P1 + (size_t)MTOK * P1W * 2 <= WS_GATE && WS_GATE + (size_t)MTOK * 6144 * 2 <= WS_SMALL && WS_SMALL + (size_t)MTOK * SMW * 4 <= WS_MERGED && WS_MERGED + (size_t)MTOK * DM * 2 <= WS_YCAT && WS_YCAT + (size_t)MTOK * 2048 * 2 <= WS_GW, "ws map 1");
static_assert(WS_GW + 1024 * GDN_CH_BYTES <= WS_GL && WS_GO + (size_t)MTOK * 512 * 4 <= WS_SX && WS_SX + (size_t)MTOK * 1536 * 2 <= WS_SDT && WS_SDT + (size_t)MTOK * 16 * 4 <= WS_SAC && WS_SAC + (size_t)MTOK * 16 * 4 <= WS_SST && WS_SST + (size_t)2 * 64 * 16 * 64 * 128 * 4 <= WS_SCD, "ws map 2");
static_assert(WS_SRC + (size_t)MTOK * 2 * 4 <= WS_QN && WS_QN + (size_t)4 * SEQ * 256 * 2 <= WS_KS && WS_KS + (size_t)4 * SEQ * 128 * 2 <= WS_KW && WS_KW + (size_t)4 * SEQ * 128 * 2 <= WS_VST && WS_VST + (size_t)4 * SEQ * 128 * 2 <= WS_VWT && WS_VWT + (size_t)4 * SEQ * 128 * 2 <= WS_KCMP, "ws map 3");
static_assert(WS_KCMP + 4 * 512 * 128 * 2 <= WS_VCMPT && WS_VCMPT + 4 * 512 * 128 * 2 <= WS_SELM && WS_SELM + (size_t)4 * SEQ * 16 <= WS_YB && WS_YB + (size_t)MTOK * 512 * 4 <= WS_END && WS_XB + (size_t)MTOK * DM * 2 <= WS_P1 && (size_t)MTOK * DFF * 2 <= (size_t)MTOK * P1W * 2, "ws map 4");

constexpr int CW_BAR = 1024;
constexpr int CW_RS = 16384;
constexpr int NRS = 13;
constexpr int CW_WQ = 8192;
static_assert(CW_RS * 4 + NRS * MTOK * 8 <= (int)CTL_BYTES, "ctl");

constexpr int RING_BYTES = 131072;
constexpr int MISC_OFF = RING_BYTES + 12288;
constexpr int LDS_BYTES = 147456;

DEV unsigned f2bf(float f) { unsigned u = __builtin_bit_cast(unsigned, f); return (u + 0x7fffu + ((u >> 16) & 1u)) >> 16; }
DEV float bf2f(unsigned b) { return __builtin_bit_cast(float, (b & 0xffffu) << 16); }
DEV unsigned pk2(float lo, float hi) { return f2bf(lo) | (f2bf(hi) << 16); }
DEV float bflo(unsigned w) { return __builtin_bit_cast(float, w << 16); }
DEV float bfhi(unsigned w) { return __builtin_bit_cast(float, w & 0xffff0000u); }
DEV float sigmoidf_(float x) { return 1.0f / (1.0f + __expf(-x)); }
DEV float siluf_(float x) { return x / (1.0f + __expf(-x)); }
DEV float softplusf_(float x) {
    const float e = __expf(-fabsf(x)), u = 1.0f + e, d = u - 1.0f;
    const float lp = d == 0.f ? e : __logf(u) * (e / d);
    return fmaxf(x, 0.f) + lp;
}
#ifndef CPU_EMU
template <int M, class T> DEV T shx(T v) {
    static_assert(sizeof(T) == 4, "shx: 32-bit values");
    const int iv = __builtin_bit_cast(int, v);
    if constexpr (M < 32) return __builtin_bit_cast(T, __builtin_amdgcn_ds_swizzle(iv, 0x1f | (M << 10)));
    else { unsigned z = 0u; asm volatile("" : "+v"(z)); const unsigned ln = __builtin_amdgcn_mbcnt_hi(~0u, __builtin_amdgcn_mbcnt_lo(~0u, z));
        return __builtin_bit_cast(T, __builtin_amdgcn_ds_bpermute((int)((ln ^ 32u) << 2), iv)); }
}
#endif
DEV float wave_sum(float v) { v += shx<1>(v); v += shx<2>(v); v += shx<4>(v); v += shx<8>(v); v += shx<16>(v); v += shx<32>(v); return v; }
DEV float sum16(float v) { v += shx<1>(v); v += shx<2>(v); v += shx<4>(v); v += shx<8>(v); return v; }
DEV float max16(float v) { v = fmaxf(v, shx<1>(v)); v = fmaxf(v, shx<2>(v)); v = fmaxf(v, shx<4>(v)); v = fmaxf(v, shx<8>(v)); return v; }
#ifndef CPU_EMU
DEV float opaque_zero() { float z = 0.f; asm volatile("" : "+v"(z)); return z; }
#endif
#define ZERO4 ((f32x4){zf_, zf_, zf_, zf_})
DEV f32x4 mfma16(bf16x8 a, bf16x8 b, f32x4 c) { return __builtin_amdgcn_mfma_f32_16x16x32_bf16(a, b, c, 0, 0, 0); }
DEV bf16x8 frag_g(const bf16* base, int pitch, int row0, int k0, int lane) { return *(const bf16x8*)(base + (size_t)(row0 + (lane & 15)) * pitch + k0 + 8 * (lane >> 4)); }
DEV bf16x8 frag_l(const LAS bf16* base, int pitch, int row0, int k0, int lane) { return *(const LAS bf16x8*)(base + (row0 + (lane & 15)) * pitch + k0 + 8 * (lane >> 4)); }
#ifndef CPU_EMU
DEV const LAS void* lds_vbase(const LAS void* p) { unsigned a = (unsigned)(size_t)p; asm volatile("" : "+v"(a)); return (const LAS void*)(size_t)a; }
#endif

struct Params {
    const float* in[30];
    float* out;
    unsigned char* ws;
    int lo, hi;
    int use_bar, pad;
};
enum { I_X = 0, I_REL, I_GF1, I_WUP1, I_WDN1, I_GMIX, I_WIN, I_GCONV, I_GALOG, I_GDTB, I_GNORM, I_NQN, I_NKN, I_NPEK, I_NPEV, I_NWCK, I_NWCV,
       I_SCW, I_SCB, I_SDTB, I_SALOG, I_SD, I_SNORM, I_PA, I_PB, I_PC, I_WO, I_GF2, I_WUP2, I_WDN2 };

#define XB_TMO      128
#define XB_XCNT(j)  (256  + 64 * (j))
#define XB_XSUB(j)  (1280 + 64 * (j))
#define XB_XGEN(j)  (2304 + 64 * (j))
#define XB_TOP      3328
#define XB_TOPGEN   3392
#define XCD_BAR_WORDS 3456
#define XB_SPIN_CAP (1u << 22)
#ifndef CPU_EMU
DEV unsigned xb_ld(unsigned* p)              { return __hip_atomic_load(p, __ATOMIC_RELAXED, __HIP_MEMORY_SCOPE_AGENT); }
DEV unsigned xb_add(unsigned* p, unsigned v) { return __hip_atomic_fetch_add(p, v, __ATOMIC_RELAXED, __HIP_MEMORY_SCOPE_AGENT); }
DEV unsigned xb_xcc_id() { return (unsigned)__builtin_amdgcn_s_getreg((3 << 11) | 20) & 0xFu; }
#define XB_SPIN(cond, bar) do { unsigned _sp = 0; while (cond) { __builtin_amdgcn_s_sleep(1); \
    if ((++_sp & 255u) == 0u) { if (xb_ld(&(bar)[XB_TMO])) break; if (_sp > XB_SPIN_CAP) { atomicAdd(&(bar)[XB_TMO], 1u); break; } } } } while (0)
struct XcdBarrier { unsigned* bar; unsigned x; volatile LAS unsigned* st; };
DEV XcdBarrier xcd_barrier_post(unsigned* bar, volatile LAS unsigned* st) {
    XcdBarrier b; b.bar = bar; b.x = xb_xcc_id(); b.st = st;
    if (threadIdx.x == 0) (void)xb_add(&bar[XB_XCNT(b.x)], 1u);
    return b;
}
DEV void xcd_barrier_complete(unsigned* bar, unsigned x, unsigned& nloc, unsigned& nx) {
    const unsigned G = gridDim.x * gridDim.y * gridDim.z;
    unsigned sum, cnt, mine, sp = 0u;
    for (;;) {
        sum = 0u; cnt = 0u; mine = 0u;
#pragma unroll
        for (unsigned j = 0; j < 16; ++j) { const unsigned c = xb_ld(&bar[XB_XCNT(j)]); sum += c; cnt += (c > 0u) ? 1u : 0u; mine = (j == x) ? c : mine; }
        if (sum == G) break;
        __builtin_amdgcn_s_sleep(1);
        if ((++sp & 255u) == 0u) { if (xb_ld(&bar[XB_TMO])) break; if (sp > XB_SPIN_CAP) { atomicAdd(&bar[XB_TMO], 1u); break; } }
    }
    nloc = mine > 0u ? mine : 1u; nx = cnt > 0u ? cnt : 1u;
}
DEV void xcd_barrier(const XcdBarrier& b) {
    asm volatile("s_waitcnt vmcnt(0)" ::: "memory");
    __syncthreads();
    if (threadIdx.x == 0) {
        unsigned* bar = b.bar;
        __builtin_amdgcn_s_waitcnt(0);
        unsigned nloc = b.st[0], nx = b.st[1];
        if (nloc == 0u) { xcd_barrier_complete(bar, b.x, nloc, nx); b.st[0] = nloc; b.st[1] = nx; }
        const unsigned old = xb_add(&bar[XB_XSUB(b.x)], 1u);
        const unsigned gen = old / nloc;
        if (old + 1u == (gen + 1u) * nloc) {
            __builtin_amdgcn_fence(__ATOMIC_RELEASE, "agent");
            asm volatile("s_waitcnt vmcnt(0)" ::: "memory");
            const unsigned og = xb_add(&bar[XB_TOP], 1u);
            const unsigned tg = og / nx;
            if (og + 1u == (tg + 1u) * nx) xb_add(&bar[XB_TOPGEN], 1u);
            else XB_SPIN(xb_ld(&bar[XB_TOPGEN]) == tg, bar);
            __builtin_amdgcn_fence(__ATOMIC_ACQUIRE, "agent");
            xb_add(&bar[XB_XGEN(b.x)], 1u);
            asm volatile("s_waitcnt vmcnt(0)" ::: "memory");
        } else {
            XB_SPIN(xb_ld(&bar[XB_XGEN(b.x)]) == gen, bar);
            __builtin_amdgcn_fence(__ATOMIC_ACQUIRE, "agent");
            asm volatile("s_waitcnt vmcnt(0)" ::: "memory");
        }
    }
    __syncthreads();
}
#endif

namespace pg8 {
constexpr int BM = 256, BK = 64, HALF = 128, HTB = HALF * BK * 2, STAGE_BYTES = 8 * HTB, NXCD = 8, WGM = 8;
__host__ __device__ __forceinline__ int lds_byte(int r, int c) { const int st = (r >> 4) * 2 + (c >> 5), rr = r & 15, cc = c & 31, ob = rr * 64 + cc * 2; return st * 1024 + (ob ^ (((ob >> 9) & 1) << 5)); }
__host__ __device__ __forceinline__ void stage_rc(int b, int& R, int& C) { const int st = b / 1024, sb = b % 1024, swz = sb ^ (((sb >> 9) & 1) << 5); R = (st >> 1) * 16 + swz / 64; C = (st & 1) * 32 + (swz % 64) / 2; }
__host__ __device__ __forceinline__ int perm32(int rho) { const int n = rho >> 4, i = rho & 15; return 8 * (i >> 2) + 4 * n + (i & 3); }
struct Unit { int pm, pn, koff, seg; };
struct Gemm { const bf16* A; const bf16* Bt; int M, N, K, lda, ldb; };
struct StaticOrder {
    int nM, nN, nwg, G, c;
    __host__ __device__ void init(int M, int N, int G_, int c_) { nM = M / BM; nN = N / BM; nwg = nM * nN; G = G_; c = c_; }
    __host__ __device__ bool next(int i, Unit& u) const {
        const long L = (long)i * G + c; if (L >= nwg) return false;
        int wgid = (int)L; { const int q = nwg / NXCD, r = nwg % NXCD, xcd = wgid % NXCD, off = wgid / NXCD; wgid = (xcd < r ? xcd * (q + 1) : r * (q + 1) + (xcd - r) * q) + off; }
        const int nig = WGM * nN, gid = wgid / nig, fm = gid * WGM, gsz = (nM - fm) < WGM ? (nM - fm) : WGM;
        u.pm = fm + ((wgid % nig) % gsz); u.pn = (wgid % nig) / gsz; u.koff = 0; u.seg = 0; return true;
    }
};
struct SegOrder {
    StaticOrder S; int kseg;
    __host__ __device__ void init(int M, int N, int G_, int c_, int kseg_) { S.init(M, N, G_, c_); kseg = kseg_; }
    __host__ __device__ bool next(int i, Unit& u) const { if (!S.next(i >> 2, u)) return false; u.seg = i & 3; u.koff = u.seg * kseg; return true; }
};
#ifndef CPU_EMU
DEV unsigned cvt_pk_bf16(float lo, float hi) { unsigned r; asm volatile("s_nop 1\n\tv_cvt_pk_bf16_f32 %0, %1, %2" : "=v"(r) : "v"(lo), "v"(hi)); return r; }
#endif
DEV unsigned long long rss_fix(float ss) { return (unsigned long long)(ss * 16777216.0f + 0.5f); }
DEV float rss_val(unsigned long long v) { return (float)v * (1.0f / 16777216.0f); }

struct EpiSwiGLU {
    static constexpr bool PERM = true, SEGACC = false;
    bf16* act; const unsigned long long* rss;
    DEV void operator()(const f32x4 (&acc)[2][2][4][2], const Unit& u, int wr, int wc, int fr, int fq) const {
        const int row0 = u.pm * BM + wr * 64 + fr, col0 = u.pn * HALF + wc * 32 + 8 * fq;
        unsigned long long rv[8];
#pragma unroll
        for (int i = 0; i < 8; ++i) rv[i] = rss[row0 + (i >> 2) * HALF + (i & 3) * 16];
        CFENCE();
#pragma unroll
        for (int ai = 0; ai < 2; ++ai)
#pragma unroll
            for (int m = 0; m < 4; ++m) {
                const int row = row0 + ai * HALF + m * 16;
                const float rs = rsqrtf(rss_val(rv[ai * 4 + m]) * (1.0f / DM) + EPS);
                float o[8];
#pragma unroll
                for (int n = 0; n < 2; ++n)
#pragma unroll
                    for (int j = 0; j < 4; ++j) { const float a = acc[ai][0][m][n][j] * rs, b = acc[ai][1][m][n][j] * rs; o[4 * n + j] = a * b * __builtin_amdgcn_rcpf(1.0f + __expf(-a)); }
                u32x4 w; w.x = cvt_pk_bf16(o[0], o[1]); w.y = cvt_pk_bf16(o[2], o[3]); w.z = cvt_pk_bf16(o[4], o[5]); w.w = cvt_pk_bf16(o[6], o[7]);
                *(u32x4*)(act + (size_t)row * DFF + col0) = w;
            }
    }
};
struct EpiResidual {
    static constexpr bool PERM = true, SEGACC = false;
    float* x; bf16* xb; unsigned long long* rss_out; float alpha;
    DEV void operator()(const f32x4 (&acc)[2][2][4][2], const Unit& u, int wr, int wc, int fr, int fq) const {
        const int row0 = u.pm * BM + wr * 64 + fr, col0 = u.pn * BM + wc * 32 + 8 * fq;
#pragma unroll
        for (int ai = 0; ai < 2; ++ai) {
            f32x4 xv[4][2][2];
#pragma unroll
            for (int m = 0; m < 4; ++m)
#pragma unroll
                for (int bj = 0; bj < 2; ++bj) { const float* xp = x + (size_t)(row0 + ai * HALF + m * 16) * DM + col0 + bj * HALF; xv[m][bj][0] = *(const f32x4*)xp; xv[m][bj][1] = *(const f32x4*)(xp + 4); }
            CFENCE();
#pragma unroll
            for (int m = 0; m < 4; ++m) {
                const int row = row0 + ai * HALF + m * 16; float ss = 0.f;
#pragma unroll
                for (int bj = 0; bj < 2; ++bj) {
                    float* xp = x + (size_t)row * DM + col0 + bj * HALF;
                    const f32x4 x0 = xv[m][bj][0] + acc[ai][bj][m][0] * alpha, x1 = xv[m][bj][1] + acc[ai][bj][m][1] * alpha;
                    *(f32x4*)xp = x0; *(f32x4*)(xp + 4) = x1;
                    ss += (x0[0] * x0[0] + x0[1] * x0[1]) + (x0[2] * x0[2] + x0[3] * x0[3]) + (x1[0] * x1[0] + x1[1] * x1[1]) + (x1[2] * x1[2] + x1[3] * x1[3]);
                    u32x4 w; w.x = cvt_pk_bf16(x0[0], x0[1]); w.y = cvt_pk_bf16(x0[2], x0[3]); w.z = cvt_pk_bf16(x1[0], x1[1]); w.w = cvt_pk_bf16(x1[2], x1[3]);
                    *(u32x4*)(xb + (size_t)row * DM + col0 + bj * HALF) = w;
                }
                ss += shx<16>(ss); ss += shx<32>(ss);
                if (fq == 0) atomicAdd(rss_out + row, rss_fix(ss));
            }
            CFENCE();
        }
    }
};
struct EpiWin {
    static constexpr bool PERM = true, SEGACC = false;
    bf16* p1; float* small; bf16* gate; const unsigned long long* rss;
    DEV void operator()(const f32x4 (&acc)[2][2][4][2], const Unit& u, int wr, int wc, int fr, int fq) const {
        const int row0 = u.pm * BM + wr * 64 + fr, cl0 = wc * 32 + 8 * fq;
        unsigned long long rv[8];
#pragma unroll
        for (int i = 0; i < 8; ++i) rv[i] = rss[row0 + (i >> 2) * HALF + (i & 3) * 16];
        CFENCE();
#pragma unroll
        for (int ai = 0; ai < 2; ++ai)
#pragma unroll
            for (int m = 0; m < 4; ++m) {
                const int row = row0 + ai * HALF + m * 16;
                const float rs = rsqrtf(rss_val(rv[ai * 4 + m]) * (1.0f / DM) + EPS);
#pragma unroll
                for (int bj = 0; bj < 2; ++bj) {
                    f32x4 v0 = acc[ai][bj][m][0] * rs, v1 = acc[ai][bj][m][1] * rs;
                    const int cl = cl0 + bj * HALF;
                    if (u.pn < 26) {
                        u32x4 w; w.x = cvt_pk_bf16(v0[0], v0[1]); w.y = cvt_pk_bf16(v0[2], v0[3]); w.z = cvt_pk_bf16(v1[0], v1[1]); w.w = cvt_pk_bf16(v1[2], v1[3]);
                        *(u32x4*)(p1 + (size_t)row * P1W + u.pn * BM + cl) = w;
                    } else if (u.pn == 26) {
                        if (cl < SMW) { float* sp = small + (size_t)row * SMW + cl; *(f32x4*)sp = v0; *(f32x4*)(sp + 4) = v1; }
                    } else {
#pragma unroll
                        for (int j = 0; j < 4; ++j) { v0[j] = fminf(__builtin_amdgcn_rcpf(1.0f + __expf(-v0[j])), 1.0f); v1[j] = fminf(__builtin_amdgcn_rcpf(1.0f + __expf(-v1[j])), 1.0f); }
                        u32x4 w; w.x = cvt_pk_bf16(v0[0], v0[1]); w.y = cvt_pk_bf16(v0[2], v0[3]); w.z = cvt_pk_bf16(v1[0], v1[1]); w.w = cvt_pk_bf16(v1[2], v1[3]);
                        *(u32x4*)(gate + (size_t)row * 6144 + (u.pn - 27) * BM + cl) = w;
                    }
                }
            }
    }
};
struct EpiMergeSeg {
    static constexpr bool PERM = true, SEGACC = true;
    bf16* merged; const bf16* gate; const float* rc;
    DEV void seg(f32x4 (&acc)[2][2][4][2], const Unit& u, int wr, int wc, int fr, int fq) const {
        const int row0 = u.pm * BM + wr * 64 + fr, col0 = u.pn * BM + wc * 32 + 8 * fq, sg = u.seg;
        f32x2 rcv[8];
#pragma unroll
        for (int i = 0; i < 8; ++i) rcv[i] = *(const f32x2*)(rc + (size_t)(row0 + (i >> 2) * HALF + (i & 3) * 16) * 2);
        const int offa = sg == 0 ? 0 : (sg == 1 ? DM : 2 * DM), offb = sg == 0 ? DM : 2 * DM;
#pragma unroll
        for (int aim = 0; aim < 4; ++aim) {
            const int ai = aim >> 1, m0 = (aim & 1) * 2;
            u32x4 wa[2][2], wb[2][2];
            if (sg != 2) {
#pragma unroll
                for (int mm = 0; mm < 2; ++mm)
#pragma unroll
                    for (int bj = 0; bj < 2; ++bj) { const bf16* gp = gate + (size_t)(row0 + ai * HALF + (m0 + mm) * 16) * 6144 + col0 + bj * HALF; wa[mm][bj] = *(const u32x4*)(gp + offa); wb[mm][bj] = *(const u32x4*)(gp + offb); }
            }
            CFENCE();
#pragma unroll
            for (int mm = 0; mm < 2; ++mm) {
                const int m = m0 + mm, row = row0 + ai * HALF + m * 16;
                const float r0 = rcv[ai * 4 + m][0], r1 = rcv[ai * 4 + m][1];
#pragma unroll
                for (int bj = 0; bj < 2; ++bj) {
                    float f[8];
                    if (sg == 2) { const float q = fmaxf(r0, 1e-20f) / fmaxf(r1, 1e-20f);
#pragma unroll
                        for (int j = 0; j < 8; ++j) f[j] = q; }
                    else {
                        const u32x4 a4 = wa[mm][bj], b4 = wb[mm][bj];
                        const float na[8] = {bflo(a4.x), bfhi(a4.x), bflo(a4.y), bfhi(a4.y), bflo(a4.z), bfhi(a4.z), bflo(a4.w), bfhi(a4.w)};
                        const float nb[8] = {bflo(b4.x), bfhi(b4.x), bflo(b4.y), bfhi(b4.y), bflo(b4.z), bfhi(b4.z), bflo(b4.w), bfhi(b4.w)};
#pragma unroll
                        for (int j = 0; j < 8; ++j) {
                            if (sg == 0) f[j] = fmaxf(na[j], 1e-20f) * __builtin_amdgcn_rcpf(fmaxf(nb[j], 1e-20f));
                            else if (sg == 1) f[j] = fmaxf(na[j], 1e-20f) * __builtin_amdgcn_rcpf(fmaxf(nb[j] * r0, 1e-20f));
                            else f[j] = fmaxf(na[j] * r1, 1e-20f); }
                    }
                    f32x4 v0 = acc[ai][bj][m][0], v1 = acc[ai][bj][m][1];
#pragma unroll
                    for (int j = 0; j < 4; ++j) { v0[j] *= f[j]; v1[j] *= f[4 + j]; }
                    if (sg < 3) { acc[ai][bj][m][0] = v0; acc[ai][bj][m][1] = v1; }
                    else { u32x4 o; o.x = cvt_pk_bf16(v0[0], v0[1]); o.y = cvt_pk_bf16(v0[2], v0[3]); o.z = cvt_pk_bf16(v1[0], v1[1]); o.w = cvt_pk_bf16(v1[2], v1[3]);
                        *(u32x4*)(merged + (size_t)row * DM + col0 + bj * HALF) = o; }
                }
            }
            CFENCE();
        }
    }
};

#ifndef CPU_EMU
template <class Epi, class Sched>
DEV void gemm_phase(LAS unsigned char* lds, const int tid, const Gemm g, const Sched& S, const Epi& E) {
    const int wid = __builtin_amdgcn_readfirstlane(tid >> 6), lane = tid & 63, wr = wid >> 2, wc = wid & 3, fr = lane & 15, fq = lane >> 4;
    const int K = g.K, nt = K / BK;
    const float zf_ = opaque_zero();
    unsigned voffA[2], voffB[2];
#pragma unroll
    for (int i = 0; i < 2; ++i) { int R, C; stage_rc(tid * 16 + i * 8192, R, C); const int Rb = Epi::PERM ? ((R & ~31) + perm32(R & 31)) : R;
        voffA[i] = (unsigned)(R * g.lda + C) * 2u; voffB[i] = (unsigned)(Rb * g.ldb + C) * 2u; }
    const size_t kstep = (size_t)(BK * 2);
    const size_t hA = (size_t)HALF * g.lda * 2, hB = (size_t)HALF * g.ldb * 2;
    const size_t tA = 2 * hA, tB = 2 * hB;
    const unsigned ldsw = (unsigned)wid * 1024u;
    const int aoff = lds_byte(wr * 64 + fr, fq * 8), boff = lds_byte(wc * 32 + fr, fq * 8);
#define PG8_SA(b, h) (((b) * 2 + (h)) * HTB)
#define PG8_SB(b, h) ((4 + (b) * 2 + (h)) * HTB)
#define PG8_STAGE(bufoff, gbase, voff) do { _Pragma("unroll") for (int _i = 0; _i < 2; ++_i) \
        __builtin_amdgcn_global_load_lds((const unsigned*)((const char*)(gbase) + (voff)[_i]), (LAS unsigned*)(lds + (bufoff) + ldsw + _i * 8192), 16, 0, 0); } while (0)
#define PG8_LDA(dst, b, h) do { _Pragma("unroll") for (int m = 0; m < 4; ++m) _Pragma("unroll") for (int k = 0; k < 2; ++k) dst[m][k] = *(const LAS bf16x8*)(lds + PG8_SA(b, h) + aoff + m * 2048 + k * 1024); } while (0)
#define PG8_LDB(dst, b, h) do { _Pragma("unroll") for (int n = 0; n < 2; ++n) _Pragma("unroll") for (int k = 0; k < 2; ++k) dst[n][k] = *(const LAS bf16x8*)(lds + PG8_SB(b, h) + boff + n * 2048 + k * 1024); } while (0)
#define PG8_MMA(ai, bj, At, Bt) do { __builtin_amdgcn_s_setprio(1); _Pragma("unroll") for (int m = 0; m < 4; ++m) _Pragma("unroll") for (int n = 0; n < 2; ++n) _Pragma("unroll") for (int k = 0; k < 2; ++k) \
        acc[ai][bj][m][n] = __builtin_amdgcn_mfma_f32_16x16x32_bf16(Bt[n][k], At[m][k], acc[ai][bj][m][n], 0, 0, 0); __builtin_amdgcn_s_setprio(0); } while (0)
#define PG8_WAIT_V(n) asm volatile("s_waitcnt vmcnt(" #n ")" ::: "memory")
#define PG8_WAIT_L(n) asm volatile("s_waitcnt lgkmcnt(" #n ")" ::: "memory")
#define PG8_BAR __builtin_amdgcn_s_barrier()
#define PG8_SCHED __builtin_amdgcn_sched_barrier(0)
    Unit cur, nxt; int ui = 0;
    if (!S.next(0, cur)) return;
    f32x4 acc[2][2][4][2];
#pragma unroll
    for (int a = 0; a < 2; ++a)
#pragma unroll
        for (int b = 0; b < 2; ++b)
#pragma unroll
            for (int m = 0; m < 4; ++m)
#pragma unroll
                for (int n = 0; n < 2; ++n) acc[a][b][m][n] = ZERO4;
    bf16x8 At[4][2], B0[2][2], B1[2][2];
    const char* cA = (const char*)g.A + (size_t)cur.pm * tA + (size_t)cur.koff * 2; const char* cB = (const char*)g.Bt + (size_t)cur.pn * tB + (size_t)cur.koff * 2;
    PG8_STAGE(PG8_SB(0, 0), cB, voffB); PG8_STAGE(PG8_SB(0, 1), cB + hB, voffB); PG8_STAGE(PG8_SA(0, 0), cA, voffA); PG8_STAGE(PG8_SA(0, 1), cA + hA, voffA);
    if (wr == 1) PG8_BAR;
    PG8_WAIT_V(2); PG8_BAR;
    PG8_STAGE(PG8_SB(1, 0), cB + kstep, voffB); PG8_STAGE(PG8_SA(1, 0), cA + kstep, voffA); PG8_STAGE(PG8_SB(1, 1), cB + hB + kstep, voffB);
    PG8_WAIT_V(6); PG8_BAR;
    for (;;) {
        const bool has_next = S.next(ui + 1, nxt);
        const char* nA = has_next ? (const char*)g.A + (size_t)nxt.pm * tA + (size_t)nxt.koff * 2 : cA; const char* nB = has_next ? (const char*)g.Bt + (size_t)nxt.pn * tB + (size_t)nxt.koff * 2 : cB;
        for (int t = 0; t < nt; t += 2) {
            const bool last = (t == nt - 2);
            const char* a1 = cA + (size_t)(t + 1) * kstep;
            const char* a2 = last ? nA : cA + (size_t)(t + 2) * kstep; const char* b2 = last ? nB : cB + (size_t)(t + 2) * kstep;
            const char* a3 = a2 + kstep; const char* b3 = b2 + kstep;
            PG8_LDB(B0, 0, 0); PG8_LDB(B1, 0, 1); PG8_SCHED; PG8_LDA(At, 0, 0); PG8_STAGE(PG8_SA(1, 1), a1 + hA, voffA);
            PG8_WAIT_V(8); PG8_WAIT_L(0); PG8_BAR; PG8_MMA(0, 0, At, B0); PG8_MMA(0, 1, At, B1); PG8_BAR; PG8_SCHED;
            PG8_LDA(At, 0, 1); PG8_STAGE(PG8_SB(0, 0), b2, voffB); PG8_STAGE(PG8_SB(0, 1), b2 + hB, voffB); PG8_STAGE(PG8_SA(0, 0), a2, voffA);
            PG8_WAIT_V(8); PG8_WAIT_L(0); PG8_BAR; PG8_MMA(1, 0, At, B0); PG8_MMA(1, 1, At, B1); PG8_BAR; PG8_SCHED;
            PG8_LDB(B0, 1, 0); PG8_LDB(B1, 1, 1); PG8_SCHED; PG8_LDA(At, 1, 0); PG8_STAGE(PG8_SA(0, 1), a2 + hA, voffA);
            PG8_WAIT_V(8); PG8_WAIT_L(0); PG8_BAR; PG8_MMA(0, 0, At, B0); PG8_MMA(0, 1, At, B1); PG8_BAR; PG8_SCHED;
            PG8_LDA(At, 1, 1); PG8_STAGE(PG8_SB(1, 0), b3, voffB); PG8_STAGE(PG8_SB(1, 1), b3 + hB, voffB); PG8_STAGE(PG8_SA(1, 0), a3, voffA);
            PG8_WAIT_V(8); PG8_WAIT_L(0); PG8_BAR; PG8_MMA(1, 0, At, B0); PG8_MMA(1, 1, At, B1); PG8_BAR; PG8_SCHED;
        }
        if (wr == 0) PG8_BAR;
        if constexpr (Epi::SEGACC) E.seg(acc, cur, wr, wc, fr, fq); else E(acc, cur, wr, wc, fr, fq);
        if (!has_next) break;
        if (!(Epi::SEGACC && nxt.seg != 0)) {
#pragma unroll
        for (int a = 0; a < 2; ++a)
#pragma unroll
            for (int b = 0; b < 2; ++b)
#pragma unroll
                for (int m = 0; m < 4; ++m)
#pragma unroll
                    for (int n = 0; n < 2; ++n) acc[a][b][m][n] = ZERO4;
        }
        cur = nxt; cA = nA; cB = nB; ++ui;
        if (wr == 1) PG8_BAR;
    }
    PG8_WAIT_V(0);
    PG8_BAR;
#undef PG8_SA
#undef PG8_SB
#undef PG8_STAGE
#undef PG8_LDA
#undef PG8_LDB
#undef PG8_MMA
#undef PG8_WAIT_V
#undef PG8_WAIT_L
#undef PG8_BAR
#undef PG8_SCHED
}
#endif
}

#ifndef CPU_EMU
typedef const __attribute__((address_space(4))) Params* KParams;
#else
typedef const Params* KParams;
#endif
struct Frame {
    LAS unsigned char* lds;
    int tid, lane, wave, G, bid;
    KParams p;
    unsigned char* ws;
};
DEV const float* lin(const Frame& F, int idx, int layer, size_t per_layer) { return F.p->in[idx] + (size_t)layer * per_layer; }
#define WSP(T, off) ((T*)(F.ws + (off)))

DEV int up_dest(int n) { return n < DFF ? (n >> 7) * 256 + (n & 127) : ((n - DFF) >> 7) * 256 + 128 + ((n - DFF) & 127); }
DEV int win_dest(int n) {
    if (n < 2048) return n;
    if (n < 2052) return SM0 + S_AA + (n - 2048);
    if (n < 2056) return SM0 + S_AB + (n - 2052);
    if (n < 4104) return C_BQ + (n - 2056);
    if (n < 4116) return SM0 + S_BG + (n - 4104);
    if (n < 6676) return C_CZ + (n - 4116);
    if (n < 6692) return SM0 + S_DT + (n - 6676);
    return GT0 + (n - 6692);
}
struct XItem { const float* W; const float* ks; bf16* WT; int K, N, ldt, koff, mode, r; };
DEV void xitem_load(const XItem& it, int lane, float (&v)[32]) {
    const int nblk = (it.N + 31) / 32, kb = it.r / nblk, nb = it.r % nblk, k0 = 64 * kb, n0 = 32 * nb;
    const int nn = n0 + (lane & 31);
    const float* src = it.W + (size_t)(k0 + (lane >> 5)) * it.N + (nn < it.N ? nn : it.N - 1);
#pragma unroll
    for (int i = 0; i < 32; ++i) v[i] = src[(size_t)(2 * i) * it.N];
}
DEV void xitem_to_lds(LAS float* scr, int lane, const float (&v)[32]) {
#pragma unroll
    for (int i = 0; i < 32; ++i) scr[(2 * i + (lane >> 5)) * 33 + (lane & 31)] = v[i];
    LDS_WAIT(); CFENCE();
}
DEV void xitem_store(const XItem& it, LAS float* scr, int lane) {
    const int nblk = (it.N + 31) / 32, kb = it.r / nblk, nb = it.r % nblk, k0 = 64 * kb, n0 = 32 * nb;
    const int c = lane & 7;
    f32x4 ks0 = (f32x4){1.f, 1.f, 1.f, 1.f}, ks1 = ks0;
    if (it.ks) { ks0 = *(const f32x4*)(it.ks + k0 + 8 * c); ks1 = *(const f32x4*)(it.ks + k0 + 8 * c + 4); }
#pragma unroll
    for (int j = 0; j < 4; ++j) { const int n = (lane >> 3) + 8 * j; const LAS float* s = scr + (8 * c) * 33 + n;
        u32x4 o; o.x = pk2(s[0 * 33] * ks0[0], s[1 * 33] * ks0[1]); o.y = pk2(s[2 * 33] * ks0[2], s[3 * 33] * ks0[3]); o.z = pk2(s[4 * 33] * ks1[0], s[5 * 33] * ks1[1]); o.w = pk2(s[6 * 33] * ks1[2], s[7 * 33] * ks1[3]);
        const int ng = n0 + n;
        if (ng < it.N) { const int dr = it.mode == 0 ? ng : (it.mode == 1 ? up_dest(ng) : win_dest(ng)); *(u32x4*)(it.WT + (size_t)dr * it.ldt + it.koff + k0 + 8 * c) = o; } }
    LDS_WAIT(); CFENCE();
}
constexpr int XI_UP = (DM / 64) * (NUP / 32), XI_DN = (DFF / 64) * (DM / 32), XI_IN = (DM / 64) * ((NIN + 31) / 32), XI_P5 = (512 / 64) * (DM / 32), XI_P10 = (1024 / 64) * (DM / 32), XI_OO = (DM / 64) * (DM / 32), XI_CK = (4096 / 64) * (128 / 32);
constexpr int XI_TOTAL = 2 * XI_UP + 2 * XI_DN + XI_IN + 2 * XI_P5 + XI_P10 + XI_OO + 2 * XI_CK;
DEV XItem xitem_decode(Frame& F, int l, int idx) {
    XItem t; int r = idx; t.ks = nullptr; t.koff = 0; t.mode = 0;
    if (r < XI_UP) { t.W = lin(F, I_WUP1, l, (size_t)DM * NUP); t.K = DM; t.N = NUP; t.WT = WSP(bf16, WS_WUP1); t.ldt = DM; t.ks = lin(F, I_GF1, l, DM); t.mode = 1; }
    else if ((r -= XI_UP) < XI_UP) { t.W = lin(F, I_WUP2, l, (size_t)DM * NUP); t.K = DM; t.N = NUP; t.WT = WSP(bf16, WS_WUP2); t.ldt = DM; t.ks = lin(F, I_GF2, l, DM); t.mode = 1; }
    else if ((r -= XI_UP) < XI_DN) { t.W = lin(F, I_WDN1, l, (size_t)DFF * DM); t.K = DFF; t.N = DM; t.WT = WSP(bf16, WS_WDN1); t.ldt = DFF; }
    else if ((r -= XI_DN) < XI_DN) { t.W = lin(F, I_WDN2, l, (size_t)DFF * DM); t.K = DFF; t.N = DM; t.WT = WSP(bf16, WS_WDN2); t.ldt = DFF; }
    else if ((r -= XI_DN) < XI_IN) { t.W = lin(F, I_WIN, l, (size_t)DM * NIN); t.K = DM; t.N = NIN; t.WT = WSP(bf16, WS_WIN); t.ldt = DM; t.ks = lin(F, I_GMIX, l, DM); t.mode = 2; }
    else if ((r -= XI_IN) < XI_P5) { t.W = lin(F, I_PA, l, (size_t)512 * DM); t.K = 512; t.N = DM; t.WT = WSP(bf16, WS_WPM); t.ldt = DM; }
    else if ((r -= XI_P5) < XI_P5) { t.W = lin(F, I_PB, l, (size_t)512 * DM); t.K = 512; t.N = DM; t.WT = WSP(bf16, WS_WPM); t.ldt = DM; t.koff = 512; }
    else if ((r -= XI_P5) < XI_P10) { t.W = lin(F, I_PC, l, (size_t)1024 * DM); t.K = 1024; t.N = DM; t.WT = WSP(bf16, WS_WPM); t.ldt = DM; t.koff = 1024; t.ks = lin(F, I_SNORM, l, 1024); }
    else if ((r -= XI_P10) < XI_OO) { t.W = lin(F, I_WO, l, (size_t)DM * DM); t.K = DM; t.N = DM; t.WT = WSP(bf16, WS_WO); t.ldt = DM; }
    else if ((r -= XI_OO) < XI_CK) { t.W = lin(F, I_NWCK, l, (size_t)4096 * 128); t.K = 4096; t.N = 128; t.WT = WSP(bf16, WS_WCK); t.ldt = 4096; }
    else { r -= XI_CK; t.W = lin(F, I_NWCV, l, (size_t)4096 * 128); t.K = 4096; t.N = 128; t.WT = WSP(bf16, WS_WCV); t.ldt = 4096; }
    t.r = r; return t;
}
DEV void phase_convert(Frame& F, int l) {
    LAS float* scr = (LAS float*)(F.lds + F.wave * 16384);
    const int gw = F.bid * 8 + F.wave, NGW = F.G * 8;
    if (gw < XI_TOTAL) {
        float v[32]; XItem cur = xitem_decode(F, l, gw); xitem_load(cur, F.lane, v);
        for (int it = gw; it < XI_TOTAL; it += NGW) {
            xitem_to_lds(scr, F.lane, v);
            const bool has_next = it + NGW < XI_TOTAL; XItem nxt = cur;
            if (has_next) { nxt = xitem_decode(F, l, it + NGW); xitem_load(nxt, F.lane, v); }
            xitem_store(cur, scr, F.lane);
            cur = nxt;
        }
    }
    { bf16* w = WSP(bf16, WS_WIN) + (size_t)(SM0 + 36) * DM; const int n16 = (GT0 - SM0 - 36) * DM / 8;
      const unsigned zu = __builtin_bit_cast(unsigned, opaque_zero());
      for (int i = F.bid * 512 + F.tid; i < n16; i += F.G * 512) ((u32x4*)w)[i] = (u32x4){zu, zu, zu, zu}; }
    { const float* pek = lin(F, I_NPEK, l, 4096); const float* pev = lin(F, I_NPEV, l, 4096); float* cst = WSP(float, WS_CONST);
      for (int it = gw; it < 256; it += NGW) { const int e = it & 127; const float* pe = it < 128 ? pek : pev; const float* w = it < 128 ? lin(F, I_NWCK, l, (size_t)4096 * 128) : lin(F, I_NWCV, l, (size_t)4096 * 128); float s = 0.f;
          for (int k = F.lane; k < 4096; k += 64) s += pe[k] * w[(size_t)k * 128 + e];
          s = wave_sum(s); if (F.lane == 0) cst[it] = s; } }
    if (l == 0) {
        const float* x = F.p->in[I_X]; float* out = F.p->out; bf16* xb = WSP(bf16, WS_XB); unsigned long long* rss = WSP(unsigned long long, WS_CTL) + CW_RS / 2;
        for (int m = gw; m < MTOK; m += NGW) {
            const f32x4* xr = (const f32x4*)(x + (size_t)m * DM) + F.lane; f32x4* orow = (f32x4*)(out + (size_t)m * DM) + F.lane; u32x2* br = (u32x2*)(xb + (size_t)m * DM) + F.lane; float ss = 0.f;
#pragma unroll
            for (int j = 0; j < 8; ++j) { const f32x4 v = xr[64 * j]; orow[64 * j] = v; ss += (v[0] * v[0] + v[1] * v[1]) + (v[2] * v[2] + v[3] * v[3]); u32x2 w; w.x = pk2(v[0], v[1]); w.y = pk2(v[2], v[3]); br[64 * j] = w; }
            ss = wave_sum(ss); if (F.lane == 0) rss[m] = pg8::rss_fix(ss);
        }
    }
}

DEV void nsa_prep_job(Frame& F, int l, int job) {
    const int b = job >> 8, g = (job >> 7) & 1, j = job & 127, bg = b * 2 + g, t0 = 64 * j;
    const bf16* p1 = WSP(bf16, WS_P1);
    const float* qn = lin(F, I_NQN, l, 128); const float* kn = lin(F, I_NKN, l, 128);
    bf16* QN = WSP(bf16, WS_QN); bf16* KS = WSP(bf16, WS_KS); bf16* KW = WSP(bf16, WS_KW); bf16* VST = WSP(bf16, WS_VST); bf16* VWT = WSP(bf16, WS_VWT);
    const float gq0 = qn[2 * F.lane], gq1 = qn[2 * F.lane + 1], gk0 = kn[2 * F.lane], gk1 = kn[2 * F.lane + 1];
    unsigned wv[8][4];
#pragma unroll
    for (int i = 0; i < 8; ++i) { const size_t row = (size_t)(b * SEQ + t0 + 8 * F.wave + i) * P1W;
#pragma unroll
        for (int v = 0; v < 4; ++v) { const int col = v < 2 ? C_BQ + (g * 2 + v) * 128 : (v == 2 ? C_BKS + g * 128 : C_BKW + g * 128); wv[i][v] = *(const unsigned*)(p1 + row + col + 2 * F.lane); } }
    CFENCE();
#pragma unroll
    for (int i = 0; i < 8; ++i) {
        const int t = t0 + 8 * F.wave + i;
#pragma unroll
        for (int v = 0; v < 4; ++v) {
            const unsigned w = wv[i][v];
            const float x0 = bflo(w), x1 = bfhi(w);
            const float ss = wave_sum(x0 * x0 + x1 * x1);
            float r = rsqrtf(ss * (1.0f / 128.0f) + EPS);
            unsigned o;
            if (v < 2) { r *= 0.08838834764831845f; o = pk2(x0 * r * gq0, x1 * r * gq1); *(unsigned*)(QN + ((size_t)(bg * SEQ + t) * 2 + v) * 128 + 2 * F.lane) = o; }
            else { o = pk2(x0 * r * gk0, x1 * r * gk1); *(unsigned*)((v == 2 ? KS : KW) + (size_t)(bg * SEQ + t) * 128 + 2 * F.lane) = o; }
        }
    }
    LAS bf16* tl = (LAS bf16*)F.lds;
    for (int i = F.tid; i < 2 * 64 * 64; i += 512) {
        const int v = i >> 12, r = (i >> 6) & 63, c2 = i & 63;
        const unsigned w = *(const unsigned*)(p1 + (size_t)(b * SEQ + t0 + r) * P1W + (v ? C_BVW : C_BVS) + g * 128 + 2 * c2);
        *(LAS unsigned*)(tl + (v * 64 + r) * 130 + 2 * c2) = w;
    }
    __syncthreads();
    for (int i = F.tid; i < 2 * 128 * 8; i += 512) {
        const int v = i >> 10, d = i & 127, tc = (i >> 7) & 7;
        const LAS bf16* s = tl + (v * 64 + 8 * tc) * 130 + d;
        u32x4 o; o.x = s[0] | ((unsigned)s[130] << 16); o.y = s[260] | ((unsigned)s[390] << 16); o.z = s[520] | ((unsigned)s[650] << 16); o.w = s[780] | ((unsigned)s[910] << 16);
        *(u32x4*)((v ? VWT : VST) + ((size_t)(bg * 128 + j) * 128 + d) * 64 + 8 * tc) = o;
    }
    __syncthreads();
}

DEV void gdn_prep_job(Frame& F, int l, int job) {
    const int b = job >> 9, h = (job >> 7) & 3, c = job & 127, t0 = 64 * c;
    const bf16* p1 = WSP(bf16, WS_P1); const float* small = WSP(float, WS_SMALL);
    const float* convw = lin(F, I_GCONV, l, 4 * 1536);
    LAS float* Qs = (LAS float*)F.lds;
    LAS float* Ks = Qs + 64 * 132;
    LAS float* Vs = Ks + 64 * 132;
    LAS float* Mm = Vs + 64 * 132;
    LAS float* At = Mm + 64 * 68;
    LAS float* beta = At + 64 * 68;
    LAS float* gc = beta + 64;
    LAS float* eg = gc + 64;
    const int tid = F.tid;
    {
        const int ch = tid & 127, tg = tid >> 7;
#pragma unroll
        for (int v = 0; v < 3; ++v) {
            const int cc = v * 512 + h * 128 + ch;
            const float w0 = convw[cc], w1 = convw[1536 + cc], w2 = convw[2 * 1536 + cc], w3 = convw[3 * 1536 + cc];
            const int col = (v == 0 ? C_AQ : (v == 1 ? C_AK : C_AV)) + h * 128 + ch;
            float xin[19];
            { const int tt = t0 + 16 * tg;
#pragma unroll
              for (int i = 0; i < 19; ++i) { const int t = tt - 3 + i; xin[i] = t >= 0 ? bf2f(p1[(size_t)(b * SEQ + t) * P1W + col]) : 0.f; } }
            LAS float* dst = v == 0 ? Qs : (v == 1 ? Ks : Vs);
#pragma unroll
            for (int i = 0; i < 16; ++i) {
                const float y = w0 * xin[i] + w1 * xin[i + 1] + w2 * xin[i + 2] + w3 * xin[i + 3];
                dst[(16 * tg + i) * 132 + ch] = siluf_(y);
            }
        }
        if (tid < 64) {
            const size_t row = (size_t)(b * SEQ + t0 + tid);
            const float a = small[row * SMW + S_AA + h], bb = small[row * SMW + S_AB + h];
            beta[tid] = sigmoidf_(bb);
            gc[tid] = -__expf(lin(F, I_GALOG, l, 4)[h]) * softplusf_(a + lin(F, I_GDTB, l, 4)[h]);
        }
    }
    __syncthreads();
    for (int i = 0; i < 16; ++i) {
        const int r = F.wave * 16 + i;
        LAS float* p = (r < 64 ? Qs + r * 132 : Ks + (r - 64) * 132);
        const float x0 = p[F.lane], x1 = p[F.lane + 64];
        const float ss = wave_sum(x0 * x0 + x1 * x1);
        float sc = rsqrtf(ss + EPS); if (r < 64) sc *= 0.08838834764831845f;
        p[F.lane] = x0 * sc; p[F.lane + 64] = x1 * sc;
    }
    if (tid == 0) { float s = 0.f; for (int i = 0; i < 64; ++i) { s += gc[i]; gc[i] = s; eg[i] = __expf(s); } }
    for (int i = tid; i < 64 * 68; i += 512) At[i] = 0.f;
    __syncthreads();
    for (int tj = F.wave; tj < 20; tj += 8) {
        const int kind = tj >= 10 ? 1 : 0, idx = tj - 10 * kind;
        const int mt = idx >= 6 ? 3 : (idx >= 3 ? 2 : (idx >= 1 ? 1 : 0)), nt = idx - mt * (mt + 1) / 2;
        const int fr = F.lane & 15, fq = F.lane >> 4;
        const LAS float* ap = (kind ? Qs : Ks) + (16 * mt + fr) * 132 + 4 * fq; const LAS float* bp = Ks + (16 * nt + fr) * 132 + 4 * fq;
        f32x4 acc = (f32x4){0.f, 0.f, 0.f, 0.f};
#pragma unroll
        for (int sg = 0; sg < 8; ++sg) { const f32x4 a4 = *(const LAS f32x4*)(ap + 16 * sg), b4 = *(const LAS f32x4*)(bp + 16 * sg);
#pragma unroll
            for (int j = 0; j < 4; ++j) acc = __builtin_amdgcn_mfma_f32_16x16x4f32(a4[j], b4[j], acc, 0, 0, 0); }
        const int j = 16 * nt + fr; const float gj = gc[j];
#pragma unroll
        for (int r = 0; r < 4; ++r) { const int i = 16 * mt + 4 * fq + r; const float dec = j <= i ? __expf(gc[i] - gj) : 0.f;
            if (kind) At[i * 68 + j] = acc[r] * dec; else Mm[i * 68 + j] = j < i ? beta[i] * acc[r] * dec : 0.f; }
    }
    __syncthreads();
    unsigned char* cb = F.ws + WS_GW + (size_t)job * GDN_CH_BYTES;
    bf16* gW = (bf16*)cb; bf16* gQD = (bf16*)(cb + 16384); bf16* gKDT = (bf16*)(cb + 32768); bf16* gUT = (bf16*)(cb + 49152); bf16* gAT = (bf16*)(cb + 65536);
    float sol[64];
    if (tid < 256) {
        const int cidx = tid & 127; const bool isw = tid >= 128;
        const LAS float* src = (isw ? Ks : Vs) + cidx;
        const LAS float* MmL = (const LAS float*)lds_vbase(Mm); const LAS float* betaL = (const LAS float*)lds_vbase(beta); const LAS float* egL = (const LAS float*)lds_vbase(eg);
#pragma unroll
        for (int i = 0; i < 64; ++i) sol[i] = 0.f;
#pragma unroll
        for (int i = 0; i < 64; ++i) {
            float r = src[i * 132] * betaL[i] * (isw ? egL[i] : 1.0f), r1 = 0.f, r2 = 0.f, r3 = 0.f;
#pragma unroll
            for (int j4 = 0; j4 < (i + 3) / 4; ++j4) { const f32x4 mv = *(const LAS f32x4*)(MmL + i * 68 + 4 * j4);
                r -= mv[0] * sol[4 * j4]; r1 -= mv[1] * sol[4 * j4 + 1]; r2 -= mv[2] * sol[4 * j4 + 2]; r3 -= mv[3] * sol[4 * j4 + 3]; }
            r = (r + r1) + (r2 + r3);
            sol[i] = r;
            asm volatile("" : "+v"(sol[i]) :: "memory");
        }
    } else {
        const int t2 = tid - 256;
        const float gl = gc[63];
        for (int i = t2; i < 64 * 16; i += 256) { const int r = i >> 4, c8 = (i & 15) * 8; const float e = eg[r]; const LAS float* s = Qs + r * 132 + c8;
            u32x4 o; o.x = pk2(s[0] * e, s[1] * e); o.y = pk2(s[2] * e, s[3] * e); o.z = pk2(s[4] * e, s[5] * e); o.w = pk2(s[6] * e, s[7] * e); *(u32x4*)(gQD + r * 128 + c8) = o; }
        for (int i = t2; i < 128 * 8; i += 256) { const int dk = i & 127, i8 = (i >> 7) * 8; float v[8];
#pragma unroll
            for (int q = 0; q < 8; ++q) v[q] = Ks[(i8 + q) * 132 + dk] * __expf(gl - gc[i8 + q]);
            u32x4 o; o.x = pk2(v[0], v[1]); o.y = pk2(v[2], v[3]); o.z = pk2(v[4], v[5]); o.w = pk2(v[6], v[7]); *(u32x4*)(gKDT + dk * 64 + i8) = o; }
        for (int i = t2; i < 64 * 8; i += 256) { const int r = i >> 3, c8 = (i & 7) * 8; const LAS float* s = At + r * 68 + c8;
            u32x4 o; o.x = pk2(s[0], s[1]); o.y = pk2(s[2], s[3]); o.z = pk2(s[4], s[5]); o.w = pk2(s[6], s[7]); *(u32x4*)(gAT + r * 64 + c8) = o; }
        if (t2 == 0) WSP(float, WS_GL)[job] = __expf(gl);
    }
    __syncthreads();
    LAS bf16* Wl = (LAS bf16*)Qs;
    if (tid < 128) {
#pragma unroll
        for (int q = 0; q < 8; ++q) { u32x4 o; o.x = pk2(sol[8 * q], sol[8 * q + 1]); o.y = pk2(sol[8 * q + 2], sol[8 * q + 3]); o.z = pk2(sol[8 * q + 4], sol[8 * q + 5]); o.w = pk2(sol[8 * q + 6], sol[8 * q + 7]);
            *(u32x4*)(gUT + tid * 64 + 8 * q) = o; }
    } else if (tid < 256) {
#pragma unroll
        for (int i = 0; i < 64; ++i) Wl[i * 136 + (tid - 128)] = (bf16)f2bf(sol[i]);
    }
    __syncthreads();
    for (int i = tid; i < 64 * 16; i += 512) { const int r = i >> 4, c8 = (i & 15) * 8; *(u32x4*)(gW + r * 128 + c8) = *(const LAS u32x4*)(Wl + r * 136 + c8); }
    __syncthreads();
}

DEV void ssd_prep_job(Frame& F, int l, int job) {
    const int b = job >> 7, c = (job >> 1) & 63, g = job & 1, t0 = 128 * c;
    const float zf_ = opaque_zero();
    const bf16* p1 = WSP(bf16, WS_P1); const float* small = WSP(float, WS_SMALL);
    const float* cw = lin(F, I_SCW, l, 4 * 1536); const float* cbias = lin(F, I_SCB, l, 1536);
    bf16* SX = WSP(bf16, WS_SX); float* SDT = WSP(float, WS_SDT); float* SAC = WSP(float, WS_SAC); float* SST = WSP(float, WS_SST); float* SCD = WSP(float, WS_SCD);
    LAS bf16* BT = (LAS bf16*)F.lds;
    LAS bf16* XT = BT + 128 * 136;
    LAS float* dts = (LAS float*)(XT + 64 * 136);
    LAS float* acs = dts + 128 * 8;
    const int tid = F.tid;
    for (int i = tid; i < 1024; i += 512) { const int tl = i >> 3, hh = i & 7, h = 8 * g + hh; const size_t row = (size_t)(b * SEQ + t0 + tl);
        const float dt = softplusf_(small[row * SMW + S_DT + h] + lin(F, I_SDTB, l, 16)[h]);
        dts[i] = dt; acs[i] = dt * (-__expf(lin(F, I_SALOG, l, 16)[h])); }
    __syncthreads();
    if (tid < 8) { float s = 0.f; for (int tl = 0; tl < 128; ++tl) { s += acs[tl * 8 + tid]; acs[tl * 8 + tid] = s; } }
    __syncthreads();
    for (int i = tid; i < 1024; i += 512) { const int tl = i >> 3, hh = i & 7; const size_t row = (size_t)(b * SEQ + t0 + tl); SDT[row * 16 + 8 * g + hh] = dts[i]; SAC[row * 16 + 8 * g + hh] = acs[i]; }
    if (tid < 8) SCD[(size_t)(b * 64 + c) * 16 + 8 * g + tid] = __expf(acs[127 * 8 + tid]);
    {
        const int ch = tid & 255, half = tid >> 8; const int cc = 1024 + (ch < 128 ? g * 128 + ch : 256 + g * 128 + (ch - 128));
        const float w0 = cw[cc], w1 = cw[1536 + cc], w2 = cw[2 * 1536 + cc], w3 = cw[3 * 1536 + cc], bs = cbias[cc];
        const int col = C_CX + cc;
        for (int q = 0; q < 4; ++q) {
            const int ts = t0 + 64 * half + 16 * q; float xin[19];
#pragma unroll
            for (int i = 0; i < 19; ++i) { const int t = ts - 3 + i; xin[i] = t >= 0 ? bf2f(p1[(size_t)(b * SEQ + t) * P1W + col]) : 0.f; }
#pragma unroll
            for (int i = 0; i < 16; ++i) { const int tl = 64 * half + 16 * q + i; const size_t row = (size_t)(b * SEQ + t0 + tl);
                const float y = siluf_(w0 * xin[i] + w1 * xin[i + 1] + w2 * xin[i + 2] + w3 * xin[i + 3] + bs); const bf16 yb = (bf16)f2bf(y);
                SX[row * 1536 + cc] = yb; if (ch < 128) BT[ch * 136 + tl] = yb; }
        }
    }
    for (int hh = 0; hh < 8; ++hh) {
        const int h = 8 * g + hh;
        __syncthreads();
        {
            const int ch = tid & 63, tg = tid >> 6; const int cc = h * 64 + ch;
            const float w0 = cw[cc], w1 = cw[1536 + cc], w2 = cw[2 * 1536 + cc], w3 = cw[3 * 1536 + cc], bs = cbias[cc];
            const int col = C_CX + cc; const int ts = t0 + 16 * tg;
            float xin[19];
#pragma unroll
            for (int i = 0; i < 19; ++i) { const int t = ts - 3 + i; xin[i] = t >= 0 ? bf2f(p1[(size_t)(b * SEQ + t) * P1W + col]) : 0.f; }
            const float al = acs[127 * 8 + hh];
#pragma unroll
            for (int i = 0; i < 16; ++i) { const int tl = 16 * tg + i; const size_t row = (size_t)(b * SEQ + t0 + tl);
                const float y = siluf_(w0 * xin[i] + w1 * xin[i + 1] + w2 * xin[i + 2] + w3 * xin[i + 3] + bs); const bf16 yb = (bf16)f2bf(y);
                SX[row * 1536 + cc] = yb;
                XT[ch * 136 + tl] = (bf16)f2bf(bf2f(yb) * dts[tl * 8 + hh] * __expf(al - acs[tl * 8 + hh])); }
        }
        __syncthreads();
        {
            const int mt = F.wave & 3, nb = (F.wave >> 2) * 4;
            bf16x8 a[4];
#pragma unroll
            for (int ks = 0; ks < 4; ++ks) a[ks] = frag_l(XT, 136, 16 * mt, 32 * ks, F.lane);
            float* dst = SST + ((size_t)((b * 64 + c) * 16 + h) * 64) * 128;
#pragma unroll
            for (int q = 0; q < 4; ++q) { f32x4 acc = ZERO4;
#pragma unroll
                for (int ks = 0; ks < 4; ++ks) acc = mfma16(a[ks], frag_l(BT, 136, 16 * (nb + q), 32 * ks, F.lane), acc);
#pragma unroll
                for (int r = 0; r < 4; ++r) dst[(size_t)(16 * mt + 4 * (F.lane >> 4) + r) * 128 + 16 * (nb + q) + (F.lane & 15)] = acc[r]; }
        }
    }
    __syncthreads();
}

DEV void nsa_compress_job(Frame& F, int l, int job) {
    const int kv = job >> 4, bg = (job >> 2) & 3, rt = job & 3, b = bg >> 1, g = bg & 1, i0 = 128 * rt;
    const float zf_ = opaque_zero();
    const bf16* p1 = WSP(bf16, WS_P1); const bf16* Wt = WSP(bf16, kv ? WS_WCV : WS_WCK); const float* cst = WSP(float, WS_CONST) + kv * 128;
    const int col0 = (kv ? C_BVC : C_BKC) + g * 128;
    LAS bf16* As = (LAS bf16*)F.lds;
    LAS bf16* Bs = As + 128 * 72;
    LAS float* Cs = (LAS float*)(Bs + 128 * 72);
    const int tid = F.tid, wm = F.wave >> 1, wn = F.wave & 1;
    f32x4 acc[2][4];
#pragma unroll
    for (int i = 0; i < 2; ++i)
#pragma unroll
        for (int j = 0; j < 4; ++j) acc[i][j] = ZERO4;
    u32x4 ra[2], rb[2];
#define LOADK(ks_) do { _Pragma("unroll") for (int q = 0; q < 2; ++q) { const int ch = tid + 512 * q, r = ch >> 3, c8 = (ch & 7) * 8; \
            int t = 16 * (i0 + r) + ((ks_) >> 1); if (t > SEQ - 1) t = SEQ - 1;     \
            ra[q] = *(const u32x4*)(p1 + (size_t)(b * SEQ + t) * P1W + col0 + ((ks_) & 1) * 64 + c8); \
            rb[q] = *(const u32x4*)(Wt + (size_t)r * 4096 + 64 * (ks_) + c8); } } while (0)
    LOADK(0);
    for (int ks = 0; ks < 64; ++ks) {
        __syncthreads();
#pragma unroll
        for (int q = 0; q < 2; ++q) { const int ch = tid + 512 * q, r = ch >> 3, c8 = (ch & 7) * 8; *(LAS u32x4*)(As + r * 72 + c8) = ra[q]; *(LAS u32x4*)(Bs + r * 72 + c8) = rb[q]; }
        __syncthreads();
        if (ks + 1 < 64) LOADK(ks + 1);
#pragma unroll
        for (int k2 = 0; k2 < 2; ++k2) {
            bf16x8 a0 = frag_l(As, 72, 32 * wm, 32 * k2, F.lane), a1 = frag_l(As, 72, 32 * wm + 16, 32 * k2, F.lane);
#pragma unroll
            for (int j = 0; j < 4; ++j) { const bf16x8 bb = frag_l(Bs, 72, 64 * wn + 16 * j, 32 * k2, F.lane); acc[0][j] = mfma16(a0, bb, acc[0][j]); acc[1][j] = mfma16(a1, bb, acc[1][j]); }
        }
    }
    __syncthreads();
#pragma unroll
    for (int i = 0; i < 2; ++i)
#pragma unroll
        for (int j = 0; j < 4; ++j)
#pragma unroll
            for (int r = 0; r < 4; ++r) { const int col = 64 * wn + 16 * j + (F.lane & 15); Cs[(32 * wm + 16 * i + 4 * (F.lane >> 4) + r) * 132 + col] = acc[i][j][r] + cst[col]; }
    __syncthreads();
    if (kv == 0) {
        const float* kn = lin(F, I_NKN, l, 128); bf16* KC = WSP(bf16, WS_KCMP);
        const int r = tid >> 2, q = tid & 3; const LAS float* s = Cs + r * 132 + 32 * q; float ss = 0.f;
#pragma unroll
        for (int e = 0; e < 32; ++e) ss += s[e] * s[e];
        ss += shx<1>(ss); ss += shx<2>(ss);
        const float rs = rsqrtf(ss * (1.0f / 128.0f) + EPS);
        bf16* dst = KC + ((size_t)bg * 512 + i0 + r) * 128 + 32 * q;
#pragma unroll
        for (int e = 0; e < 32; e += 2) *(unsigned*)(dst + e) = pk2(s[e] * rs * kn[32 * q + e], s[e + 1] * rs * kn[32 * q + e + 1]);
    } else {
        bf16* VC = WSP(bf16, WS_VCMPT); const int e = tid & 127, q = tid >> 7;
#pragma unroll
        for (int i8 = 0; i8 < 4; ++i8) { const LAS float* s = Cs + (32 * q + 8 * i8) * 132 + e;
            u32x4 o; o.x = pk2(s[0], s[132]); o.y = pk2(s[264], s[396]); o.z = pk2(s[528], s[660]); o.w = pk2(s[792], s[924]);
            *(u32x4*)(VC + ((size_t)bg * 128 + e) * 512 + i0 + 32 * q + 8 * i8) = o; }
    }
    __syncthreads();
}
#undef LOADK

constexpr int AL_KT = 0, AL_VT = 17408, AL_KT1 = 35840, AL_UW = 53248, AL_TB = 54272, AL_SM = 60608, AL_PS = 61696, AL_IMP = 78336, AL_VT1 = 111104, AL_END = 129536;
static_assert(AL_KT1 + 17408 <= AL_UW && AL_UW + 128 <= AL_TB && AL_END <= MISC_OFF, "attention LDS map");
DEV int rel_bucket_dev(int n) {
    if (n < 16) return n;
    int k = 16;
    k += (n >= 21); k += (n >= 27); k += (n >= 35); k += (n >= 46); k += (n >= 59); k += (n >= 77); k += (n >= 99); k += (n >= 128);
    k += (n >= 166); k += (n >= 216); k += (n >= 280); k += (n >= 363); k += (n >= 470); k += (n >= 609); k += (n >= 790);
    return k;
}
DEV void attn_fill_bias(Frame& F, int g) {
    LAS float* tb = (LAS float*)(F.lds + AL_TB); const float* rt = F.p->in[I_REL];
    for (int i = F.tid; i < 2 * 792; i += 512) { const int hg = i / 792, d = i - hg * 792; tb[i] = rt[rel_bucket_dev(d) * 4 + 2 * g + hg]; }
}
DEV void attn_load_tile(u32x4 (&rk)[2], u32x4 (&rv)[2], const bf16* ksrc, const bf16* vsrc, int vpitch, int tid) {
#pragma unroll
    for (int q = 0; q < 2; ++q) { const int ch = tid + 512 * q; rk[q] = *(const u32x4*)(ksrc + (size_t)ch * 8); rv[q] = *(const u32x4*)(vsrc + (size_t)(ch >> 3) * vpitch + (ch & 7) * 8); }
}
DEV void attn_store_tile(LAS unsigned char* lds, int buf, const u32x4 (&rk)[2], const u32x4 (&rv)[2], int tid) {
    LAS bf16* Kt = (LAS bf16*)(lds + (buf ? AL_KT1 : AL_KT)); LAS bf16* Vt = (LAS bf16*)(lds + (buf ? AL_VT1 : AL_VT));
#pragma unroll
    for (int q = 0; q < 2; ++q) { const int ch = tid + 512 * q; *(LAS u32x4*)(Kt + (ch >> 4) * 136 + (ch & 15) * 8) = rk[q]; *(LAS u32x4*)(Vt + (ch >> 3) * 72 + (ch & 7) * 8) = rv[q]; }
}
template <int MODE, int PATH = 0>
DEV unsigned attn_scores(LAS unsigned char* lds, int buf, const bf16x8 (&qf)[4], int lane, int n0, int tok, int hg, unsigned selbit, f32x4 (&s)[4]) {
    const float zf_ = opaque_zero();
    const LAS bf16* Kt = (const LAS bf16*)(lds + (buf ? AL_KT1 : AL_KT)); const LAS float* tb = (const LAS float*)(lds + AL_TB) + hg * 792;
#pragma unroll
    for (int nt = 0; nt < 4; ++nt) { s[nt] = ZERO4;
#pragma unroll
        for (int ks = 0; ks < 4; ++ks) s[nt] = mfma16(frag_l(Kt, 136, 16 * nt, 32 * ks, lane), qf[ks], s[nt]); }
    if (PATH == 1) {
        const float bf = tb[790]; const bool ok = selbit != 0u;
#pragma unroll
        for (int nt = 0; nt < 4; ++nt)
#pragma unroll
            for (int r = 0; r < 4; ++r) s[nt][r] = ok ? s[nt][r] + bf : -1e30f;
        return ok ? 0xffffu : 0u;
    }
    if (PATH == 2) {
        const bool ok = MODE == 2 ? true : (selbit != 0u);
        const LAS float* tp = tb + (tok - n0 - 4 * (lane >> 4));
#pragma unroll
        for (int nt = 0; nt < 4; ++nt)
#pragma unroll
            for (int r = 0; r < 4; ++r) s[nt][r] = ok ? s[nt][r] + tp[-16 * nt - r] : -1e30f;
        return ok ? 0xffffu : 0u;
    }
    unsigned vm = 0u;
#pragma unroll
    for (int nh = 0; nh < 2; ++nh) {
        float bv[8];
#pragma unroll
        for (int q = 0; q < 8; ++q) { const int nt = 2 * nh + (q >> 2), r = q & 3; const int n = n0 + 16 * nt + 4 * (lane >> 4) + r; const int dist = MODE == 0 ? tok - (16 * n + 31) : tok - n;
            int di = dist < 0 ? 0 : dist; di = di > 790 ? 790 : di; bv[q] = tb[di]; }
#pragma unroll
        for (int q = 0; q < 8; ++q) asm volatile("" : "+v"(bv[q]));
#pragma unroll
        for (int q = 0; q < 8; ++q) { const int nt = 2 * nh + (q >> 2), r = q & 3; const int n = n0 + 16 * nt + 4 * (lane >> 4) + r; int dist; bool ok;
            if (MODE == 0) { dist = tok - (16 * n + 31); ok = dist >= 0 && n < 511; }
            else if (MODE == 1) { dist = tok - n; ok = dist >= 0 && selbit != 0u; }
            else { dist = tok - n; ok = dist >= 0 && dist < 512; }
            s[nt][r] = ok ? s[nt][r] + bv[q] : -1e30f;
            vm |= (ok ? 1u : 0u) << (4 * nt + r); }
    }
    return vm;
}
DEV float fq_max(float v) {
    const auto a = __builtin_amdgcn_permlane16_swap(__builtin_bit_cast(unsigned, v), __builtin_bit_cast(unsigned, v), false, false);
    const float m = fmaxf(__builtin_bit_cast(float, a[0]), __builtin_bit_cast(float, a[1]));
    const auto b = __builtin_amdgcn_permlane32_swap(__builtin_bit_cast(unsigned, m), __builtin_bit_cast(unsigned, m), false, false);
    return fmaxf(__builtin_bit_cast(float, b[0]), __builtin_bit_cast(float, b[1]));
}
DEV float fq_sum(float v) {
    const auto a = __builtin_amdgcn_permlane16_swap(__builtin_bit_cast(unsigned, v), __builtin_bit_cast(unsigned, v), false, false);
    const float m = __builtin_bit_cast(float, a[0]) + __builtin_bit_cast(float, a[1]);
    const auto b = __builtin_amdgcn_permlane32_swap(__builtin_bit_cast(unsigned, m), __builtin_bit_cast(unsigned, m), false, false);
    return __builtin_bit_cast(float, b[0]) + __builtin_bit_cast(float, b[1]);
}
DEV float attn_online(const f32x4 (&s)[4], unsigned vm, float& m, float& l, f32x4 (&p)[4]) {
    float mx = fmaxf(fmaxf(fmaxf(s[0][0], s[0][1]), fmaxf(s[0][2], s[0][3])), fmaxf(fmaxf(s[1][0], s[1][1]), fmaxf(s[1][2], s[1][3])));
    mx = fmaxf(mx, fmaxf(fmaxf(fmaxf(s[2][0], s[2][1]), fmaxf(s[2][2], s[2][3])), fmaxf(fmaxf(s[3][0], s[3][1]), fmaxf(s[3][2], s[3][3]))));
    mx = fmaxf(mx, shx<16>(mx)); mx = fmaxf(mx, shx<32>(mx));
    const float mn = fmaxf(m, mx), sc = __expf(m - mn); float rs = 0.f;
#pragma unroll
    for (int nt = 0; nt < 4; ++nt)
#pragma unroll
        for (int r = 0; r < 4; ++r) { const float pv = ((vm >> (4 * nt + r)) & 1u) ? __expf(s[nt][r] - mn) : 0.f; p[nt][r] = pv; rs += pv; }
    rs += shx<16>(rs); rs += shx<32>(rs);
    l = l * sc + rs; m = mn;
    return sc;
}
DEV void attn_pv(LAS unsigned char* lds, int buf, int lane, const f32x4 (&p)[4], f32x4 (&o)[8]) {
    const LAS bf16* Vt = (const LAS bf16*)(lds + (buf ? AL_VT1 : AL_VT)) + (lane & 15) * 72 + 4 * (lane >> 4);
#pragma unroll
    for (int ks = 0; ks < 2; ++ks) {
        u32x4 pw; pw.x = pg8::cvt_pk_bf16(p[2 * ks][0], p[2 * ks][1]); pw.y = pg8::cvt_pk_bf16(p[2 * ks][2], p[2 * ks][3]); pw.z = pg8::cvt_pk_bf16(p[2 * ks + 1][0], p[2 * ks + 1][1]); pw.w = pg8::cvt_pk_bf16(p[2 * ks + 1][2], p[2 * ks + 1][3]);
        const bf16x8 pb = __builtin_bit_cast(bf16x8, pw);
#pragma unroll
        for (int dt = 0; dt < 8; ++dt) {
            const u32x2 v0 = *(const LAS u32x2*)(Vt + 16 * dt * 72 + 32 * ks), v1 = *(const LAS u32x2*)(Vt + 16 * dt * 72 + 32 * ks + 16);
            u32x4 vw; vw.x = v0.x; vw.y = v0.y; vw.z = v1.x; vw.w = v1.y;
            o[dt] = mfma16(__builtin_bit_cast(bf16x8, vw), pb, o[dt]); }
    }
}
DEV void attn_load_q(Frame& F, int bg, int t0, bf16x8 (&qf)[4]) {
    const bf16* QN = WSP(bf16, WS_QN); const int rho = F.lane & 15;
    const bf16* src = QN + ((size_t)(bg * SEQ + t0 + 8 * F.wave + (rho & 7)) * 2 + (rho >> 3)) * 128 + 8 * (F.lane >> 4);
#pragma unroll
    for (int ks = 0; ks < 4; ++ks) qf[ks] = *(const bf16x8*)(src + 32 * ks);
}

DEV void nsa_job(Frame& F, int job) {
    const int bg = job >> 7, qt = job & 127, b = bg >> 1, g = bg & 1, t0 = 64 * qt, tid = F.tid, lane = F.lane, wave = F.wave;
    const float zf_ = opaque_zero();
    const int fq = lane >> 4, fr = lane & 15, hg = fr >> 3, tok = t0 + 8 * wave + (fr & 7);
    const float* small = WSP(float, WS_SMALL); const size_t row = (size_t)(b * SEQ + tok);
    LAS float* PS = (LAS float*)(F.lds + AL_PS) + wave * (8 * 65); LAS float* IMP = (LAS float*)(F.lds + AL_IMP);
    LAS unsigned* SM = (LAS unsigned*)(F.lds + AL_SM);
    LAS unsigned* UW = (LAS unsigned*)(F.lds + AL_UW);
    __syncthreads();
    attn_fill_bias(F, g);
    for (int i = tid; i < 64 * 128; i += 512) IMP[i] = 0.f;
    if (lane < 8) PS[lane * 65] = 0.f;
    bf16x8 qf[4]; attn_load_q(F, bg, t0, qf);
    f32x4 tot[8];
    u32x4 rk[2], rv[2];
    for (int dr_ = 0; dr_ < (DBG_NSA == 1 ? 2 : 1); ++dr_) {
        if (dr_ == 1) { WAVE_SYNC(); if (lane < 8) PS[lane * 65] = 0.f; WAVE_SYNC(); }
        const int ntiles = (4 * qt + 2) / 64 + 1;
        const bf16* KC = WSP(bf16, WS_KCMP) + (size_t)bg * 512 * 128; const bf16* VC = WSP(bf16, WS_VCMPT) + (size_t)bg * 128 * 512;
        float m = -1e30f, l = 0.f;
        attn_load_tile(rk, rv, KC, VC, 512, tid); attn_store_tile(F.lds, 0, rk, rv, tid); __syncthreads();
        for (int j = 0; j < ntiles; ++j) {
            if (j + 1 < ntiles) attn_load_tile(rk, rv, KC + (size_t)(j + 1) * 64 * 128, VC + (j + 1) * 64, 512, tid);
            f32x4 s[4], p[4];
            const unsigned vm = attn_scores<0>(F.lds, j & 1, qf, lane, 64 * j, tok, hg, 0u, s);
            (void)attn_online(s, vm, m, l, p);
            if (j + 1 < ntiles) attn_store_tile(F.lds, (j + 1) & 1, rk, rv, tid);
            __syncthreads();
        }
        const float il = l > 0.f ? 1.0f / l : 0.f;
        f32x4 o[8];
#pragma unroll
        for (int dt = 0; dt < 8; ++dt) o[dt] = ZERO4;
        attn_load_tile(rk, rv, KC, VC, 512, tid); attn_store_tile(F.lds, 0, rk, rv, tid); __syncthreads();
        for (int j = 0; j < ntiles; ++j) {
            if (j + 1 < ntiles) attn_load_tile(rk, rv, KC + (size_t)(j + 1) * 64 * 128, VC + (j + 1) * 64, 512, tid);
            f32x4 s[4], p[4];
            const unsigned vm = attn_scores<0>(F.lds, j & 1, qf, lane, 64 * j, tok, hg, 0u, s);
#pragma unroll
            for (int nt = 0; nt < 4; ++nt)
#pragma unroll
                for (int r = 0; r < 4; ++r) {
                    const float pv = ((vm >> (4 * nt + r)) & 1u) ? __expf(s[nt][r] - m) * il : 0.f; p[nt][r] = pv;
                    const float ps = pv + shx<8>(pv);
                    if (fr < 8) PS[fr * 65 + 1 + 16 * nt + 4 * fq + r] = ps;
                }
            WAVE_SYNC();
#pragma unroll
            for (int q = 0; q < 2; ++q) { const int idx = lane + 64 * q, tk = idx >> 4, bl = idx & 15; const LAS float* ps = PS + tk * 65 + 4 * bl;
                IMP[(8 * wave + tk) * 128 + 16 * j + bl] = ps[0] + 2.0f * ps[1] + 2.0f * ps[2] + 2.0f * ps[3] + ps[4]; }
            WAVE_SYNC();
            if (lane < 8) PS[lane * 65] = PS[lane * 65 + 64];
            WAVE_SYNC();
            attn_pv(F.lds, j & 1, lane, p, o);
            if (j + 1 < ntiles) attn_store_tile(F.lds, (j + 1) & 1, rk, rv, tid);
            __syncthreads();
        }
        const float gt = sigmoidf_(small[row * SMW + S_BG + (2 * g + hg) * 3 + 0]);
#pragma unroll
        for (int dt = 0; dt < 8; ++dt) tot[dt] = o[dt] * gt;
    }
    unsigned wum[4] = {0u, 0u, 0u, 0u};
    for (int dr_ = 0; dr_ < (DBG_NSA == 4 ? 2 : 1); ++dr_) {
        const int cur = qt;
        for (int tk = 0; tk < 8; ++tk) {
            const LAS float* rowp = IMP + (8 * wave + tk) * 128;
            const int b0 = lane, b1 = lane + 64;
            const float s0 = b0 > cur ? -1e4f : ((b0 == 0 || b0 >= cur - 1) ? 1e4f : rowp[b0]);
            const float s1 = b1 > cur ? -1e4f : ((b1 == 0 || b1 >= cur - 1) ? 1e4f : rowp[b1]);
            unsigned k0 = __builtin_bit_cast(unsigned, s0), k1 = __builtin_bit_cast(unsigned, s1);
            k0 = (k0 & 0x80000000u) ? ~k0 : (k0 | 0x80000000u); k1 = (k1 & 0x80000000u) ? ~k1 : (k1 | 0x80000000u);
            unsigned prefix = 0u; int need = 16;
            for (int bit = 31; bit >= 0; --bit) {
                const unsigned cand = (prefix | (1u << bit)) >> bit;
                const int cnt = __builtin_popcountll(__ballot((k0 >> bit) == cand)) + __builtin_popcountll(__ballot((k1 >> bit) == cand));
                if (cnt >= need) prefix |= (1u << bit); else need -= cnt;
            }
            const unsigned long long e0 = __ballot(k0 == prefix), e1 = __ballot(k1 == prefix);
            const int r0 = (int)__builtin_amdgcn_mbcnt_hi((unsigned)(e0 >> 32), __builtin_amdgcn_mbcnt_lo((unsigned)e0, 0u));
            const int r1 = __builtin_popcountll(e0) + (int)__builtin_amdgcn_mbcnt_hi((unsigned)(e1 >> 32), __builtin_amdgcn_mbcnt_lo((unsigned)e1, 0u));
            const bool sel0 = k0 > prefix || (k0 == prefix && r0 < need), sel1 = k1 > prefix || (k1 == prefix && r1 < need);
            const unsigned long long m0 = __ballot(sel0), m1 = __ballot(sel1);
            const unsigned w0 = (unsigned)m0, w1 = (unsigned)(m0 >> 32), w2 = (unsigned)m1, w3 = (unsigned)(m1 >> 32);
            wum[0] |= w0; wum[1] |= w1; wum[2] |= w2; wum[3] |= w3;
            if (lane == 0) { SM[(8 * wave + tk) * 4 + 0] = w0; SM[(8 * wave + tk) * 4 + 1] = w1; SM[(8 * wave + tk) * 4 + 2] = w2; SM[(8 * wave + tk) * 4 + 3] = w3; }
        }
        if (lane == 0) { UW[wave * 4 + 0] = wum[0]; UW[wave * 4 + 1] = wum[1]; UW[wave * 4 + 2] = wum[2]; UW[wave * 4 + 3] = wum[3]; }
    }
    __syncthreads();
    const u32x4 smw = *(const LAS u32x4*)(SM + (8 * wave + (fr & 7)) * 4);
    unsigned um[4];
#pragma unroll
    for (int w = 0; w < 4; ++w) { unsigned v = 0u;
#pragma unroll
        for (int q = 0; q < 8; ++q) v |= UW[q * 4 + w];
        um[w] = __builtin_amdgcn_readfirstlane(v); }
    const bf16* KS = WSP(bf16, WS_KS) + (size_t)bg * SEQ * 128; const bf16* VS = WSP(bf16, WS_VST) + (size_t)bg * 128 * 8192;
    const bf16* KW = WSP(bf16, WS_KW) + (size_t)bg * SEQ * 128; const bf16* VW = WSP(bf16, WS_VWT) + (size_t)bg * 128 * 8192;
    for (int dr_ = 0; dr_ < (DBG_NSA == 2 ? 2 : 1); ++dr_) {
        float m = -1e30f, l = 0.f; f32x4 o[8];
#pragma unroll
        for (int dt = 0; dt < 8; ++dt) o[dt] = ZERO4;
        int j = 0, cb = 0;
        attn_load_tile(rk, rv, KS, VS, 64, tid); attn_store_tile(F.lds, 0, rk, rv, tid); __syncthreads();
        while (j <= qt) {
            int jn = j + 1;
            while (jn <= qt) { const unsigned w = jn < 32 ? um[0] : (jn < 64 ? um[1] : (jn < 96 ? um[2] : um[3])); if ((w >> (jn & 31)) & 1u) break; ++jn; }
            if (jn <= qt) attn_load_tile(rk, rv, KS + (size_t)jn * 64 * 128, VS + (size_t)jn * 128 * 64, 64, tid);
            const unsigned wsel = j < 32 ? wum[0] : (j < 64 ? wum[1] : (j < 96 ? wum[2] : wum[3]));
            if ((wsel >> (j & 31)) & 1u) {
                const unsigned w = j < 32 ? smw.x : (j < 64 ? smw.y : (j < 96 ? smw.z : smw.w)); const unsigned selbit = (w >> (j & 31)) & 1u;
                f32x4 s[4], p[4];
                const unsigned vm = (j <= qt - 14) ? attn_scores<1, 1>(F.lds, cb, qf, lane, 64 * j, tok, hg, selbit, s) : ((j >= qt - 11 && j < qt) ? attn_scores<1, 2>(F.lds, cb, qf, lane, 64 * j, tok, hg, selbit, s) : attn_scores<1, 0>(F.lds, cb, qf, lane, 64 * j, tok, hg, selbit, s));
                const float sc = attn_online(s, vm, m, l, p);
#pragma unroll
                for (int dt = 0; dt < 8; ++dt) o[dt] = o[dt] * sc;
                attn_pv(F.lds, cb, lane, p, o);
            }
            if (jn <= qt) attn_store_tile(F.lds, cb ^ 1, rk, rv, tid);
            __syncthreads();
            cb ^= 1; j = jn;
        }
        const float gt = (DBG_NSA == 2 && dr_ == 0) ? zf_ * l : sigmoidf_(small[row * SMW + S_BG + (2 * g + hg) * 3 + 1]) / l;
#pragma unroll
        for (int dt = 0; dt < 8; ++dt) tot[dt] = tot[dt] + o[dt] * gt;
    }
    for (int dr_ = 0; dr_ < (DBG_NSA == 3 ? 2 : 1); ++dr_) {
        float m = -1e30f, l = 0.f; f32x4 o[8];
#pragma unroll
        for (int dt = 0; dt < 8; ++dt) o[dt] = ZERO4;
        const int j0 = qt >= 8 ? qt - 8 : 0;
        attn_load_tile(rk, rv, KW + (size_t)j0 * 64 * 128, VW + (size_t)j0 * 128 * 64, 64, tid); attn_store_tile(F.lds, 0, rk, rv, tid); __syncthreads();
        for (int j = j0; j <= qt; ++j) {
            const int cb = (j - j0) & 1;
            if (j + 1 <= qt) attn_load_tile(rk, rv, KW + (size_t)(j + 1) * 64 * 128, VW + (size_t)(j + 1) * 128 * 64, 64, tid);
            f32x4 s[4], p[4];
            const unsigned vm = (j >= qt - 7 && j < qt) ? attn_scores<2, 2>(F.lds, cb, qf, lane, 64 * j, tok, hg, 0u, s) : attn_scores<2, 0>(F.lds, cb, qf, lane, 64 * j, tok, hg, 0u, s);
            const float sc = attn_online(s, vm, m, l, p);
#pragma unroll
            for (int dt = 0; dt < 8; ++dt) o[dt] = o[dt] * sc;
            attn_pv(F.lds, cb, lane, p, o);
            if (j + 1 <= qt) attn_store_tile(F.lds, cb ^ 1, rk, rv, tid);
            __syncthreads();
        }
        const float gt = (DBG_NSA == 3 && dr_ == 0) ? zf_ * l : sigmoidf_(small[row * SMW + S_BG + (2 * g + hg) * 3 + 2]) / l;
#pragma unroll
        for (int dt = 0; dt < 8; ++dt) tot[dt] = tot[dt] + o[dt] * gt;
    }
    {
        bf16* YC = WSP(bf16, WS_YCAT);
#pragma unroll
        for (int dt = 0; dt < 8; ++dt) { const int cidx = (2 * g + hg) * 128 + 16 * dt + 4 * fq;
            f32x4 y = tot[dt]; if (DBG_ZERO & 2) y = ZERO4;
            u32x2 w; w.x = pk2(y[0], y[1]); w.y = pk2(y[2], y[3]); *(u32x2*)(YC + row * 2048 + 512 + cidx) = w; }
    }
    __syncthreads();
}

DEV void gdn_scan_job(Frame& F, int job) {
    const int bh = job >> 3, sl = job & 7, b = bh >> 2, h = bh & 3, lane = F.lane, wave = F.wave, fq = lane >> 4, fr = lane & 15;
    LAS bf16* St = (LAS bf16*)F.lds;
    LAS bf16* Vn = St + 16 * 136;
    const float* GL = WSP(float, WS_GL); float* GO = WSP(float, WS_GO);
    const float zf_ = opaque_zero();
    __syncthreads();
    for (int i = F.tid; i < 16 * 136 / 2; i += 512) ((LAS unsigned*)St)[i] = 0u;
    f32x4 S = ZERO4;
    const int mt = wave & 3;
    __syncthreads();
    const int o1 = (wave < 4 ? 0 : 8192) + (16 * mt + fr) * 128 + 8 * fq;
    const int oA = 32768 + (16 * mt + fr) * 64 + 8 * fq;
    const int oK = 16384 + (16 * wave + fr) * 64 + 8 * fq;
    const int oU = 24576 + (16 * sl + fr) * 64 + 16 * mt + 4 * fq;
    const bf16* rec = (const bf16*)(F.ws + WS_GW + (size_t)(bh * 128) * GDN_CH_BYTES);
    bf16x8 a1[4], aA[2], aK[2], n1[4], nA[2], nK[2]; u32x2 uu, nu; float gl, ngl;
#define GLOAD(A1, AA, AK, UU, G, c_) do { const bf16* r_ = rec + (size_t)(c_) * (GDN_CH_BYTES / 2); \
        _Pragma("unroll") for (int ks = 0; ks < 4; ++ks) A1[ks] = *(const bf16x8*)(r_ + o1 + 32 * ks); \
        AA[0] = *(const bf16x8*)(r_ + oA); AA[1] = *(const bf16x8*)(r_ + oA + 32); AK[0] = *(const bf16x8*)(r_ + oK); AK[1] = *(const bf16x8*)(r_ + oK + 32); \
        UU = *(const u32x2*)(r_ + oU); G = GL[bh * 128 + (c_)]; } while (0)
    GLOAD(a1, aA, aK, uu, gl, 0);
    for (int c = 0; c < 128; ++c) {
        const int cn = c + 1 < 128 ? c + 1 : c;
        GLOAD(n1, nA, nK, nu, ngl, cn);
        f32x4 d1 = ZERO4;
#pragma unroll
        for (int ks = 0; ks < 4; ++ks) d1 = mfma16(a1[ks], frag_l(St, 136, 0, 32 * ks, lane), d1);
        if (wave < 4) {
            const float v0 = bflo(uu.x) - d1[0], v1 = bfhi(uu.x) - d1[1], v2 = bflo(uu.y) - d1[2], v3 = bfhi(uu.y) - d1[3];
            u32x2 w; w.x = pk2(v0, v1); w.y = pk2(v2, v3);
            *(LAS u32x2*)(Vn + fr * 72 + 16 * mt + 4 * fq) = w;
        }
        LDS_WAIT(); __builtin_amdgcn_s_barrier(); CFENCE();
        const bf16x8 bv0 = frag_l(Vn, 72, 0, 0, lane), bv1 = frag_l(Vn, 72, 0, 32, lane);
        if (wave >= 4) {
            d1 = mfma16(aA[0], bv0, d1); d1 = mfma16(aA[1], bv1, d1);
#pragma unroll
            for (int r = 0; r < 4; ++r) GO[(size_t)(b * SEQ + 64 * c + 16 * mt + 4 * fq + r) * 512 + h * 128 + 16 * sl + fr] = d1[r];
        }
        f32x4 dk = ZERO4;
        dk = mfma16(aK[0], bv0, dk); dk = mfma16(aK[1], bv1, dk);
        S = S * gl + dk;
        { u32x2 w; w.x = pk2(S[0], S[1]); w.y = pk2(S[2], S[3]); *(LAS u32x2*)(St + fr * 136 + 16 * wave + 4 * fq) = w; }
        LDS_WAIT(); __builtin_amdgcn_s_barrier(); CFENCE();
#pragma unroll
        for (int ks = 0; ks < 4; ++ks) a1[ks] = n1[ks];
        aA[0] = nA[0]; aA[1] = nA[1]; aK[0] = nK[0]; aK[1] = nK[1]; uu = nu; gl = ngl;
    }
#undef GLOAD
    __syncthreads();
}

DEV void ssd_scan_part(Frame& F, int part, int nparts) {
    float* __restrict__ SST = WSP(float, WS_SST); const float* __restrict__ SCD = WSP(float, WS_SCD);
    constexpr int PER_B = 16 * 64 * 128;
    for (int e = part * 512 + F.tid; e < 2 * PER_B; e += nparts * 512) {
        const int b = e / PER_B, r = e - b * PER_B, h = r >> 13;
        float* p = SST + (size_t)(b * 64) * PER_B + r; const float* cdp = SCD + (b * 64) * 16 + h;
        float s = 0.f;
#pragma unroll
        for (int hb = 0; hb < 2; ++hb) {
            float v[32], cd[32];
#pragma unroll
            for (int c = 0; c < 32; ++c) { v[c] = p[(size_t)(32 * hb + c) * PER_B]; cd[c] = cdp[(32 * hb + c) * 16]; }
#pragma unroll
            for (int c = 0; c < 32; ++c) { p[(size_t)(32 * hb + c) * PER_B] = s; s = s * cd[c] + v[c]; }
        }
    }
}

DEV void gdn_final_rows(Frame& F, int l, int w0, int nw) {
    const float* GO = WSP(float, WS_GO); const bf16* p1 = WSP(bf16, WS_P1); bf16* YC = WSP(bf16, WS_YCAT); const float* gn = lin(F, I_GNORM, l, 128);
    const int lane = F.lane, dv0 = (lane & 15) * 8;
    float gv[8];
#pragma unroll
    for (int j = 0; j < 8; ++j) gv[j] = gn[dv0 + j];
    for (int row = w0; row < MTOK; row += nw) {
        const f32x4 a = *(const f32x4*)(GO + (size_t)row * 512 + lane * 8), bq = *(const f32x4*)(GO + (size_t)row * 512 + lane * 8 + 4);
        float ss = (a[0] * a[0] + a[1] * a[1]) + (a[2] * a[2] + a[3] * a[3]) + (bq[0] * bq[0] + bq[1] * bq[1]) + (bq[2] * bq[2] + bq[3] * bq[3]);
        ss = sum16(ss);
        const float rs = rsqrtf(ss * (1.0f / 128.0f) + EPS);
        const u32x4 zw = *(const u32x4*)(p1 + (size_t)row * P1W + C_AZ + lane * 8);
        const float z[8] = {bflo(zw.x), bfhi(zw.x), bflo(zw.y), bfhi(zw.y), bflo(zw.z), bfhi(zw.z), bflo(zw.w), bfhi(zw.w)};
        const float o[8] = {a[0], a[1], a[2], a[3], bq[0], bq[1], bq[2], bq[3]};
        float y[8];
#pragma unroll
        for (int j = 0; j < 8; ++j) y[j] = (DBG_ZERO & 1) ? opaque_zero() : o[j] * rs * gv[j] * siluf_(z[j]);
        u32x4 w; w.x = pk2(y[0], y[1]); w.y = pk2(y[2], y[3]); w.z = pk2(y[4], y[5]); w.w = pk2(y[6], y[7]);
        *(u32x4*)(YC + (size_t)row * 2048 + lane * 8) = w;
    }
}

DEV void ssd_out_job(Frame& F, int l, int job) {
    const int b = job >> 7, c = (job >> 1) & 63, g = job & 1, t0 = 128 * c, tid = F.tid, lane = F.lane, wave = F.wave, fq = lane >> 4, fr = lane & 15;
    const bf16* SX = WSP(bf16, WS_SX); const bf16* p1 = WSP(bf16, WS_P1); const float* SDT = WSP(float, WS_SDT); const float* SAC = WSP(float, WS_SAC); const float* SST = WSP(float, WS_SST);
    bf16* YC = WSP(bf16, WS_YCAT); float* RC = WSP(float, WS_SRC);
    const float zf_ = opaque_zero();
    LAS bf16* Cs = (LAS bf16*)F.lds;
    LAS bf16* Bs = Cs + 128 * 136;
    LAS bf16* XdT = Bs + 128 * 136;
    LAS bf16* SiT = XdT + 64 * 136;
    LAS bf16* Pw = SiT + 64 * 136;
    LAS float* acs = (LAS float*)(Pw + 8 * 16 * 136);
    __syncthreads();
    for (int i = tid; i < 2 * 128 * 16; i += 512) { const int v = i >> 11, r = (i >> 4) & 127, c8 = (i & 15) * 8;
        const u32x4 w = *(const u32x4*)(SX + (size_t)(b * SEQ + t0 + r) * 1536 + 1024 + (v ? 256 : 0) + g * 128 + c8);
        *(LAS u32x4*)((v ? Cs : Bs) + r * 136 + c8) = w; }
    for (int i = tid; i < 1024; i += 512) { const size_t row = (size_t)(b * SEQ + t0 + (i >> 3)); acs[i] = SAC[row * 16 + 8 * g + (i & 7)]; }
    __syncthreads();
    f32x4 cb[8];
    {
        bf16x8 ca[4];
#pragma unroll
        for (int ks = 0; ks < 4; ++ks) ca[ks] = frag_l(Cs, 136, 16 * wave, 32 * ks, lane);
#pragma unroll
        for (int nt = 0; nt < 8; ++nt) { cb[nt] = ZERO4;
#pragma unroll
            for (int ks = 0; ks < 4; ++ks) cb[nt] = mfma16(ca[ks], frag_l(Bs, 136, 16 * nt, 32 * ks, lane), cb[nt]); }
    }
    float ssq[4] = {0.f, 0.f, 0.f, 0.f};
    LAS bf16* pw = Pw + wave * 16 * 136;
    const float* dsk = lin(F, I_SD, l, 16);
    for (int hh = 0; hh < 8; ++hh) {
        const int h = 8 * g + hh;
        __syncthreads();
        for (int i = tid; i < 64 * 128; i += 512) { const int p = i & 63, s = i >> 6;
            XdT[p * 136 + s] = (bf16)f2bf(bf2f(SX[(size_t)(b * SEQ + t0 + s) * 1536 + h * 64 + p]) * SDT[(size_t)(b * SEQ + t0 + s) * 16 + h]); }
        { const float* sin = SST + ((size_t)((b * 64 + c) * 16 + h) * 64) * 128;
          for (int i = tid; i < 64 * 32; i += 512) { const int p = i >> 5, n4 = (i & 31) * 4; const f32x4 v = *(const f32x4*)(sin + p * 128 + n4);
              u32x2 w; w.x = pk2(v[0], v[1]); w.y = pk2(v[2], v[3]); *(LAS u32x2*)(SiT + p * 136 + n4) = w; } }
        float al[4];
#pragma unroll
        for (int r = 0; r < 4; ++r) al[r] = acs[(16 * wave + 4 * fq + r) * 8 + hh];
#pragma unroll
        for (int nt = 0; nt < 8; ++nt) { const int s = 16 * nt + fr; const float as = acs[s * 8 + hh];
#pragma unroll
            for (int r = 0; r < 4; ++r) { const int li = 16 * wave + 4 * fq + r; const float v = s <= li ? cb[nt][r] * __expf(al[r] - as) : 0.f; pw[(4 * fq + r) * 136 + s] = (bf16)f2bf(v); } }
        __syncthreads();
        f32x4 y[4], ys[4];
#pragma unroll
        for (int nt = 0; nt < 4; ++nt) { y[nt] = ZERO4; ys[nt] = ZERO4; }
#pragma unroll
        for (int ks = 0; ks < 4; ++ks) { const bf16x8 pa = frag_l(pw, 136, 0, 32 * ks, lane), cc = frag_l(Cs, 136, 16 * wave, 32 * ks, lane);
#pragma unroll
            for (int nt = 0; nt < 4; ++nt) { y[nt] = mfma16(pa, frag_l(XdT, 136, 16 * nt, 32 * ks, lane), y[nt]); ys[nt] = mfma16(cc, frag_l(SiT, 136, 16 * nt, 32 * ks, lane), ys[nt]); } }
        const float dh = dsk[h];
        unsigned short xv[4][4], zv[4][4];
#pragma unroll
        for (int r = 0; r < 4; ++r) { const size_t row = (size_t)(b * SEQ + t0 + 16 * wave + 4 * fq + r);
#pragma unroll
            for (int nt = 0; nt < 4; ++nt) { xv[r][nt] = SX[row * 1536 + h * 64 + 16 * nt + fr]; zv[r][nt] = p1[row * P1W + C_CZ + h * 64 + 16 * nt + fr]; } }
        CFENCE();
#pragma unroll
        for (int r = 0; r < 4; ++r) { const size_t row = (size_t)(b * SEQ + t0 + 16 * wave + 4 * fq + r); const float ea = __expf(al[r]);
#pragma unroll
            for (int nt = 0; nt < 4; ++nt) { const int p = 16 * nt + fr;
                const float xs = bf2f(xv[r][nt]); const float z = bf2f(zv[r][nt]);
                const float v = (DBG_ZERO & 4) ? zf_ : (y[nt][r] + ea * ys[nt][r] + xs * dh) * siluf_(z);
                ssq[r] += v * v; YC[row * 2048 + 1024 + h * 64 + p] = (bf16)f2bf(v); } }
    }
#pragma unroll
    for (int r = 0; r < 4; ++r) { const float s = sum16(ssq[r]); if (fr == 0) RC[(size_t)(b * SEQ + t0 + 16 * wave + 4 * fq + r) * 2 + g] = rsqrtf(s * (1.0f / 512.0f) + EPS); }
    __syncthreads();
}

constexpr int NPH = 12;
#ifndef CPU_EMU
DEV unsigned long long launder64(unsigned long long v) {
    unsigned lo = __builtin_amdgcn_readfirstlane((unsigned)v), hi = __builtin_amdgcn_readfirstlane((unsigned)(v >> 32));
    asm volatile("" : "+s"(lo), "+s"(hi));
    return ((unsigned long long)hi << 32) | lo;
}
DEV bool phase_begin(Frame& F, const Params& prm, int wave0) {
    F.ws = (unsigned char*)launder64((unsigned long long)prm.ws);
    F.p = (KParams)launder64((unsigned long long)__builtin_amdgcn_kernarg_segment_ptr());
    unsigned z = 0u; asm volatile("" : "+v"(z)); const int ln = (int)__builtin_amdgcn_mbcnt_hi(~0u, __builtin_amdgcn_mbcnt_lo(~0u, z));
    int wv = wave0; asm volatile("" : "+s"(wv)); F.wave = wv; F.lane = ln; F.tid = wv * 64 + ln;
    int bi = __builtin_amdgcn_readfirstlane(blockIdx.x); asm volatile("" : "+s"(bi)); F.bid = bi;
    int gg = __builtin_amdgcn_readfirstlane(gridDim.x); asm volatile("" : "+s"(gg)); F.G = gg;
    unsigned la = __builtin_amdgcn_readfirstlane((unsigned)(size_t)F.lds); asm volatile("" : "+s"(la)); F.lds = (LAS unsigned char*)(size_t)la;
    return true;
}
DEV void job_begin(Frame& F) { int t = F.tid; asm volatile("" : "+v"(t)); F.tid = t; F.lane = t & 63; }
__global__ void __launch_bounds__(512, 2) hybrid_fwd(Params prm) {
    extern __shared__ __attribute__((aligned(16))) unsigned char lds_raw[];
    Frame F;
    F.lds = (LAS unsigned char*)lds_raw; F.tid = threadIdx.x; F.lane = F.tid & 63; F.wave = __builtin_amdgcn_readfirstlane(F.tid >> 6);
    const int wave0 = F.wave;
    F.G = gridDim.x; F.bid = blockIdx.x; F.p = (KParams)__builtin_amdgcn_kernarg_segment_ptr(); F.ws = prm.ws;
    volatile LAS unsigned* MISC = (volatile LAS unsigned*)(F.lds + MISC_OFF);
    if (F.tid < 64) MISC[F.tid] = 0u;
    __syncthreads();
    unsigned* ctl = (unsigned*)(F.ws + WS_CTL);
    XcdBarrier bar; bar.bar = ctl + CW_BAR; bar.x = 0; bar.st = nullptr;
    if (prm.use_bar) bar = xcd_barrier_post(ctl + CW_BAR, MISC + 8);
    const int lo = prm.lo, hi = prm.hi;
    for (int l = 0; l < DEPTH; ++l) {
#define IN(k) (lo <= l * NPH + (k) && l * NPH + (k) < hi && phase_begin(F, prm, wave0))
#define REP_BEGIN(k) for (int rep_ = 0; rep_ < ((DBG_REP == (k)) ? 2 : 1); ++rep_) {
#define REP_END(k) if (DBG_REP == (k) && rep_ == 0) { XcdBarrier bb_ = bar; bb_.bar = (unsigned*)launder64((unsigned long long)bar.bar); xcd_barrier(bb_); } }
#define SEAM(k) do { if (l * NPH + (k) + 1 < hi && prm.use_bar) { XcdBarrier bb_ = bar; bb_.bar = (unsigned*)launder64((unsigned long long)bar.bar); { unsigned x_ = __builtin_amdgcn_readfirstlane(bar.x); asm volatile("" : "+s"(x_)); bb_.x = x_; } xcd_barrier(bb_); } } while (0)
#define RSB(i) (WSP(unsigned long long, WS_CTL) + CW_RS / 2 + (size_t)(3 * l + (i)) * MTOK)
#define XB WSP(bf16, WS_XB)
#define ACT WSP(bf16, WS_ACT)
        if (IN(0)) { REP_BEGIN(0) phase_convert(F, l); REP_END(0) SEAM(0); }
        if (IN(1)) { REP_BEGIN(1) pg8::Gemm g{XB, WSP(bf16, WS_WUP1), MTOK, NUP, DM, DM, DM}; pg8::StaticOrder S; S.init(MTOK, NUP, F.G, F.bid);
            pg8::EpiSwiGLU E{ACT, RSB(0)}; pg8::gemm_phase<pg8::EpiSwiGLU, pg8::StaticOrder>(F.lds, F.tid, g, S, E); REP_END(1) SEAM(1); }
        if (IN(2)) { pg8::Gemm g{ACT, WSP(bf16, WS_WDN1), MTOK, DM, DFF, DFF, DFF}; pg8::StaticOrder S; S.init(MTOK, DM, F.G, F.bid);
            pg8::EpiResidual E{prm.out, XB, RSB(1), 0.5f}; pg8::gemm_phase<pg8::EpiResidual, pg8::StaticOrder>(F.lds, F.tid, g, S, E); SEAM(2); }
        if (IN(3)) { REP_BEGIN(3) pg8::Gemm g{XB, WSP(bf16, WS_WIN), MTOK, NINP, DM, DM, DM}; pg8::StaticOrder S; S.init(MTOK, NINP, F.G, F.bid);
            pg8::EpiWin E{WSP(bf16, WS_P1), WSP(float, WS_SMALL), WSP(bf16, WS_GATE), RSB(1)}; pg8::gemm_phase<pg8::EpiWin, pg8::StaticOrder>(F.lds, F.tid, g, S, E); REP_END(3) SEAM(3); }
        if (IN(4)) {
            REP_BEGIN(4)
            {
                unsigned* ctr = WSP(unsigned, WS_CTL) + CW_WQ + 64 * (8 + l * 2 + rep_);
                LAS unsigned* jslot = (LAS unsigned*)(F.lds + MISC_OFF + 128);
                for (;;) {
                    __syncthreads();
                    if (F.tid == 0) *jslot = __hip_atomic_fetch_add(ctr, 1u, __ATOMIC_RELAXED, __HIP_MEMORY_SCOPE_AGENT);
                    __syncthreads();
                    const int j = (int)*jslot;
                    if (j >= 32 + 1024 + 256 + 512) break;
                    job_begin(F);
                    if (j < 32) nsa_compress_job(F, l, j);
                    else if (j < 32 + 256) ssd_prep_job(F, l, j - 32);
                    else if (j < 32 + 256 + 1024) gdn_prep_job(F, l, j - 32 - 256);
                    else nsa_prep_job(F, l, j - 32 - 256 - 1024);
                }
            }
            REP_END(4)
            SEAM(4);
        }
        if (IN(5)) {
            REP_BEGIN(5)
            if (F.bid < 64) gdn_scan_job(F, (F.bid & 7) * 8 + (F.bid >> 3));
            else if (rep_ == 0) ssd_scan_part(F, F.bid - 64, F.G - 64);
            {
                unsigned* ctr = WSP(unsigned, WS_CTL) + CW_WQ + 64 * (16 + (l * 2 + rep_) * 8);
                LAS unsigned* jslot = (LAS unsigned*)(F.lds + MISC_OFF + 128);
                const unsigned myq = xb_xcc_id() & 7u;
                for (;;) {
                    __syncthreads();
                    if (F.tid == 0) {
                        unsigned got = 0xffffffffu;
                        for (unsigned t = 0; t < 8u && got == 0xffffffffu; ++t) { const unsigned q = (myq + t) & 7u;
                            if (__hip_atomic_load(ctr + 64 * q, __ATOMIC_RELAXED, __HIP_MEMORY_SCOPE_AGENT) >= 64u) continue;
                            const unsigned k = __hip_atomic_fetch_add(ctr + 64 * q, 1u, __ATOMIC_RELAXED, __HIP_MEMORY_SCOPE_AGENT);
                            if (k < 64u) got = (q >> 1) * 128u + (127u - (2u * k + (q & 1u))); }
                        *jslot = got;
                    }
                    __syncthreads();
                    const unsigned j = *jslot;
                    if (j == 0xffffffffu) break;
                    job_begin(F);
                    nsa_job(F, (int)j);
                }
            }
            REP_END(5)
            SEAM(5);
        }
        if (IN(7)) {
            REP_BEGIN(7)
            for (int j = F.bid; j < 256; j += F.G) { job_begin(F); ssd_out_job(F, l, j); }
            job_begin(F);
            gdn_final_rows(F, l, F.bid * 8 + F.wave, F.G * 8);
            REP_END(7)
            SEAM(7);
        }
        if (IN(8)) { REP_BEGIN(8) pg8::Gemm g{WSP(bf16, WS_YCAT), WSP(bf16, WS_WPM), MTOK, DM, 512, DM, DM}; pg8::SegOrder S; S.init(MTOK, DM, F.G, F.bid, 512);
            pg8::EpiMergeSeg E{WSP(bf16, WS_MERGED), WSP(bf16, WS_GATE), WSP(float, WS_SRC)}; pg8::gemm_phase<pg8::EpiMergeSeg, pg8::SegOrder>(F.lds, F.tid, g, S, E); REP_END(8) SEAM(8); }
        if (IN(9)) { pg8::Gemm g{WSP(bf16, WS_MERGED), WSP(bf16, WS_WO), MTOK, DM, DM, DM, DM}; pg8::StaticOrder S; S.init(MTOK, DM, F.G, F.bid);
            pg8::EpiResidual E{prm.out, XB, RSB(2), 1.0f}; pg8::gemm_phase<pg8::EpiResidual, pg8::StaticOrder>(F.lds, F.tid, g, S, E); SEAM(9); }
        if (IN(10)) { pg8::Gemm g{XB, WSP(bf16, WS_WUP2), MTOK, NUP, DM, DM, DM}; pg8::StaticOrder S; S.init(MTOK, NUP, F.G, F.bid);
            pg8::EpiSwiGLU E{ACT, RSB(2)}; pg8::gemm_phase<pg8::EpiSwiGLU, pg8::StaticOrder>(F.lds, F.tid, g, S, E); SEAM(10); }
        if (IN(11)) { pg8::Gemm g{ACT, WSP(bf16, WS_WDN2), MTOK, DM, DFF, DFF, DFF}; pg8::StaticOrder S; S.init(MTOK, DM, F.G, F.bid);
            pg8::EpiResidual E{prm.out, XB, RSB(3), 0.5f}; pg8::gemm_phase<pg8::EpiResidual, pg8::StaticOrder>(F.lds, F.tid, g, S, E); SEAM(11); }
#undef IN
#undef SEAM
#undef REP_BEGIN
#undef REP_END
#undef RSB
#undef XB
#undef ACT
    }
}

#ifndef DBG_DUMP
#define DBG_DUMP 0
#endif
#ifndef DBG_STOP
#define DBG_STOP 48
#endif
__global__ void dbg_dump_bf16(const unsigned short* src, size_t n, float* out, size_t nout) {
    for (size_t i = (size_t)blockIdx.x * blockDim.x + threadIdx.x; i < nout; i += (size_t)gridDim.x * blockDim.x) { float s = 0.f; for (size_t k = i; k < n; k += nout) s += __builtin_bit_cast(float, (unsigned)src[k] << 16); out[i] = s; }
}
__global__ void dbg_dump_f32(const float* src, size_t n, float* out, size_t nout) {
    for (size_t i = (size_t)blockIdx.x * blockDim.x + threadIdx.x; i < nout; i += (size_t)gridDim.x * blockDim.x) { float s = 0.f; for (size_t k = i; k < n; k += nout) s += src[k]; out[i] = s; }
}
#ifndef N_LAUNCH_MODE
#define N_LAUNCH_MODE 0
#endif
extern "C" void kernel_launch(void* const* d_in, const int* in_sizes, int n_in, void* d_out, int out_size, void* d_ws, size_t ws_size, hipStream_t stream) {
    static int grid = 0;
    if (grid == 0) {
        if (n_in != 30 || out_size != MTOK * DM || ws_size < WS_END) { fprintf(stderr, "kernel_launch: unexpected shapes (n_in %d out %d ws %zu, need %zu)\n", n_in, out_size, ws_size, (size_t)WS_END); grid = -1; return; }
        int dev = 0, cus = 0, per_cu = 0;
        if (hipGetDevice(&dev) != hipSuccess || hipDeviceGetAttribute(&cus, hipDeviceAttributeMultiprocessorCount, dev) != hipSuccess) { grid = -1; return; }
        if (hipFuncSetAttribute((const void*)hybrid_fwd, hipFuncAttributeMaxDynamicSharedMemorySize, LDS_BYTES) != hipSuccess) { fprintf(stderr, "kernel_launch: hipFuncSetAttribute failed\n"); grid = -1; return; }
        if (hipOccupancyMaxActiveBlocksPerMultiprocessor(&per_cu, (const void*)hybrid_fwd, 512, LDS_BYTES) != hipSuccess || per_cu < 1) { fprintf(stderr, "kernel_launch: occupancy query says %d\n", per_cu); }
        (void)hipGetLastError();
        grid = cus;
    }
    if (grid < 0) return;
    (void)hipMemsetAsync((char*)d_ws + WS_CTL, 0, CTL_BYTES, stream);
    Params p{};
    for (int i = 0; i < 30; ++i) p.in[i] = (const float*)d_in[i];
    p.out = (float*)d_out; p.ws = (unsigned char*)d_ws; p.pad = 0;
    if (N_LAUNCH_MODE == 0) { p.lo = 0; p.hi = DEPTH * NPH; p.use_bar = 1; hipLaunchKernelGGL(hybrid_fwd, dim3(grid), dim3(512), LDS_BYTES, stream, p); }
    else { for (int ph = 0; ph < (DBG_DUMP ? DBG_STOP : DEPTH * NPH); ++ph) { p.lo = ph; p.hi = ph + 1; p.use_bar = 0; hipLaunchKernelGGL(hybrid_fwd, dim3(grid), dim3(512), LDS_BYTES, stream, p); } }
    if (DBG_DUMP) {
        const size_t nout = (size_t)MTOK * DM; char* w = (char*)d_ws;
        if (DBG_DUMP == 1) hipLaunchKernelGGL(dbg_dump_bf16, dim3(2048), dim3(256), 0, stream, (const unsigned short*)(w + WS_P1), (size_t)MTOK * P1W, (float*)d_out, nout);
        if (DBG_DUMP == 2) hipLaunchKernelGGL(dbg_dump_f32, dim3(2048), dim3(256), 0, stream, (const float*)(w + WS_SMALL), (size_t)MTOK * SMW, (float*)d_out, nout);
        if (DBG_DUMP == 3) hipLaunchKernelGGL(dbg_dump_bf16, dim3(2048), dim3(256), 0, stream, (const unsigned short*)(w + WS_GW), (size_t)1024 * GDN_CH_BYTES / 2, (float*)d_out, nout);
        if (DBG_DUMP == 4) hipLaunchKernelGGL(dbg_dump_f32, dim3(2048), dim3(256), 0, stream, (const float*)(w + WS_SST), (size_t)2 * 64 * 16 * 64 * 128, (float*)d_out, nout);
        if (DBG_DUMP == 5) hipLaunchKernelGGL(dbg_dump_f32, dim3(2048), dim3(256), 0, stream, (const float*)(w + WS_GO), (size_t)MTOK * 512, (float*)d_out, nout);
        if (DBG_DUMP == 6) hipLaunchKernelGGL(dbg_dump_bf16, dim3(2048), dim3(256), 0, stream, (const unsigned short*)(w + WS_YCAT), (size_t)MTOK * 2048, (float*)d_out, nout);
        if (DBG_DUMP == 7) hipLaunchKernelGGL(dbg_dump_bf16, dim3(2048), dim3(256), 0, stream, (const unsigned short*)(w + WS_MERGED), (size_t)MTOK * 2048, (float*)d_out, nout);
        if (DBG_DUMP == 8) hipLaunchKernelGGL(dbg_dump_bf16, dim3(2048), dim3(256), 0, stream, (const unsigned short*)(w + WS_SX), (size_t)MTOK * 1536, (float*)d_out, nout);
        if (DBG_DUMP == 9) hipLaunchKernelGGL(dbg_dump_bf16, dim3(2048), dim3(256), 0, stream, (const unsigned short*)(w + WS_GATE), (size_t)MTOK * 6144, (float*)d_out, nout);
        if (DBG_DUMP == 11) hipLaunchKernelGGL(dbg_dump_f32, dim3(2048), dim3(256), 0, stream, (const float*)(w + WS_SRC), (size_t)MTOK * 2, (float*)d_out, nout);
        if (DBG_DUMP == 12) hipLaunchKernelGGL(dbg_dump_bf16, dim3(2048), dim3(256), 0, stream, (const unsigned short*)(w + WS_WPM), (size_t)DM * DM, (float*)d_out, nout);
        if (DBG_DUMP == 13) hipLaunchKernelGGL(dbg_dump_f32, dim3(2048), dim3(256), 0, stream, (const float*)(w + WS_MTMP), (size_t)MTOK * DM, (float*)d_out, nout);
        if (DBG_DUMP == 15) hipLaunchKernelGGL(dbg_dump_bf16, dim3(2048), dim3(256), 0, stream, (const unsigned short*)(w + WS_ACT), (size_t)MTOK * DFF, (float*)d_out, nout);
        if (DBG_DUMP == 16) hipLaunchKernelGGL(dbg_dump_bf16, dim3(2048), dim3(256), 0, stream, (const unsigned short*)(w + WS_XB), (size_t)MTOK * DM, (float*)d_out, nout);
        if (DBG_DUMP == 17) hipLaunchKernelGGL(dbg_dump_bf16, dim3(2048), dim3(256), 0, stream, (const unsigned short*)(w + WS_WIN), (size_t)NINP * DM, (float*)d_out, nout);
        if (DBG_DUMP == 18) hipLaunchKernelGGL(dbg_dump_f32, dim3(2048), dim3(256), 0, stream, (const float*)(w + WS_CTL) + CW_RS, (size_t)NRS * MTOK, (float*)d_out, nout);
        if (DBG_DUMP == 10) hipLaunchKernelGGL(dbg_dump_f32, dim3(2048), dim3(256), 0, stream, (const float*)(w + WS_YB), (size_t)MTOK * 512, (float*)d_out, nout);
    }
}
#endif
```

```cpp
#include <hip/hip_runtime.h>
#include <cstdio>
#include <cstdint>

#ifndef CPU_EMU
#define DEV __device__ __forceinline__
#define LAS __attribute__((address_space(3)))
#define VM_WAIT() asm volatile("s_waitcnt vmcnt(0)" ::: "memory")
#define LDS_WAIT() asm volatile("s_waitcnt lgkmcnt(0)" ::: "memory")
#define CFENCE() asm volatile("" ::: "memory")
#define WAVE_SYNC() do { asm volatile("" ::: "memory"); __builtin_amdgcn_wave_barrier(); asm volatile("" ::: "memory"); } while (0)
#endif

#define DBG_DUMP 0
#define DBG_NSA 0
#define DBG_REP (-1)
#define DBG_STOP 48
#ifndef DBG_ZERO
#define DBG_ZERO 0
#endif
typedef unsigned short bf16;
typedef short bf16x8 __attribute__((ext_vector_type(8)));
typedef float f32x4 __attribute__((ext_vector_type(4)));
typedef float f32x2 __attribute__((ext_vector_type(2)));
typedef unsigned u32x4 __attribute__((ext_vector_type(4)));
typedef unsigned u32x2 __attribute__((ext_vector_type(2)));

constexpr int BATCH = 2, SEQ = 8192, DM = 2048, DEPTH = 4, DFF = 5504, NUP = 2 * DFF;
constexpr int MTOK = BATCH * SEQ;
constexpr int NIN = 12836, NINP = 13056;
constexpr int P1W = 6656;
constexpr int SM0 = 6656;
constexpr int GT0 = 6912;
constexpr float EPS = 1e-6f;
constexpr int C_AQ = 0, C_AK = 512, C_AV = 1024, C_AZ = 1536, C_BQ = 2048, C_BKC = 2560, C_BVC = 2816, C_BKS = 3072, C_BVS = 3328, C_BKW = 3584, C_BVW = 3840, C_CZ = 4096, C_CX = 5120;
constexpr int S_AA = 0, S_AB = 4, S_BG = 8, S_DT = 20, SMW = 64;

constexpr size_t MiB = 1u << 20;
constexpr size_t WS_CTL = 0, CTL_BYTES = 2 * MiB;
constexpr size_t WS_WUP1 = 2 * MiB;
constexpr size_t WS_WDN1 = WS_WUP1 + (size_t)NUP * DM * 2;
constexpr size_t WS_WIN = WS_WDN1 + (size_t)DM * DFF * 2;
constexpr size_t WS_WPM = WS_WIN + (size_t)NINP * DM * 2;
constexpr size_t WS_WO = WS_WPM + (size_t)DM * DM * 2;
constexpr size_t WS_WUP2 = WS_WO + (size_t)DM * DM * 2;
constexpr size_t WS_WDN2 = WS_WUP2 + (size_t)NUP * DM * 2;
constexpr size_t WS_WCK = WS_WDN2 + (size_t)DM * DFF * 2;
constexpr size_t WS_WCV = WS_WCK + 128 * 4096 * 2;
constexpr size_t WS_CONST = WS_WCV + 128 * 4096 * 2;
constexpr size_t WS_WEND = WS_CONST + 4096;
static_assert(WS_WEND <= 212 * MiB, "weights region");
constexpr size_t WS_XB = 212 * MiB;
constexpr size_t WS_P1 = 276 * MiB;
constexpr size_t WS_ACT = WS_P1;
constexpr size_t WS_GATE = 484 * MiB;
constexpr size_t WS_SMALL = 676 * MiB;
constexpr size_t WS_MERGED = 680 * MiB;
constexpr size_t WS_YCAT = 744 * MiB;
constexpr size_t WS_GW = 808 * MiB;
constexpr size_t GDN_CH_BYTES = 73728;
constexpr size_t WS_GL = 880 * MiB;
constexpr size_t WS_GO = 881 * MiB;
constexpr size_t WS_SX = 913 * MiB;
constexpr size_t WS_SDT = 961 * MiB;
constexpr size_t WS_SAC = 962 * MiB;
constexpr size_t WS_SST = 963 * MiB;
constexpr size_t WS_SCD = 1027 * MiB;
constexpr size_t WS_SRC = 1028 * MiB;
constexpr size_t WS_QN = 1029 * MiB;
constexpr size_t WS_KS = 1045 * MiB;
constexpr size_t WS_KW = 1053 * MiB;
constexpr size_t WS_VST = 1061 * MiB;
constexpr size_t WS_VWT = 1069 * MiB;
constexpr size_t WS_KCMP = 1077 * MiB;
constexpr size_t WS_VCMPT = 1078 * MiB;
constexpr size_t WS_SELM = 1079 * MiB;
constexpr size_t WS_YB = 1080 * MiB;
constexpr size_t WS_MTMP = 1112 * MiB;
constexpr size_t WS_END = 1240 * MiB;
static_assert(WS_P1 + (size_t)MTOK * P1W * 2 <= WS_GATE && WS_GATE + (size_t)MTOK * 6144 * 2 <= WS_SMALL && WS_SMALL + (size_t)MTOK * SMW * 4 <= WS_MERGED && WS_MERGED + (size_t)MTOK * DM * 2 <= WS_YCAT && WS_YCAT + (size_t)MTOK * 2048 * 2 <= WS_GW, "ws map 1");
static_assert(WS_GW + 1024 * GDN_CH_BYTES <= WS_GL && WS_GO + (size_t)MTOK * 512 * 4 <= WS_SX && WS_SX + (size_t)MTOK * 1536 * 2 <= WS_SDT && WS_SDT + (size_t)MTOK * 16 * 4 <= WS_SAC && WS_SAC + (size_t)MTOK * 16 * 4 <= WS_SST && WS_SST + (size_t)2 * 64 * 16 * 64 * 128 * 4 <= WS_SCD, "ws map 2");
static_assert(WS_SRC + (size_t)MTOK * 2 * 4 <= WS_QN && WS_QN + (size_t)4 * SEQ * 256 * 2 <= WS_KS && WS_KS + (size_t)4 * SEQ * 128 * 2 <= WS_KW && WS_KW + (size_t)4 * SEQ * 128 * 2 <= WS_VST && WS_VST + (size_t)4 * SEQ * 128 * 2 <= WS_VWT && WS_VWT + (size_t)4 * SEQ * 128 * 2 <= WS_KCMP, "ws map 3");
static_assert(WS_KCMP + 4 * 512 * 128 * 2 <= WS_VCMPT && WS_VCMPT + 4 * 512 * 128 * 2 <= WS_SELM && WS_SELM + (size_t)4 * SEQ * 16 <= WS_YB && WS_YB + (size_t)MTOK * 512 * 4 <= WS_END && WS_XB + (size_t)MTOK * DM * 2 <= WS_P1 && (size_t)MTOK * DFF * 2 <= (size_t)MTOK * P1W * 2, "ws map 4");

constexpr int CW_BAR = 1024;
constexpr int CW_RS = 16384;
constexpr int NRS = 13;
constexpr int CW_WQ = 8192;
static_assert(CW_RS * 4 + NRS * MTOK * 8 <= (int)CTL_BYTES, "ctl");

constexpr int RING_BYTES = 131072;
constexpr int MISC_OFF = RING_BYTES + 12288;
constexpr int LDS_BYTES = 147456;

DEV unsigned f2bf(float f) { unsigned u = __builtin_bit_cast(unsigned, f); return (u + 0x7fffu + ((u >> 16) & 1u)) >> 16; }
DEV float bf2f(unsigned b) { return __builtin_bit_cast(float, (b & 0xffffu) << 16); }
DEV unsigned pk2(float lo, float hi) { return f2bf(lo) | (f2bf(hi) << 16); }
DEV float bflo(unsigned w) { return __builtin_bit_cast(float, w << 16); }
DEV float bfhi(unsigned w) { return __builtin_bit_cast(float, w & 0xffff0000u); }
DEV float sigmoidf_(float x) { return 1.0f / (1.0f + __expf(-x)); }
DEV float siluf_(float x) { return x / (1.0f + __expf(-x)); }
DEV float softplusf_(float x) {
    const float e = __expf(-fabsf(x)), u = 1.0f + e, d = u - 1.0f;
    const float lp = d == 0.f ? e : __logf(u) * (e / d);
    return fmaxf(x, 0.f) + lp;
}
#ifndef CPU_EMU
template <int M, class T> DEV T shx(T v) {
    static_assert(sizeof(T) == 4, "shx: 32-bit values");
    const int iv = __builtin_bit_cast(int, v);
    if constexpr (M < 32) return __builtin_bit_cast(T, __builtin_amdgcn_ds_swizzle(iv, 0x1f | (M << 10)));
    else { unsigned z = 0u; asm volatile("" : "+v"(z)); const unsigned ln = __builtin_amdgcn_mbcnt_hi(~0u, __builtin_amdgcn_mbcnt_lo(~0u, z));
        return __builtin_bit_cast(T, __builtin_amdgcn_ds_bpermute((int)((ln ^ 32u) << 2), iv)); }
}
#endif
DEV float wave_sum(float v) { v += shx<1>(v); v += shx<2>(v); v += shx<4>(v); v += shx<8>(v); v += shx<16>(v); v += shx<32>(v); return v; }
DEV float sum16(float v) { v += shx<1>(v); v += shx<2>(v); v += shx<4>(v); v += shx<8>(v); return v; }
DEV float max16(float v) { v = fmaxf(v, shx<1>(v)); v = fmaxf(v, shx<2>(v)); v = fmaxf(v, shx<4>(v)); v = fmaxf(v, shx<8>(v)); return v; }
#ifndef CPU_EMU
DEV float opaque_zero() { float z = 0.f; asm volatile("" : "+v"(z)); return z; }
#endif
#define ZERO4 ((f32x4){zf_, zf_, zf_, zf_})
DEV f32x4 mfma16(bf16x8 a, bf16x8 b, f32x4 c) { return __builtin_amdgcn_mfma_f32_16x16x32_bf16(a, b, c, 0, 0, 0); }
DEV bf16x8 frag_g(const bf16* base, int pitch, int row0, int k0, int lane) { return *(const bf16x8*)(base + (size_t)(row0 + (lane & 15)) * pitch + k0 + 8 * (lane >> 4)); }
DEV bf16x8 frag_l(const LAS bf16* base, int pitch, int row0, int k0, int lane) { return *(const LAS bf16x8*)(base + (row0 + (lane & 15)) * pitch + k0 + 8 * (lane >> 4)); }
#ifndef CPU_EMU
DEV const LAS void* lds_vbase(const LAS void* p) { unsigned a = (unsigned)(size_t)p; asm volatile("" : "+v"(a)); return (const LAS void*)(size_t)a; }
#endif

struct Params {
    const float* in[30];
    float* out;
    unsigned char* ws;
    int lo, hi;
    int use_bar, pad;
};
enum { I_X = 0, I_REL, I_GF1, I_WUP1, I_WDN1, I_GMIX, I_WIN, I_GCONV, I_GALOG, I_GDTB, I_GNORM, I_NQN, I_NKN, I_NPEK, I_NPEV, I_NWCK, I_NWCV,
       I_SCW, I_SCB, I_SDTB, I_SALOG, I_SD, I_SNORM, I_PA, I_PB, I_PC, I_WO, I_GF2, I_WUP2, I_WDN2 };

#define XB_TMO      128
#define XB_XCNT(j)  (256  + 64 * (j))
#define XB_XSUB(j)  (1280 + 64 * (j))
#define XB_XGEN(j)  (2304 + 64 * (j))
#define XB_TOP      3328
#define XB_TOPGEN   3392
#define XCD_BAR_WORDS 3456
#define XB_SPIN_CAP (1u << 22)
#ifndef CPU_EMU
DEV unsigned xb_ld(unsigned* p)              { return __hip_atomic_load(p, __ATOMIC_RELAXED, __HIP_MEMORY_SCOPE_AGENT); }
DEV unsigned xb_add(unsigned* p, unsigned v) { return __hip_atomic_fetch_add(p, v, __ATOMIC_RELAXED, __HIP_MEMORY_SCOPE_AGENT); }
DEV unsigned xb_xcc_id() { return (unsigned)__builtin_amdgcn_s_getreg((3 << 11) | 20) & 0xFu; }
#define XB_SPIN(cond, bar) do { unsigned _sp = 0; while (cond) { __builtin_amdgcn_s_sleep(1); \
    if ((++_sp & 255u) == 0u) { if (xb_ld(&(bar)[XB_TMO])) break; if (_sp > XB_SPIN_CAP) { atomicAdd(&(bar)[XB_TMO], 1u); break; } } } } while (0)
struct XcdBarrier { unsigned* bar; unsigned x; volatile LAS unsigned* st; };
DEV XcdBarrier xcd_barrier_post(unsigned* bar, volatile LAS unsigned* st) {
    XcdBarrier b; b.bar = bar; b.x = xb_xcc_id(); b.st = st;
    if (threadIdx.x == 0) (void)xb_add(&bar[XB_XCNT(b.x)], 1u);
    return b;
}
DEV void xcd_barrier_complete(unsigned* bar, unsigned x, unsigned& nloc, unsigned& nx) {
    const unsigned G = gridDim.x * gridDim.y * gridDim.z;
    unsigned sum, cnt, mine, sp = 0u;
    for (;;) {
        sum = 0u; cnt = 0u; mine = 0u;
#pragma unroll
        for (unsigned j = 0; j < 16; ++j) { const unsigned c = xb_ld(&bar[XB_XCNT(j)]); sum += c; cnt += (c > 0u) ? 1u : 0u; mine = (j == x) ? c : mine; }
        if (sum == G) break;
        __builtin_amdgcn_s_sleep(1);
        if ((++sp & 255u) == 0u) { if (xb_ld(&bar[XB_TMO])) break; if (sp > XB_SPIN_CAP) { atomicAdd(&bar[XB_TMO], 1u); break; } }
    }
    nloc = mine > 0u ? mine : 1u; nx = cnt > 0u ? cnt : 1u;
}
DEV void xcd_barrier(const XcdBarrier& b) {
    asm volatile("s_waitcnt vmcnt(0)" ::: "memory");
    __syncthreads();
    if (threadIdx.x == 0) {
        unsigned* bar = b.bar;
        __builtin_amdgcn_s_waitcnt(0);
        unsigned nloc = b.st[0], nx = b.st[1];
        if (nloc == 0u) { xcd_barrier_complete(bar, b.x, nloc, nx); b.st[0] = nloc; b.st[1] = nx; }
        const unsigned old = xb_add(&bar[XB_XSUB(b.x)], 1u);
        const unsigned gen = old / nloc;
        if (old + 1u == (gen + 1u) * nloc) {
            __builtin_amdgcn_fence(__ATOMIC_RELEASE, "agent");
            asm volatile("s_waitcnt vmcnt(0)" ::: "memory");
            const unsigned og = xb_add(&bar[XB_TOP], 1u);
            const unsigned tg = og / nx;
            if (og + 1u == (tg + 1u) * nx) xb_add(&bar[XB_TOPGEN], 1u);
            else XB_SPIN(xb_ld(&bar[XB_TOPGEN]) == tg, bar);
            __builtin_amdgcn_fence(__ATOMIC_ACQUIRE, "agent");
            xb_add(&bar[XB_XGEN(b.x)], 1u);
            asm volatile("s_waitcnt vmcnt(0)" ::: "memory");
        } else {
            XB_SPIN(xb_ld(&bar[XB_XGEN(b.x)]) == gen, bar);
            __builtin_amdgcn_fence(__ATOMIC_ACQUIRE, "agent");
            asm volatile("s_waitcnt vmcnt(0)" ::: "memory");
        }
    }
    __syncthreads();
}
#endif

namespace pg8 {
constexpr int BM = 256, BK = 64, HALF = 128, HTB = HALF * BK * 2, STAGE_BYTES = 8 * HTB, NXCD = 8, WGM = 8;
__host__ __device__ __forceinline__ int lds_byte(int r, int c) { const int st = (r >> 4) * 2 + (c >> 5), rr = r & 15, cc = c & 31, ob = rr * 64 + cc * 2; return st * 1024 + (ob ^ (((ob >> 9) & 1) << 5)); }
__host__ __device__ __forceinline__ void stage_rc(int b, int& R, int& C) { const int st = b / 1024, sb = b % 1024, swz = sb ^ (((sb >> 9) & 1) << 5); R = (st >> 1) * 16 + swz / 64; C = (st & 1) * 32 + (swz % 64) / 2; }
__host__ __device__ __forceinline__ int perm32(int rho) { const int n = rho >> 4, i = rho & 15; return 8 * (i >> 2) + 4 * n + (i & 3); }
struct Unit { int pm, pn, koff, seg; };
struct Gemm { const bf16* A; const bf16* Bt; int M, N, K, lda, ldb; };
struct StaticOrder {
    int nM, nN, nwg, G, c;
    __host__ __device__ void init(int M, int N, int G_, int c_) { nM = M / BM; nN = N / BM; nwg = nM * nN; G = G_; c = c_; }
    __host__ __device__ bool next(int i, Unit& u) const {
        const long L = (long)i * G + c; if (L >= nwg) return false;
        int wgid = (int)L; { const int q = nwg / NXCD, r = nwg % NXCD, xcd = wgid % NXCD, off = wgid / NXCD; wgid = (xcd < r ? xcd * (q + 1) : r * (q + 1) + (xcd - r) * q) + off; }
        const int nig = WGM * nN, gid = wgid / nig, fm = gid * WGM, gsz = (nM - fm) < WGM ? (nM - fm) : WGM;
        u.pm = fm + ((wgid % nig) % gsz); u.pn = (wgid % nig) / gsz; u.koff = 0; u.seg = 0; return true;
    }
};
struct SegOrder {
    StaticOrder S; int kseg;
    __host__ __device__ void init(int M, int N, int G_, int c_, int kseg_) { S.init(M, N, G_, c_); kseg = kseg_; }
    __host__ __device__ bool next(int i, Unit& u) const { if (!S.next(i >> 2, u)) return false; u.seg = i & 3; u.koff = u.seg * kseg; return true; }
};
#ifndef CPU_EMU
DEV unsigned cvt_pk_bf16(float lo, float hi) { unsigned r; asm volatile("s_nop 1\n\tv_cvt_pk_bf16_f32 %0, %1, %2" : "=v"(r) : "v"(lo), "v"(hi)); return r; }
#endif
DEV unsigned long long rss_fix(float ss) { return (unsigned long long)(ss * 16777216.0f + 0.5f); }
DEV float rss_val(unsigned long long v) { return (float)v * (1.0f / 16777216.0f); }

struct EpiSwiGLU {
    static constexpr bool PERM = true, SEGACC = false;
    bf16* act; const unsigned long long* rss;
    DEV void operator()(const f32x4 (&acc)[2][2][4][2], const Unit& u, int wr, int wc, int fr, int fq) const {
        const int row0 = u.pm * BM + wr * 64 + fr, col0 = u.pn * HALF + wc * 32 + 8 * fq;
        unsigned long long rv[8];
#pragma unroll
        for (int i = 0; i < 8; ++i) rv[i] = rss[row0 + (i >> 2) * HALF + (i & 3) * 16];
        CFENCE();
#pragma unroll
        for (int ai = 0; ai < 2; ++ai)
#pragma unroll
            for (int m = 0; m < 4; ++m) {
                const int row = row0 + ai * HALF + m * 16;
                const float rs = rsqrtf(rss_val(rv[ai * 4 + m]) * (1.0f / DM) + EPS);
                float o[8];
#pragma unroll
                for (int n = 0; n < 2; ++n)
#pragma unroll
                    for (int j = 0; j < 4; ++j) { const float a = acc[ai][0][m][n][j] * rs, b = acc[ai][1][m][n][j] * rs; o[4 * n + j] = a * b * __builtin_amdgcn_rcpf(1.0f + __expf(-a)); }
                u32x4 w; w.x = cvt_pk_bf16(o[0], o[1]); w.y = cvt_pk_bf16(o[2], o[3]); w.z = cvt_pk_bf16(o[4], o[5]); w.w = cvt_pk_bf16(o[6], o[7]);
                *(u32x4*)(act + (size_t)row * DFF + col0) = w;
            }
    }
};
struct EpiResidual {
    static constexpr bool PERM = true, SEGACC = false;
    float* x; bf16* xb; unsigned long long* rss_out; float alpha;
    DEV void operator()(const f32x4 (&acc)[2][2][4][2], const Unit& u, int wr, int wc, int fr, int fq) const {
        const int row0 = u.pm * BM + wr * 64 + fr, col0 = u.pn * BM + wc * 32 + 8 * fq;
#pragma unroll
        for (int aim = 0; aim < 4; ++aim) {
            const int ai = aim >> 1, m0 = (aim & 1) * 2;
            f32x4 xv[2][2][2];
#pragma unroll
            for (int mm = 0; mm < 2; ++mm)
#pragma unroll
                for (int bj = 0; bj < 2; ++bj) { const float* xp = x + (size_t)(row0 + ai * HALF + (m0 + mm) * 16) * DM + col0 + bj * HALF; xv[mm][bj][0] = *(const f32x4*)xp; xv[mm][bj][1] = *(const f32x4*)(xp + 4); }
            CFENCE();
#pragma unroll
            for (int mm = 0; mm < 2; ++mm) {
                const int m = m0 + mm, row = row0 + ai * HALF + m * 16; float ss = 0.f;
#pragma unroll
                for (int bj = 0; bj < 2; ++bj) {
                    float* xp = x + (size_t)row * DM + col0 + bj * HALF;
                    const f32x4 x0 = xv[mm][bj][0] + acc[ai][bj][m][0] * alpha, x1 = xv[mm][bj][1] + acc[ai][bj][m][1] * alpha;
                    *(f32x4*)xp = x0; *(f32x4*)(xp + 4) = x1;
                    ss += (x0[0] * x0[0] + x0[1] * x0[1]) + (x0[2] * x0[2] + x0[3] * x0[3]) + (x1[0] * x1[0] + x1[1] * x1[1]) + (x1[2] * x1[2] + x1[3] * x1[3]);
                    u32x4 w; w.x = cvt_pk_bf16(x0[0], x0[1]); w.y = cvt_pk_bf16(x0[2], x0[3]); w.z = cvt_pk_bf16(x1[0], x1[1]); w.w = cvt_pk_bf16(x1[2], x1[3]);
                    *(u32x4*)(xb + (size_t)row * DM + col0 + bj * HALF) = w;
                }
                ss += shx<16>(ss); ss += shx<32>(ss);
                if (fq == 0) atomicAdd(rss_out + row, rss_fix(ss));
            }
            CFENCE();
        }
    }
};
struct EpiWin {
    static constexpr bool PERM = true, SEGACC = false;
    bf16* p1; float* small; bf16* gate; const unsigned long long* rss;
    DEV void operator()(const f32x4 (&acc)[2][2][4][2], const Unit& u, int wr, int wc, int fr, int fq) const {
        const int row0 = u.pm * BM + wr * 64 + fr, cl0 = wc * 32 + 8 * fq;
        unsigned long long rv[8];
#pragma unroll
        for (int i = 0; i < 8; ++i) rv[i] = rss[row0 + (i >> 2) * HALF + (i & 3) * 16];
        CFENCE();
#pragma unroll
        for (int ai = 0; ai < 2; ++ai)
#pragma unroll
            for (int m = 0; m < 4; ++m) {
                const int row = row0 + ai * HALF + m * 16;
                const float rs = rsqrtf(rss_val(rv[ai * 4 + m]) * (1.0f / DM) + EPS);
#pragma unroll
                for (int bj = 0; bj < 2; ++bj) {
                    f32x4 v0 = acc[ai][bj][m][0] * rs, v1 = acc[ai][bj][m][1] * rs;
                    const int cl = cl0 + bj * HALF;
                    if (u.pn < 26) {
                        u32x4 w; w.x = cvt_pk_bf16(v0[0], v0[1]); w.y = cvt_pk_bf16(v0[2], v0[3]); w.z = cvt_pk_bf16(v1[0], v1[1]); w.w = cvt_pk_bf16(v1[2], v1[3]);
                        *(u32x4*)(p1 + (size_t)row * P1W + u.pn * BM + cl) = w;
                    } else if (u.pn == 26) {
                        if (cl < SMW) { float* sp = small + (size_t)row * SMW + cl; *(f32x4*)sp = v0; *(f32x4*)(sp + 4) = v1; }
                    } else {
#pragma unroll
                        for (int j = 0; j < 4; ++j) { v0[j] = fminf(__builtin_amdgcn_rcpf(1.0f + __expf(-v0[j])), 1.0f); v1[j] = fminf(__builtin_amdgcn_rcpf(1.0f + __expf(-v1[j])), 1.0f); }
                        u32x4 w; w.x = cvt_pk_bf16(v0[0], v0[1]); w.y = cvt_pk_bf16(v0[2], v0[3]); w.z = cvt_pk_bf16(v1[0], v1[1]); w.w = cvt_pk_bf16(v1[2], v1[3]);
                        *(u32x4*)(gate + (size_t)row * 6144 + (u.pn - 27) * BM + cl) = w;
                    }
                }
            }
    }
};
struct EpiMergeSeg {
    static constexpr bool PERM = true, SEGACC = true;
    bf16* merged; const bf16* gate; const float* rc;
    DEV void seg(f32x4 (&acc)[2][2][4][2], const Unit& u, int wr, int wc, int fr, int fq) const {
        const int row0 = u.pm * BM + wr * 64 + fr, col0 = u.pn * BM + wc * 32 + 8 * fq, sg = u.seg;
        f32x2 rcv[8];
#pragma unroll
        for (int i = 0; i < 8; ++i) rcv[i] = *(const f32x2*)(rc + (size_t)(row0 + (i >> 2) * HALF + (i & 3) * 16) * 2);
        const int offa = sg == 0 ? 0 : (sg == 1 ? DM : 2 * DM), offb = sg == 0 ? DM : 2 * DM;
#pragma unroll
        for (int aim = 0; aim < 4; ++aim) {
            const int ai = aim >> 1, m0 = (aim & 1) * 2;
            u32x4 wa[2][2], wb[2][2];
            if (sg != 2) {
#pragma unroll
                for (int mm = 0; mm < 2; ++mm)
#pragma unroll
                    for (int bj = 0; bj < 2; ++bj) { const bf16* gp = gate + (size_t)(row0 + ai * HALF + (m0 + mm) * 16) * 6144 + col0 + bj * HALF; wa[mm][bj] = *(const u32x4*)(gp + offa); wb[mm][bj] = *(const u32x4*)(gp + offb); }
            }
            CFENCE();
#pragma unroll
            for (int mm = 0; mm < 2; ++mm) {
                const int m = m0 + mm, row = row0 + ai * HALF + m * 16;
                const float r0 = rcv[ai * 4 + m][0], r1 = rcv[ai * 4 + m][1];
#pragma unroll
                for (int bj = 0; bj < 2; ++bj) {
                    float f[8];
                    if (sg == 2) { const float q = fmaxf(r0, 1e-20f) / fmaxf(r1, 1e-20f);
#pragma unroll
                        for (int j = 0; j < 8; ++j) f[j] = q; }
                    else {
                        const u32x4 a4 = wa[mm][bj], b4 = wb[mm][bj];
                        const float na[8] = {bflo(a4.x), bfhi(a4.x), bflo(a4.y), bfhi(a4.y), bflo(a4.z), bfhi(a4.z), bflo(a4.w), bfhi(a4.w)};
                        const float nb[8] = {bflo(b4.x), bfhi(b4.x), bflo(b4.y), bfhi(b4.y), bflo(b4.z), bfhi(b4.z), bflo(b4.w), bfhi(b4.w)};
#pragma unroll
                        for (int j = 0; j < 8; ++j) {
                            if (sg == 0) f[j] = fmaxf(na[j], 1e-20f) * __builtin_amdgcn_rcpf(fmaxf(nb[j], 1e-20f));
                            else if (sg == 1) f[j] = fmaxf(na[j], 1e-20f) * __builtin_amdgcn_rcpf(fmaxf(nb[j] * r0, 1e-20f));
                            else f[j] = fmaxf(na[j] * r1, 1e-20f); }
                    }
                    f32x4 v0 = acc[ai][bj][m][0], v1 = acc[ai][bj][m][1];
#pragma unroll
                    for (int j = 0; j < 4; ++j) { v0[j] *= f[j]; v1[j] *= f[4 + j]; }
                    if (sg < 3) { acc[ai][bj][m][0] = v0; acc[ai][bj][m][1] = v1; }
                    else { u32x4 o; o.x = cvt_pk_bf16(v0[0], v0[1]); o.y = cvt_pk_bf16(v0[2], v0[3]); o.z = cvt_pk_bf16(v1[0], v1[1]); o.w = cvt_pk_bf16(v1[2], v1[3]);
                        *(u32x4*)(merged + (size_t)row * DM + col0 + bj * HALF) = o; }
                }
            }
            CFENCE();
        }
    }
};

#ifndef CPU_EMU
template <class Epi, class Sched>
DEV void gemm_phase(LAS unsigned char* lds, const int tid, const Gemm g, const Sched& S, const Epi& E) {
    const int wid = __builtin_amdgcn_readfirstlane(tid >> 6), lane = tid & 63, wr = wid >> 2, wc = wid & 3, fr = lane & 15, fq = lane >> 4;
    const int K = g.K, nt = K / BK;
    const float zf_ = opaque_zero();
    unsigned voffA[2], voffB[2];
#pragma unroll
    for (int i = 0; i < 2; ++i) { int R, C; stage_rc(tid * 16 + i * 8192, R, C); const int Rb = Epi::PERM ? ((R & ~31) + perm32(R & 31)) : R;
        voffA[i] = (unsigned)(R * g.lda + C) * 2u; voffB[i] = (unsigned)(Rb * g.ldb + C) * 2u; }
    const size_t kstep = (size_t)(BK * 2);
    const size_t hA = (size_t)HALF * g.lda * 2, hB = (size_t)HALF * g.ldb * 2;
    const size_t tA = 2 * hA, tB = 2 * hB;
    const unsigned ldsw = (unsigned)wid * 1024u;
    const int aoff = lds_byte(wr * 64 + fr, fq * 8), boff = lds_byte(wc * 32 + fr, fq * 8);
#define PG8_SA(b, h) (((b) * 2 + (h)) * HTB)
#define PG8_SB(b, h) ((4 + (b) * 2 + (h)) * HTB)
#define PG8_STAGE(bufoff, gbase, voff) do { _Pragma("unroll") for (int _i = 0; _i < 2; ++_i) \
        __builtin_amdgcn_global_load_lds((const unsigned*)((const char*)(gbase) + (voff)[_i]), (LAS unsigned*)(lds + (bufoff) + ldsw + _i * 8192), 16, 0, 0); } while (0)
#define PG8_LDA(dst, b, h) do { _Pragma("unroll") for (int m = 0; m < 4; ++m) _Pragma("unroll") for (int k = 0; k < 2; ++k) dst[m][k] = *(const LAS bf16x8*)(lds + PG8_SA(b, h) + aoff + m * 2048 + k * 1024); } while (0)
#define PG8_LDB(dst, b, h) do { _Pragma("unroll") for (int n = 0; n < 2; ++n) _Pragma("unroll") for (int k = 0; k < 2; ++k) dst[n][k] = *(const LAS bf16x8*)(lds + PG8_SB(b, h) + boff + n * 2048 + k * 1024); } while (0)
#define PG8_MMA(ai, bj, At, Bt) do { __builtin_amdgcn_s_setprio(1); _Pragma("unroll") for (int m = 0; m < 4; ++m) _Pragma("unroll") for (int n = 0; n < 2; ++n) _Pragma("unroll") for (int k = 0; k < 2; ++k) \
        acc[ai][bj][m][n] = __builtin_amdgcn_mfma_f32_16x16x32_bf16(Bt[n][k], At[m][k], acc[ai][bj][m][n], 0, 0, 0); __builtin_amdgcn_s_setprio(0); } while (0)
#define PG8_WAIT_V(n) asm volatile("s_waitcnt vmcnt(" #n ")" ::: "memory")
#define PG8_WAIT_L(n) asm volatile("s_waitcnt lgkmcnt(" #n ")" ::: "memory")
#define PG8_BAR __builtin_amdgcn_s_barrier()
#define PG8_SCHED __builtin_amdgcn_sched_barrier(0)
    Unit cur, nxt; int ui = 0;
    if (!S.next(0, cur)) return;
    f32x4 acc[2][2][4][2];
#pragma unroll
    for (int a = 0; a < 2; ++a)
#pragma unroll
        for (int b = 0; b < 2; ++b)
#pragma unroll
            for (int m = 0; m < 4; ++m)
#pragma unroll
                for (int n = 0; n < 2; ++n) acc[a][b][m][n] = ZERO4;
    bf16x8 At[4][2], B0[2][2], B1[2][2];
    const char* cA = (const char*)g.A + (size_t)cur.pm * tA + (size_t)cur.koff * 2; const char* cB = (const char*)g.Bt + (size_t)cur.pn * tB + (size_t)cur.koff * 2;
    PG8_STAGE(PG8_SB(0, 0), cB, voffB); PG8_STAGE(PG8_SB(0, 1), cB + hB, voffB); PG8_STAGE(PG8_SA(0, 0), cA, voffA); PG8_STAGE(PG8_SA(0, 1), cA + hA, voffA);
    if (wr == 1) PG8_BAR;
    PG8_WAIT_V(2); PG8_BAR;
    PG8_STAGE(PG8_SB(1, 0), cB + kstep, voffB); PG8_STAGE(PG8_SA(1, 0), cA + kstep, voffA); PG8_STAGE(PG8_SB(1, 1), cB + hB + kstep, voffB);
    PG8_WAIT_V(6); PG8_BAR;
    for (;;) {
        const bool has_next = S.next(ui + 1, nxt);
        const char* nA = has_next ? (const char*)g.A + (size_t)nxt.pm * tA + (size_t)nxt.koff * 2 : cA; const char* nB = has_next ? (const char*)g.Bt + (size_t)nxt.pn * tB + (size_t)nxt.koff * 2 : cB;
        for (int t = 0; t < nt; t += 2) {
            const bool last = (t == nt - 2);
            const char* a1 = cA + (size_t)(t + 1) * kstep;
            const char* a2 = last ? nA : cA + (size_t)(t + 2) * kstep; const char* b2 = last ? nB : cB + (size_t)(t + 2) * kstep;
            const char* a3 = a2 + kstep; const char* b3 = b2 + kstep;
            PG8_LDB(B0, 0, 0); PG8_LDB(B1, 0, 1); PG8_SCHED; PG8_LDA(At, 0, 0); PG8_STAGE(PG8_SA(1, 1), a1 + hA, voffA);
            PG8_WAIT_V(8); PG8_WAIT_L(0); PG8_BAR; PG8_MMA(0, 0, At, B0); PG8_MMA(0, 1, At, B1); PG8_BAR; PG8_SCHED;
            PG8_LDA(At, 0, 1); PG8_STAGE(PG8_SB(0, 0), b2, voffB); PG8_STAGE(PG8_SB(0, 1), b2 + hB, voffB); PG8_STAGE(PG8_SA(0, 0), a2, voffA);
            PG8_WAIT_V(8); PG8_WAIT_L(0); PG8_BAR; PG8_MMA(1, 0, At, B0); PG8_MMA(1, 1, At, B1); PG8_BAR; PG8_SCHED;
            PG8_LDB(B0, 1, 0); PG8_LDB(B1, 1, 1); PG8_SCHED; PG8_LDA(At, 1, 0); PG8_STAGE(PG8_SA(0, 1), a2 + hA, voffA);
            PG8_WAIT_V(8); PG8_WAIT_L(0); PG8_BAR; PG8_MMA(0, 0, At, B0); PG8_MMA(0, 1, At, B1); PG8_BAR; PG8_SCHED;
            PG8_LDA(At, 1, 1); PG8_STAGE(PG8_SB(1, 0), b3, voffB); PG8_STAGE(PG8_SB(1, 1), b3 + hB, voffB); PG8_STAGE(PG8_SA(1, 0), a3, voffA);
            PG8_WAIT_V(8); PG8_WAIT_L(0); PG8_BAR; PG8_MMA(1, 0, At, B0); PG8_MMA(1, 1, At, B1); PG8_BAR; PG8_SCHED;
        }
        if (wr == 0) PG8_BAR;
        if constexpr (Epi::SEGACC) E.seg(acc, cur, wr, wc, fr, fq); else E(acc, cur, wr, wc, fr, fq);
        if (!has_next) break;
        if (!(Epi::SEGACC && nxt.seg != 0)) {
#pragma unroll
        for (int a = 0; a < 2; ++a)
#pragma unroll
            for (int b = 0; b < 2; ++b)
#pragma unroll
                for (int m = 0; m < 4; ++m)
#pragma unroll
                    for (int n = 0; n < 2; ++n) acc[a][b][m][n] = ZERO4;
        }
        cur = nxt; cA = nA; cB = nB; ++ui;
        if (wr == 1) PG8_BAR;
    }
    PG8_WAIT_V(0);
    PG8_BAR;
#undef PG8_SA
#undef PG8_SB
#undef PG8_STAGE
#undef PG8_LDA
#undef PG8_LDB
#undef PG8_MMA
#undef PG8_WAIT_V
#undef PG8_WAIT_L
#undef PG8_BAR
#undef PG8_SCHED
}
#endif
}

#ifndef CPU_EMU
typedef const __attribute__((address_space(4))) Params* KParams;
#else
typedef const Params* KParams;
#endif
struct Frame {
    LAS unsigned char* lds;
    int tid, lane, wave, G, bid;
    KParams p;
    unsigned char* ws;
};
DEV const float* lin(const Frame& F, int idx, int layer, size_t per_layer) { return F.p->in[idx] + (size_t)layer * per_layer; }
#define WSP(T, off) ((T*)(F.ws + (off)))

DEV int up_dest(int n) { return n < DFF ? (n >> 7) * 256 + (n & 127) : ((n - DFF) >> 7) * 256 + 128 + ((n - DFF) & 127); }
DEV int win_dest(int n) {
    if (n < 2048) return n;
    if (n < 2052) return SM0 + S_AA + (n - 2048);
    if (n < 2056) return SM0 + S_AB + (n - 2052);
    if (n < 4104) return C_BQ + (n - 2056);
    if (n < 4116) return SM0 + S_BG + (n - 4104);
    if (n < 6676) return C_CZ + (n - 4116);
    if (n < 6692) return SM0 + S_DT + (n - 6676);
    return GT0 + (n - 6692);
}
struct XItem { const float* W; const float* ks; bf16* WT; int K, N, ldt, koff, mode, r; };
DEV void xitem_load(const XItem& it, int lane, float (&v)[32]) {
    const int nblk = (it.N + 31) / 32, kb = it.r / nblk, nb = it.r % nblk, k0 = 64 * kb, n0 = 32 * nb;
    const int nn = n0 + (lane & 31);
    const float* src = it.W + (size_t)(k0 + (lane >> 5)) * it.N + (nn < it.N ? nn : it.N - 1);
#pragma unroll
    for (int i = 0; i < 32; ++i) v[i] = src[(size_t)(2 * i) * it.N];
}
DEV void xitem_to_lds(LAS float* scr, int lane, const float (&v)[32]) {
#pragma unroll
    for (int i = 0; i < 32; ++i) scr[(2 * i + (lane >> 5)) * 33 + (lane & 31)] = v[i];
    LDS_WAIT(); CFENCE();
}
DEV void xitem_store(const XItem& it, LAS float* scr, int lane) {
    const int nblk = (it.N + 31) / 32, kb = it.r / nblk, nb = it.r % nblk, k0 = 64 * kb, n0 = 32 * nb;
    const int c = lane & 7;
    f32x4 ks0 = (f32x4){1.f, 1.f, 1.f, 1.f}, ks1 = ks0;
    if (it.ks) { ks0 = *(const f32x4*)(it.ks + k0 + 8 * c); ks1 = *(const f32x4*)(it.ks + k0 + 8 * c + 4); }
#pragma unroll
    for (int j = 0; j < 4; ++j) { const int n = (lane >> 3) + 8 * j; const LAS float* s = scr + (8 * c) * 33 + n;
        u32x4 o; o.x = pk2(s[0 * 33] * ks0[0], s[1 * 33] * ks0[1]); o.y = pk2(s[2 * 33] * ks0[2], s[3 * 33] * ks0[3]); o.z = pk2(s[4 * 33] * ks1[0], s[5 * 33] * ks1[1]); o.w = pk2(s[6 * 33] * ks1[2], s[7 * 33] * ks1[3]);
        const int ng = n0 + n;
        if (ng < it.N) { const int dr = it.mode == 0 ? ng : (it.mode == 1 ? up_dest(ng) : win_dest(ng)); *(u32x4*)(it.WT + (size_t)dr * it.ldt + it.koff + k0 + 8 * c) = o; } }
    LDS_WAIT(); CFENCE();
}
constexpr int XI_UP = (DM / 64) * (NUP / 32), XI_DN = (DFF / 64) * (DM / 32), XI_IN = (DM / 64) * ((NIN + 31) / 32), XI_P5 = (512 / 64) * (DM / 32), XI_P10 = (1024 / 64) * (DM / 32), XI_OO = (DM / 64) * (DM / 32), XI_CK = (4096 / 64) * (128 / 32);
constexpr int XI_TOTAL = 2 * XI_UP + 2 * XI_DN + XI_IN + 2 * XI_P5 + XI_P10 + XI_OO + 2 * XI_CK;
DEV XItem xitem_decode(Frame& F, int l, int idx) {
    XItem t; int r = idx; t.ks = nullptr; t.koff = 0; t.mode = 0;
    if (r < XI_UP) { t.W = lin(F, I_WUP1, l, (size_t)DM * NUP); t.K = DM; t.N = NUP; t.WT = WSP(bf16, WS_WUP1); t.ldt = DM; t.ks = lin(F, I_GF1, l, DM); t.mode = 1; }
    else if ((r -= XI_UP) < XI_UP) { t.W = lin(F, I_WUP2, l, (size_t)DM * NUP); t.K = DM; t.N = NUP; t.WT = WSP(bf16, WS_WUP2); t.ldt = DM; t.ks = lin(F, I_GF2, l, DM); t.mode = 1; }
    else if ((r -= XI_UP) < XI_DN) { t.W = lin(F, I_WDN1, l, (size_t)DFF * DM); t.K = DFF; t.N = DM; t.WT = WSP(bf16, WS_WDN1); t.ldt = DFF; }
    else if ((r -= XI_DN) < XI_DN) { t.W = lin(F, I_WDN2, l, (size_t)DFF * DM); t.K = DFF; t.N = DM; t.WT = WSP(bf16, WS_WDN2); t.ldt = DFF; }
    else if ((r -= XI_DN) < XI_IN) { t.W = lin(F, I_WIN, l, (size_t)DM * NIN); t.K = DM; t.N = NIN; t.WT = WSP(bf16, WS_WIN); t.ldt = DM; t.ks = lin(F, I_GMIX, l, DM); t.mode = 2; }
    else if ((r -= XI_IN) < XI_P5) { t.W = lin(F, I_PA, l, (size_t)512 * DM); t.K = 512; t.N = DM; t.WT = WSP(bf16, WS_WPM); t.ldt = DM; }
    else if ((r -= XI_P5) < XI_P5) { t.W = lin(F, I_PB, l, (size_t)512 * DM); t.K = 512; t.N = DM; t.WT = WSP(bf16, WS_WPM); t.ldt = DM; t.koff = 512; }
    else if ((r -= XI_P5) < XI_P10) { t.W = lin(F, I_PC, l, (size_t)1024 * DM); t.K = 1024; t.N = DM; t.WT = WSP(bf16, WS_WPM); t.ldt = DM; t.koff = 1024; t.ks = lin(F, I_SNORM, l, 1024); }
    else if ((r -= XI_P10) < XI_OO) { t.W = lin(F, I_WO, l, (size_t)DM * DM); t.K = DM; t.N = DM; t.WT = WSP(bf16, WS_WO); t.ldt = DM; }
    else if ((r -= XI_OO) < XI_CK) { t.W = lin(F, I_NWCK, l, (size_t)4096 * 128); t.K = 4096; t.N = 128; t.WT = WSP(bf16, WS_WCK); t.ldt = 4096; }
    else { r -= XI_CK; t.W = lin(F, I_NWCV, l, (size_t)4096 * 128); t.K = 4096; t.N = 128; t.WT = WSP(bf16, WS_WCV); t.ldt = 4096; }
    t.r = r; return t;
}
DEV void phase_convert(Frame& F, int l) {
    LAS float* scr = (LAS float*)(F.lds + F.wave * 16384);
    const int gw = F.bid * 8 + F.wave, NGW = F.G * 8;
    if (gw < XI_TOTAL) {
        float v[32]; XItem cur = xitem_decode(F, l, gw); xitem_load(cur, F.lane, v);
        for (int it = gw; it < XI_TOTAL; it += NGW) {
            xitem_to_lds(scr, F.lane, v);
            const bool has_next = it + NGW < XI_TOTAL; XItem nxt = cur;
            if (has_next) { nxt = xitem_decode(F, l, it + NGW); xitem_load(nxt, F.lane, v); }
            xitem_store(cur, scr, F.lane);
            cur = nxt;
        }
    }
    { bf16* w = WSP(bf16, WS_WIN) + (size_t)(SM0 + 36) * DM; const int n16 = (GT0 - SM0 - 36) * DM / 8;
      const unsigned zu = __builtin_bit_cast(unsigned, opaque_zero());
      for (int i = F.bid * 512 + F.tid; i < n16; i += F.G * 512) ((u32x4*)w)[i] = (u32x4){zu, zu, zu, zu}; }
    { const float* pek = lin(F, I_NPEK, l, 4096); const float* pev = lin(F, I_NPEV, l, 4096); float* cst = WSP(float, WS_CONST);
      for (int it = gw; it < 256; it += NGW) { const int e = it & 127; const float* pe = it < 128 ? pek : pev; const float* w = it < 128 ? lin(F, I_NWCK, l, (size_t)4096 * 128) : lin(F, I_NWCV, l, (size_t)4096 * 128); float s = 0.f;
          for (int k = F.lane; k < 4096; k += 64) s += pe[k] * w[(size_t)k * 128 + e];
          s = wave_sum(s); if (F.lane == 0) cst[it] = s; } }
    if (l == 0) {
        const float* x = F.p->in[I_X]; float* out = F.p->out; bf16* xb = WSP(bf16, WS_XB); unsigned long long* rss = WSP(unsigned long long, WS_CTL) + CW_RS / 2;
        for (int m = gw; m < MTOK; m += NGW) {
            const f32x4* xr = (const f32x4*)(x + (size_t)m * DM) + F.lane; f32x4* orow = (f32x4*)(out + (size_t)m * DM) + F.lane; u32x2* br = (u32x2*)(xb + (size_t)m * DM) + F.lane; float ss = 0.f;
#pragma unroll
            for (int j = 0; j < 8; ++j) { const f32x4 v = xr[64 * j]; orow[64 * j] = v; ss += (v[0] * v[0] + v[1] * v[1]) + (v[2] * v[2] + v[3] * v[3]); u32x2 w; w.x = pk2(v[0], v[1]); w.y = pk2(v[2], v[3]); br[64 * j] = w; }
            ss = wave_sum(ss); if (F.lane == 0) rss[m] = pg8::rss_fix(ss);
        }
    }
}

DEV void nsa_prep_job(Frame& F, int l, int job) {
    const int b = job >> 8, g = (job >> 7) & 1, j = job & 127, bg = b * 2 + g, t0 = 64 * j;
    const bf16* p1 = WSP(bf16, WS_P1);
    const float* qn = lin(F, I_NQN, l, 128); const float* kn = lin(F, I_NKN, l, 128);
    bf16* QN = WSP(bf16, WS_QN); bf16* KS = WSP(bf16, WS_KS); bf16* KW = WSP(bf16, WS_KW); bf16* VST = WSP(bf16, WS_VST); bf16* VWT = WSP(bf16, WS_VWT);
    const float gq0 = qn[2 * F.lane], gq1 = qn[2 * F.lane + 1], gk0 = kn[2 * F.lane], gk1 = kn[2 * F.lane + 1];
    unsigned wv[8][4];
#pragma unroll
    for (int i = 0; i < 8; ++i) { const size_t row = (size_t)(b * SEQ + t0 + 8 * F.wave + i) * P1W;
#pragma unroll
        for (int v = 0; v < 4; ++v) { const int col = v < 2 ? C_BQ + (g * 2 + v) * 128 : (v == 2 ? C_BKS + g * 128 : C_BKW + g * 128); wv[i][v] = *(const unsigned*)(p1 + row + col + 2 * F.lane); } }
    CFENCE();
#pragma unroll
    for (int i = 0; i < 8; ++i) {
        const int t = t0 + 8 * F.wave + i;
#pragma unroll
        for (int v = 0; v < 4; ++v) {
            const unsigned w = wv[i][v];
            const float x0 = bflo(w), x1 = bfhi(w);
            const float ss = wave_sum(x0 * x0 + x1 * x1);
            float r = rsqrtf(ss * (1.0f / 128.0f) + EPS);
            unsigned o;
            if (v < 2) { r *= 0.08838834764831845f; o = pk2(x0 * r * gq0, x1 * r * gq1); *(unsigned*)(QN + ((size_t)(bg * SEQ + t) * 2 + v) * 128 + 2 * F.lane) = o; }
            else { o = pk2(x0 * r * gk0, x1 * r * gk1); *(unsigned*)((v == 2 ? KS : KW) + (size_t)(bg * SEQ + t) * 128 + 2 * F.lane) = o; }
        }
    }
    LAS bf16* tl = (LAS bf16*)F.lds;
    for (int i = F.tid; i < 2 * 64 * 64; i += 512) {
        const int v = i >> 12, r = (i >> 6) & 63, c2 = i & 63;
        const unsigned w = *(const unsigned*)(p1 + (size_t)(b * SEQ + t0 + r) * P1W + (v ? C_BVW : C_BVS) + g * 128 + 2 * c2);
        *(LAS unsigned*)(tl + (v * 64 + r) * 130 + 2 * c2) = w;
    }
    __syncthreads();
    for (int i = F.tid; i < 2 * 128 * 8; i += 512) {
        const int v = i >> 10, d = i & 127, tc = (i >> 7) & 7;
        const LAS bf16* s = tl + (v * 64 + 8 * tc) * 130 + d;
        u32x4 o; o.x = s[0] | ((unsigned)s[130] << 16); o.y = s[260] | ((unsigned)s[390] << 16); o.z = s[520] | ((unsigned)s[650] << 16); o.w = s[780] | ((unsigned)s[910] << 16);
        *(u32x4*)((v ? VWT : VST) + ((size_t)(bg * 128 + j) * 128 + d) * 64 + 8 * tc) = o;
    }
    __syncthreads();
}

DEV void gdn_prep_job(Frame& F, int l, int job) {
    const int b = job >> 9, h = (job >> 7) & 3, c = job & 127, t0 = 64 * c;
    const bf16* p1 = WSP(bf16, WS_P1); const float* small = WSP(float, WS_SMALL);
    const float* convw = lin(F, I_GCONV, l, 4 * 1536);
    LAS float* Qs = (LAS float*)F.lds;
    LAS float* Ks = Qs + 64 * 132;
    LAS float* Vs = Ks + 64 * 132;
    LAS float* Mm = Vs + 64 * 132;
    LAS float* At = Mm + 64 * 68;
    LAS float* beta = At + 64 * 68;
    LAS float* gc = beta + 64;
    LAS float* eg = gc + 64;
    const int tid = F.tid;
    {
        const int ch = tid & 127, tg = tid >> 7;
#pragma unroll
        for (int v = 0; v < 3; ++v) {
            const int cc = v * 512 + h * 128 + ch;
            const float w0 = convw[cc], w1 = convw[1536 + cc], w2 = convw[2 * 1536 + cc], w3 = convw[3 * 1536 + cc];
            const int col = (v == 0 ? C_AQ : (v == 1 ? C_AK : C_AV)) + h * 128 + ch;
            float xin[19];
            { const int tt = t0 + 16 * tg;
#pragma unroll
              for (int i = 0; i < 19; ++i) { const int t = tt - 3 + i; xin[i] = t >= 0 ? bf2f(p1[(size_t)(b * SEQ + t) * P1W + col]) : 0.f; } }
            LAS float* dst = v == 0 ? Qs : (v == 1 ? Ks : Vs);
#pragma unroll
            for (int i = 0; i < 16; ++i) {
                const float y = w0 * xin[i] + w1 * xin[i + 1] + w2 * xin[i + 2] + w3 * xin[i + 3];
                dst[(16 * tg + i) * 132 + ch] = siluf_(y);
            }
        }
        if (tid < 64) {
            const size_t row = (size_t)(b * SEQ + t0 + tid);
            const float a = small[row * SMW + S_AA + h], bb = small[row * SMW + S_AB + h];
            beta[tid] = sigmoidf_(bb);
            gc[tid] = -__expf(lin(F, I_GALOG, l, 4)[h]) * softplusf_(a + lin(F, I_GDTB, l, 4)[h]);
        }
    }
    __syncthreads();
    for (int i = 0; i < 16; ++i) {
        const int r = F.wave * 16 + i;
        LAS float* p = (r < 64 ? Qs + r * 132 : Ks + (r - 64) * 132);
        const float x0 = p[F.lane], x1 = p[F.lane + 64];
        const float ss = wave_sum(x0 * x0 + x1 * x1);
        float sc = rsqrtf(ss + EPS); if (r < 64) sc *= 0.08838834764831845f;
        p[F.lane] = x0 * sc; p[F.lane + 64] = x1 * sc;
    }
    if (tid == 0) { float s = 0.f; for (int i = 0; i < 64; ++i) { s += gc[i]; gc[i] = s; eg[i] = __expf(s); } }
    for (int i = tid; i < 64 * 68; i += 512) At[i] = 0.f;
    __syncthreads();
    for (int tj = F.wave; tj < 20; tj += 8) {
        const int kind = tj >= 10 ? 1 : 0, idx = tj - 10 * kind;
        const int mt = idx >= 6 ? 3 : (idx >= 3 ? 2 : (idx >= 1 ? 1 : 0)), nt = idx - mt * (mt + 1) / 2;
        const int fr = F.lane & 15, fq = F.lane >> 4;
        const LAS float* ap = (kind ? Qs : Ks) + (16 * mt + fr) * 132 + 4 * fq; const LAS float* bp = Ks + (16 * nt + fr) * 132 + 4 * fq;
        f32x4 acc = (f32x4){0.f, 0.f, 0.f, 0.f};
#pragma unroll
        for (int sg = 0; sg < 8; ++sg) { const f32x4 a4 = *(const LAS f32x4*)(ap + 16 * sg), b4 = *(const LAS f32x4*)(bp + 16 * sg);
#pragma unroll
            for (int j = 0; j < 4; ++j) acc = __builtin_amdgcn_mfma_f32_16x16x4f32(a4[j], b4[j], acc, 0, 0, 0); }
        const int j = 16 * nt + fr; const float gj = gc[j];
#pragma unroll
        for (int r = 0; r < 4; ++r) { const int i = 16 * mt + 4 * fq + r; const float dec = j <= i ? __expf(gc[i] - gj) : 0.f;
            if (kind) At[i * 68 + j] = acc[r] * dec; else Mm[i * 68 + j] = j < i ? beta[i] * acc[r] * dec : 0.f; }
    }
    __syncthreads();
    unsigned char* cb = F.ws + WS_GW + (size_t)job * GDN_CH_BYTES;
    bf16* gW = (bf16*)cb; bf16* gQD = (bf16*)(cb + 16384); bf16* gKDT = (bf16*)(cb + 32768); bf16* gUT = (bf16*)(cb + 49152); bf16* gAT = (bf16*)(cb + 65536);
    float sol[64];
    if (tid < 256) {
        const int cidx = tid & 127; const bool isw = tid >= 128;
        const LAS float* src = (isw ? Ks : Vs) + cidx;
        const LAS float* MmL = (const LAS float*)lds_vbase(Mm); const LAS float* betaL = (const LAS float*)lds_vbase(beta); const LAS float* egL = (const LAS float*)lds_vbase(eg);
#pragma unroll
        for (int i = 0; i < 64; ++i) sol[i] = 0.f;
#pragma unroll
        for (int i = 0; i < 64; ++i) {
            float r = src[i * 132] * betaL[i] * (isw ? egL[i] : 1.0f), r1 = 0.f, r2 = 0.f, r3 = 0.f;
#pragma unroll
            for (int j4 = 0; j4 < (i + 3) / 4; ++j4) { const f32x4 mv = *(const LAS f32x4*)(MmL + i * 68 + 4 * j4);
                r -= mv[0] * sol[4 * j4]; r1 -= mv[1] * sol[4 * j4 + 1]; r2 -= mv[2] * sol[4 * j4 + 2]; r3 -= mv[3] * sol[4 * j4 + 3]; }
            r = (r + r1) + (r2 + r3);
            sol[i] = r;
            asm volatile("" : "+v"(sol[i]) :: "memory");
        }
    } else {
        const int t2 = tid - 256;
        const float gl = gc[63];
        for (int i = t2; i < 64 * 16; i += 256) { const int r = i >> 4, c8 = (i & 15) * 8; const float e = eg[r]; const LAS float* s = Qs + r * 132 + c8;
            u32x4 o; o.x = pk2(s[0] * e, s[1] * e); o.y = pk2(s[2] * e, s[3] * e); o.z = pk2(s[4] * e, s[5] * e); o.w = pk2(s[6] * e, s[7] * e); *(u32x4*)(gQD + r * 128 + c8) = o; }
        for (int i = t2; i < 128 * 8; i += 256) { const int dk = i & 127, i8 = (i >> 7) * 8; float v[8];
#pragma unroll
            for (int q = 0; q < 8; ++q) v[q] = Ks[(i8 + q) * 132 + dk] * __expf(gl - gc[i8 + q]);
            u32x4 o; o.x = pk2(v[0], v[1]); o.y = pk2(v[2], v[3]); o.z = pk2(v[4], v[5]); o.w = pk2(v[6], v[7]); *(u32x4*)(gKDT + dk * 64 + i8) = o; }
        for (int i = t2; i < 64 * 8; i += 256) { const int r = i >> 3, c8 = (i & 7) * 8; const LAS float* s = At + r * 68 + c8;
            u32x4 o; o.x = pk2(s[0], s[1]); o.y = pk2(s[2], s[3]); o.z = pk2(s[4], s[5]); o.w = pk2(s[6], s[7]); *(u32x4*)(gAT + r * 64 + c8) = o; }
        if (t2 == 0) WSP(float, WS_GL)[job] = __expf(gl);
    }
    __syncthreads();
    LAS bf16* Wl = (LAS bf16*)Qs;
    if (tid < 128) {
#pragma unroll
        for (int q = 0; q < 8; ++q) { u32x4 o; o.x = pk2(sol[8 * q], sol[8 * q + 1]); o.y = pk2(sol[8 * q + 2], sol[8 * q + 3]); o.z = pk2(sol[8 * q + 4], sol[8 * q + 5]); o.w = pk2(sol[8 * q + 6], sol[8 * q + 7]);
            *(u32x4*)(gUT + tid * 64 + 8 * q) = o; }
    } else if (tid < 256) {
#pragma unroll
        for (int i = 0; i < 64; ++i) Wl[i * 136 + (tid - 128)] = (bf16)f2bf(sol[i]);
    }
    __syncthreads();
    for (int i = tid; i < 64 * 16; i += 512) { const int r = i >> 4, c8 = (i & 15) * 8; *(u32x4*)(gW + r * 128 + c8) = *(const LAS u32x4*)(Wl + r * 136 + c8); }
    __syncthreads();
}

DEV void ssd_prep_job(Frame& F, int l, int job) {
    const int b = job >> 7, c = (job >> 1) & 63, g = job & 1, t0 = 128 * c;
    const float zf_ = opaque_zero();
    const bf16* p1 = WSP(bf16, WS_P1); const float* small = WSP(float, WS_SMALL);
    const float* cw = lin(F, I_SCW, l, 4 * 1536); const float* cbias = lin(F, I_SCB, l, 1536);
    bf16* SX = WSP(bf16, WS_SX); float* SDT = WSP(float, WS_SDT); float* SAC = WSP(float, WS_SAC); float* SST = WSP(float, WS_SST); float* SCD = WSP(float, WS_SCD);
    LAS bf16* BT = (LAS bf16*)F.lds;
    LAS bf16* XT = BT + 128 * 136;
    LAS float* dts = (LAS float*)(XT + 64 * 136);
    LAS float* acs = dts + 128 * 8;
    const int tid = F.tid;
    for (int i = tid; i < 1024; i += 512) { const int tl = i >> 3, hh = i & 7, h = 8 * g + hh; const size_t row = (size_t)(b * SEQ + t0 + tl);
        const float dt = softplusf_(small[row * SMW + S_DT + h] + lin(F, I_SDTB, l, 16)[h]);
        dts[i] = dt; acs[i] = dt * (-__expf(lin(F, I_SALOG, l, 16)[h])); }
    __syncthreads();
    if (tid < 8) { float s = 0.f; for (int tl = 0; tl < 128; ++tl) { s += acs[tl * 8 + tid]; acs[tl * 8 + tid] = s; } }
    __syncthreads();
    for (int i = tid; i < 1024; i += 512) { const int tl = i >> 3, hh = i & 7; const size_t row = (size_t)(b * SEQ + t0 + tl); SDT[row * 16 + 8 * g + hh] = dts[i]; SAC[row * 16 + 8 * g + hh] = acs[i]; }
    if (tid < 8) SCD[(size_t)(b * 64 + c) * 16 + 8 * g + tid] = __expf(acs[127 * 8 + tid]);
    {
        const int ch = tid & 255, half = tid >> 8; const int cc = 1024 + (ch < 128 ? g * 128 + ch : 256 + g * 128 + (ch - 128));
        const float w0 = cw[cc], w1 = cw[1536 + cc], w2 = cw[2 * 1536 + cc], w3 = cw[3 * 1536 + cc], bs = cbias[cc];
        const int col = C_CX + cc;
        for (int q = 0; q < 4; ++q) {
            const int ts = t0 + 64 * half + 16 * q; float xin[19];
#pragma unroll
            for (int i = 0; i < 19; ++i) { const int t = ts - 3 + i; xin[i] = t >= 0 ? bf2f(p1[(size_t)(b * SEQ + t) * P1W + col]) : 0.f; }
#pragma unroll
            for (int i = 0; i < 16; ++i) { const int tl = 64 * half + 16 * q + i; const size_t row = (size_t)(b * SEQ + t0 + tl);
                const float y = siluf_(w0 * xin[i] + w1 * xin[i + 1] + w2 * xin[i + 2] + w3 * xin[i + 3] + bs); const bf16 yb = (bf16)f2bf(y);
                SX[row * 1536 + cc] = yb; if (ch < 128) BT[ch * 136 + tl] = yb; }
        }
    }
    for (int hh = 0; hh < 8; ++hh) {
        const int h = 8 * g + hh;
        __syncthreads();
        {
            const int ch = tid & 63, tg = tid >> 6; const int cc = h * 64 + ch;
            const float w0 = cw[cc], w1 = cw[1536 + cc], w2 = cw[2 * 1536 + cc], w3 = cw[3 * 1536 + cc], bs = cbias[cc];
            const int col = C_CX + cc; const int ts = t0 + 16 * tg;
            float xin[19];
#pragma unroll
            for (int i = 0; i < 19; ++i) { const int t = ts - 3 + i; xin[i] = t >= 0 ? bf2f(p1[(size_t)(b * SEQ + t) * P1W + col]) : 0.f; }
            const float al = acs[127 * 8 + hh];
#pragma unroll
            for (int i = 0; i < 16; ++i) { const int tl = 16 * tg + i; const size_t row = (size_t)(b * SEQ + t0 + tl);
                const float y = siluf_(w0 * xin[i] + w1 * xin[i + 1] + w2 * xin[i + 2] + w3 * xin[i + 3] + bs); const bf16 yb = (bf16)f2bf(y);
                SX[row * 1536 + cc] = yb;
                XT[ch * 136 + tl] = (bf16)f2bf(bf2f(yb) * dts[tl * 8 + hh] * __expf(al - acs[tl * 8 + hh])); }
        }
        __syncthreads();
        {
            const int mt = F.wave & 3, nb = (F.wave >> 2) * 4;
            bf16x8 a[4];
#pragma unroll
            for (int ks = 0; ks < 4; ++ks) a[ks] = frag_l(XT, 136, 16 * mt, 32 * ks, F.lane);
            float* dst = SST + ((size_t)((b * 64 + c) * 16 + h) * 64) * 128;
#pragma unroll
            for (int q = 0; q < 4; ++q) { f32x4 acc = ZERO4;
#pragma unroll
                for (int ks = 0; ks < 4; ++ks) acc = mfma16(a[ks], frag_l(BT, 136, 16 * (nb + q), 32 * ks, F.lane), acc);
#pragma unroll
                for (int r = 0; r < 4; ++r) dst[(size_t)(16 * mt + 4 * (F.lane >> 4) + r) * 128 + 16 * (nb + q) + (F.lane & 15)] = acc[r]; }
        }
    }
    __syncthreads();
}

DEV void nsa_compress_job(Frame& F, int l, int job) {
    const int kv = job >> 4, bg = (job >> 2) & 3, rt = job & 3, b = bg >> 1, g = bg & 1, i0 = 128 * rt;
    const float zf_ = opaque_zero();
    const bf16* p1 = WSP(bf16, WS_P1); const bf16* Wt = WSP(bf16, kv ? WS_WCV : WS_WCK); const float* cst = WSP(float, WS_CONST) + kv * 128;
    const int col0 = (kv ? C_BVC : C_BKC) + g * 128;
    LAS bf16* As = (LAS bf16*)F.lds;
    LAS bf16* Bs = As + 128 * 72;
    LAS float* Cs = (LAS float*)(Bs + 128 * 72);
    const int tid = F.tid, wm = F.wave >> 1, wn = F.wave & 1;
    f32x4 acc[2][4];
#pragma unroll
    for (int i = 0; i < 2; ++i)
#pragma unroll
        for (int j = 0; j < 4; ++j) acc[i][j] = ZERO4;
    u32x4 ra[2], rb[2];
#define LOADK(ks_) do { _Pragma("unroll") for (int q = 0; q < 2; ++q) { const int ch = tid + 512 * q, r = ch >> 3, c8 = (ch & 7) * 8; \
            int t = 16 * (i0 + r) + ((ks_) >> 1); if (t > SEQ - 1) t = SEQ - 1;     \
            ra[q] = *(const u32x4*)(p1 + (size_t)(b * SEQ + t) * P1W + col0 + ((ks_) & 1) * 64 + c8); \
            rb[q] = *(const u32x4*)(Wt + (size_t)r * 4096 + 64 * (ks_) + c8); } } while (0)
    LOADK(0);
    for (int ks = 0; ks < 64; ++ks) {
        __syncthreads();
#pragma unroll
        for (int q = 0; q < 2; ++q) { const int ch = tid + 512 * q, r = ch >> 3, c8 = (ch & 7) * 8; *(LAS u32x4*)(As + r * 72 + c8) = ra[q]; *(LAS u32x4*)(Bs + r * 72 + c8) = rb[q]; }
        __syncthreads();
        if (ks + 1 < 64) LOADK(ks + 1);
#pragma unroll
        for (int k2 = 0; k2 < 2; ++k2) {
            bf16x8 a0 = frag_l(As, 72, 32 * wm, 32 * k2, F.lane), a1 = frag_l(As, 72, 32 * wm + 16, 32 * k2, F.lane);
#pragma unroll
            for (int j = 0; j < 4; ++j) { const bf16x8 bb = frag_l(Bs, 72, 64 * wn + 16 * j, 32 * k2, F.lane); acc[0][j] = mfma16(a0, bb, acc[0][j]); acc[1][j] = mfma16(a1, bb, acc[1][j]); }
        }
    }
    __syncthreads();
#pragma unroll
    for (int i = 0; i < 2; ++i)
#pragma unroll
        for (int j = 0; j < 4; ++j)
#pragma unroll
            for (int r = 0; r < 4; ++r) { const int col = 64 * wn + 16 * j + (F.lane & 15); Cs[(32 * wm + 16 * i + 4 * (F.lane >> 4) + r) * 132 + col] = acc[i][j][r] + cst[col]; }
    __syncthreads();
    if (kv == 0) {
        const float* kn = lin(F, I_NKN, l, 128); bf16* KC = WSP(bf16, WS_KCMP);
        const int r = tid >> 2, q = tid & 3; const LAS float* s = Cs + r * 132 + 32 * q; float ss = 0.f;
#pragma unroll
        for (int e = 0; e < 32; ++e) ss += s[e] * s[e];
        ss += shx<1>(ss); ss += shx<2>(ss);
        const float rs = rsqrtf(ss * (1.0f / 128.0f) + EPS);
        bf16* dst = KC + ((size_t)bg * 512 + i0 + r) * 128 + 32 * q;
#pragma unroll
        for (int e = 0; e < 32; e += 2) *(unsigned*)(dst + e) = pk2(s[e] * rs * kn[32 * q + e], s[e + 1] * rs * kn[32 * q + e + 1]);
    } else {
        bf16* VC = WSP(bf16, WS_VCMPT); const int e = tid & 127, q = tid >> 7;
#pragma unroll
        for (int i8 = 0; i8 < 4; ++i8) { const LAS float* s = Cs + (32 * q + 8 * i8) * 132 + e;
            u32x4 o; o.x = pk2(s[0], s[132]); o.y = pk2(s[264], s[396]); o.z = pk2(s[528], s[660]); o.w = pk2(s[792], s[924]);
            *(u32x4*)(VC + ((size_t)bg * 128 + e) * 512 + i0 + 32 * q + 8 * i8) = o; }
    }
    __syncthreads();
}
#undef LOADK

constexpr int AL_KT = 0, AL_VT = 17408, AL_KT1 = 35840, AL_UW = 53248, AL_TB = 54272, AL_SM = 60608, AL_PS = 61696, AL_IMP = 78336, AL_VT1 = 111104, AL_END = 129536;
static_assert(AL_KT1 + 17408 <= AL_UW && AL_UW + 128 <= AL_TB && AL_END <= MISC_OFF, "attention LDS map");
DEV int rel_bucket_dev(int n) {
    if (n < 16) return n;
    int k = 16;
    k += (n >= 21); k += (n >= 27); k += (n >= 35); k += (n >= 46); k += (n >= 59); k += (n >= 77); k += (n >= 99); k += (n >= 128);
    k += (n >= 166); k += (n >= 216); k += (n >= 280); k += (n >= 363); k += (n >= 470); k += (n >= 609); k += (n >= 790);
    return k;
}
DEV void attn_fill_bias(Frame& F, int g) {
    LAS float* tb = (LAS float*)(F.lds + AL_TB); const float* rt = F.p->in[I_REL];
    for (int i = F.tid; i < 2 * 792; i += 512) { const int hg = i / 792, d = i - hg * 792; tb[i] = rt[rel_bucket_dev(d) * 4 + 2 * g + hg]; }
}
DEV void attn_load_tile(u32x4 (&rk)[2], u32x4 (&rv)[2], const bf16* ksrc, const bf16* vsrc, int vpitch, int tid) {
#pragma unroll
    for (int q = 0; q < 2; ++q) { const int ch = tid + 512 * q; rk[q] = *(const u32x4*)(ksrc + (size_t)ch * 8); rv[q] = *(const u32x4*)(vsrc + (size_t)(ch >> 3) * vpitch + (ch & 7) * 8); }
}
DEV void attn_store_tile(LAS unsigned char* lds, int buf, const u32x4 (&rk)[2], const u32x4 (&rv)[2], int tid) {
    LAS bf16* Kt = (LAS bf16*)(lds + (buf ? AL_KT1 : AL_KT)); LAS bf16* Vt = (LAS bf16*)(lds + (buf ? AL_VT1 : AL_VT));
#pragma unroll
    for (int q = 0; q < 2; ++q) { const int ch = tid + 512 * q; *(LAS u32x4*)(Kt + (ch >> 4) * 136 + (ch & 15) * 8) = rk[q]; *(LAS u32x4*)(Vt + (ch >> 3) * 72 + (ch & 7) * 8) = rv[q]; }
}
template <int MODE, int PATH = 0>
DEV unsigned attn_scores(LAS unsigned char* lds, int buf, const bf16x8 (&qf)[4], int lane, int n0, int tok, int hg, unsigned selbit, f32x4 (&s)[4]) {
    const float zf_ = opaque_zero();
    const LAS bf16* Kt = (const LAS bf16*)(lds + (buf ? AL_KT1 : AL_KT)); const LAS float* tb = (const LAS float*)(lds + AL_TB) + hg * 792;
#pragma unroll
    for (int nt = 0; nt < 4; ++nt) { s[nt] = ZERO4;
#pragma unroll
        for (int ks = 0; ks < 4; ++ks) s[nt] = mfma16(frag_l(Kt, 136, 16 * nt, 32 * ks, lane), qf[ks], s[nt]); }
    if (PATH == 1) {
        const float bf = tb[790]; const bool ok = selbit != 0u;
#pragma unroll
        for (int nt = 0; nt < 4; ++nt)
#pragma unroll
            for (int r = 0; r < 4; ++r) s[nt][r] = ok ? s[nt][r] + bf : -1e30f;
        return ok ? 0xffffu : 0u;
    }
    if (PATH == 2) {
        const bool ok = MODE == 2 ? true : (selbit != 0u);
        const LAS float* tp = tb + (tok - n0 - 4 * (lane >> 4));
#pragma unroll
        for (int nt = 0; nt < 4; ++nt)
#pragma unroll
            for (int r = 0; r < 4; ++r) s[nt][r] = ok ? s[nt][r] + tp[-16 * nt - r] : -1e30f;
        return ok ? 0xffffu : 0u;
    }
    unsigned vm = 0u;
#pragma unroll
    for (int nh = 0; nh < 2; ++nh) {
        float bv[8];
#pragma unroll
        for (int q = 0; q < 8; ++q) { const int nt = 2 * nh + (q >> 2), r = q & 3; const int n = n0 + 16 * nt + 4 * (lane >> 4) + r; const int dist = MODE == 0 ? tok - (16 * n + 31) : tok - n;
            int di = dist < 0 ? 0 : dist; di = di > 790 ? 790 : di; bv[q] = tb[di]; }
#pragma unroll
        for (int q = 0; q < 8; ++q) asm volatile("" : "+v"(bv[q]));
#pragma unroll
        for (int q = 0; q < 8; ++q) { const int nt = 2 * nh + (q >> 2), r = q & 3; const int n = n0 + 16 * nt + 4 * (lane >> 4) + r; int dist; bool ok;
            if (MODE == 0) { dist = tok - (16 * n + 31); ok = dist >= 0 && n < 511; }
            else if (MODE == 1) { dist = tok - n; ok = dist >= 0 && selbit != 0u; }
            else { dist = tok - n; ok = dist >= 0 && dist < 512; }
            s[nt][r] = ok ? s[nt][r] + bv[q] : -1e30f;
            vm |= (ok ? 1u : 0u) << (4 * nt + r); }
    }
    return vm;
}
DEV float fq_max(float v) {
    const auto a = __builtin_amdgcn_permlane16_swap(__builtin_bit_cast(unsigned, v), __builtin_bit_cast(unsigned, v), false, false);
    const float m = fmaxf(__builtin_bit_cast(float, a[0]), __builtin_bit_cast(float, a[1]));
    const auto b = __builtin_amdgcn_permlane32_swap(__builtin_bit_cast(unsigned, m), __builtin_bit_cast(unsigned, m), false, false);
    return fmaxf(__builtin_bit_cast(float, b[0]), __builtin_bit_cast(float, b[1]));
}
DEV float fq_sum(float v) {
    const auto a = __builtin_amdgcn_permlane16_swap(__builtin_bit_cast(unsigned, v), __builtin_bit_cast(unsigned, v), false, false);
    const float m = __builtin_bit_cast(float, a[0]) + __builtin_bit_cast(float, a[1]);
    const auto b = __builtin_amdgcn_permlane32_swap(__builtin_bit_cast(unsigned, m), __builtin_bit_cast(unsigned, m), false, false);
    return __builtin_bit_cast(float, b[0]) + __builtin_bit_cast(float, b[1]);
}
DEV float attn_online(const f32x4 (&s)[4], unsigned vm, float& m, float& l, f32x4 (&p)[4]) {
    float mx = fmaxf(fmaxf(fmaxf(s[0][0], s[0][1]), fmaxf(s[0][2], s[0][3])), fmaxf(fmaxf(s[1][0], s[1][1]), fmaxf(s[1][2], s[1][3])));
    mx = fmaxf(mx, fmaxf(fmaxf(fmaxf(s[2][0], s[2][1]), fmaxf(s[2][2], s[2][3])), fmaxf(fmaxf(s[3][0], s[3][1]), fmaxf(s[3][2], s[3][3]))));
    mx = fmaxf(mx, shx<16>(mx)); mx = fmaxf(mx, shx<32>(mx));
    const float mn = fmaxf(m, mx), sc = __expf(m - mn); float rs = 0.f;
#pragma unroll
    for (int nt = 0; nt < 4; ++nt)
#pragma unroll
        for (int r = 0; r < 4; ++r) { const float pv = ((vm >> (4 * nt + r)) & 1u) ? __expf(s[nt][r] - mn) : 0.f; p[nt][r] = pv; rs += pv; }
    rs += shx<16>(rs); rs += shx<32>(rs);
    l = l * sc + rs; m = mn;
    return sc;
}
DEV void attn_pv(LAS unsigned char* lds, int buf, int lane, const f32x4 (&p)[4], f32x4 (&o)[8]) {
    const LAS bf16* Vt = (const LAS bf16*)(lds + (buf ? AL_VT1 : AL_VT)) + (lane & 15) * 72 + 4 * (lane >> 4);
#pragma unroll
    for (int ks = 0; ks < 2; ++ks) {
        u32x4 pw; pw.x = pg8::cvt_pk_bf16(p[2 * ks][0], p[2 * ks][1]); pw.y = pg8::cvt_pk_bf16(p[2 * ks][2], p[2 * ks][3]); pw.z = pg8::cvt_pk_bf16(p[2 * ks + 1][0], p[2 * ks + 1][1]); pw.w = pg8::cvt_pk_bf16(p[2 * ks + 1][2], p[2 * ks + 1][3]);
        const bf16x8 pb = __builtin_bit_cast(bf16x8, pw);
#pragma unroll
        for (int dt = 0; dt < 8; ++dt) {
            const u32x2 v0 = *(const LAS u32x2*)(Vt + 16 * dt * 72 + 32 * ks), v1 = *(const LAS u32x2*)(Vt + 16 * dt * 72 + 32 * ks + 16);
            u32x4 vw; vw.x = v0.x; vw.y = v0.y; vw.z = v1.x; vw.w = v1.y;
            o[dt] = mfma16(__builtin_bit_cast(bf16x8, vw), pb, o[dt]); }
    }
}
DEV void attn_load_q(Frame& F, int bg, int t0, bf16x8 (&qf)[4]) {
    const bf16* QN = WSP(bf16, WS_QN); const int rho = F.lane & 15;
    const bf16* src = QN + ((size_t)(bg * SEQ + t0 + 8 * F.wave + (rho & 7)) * 2 + (rho >> 3)) * 128 + 8 * (F.lane >> 4);
#pragma unroll
    for (int ks = 0; ks < 4; ++ks) qf[ks] = *(const bf16x8*)(src + 32 * ks);
}

DEV void sel_step(Frame& F, const bf16* KS, const bf16* VS, int j, int jn, int jnn, int qt, int cb, const u32x4 (&st_k)[2], const u32x4 (&st_v)[2], u32x4 (&ld_k)[2], u32x4 (&ld_v)[2],
                  const bf16x8 (&qf)[4], const u32x4& smw, const unsigned (&wum)[4], int tok, int hg, float& m, float& l, f32x4 (&o)[8]) {
    const int lane = F.lane;
    if (jnn <= qt) attn_load_tile(ld_k, ld_v, KS + (size_t)jnn * 64 * 128, VS + (size_t)jnn * 128 * 64, 64, F.tid);
    const unsigned wsel = j < 32 ? wum[0] : (j < 64 ? wum[1] : (j < 96 ? wum[2] : wum[3]));
    if ((wsel >> (j & 31)) & 1u) {
        const unsigned w = j < 32 ? smw.x : (j < 64 ? smw.y : (j < 96 ? smw.z : smw.w)); const unsigned selbit = (w >> (j & 31)) & 1u;
        f32x4 s[4], p[4];
        const unsigned vm = (j <= qt - 14) ? attn_scores<1, 1>(F.lds, cb, qf, lane, 64 * j, tok, hg, selbit, s) : ((j >= qt - 11 && j < qt) ? attn_scores<1, 2>(F.lds, cb, qf, lane, 64 * j, tok, hg, selbit, s) : attn_scores<1, 0>(F.lds, cb, qf, lane, 64 * j, tok, hg, selbit, s));
        const float sc = attn_online(s, vm, m, l, p);
#pragma unroll
        for (int dt = 0; dt < 8; ++dt) o[dt] = o[dt] * sc;
        attn_pv(F.lds, cb, lane, p, o);
    }
    if (jn <= qt) attn_store_tile(F.lds, cb ^ 1, st_k, st_v, F.tid);
    __syncthreads();
}
DEV int sel_next(int j, int qt, const unsigned (&um)[4]) {
    int jn = j + 1;
    while (jn <= qt) { const unsigned w = jn < 32 ? um[0] : (jn < 64 ? um[1] : (jn < 96 ? um[2] : um[3])); if ((w >> (jn & 31)) & 1u) break; ++jn; }
    return jn;
}
DEV void nsa_job(Frame& F, int job) {
    const int bg = job >> 7, qt = job & 127, b = bg >> 1, g = bg & 1, t0 = 64 * qt, tid = F.tid, lane = F.lane, wave = F.wave;
    const float zf_ = opaque_zero();
    const int fq = lane >> 4, fr = lane & 15, hg = fr >> 3, tok = t0 + 8 * wave + (fr & 7);
    const float* small = WSP(float, WS_SMALL); const size_t row = (size_t)(b * SEQ + tok);
    LAS float* PS = (LAS float*)(F.lds + AL_PS) + wave * (8 * 65); LAS float* IMP = (LAS float*)(F.lds + AL_IMP);
    LAS unsigned* SM = (LAS unsigned*)(F.lds + AL_SM);
    LAS unsigned* UW = (LAS unsigned*)(F.lds + AL_UW);
    __syncthreads();
    attn_fill_bias(F, g);
    for (int i = tid; i < 64 * 128; i += 512) IMP[i] = 0.f;
    if (lane < 8) PS[lane * 65] = 0.f;
    bf16x8 qf[4]; attn_load_q(F, bg, t0, qf);
    f32x4 tot[8];
    u32x4 rk[2], rv[2];
    for (int dr_ = 0; dr_ < (DBG_NSA == 1 ? 2 : 1); ++dr_) {
        if (dr_ == 1) { WAVE_SYNC(); if (lane < 8) PS[lane * 65] = 0.f; WAVE_SYNC(); }
        const int ntiles = (4 * qt + 2) / 64 + 1;
        const bf16* KC = WSP(bf16, WS_KCMP) + (size_t)bg * 512 * 128; const bf16* VC = WSP(bf16, WS_VCMPT) + (size_t)bg * 128 * 512;
        float m = -1e30f, l = 0.f;
        attn_load_tile(rk, rv, KC, VC, 512, tid); attn_store_tile(F.lds, 0, rk, rv, tid); __syncthreads();
        for (int j = 0; j < ntiles; ++j) {
            if (j + 1 < ntiles) attn_load_tile(rk, rv, KC + (size_t)(j + 1) * 64 * 128, VC + (j + 1) * 64, 512, tid);
            f32x4 s[4], p[4];
            const unsigned vm = attn_scores<0>(F.lds, j & 1, qf, lane, 64 * j, tok, hg, 0u, s);
            (void)attn_online(s, vm, m, l, p);
            if (j + 1 < ntiles) attn_store_tile(F.lds, (j + 1) & 1, rk, rv, tid);
            __syncthreads();
        }
        const float il = l > 0.f ? 1.0f / l : 0.f;
        f32x4 o[8];
#pragma unroll
        for (int dt = 0; dt < 8; ++dt) o[dt] = ZERO4;
        attn_load_tile(rk, rv, KC, VC, 512, tid); attn_store_tile(F.lds, 0, rk, rv, tid); __syncthreads();
        for (int j = 0; j < ntiles; ++j) {
            if (j + 1 < ntiles) attn_load_tile(rk, rv, KC + (size_t)(j + 1) * 64 * 128, VC + (j + 1) * 64, 512, tid);
            f32x4 s[4], p[4];
            const unsigned vm = attn_scores<0>(F.lds, j & 1, qf, lane, 64 * j, tok, hg, 0u, s);
#pragma unroll
            for (int nt = 0; nt < 4; ++nt)
#pragma unroll
                for (int r = 0; r < 4; ++r) {
                    const float pv = ((vm >> (4 * nt + r)) & 1u) ? __expf(s[nt][r] - m) * il : 0.f; p[nt][r] = pv;
                    const float ps = pv + shx<8>(pv);
                    if (fr < 8) PS[fr * 65 + 1 + 16 * nt + 4 * fq + r] = ps;
                }
            WAVE_SYNC();
#pragma unroll
            for (int q = 0; q < 2; ++q) { const int idx = lane + 64 * q, tk = idx >> 4, bl = idx & 15; const LAS float* ps = PS + tk * 65 + 4 * bl;
                IMP[(8 * wave + tk) * 128 + 16 * j + bl] = ps[0] + 2.0f * ps[1] + 2.0f * ps[2] + 2.0f * ps[3] + ps[4]; }
            WAVE_SYNC();
            if (lane < 8) PS[lane * 65] = PS[lane * 65 + 64];
            WAVE_SYNC();
            attn_pv(F.lds, j & 1, lane, p, o);
            if (j + 1 < ntiles) attn_store_tile(F.lds, (j + 1) & 1, rk, rv, tid);
            __syncthreads();
        }
        const float gt = sigmoidf_(small[row * SMW + S_BG + (2 * g + hg) * 3 + 0]);
#pragma unroll
        for (int dt = 0; dt < 8; ++dt) tot[dt] = o[dt] * gt;
    }
    unsigned wum[4] = {0u, 0u, 0u, 0u};
    for (int dr_ = 0; dr_ < (DBG_NSA == 4 ? 2 : 1); ++dr_) {
        const int cur = qt;
        for (int tk = 0; tk < 8; ++tk) {
            const LAS float* rowp = IMP + (8 * wave + tk) * 128;
            const int b0 = lane, b1 = lane + 64;
            const float s0 = b0 > cur ? -1e4f : ((b0 == 0 || b0 >= cur - 1) ? 1e4f : rowp[b0]);
            const float s1 = b1 > cur ? -1e4f : ((b1 == 0 || b1 >= cur - 1) ? 1e4f : rowp[b1]);
            unsigned k0 = __builtin_bit_cast(unsigned, s0), k1 = __builtin_bit_cast(unsigned, s1);
            k0 = (k0 & 0x80000000u) ? ~k0 : (k0 | 0x80000000u); k1 = (k1 & 0x80000000u) ? ~k1 : (k1 | 0x80000000u);
            unsigned prefix = 0u; int need = 16;
            for (int bit = 31; bit >= 0; --bit) {
                const unsigned cand = (prefix | (1u << bit)) >> bit;
                const int cnt = __builtin_popcountll(__ballot((k0 >> bit) == cand)) + __builtin_popcountll(__ballot((k1 >> bit) == cand));
                if (cnt >= need) prefix |= (1u << bit); else need -= cnt;
            }
            const unsigned long long e0 = __ballot(k0 == prefix), e1 = __ballot(k1 == prefix);
            const int r0 = (int)__builtin_amdgcn_mbcnt_hi((unsigned)(e0 >> 32), __builtin_amdgcn_mbcnt_lo((unsigned)e0, 0u));
            const int r1 = __builtin_popcountll(e0) + (int)__builtin_amdgcn_mbcnt_hi((unsigned)(e1 >> 32), __builtin_amdgcn_mbcnt_lo((unsigned)e1, 0u));
            const bool sel0 = k0 > prefix || (k0 == prefix && r0 < need), sel1 = k1 > prefix || (k1 == prefix && r1 < need);
            const unsigned long long m0 = __ballot(sel0), m1 = __ballot(sel1);
            const unsigned w0 = (unsigned)m0, w1 = (unsigned)(m0 >> 32), w2 = (unsigned)m1, w3 = (unsigned)(m1 >> 32);
            wum[0] |= w0; wum[1] |= w1; wum[2] |= w2; wum[3] |= w3;
            if (lane == 0) { SM[(8 * wave + tk) * 4 + 0] = w0; SM[(8 * wave + tk) * 4 + 1] = w1; SM[(8 * wave + tk) * 4 + 2] = w2; SM[(8 * wave + tk) * 4 + 3] = w3; }
        }
        if (lane == 0) { UW[wave * 4 + 0] = wum[0]; UW[wave * 4 + 1] = wum[1]; UW[wave * 4 + 2] = wum[2]; UW[wave * 4 + 3] = wum[3]; }
    }
    __syncthreads();
    const u32x4 smw = *(const LAS u32x4*)(SM + (8 * wave + (fr & 7)) * 4);
    unsigned um[4];
#pragma unroll
    for (int w = 0; w < 4; ++w) { unsigned v = 0u;
#pragma unroll
        for (int q = 0; q < 8; ++q) v |= UW[q * 4 + w];
        um[w] = __builtin_amdgcn_readfirstlane(v); }
    const bf16* KS = WSP(bf16, WS_KS) + (size_t)bg * SEQ * 128; const bf16* VS = WSP(bf16, WS_VST) + (size_t)bg * 128 * 8192;
    const bf16* KW = WSP(bf16, WS_KW) + (size_t)bg * SEQ * 128; const bf16* VW = WSP(bf16, WS_VWT) + (size_t)bg * 128 * 8192;
    for (int dr_ = 0; dr_ < (DBG_NSA == 2 ? 2 : 1); ++dr_) {
        float m = -1e30f, l = 0.f; f32x4 o[8];
#pragma unroll
        for (int dt = 0; dt < 8; ++dt) o[dt] = ZERO4;
        u32x4 rk2[2], rv2[2];
        int j = 0, jn = sel_next(0, qt, um), cb = 0;
        attn_load_tile(rk, rv, KS, VS, 64, tid); attn_store_tile(F.lds, 0, rk, rv, tid);
        if (jn <= qt) attn_load_tile(rk, rv, KS + (size_t)jn * 64 * 128, VS + (size_t)jn * 128 * 64, 64, tid);
        __syncthreads();
        while (j <= qt) {
            int jnn = jn <= qt ? sel_next(jn, qt, um) : jn;
            sel_step(F, KS, VS, j, jn, jnn, qt, cb, rk, rv, rk2, rv2, qf, smw, wum, tok, hg, m, l, o);
            cb ^= 1; j = jn; jn = jnn;
            if (j > qt) break;
            jnn = jn <= qt ? sel_next(jn, qt, um) : jn;
            sel_step(F, KS, VS, j, jn, jnn, qt, cb, rk2, rv2, rk, rv, qf, smw, wum, tok, hg, m, l, o);
            cb ^= 1; j = jn; jn = jnn;
        }
        const float gt = (DBG_NSA == 2 && dr_ == 0) ? zf_ * l : sigmoidf_(small[row * SMW + S_BG + (2 * g + hg) * 3 + 1]) / l;
#pragma unroll
        for (int dt = 0; dt < 8; ++dt) tot[dt] = tot[dt] + o[dt] * gt;
    }
    for (int dr_ = 0; dr_ < (DBG_NSA == 3 ? 2 : 1); ++dr_) {
        float m = -1e30f, l = 0.f; f32x4 o[8];
#pragma unroll
        for (int dt = 0; dt < 8; ++dt) o[dt] = ZERO4;
        const int j0 = qt >= 8 ? qt - 8 : 0;
        attn_load_tile(rk, rv, KW + (size_t)j0 * 64 * 128, VW + (size_t)j0 * 128 * 64, 64, tid); attn_store_tile(F.lds, 0, rk, rv, tid); __syncthreads();
        for (int j = j0; j <= qt; ++j) {
            const int cb = (j - j0) & 1;
            if (j + 1 <= qt) attn_load_tile(rk, rv, KW + (size_t)(j + 1) * 64 * 128, VW + (size_t)(j + 1) * 128 * 64, 64, tid);
            f32x4 s[4], p[4];
            const unsigned vm = (j >= qt - 7 && j < qt) ? attn_scores<2, 2>(F.lds, cb, qf, lane, 64 * j, tok, hg, 0u, s) : attn_scores<2, 0>(F.lds, cb, qf, lane, 64 * j, tok, hg, 0u, s);
            const float sc = attn_online(s, vm, m, l, p);
#pragma unroll
            for (int dt = 0; dt < 8; ++dt) o[dt] = o[dt] * sc;
            attn_pv(F.lds, cb, lane, p, o);
            if (j + 1 <= qt) attn_store_tile(F.lds, cb ^ 1, rk, rv, tid);
            __syncthreads();
        }
        const float gt = (DBG_NSA == 3 && dr_ == 0) ? zf_ * l : sigmoidf_(small[row * SMW + S_BG + (2 * g + hg) * 3 + 2]) / l;
#pragma unroll
        for (int dt = 0; dt < 8; ++dt) tot[dt] = tot[dt] + o[dt] * gt;
    }
    {
        bf16* YC = WSP(bf16, WS_YCAT);
#pragma unroll
        for (int dt = 0; dt < 8; ++dt) { const int cidx = (2 * g + hg) * 128 + 16 * dt + 4 * fq;
            f32x4 y = tot[dt]; if (DBG_ZERO & 2) y = ZERO4;
            u32x2 w; w.x = pk2(y[0], y[1]); w.y = pk2(y[2], y[3]); *(u32x2*)(YC + row * 2048 + 512 + cidx) = w; }
    }
    __syncthreads();
}

DEV void gdn_scan_job(Frame& F, int job) {
    const int bh = job >> 3, sl = job & 7, b = bh >> 2, h = bh & 3, lane = F.lane, wave = F.wave, fq = lane >> 4, fr = lane & 15;
    LAS bf16* St = (LAS bf16*)F.lds;
    LAS bf16* Vn = St + 16 * 136;
    const float* GL = WSP(float, WS_GL); float* GO = WSP(float, WS_GO);
    const float zf_ = opaque_zero();
    __syncthreads();
    for (int i = F.tid; i < 16 * 136 / 2; i += 512) ((LAS unsigned*)St)[i] = 0u;
    f32x4 S = ZERO4;
    const int mt = wave & 3;
    __syncthreads();
    const int o1 = (wave < 4 ? 0 : 8192) + (16 * mt + fr) * 128 + 8 * fq;
    const int oA = 32768 + (16 * mt + fr) * 64 + 8 * fq;
    const int oK = 16384 + (16 * wave + fr) * 64 + 8 * fq;
    const int oU = 24576 + (16 * sl + fr) * 64 + 16 * mt + 4 * fq;
    const bf16* rec = (const bf16*)(F.ws + WS_GW + (size_t)(bh * 128) * GDN_CH_BYTES);
    bf16x8 a1[4], aA[2], aK[2], n1[4], nA[2], nK[2]; u32x2 uu, nu; float gl, ngl;
#define GLOAD(A1, AA, AK, UU, G, c_) do { const bf16* r_ = rec + (size_t)(c_) * (GDN_CH_BYTES / 2); \
        _Pragma("unroll") for (int ks = 0; ks < 4; ++ks) A1[ks] = *(const bf16x8*)(r_ + o1 + 32 * ks); \
        AA[0] = *(const bf16x8*)(r_ + oA); AA[1] = *(const bf16x8*)(r_ + oA + 32); AK[0] = *(const bf16x8*)(r_ + oK); AK[1] = *(const bf16x8*)(r_ + oK + 32); \
        UU = *(const u32x2*)(r_ + oU); G = GL[bh * 128 + (c_)]; } while (0)
    GLOAD(a1, aA, aK, uu, gl, 0);
    for (int c = 0; c < 128; ++c) {
        const int cn = c + 1 < 128 ? c + 1 : c;
        GLOAD(n1, nA, nK, nu, ngl, cn);
        f32x4 d1 = ZERO4;
#pragma unroll
        for (int ks = 0; ks < 4; ++ks) d1 = mfma16(a1[ks], frag_l(St, 136, 0, 32 * ks, lane), d1);
        if (wave < 4) {
            const float v0 = bflo(uu.x) - d1[0], v1 = bfhi(uu.x) - d1[1], v2 = bflo(uu.y) - d1[2], v3 = bfhi(uu.y) - d1[3];
            u32x2 w; w.x = pk2(v0, v1); w.y = pk2(v2, v3);
            *(LAS u32x2*)(Vn + fr * 72 + 16 * mt + 4 * fq) = w;
        }
        LDS_WAIT(); __builtin_amdgcn_s_barrier(); CFENCE();
        const bf16x8 bv0 = frag_l(Vn, 72, 0, 0, lane), bv1 = frag_l(Vn, 72, 0, 32, lane);
        if (wave >= 4) {
            d1 = mfma16(aA[0], bv0, d1); d1 = mfma16(aA[1], bv1, d1);
#pragma unroll
            for (int r = 0; r < 4; ++r) GO[(size_t)(b * SEQ + 64 * c + 16 * mt + 4 * fq + r) * 512 + h * 128 + 16 * sl + fr] = d1[r];
        }
        f32x4 dk = ZERO4;
        dk = mfma16(aK[0], bv0, dk); dk = mfma16(aK[1], bv1, dk);
        S = S * gl + dk;
        { u32x2 w; w.x = pk2(S[0], S[1]); w.y = pk2(S[2], S[3]); *(LAS u32x2*)(St + fr * 136 + 16 * wave + 4 * fq) = w; }
        LDS_WAIT(); __builtin_amdgcn_s_barrier(); CFENCE();
#pragma unroll
        for (int ks = 0; ks < 4; ++ks) a1[ks] = n1[ks];
        aA[0] = nA[0]; aA[1] = nA[1]; aK[0] = nK[0]; aK[1] = nK[1]; uu = nu; gl = ngl;
    }
#undef GLOAD
    __syncthreads();
}

DEV void ssd_scan_part(Frame& F, int part, int nparts) {
    float* __restrict__ SST = WSP(float, WS_SST); const float* __restrict__ SCD = WSP(float, WS_SCD);
    constexpr int PER_B = 16 * 64 * 128;
    for (int e = part * 512 + F.tid; e < 2 * PER_B; e += nparts * 512) {
        const int b = e / PER_B, r = e - b * PER_B, h = r >> 13;
        float* p = SST + (size_t)(b * 64) * PER_B + r; const float* cdp = SCD + (b * 64) * 16 + h;
        float s = 0.f;
#pragma unroll
        for (int hb = 0; hb < 2; ++hb) {
            float v[32], cd[32];
#pragma unroll
            for (int c = 0; c < 32; ++c) { v[c] = p[(size_t)(32 * hb + c) * PER_B]; cd[c] = cdp[(32 * hb + c) * 16]; }
#pragma unroll
            for (int c = 0; c < 32; ++c) { p[(size_t)(32 * hb + c) * PER_B] = s; s = s * cd[c] + v[c]; }
        }
    }
}

DEV void gdn_final_rows(Frame& F, int l, int w0, int nw) {
    const float* GO = WSP(float, WS_GO); const bf16* p1 = WSP(bf16, WS_P1); bf16* YC = WSP(bf16, WS_YCAT); const float* gn = lin(F, I_GNORM, l, 128);
    const int lane = F.lane, dv0 = (lane & 15) * 8;
    float gv[8];
#pragma unroll
    for (int j = 0; j < 8; ++j) gv[j] = gn[dv0 + j];
    for (int row = w0; row < MTOK; row += nw) {
        const f32x4 a = *(const f32x4*)(GO + (size_t)row * 512 + lane * 8), bq = *(const f32x4*)(GO + (size_t)row * 512 + lane * 8 + 4);
        float ss = (a[0] * a[0] + a[1] * a[1]) + (a[2] * a[2] + a[3] * a[3]) + (bq[0] * bq[0] + bq[1] * bq[1]) + (bq[2] * bq[2] + bq[3] * bq[3]);
        ss = sum16(ss);
        const float rs = rsqrtf(ss * (1.0f / 128.0f) + EPS);
        const u32x4 zw = *(const u32x4*)(p1 + (size_t)row * P1W + C_AZ + lane * 8);
        const float z[8] = {bflo(zw.x), bfhi(zw.x), bflo(zw.y), bfhi(zw.y), bflo(zw.z), bfhi(zw.z), bflo(zw.w), bfhi(zw.w)};
        const float o[8] = {a[0], a[1], a[2], a[3], bq[0], bq[1], bq[2], bq[3]};
        float y[8];
#pragma unroll
        for (int j = 0; j < 8; ++j) y[j] = (DBG_ZERO & 1) ? opaque_zero() : o[j] * rs * gv[j] * siluf_(z[j]);
        u32x4 w; w.x = pk2(y[0], y[1]); w.y = pk2(y[2], y[3]); w.z = pk2(y[4], y[5]); w.w = pk2(y[6], y[7]);
        *(u32x4*)(YC + (size_t)row * 2048 + lane * 8) = w;
    }
}

DEV void ssd_out_job(Frame& F, int l, int job) {
    const int b = job >> 7, c = (job >> 1) & 63, g = job & 1, t0 = 128 * c, tid = F.tid, lane = F.lane, wave = F.wave, fq = lane >> 4, fr = lane & 15;
    const bf16* SX = WSP(bf16, WS_SX); const bf16* p1 = WSP(bf16, WS_P1); const float* SDT = WSP(float, WS_SDT); const float* SAC = WSP(float, WS_SAC); const float* SST = WSP(float, WS_SST);
    bf16* YC = WSP(bf16, WS_YCAT); float* RC = WSP(float, WS_SRC);
    const float zf_ = opaque_zero();
    LAS bf16* Cs = (LAS bf16*)F.lds;
    LAS bf16* Bs = Cs + 128 * 136;
    LAS bf16* XdT = Bs + 128 * 136;
    LAS bf16* SiT = XdT + 64 * 136;
    LAS bf16* Pw = SiT + 64 * 136;
    LAS float* acs = (LAS float*)(Pw + 8 * 16 * 136);
    __syncthreads();
    for (int i = tid; i < 2 * 128 * 16; i += 512) { const int v = i >> 11, r = (i >> 4) & 127, c8 = (i & 15) * 8;
        const u32x4 w = *(const u32x4*)(SX + (size_t)(b * SEQ + t0 + r) * 1536 + 1024 + (v ? 256 : 0) + g * 128 + c8);
        *(LAS u32x4*)((v ? Cs : Bs) + r * 136 + c8) = w; }
    for (int i = tid; i < 1024; i += 512) { const size_t row = (size_t)(b * SEQ + t0 + (i >> 3)); acs[i] = SAC[row * 16 + 8 * g + (i & 7)]; }
    __syncthreads();
    f32x4 cb[8];
    {
        bf16x8 ca[4];
#pragma unroll
        for (int ks = 0; ks < 4; ++ks) ca[ks] = frag_l(Cs, 136, 16 * wave, 32 * ks, lane);
#pragma unroll
        for (int nt = 0; nt < 8; ++nt) { cb[nt] = ZERO4;
#pragma unroll
            for (int ks = 0; ks < 4; ++ks) cb[nt] = mfma16(ca[ks], frag_l(Bs, 136, 16 * nt, 32 * ks, lane), cb[nt]); }
    }
    float ssq[4] = {0.f, 0.f, 0.f, 0.f};
    LAS bf16* pw = Pw + wave * 16 * 136;
    const float* dsk = lin(F, I_SD, l, 16);
    for (int hh = 0; hh < 8; ++hh) {
        const int h = 8 * g + hh;
        __syncthreads();
        for (int i = tid; i < 64 * 128; i += 512) { const int p = i & 63, s = i >> 6;
            XdT[p * 136 + s] = (bf16)f2bf(bf2f(SX[(size_t)(b * SEQ + t0 + s) * 1536 + h * 64 + p]) * SDT[(size_t)(b * SEQ + t0 + s) * 16 + h]); }
        { const float* sin = SST + ((size_t)((b * 64 + c) * 16 + h) * 64) * 128;
          for (int i = tid; i < 64 * 32; i += 512) { const int p = i >> 5, n4 = (i & 31) * 4; const f32x4 v = *(const f32x4*)(sin + p * 128 + n4);
              u32x2 w; w.x = pk2(v[0], v[1]); w.y = pk2(v[2], v[3]); *(LAS u32x2*)(SiT + p * 136 + n4) = w; } }
        float al[4];
#pragma unroll
        for (int r = 0; r < 4; ++r) al[r] = acs[(16 * wave + 4 * fq + r) * 8 + hh];
#pragma unroll
        for (int nt = 0; nt < 8; ++nt) { const int s = 16 * nt + fr; const float as = acs[s * 8 + hh];
#pragma unroll
            for (int r = 0; r < 4; ++r) { const int li = 16 * wave + 4 * fq + r; const float v = s <= li ? cb[nt][r] * __expf(al[r] - as) : 0.f; pw[(4 * fq + r) * 136 + s] = (bf16)f2bf(v); } }
        __syncthreads();
        f32x4 y[4], ys[4];
#pragma unroll
        for (int nt = 0; nt < 4; ++nt) { y[nt] = ZERO4; ys[nt] = ZERO4; }
#pragma unroll
        for (int ks = 0; ks < 4; ++ks) { const bf16x8 pa = frag_l(pw, 136, 0, 32 * ks, lane), cc = frag_l(Cs, 136, 16 * wave, 32 * ks, lane);
#pragma unroll
            for (int nt = 0; nt < 4; ++nt) { y[nt] = mfma16(pa, frag_l(XdT, 136, 16 * nt, 32 * ks, lane), y[nt]); ys[nt] = mfma16(cc, frag_l(SiT, 136, 16 * nt, 32 * ks, lane), ys[nt]); } }
        const float dh = dsk[h];
        unsigned short xv[4][4], zv[4][4];
#pragma unroll
        for (int r = 0; r < 4; ++r) { const size_t row = (size_t)(b * SEQ + t0 + 16 * wave + 4 * fq + r);
#pragma unroll
            for (int nt = 0; nt < 4; ++nt) { xv[r][nt] = SX[row * 1536 + h * 64 + 16 * nt + fr]; zv[r][nt] = p1[row * P1W + C_CZ + h * 64 + 16 * nt + fr]; } }
        CFENCE();
#pragma unroll
        for (int r = 0; r < 4; ++r) { const size_t row = (size_t)(b * SEQ + t0 + 16 * wave + 4 * fq + r); const float ea = __expf(al[r]);
#pragma unroll
            for (int nt = 0; nt < 4; ++nt) { const int p = 16 * nt + fr;
                const float xs = bf2f(xv[r][nt]); const float z = bf2f(zv[r][nt]);
                const float v = (DBG_ZERO & 4) ? zf_ : (y[nt][r] + ea * ys[nt][r] + xs * dh) * siluf_(z);
                ssq[r] += v * v; YC[row * 2048 + 1024 + h * 64 + p] = (bf16)f2bf(v); } }
    }
#pragma unroll
    for (int r = 0; r < 4; ++r) { const float s = sum16(ssq[r]); if (fr == 0) RC[(size_t)(b * SEQ + t0 + 16 * wave + 4 * fq + r) * 2 + g] = rsqrtf(s * (1.0f / 512.0f) + EPS); }
    __syncthreads();
}

constexpr int NPH = 12;
#ifndef CPU_EMU
DEV unsigned long long launder64(unsigned long long v) {
    unsigned lo = __builtin_amdgcn_readfirstlane((unsigned)v), hi = __builtin_amdgcn_readfirstlane((unsigned)(v >> 32));
    asm volatile("" : "+s"(lo), "+s"(hi));
    return ((unsigned long long)hi << 32) | lo;
}
DEV bool phase_begin(Frame& F, const Params& prm, int wave0) {
    F.ws = (unsigned char*)launder64((unsigned long long)prm.ws);
    F.p = (KParams)launder64((unsigned long long)__builtin_amdgcn_kernarg_segment_ptr());
    unsigned z = 0u; asm volatile("" : "+v"(z)); const int ln = (int)__builtin_amdgcn_mbcnt_hi(~0u, __builtin_amdgcn_mbcnt_lo(~0u, z));
    int wv = wave0; asm volatile("" : "+s"(wv)); F.wave = wv; F.lane = ln; F.tid = wv * 64 + ln;
    int bi = __builtin_amdgcn_readfirstlane(blockIdx.x); asm volatile("" : "+s"(bi)); F.bid = bi;
    int gg = __builtin_amdgcn_readfirstlane(gridDim.x); asm volatile("" : "+s"(gg)); F.G = gg;
    unsigned la = __builtin_amdgcn_readfirstlane((unsigned)(size_t)F.lds); asm volatile("" : "+s"(la)); F.lds = (LAS unsigned char*)(size_t)la;
    return true;
}
DEV void job_begin(Frame& F) { int t = F.tid; asm volatile("" : "+v"(t)); F.tid = t; F.lane = t & 63; }
__global__ void __launch_bounds__(512, 2) hybrid_fwd(Params prm) {
    extern __shared__ __attribute__((aligned(16))) unsigned char lds_raw[];
    Frame F;
    F.lds = (LAS unsigned char*)lds_raw; F.tid = threadIdx.x; F.lane = F.tid & 63; F.wave = __builtin_amdgcn_readfirstlane(F.tid >> 6);
    const int wave0 = F.wave;
    F.G = gridDim.x; F.bid = blockIdx.x; F.p = (KParams)__builtin_amdgcn_kernarg_segment_ptr(); F.ws = prm.ws;
    volatile LAS unsigned* MISC = (volatile LAS unsigned*)(F.lds + MISC_OFF);
    if (F.tid < 64) MISC[F.tid] = 0u;
    __syncthreads();
    unsigned* ctl = (unsigned*)(F.ws + WS_CTL);
    XcdBarrier bar; bar.bar = ctl + CW_BAR; bar.x = 0; bar.st = nullptr;
    if (prm.use_bar) bar = xcd_barrier_post(ctl + CW_BAR, MISC + 8);
    const int lo = prm.lo, hi = prm.hi;
    for (int l = 0; l < DEPTH; ++l) {
#define IN(k) (lo <= l * NPH + (k) && l * NPH + (k) < hi && phase_begin(F, prm, wave0))
#define REP_BEGIN(k) for (int rep_ = 0; rep_ < ((DBG_REP == (k)) ? 2 : 1); ++rep_) {
#define REP_END(k) if (DBG_REP == (k) && rep_ == 0) { XcdBarrier bb_ = bar; bb_.bar = (unsigned*)launder64((unsigned long long)bar.bar); xcd_barrier(bb_); } }
#define SEAM(k) do { if (l * NPH + (k) + 1 < hi && prm.use_bar) { XcdBarrier bb_ = bar; bb_.bar = (unsigned*)launder64((unsigned long long)bar.bar); { unsigned x_ = __builtin_amdgcn_readfirstlane(bar.x); asm volatile("" : "+s"(x_)); bb_.x = x_; } xcd_barrier(bb_); } } while (0)
#define RSB(i) (WSP(unsigned long long, WS_CTL) + CW_RS / 2 + (size_t)(3 * l + (i)) * MTOK)
#define XB WSP(bf16, WS_XB)
#define ACT WSP(bf16, WS_ACT)
        if (IN(0)) { REP_BEGIN(0) phase_convert(F, l); REP_END(0) SEAM(0); }
        if (IN(1)) { REP_BEGIN(1) pg8::Gemm g{XB, WSP(bf16, WS_WUP1), MTOK, NUP, DM, DM, DM}; pg8::StaticOrder S; S.init(MTOK, NUP, F.G, F.bid);
            pg8::EpiSwiGLU E{ACT, RSB(0)}; pg8::gemm_phase<pg8::EpiSwiGLU, pg8::StaticOrder>(F.lds, F.tid, g, S, E); REP_END(1) SEAM(1); }
        if (IN(2)) { pg8::Gemm g{ACT, WSP(bf16, WS_WDN1), MTOK, DM, DFF, DFF, DFF}; pg8::StaticOrder S; S.init(MTOK, DM, F.G, F.bid);
            pg8::EpiResidual E{prm.out, XB, RSB(1), 0.5f}; pg8::gemm_phase<pg8::EpiResidual, pg8::StaticOrder>(F.lds, F.tid, g, S, E); SEAM(2); }
        if (IN(3)) { REP_BEGIN(3) pg8::Gemm g{XB, WSP(bf16, WS_WIN), MTOK, NINP, DM, DM, DM}; pg8::StaticOrder S; S.init(MTOK, NINP, F.G, F.bid);
            pg8::EpiWin E{WSP(bf16, WS_P1), WSP(float, WS_SMALL), WSP(bf16, WS_GATE), RSB(1)}; pg8::gemm_phase<pg8::EpiWin, pg8::StaticOrder>(F.lds, F.tid, g, S, E); REP_END(3) SEAM(3); }
        if (IN(4)) {
            REP_BEGIN(4)
            {
                unsigned* ctr = WSP(unsigned, WS_CTL) + CW_WQ + 64 * (8 + l * 2 + rep_);
                LAS unsigned* jslot = (LAS unsigned*)(F.lds + MISC_OFF + 128);
                for (;;) {
                    __syncthreads();
                    if (F.tid == 0) *jslot = __hip_atomic_fetch_add(ctr, 1u, __ATOMIC_RELAXED, __HIP_MEMORY_SCOPE_AGENT);
                    __syncthreads();
                    const int j = (int)*jslot;
                    if (j >= 32 + 1024 + 256 + 512) break;
                    job_begin(F);
                    if (j < 32) nsa_compress_job(F, l, j);
                    else if (j < 32 + 256) ssd_prep_job(F, l, j - 32);
                    else if (j < 32 + 256 + 1024) gdn_prep_job(F, l, j - 32 - 256);
                    else nsa_prep_job(F, l, j - 32 - 256 - 1024);
                }
            }
            REP_END(4)
            SEAM(4);
        }
        if (IN(5)) {
            REP_BEGIN(5)
            if (F.bid < 64) gdn_scan_job(F, (F.bid & 7) * 8 + (F.bid >> 3));
            else if (rep_ == 0) ssd_scan_part(F, F.bid - 64, F.G - 64);
            {
                unsigned* ctr = WSP(unsigned, WS_CTL) + CW_WQ + 64 * (16 + (l * 2 + rep_) * 8);
                LAS unsigned* jslot = (LAS unsigned*)(F.lds + MISC_OFF + 128);
                const unsigned myq = xb_xcc_id() & 7u;
                for (;;) {
                    __syncthreads();
                    if (F.tid == 0) {
                        unsigned got = 0xffffffffu;
                        for (unsigned t = 0; t < 8u && got == 0xffffffffu; ++t) { const unsigned q = (myq + t) & 7u;
                            if (__hip_atomic_load(ctr + 64 * q, __ATOMIC_RELAXED, __HIP_MEMORY_SCOPE_AGENT) >= 64u) continue;
                            const unsigned k = __hip_atomic_fetch_add(ctr + 64 * q, 1u, __ATOMIC_RELAXED, __HIP_MEMORY_SCOPE_AGENT);
                            if (k < 64u) got = (q >> 1) * 128u + (127u - (2u * k + (q & 1u))); }
                        *jslot = got;
                    }
                    __syncthreads();
                    const unsigned j = *jslot;
                    if (j == 0xffffffffu) break;
                    job_begin(F);
                    nsa_job(F, (int)j);
                }
            }
            REP_END(5)
            SEAM(5);
        }
        if (IN(7)) {
            REP_BEGIN(7)
            for (int j = F.bid; j < 256; j += F.G) { job_begin(F); ssd_out_job(F, l, j); }
            job_begin(F);
            gdn_final_rows(F, l, F.bid * 8 + F.wave, F.G * 8);
            REP_END(7)
            SEAM(7);
        }
        if (IN(8)) { REP_BEGIN(8) pg8::Gemm g{WSP(bf16, WS_YCAT), WSP(bf16, WS_WPM), MTOK, DM, 512, DM, DM}; pg8::SegOrder S; S.init(MTOK, DM, F.G, F.bid, 512);
            pg8::EpiMergeSeg E{WSP(bf16, WS_MERGED), WSP(bf16, WS_GATE), WSP(float, WS_SRC)}; pg8::gemm_phase<pg8::EpiMergeSeg, pg8::SegOrder>(F.lds, F.tid, g, S, E); REP_END(8) SEAM(8); }
        if (IN(9)) { pg8::Gemm g{WSP(bf16, WS_MERGED), WSP(bf16, WS_WO), MTOK, DM, DM, DM, DM}; pg8::StaticOrder S; S.init(MTOK, DM, F.G, F.bid);
            pg8::EpiResidual E{prm.out, XB, RSB(2), 1.0f}; pg8::gemm_phase<pg8::EpiResidual, pg8::StaticOrder>(F.lds, F.tid, g, S, E); SEAM(9); }
        if (IN(10)) { pg8::Gemm g{XB, WSP(bf16, WS_WUP2), MTOK, NUP, DM, DM, DM}; pg8::StaticOrder S; S.init(MTOK, NUP, F.G, F.bid);
            pg8::EpiSwiGLU E{ACT, RSB(2)}; pg8::gemm_phase<pg8::EpiSwiGLU, pg8::StaticOrder>(F.lds, F.tid, g, S, E); SEAM(10); }
        if (IN(11)) { pg8::Gemm g{ACT, WSP(bf16, WS_WDN2), MTOK, DM, DFF, DFF, DFF}; pg8::StaticOrder S; S.init(MTOK, DM, F.G, F.bid);
            pg8::EpiResidual E{prm.out, XB, RSB(3), 0.5f}; pg8::gemm_phase<pg8::EpiResidual, pg8::StaticOrder>(F.lds, F.tid, g, S, E); SEAM(11); }
#undef IN
#undef SEAM
#undef REP_BEGIN
#undef REP_END
#undef RSB
#undef XB
#undef ACT
    }
}

#ifndef DBG_DUMP
#define DBG_DUMP 0
#endif
#ifndef DBG_STOP
#define DBG_STOP 48
#endif
__global__ void dbg_dump_bf16(const unsigned short* src, size_t n, float* out, size_t nout) {
    for (size_t i = (size_t)blockIdx.x * blockDim.x + threadIdx.x; i < nout; i += (size_t)gridDim.x * blockDim.x) { float s = 0.f; for (size_t k = i; k < n; k += nout) s += __builtin_bit_cast(float, (unsigned)src[k] << 16); out[i] = s; }
}
__global__ void dbg_dump_f32(const float* src, size_t n, float* out, size_t nout) {
    for (size_t i = (size_t)blockIdx.x * blockDim.x + threadIdx.x; i < nout; i += (size_t)gridDim.x * blockDim.x) { float s = 0.f; for (size_t k = i; k < n; k += nout) s += src[k]; out[i] = s; }
}
#ifndef N_LAUNCH_MODE
#define N_LAUNCH_MODE 0
#endif
extern "C" void kernel_launch(void* const* d_in, const int* in_sizes, int n_in, void* d_out, int out_size, void* d_ws, size_t ws_size, hipStream_t stream) {
    static int grid = 0;
    if (grid == 0) {
        if (n_in != 30 || out_size != MTOK * DM || ws_size < WS_END) { fprintf(stderr, "kernel_launch: unexpected shapes (n_in %d out %d ws %zu, need %zu)\n", n_in, out_size, ws_size, (size_t)WS_END); grid = -1; return; }
        int dev = 0, cus = 0, per_cu = 0;
        if (hipGetDevice(&dev) != hipSuccess || hipDeviceGetAttribute(&cus, hipDeviceAttributeMultiprocessorCount, dev) != hipSuccess) { grid = -1; return; }
        if (hipFuncSetAttribute((const void*)hybrid_fwd, hipFuncAttributeMaxDynamicSharedMemorySize, LDS_BYTES) != hipSuccess) { fprintf(stderr, "kernel_launch: hipFuncSetAttribute failed\n"); grid = -1; return; }
        if (hipOccupancyMaxActiveBlocksPerMultiprocessor(&per_cu, (const void*)hybrid_fwd, 512, LDS_BYTES) != hipSuccess || per_cu < 1) { fprintf(stderr, "kernel_launch: occupancy query says %d\n", per_cu); }
        (void)hipGetLastError();
        grid = cus;
    }
    if (grid < 0) return;
    (void)hipMemsetAsync((char*)d_ws + WS_CTL, 0, CTL_BYTES, stream);
    Params p{};
    for (int i = 0; i < 30; ++i) p.in[i] = (const float*)d_in[i];
    p.out = (float*)d_out; p.ws = (unsigned char*)d_ws; p.pad = 0;
    if (N_LAUNCH_MODE == 0) { p.lo = 0; p.hi = DEPTH * NPH; p.use_bar = 1; hipLaunchKernelGGL(hybrid_fwd, dim3(grid), dim3(512), LDS_BYTES, stream, p); }
    else { for (int ph = 0; ph < (DBG_DUMP ? DBG_STOP : DEPTH * NPH); ++ph) { p.lo = ph; p.hi = ph + 1; p.use_bar = 0; hipLaunchKernelGGL(hybrid_fwd, dim3(grid), dim3(512), LDS_BYTES, stream, p); } }
    if (DBG_DUMP) {
        const size_t nout = (size_t)MTOK * DM; char* w = (char*)d_ws;
        if (DBG_DUMP == 1) hipLaunchKernelGGL(dbg_dump_bf16, dim3(2048), dim3(256), 0, stream, (const unsigned short*)(w + WS_P1), (size_t)MTOK * P1W, (float*)d_out, nout);
        if (DBG_DUMP == 2) hipLaunchKernelGGL(dbg_dump_f32, dim3(2048), dim3(256), 0, stream, (const float*)(w + WS_SMALL), (size_t)MTOK * SMW, (float*)d_out, nout);
        if (DBG_DUMP == 3) hipLaunchKernelGGL(dbg_dump_bf16, dim3(2048), dim3(256), 0, stream, (const unsigned short*)(w + WS_GW), (size_t)1024 * GDN_CH_BYTES / 2, (float*)d_out, nout);
        if (DBG_DUMP == 4) hipLaunchKernelGGL(dbg_dump_f32, dim3(2048), dim3(256), 0, stream, (const float*)(w + WS_SST), (size_t)2 * 64 * 16 * 64 * 128, (float*)d_out, nout);
        if (DBG_DUMP == 5) hipLaunchKernelGGL(dbg_dump_f32, dim3(2048), dim3(256), 0, stream, (const float*)(w + WS_GO), (size_t)MTOK * 512, (float*)d_out, nout);
        if (DBG_DUMP == 6) hipLaunchKernelGGL(dbg_dump_bf16, dim3(2048), dim3(256), 0, stream, (const unsigned short*)(w + WS_YCAT), (size_t)MTOK * 2048, (float*)d_out, nout);
        if (DBG_DUMP == 7) hipLaunchKernelGGL(dbg_dump_bf16, dim3(2048), dim3(256), 0, stream, (const unsigned short*)(w + WS_MERGED), (size_t)MTOK * 2048, (float*)d_out, nout);
        if (DBG_DUMP == 8) hipLaunchKernelGGL(dbg_dump_bf16, dim3(2048), dim3(256), 0, stream, (const unsigned short*)(w + WS_SX), (size_t)MTOK * 1536, (float*)d_out, nout);
        if (DBG_DUMP == 9) hipLaunchKernelGGL(dbg_dump_bf16, dim3(2048), dim3(256), 0, stream, (const unsigned short*)(w + WS_GATE), (size_t)MTOK * 6144, (float*)d_out, nout);
        if (DBG_DUMP == 11) hipLaunchKernelGGL(dbg_dump_f32, dim3(2048), dim3(256), 0, stream, (const float*)(w + WS_SRC), (size_t)MTOK * 2, (float*)d_out, nout);
        if (DBG_DUMP == 12) hipLaunchKernelGGL(dbg_dump_bf16, dim3(2048), dim3(256), 0, stream, (const unsigned short*)(w + WS_WPM), (size_t)DM * DM, (float*)d_out, nout);
        if (DBG_DUMP == 13) hipLaunchKernelGGL(dbg_dump_f32, dim3(2048), dim3(256), 0, stream, (const float*)(w + WS_MTMP), (size_t)MTOK * DM, (float*)d_out, nout);
        if (DBG_DUMP == 15) hipLaunchKernelGGL(dbg_dump_bf16, dim3(2048), dim3(256), 0, stream, (const unsigned short*)(w + WS_ACT), (size_t)MTOK * DFF, (float*)d_out, nout);
        if (DBG_DUMP == 16) hipLaunchKernelGGL(dbg_dump_bf16, dim3(2048), dim3(256), 0, stream, (const unsigned short*)(w + WS_XB), (size_t)MTOK * DM, (float*)d_out, nout);
        if (DBG_DUMP == 17) hipLaunchKernelGGL(dbg_dump_bf16, dim3(2048), dim3(256), 0, stream, (const unsigned short*)(w + WS_WIN), (size_t)NINP * DM, (float*)d_out, nout);
        if (DBG_DUMP == 18) hipLaunchKernelGGL(dbg_dump_f32, dim3(2048), dim3(256), 0, stream, (const float*)(w + WS_CTL) + CW_RS, (size_t)NRS * MTOK, (float*)d_out, nout);
        if (DBG_DUMP == 10) hipLaunchKernelGGL(dbg_dump_f32, dim3(2048), dim3(256), 0, stream, (const float*)(w + WS_YB), (size_t)MTOK * 512, (float*)d_out, nout);
    }
}
#endif
```

```cpp
#include <hip/hip_runtime.h>
#include <cstdio>
#include <cstdint>

#ifndef CPU_EMU
#define DEV __device__ __forceinline__
#define LAS __attribute__((address_space(3)))
#define VM_WAIT() asm volatile("s_waitcnt vmcnt(0)" ::: "memory")
#define LDS_WAIT() asm volatile("s_waitcnt lgkmcnt(0)" ::: "memory")
#define CFENCE() asm volatile("" ::: "memory")
#define WAVE_SYNC() do { asm volatile("" ::: "memory"); __builtin_amdgcn_wave_barrier(); asm volatile("" ::: "memory"); } while (0)
#endif

#define DBG_DUMP 0
#define DBG_NSAZ 0
#define DBG_NSA 0
#define DBG_REP (-1)
#define DBG_STOP 48
#ifndef DBG_ZERO
#define DBG_ZERO 0
#endif
typedef unsigned short bf16;
typedef short bf16x8 __attribute__((ext_vector_type(8)));
typedef float f32x4 __attribute__((ext_vector_type(4)));
typedef float f32x2 __attribute__((ext_vector_type(2)));
typedef unsigned u32x4 __attribute__((ext_vector_type(4)));
typedef unsigned u32x2 __attribute__((ext_vector_type(2)));

constexpr int BATCH = 2, SEQ = 8192, DM = 2048, DEPTH = 4, DFF = 5504, NUP = 2 * DFF;
constexpr int MTOK = BATCH * SEQ;
constexpr int NIN = 12836, NINP = 13056;
constexpr int P1W = 6656;
constexpr int SM0 = 6656;
constexpr int GT0 = 6912;
constexpr float EPS = 1e-6f;
constexpr int C_AQ = 0, C_AK = 512, C_AV = 1024, C_AZ = 1536, C_BQ = 2048, C_BKC = 2560, C_BVC = 2816, C_BKS = 3072, C_BVS = 3328, C_BKW = 3584, C_BVW = 3840, C_CZ = 4096, C_CX = 5120;
constexpr int S_AA = 0, S_AB = 4, S_BG = 8, S_DT = 20, SMW = 64;

constexpr size_t MiB = 1u << 20;
constexpr size_t WS_CTL = 0, CTL_BYTES = 2 * MiB;
constexpr size_t WS_WUP1 = 2 * MiB;
constexpr size_t WS_WDN1 = WS_WUP1 + (size_t)NUP * DM * 2;
constexpr size_t WS_WIN = WS_WDN1 + (size_t)DM * DFF * 2;
constexpr size_t WS_WPM = WS_WIN + (size_t)NINP * DM * 2;
constexpr size_t WS_WO = WS_WPM + (size_t)DM * DM * 2;
constexpr size_t WS_WUP2 = WS_WO + (size_t)DM * DM * 2;
constexpr size_t WS_WDN2 = WS_WUP2 + (size_t)NUP * DM * 2;
constexpr size_t WS_WCK = WS_WDN2 + (size_t)DM * DFF * 2;
constexpr size_t WS_WCV = WS_WCK + 128 * 4096 * 2;
constexpr size_t WS_CONST = WS_WCV + 128 * 4096 * 2;
constexpr size_t WS_WEND = WS_CONST + 4096;
static_assert(WS_WEND <= 212 * MiB, "weights region");
constexpr size_t WS_XB = 212 * MiB;
constexpr size_t WS_P1 = 276 * MiB;
constexpr size_t WS_ACT = WS_P1;
constexpr size_t WS_GATE = 484 * MiB;
constexpr size_t WS_SMALL = 676 * MiB;
constexpr size_t WS_MERGED = 680 * MiB;
constexpr size_t WS_YCAT = 744 * MiB;
constexpr size_t WS_GW = 808 * MiB;
constexpr size_t GDN_CH_BYTES = 73728;
constexpr size_t WS_GL = 880 * MiB;
constexpr size_t WS_GO = 881 * MiB;
constexpr size_t WS_SX = 913 * MiB;
constexpr size_t WS_SDT = 961 * MiB;
constexpr size_t WS_SAC = 962 * MiB;
constexpr size_t WS_SST = 963 * MiB;
constexpr size_t WS_SCD = 1027 * MiB;
constexpr size_t WS_SRC = 1028 * MiB;
constexpr size_t WS_QN = 1029 * MiB;
constexpr size_t WS_KS = 1045 * MiB;
constexpr size_t WS_KW = 1053 * MiB;
constexpr size_t WS_VST = 1061 * MiB;
constexpr size_t WS_VWT = 1069 * MiB;
constexpr size_t WS_KCMP = 1077 * MiB;
constexpr size_t WS_VCMPT = 1078 * MiB;
constexpr size_t WS_SELM = 1079 * MiB;
constexpr size_t WS_YB = 1080 * MiB;
constexpr size_t WS_MTMP = 1112 * MiB;
constexpr size_t WS_END = 1240 * MiB;
static_assert(WS_P1 + (size_t)MTOK * P1W * 2 <= WS_GATE && WS_GATE + (size_t)MTOK * 6144 * 2 <= WS_SMALL && WS_SMALL + (size_t)MTOK * SMW * 4 <= WS_MERGED && WS_MERGED + (size_t)MTOK * DM * 2 <= WS_YCAT && WS_YCAT + (size_t)MTOK * 2048 * 2 <= WS_GW, "ws map 1");
static_assert(WS_GW + 1024 * GDN_CH_BYTES <= WS_GL && WS_GO + (size_t)MTOK * 512 * 4 <= WS_SX && WS_SX + (size_t)MTOK * 1536 * 2 <= WS_SDT && WS_SDT + (size_t)MTOK * 16 * 4 <= WS_SAC && WS_SAC + (size_t)MTOK * 16 * 4 <= WS_SST && WS_SST + (size_t)2 * 64 * 16 * 64 * 128 * 4 <= WS_SCD, "ws map 2");
static_assert(WS_SRC + (size_t)MTOK * 2 * 4 <= WS_QN && WS_QN + (size_t)4 * SEQ * 256 * 2 <= WS_KS && WS_KS + (size_t)4 * SEQ * 128 * 2 <= WS_KW && WS_KW + (size_t)4 * SEQ * 128 * 2 <= WS_VST && WS_VST + (size_t)4 * SEQ * 128 * 2 <= WS_VWT && WS_VWT + (size_t)4 * SEQ * 128 * 2 <= WS_KCMP, "ws map 3");
static_assert(WS_KCMP + 4 * 512 * 128 * 2 <= WS_VCMPT && WS_VCMPT + 4 * 512 * 128 * 2 <= WS_SELM && WS_SELM + (size_t)4 * SEQ * 16 <= WS_YB && WS_YB + (size_t)MTOK * 512 * 4 <= WS_END && WS_XB + (size_t)MTOK * DM * 2 <= WS_P1 && (size_t)MTOK * DFF * 2 <= (size_t)MTOK * P1W * 2, "ws map 4");

constexpr int CW_BAR = 1024;
constexpr int CW_RS = 16384;
constexpr int NRS = 13;
constexpr int CW_WQ = 8192;
static_assert(CW_RS * 4 + NRS * MTOK * 8 <= (int)CTL_BYTES, "ctl");

constexpr int RING_BYTES = 131072;
constexpr int MISC_OFF = RING_BYTES + 12288;
constexpr int LDS_BYTES = 147456;

DEV unsigned f2bf(float f) { unsigned u = __builtin_bit_cast(unsigned, f); return (u + 0x7fffu + ((u >> 16) & 1u)) >> 16; }
DEV float bf2f(unsigned b) { return __builtin_bit_cast(float, (b & 0xffffu) << 16); }
DEV unsigned pk2(float lo, float hi) { return f2bf(lo) | (f2bf(hi) << 16); }
DEV float bflo(unsigned w) { return __builtin_bit_cast(float, w << 16); }
DEV float bfhi(unsigned w) { return __builtin_bit_cast(float, w & 0xffff0000u); }
DEV float sigmoidf_(float x) { return 1.0f / (1.0f + __expf(-x)); }
DEV float siluf_(float x) { return x / (1.0f + __expf(-x)); }
DEV float softplusf_(float x) {
    const float e = __expf(-fabsf(x)), u = 1.0f + e, d = u - 1.0f;
    const float lp = d == 0.f ? e : __logf(u) * (e / d);
    return fmaxf(x, 0.f) + lp;
}
#ifndef CPU_EMU
template <int M, class T> DEV T shx(T v) {
    static_assert(sizeof(T) == 4, "shx: 32-bit values");
    const int iv = __builtin_bit_cast(int, v);
    if constexpr (M < 32) return __builtin_bit_cast(T, __builtin_amdgcn_ds_swizzle(iv, 0x1f | (M << 10)));
    else { unsigned z = 0u; asm volatile("" : "+v"(z)); const unsigned ln = __builtin_amdgcn_mbcnt_hi(~0u, __builtin_amdgcn_mbcnt_lo(~0u, z));
        return __builtin_bit_cast(T, __builtin_amdgcn_ds_bpermute((int)((ln ^ 32u) << 2), iv)); }
}
#endif
DEV float wave_sum(float v) { v += shx<1>(v); v += shx<2>(v); v += shx<4>(v); v += shx<8>(v); v += shx<16>(v); v += shx<32>(v); return v; }
DEV float sum16(float v) { v += shx<1>(v); v += shx<2>(v); v += shx<4>(v); v += shx<8>(v); return v; }
DEV float max16(float v) { v = fmaxf(v, shx<1>(v)); v = fmaxf(v, shx<2>(v)); v = fmaxf(v, shx<4>(v)); v = fmaxf(v, shx<8>(v)); return v; }
#ifndef CPU_EMU
DEV float opaque_zero() { float z = 0.f; asm volatile("" : "+v"(z)); return z; }
#endif
#define ZERO4 ((f32x4){zf_, zf_, zf_, zf_})
DEV f32x4 mfma16(bf16x8 a, bf16x8 b, f32x4 c) { return __builtin_amdgcn_mfma_f32_16x16x32_bf16(a, b, c, 0, 0, 0); }
DEV bf16x8 frag_g(const bf16* base, int pitch, int row0, int k0, int lane) { return *(const bf16x8*)(base + (size_t)(row0 + (lane & 15)) * pitch + k0 + 8 * (lane >> 4)); }
DEV bf16x8 frag_l(const LAS bf16* base, int pitch, int row0, int k0, int lane) { return *(const LAS bf16x8*)(base + (row0 + (lane & 15)) * pitch + k0 + 8 * (lane >> 4)); }
#ifndef CPU_EMU
DEV const LAS void* lds_vbase(const LAS void* p) { unsigned a = (unsigned)(size_t)p; asm volatile("" : "+v"(a)); return (const LAS void*)(size_t)a; }
#endif

struct Params {
    const float* in[30];
    float* out;
    unsigned char* ws;
    int lo, hi;
    int use_bar, pad;
};
enum { I_X = 0, I_REL, I_GF1, I_WUP1, I_WDN1, I_GMIX, I_WIN, I_GCONV, I_GALOG, I_GDTB, I_GNORM, I_NQN, I_NKN, I_NPEK, I_NPEV, I_NWCK, I_NWCV,
       I_SCW, I_SCB, I_SDTB, I_SALOG, I_SD, I_SNORM, I_PA, I_PB, I_PC, I_WO, I_GF2, I_WUP2, I_WDN2 };

#define XB_TMO      128
#define XB_XCNT(j)  (256  + 64 * (j))
#define XB_XSUB(j)  (1280 + 64 * (j))
#define XB_XGEN(j)  (2304 + 64 * (j))
#define XB_TOP      3328
#define XB_TOPGEN   3392
#define XCD_BAR_WORDS 3456
#define XB_SPIN_CAP (1u << 22)
#ifndef CPU_EMU
DEV unsigned xb_ld(unsigned* p)              { return __hip_atomic_load(p, __ATOMIC_RELAXED, __HIP_MEMORY_SCOPE_AGENT); }
DEV unsigned xb_add(unsigned* p, unsigned v) { return __hip_atomic_fetch_add(p, v, __ATOMIC_RELAXED, __HIP_MEMORY_SCOPE_AGENT); }
DEV unsigned xb_xcc_id() { return (unsigned)__builtin_amdgcn_s_getreg((3 << 11) | 20) & 0xFu; }
#define XB_SPIN(cond, bar) do { unsigned _sp = 0; while (cond) { __builtin_amdgcn_s_sleep(1); \
    if ((++_sp & 255u) == 0u) { if (xb_ld(&(bar)[XB_TMO])) break; if (_sp > XB_SPIN_CAP) { atomicAdd(&(bar)[XB_TMO], 1u); break; } } } } while (0)
struct XcdBarrier { unsigned* bar; unsigned x; volatile LAS unsigned* st; };
DEV XcdBarrier xcd_barrier_post(unsigned* bar, volatile LAS unsigned* st) {
    XcdBarrier b; b.bar = bar; b.x = xb_xcc_id(); b.st = st;
    if (threadIdx.x == 0) (void)xb_add(&bar[XB_XCNT(b.x)], 1u);
    return b;
}
DEV void xcd_barrier_complete(unsigned* bar, unsigned x, unsigned& nloc, unsigned& nx) {
    const unsigned G = gridDim.x * gridDim.y * gridDim.z;
    unsigned sum, cnt, mine, sp = 0u;
    for (;;) {
        sum = 0u; cnt = 0u; mine = 0u;
#pragma unroll
        for (unsigned j = 0; j < 16; ++j) { const unsigned c = xb_ld(&bar[XB_XCNT(j)]); sum += c; cnt += (c > 0u) ? 1u : 0u; mine = (j == x) ? c : mine; }
        if (sum == G) break;
        __builtin_amdgcn_s_sleep(1);
        if ((++sp & 255u) == 0u) { if (xb_ld(&bar[XB_TMO])) break; if (sp > XB_SPIN_CAP) { atomicAdd(&bar[XB_TMO], 1u); break; } }
    }
    nloc = mine > 0u ? mine : 1u; nx = cnt > 0u ? cnt : 1u;
}
DEV void xcd_barrier(const XcdBarrier& b) {
    asm volatile("s_waitcnt vmcnt(0)" ::: "memory");
    __syncthreads();
    if (threadIdx.x == 0) {
        unsigned* bar = b.bar;
        __builtin_amdgcn_s_waitcnt(0);
        unsigned nloc = b.st[0], nx = b.st[1];
        if (nloc == 0u) { xcd_barrier_complete(bar, b.x, nloc, nx); b.st[0] = nloc; b.st[1] = nx; }
        const unsigned old = xb_add(&bar[XB_XSUB(b.x)], 1u);
        const unsigned gen = old / nloc;
        if (old + 1u == (gen + 1u) * nloc) {
            __builtin_amdgcn_fence(__ATOMIC_RELEASE, "agent");
            asm volatile("s_waitcnt vmcnt(0)" ::: "memory");
            const unsigned og = xb_add(&bar[XB_TOP], 1u);
            const unsigned tg = og / nx;
            if (og + 1u == (tg + 1u) * nx) xb_add(&bar[XB_TOPGEN], 1u);
            else XB_SPIN(xb_ld(&bar[XB_TOPGEN]) == tg, bar);
            __builtin_amdgcn_fence(__ATOMIC_ACQUIRE, "agent");
            xb_add(&bar[XB_XGEN(b.x)], 1u);
            asm volatile("s_waitcnt vmcnt(0)" ::: "memory");
        } else {
            XB_SPIN(xb_ld(&bar[XB_XGEN(b.x)]) == gen, bar);
            __builtin_amdgcn_fence(__ATOMIC_ACQUIRE, "agent");
            asm volatile("s_waitcnt vmcnt(0)" ::: "memory");
        }
    }
    __syncthreads();
}
#endif

namespace pg8 {
constexpr int BM = 256, BK = 64, HALF = 128, HTB = HALF * BK * 2, STAGE_BYTES = 8 * HTB, NXCD = 8, WGM = 8;
__host__ __device__ __forceinline__ int lds_byte(int r, int c) { const int st = (r >> 4) * 2 + (c >> 5), rr = r & 15, cc = c & 31, ob = rr * 64 + cc * 2; return st * 1024 + (ob ^ (((ob >> 9) & 1) << 5)); }
__host__ __device__ __forceinline__ void stage_rc(int b, int& R, int& C) { const int st = b / 1024, sb = b % 1024, swz = sb ^ (((sb >> 9) & 1) << 5); R = (st >> 1) * 16 + swz / 64; C = (st & 1) * 32 + (swz % 64) / 2; }
__host__ __device__ __forceinline__ int perm32(int rho) { const int n = rho >> 4, i = rho & 15; return 8 * (i >> 2) + 4 * n + (i & 3); }
struct Unit { int pm, pn, koff, seg; };
struct Gemm { const bf16* A; const bf16* Bt; int M, N, K, lda, ldb; };
struct StaticOrder {
    int nM, nN, nwg, G, c;
    __host__ __device__ void init(int M, int N, int G_, int c_) { nM = M / BM; nN = N / BM; nwg = nM * nN; G = G_; c = c_; }
    __host__ __device__ bool next(int i, Unit& u) const {
        const long L = (long)i * G + c; if (L >= nwg) return false;
        int wgid = (int)L; { const int q = nwg / NXCD, r = nwg % NXCD, xcd = wgid % NXCD, off = wgid / NXCD; wgid = (xcd < r ? xcd * (q + 1) : r * (q + 1) + (xcd - r) * q) + off; }
        const int nig = WGM * nN, gid = wgid / nig, fm = gid * WGM, gsz = (nM - fm) < WGM ? (nM - fm) : WGM;
        u.pm = fm + ((wgid % nig) % gsz); u.pn = (wgid % nig) / gsz; u.koff = 0; u.seg = 0; return true;
    }
};
struct SegOrder {
    StaticOrder S; int kseg;
    __host__ __device__ void init(int M, int N, int G_, int c_, int kseg_) { S.init(M, N, G_, c_); kseg = kseg_; }
    __host__ __device__ bool next(int i, Unit& u) const { if (!S.next(i >> 2, u)) return false; u.seg = i & 3; u.koff = u.seg * kseg; return true; }
};
#ifndef CPU_EMU
DEV unsigned cvt_pk_bf16(float lo, float hi) { unsigned r; asm volatile("s_nop 1\n\tv_cvt_pk_bf16_f32 %0, %1, %2" : "=v"(r) : "v"(lo), "v"(hi)); return r; }
#endif
DEV unsigned long long rss_fix(float ss) { return (unsigned long long)(ss * 16777216.0f + 0.5f); }
DEV float rss_val(unsigned long long v) { return (float)v * (1.0f / 16777216.0f); }

struct EpiSwiGLU {
    static constexpr bool PERM = true, SEGACC = false;
    bf16* act; const unsigned long long* rss;
    DEV void operator()(const f32x4 (&acc)[2][2][4][2], const Unit& u, int wr, int wc, int fr, int fq) const {
        const int row0 = u.pm * BM + wr * 64 + fr, col0 = u.pn * HALF + wc * 32 + 8 * fq;
        unsigned long long rv[8];
#pragma unroll
        for (int i = 0; i < 8; ++i) rv[i] = rss[row0 + (i >> 2) * HALF + (i & 3) * 16];
        CFENCE();
#pragma unroll
        for (int ai = 0; ai < 2; ++ai)
#pragma unroll
            for (int m = 0; m < 4; ++m) {
                const int row = row0 + ai * HALF + m * 16;
                const float rs = rsqrtf(rss_val(rv[ai * 4 + m]) * (1.0f / DM) + EPS);
                float o[8];
#pragma unroll
                for (int n = 0; n < 2; ++n)
#pragma unroll
                    for (int j = 0; j < 4; ++j) { const float a = acc[ai][0][m][n][j] * rs, b = acc[ai][1][m][n][j] * rs; o[4 * n + j] = a * b * __builtin_amdgcn_rcpf(1.0f + __expf(-a)); }
                u32x4 w; w.x = cvt_pk_bf16(o[0], o[1]); w.y = cvt_pk_bf16(o[2], o[3]); w.z = cvt_pk_bf16(o[4], o[5]); w.w = cvt_pk_bf16(o[6], o[7]);
                *(u32x4*)(act + (size_t)row * DFF + col0) = w;
            }
    }
};
struct EpiResidual {
    static constexpr bool PERM = true, SEGACC = false;
    float* x; bf16* xb; unsigned long long* rss_out; float alpha;
    DEV void operator()(const f32x4 (&acc)[2][2][4][2], const Unit& u, int wr, int wc, int fr, int fq) const {
        const int row0 = u.pm * BM + wr * 64 + fr, col0 = u.pn * BM + wc * 32 + 8 * fq;
#pragma unroll
        for (int aim = 0; aim < 4; ++aim) {
            const int ai = aim >> 1, m0 = (aim & 1) * 2;
            f32x4 xv[2][2][2];
#pragma unroll
            for (int mm = 0; mm < 2; ++mm)
#pragma unroll
                for (int bj = 0; bj < 2; ++bj) { const float* xp = x + (size_t)(row0 + ai * HALF + (m0 + mm) * 16) * DM + col0 + bj * HALF; xv[mm][bj][0] = *(const f32x4*)xp; xv[mm][bj][1] = *(const f32x4*)(xp + 4); }
            CFENCE();
#pragma unroll
            for (int mm = 0; mm < 2; ++mm) {
                const int m = m0 + mm, row = row0 + ai * HALF + m * 16; float ss = 0.f;
#pragma unroll
                for (int bj = 0; bj < 2; ++bj) {
                    float* xp = x + (size_t)row * DM + col0 + bj * HALF;
                    const f32x4 x0 = xv[mm][bj][0] + acc[ai][bj][m][0] * alpha, x1 = xv[mm][bj][1] + acc[ai][bj][m][1] * alpha;
                    *(f32x4*)xp = x0; *(f32x4*)(xp + 4) = x1;
                    ss += (x0[0] * x0[0] + x0[1] * x0[1]) + (x0[2] * x0[2] + x0[3] * x0[3]) + (x1[0] * x1[0] + x1[1] * x1[1]) + (x1[2] * x1[2] + x1[3] * x1[3]);
                    u32x4 w; w.x = cvt_pk_bf16(x0[0], x0[1]); w.y = cvt_pk_bf16(x0[2], x0[3]); w.z = cvt_pk_bf16(x1[0], x1[1]); w.w = cvt_pk_bf16(x1[2], x1[3]);
                    *(u32x4*)(xb + (size_t)row * DM + col0 + bj * HALF) = w;
                }
                ss += shx<16>(ss); ss += shx<32>(ss);
                if (fq == 0) atomicAdd(rss_out + row, rss_fix(ss));
            }
            CFENCE();
        }
    }
};
struct EpiWin {
    static constexpr bool PERM = true, SEGACC = false;
    bf16* p1; float* small; bf16* gate; const unsigned long long* rss;
    DEV void operator()(const f32x4 (&acc)[2][2][4][2], const Unit& u, int wr, int wc, int fr, int fq) const {
        const int row0 = u.pm * BM + wr * 64 + fr, cl0 = wc * 32 + 8 * fq;
        unsigned long long rv[8];
#pragma unroll
        for (int i = 0; i < 8; ++i) rv[i] = rss[row0 + (i >> 2) * HALF + (i & 3) * 16];
        CFENCE();
#pragma unroll
        for (int ai = 0; ai < 2; ++ai)
#pragma unroll
            for (int m = 0; m < 4; ++m) {
                const int row = row0 + ai * HALF + m * 16;
                const float rs = rsqrtf(rss_val(rv[ai * 4 + m]) * (1.0f / DM) + EPS);
#pragma unroll
                for (int bj = 0; bj < 2; ++bj) {
                    f32x4 v0 = acc[ai][bj][m][0] * rs, v1 = acc[ai][bj][m][1] * rs;
                    const int cl = cl0 + bj * HALF;
                    if (u.pn < 26) {
                        u32x4 w; w.x = cvt_pk_bf16(v0[0], v0[1]); w.y = cvt_pk_bf16(v0[2], v0[3]); w.z = cvt_pk_bf16(v1[0], v1[1]); w.w = cvt_pk_bf16(v1[2], v1[3]);
                        *(u32x4*)(p1 + (size_t)row * P1W + u.pn * BM + cl) = w;
                    } else if (u.pn == 26) {
                        if (cl < SMW) { float* sp = small + (size_t)row * SMW + cl; *(f32x4*)sp = v0; *(f32x4*)(sp + 4) = v1; }
                    } else {
#pragma unroll
                        for (int j = 0; j < 4; ++j) { v0[j] = fminf(__builtin_amdgcn_rcpf(1.0f + __expf(-v0[j])), 1.0f); v1[j] = fminf(__builtin_amdgcn_rcpf(1.0f + __expf(-v1[j])), 1.0f); }
                        u32x4 w; w.x = cvt_pk_bf16(v0[0], v0[1]); w.y = cvt_pk_bf16(v0[2], v0[3]); w.z = cvt_pk_bf16(v1[0], v1[1]); w.w = cvt_pk_bf16(v1[2], v1[3]);
                        *(u32x4*)(gate + (size_t)row * 6144 + (u.pn - 27) * BM + cl) = w;
                    }
                }
            }
    }
};
struct EpiMergeSeg {
    static constexpr bool PERM = true, SEGACC = true;
    bf16* merged; const bf16* gate; const float* rc;
    DEV void seg(f32x4 (&acc)[2][2][4][2], const Unit& u, int wr, int wc, int fr, int fq) const {
        const int row0 = u.pm * BM + wr * 64 + fr, col0 = u.pn * BM + wc * 32 + 8 * fq, sg = u.seg;
        f32x2 rcv[8];
#pragma unroll
        for (int i = 0; i < 8; ++i) rcv[i] = *(const f32x2*)(rc + (size_t)(row0 + (i >> 2) * HALF + (i & 3) * 16) * 2);
        const int offa = sg == 0 ? 0 : (sg == 1 ? DM : 2 * DM), offb = sg == 0 ? DM : 2 * DM;
#pragma unroll
        for (int aim = 0; aim < 4; ++aim) {
            const int ai = aim >> 1, m0 = (aim & 1) * 2;
            u32x4 wa[2][2], wb[2][2];
            if (sg != 2) {
#pragma unroll
                for (int mm = 0; mm < 2; ++mm)
#pragma unroll
                    for (int bj = 0; bj < 2; ++bj) { const bf16* gp = gate + (size_t)(row0 + ai * HALF + (m0 + mm) * 16) * 6144 + col0 + bj * HALF; wa[mm][bj] = *(const u32x4*)(gp + offa); wb[mm][bj] = *(const u32x4*)(gp + offb); }
            }
            CFENCE();
#pragma unroll
            for (int mm = 0; mm < 2; ++mm) {
                const int m = m0 + mm, row = row0 + ai * HALF + m * 16;
                const float r0 = rcv[ai * 4 + m][0], r1 = rcv[ai * 4 + m][1];
#pragma unroll
                for (int bj = 0; bj < 2; ++bj) {
                    float f[8];
                    if (sg == 2) { const float q = fmaxf(r0, 1e-20f) / fmaxf(r1, 1e-20f);
#pragma unroll
                        for (int j = 0; j < 8; ++j) f[j] = q; }
                    else {
                        const u32x4 a4 = wa[mm][bj], b4 = wb[mm][bj];
                        const float na[8] = {bflo(a4.x), bfhi(a4.x), bflo(a4.y), bfhi(a4.y), bflo(a4.z), bfhi(a4.z), bflo(a4.w), bfhi(a4.w)};
                        const float nb[8] = {bflo(b4.x), bfhi(b4.x), bflo(b4.y), bfhi(b4.y), bflo(b4.z), bfhi(b4.z), bflo(b4.w), bfhi(b4.w)};
#pragma unroll
                        for (int j = 0; j < 8; ++j) {
                            if (sg == 0) f[j] = fmaxf(na[j], 1e-20f) * __builtin_amdgcn_rcpf(fmaxf(nb[j], 1e-20f));
                            else if (sg == 1) f[j] = fmaxf(na[j], 1e-20f) * __builtin_amdgcn_rcpf(fmaxf(nb[j] * r0, 1e-20f));
                            else f[j] = fmaxf(na[j] * r1, 1e-20f); }
                    }
                    f32x4 v0 = acc[ai][bj][m][0], v1 = acc[ai][bj][m][1];
#pragma unroll
                    for (int j = 0; j < 4; ++j) { v0[j] *= f[j]; v1[j] *= f[4 + j]; }
                    if (sg < 3) { acc[ai][bj][m][0] = v0; acc[ai][bj][m][1] = v1; }
                    else { u32x4 o; o.x = cvt_pk_bf16(v0[0], v0[1]); o.y = cvt_pk_bf16(v0[2], v0[3]); o.z = cvt_pk_bf16(v1[0], v1[1]); o.w = cvt_pk_bf16(v1[2], v1[3]);
                        *(u32x4*)(merged + (size_t)row * DM + col0 + bj * HALF) = o; }
                }
            }
            CFENCE();
        }
    }
};

#ifndef CPU_EMU
template <class Epi, class Sched>
DEV void gemm_phase(LAS unsigned char* lds, const int tid, const Gemm g, const Sched& S, const Epi& E) {
    const int wid = __builtin_amdgcn_readfirstlane(tid >> 6), lane = tid & 63, wr = wid >> 2, wc = wid & 3, fr = lane & 15, fq = lane >> 4;
    const int K = g.K, nt = K / BK;
    const float zf_ = opaque_zero();
    unsigned voffA[2], voffB[2];
#pragma unroll
    for (int i = 0; i < 2; ++i) { int R, C; stage_rc(tid * 16 + i * 8192, R, C); const int Rb = Epi::PERM ? ((R & ~31) + perm32(R & 31)) : R;
        voffA[i] = (unsigned)(R * g.lda + C) * 2u; voffB[i] = (unsigned)(Rb * g.ldb + C) * 2u; }
    const size_t kstep = (size_t)(BK * 2);
    const size_t hA = (size_t)HALF * g.lda * 2, hB = (size_t)HALF * g.ldb * 2;
    const size_t tA = 2 * hA, tB = 2 * hB;
    const unsigned ldsw = (unsigned)wid * 1024u;
    const int aoff = lds_byte(wr * 64 + fr, fq * 8), boff = lds_byte(wc * 32 + fr, fq * 8);
#define PG8_SA(b, h) (((b) * 2 + (h)) * HTB)
#define PG8_SB(b, h) ((4 + (b) * 2 + (h)) * HTB)
#define PG8_STAGE(bufoff, gbase, voff) do { _Pragma("unroll") for (int _i = 0; _i < 2; ++_i) \
        __builtin_amdgcn_global_load_lds((const unsigned*)((const char*)(gbase) + (voff)[_i]), (LAS unsigned*)(lds + (bufoff) + ldsw + _i * 8192), 16, 0, 0); } while (0)
#define PG8_LDA(dst, b, h) do { _Pragma("unroll") for (int m = 0; m < 4; ++m) _Pragma("unroll") for (int k = 0; k < 2; ++k) dst[m][k] = *(const LAS bf16x8*)(lds + PG8_SA(b, h) + aoff + m * 2048 + k * 1024); } while (0)
#define PG8_LDB(dst, b, h) do { _Pragma("unroll") for (int n = 0; n < 2; ++n) _Pragma("unroll") for (int k = 0; k < 2; ++k) dst[n][k] = *(const LAS bf16x8*)(lds + PG8_SB(b, h) + boff + n * 2048 + k * 1024); } while (0)
#define PG8_MMA(ai, bj, At, Bt) do { __builtin_amdgcn_s_setprio(1); _Pragma("unroll") for (int m = 0; m < 4; ++m) _Pragma("unroll") for (int n = 0; n < 2; ++n) _Pragma("unroll") for (int k = 0; k < 2; ++k) \
        acc[ai][bj][m][n] = __builtin_amdgcn_mfma_f32_16x16x32_bf16(Bt[n][k], At[m][k], acc[ai][bj][m][n], 0, 0, 0); __builtin_amdgcn_s_setprio(0); } while (0)
#define PG8_WAIT_V(n) asm volatile("s_waitcnt vmcnt(" #n ")" ::: "memory")
#define PG8_WAIT_L(n) asm volatile("s_waitcnt lgkmcnt(" #n ")" ::: "memory")
#define PG8_BAR __builtin_amdgcn_s_barrier()
#define PG8_SCHED __builtin_amdgcn_sched_barrier(0)
    Unit cur, nxt; int ui = 0;
    if (!S.next(0, cur)) return;
    f32x4 acc[2][2][4][2];
#pragma unroll
    for (int a = 0; a < 2; ++a)
#pragma unroll
        for (int b = 0; b < 2; ++b)
#pragma unroll
            for (int m = 0; m < 4; ++m)
#pragma unroll
                for (int n = 0; n < 2; ++n) acc[a][b][m][n] = ZERO4;
    bf16x8 At[4][2], B0[2][2], B1[2][2];
    const char* cA = (const char*)g.A + (size_t)cur.pm * tA + (size_t)cur.koff * 2; const char* cB = (const char*)g.Bt + (size_t)cur.pn * tB + (size_t)cur.koff * 2;
    PG8_STAGE(PG8_SB(0, 0), cB, voffB); PG8_STAGE(PG8_SB(0, 1), cB + hB, voffB); PG8_STAGE(PG8_SA(0, 0), cA, voffA); PG8_STAGE(PG8_SA(0, 1), cA + hA, voffA);
    if (wr == 1) PG8_BAR;
    PG8_WAIT_V(2); PG8_BAR;
    PG8_STAGE(PG8_SB(1, 0), cB + kstep, voffB); PG8_STAGE(PG8_SA(1, 0), cA + kstep, voffA); PG8_STAGE(PG8_SB(1, 1), cB + hB + kstep, voffB);
    PG8_WAIT_V(6); PG8_BAR;
    for (;;) {
        const bool has_next = S.next(ui + 1, nxt);
        const char* nA = has_next ? (const char*)g.A + (size_t)nxt.pm * tA + (size_t)nxt.koff * 2 : cA; const char* nB = has_next ? (const char*)g.Bt + (size_t)nxt.pn * tB + (size_t)nxt.koff * 2 : cB;
        for (int t = 0; t < nt; t += 2) {
            const bool last = (t == nt - 2);
            const char* a1 = cA + (size_t)(t + 1) * kstep;
            const char* a2 = last ? nA : cA + (size_t)(t + 2) * kstep; const char* b2 = last ? nB : cB + (size_t)(t + 2) * kstep;
            const char* a3 = a2 + kstep; const char* b3 = b2 + kstep;
            PG8_LDB(B0, 0, 0); PG8_LDB(B1, 0, 1); PG8_SCHED; PG8_LDA(At, 0, 0); PG8_STAGE(PG8_SA(1, 1), a1 + hA, voffA);
            PG8_WAIT_V(8); PG8_WAIT_L(0); PG8_BAR; PG8_MMA(0, 0, At, B0); PG8_MMA(0, 1, At, B1); PG8_BAR; PG8_SCHED;
            PG8_LDA(At, 0, 1); PG8_STAGE(PG8_SB(0, 0), b2, voffB); PG8_STAGE(PG8_SB(0, 1), b2 + hB, voffB); PG8_STAGE(PG8_SA(0, 0), a2, voffA);
            PG8_WAIT_V(8); PG8_WAIT_L(0); PG8_BAR; PG8_MMA(1, 0, At, B0); PG8_MMA(1, 1, At, B1); PG8_BAR; PG8_SCHED;
            PG8_LDB(B0, 1, 0); PG8_LDB(B1, 1, 1); PG8_SCHED; PG8_LDA(At, 1, 0); PG8_STAGE(PG8_SA(0, 1), a2 + hA, voffA);
            PG8_WAIT_V(8); PG8_WAIT_L(0); PG8_BAR; PG8_MMA(0, 0, At, B0); PG8_MMA(0, 1, At, B1); PG8_BAR; PG8_SCHED;
            PG8_LDA(At, 1, 1); PG8_STAGE(PG8_SB(1, 0), b3, voffB); PG8_STAGE(PG8_SB(1, 1), b3 + hB, voffB); PG8_STAGE(PG8_SA(1, 0), a3, voffA);
            PG8_WAIT_V(8); PG8_WAIT_L(0); PG8_BAR; PG8_MMA(1, 0, At, B0); PG8_MMA(1, 1, At, B1); PG8_BAR; PG8_SCHED;
        }
        if (wr == 0) PG8_BAR;
        if constexpr (Epi::SEGACC) E.seg(acc, cur, wr, wc, fr, fq); else E(acc, cur, wr, wc, fr, fq);
        if (!has_next) break;
        if (!(Epi::SEGACC && nxt.seg != 0)) {
#pragma unroll
        for (int a = 0; a < 2; ++a)
#pragma unroll
            for (int b = 0; b < 2; ++b)
#pragma unroll
                for (int m = 0; m < 4; ++m)
#pragma unroll
                    for (int n = 0; n < 2; ++n) acc[a][b][m][n] = ZERO4;
        }
        cur = nxt; cA = nA; cB = nB; ++ui;
        if (wr == 1) PG8_BAR;
    }
    PG8_WAIT_V(0);
    PG8_BAR;
#undef PG8_SA
#undef PG8_SB
#undef PG8_STAGE
#undef PG8_LDA
#undef PG8_LDB
#undef PG8_MMA
#undef PG8_WAIT_V
#undef PG8_WAIT_L
#undef PG8_BAR
#undef PG8_SCHED
}
#endif
}

#ifndef CPU_EMU
typedef const __attribute__((address_space(4))) Params* KParams;
#else
typedef const Params* KParams;
#endif
struct Frame {
    LAS unsigned char* lds;
    int tid, lane, wave, G, bid;
    KParams p;
    unsigned char* ws;
};
DEV const float* lin(const Frame& F, int idx, int layer, size_t per_layer) { return F.p->in[idx] + (size_t)layer * per_layer; }
#define WSP(T, off) ((T*)(F.ws + (off)))

DEV int up_dest(int n) { return n < DFF ? (n >> 7) * 256 + (n & 127) : ((n - DFF) >> 7) * 256 + 128 + ((n - DFF) & 127); }
DEV int win_dest(int n) {
    if (n < 2048) return n;
    if (n < 2052) return SM0 + S_AA + (n - 2048);
    if (n < 2056) return SM0 + S_AB + (n - 2052);
    if (n < 4104) return C_BQ + (n - 2056);
    if (n < 4116) return SM0 + S_BG + (n - 4104);
    if (n < 6676) return C_CZ + (n - 4116);
    if (n < 6692) return SM0 + S_DT + (n - 6676);
    return GT0 + (n - 6692);
}
struct XItem { const float* W; const float* ks; bf16* WT; int K, N, ldt, koff, mode, r; };
DEV void xitem_load(const XItem& it, int lane, float (&v)[32]) {
    const int nblk = (it.N + 31) / 32, kb = it.r / nblk, nb = it.r % nblk, k0 = 64 * kb, n0 = 32 * nb;
    const int nn = n0 + (lane & 31);
    const float* src = it.W + (size_t)(k0 + (lane >> 5)) * it.N + (nn < it.N ? nn : it.N - 1);
#pragma unroll
    for (int i = 0; i < 32; ++i) v[i] = src[(size_t)(2 * i) * it.N];
}
DEV void xitem_to_lds(LAS float* scr, int lane, const float (&v)[32]) {
#pragma unroll
    for (int i = 0; i < 32; ++i) scr[(2 * i + (lane >> 5)) * 33 + (lane & 31)] = v[i];
    LDS_WAIT(); CFENCE();
}
DEV void xitem_store(const XItem& it, LAS float* scr, int lane) {
    const int nblk = (it.N + 31) / 32, kb = it.r / nblk, nb = it.r % nblk, k0 = 64 * kb, n0 = 32 * nb;
    const int c = lane & 7;
    f32x4 ks0 = (f32x4){1.f, 1.f, 1.f, 1.f}, ks1 = ks0;
    if (it.ks) { ks0 = *(const f32x4*)(it.ks + k0 + 8 * c); ks1 = *(const f32x4*)(it.ks + k0 + 8 * c + 4); }
#pragma unroll
    for (int j = 0; j < 4; ++j) { const int n = (lane >> 3) + 8 * j; const LAS float* s = scr + (8 * c) * 33 + n;
        u32x4 o; o.x = pk2(s[0 * 33] * ks0[0], s[1 * 33] * ks0[1]); o.y = pk2(s[2 * 33] * ks0[2], s[3 * 33] * ks0[3]); o.z = pk2(s[4 * 33] * ks1[0], s[5 * 33] * ks1[1]); o.w = pk2(s[6 * 33] * ks1[2], s[7 * 33] * ks1[3]);
        const int ng = n0 + n;
        if (ng < it.N) { const int dr = it.mode == 0 ? ng : (it.mode == 1 ? up_dest(ng) : win_dest(ng)); *(u32x4*)(it.WT + (size_t)dr * it.ldt + it.koff + k0 + 8 * c) = o; } }
    LDS_WAIT(); CFENCE();
}
constexpr int XI_UP = (DM / 64) * (NUP / 32), XI_DN = (DFF / 64) * (DM / 32), XI_IN = (DM / 64) * ((NIN + 31) / 32), XI_P5 = (512 / 64) * (DM / 32), XI_P10 = (1024 / 64) * (DM / 32), XI_OO = (DM / 64) * (DM / 32), XI_CK = (4096 / 64) * (128 / 32);
constexpr int XI_TOTAL = 2 * XI_UP + 2 * XI_DN + XI_IN + 2 * XI_P5 + XI_P10 + XI_OO + 2 * XI_CK;
DEV XItem xitem_decode(Frame& F, int l, int idx) {
    XItem t; int r = idx; t.ks = nullptr; t.koff = 0; t.mode = 0;
    if (r < XI_UP) { t.W = lin(F, I_WUP1, l, (size_t)DM * NUP); t.K = DM; t.N = NUP; t.WT = WSP(bf16, WS_WUP1); t.ldt = DM; t.ks = lin(F, I_GF1, l, DM); t.mode = 1; }
    else if ((r -= XI_UP) < XI_UP) { t.W = lin(F, I_WUP2, l, (size_t)DM * NUP); t.K = DM; t.N = NUP; t.WT = WSP(bf16, WS_WUP2); t.ldt = DM; t.ks = lin(F, I_GF2, l, DM); t.mode = 1; }
    else if ((r -= XI_UP) < XI_DN) { t.W = lin(F, I_WDN1, l, (size_t)DFF * DM); t.K = DFF; t.N = DM; t.WT = WSP(bf16, WS_WDN1); t.ldt = DFF; }
    else if ((r -= XI_DN) < XI_DN) { t.W = lin(F, I_WDN2, l, (size_t)DFF * DM); t.K = DFF; t.N = DM; t.WT = WSP(bf16, WS_WDN2); t.ldt = DFF; }
    else if ((r -= XI_DN) < XI_IN) { t.W = lin(F, I_WIN, l, (size_t)DM * NIN); t.K = DM; t.N = NIN; t.WT = WSP(bf16, WS_WIN); t.ldt = DM; t.ks = lin(F, I_GMIX, l, DM); t.mode = 2; }
    else if ((r -= XI_IN) < XI_P5) { t.W = lin(F, I_PA, l, (size_t)512 * DM); t.K = 512; t.N = DM; t.WT = WSP(bf16, WS_WPM); t.ldt = DM; }
    else if ((r -= XI_P5) < XI_P5) { t.W = lin(F, I_PB, l, (size_t)512 * DM); t.K = 512; t.N = DM; t.WT = WSP(bf16, WS_WPM); t.ldt = DM; t.koff = 512; }
    else if ((r -= XI_P5) < XI_P10) { t.W = lin(F, I_PC, l, (size_t)1024 * DM); t.K = 1024; t.N = DM; t.WT = WSP(bf16, WS_WPM); t.ldt = DM; t.koff = 1024; t.ks = lin(F, I_SNORM, l, 1024); }
    else if ((r -= XI_P10) < XI_OO) { t.W = lin(F, I_WO, l, (size_t)DM * DM); t.K = DM; t.N = DM; t.WT = WSP(bf16, WS_WO); t.ldt = DM; }
    else if ((r -= XI_OO) < XI_CK) { t.W = lin(F, I_NWCK, l, (size_t)4096 * 128); t.K = 4096; t.N = 128; t.WT = WSP(bf16, WS_WCK); t.ldt = 4096; }
    else { r -= XI_CK; t.W = lin(F, I_NWCV, l, (size_t)4096 * 128); t.K = 4096; t.N = 128; t.WT = WSP(bf16, WS_WCV); t.ldt = 4096; }
    t.r = r; return t;
}
DEV void phase_convert(Frame& F, int l) {
    LAS float* scr = (LAS float*)(F.lds + F.wave * 16384);
    const int gw = F.bid * 8 + F.wave, NGW = F.G * 8;
    if (gw < XI_TOTAL) {
        float v[32]; XItem cur = xitem_decode(F, l, gw); xitem_load(cur, F.lane, v);
        for (int it = gw; it < XI_TOTAL; it += NGW) {
            xitem_to_lds(scr, F.lane, v);
            const bool has_next = it + NGW < XI_TOTAL; XItem nxt = cur;
            if (has_next) { nxt = xitem_decode(F, l, it + NGW); xitem_load(nxt, F.lane, v); }
            xitem_store(cur, scr, F.lane);
            cur = nxt;
        }
    }
    { bf16* w = WSP(bf16, WS_WIN) + (size_t)(SM0 + 36) * DM; const int n16 = (GT0 - SM0 - 36) * DM / 8;
      const unsigned zu = __builtin_bit_cast(unsigned, opaque_zero());
      for (int i = F.bid * 512 + F.tid; i < n16; i += F.G * 512) ((u32x4*)w)[i] = (u32x4){zu, zu, zu, zu}; }
    { const float* pek = lin(F, I_NPEK, l, 4096); const float* pev = lin(F, I_NPEV, l, 4096); float* cst = WSP(float, WS_CONST);
      for (int it = gw; it < 256; it += NGW) { const int e = it & 127; const float* pe = it < 128 ? pek : pev; const float* w = it < 128 ? lin(F, I_NWCK, l, (size_t)4096 * 128) : lin(F, I_NWCV, l, (size_t)4096 * 128); float s = 0.f;
          for (int k = F.lane; k < 4096; k += 64) s += pe[k] * w[(size_t)k * 128 + e];
          s = wave_sum(s); if (F.lane == 0) cst[it] = s; } }
    if (l == 0) {
        const float* x = F.p->in[I_X]; float* out = F.p->out; bf16* xb = WSP(bf16, WS_XB); unsigned long long* rss = WSP(unsigned long long, WS_CTL) + CW_RS / 2;
        for (int m = gw; m < MTOK; m += NGW) {
            const f32x4* xr = (const f32x4*)(x + (size_t)m * DM) + F.lane; f32x4* orow = (f32x4*)(out + (size_t)m * DM) + F.lane; u32x2* br = (u32x2*)(xb + (size_t)m * DM) + F.lane; float ss = 0.f;
#pragma unroll
            for (int j = 0; j < 8; ++j) { const f32x4 v = xr[64 * j]; orow[64 * j] = v; ss += (v[0] * v[0] + v[1] * v[1]) + (v[2] * v[2] + v[3] * v[3]); u32x2 w; w.x = pk2(v[0], v[1]); w.y = pk2(v[2], v[3]); br[64 * j] = w; }
            ss = wave_sum(ss); if (F.lane == 0) rss[m] = pg8::rss_fix(ss);
        }
    }
}

DEV void nsa_prep_job(Frame& F, int l, int job) {
    const int b = job >> 8, g = (job >> 7) & 1, j = job & 127, bg = b * 2 + g, t0 = 64 * j;
    const bf16* p1 = WSP(bf16, WS_P1);
    const float* qn = lin(F, I_NQN, l, 128); const float* kn = lin(F, I_NKN, l, 128);
    bf16* QN = WSP(bf16, WS_QN); bf16* KS = WSP(bf16, WS_KS); bf16* KW = WSP(bf16, WS_KW); bf16* VST = WSP(bf16, WS_VST); bf16* VWT = WSP(bf16, WS_VWT);
    const float gq0 = qn[2 * F.lane], gq1 = qn[2 * F.lane + 1], gk0 = kn[2 * F.lane], gk1 = kn[2 * F.lane + 1];
    unsigned wv[8][4];
#pragma unroll
    for (int i = 0; i < 8; ++i) { const size_t row = (size_t)(b * SEQ + t0 + 8 * F.wave + i) * P1W;
#pragma unroll
        for (int v = 0; v < 4; ++v) { const int col = v < 2 ? C_BQ + (g * 2 + v) * 128 : (v == 2 ? C_BKS + g * 128 : C_BKW + g * 128); wv[i][v] = *(const unsigned*)(p1 + row + col + 2 * F.lane); } }
    CFENCE();
#pragma unroll
    for (int i = 0; i < 8; ++i) {
        const int t = t0 + 8 * F.wave + i;
#pragma unroll
        for (int v = 0; v < 4; ++v) {
            const unsigned w = wv[i][v];
            const float x0 = bflo(w), x1 = bfhi(w);
            const float ss = wave_sum(x0 * x0 + x1 * x1);
            float r = rsqrtf(ss * (1.0f / 128.0f) + EPS);
            unsigned o;
            if (v < 2) { r *= 0.08838834764831845f * 1.4426950408889634f;     o = pk2(x0 * r * gq0, x1 * r * gq1); *(unsigned*)(QN + ((size_t)(bg * SEQ + t) * 2 + v) * 128 + 2 * F.lane) = o; }
            else { o = pk2(x0 * r * gk0, x1 * r * gk1); *(unsigned*)((v == 2 ? KS : KW) + (size_t)(bg * SEQ + t) * 128 + 2 * F.lane) = o; }
        }
    }
    LAS bf16* tl = (LAS bf16*)F.lds;
    for (int i = F.tid; i < 2 * 64 * 64; i += 512) {
        const int v = i >> 12, r = (i >> 6) & 63, c2 = i & 63;
        const unsigned w = *(const unsigned*)(p1 + (size_t)(b * SEQ + t0 + r) * P1W + (v ? C_BVW : C_BVS) + g * 128 + 2 * c2);
        *(LAS unsigned*)(tl + (v * 64 + r) * 130 + 2 * c2) = w;
    }
    __syncthreads();
    for (int i = F.tid; i < 2 * 128 * 8; i += 512) {
        const int v = i >> 10, d = i & 127, tc = (i >> 7) & 7;
        const LAS bf16* s = tl + (v * 64 + 8 * tc) * 130 + d;
        u32x4 o; o.x = s[0] | ((unsigned)s[130] << 16); o.y = s[260] | ((unsigned)s[390] << 16); o.z = s[520] | ((unsigned)s[650] << 16); o.w = s[780] | ((unsigned)s[910] << 16);
        *(u32x4*)((v ? VWT : VST) + ((size_t)(bg * 128 + j) * 128 + d) * 64 + 8 * tc) = o;
    }
    __syncthreads();
}

DEV void gdn_prep_job(Frame& F, int l, int job) {
    const int b = job >> 9, h = (job >> 7) & 3, c = job & 127, t0 = 64 * c;
    const bf16* p1 = WSP(bf16, WS_P1); const float* small = WSP(float, WS_SMALL);
    const float* convw = lin(F, I_GCONV, l, 4 * 1536);
    LAS float* Qs = (LAS float*)F.lds;
    LAS float* Ks = Qs + 64 * 132;
    LAS float* Vs = Ks + 64 * 132;
    LAS float* Mm = Vs + 64 * 132;
    LAS float* At = Mm + 64 * 68;
    LAS float* beta = At + 64 * 68;
    LAS float* gc = beta + 64;
    LAS float* eg = gc + 64;
    const int tid = F.tid;
    {
        const int ch = tid & 127, tg = tid >> 7;
#pragma unroll
        for (int v = 0; v < 3; ++v) {
            const int cc = v * 512 + h * 128 + ch;
            const float w0 = convw[cc], w1 = convw[1536 + cc], w2 = convw[2 * 1536 + cc], w3 = convw[3 * 1536 + cc];
            const int col = (v == 0 ? C_AQ : (v == 1 ? C_AK : C_AV)) + h * 128 + ch;
            float xin[19];
            { const int tt = t0 + 16 * tg;
#pragma unroll
              for (int i = 0; i < 19; ++i) { const int t = tt - 3 + i; xin[i] = t >= 0 ? bf2f(p1[(size_t)(b * SEQ + t) * P1W + col]) : 0.f; } }
            LAS float* dst = v == 0 ? Qs : (v == 1 ? Ks : Vs);
#pragma unroll
            for (int i = 0; i < 16; ++i) {
                const float y = w0 * xin[i] + w1 * xin[i + 1] + w2 * xin[i + 2] + w3 * xin[i + 3];
                dst[(16 * tg + i) * 132 + ch] = siluf_(y);
            }
        }
        if (tid < 64) {
            const size_t row = (size_t)(b * SEQ + t0 + tid);
            const float a = small[row * SMW + S_AA + h], bb = small[row * SMW + S_AB + h];
            beta[tid] = sigmoidf_(bb);
            gc[tid] = -__expf(lin(F, I_GALOG, l, 4)[h]) * softplusf_(a + lin(F, I_GDTB, l, 4)[h]);
        }
    }
    __syncthreads();
    for (int i = 0; i < 16; ++i) {
        const int r = F.wave * 16 + i;
        LAS float* p = (r < 64 ? Qs + r * 132 : Ks + (r - 64) * 132);
        const float x0 = p[F.lane], x1 = p[F.lane + 64];
        const float ss = wave_sum(x0 * x0 + x1 * x1);
        float sc = rsqrtf(ss + EPS); if (r < 64) sc *= 0.08838834764831845f;
        p[F.lane] = x0 * sc; p[F.lane + 64] = x1 * sc;
    }
    if (tid == 0) { float s = 0.f; for (int i = 0; i < 64; ++i) { s += gc[i]; gc[i] = s; eg[i] = __expf(s); } }
    for (int i = tid; i < 64 * 68; i += 512) At[i] = 0.f;
    __syncthreads();
    for (int tj = F.wave; tj < 20; tj += 8) {
        const int kind = tj >= 10 ? 1 : 0, idx = tj - 10 * kind;
        const int mt = idx >= 6 ? 3 : (idx >= 3 ? 2 : (idx >= 1 ? 1 : 0)), nt = idx - mt * (mt + 1) / 2;
        const int fr = F.lane & 15, fq = F.lane >> 4;
        const LAS float* ap = (kind ? Qs : Ks) + (16 * mt + fr) * 132 + 4 * fq; const LAS float* bp = Ks + (16 * nt + fr) * 132 + 4 * fq;
        f32x4 acc = (f32x4){0.f, 0.f, 0.f, 0.f};
#pragma unroll
        for (int sg = 0; sg < 8; ++sg) { const f32x4 a4 = *(const LAS f32x4*)(ap + 16 * sg), b4 = *(const LAS f32x4*)(bp + 16 * sg);
#pragma unroll
            for (int j = 0; j < 4; ++j) acc = __builtin_amdgcn_mfma_f32_16x16x4f32(a4[j], b4[j], acc, 0, 0, 0); }
        const int j = 16 * nt + fr; const float gj = gc[j];
#pragma unroll
        for (int r = 0; r < 4; ++r) { const int i = 16 * mt + 4 * fq + r; const float dec = j <= i ? __expf(gc[i] - gj) : 0.f;
            if (kind) At[i * 68 + j] = acc[r] * dec; else Mm[i * 68 + j] = j < i ? beta[i] * acc[r] * dec : 0.f; }
    }
    __syncthreads();
    unsigned char* cb = F.ws + WS_GW + (size_t)job * GDN_CH_BYTES;
    bf16* gW = (bf16*)cb; bf16* gQD = (bf16*)(cb + 16384); bf16* gKDT = (bf16*)(cb + 32768); bf16* gUT = (bf16*)(cb + 49152); bf16* gAT = (bf16*)(cb + 65536);
    float sol[64];
    if (tid < 256) {
        const int cidx = tid & 127; const bool isw = tid >= 128;
        const LAS float* src = (isw ? Ks : Vs) + cidx;
        const LAS float* MmL = (const LAS float*)lds_vbase(Mm); const LAS float* betaL = (const LAS float*)lds_vbase(beta); const LAS float* egL = (const LAS float*)lds_vbase(eg);
#pragma unroll
        for (int i = 0; i < 64; ++i) sol[i] = 0.f;
#pragma unroll
        for (int i = 0; i < 64; ++i) {
            float r = src[i * 132] * betaL[i] * (isw ? egL[i] : 1.0f), r1 = 0.f, r2 = 0.f, r3 = 0.f;
#pragma unroll
            for (int j4 = 0; j4 < (i + 3) / 4; ++j4) { const f32x4 mv = *(const LAS f32x4*)(MmL + i * 68 + 4 * j4);
                r -= mv[0] * sol[4 * j4]; r1 -= mv[1] * sol[4 * j4 + 1]; r2 -= mv[2] * sol[4 * j4 + 2]; r3 -= mv[3] * sol[4 * j4 + 3]; }
            r = (r + r1) + (r2 + r3);
            sol[i] = r;
            asm volatile("" : "+v"(sol[i]) :: "memory");
        }
    } else {
        const int t2 = tid - 256;
        const float gl = gc[63];
        for (int i = t2; i < 64 * 16; i += 256) { const int r = i >> 4, c8 = (i & 15) * 8; const float e = eg[r]; const LAS float* s = Qs + r * 132 + c8;
            u32x4 o; o.x = pk2(s[0] * e, s[1] * e); o.y = pk2(s[2] * e, s[3] * e); o.z = pk2(s[4] * e, s[5] * e); o.w = pk2(s[6] * e, s[7] * e); *(u32x4*)(gQD + r * 128 + c8) = o; }
        for (int i = t2; i < 128 * 8; i += 256) { const int dk = i & 127, i8 = (i >> 7) * 8; float v[8];
#pragma unroll
            for (int q = 0; q < 8; ++q) v[q] = Ks[(i8 + q) * 132 + dk] * __expf(gl - gc[i8 + q]);
            u32x4 o; o.x = pk2(v[0], v[1]); o.y = pk2(v[2], v[3]); o.z = pk2(v[4], v[5]); o.w = pk2(v[6], v[7]); *(u32x4*)(gKDT + dk * 64 + i8) = o; }
        for (int i = t2; i < 64 * 8; i += 256) { const int r = i >> 3, c8 = (i & 7) * 8; const LAS float* s = At + r * 68 + c8;
            u32x4 o; o.x = pk2(s[0], s[1]); o.y = pk2(s[2], s[3]); o.z = pk2(s[4], s[5]); o.w = pk2(s[6], s[7]); *(u32x4*)(gAT + r * 64 + c8) = o; }
        if (t2 == 0) WSP(float, WS_GL)[job] = __expf(gl);
    }
    __syncthreads();
    LAS bf16* Wl = (LAS bf16*)Qs;
    if (tid < 128) {
#pragma unroll
        for (int q = 0; q < 8; ++q) { u32x4 o; o.x = pk2(sol[8 * q], sol[8 * q + 1]); o.y = pk2(sol[8 * q + 2], sol[8 * q + 3]); o.z = pk2(sol[8 * q + 4], sol[8 * q + 5]); o.w = pk2(sol[8 * q + 6], sol[8 * q + 7]);
            *(u32x4*)(gUT + tid * 64 + 8 * q) = o; }
    } else if (tid < 256) {
#pragma unroll
        for (int i = 0; i < 64; ++i) Wl[i * 136 + (tid - 128)] = (bf16)f2bf(sol[i]);
    }
    __syncthreads();
    for (int i = tid; i < 64 * 16; i += 512) { const int r = i >> 4, c8 = (i & 15) * 8; *(u32x4*)(gW + r * 128 + c8) = *(const LAS u32x4*)(Wl + r * 136 + c8); }
    __syncthreads();
}

DEV void ssd_prep_job(Frame& F, int l, int job) {
    const int b = job >> 7, c = (job >> 1) & 63, g = job & 1, t0 = 128 * c;
    const float zf_ = opaque_zero();
    const bf16* p1 = WSP(bf16, WS_P1); const float* small = WSP(float, WS_SMALL);
    const float* cw = lin(F, I_SCW, l, 4 * 1536); const float* cbias = lin(F, I_SCB, l, 1536);
    bf16* SX = WSP(bf16, WS_SX); float* SDT = WSP(float, WS_SDT); float* SAC = WSP(float, WS_SAC); float* SST = WSP(float, WS_SST); float* SCD = WSP(float, WS_SCD);
    LAS bf16* BT = (LAS bf16*)F.lds;
    LAS bf16* XT = BT + 128 * 136;
    LAS float* dts = (LAS float*)(XT + 64 * 136);
    LAS float* acs = dts + 128 * 8;
    const int tid = F.tid;
    for (int i = tid; i < 1024; i += 512) { const int tl = i >> 3, hh = i & 7, h = 8 * g + hh; const size_t row = (size_t)(b * SEQ + t0 + tl);
        const float dt = softplusf_(small[row * SMW + S_DT + h] + lin(F, I_SDTB, l, 16)[h]);
        dts[i] = dt; acs[i] = dt * (-__expf(lin(F, I_SALOG, l, 16)[h])); }
    __syncthreads();
    if (tid < 8) { float s = 0.f; for (int tl = 0; tl < 128; ++tl) { s += acs[tl * 8 + tid]; acs[tl * 8 + tid] = s; } }
    __syncthreads();
    for (int i = tid; i < 1024; i += 512) { const int tl = i >> 3, hh = i & 7; const size_t row = (size_t)(b * SEQ + t0 + tl); SDT[row * 16 + 8 * g + hh] = dts[i]; SAC[row * 16 + 8 * g + hh] = acs[i]; }
    if (tid < 8) SCD[(size_t)(b * 64 + c) * 16 + 8 * g + tid] = __expf(acs[127 * 8 + tid]);
    {
        const int ch = tid & 255, half = tid >> 8; const int cc = 1024 + (ch < 128 ? g * 128 + ch : 256 + g * 128 + (ch - 128));
        const float w0 = cw[cc], w1 = cw[1536 + cc], w2 = cw[2 * 1536 + cc], w3 = cw[3 * 1536 + cc], bs = cbias[cc];
        const int col = C_CX + cc;
        for (int q = 0; q < 4; ++q) {
            const int ts = t0 + 64 * half + 16 * q; float xin[19];
#pragma unroll
            for (int i = 0; i < 19; ++i) { const int t = ts - 3 + i; xin[i] = t >= 0 ? bf2f(p1[(size_t)(b * SEQ + t) * P1W + col]) : 0.f; }
#pragma unroll
            for (int i = 0; i < 16; ++i) { const int tl = 64 * half + 16 * q + i; const size_t row = (size_t)(b * SEQ + t0 + tl);
                const float y = siluf_(w0 * xin[i] + w1 * xin[i + 1] + w2 * xin[i + 2] + w3 * xin[i + 3] + bs); const bf16 yb = (bf16)f2bf(y);
                SX[row * 1536 + cc] = yb; if (ch < 128) BT[ch * 136 + tl] = yb; }
        }
    }
    for (int hh = 0; hh < 8; ++hh) {
        const int h = 8 * g + hh;
        __syncthreads();
        {
            const int ch = tid & 63, tg = tid >> 6; const int cc = h * 64 + ch;
            const float w0 = cw[cc], w1 = cw[1536 + cc], w2 = cw[2 * 1536 + cc], w3 = cw[3 * 1536 + cc], bs = cbias[cc];
            const int col = C_CX + cc; const int ts = t0 + 16 * tg;
            float xin[19];
#pragma unroll
            for (int i = 0; i < 19; ++i) { const int t = ts - 3 + i; xin[i] = t >= 0 ? bf2f(p1[(size_t)(b * SEQ + t) * P1W + col]) : 0.f; }
            const float al = acs[127 * 8 + hh];
#pragma unroll
            for (int i = 0; i < 16; ++i) { const int tl = 16 * tg + i; const size_t row = (size_t)(b * SEQ + t0 + tl);
                const float y = siluf_(w0 * xin[i] + w1 * xin[i + 1] + w2 * xin[i + 2] + w3 * xin[i + 3] + bs); const bf16 yb = (bf16)f2bf(y);
                SX[row * 1536 + cc] = yb;
                XT[ch * 136 + tl] = (bf16)f2bf(bf2f(yb) * dts[tl * 8 + hh] * __expf(al - acs[tl * 8 + hh])); }
        }
        __syncthreads();
        {
            const int mt = F.wave & 3, nb = (F.wave >> 2) * 4;
            bf16x8 a[4];
#pragma unroll
            for (int ks = 0; ks < 4; ++ks) a[ks] = frag_l(XT, 136, 16 * mt, 32 * ks, F.lane);
            float* dst = SST + ((size_t)((b * 64 + c) * 16 + h) * 64) * 128;
#pragma unroll
            for (int q = 0; q < 4; ++q) { f32x4 acc = ZERO4;
#pragma unroll
                for (int ks = 0; ks < 4; ++ks) acc = mfma16(a[ks], frag_l(BT, 136, 16 * (nb + q), 32 * ks, F.lane), acc);
#pragma unroll
                for (int r = 0; r < 4; ++r) dst[(size_t)(16 * mt + 4 * (F.lane >> 4) + r) * 128 + 16 * (nb + q) + (F.lane & 15)] = acc[r]; }
        }
    }
    __syncthreads();
}

DEV void nsa_compress_job(Frame& F, int l, int job) {
    const int kv = job >> 4, bg = (job >> 2) & 3, rt = job & 3, b = bg >> 1, g = bg & 1, i0 = 128 * rt;
    const float zf_ = opaque_zero();
    const bf16* p1 = WSP(bf16, WS_P1); const bf16* Wt = WSP(bf16, kv ? WS_WCV : WS_WCK); const float* cst = WSP(float, WS_CONST) + kv * 128;
    const int col0 = (kv ? C_BVC : C_BKC) + g * 128;
    LAS bf16* As = (LAS bf16*)F.lds;
    LAS bf16* Bs = As + 128 * 72;
    LAS float* Cs = (LAS float*)(Bs + 128 * 72);
    const int tid = F.tid, wm = F.wave >> 1, wn = F.wave & 1;
    f32x4 acc[2][4];
#pragma unroll
    for (int i = 0; i < 2; ++i)
#pragma unroll
        for (int j = 0; j < 4; ++j) acc[i][j] = ZERO4;
    u32x4 ra[2], rb[2];
#define LOADK(ks_) do { _Pragma("unroll") for (int q = 0; q < 2; ++q) { const int ch = tid + 512 * q, r = ch >> 3, c8 = (ch & 7) * 8; \
            int t = 16 * (i0 + r) + ((ks_) >> 1); if (t > SEQ - 1) t = SEQ - 1;     \
            ra[q] = *(const u32x4*)(p1 + (size_t)(b * SEQ + t) * P1W + col0 + ((ks_) & 1) * 64 + c8); \
            rb[q] = *(const u32x4*)(Wt + (size_t)r * 4096 + 64 * (ks_) + c8); } } while (0)
    LOADK(0);
    for (int ks = 0; ks < 64; ++ks) {
        __syncthreads();
#pragma unroll
        for (int q = 0; q < 2; ++q) { const int ch = tid + 512 * q, r = ch >> 3, c8 = (ch & 7) * 8; *(LAS u32x4*)(As + r * 72 + c8) = ra[q]; *(LAS u32x4*)(Bs + r * 72 + c8) = rb[q]; }
        __syncthreads();
        if (ks + 1 < 64) LOADK(ks + 1);
#pragma unroll
        for (int k2 = 0; k2 < 2; ++k2) {
            bf16x8 a0 = frag_l(As, 72, 32 * wm, 32 * k2, F.lane), a1 = frag_l(As, 72, 32 * wm + 16, 32 * k2, F.lane);
#pragma unroll
            for (int j = 0; j < 4; ++j) { const bf16x8 bb = frag_l(Bs, 72, 64 * wn + 16 * j, 32 * k2, F.lane); acc[0][j] = mfma16(a0, bb, acc[0][j]); acc[1][j] = mfma16(a1, bb, acc[1][j]); }
        }
    }
    __syncthreads();
#pragma unroll
    for (int i = 0; i < 2; ++i)
#pragma unroll
        for (int j = 0; j < 4; ++j)
#pragma unroll
            for (int r = 0; r < 4; ++r) { const int col = 64 * wn + 16 * j + (F.lane & 15); Cs[(32 * wm + 16 * i + 4 * (F.lane >> 4) + r) * 132 + col] = acc[i][j][r] + cst[col]; }
    __syncthreads();
    if (kv == 0) {
        const float* kn = lin(F, I_NKN, l, 128); bf16* KC = WSP(bf16, WS_KCMP);
        const int r = tid >> 2, q = tid & 3; const LAS float* s = Cs + r * 132 + 32 * q; float ss = 0.f;
#pragma unroll
        for (int e = 0; e < 32; ++e) ss += s[e] * s[e];
        ss += shx<1>(ss); ss += shx<2>(ss);
        const float rs = rsqrtf(ss * (1.0f / 128.0f) + EPS);
        bf16* dst = KC + ((size_t)bg * 512 + i0 + r) * 128 + 32 * q;
#pragma unroll
        for (int e = 0; e < 32; e += 2) *(unsigned*)(dst + e) = pk2(s[e] * rs * kn[32 * q + e], s[e + 1] * rs * kn[32 * q + e + 1]);
    } else {
        bf16* VC = WSP(bf16, WS_VCMPT); const int e = tid & 127, q = tid >> 7;
#pragma unroll
        for (int i8 = 0; i8 < 4; ++i8) { const LAS float* s = Cs + (32 * q + 8 * i8) * 132 + e;
            u32x4 o; o.x = pk2(s[0], s[132]); o.y = pk2(s[264], s[396]); o.z = pk2(s[528], s[660]); o.w = pk2(s[792], s[924]);
            *(u32x4*)(VC + ((size_t)bg * 128 + e) * 512 + i0 + 32 * q + 8 * i8) = o; }
    }
    __syncthreads();
}
#undef LOADK

constexpr int AL_KT = 0, AL_VT = 17408, AL_KT1 = 35840, AL_UW = 53248, AL_TB = 54272, AL_SM = 60608, AL_PS = 61696, AL_IMP = 78336, AL_VT1 = 111104, AL_END = 129536;
static_assert(AL_KT1 + 17408 <= AL_UW && AL_UW + 128 <= AL_TB && AL_END <= MISC_OFF, "attention LDS map");
DEV int rel_bucket_dev(int n) {
    if (n < 16) return n;
    int k = 16;
    k += (n >= 21); k += (n >= 27); k += (n >= 35); k += (n >= 46); k += (n >= 59); k += (n >= 77); k += (n >= 99); k += (n >= 128);
    k += (n >= 166); k += (n >= 216); k += (n >= 280); k += (n >= 363); k += (n >= 470); k += (n >= 609); k += (n >= 790);
    return k;
}
DEV void attn_fill_bias(Frame& F, int g) {
    LAS float* tb = (LAS float*)(F.lds + AL_TB); const float* rt = F.p->in[I_REL];
    for (int i = F.tid; i < 2 * 792; i += 512) { const int hg = i / 792, d = i - hg * 792; tb[i] = rt[rel_bucket_dev(d) * 4 + 2 * g + hg] * 1.4426950408889634f; }
}
DEV void attn_load_tile(u32x4 (&rk)[2], u32x4 (&rv)[2], const bf16* ksrc, const bf16* vsrc, int vpitch, int tid) {
#pragma unroll
    for (int q = 0; q < 2; ++q) { const int ch = tid + 512 * q; rk[q] = *(const u32x4*)(ksrc + (size_t)ch * 8); rv[q] = *(const u32x4*)(vsrc + (size_t)(ch >> 3) * vpitch + (ch & 7) * 8); }
}
DEV void attn_store_tile(LAS unsigned char* lds, int buf, const u32x4 (&rk)[2], const u32x4 (&rv)[2], int tid) {
    LAS bf16* Kt = (LAS bf16*)(lds + (buf ? AL_KT1 : AL_KT)); LAS bf16* Vt = (LAS bf16*)(lds + (buf ? AL_VT1 : AL_VT));
#pragma unroll
    for (int q = 0; q < 2; ++q) { const int ch = tid + 512 * q; *(LAS u32x4*)(Kt + (ch >> 4) * 136 + (ch & 15) * 8) = rk[q]; *(LAS u32x4*)(Vt + (ch >> 3) * 72 + (ch & 7) * 8) = rv[q]; }
}
template <int MODE, int PATH = 0>
DEV unsigned attn_scores(LAS unsigned char* lds, int buf, const bf16x8 (&qf)[4], int lane, int n0, int tok, int hg, unsigned selbit, f32x4 (&s)[4]) {
    const float zf_ = opaque_zero();
    const LAS bf16* Kt = (const LAS bf16*)(lds + (buf ? AL_KT1 : AL_KT)); const LAS float* tb = (const LAS float*)(lds + AL_TB) + hg * 792;
#pragma unroll
    for (int nt = 0; nt < 4; ++nt) { s[nt] = ZERO4;
#pragma unroll
        for (int ks = 0; ks < 4; ++ks) s[nt] = mfma16(frag_l(Kt, 136, 16 * nt, 32 * ks, lane), qf[ks], s[nt]); }
    if (PATH == 1) {
        const float bf = tb[790]; const bool ok = selbit != 0u;
#pragma unroll
        for (int nt = 0; nt < 4; ++nt)
#pragma unroll
            for (int r = 0; r < 4; ++r) s[nt][r] = ok ? s[nt][r] + bf : -1e30f;
        return ok ? 0xffffu : 0u;
    }
    if (PATH == 2) {
        const bool ok = MODE == 2 ? true : (selbit != 0u);
        const LAS float* tp = tb + (tok - n0 - 4 * (lane >> 4));
#pragma unroll
        for (int nt = 0; nt < 4; ++nt)
#pragma unroll
            for (int r = 0; r < 4; ++r) s[nt][r] = ok ? s[nt][r] + tp[-16 * nt - r] : -1e30f;
        return ok ? 0xffffu : 0u;
    }
    unsigned vm = 0u;
#pragma unroll
    for (int nh = 0; nh < 2; ++nh) {
        float bv[8];
#pragma unroll
        for (int q = 0; q < 8; ++q) { const int nt = 2 * nh + (q >> 2), r = q & 3; const int n = n0 + 16 * nt + 4 * (lane >> 4) + r; const int dist = MODE == 0 ? tok - (16 * n + 31) : tok - n;
            int di = dist < 0 ? 0 : dist; di = di > 790 ? 790 : di; bv[q] = tb[di]; }
#pragma unroll
        for (int q = 0; q < 8; ++q) asm volatile("" : "+v"(bv[q]));
#pragma unroll
        for (int q = 0; q < 8; ++q) { const int nt = 2 * nh + (q >> 2), r = q & 3; const int n = n0 + 16 * nt + 4 * (lane >> 4) + r; int dist; bool ok;
            if (MODE == 0) { dist = tok - (16 * n + 31); ok = dist >= 0 && n < 511; }
            else if (MODE == 1) { dist = tok - n; ok = dist >= 0 && selbit != 0u; }
            else { dist = tok - n; ok = dist >= 0 && dist < 512; }
            s[nt][r] = ok ? s[nt][r] + bv[q] : -1e30f;
            vm |= (ok ? 1u : 0u) << (4 * nt + r); }
    }
    return vm;
}
DEV float fq_max(float v) {
    const auto a = __builtin_amdgcn_permlane16_swap(__builtin_bit_cast(unsigned, v), __builtin_bit_cast(unsigned, v), false, false);
    const float m = fmaxf(__builtin_bit_cast(float, a[0]), __builtin_bit_cast(float, a[1]));
    const auto b = __builtin_amdgcn_permlane32_swap(__builtin_bit_cast(unsigned, m), __builtin_bit_cast(unsigned, m), false, false);
    return fmaxf(__builtin_bit_cast(float, b[0]), __builtin_bit_cast(float, b[1]));
}
DEV float fq_sum(float v) {
    const auto a = __builtin_amdgcn_permlane16_swap(__builtin_bit_cast(unsigned, v), __builtin_bit_cast(unsigned, v), false, false);
    const float m = __builtin_bit_cast(float, a[0]) + __builtin_bit_cast(float, a[1]);
    const auto b = __builtin_amdgcn_permlane32_swap(__builtin_bit_cast(unsigned, m), __builtin_bit_cast(unsigned, m), false, false);
    return __builtin_bit_cast(float, b[0]) + __builtin_bit_cast(float, b[1]);
}
DEV float attn_online(const f32x4 (&s)[4], unsigned vm, float& m, float& l, f32x4 (&p)[4]) {
    float mx = fmaxf(fmaxf(fmaxf(s[0][0], s[0][1]), fmaxf(s[0][2], s[0][3])), fmaxf(fmaxf(s[1][0], s[1][1]), fmaxf(s[1][2], s[1][3])));
    mx = fmaxf(mx, fmaxf(fmaxf(fmaxf(s[2][0], s[2][1]), fmaxf(s[2][2], s[2][3])), fmaxf(fmaxf(s[3][0], s[3][1]), fmaxf(s[3][2], s[3][3]))));
    mx = fmaxf(mx, shx<16>(mx)); mx = fmaxf(mx, shx<32>(mx));
    const float mn = fmaxf(m, mx), sc = __builtin_amdgcn_exp2f(m - mn); float rs = 0.f;
#pragma unroll
    for (int nt = 0; nt < 4; ++nt)
#pragma unroll
        for (int r = 0; r < 4; ++r) { const float pv = ((vm >> (4 * nt + r)) & 1u) ? __builtin_amdgcn_exp2f(s[nt][r] - mn) : 0.f; p[nt][r] = pv; rs += pv; }
    rs += shx<16>(rs); rs += shx<32>(rs);
    l = l * sc + rs; m = mn;
    return sc;
}
DEV void attn_pv(LAS unsigned char* lds, int buf, int lane, const f32x4 (&p)[4], f32x4 (&o)[8]) {
    const LAS bf16* Vt = (const LAS bf16*)(lds + (buf ? AL_VT1 : AL_VT)) + (lane & 15) * 72 + 4 * (lane >> 4);
#pragma unroll
    for (int ks = 0; ks < 2; ++ks) {
        u32x4 pw; pw.x = pg8::cvt_pk_bf16(p[2 * ks][0], p[2 * ks][1]); pw.y = pg8::cvt_pk_bf16(p[2 * ks][2], p[2 * ks][3]); pw.z = pg8::cvt_pk_bf16(p[2 * ks + 1][0], p[2 * ks + 1][1]); pw.w = pg8::cvt_pk_bf16(p[2 * ks + 1][2], p[2 * ks + 1][3]);
        const bf16x8 pb = __builtin_bit_cast(bf16x8, pw);
#pragma unroll
        for (int dt = 0; dt < 8; ++dt) {
            const u32x2 v0 = *(const LAS u32x2*)(Vt + 16 * dt * 72 + 32 * ks), v1 = *(const LAS u32x2*)(Vt + 16 * dt * 72 + 32 * ks + 16);
            u32x4 vw; vw.x = v0.x; vw.y = v0.y; vw.z = v1.x; vw.w = v1.y;
            o[dt] = mfma16(__builtin_bit_cast(bf16x8, vw), pb, o[dt]); }
    }
}
DEV void attn_load_q(Frame& F, int bg, int t0, bf16x8 (&qf)[4]) {
    const bf16* QN = WSP(bf16, WS_QN); const int rho = F.lane & 15;
    const bf16* src = QN + ((size_t)(bg * SEQ + t0 + 8 * F.wave + (rho & 7)) * 2 + (rho >> 3)) * 128 + 8 * (F.lane >> 4);
#pragma unroll
    for (int ks = 0; ks < 4; ++ks) qf[ks] = *(const bf16x8*)(src + 32 * ks);
}

DEV void sel_step(Frame& F, const bf16* KS, const bf16* VS, int j, int jn, int jnn, int qt, int cb, const u32x4 (&st_k)[2], const u32x4 (&st_v)[2], u32x4 (&ld_k)[2], u32x4 (&ld_v)[2],
                  const bf16x8 (&qf)[4], const u32x4& smw, const unsigned (&wum)[4], int tok, int hg, float& m, float& l, f32x4 (&o)[8]) {
    const int lane = F.lane;
    if (jnn <= qt) attn_load_tile(ld_k, ld_v, KS + (size_t)jnn * 64 * 128, VS + (size_t)jnn * 128 * 64, 64, F.tid);
    const unsigned wsel = j < 32 ? wum[0] : (j < 64 ? wum[1] : (j < 96 ? wum[2] : wum[3]));
    if ((wsel >> (j & 31)) & 1u) {
        const unsigned w = j < 32 ? smw.x : (j < 64 ? smw.y : (j < 96 ? smw.z : smw.w)); const unsigned selbit = (w >> (j & 31)) & 1u;
        f32x4 s[4], p[4];
        const unsigned vm = (j <= qt - 14) ? attn_scores<1, 1>(F.lds, cb, qf, lane, 64 * j, tok, hg, selbit, s) : ((j >= qt - 11 && j < qt) ? attn_scores<1, 2>(F.lds, cb, qf, lane, 64 * j, tok, hg, selbit, s) : attn_scores<1, 0>(F.lds, cb, qf, lane, 64 * j, tok, hg, selbit, s));
        const float sc = attn_online(s, vm, m, l, p);
        if (__ballot(sc != 1.0f) != 0ull) {
#pragma unroll
            for (int dt = 0; dt < 8; ++dt) o[dt] = o[dt] * sc; }
        attn_pv(F.lds, cb, lane, p, o);
    }
    if (jn <= qt) attn_store_tile(F.lds, cb ^ 1, st_k, st_v, F.tid);
    __syncthreads();
}
DEV int sel_next(int j, int qt, const unsigned (&um)[4]) {
    int jn = j + 1;
    while (jn <= qt) { const unsigned w = jn < 32 ? um[0] : (jn < 64 ? um[1] : (jn < 96 ? um[2] : um[3])); if ((w >> (jn & 31)) & 1u) break; ++jn; }
    return jn;
}
DEV void nsa_job(Frame& F, int job) {
    const int bg = job >> 7, qt = job & 127, b = bg >> 1, g = bg & 1, t0 = 64 * qt, tid = F.tid, lane = F.lane, wave = F.wave;
    const float zf_ = opaque_zero();
    const int fq = lane >> 4, fr = lane & 15, hg = fr >> 3, tok = t0 + 8 * wave + (fr & 7);
    const float* small = WSP(float, WS_SMALL); const size_t row = (size_t)(b * SEQ + tok);
    LAS float* PS = (LAS float*)(F.lds + AL_PS) + wave * (8 * 65); LAS float* IMP = (LAS float*)(F.lds + AL_IMP);
    LAS unsigned* SM = (LAS unsigned*)(F.lds + AL_SM);
    LAS unsigned* UW = (LAS unsigned*)(F.lds + AL_UW);
    __syncthreads();
    attn_fill_bias(F, g);
    for (int i = tid; i < 64 * 128; i += 512) IMP[i] = 0.f;
    if (lane < 8) PS[lane * 65] = 0.f;
    bf16x8 qf[4]; attn_load_q(F, bg, t0, qf);
    f32x4 tot[8];
    u32x4 rk[2], rv[2];
    for (int dr_ = 0; dr_ < (DBG_NSA == 1 ? 2 : 1); ++dr_) {
        if (dr_ == 1) { WAVE_SYNC(); if (lane < 8) PS[lane * 65] = 0.f; WAVE_SYNC(); }
        const int ntiles = (4 * qt + 2) / 64 + 1;
        const bf16* KC = WSP(bf16, WS_KCMP) + (size_t)bg * 512 * 128; const bf16* VC = WSP(bf16, WS_VCMPT) + (size_t)bg * 128 * 512;
        float m = -1e30f, l = 0.f;
        attn_load_tile(rk, rv, KC, VC, 512, tid); attn_store_tile(F.lds, 0, rk, rv, tid); __syncthreads();
        for (int j = 0; j < ntiles; ++j) {
            if (j + 1 < ntiles) attn_load_tile(rk, rv, KC + (size_t)(j + 1) * 64 * 128, VC + (j + 1) * 64, 512, tid);
            f32x4 s[4], p[4];
            const unsigned vm = attn_scores<0>(F.lds, j & 1, qf, lane, 64 * j, tok, hg, 0u, s);
            (void)attn_online(s, vm, m, l, p);
            if (j + 1 < ntiles) attn_store_tile(F.lds, (j + 1) & 1, rk, rv, tid);
            __syncthreads();
        }
        const float il = l > 0.f ? 1.0f / l : 0.f;
        f32x4 o[8];
#pragma unroll
        for (int dt = 0; dt < 8; ++dt) o[dt] = ZERO4;
        attn_load_tile(rk, rv, KC, VC, 512, tid); attn_store_tile(F.lds, 0, rk, rv, tid); __syncthreads();
        for (int j = 0; j < ntiles; ++j) {
            if (j + 1 < ntiles) attn_load_tile(rk, rv, KC + (size_t)(j + 1) * 64 * 128, VC + (j + 1) * 64, 512, tid);
            f32x4 s[4], p[4];
            const unsigned vm = attn_scores<0>(F.lds, j & 1, qf, lane, 64 * j, tok, hg, 0u, s);
#pragma unroll
            for (int nt = 0; nt < 4; ++nt)
#pragma unroll
                for (int r = 0; r < 4; ++r) {
                    const float pv = ((vm >> (4 * nt + r)) & 1u) ? __builtin_amdgcn_exp2f(s[nt][r] - m) * il : 0.f; p[nt][r] = pv;
                    const float ps = pv + shx<8>(pv);
                    if (fr < 8) PS[fr * 65 + 1 + 16 * nt + 4 * fq + r] = ps;
                }
            WAVE_SYNC();
#pragma unroll
            for (int q = 0; q < 2; ++q) { const int idx = lane + 64 * q, tk = idx >> 4, bl = idx & 15; const LAS float* ps = PS + tk * 65 + 4 * bl;
                IMP[(8 * wave + tk) * 128 + 16 * j + bl] = ps[0] + 2.0f * ps[1] + 2.0f * ps[2] + 2.0f * ps[3] + ps[4]; }
            WAVE_SYNC();
            if (lane < 8) PS[lane * 65] = PS[lane * 65 + 64];
            WAVE_SYNC();
            attn_pv(F.lds, j & 1, lane, p, o);
            if (j + 1 < ntiles) attn_store_tile(F.lds, (j + 1) & 1, rk, rv, tid);
            __syncthreads();
        }
        const float gt = (DBG_NSAZ & 1) ? zf_ : sigmoidf_(small[row * SMW + S_BG + (2 * g + hg) * 3 + 0]);
#pragma unroll
        for (int dt = 0; dt < 8; ++dt) tot[dt] = o[dt] * gt;
    }
    unsigned wum[4] = {0u, 0u, 0u, 0u};
    for (int dr_ = 0; dr_ < (DBG_NSA == 4 ? 2 : 1); ++dr_) {
        const int cur = qt;
        for (int tk = 0; tk < 8; ++tk) {
            const LAS float* rowp = IMP + (8 * wave + tk) * 128;
            const int b0 = lane, b1 = lane + 64;
            const float s0 = b0 > cur ? -1e4f : ((b0 == 0 || b0 >= cur - 1) ? 1e4f : rowp[b0]);
            const float s1 = b1 > cur ? -1e4f : ((b1 == 0 || b1 >= cur - 1) ? 1e4f : rowp[b1]);
            unsigned k0 = __builtin_bit_cast(unsigned, s0), k1 = __builtin_bit_cast(unsigned, s1);
            k0 = (k0 & 0x80000000u) ? ~k0 : (k0 | 0x80000000u); k1 = (k1 & 0x80000000u) ? ~k1 : (k1 | 0x80000000u);
            unsigned prefix = 0u; int need = 16;
            for (int bit = 31; bit >= 0; --bit) {
                const unsigned cand = (prefix | (1u << bit)) >> bit;
                const int cnt = __builtin_popcountll(__ballot((k0 >> bit) == cand)) + __builtin_popcountll(__ballot((k1 >> bit) == cand));
                if (cnt >= need) prefix |= (1u << bit); else need -= cnt;
            }
            const unsigned long long e0 = __ballot(k0 == prefix), e1 = __ballot(k1 == prefix);
            const int r0 = (int)__builtin_amdgcn_mbcnt_hi((unsigned)(e0 >> 32), __builtin_amdgcn_mbcnt_lo((unsigned)e0, 0u));
            const int r1 = __builtin_popcountll(e0) + (int)__builtin_amdgcn_mbcnt_hi((unsigned)(e1 >> 32), __builtin_amdgcn_mbcnt_lo((unsigned)e1, 0u));
            const bool sel0 = k0 > prefix || (k0 == prefix && r0 < need), sel1 = k1 > prefix || (k1 == prefix && r1 < need);
            const unsigned long long m0 = __ballot(sel0), m1 = __ballot(sel1);
            const unsigned w0 = (unsigned)m0, w1 = (unsigned)(m0 >> 32), w2 = (unsigned)m1, w3 = (unsigned)(m1 >> 32);
            wum[0] |= w0; wum[1] |= w1; wum[2] |= w2; wum[3] |= w3;
            if (lane == 0) { SM[(8 * wave + tk) * 4 + 0] = w0; SM[(8 * wave + tk) * 4 + 1] = w1; SM[(8 * wave + tk) * 4 + 2] = w2; SM[(8 * wave + tk) * 4 + 3] = w3; }
        }
        if (lane == 0) { UW[wave * 4 + 0] = wum[0]; UW[wave * 4 + 1] = wum[1]; UW[wave * 4 + 2] = wum[2]; UW[wave * 4 + 3] = wum[3]; }
    }
    __syncthreads();
    const u32x4 smw = *(const LAS u32x4*)(SM + (8 * wave + (fr & 7)) * 4);
    unsigned um[4];
#pragma unroll
    for (int w = 0; w < 4; ++w) { unsigned v = 0u;
#pragma unroll
        for (int q = 0; q < 8; ++q) v |= UW[q * 4 + w];
        um[w] = __builtin_amdgcn_readfirstlane(v); }
    const bf16* KS = WSP(bf16, WS_KS) + (size_t)bg * SEQ * 128; const bf16* VS = WSP(bf16, WS_VST) + (size_t)bg * 128 * 8192;
    const bf16* KW = WSP(bf16, WS_KW) + (size_t)bg * SEQ * 128; const bf16* VW = WSP(bf16, WS_VWT) + (size_t)bg * 128 * 8192;
    for (int dr_ = 0; dr_ < (DBG_NSA == 2 ? 2 : 1); ++dr_) {
        float m = -1e30f, l = 0.f; f32x4 o[8];
#pragma unroll
        for (int dt = 0; dt < 8; ++dt) o[dt] = ZERO4;
        u32x4 rk2[2], rv2[2];
        int j = 0, jn = sel_next(0, qt, um), cb = 0;
        attn_load_tile(rk, rv, KS, VS, 64, tid); attn_store_tile(F.lds, 0, rk, rv, tid);
        if (jn <= qt) attn_load_tile(rk, rv, KS + (size_t)jn * 64 * 128, VS + (size_t)jn * 128 * 64, 64, tid);
        __syncthreads();
        while (j <= qt) {
            int jnn = jn <= qt ? sel_next(jn, qt, um) : jn;
            sel_step(F, KS, VS, j, jn, jnn, qt, cb, rk, rv, rk2, rv2, qf, smw, wum, tok, hg, m, l, o);
            cb ^= 1; j = jn; jn = jnn;
            if (j > qt) break;
            jnn = jn <= qt ? sel_next(jn, qt, um) : jn;
            sel_step(F, KS, VS, j, jn, jnn, qt, cb, rk2, rv2, rk, rv, qf, smw, wum, tok, hg, m, l, o);
            cb ^= 1; j = jn; jn = jnn;
        }
        const float gt = ((DBG_NSA == 2 && dr_ == 0) || (DBG_NSAZ & 2)) ? zf_ * l : sigmoidf_(small[row * SMW + S_BG + (2 * g + hg) * 3 + 1]) / l;
#pragma unroll
        for (int dt = 0; dt < 8; ++dt) tot[dt] = tot[dt] + o[dt] * gt;
    }
    for (int dr_ = 0; dr_ < (DBG_NSA == 3 ? 2 : 1); ++dr_) {
        float m = -1e30f, l = 0.f; f32x4 o[8];
#pragma unroll
        for (int dt = 0; dt < 8; ++dt) o[dt] = ZERO4;
        const int j0 = qt >= 8 ? qt - 8 : 0;
        attn_load_tile(rk, rv, KW + (size_t)j0 * 64 * 128, VW + (size_t)j0 * 128 * 64, 64, tid); attn_store_tile(F.lds, 0, rk, rv, tid); __syncthreads();
        for (int j = j0; j <= qt; ++j) {
            const int cb = (j - j0) & 1;
            if (j + 1 <= qt) attn_load_tile(rk, rv, KW + (size_t)(j + 1) * 64 * 128, VW + (size_t)(j + 1) * 128 * 64, 64, tid);
            f32x4 s[4], p[4];
            const unsigned vm = (j >= qt - 7 && j < qt) ? attn_scores<2, 2>(F.lds, cb, qf, lane, 64 * j, tok, hg, 0u, s) : attn_scores<2, 0>(F.lds, cb, qf, lane, 64 * j, tok, hg, 0u, s);
            const float sc = attn_online(s, vm, m, l, p);
#pragma unroll
            for (int dt = 0; dt < 8; ++dt) o[dt] = o[dt] * sc;
            attn_pv(F.lds, cb, lane, p, o);
            if (j + 1 <= qt) attn_store_tile(F.lds, cb ^ 1, rk, rv, tid);
            __syncthreads();
        }
        const float gt = ((DBG_NSA == 3 && dr_ == 0) || (DBG_NSAZ & 4)) ? zf_ * l : sigmoidf_(small[row * SMW + S_BG + (2 * g + hg) * 3 + 2]) / l;
#pragma unroll
        for (int dt = 0; dt < 8; ++dt) tot[dt] = tot[dt] + o[dt] * gt;
    }
    {
        bf16* YC = WSP(bf16, WS_YCAT);
#pragma unroll
        for (int dt = 0; dt < 8; ++dt) { const int cidx = (2 * g + hg) * 128 + 16 * dt + 4 * fq;
            f32x4 y = tot[dt]; if (DBG_ZERO & 2) y = ZERO4;
            u32x2 w; w.x = pk2(y[0], y[1]); w.y = pk2(y[2], y[3]); *(u32x2*)(YC + row * 2048 + 512 + cidx) = w; }
    }
    __syncthreads();
}

DEV void gdn_scan_job(Frame& F, int job) {
    const int bh = job >> 3, sl = job & 7, b = bh >> 2, h = bh & 3, lane = F.lane, wave = F.wave, fq = lane >> 4, fr = lane & 15;
    LAS bf16* St = (LAS bf16*)F.lds;
    LAS bf16* Vn = St + 16 * 136;
    const float* GL = WSP(float, WS_GL); float* GO = WSP(float, WS_GO);
    const float zf_ = opaque_zero();
    __syncthreads();
    for (int i = F.tid; i < 16 * 136 / 2; i += 512) ((LAS unsigned*)St)[i] = 0u;
    f32x4 S = ZERO4;
    const int mt = wave & 3;
    __syncthreads();
    const int o1 = (wave < 4 ? 0 : 8192) + (16 * mt + fr) * 128 + 8 * fq;
    const int oA = 32768 + (16 * mt + fr) * 64 + 8 * fq;
    const int oK = 16384 + (16 * wave + fr) * 64 + 8 * fq;
    const int oU = 24576 + (16 * sl + fr) * 64 + 16 * mt + 4 * fq;
    const bf16* rec = (const bf16*)(F.ws + WS_GW + (size_t)(bh * 128) * GDN_CH_BYTES);
    bf16x8 a1[4], aA[2], aK[2], n1[4], nA[2], nK[2]; u32x2 uu, nu; float gl, ngl;
#define GLOAD(A1, AA, AK, UU, G, c_) do { const bf16* r_ = rec + (size_t)(c_) * (GDN_CH_BYTES / 2); \
        _Pragma("unroll") for (int ks = 0; ks < 4; ++ks) A1[ks] = *(const bf16x8*)(r_ + o1 + 32 * ks); \
        AA[0] = *(const bf16x8*)(r_ + oA); AA[1] = *(const bf16x8*)(r_ + oA + 32); AK[0] = *(const bf16x8*)(r_ + oK); AK[1] = *(const bf16x8*)(r_ + oK + 32); \
        UU = *(const u32x2*)(r_ + oU); G = GL[bh * 128 + (c_)]; } while (0)
    GLOAD(a1, aA, aK, uu, gl, 0);
    for (int c = 0; c < 128; ++c) {
        const int cn = c + 1 < 128 ? c + 1 : c;
        GLOAD(n1, nA, nK, nu, ngl, cn);
        f32x4 d1 = ZERO4;
#pragma unroll
        for (int ks = 0; ks < 4; ++ks) d1 = mfma16(a1[ks], frag_l(St, 136, 0, 32 * ks, lane), d1);
        if (wave < 4) {
            const float v0 = bflo(uu.x) - d1[0], v1 = bfhi(uu.x) - d1[1], v2 = bflo(uu.y) - d1[2], v3 = bfhi(uu.y) - d1[3];
            u32x2 w; w.x = pk2(v0, v1); w.y = pk2(v2, v3);
            *(LAS u32x2*)(Vn + fr * 72 + 16 * mt + 4 * fq) = w;
        }
        LDS_WAIT(); __builtin_amdgcn_s_barrier(); CFENCE();
        const bf16x8 bv0 = frag_l(Vn, 72, 0, 0, lane), bv1 = frag_l(Vn, 72, 0, 32, lane);
        if (wave >= 4) {
            d1 = mfma16(aA[0], bv0, d1); d1 = mfma16(aA[1], bv1, d1);
#pragma unroll
            for (int r = 0; r < 4; ++r) GO[(size_t)(b * SEQ + 64 * c + 16 * mt + 4 * fq + r) * 512 + h * 128 + 16 * sl + fr] = d1[r];
        }
        f32x4 dk = ZERO4;
        dk = mfma16(aK[0], bv0, dk); dk = mfma16(aK[1], bv1, dk);
        S = S * gl + dk;
        { u32x2 w; w.x = pk2(S[0], S[1]); w.y = pk2(S[2], S[3]); *(LAS u32x2*)(St + fr * 136 + 16 * wave + 4 * fq) = w; }
        LDS_WAIT(); __builtin_amdgcn_s_barrier(); CFENCE();
#pragma unroll
        for (int ks = 0; ks < 4; ++ks) a1[ks] = n1[ks];
        aA[0] = nA[0]; aA[1] = nA[1]; aK[0] = nK[0]; aK[1] = nK[1]; uu = nu; gl = ngl;
    }
#undef GLOAD
    __syncthreads();
}

DEV void ssd_scan_part(Frame& F, int part, int nparts) {
    float* __restrict__ SST = WSP(float, WS_SST); const float* __restrict__ SCD = WSP(float, WS_SCD);
    constexpr int PER_B = 16 * 64 * 128;
    for (int e = part * 512 + F.tid; e < 2 * PER_B; e += nparts * 512) {
        const int b = e / PER_B, r = e - b * PER_B, h = r >> 13;
        float* p = SST + (size_t)(b * 64) * PER_B + r; const float* cdp = SCD + (b * 64) * 16 + h;
        float s = 0.f;
#pragma unroll
        for (int hb = 0; hb < 2; ++hb) {
            float v[32], cd[32];
#pragma unroll
            for (int c = 0; c < 32; ++c) { v[c] = p[(size_t)(32 * hb + c) * PER_B]; cd[c] = cdp[(32 * hb + c) * 16]; }
#pragma unroll
            for (int c = 0; c < 32; ++c) { p[(size_t)(32 * hb + c) * PER_B] = s; s = s * cd[c] + v[c]; }
        }
    }
}

DEV void gdn_final_rows(Frame& F, int l, int w0, int nw) {
    const float* GO = WSP(float, WS_GO); const bf16* p1 = WSP(bf16, WS_P1); bf16* YC = WSP(bf16, WS_YCAT); const float* gn = lin(F, I_GNORM, l, 128);
    const int lane = F.lane, dv0 = (lane & 15) * 8;
    float gv[8];
#pragma unroll
    for (int j = 0; j < 8; ++j) gv[j] = gn[dv0 + j];
    for (int row = w0; row < MTOK; row += nw) {
        const f32x4 a = *(const f32x4*)(GO + (size_t)row * 512 + lane * 8), bq = *(const f32x4*)(GO + (size_t)row * 512 + lane * 8 + 4);
        float ss = (a[0] * a[0] + a[1] * a[1]) + (a[2] * a[2] + a[3] * a[3]) + (bq[0] * bq[0] + bq[1] * bq[1]) + (bq[2] * bq[2] + bq[3] * bq[3]);
        ss = sum16(ss);
        const float rs = rsqrtf(ss * (1.0f / 128.0f) + EPS);
        const u32x4 zw = *(const u32x4*)(p1 + (size_t)row * P1W + C_AZ + lane * 8);
        const float z[8] = {bflo(zw.x), bfhi(zw.x), bflo(zw.y), bfhi(zw.y), bflo(zw.z), bfhi(zw.z), bflo(zw.w), bfhi(zw.w)};
        const float o[8] = {a[0], a[1], a[2], a[3], bq[0], bq[1], bq[2], bq[3]};
        float y[8];
#pragma unroll
        for (int j = 0; j < 8; ++j) y[j] = (DBG_ZERO & 1) ? opaque_zero() : o[j] * rs * gv[j] * siluf_(z[j]);
        u32x4 w; w.x = pk2(y[0], y[1]); w.y = pk2(y[2], y[3]); w.z = pk2(y[4], y[5]); w.w = pk2(y[6], y[7]);
        *(u32x4*)(YC + (size_t)row * 2048 + lane * 8) = w;
    }
}

DEV void ssd_out_job(Frame& F, int l, int job) {
    const int b = job >> 7, c = (job >> 1) & 63, g = job & 1, t0 = 128 * c, tid = F.tid, lane = F.lane, wave = F.wave, fq = lane >> 4, fr = lane & 15;
    const bf16* SX = WSP(bf16, WS_SX); const bf16* p1 = WSP(bf16, WS_P1); const float* SDT = WSP(float, WS_SDT); const float* SAC = WSP(float, WS_SAC); const float* SST = WSP(float, WS_SST);
    bf16* YC = WSP(bf16, WS_YCAT); float* RC = WSP(float, WS_SRC);
    const float zf_ = opaque_zero();
    LAS bf16* Cs = (LAS bf16*)F.lds;
    LAS bf16* Bs = Cs + 128 * 136;
    LAS bf16* XdT = Bs + 128 * 136;
    LAS bf16* SiT = XdT + 64 * 136;
    LAS bf16* Pw = SiT + 64 * 136;
    LAS float* acs = (LAS float*)(Pw + 8 * 16 * 136);
    __syncthreads();
    for (int i = tid; i < 2 * 128 * 16; i += 512) { const int v = i >> 11, r = (i >> 4) & 127, c8 = (i & 15) * 8;
        const u32x4 w = *(const u32x4*)(SX + (size_t)(b * SEQ + t0 + r) * 1536 + 1024 + (v ? 256 : 0) + g * 128 + c8);
        *(LAS u32x4*)((v ? Cs : Bs) + r * 136 + c8) = w; }
    for (int i = tid; i < 1024; i += 512) { const size_t row = (size_t)(b * SEQ + t0 + (i >> 3)); acs[i] = SAC[row * 16 + 8 * g + (i & 7)]; }
    __syncthreads();
    f32x4 cb[8];
    {
        bf16x8 ca[4];
#pragma unroll
        for (int ks = 0; ks < 4; ++ks) ca[ks] = frag_l(Cs, 136, 16 * wave, 32 * ks, lane);
#pragma unroll
        for (int nt = 0; nt < 8; ++nt) { cb[nt] = ZERO4;
#pragma unroll
            for (int ks = 0; ks < 4; ++ks) cb[nt] = mfma16(ca[ks], frag_l(Bs, 136, 16 * nt, 32 * ks, lane), cb[nt]); }
    }
    float ssq[4] = {0.f, 0.f, 0.f, 0.f};
    LAS bf16* pw = Pw + wave * 16 * 136;
    const float* dsk = lin(F, I_SD, l, 16);
    for (int hh = 0; hh < 8; ++hh) {
        const int h = 8 * g + hh;
        __syncthreads();
        for (int i = tid; i < 64 * 128; i += 512) { const int p = i & 63, s = i >> 6;
            XdT[p * 136 + s] = (bf16)f2bf(bf2f(SX[(size_t)(b * SEQ + t0 + s) * 1536 + h * 64 + p]) * SDT[(size_t)(b * SEQ + t0 + s) * 16 + h]); }
        { const float* sin = SST + ((size_t)((b * 64 + c) * 16 + h) * 64) * 128;
          for (int i = tid; i < 64 * 32; i += 512) { const int p = i >> 5, n4 = (i & 31) * 4; const f32x4 v = *(const f32x4*)(sin + p * 128 + n4);
              u32x2 w; w.x = pk2(v[0], v[1]); w.y = pk2(v[2], v[3]); *(LAS u32x2*)(SiT + p * 136 + n4) = w; } }
        float al[4];
#pragma unroll
        for (int r = 0; r < 4; ++r) al[r] = acs[(16 * wave + 4 * fq + r) * 8 + hh];
#pragma unroll
        for (int nt = 0; nt < 8; ++nt) { const int s = 16 * nt + fr; const float as = acs[s * 8 + hh];
#pragma unroll
            for (int r = 0; r < 4; ++r) { const int li = 16 * wave + 4 * fq + r; const float v = s <= li ? cb[nt][r] * __expf(al[r] - as) : 0.f; pw[(4 * fq + r) * 136 + s] = (bf16)f2bf(v); } }
        __syncthreads();
        f32x4 y[4], ys[4];
#pragma unroll
        for (int nt = 0; nt < 4; ++nt) { y[nt] = ZERO4; ys[nt] = ZERO4; }
#pragma unroll
        for (int ks = 0; ks < 4; ++ks) { const bf16x8 pa = frag_l(pw, 136, 0, 32 * ks, lane), cc = frag_l(Cs, 136, 16 * wave, 32 * ks, lane);
#pragma unroll
            for (int nt = 0; nt < 4; ++nt) { y[nt] = mfma16(pa, frag_l(XdT, 136, 16 * nt, 32 * ks, lane), y[nt]); ys[nt] = mfma16(cc, frag_l(SiT, 136, 16 * nt, 32 * ks, lane), ys[nt]); } }
        const float dh = dsk[h];
        unsigned short xv[4][4], zv[4][4];
#pragma unroll
        for (int r = 0; r < 4; ++r) { const size_t row = (size_t)(b * SEQ + t0 + 16 * wave + 4 * fq + r);
#pragma unroll
            for (int nt = 0; nt < 4; ++nt) { xv[r][nt] = SX[row * 1536 + h * 64 + 16 * nt + fr]; zv[r][nt] = p1[row * P1W + C_CZ + h * 64 + 16 * nt + fr]; } }
        CFENCE();
#pragma unroll
        for (int r = 0; r < 4; ++r) { const size_t row = (size_t)(b * SEQ + t0 + 16 * wave + 4 * fq + r); const float ea = __expf(al[r]);
#pragma unroll
            for (int nt = 0; nt < 4; ++nt) { const int p = 16 * nt + fr;
                const float xs = bf2f(xv[r][nt]); const float z = bf2f(zv[r][nt]);
                const float v = (DBG_ZERO & 4) ? zf_ : (y[nt][r] + ea * ys[nt][r] + xs * dh) * siluf_(z);
                ssq[r] += v * v; YC[row * 2048 + 1024 + h * 64 + p] = (bf16)f2bf(v); } }
    }
#pragma unroll
    for (int r = 0; r < 4; ++r) { const float s = sum16(ssq[r]); if (fr == 0) RC[(size_t)(b * SEQ + t0 + 16 * wave + 4 * fq + r) * 2 + g] = rsqrtf(s * (1.0f / 512.0f) + EPS); }
    __syncthreads();
}

constexpr int NPH = 12;
#ifndef CPU_EMU
DEV unsigned long long launder64(unsigned long long v) {
    unsigned lo = __builtin_amdgcn_readfirstlane((unsigned)v), hi = __builtin_amdgcn_readfirstlane((unsigned)(v >> 32));
    asm volatile("" : "+s"(lo), "+s"(hi));
    return ((unsigned long long)hi << 32) | lo;
}
DEV bool phase_begin(Frame& F, const Params& prm, int wave0) {
    F.ws = (unsigned char*)launder64((unsigned long long)prm.ws);
    F.p = (KParams)launder64((unsigned long long)__builtin_amdgcn_kernarg_segment_ptr());
    unsigned z = 0u; asm volatile("" : "+v"(z)); const int ln = (int)__builtin_amdgcn_mbcnt_hi(~0u, __builtin_amdgcn_mbcnt_lo(~0u, z));
    int wv = wave0; asm volatile("" : "+s"(wv)); F.wave = wv; F.lane = ln; F.tid = wv * 64 + ln;
    int bi = __builtin_amdgcn_readfirstlane(blockIdx.x); asm volatile("" : "+s"(bi)); F.bid = bi;
    int gg = __builtin_amdgcn_readfirstlane(gridDim.x); asm volatile("" : "+s"(gg)); F.G = gg;
    unsigned la = __builtin_amdgcn_readfirstlane((unsigned)(size_t)F.lds); asm volatile("" : "+s"(la)); F.lds = (LAS unsigned char*)(size_t)la;
    return true;
}
DEV void job_begin(Frame& F) { int t = F.tid; asm volatile("" : "+v"(t)); F.tid = t; F.lane = t & 63; }
__global__ void __launch_bounds__(512, 2) hybrid_fwd(Params prm) {
    extern __shared__ __attribute__((aligned(16))) unsigned char lds_raw[];
    Frame F;
    F.lds = (LAS unsigned char*)lds_raw; F.tid = threadIdx.x; F.lane = F.tid & 63; F.wave = __builtin_amdgcn_readfirstlane(F.tid >> 6);
    const int wave0 = F.wave;
    F.G = gridDim.x; F.bid = blockIdx.x; F.p = (KParams)__builtin_amdgcn_kernarg_segment_ptr(); F.ws = prm.ws;
    volatile LAS unsigned* MISC = (volatile LAS unsigned*)(F.lds + MISC_OFF);
    if (F.tid < 64) MISC[F.tid] = 0u;
    __syncthreads();
    unsigned* ctl = (unsigned*)(F.ws + WS_CTL);
    XcdBarrier bar; bar.bar = ctl + CW_BAR; bar.x = 0; bar.st = nullptr;
    if (prm.use_bar) bar = xcd_barrier_post(ctl + CW_BAR, MISC + 8);
    const int lo = prm.lo, hi = prm.hi;
    for (int l = 0; l < DEPTH; ++l) {
#define IN(k) (lo <= l * NPH + (k) && l * NPH + (k) < hi && phase_begin(F, prm, wave0))
#define REP_BEGIN(k) for (int rep_ = 0; rep_ < ((DBG_REP == (k)) ? 2 : 1); ++rep_) {
#define REP_END(k) if (DBG_REP == (k) && rep_ == 0) { XcdBarrier bb_ = bar; bb_.bar = (unsigned*)launder64((unsigned long long)bar.bar); xcd_barrier(bb_); } }
#define SEAM(k) do { if (l * NPH + (k) + 1 < hi && prm.use_bar) { XcdBarrier bb_ = bar; bb_.bar = (unsigned*)launder64((unsigned long long)bar.bar); { unsigned x_ = __builtin_amdgcn_readfirstlane(bar.x); asm volatile("" : "+s"(x_)); bb_.x = x_; } xcd_barrier(bb_); } } while (0)
#define RSB(i) (WSP(unsigned long long, WS_CTL) + CW_RS / 2 + (size_t)(3 * l + (i)) * MTOK)
#define XB WSP(bf16, WS_XB)
#define ACT WSP(bf16, WS_ACT)
        if (IN(0)) { REP_BEGIN(0) phase_convert(F, l); REP_END(0) SEAM(0); }
        if (IN(1)) { REP_BEGIN(1) pg8::Gemm g{XB, WSP(bf16, WS_WUP1), MTOK, NUP, DM, DM, DM}; pg8::StaticOrder S; S.init(MTOK, NUP, F.G, F.bid);
            pg8::EpiSwiGLU E{ACT, RSB(0)}; pg8::gemm_phase<pg8::EpiSwiGLU, pg8::StaticOrder>(F.lds, F.tid, g, S, E); REP_END(1) SEAM(1); }
        if (IN(2)) { pg8::Gemm g{ACT, WSP(bf16, WS_WDN1), MTOK, DM, DFF, DFF, DFF}; pg8::StaticOrder S; S.init(MTOK, DM, F.G, F.bid);
            pg8::EpiResidual E{prm.out, XB, RSB(1), 0.5f}; pg8::gemm_phase<pg8::EpiResidual, pg8::StaticOrder>(F.lds, F.tid, g, S, E); SEAM(2); }
        if (IN(3)) { REP_BEGIN(3) pg8::Gemm g{XB, WSP(bf16, WS_WIN), MTOK, NINP, DM, DM, DM}; pg8::StaticOrder S; S.init(MTOK, NINP, F.G, F.bid);
            pg8::EpiWin E{WSP(bf16, WS_P1), WSP(float, WS_SMALL), WSP(bf16, WS_GATE), RSB(1)}; pg8::gemm_phase<pg8::EpiWin, pg8::StaticOrder>(F.lds, F.tid, g, S, E); REP_END(3) SEAM(3); }
        if (IN(4)) {
            REP_BEGIN(4)
            {
                unsigned* ctr = WSP(unsigned, WS_CTL) + CW_WQ + 64 * (8 + l * 2 + rep_);
                LAS unsigned* jslot = (LAS unsigned*)(F.lds + MISC_OFF + 128);
                for (;;) {
                    __syncthreads();
                    if (F.tid == 0) *jslot = __hip_atomic_fetch_add(ctr, 1u, __ATOMIC_RELAXED, __HIP_MEMORY_SCOPE_AGENT);
                    __syncthreads();
                    const int j = (int)*jslot;
                    if (j >= 32 + 1024 + 256 + 512) break;
                    job_begin(F);
                    if (j < 32) nsa_compress_job(F, l, j);
                    else if (j < 32 + 256) ssd_prep_job(F, l, j - 32);
                    else if (j < 32 + 256 + 1024) gdn_prep_job(F, l, j - 32 - 256);
                    else nsa_prep_job(F, l, j - 32 - 256 - 1024);
                }
            }
            REP_END(4)
            SEAM(4);
        }
        if (IN(5)) {
            REP_BEGIN(5)
            if (F.bid < 64) gdn_scan_job(F, (F.bid & 7) * 8 + (F.bid >> 3));
            else if (rep_ == 0) ssd_scan_part(F, F.bid - 64, F.G - 64);
            {
                unsigned* ctr = WSP(unsigned, WS_CTL) + CW_WQ + 64 * (16 + (l * 2 + rep_) * 8);
                LAS unsigned* jslot = (LAS unsigned*)(F.lds + MISC_OFF + 128);
                const unsigned myq = xb_xcc_id() & 7u;
                for (;;) {
                    __syncthreads();
                    if (F.tid == 0) {
                        unsigned got = 0xffffffffu;
                        for (unsigned t = 0; t < 8u && got == 0xffffffffu; ++t) { const unsigned q = (myq + t) & 7u;
                            if (__hip_atomic_load(ctr + 64 * q, __ATOMIC_RELAXED, __HIP_MEMORY_SCOPE_AGENT) >= 64u) continue;
                            const unsigned k = __hip_atomic_fetch_add(ctr + 64 * q, 1u, __ATOMIC_RELAXED, __HIP_MEMORY_SCOPE_AGENT);
                            if (k < 64u) got = (q >> 1) * 128u + (127u - (2u * k + (q & 1u))); }
                        *jslot = got;
                    }
                    __syncthreads();
                    const unsigned j = *jslot;
                    if (j == 0xffffffffu) break;
                    job_begin(F);
                    nsa_job(F, (int)j);
                }
            }
            REP_END(5)
            SEAM(5);
        }
        if (IN(7)) {
            REP_BEGIN(7)
            for (int j = F.bid; j < 256; j += F.G) { job_begin(F); ssd_out_job(F, l, j); }
            job_begin(F);
            gdn_final_rows(F, l, F.bid * 8 + F.wave, F.G * 8);
            REP_END(7)
            SEAM(7);
        }
        if (IN(8)) { REP_BEGIN(8) pg8::Gemm g{WSP(bf16, WS_YCAT), WSP(bf16, WS_WPM), MTOK, DM, 512, DM, DM}; pg8::SegOrder S; S.init(MTOK, DM, F.G, F.bid, 512);
            pg8::EpiMergeSeg E{WSP(bf16, WS_MERGED), WSP(bf16, WS_GATE), WSP(float, WS_SRC)}; pg8::gemm_phase<pg8::EpiMergeSeg, pg8::SegOrder>(F.lds, F.tid, g, S, E); REP_END(8) SEAM(8); }
        if (IN(9)) { pg8::Gemm g{WSP(bf16, WS_MERGED), WSP(bf16, WS_WO), MTOK, DM, DM, DM, DM}; pg8::StaticOrder S; S.init(MTOK, DM, F.G, F.bid);
            pg8::EpiResidual E{prm.out, XB, RSB(2), 1.0f}; pg8::gemm_phase<pg8::EpiResidual, pg8::StaticOrder>(F.lds, F.tid, g, S, E); SEAM(9); }
        if (IN(10)) { pg8::Gemm g{XB, WSP(bf16, WS_WUP2), MTOK, NUP, DM, DM, DM}; pg8::StaticOrder S; S.init(MTOK, NUP, F.G, F.bid);
            pg8::EpiSwiGLU E{ACT, RSB(2)}; pg8::gemm_phase<pg8::EpiSwiGLU, pg8::StaticOrder>(F.lds, F.tid, g, S, E); SEAM(10); }
        if (IN(11)) { pg8::Gemm g{ACT, WSP(bf16, WS_WDN2), MTOK, DM, DFF, DFF, DFF}; pg8::StaticOrder S; S.init(MTOK, DM, F.G, F.bid);
            pg8::EpiResidual E{prm.out, XB, RSB(3), 0.5f}; pg8::gemm_phase<pg8::EpiResidual, pg8::StaticOrder>(F.lds, F.tid, g, S, E); SEAM(11); }
#undef IN
#undef SEAM
#undef REP_BEGIN
#undef REP_END
#undef RSB
#undef XB
#undef ACT
    }
}

#ifndef DBG_DUMP
#define DBG_DUMP 0
#endif
#ifndef DBG_STOP
#define DBG_STOP 48
#endif
__global__ void dbg_dump_bf16(const unsigned short* src, size_t n, float* out, size_t nout) {
    for (size_t i = (size_t)blockIdx.x * blockDim.x + threadIdx.x; i < nout; i += (size_t)gridDim.x * blockDim.x) { float s = 0.f; for (size_t k = i; k < n; k += nout) s += __builtin_bit_cast(float, (unsigned)src[k] << 16); out[i] = s; }
}
__global__ void dbg_dump_f32(const float* src, size_t n, float* out, size_t nout) {
    for (size_t i = (size_t)blockIdx.x * blockDim.x + threadIdx.x; i < nout; i += (size_t)gridDim.x * blockDim.x) { float s = 0.f; for (size_t k = i; k < n; k += nout) s += src[k]; out[i] = s; }
}
#ifndef N_LAUNCH_MODE
#define N_LAUNCH_MODE 0
#endif
extern "C" void kernel_launch(void* const* d_in, const int* in_sizes, int n_in, void* d_out, int out_size, void* d_ws, size_t ws_size, hipStream_t stream) {
    static int grid = 0;
    if (grid == 0) {
        if (n_in != 30 || out_size != MTOK * DM || ws_size < WS_END) { fprintf(stderr, "kernel_launch: unexpected shapes (n_in %d out %d ws %zu, need %zu)\n", n_in, out_size, ws_size, (size_t)WS_END); grid = -1; return; }
        int dev = 0, cus = 0, per_cu = 0;
        if (hipGetDevice(&dev) != hipSuccess || hipDeviceGetAttribute(&cus, hipDeviceAttributeMultiprocessorCount, dev) != hipSuccess) { grid = -1; return; }
        if (hipFuncSetAttribute((const void*)hybrid_fwd, hipFuncAttributeMaxDynamicSharedMemorySize, LDS_BYTES) != hipSuccess) { fprintf(stderr, "kernel_launch: hipFuncSetAttribute failed\n"); grid = -1; return; }
        if (hipOccupancyMaxActiveBlocksPerMultiprocessor(&per_cu, (const void*)hybrid_fwd, 512, LDS_BYTES) != hipSuccess || per_cu < 1) { fprintf(stderr, "kernel_launch: occupancy query says %d\n", per_cu); }
        (void)hipGetLastError();
        grid = cus;
    }
    if (grid < 0) return;
    (void)hipMemsetAsync((char*)d_ws + WS_CTL, 0, CTL_BYTES, stream);
    Params p{};
    for (int i = 0; i < 30; ++i) p.in[i] = (const float*)d_in[i];
    p.out = (float*)d_out; p.ws = (unsigned char*)d_ws; p.pad = 0;
    if (N_LAUNCH_MODE == 0) { p.lo = 0; p.hi = DEPTH * NPH; p.use_bar = 1; hipLaunchKernelGGL(hybrid_fwd, dim3(grid), dim3(512), LDS_BYTES, stream, p); }
    else { for (int ph = 0; ph < (DBG_DUMP ? DBG_STOP : DEPTH * NPH); ++ph) { p.lo = ph; p.hi = ph + 1; p.use_bar = 0; hipLaunchKernelGGL(hybrid_fwd, dim3(grid), dim3(512), LDS_BYTES, stream, p); } }
    if (DBG_DUMP) {
        const size_t nout = (size_t)MTOK * DM; char* w = (char*)d_ws;
        if (DBG_DUMP == 1) hipLaunchKernelGGL(dbg_dump_bf16, dim3(2048), dim3(256), 0, stream, (const unsigned short*)(w + WS_P1), (size_t)MTOK * P1W, (float*)d_out, nout);
        if (DBG_DUMP == 2) hipLaunchKernelGGL(dbg_dump_f32, dim3(2048), dim3(256), 0, stream, (const float*)(w + WS_SMALL), (size_t)MTOK * SMW, (float*)d_out, nout);
        if (DBG_DUMP == 3) hipLaunchKernelGGL(dbg_dump_bf16, dim3(2048), dim3(256), 0, stream, (const unsigned short*)(w + WS_GW), (size_t)1024 * GDN_CH_BYTES / 2, (float*)d_out, nout);
        if (DBG_DUMP == 4) hipLaunchKernelGGL(dbg_dump_f32, dim3(2048), dim3(256), 0, stream, (const float*)(w + WS_SST), (size_t)2 * 64 * 16 * 64 * 128, (float*)d_out, nout);
        if (DBG_DUMP == 5) hipLaunchKernelGGL(dbg_dump_f32, dim3(2048), dim3(256), 0, stream, (const float*)(w + WS_GO), (size_t)MTOK * 512, (float*)d_out, nout);
        if (DBG_DUMP == 6) hipLaunchKernelGGL(dbg_dump_bf16, dim3(2048), dim3(256), 0, stream, (const unsigned short*)(w + WS_YCAT), (size_t)MTOK * 2048, (float*)d_out, nout);
        if (DBG_DUMP == 7) hipLaunchKernelGGL(dbg_dump_bf16, dim3(2048), dim3(256), 0, stream, (const unsigned short*)(w + WS_MERGED), (size_t)MTOK * 2048, (float*)d_out, nout);
        if (DBG_DUMP == 8) hipLaunchKernelGGL(dbg_dump_bf16, dim3(2048), dim3(256), 0, stream, (const unsigned short*)(w + WS_SX), (size_t)MTOK * 1536, (float*)d_out, nout);
        if (DBG_DUMP == 9) hipLaunchKernelGGL(dbg_dump_bf16, dim3(2048), dim3(256), 0, stream, (const unsigned short*)(w + WS_GATE), (size_t)MTOK * 6144, (float*)d_out, nout);
        if (DBG_DUMP == 11) hipLaunchKernelGGL(dbg_dump_f32, dim3(2048), dim3(256), 0, stream, (const float*)(w + WS_SRC), (size_t)MTOK * 2, (float*)d_out, nout);
        if (DBG_DUMP == 12) hipLaunchKernelGGL(dbg_dump_bf16, dim3(2048), dim3(256), 0, stream, (const unsigned short*)(w + WS_WPM), (size_t)DM * DM, (float*)d_out, nout);
        if (DBG_DUMP == 13) hipLaunchKernelGGL(dbg_dump_f32, dim3(2048), dim3(256), 0, stream, (const float*)(w + WS_MTMP), (size_t)MTOK * DM, (float*)d_out, nout);
        if (DBG_DUMP == 15) hipLaunchKernelGGL(dbg_dump_bf16, dim3(2048), dim3(256), 0, stream, (const unsigned short*)(w + WS_ACT), (size_t)MTOK * DFF, (float*)d_out, nout);
        if (DBG_DUMP == 16) hipLaunchKernelGGL(dbg_dump_bf16, dim3(2048), dim3(256), 0, stream, (const unsigned short*)(w + WS_XB), (size_t)MTOK * DM, (float*)d_out, nout);
        if (DBG_DUMP == 17) hipLaunchKernelGGL(dbg_dump_bf16, dim3(2048), dim3(256), 0, stream, (const unsigned short*)(w + WS_WIN), (size_t)NINP * DM, (float*)d_out, nout);
        if (DBG_DUMP == 18) hipLaunchKernelGGL(dbg_dump_f32, dim3(2048), dim3(256), 0, stream, (const float*)(w + WS_CTL) + CW_RS, (size_t)NRS * MTOK, (float*)d_out, nout);
        if (DBG_DUMP == 10) hipLaunchKernelGGL(dbg_dump_f32, dim3(2048), dim3(256), 0, stream, (const float*)(w + WS_YB), (size_t)MTOK * 512, (float*)d_out, nout);
    }
}
#endif
```

```cpp
#include <hip/hip_runtime.h>
#include <cstdio>
#include <cstdint>

#ifndef CPU_EMU
#define DEV __device__ __forceinline__
#define LAS __attribute__((address_space(3)))
#define VM_WAIT() asm volatile("s_waitcnt vmcnt(0)" ::: "memory")
#define LDS_WAIT() asm volatile("s_waitcnt lgkmcnt(0)" ::: "memory")
#define CFENCE() asm volatile("" ::: "memory")
#define WAVE_SYNC() do { asm volatile("" ::: "memory"); __builtin_amdgcn_wave_barrier(); asm volatile("" ::: "memory"); } while (0)
#endif

#define DBG_DUMP 0
#define DBG_NSAZ 0
#define DBG_NSA 0
#define DBG_REP (-1)
#define DBG_STOP 48
#ifndef DBG_ZERO
#define DBG_ZERO 0
#endif
typedef unsigned short bf16;
typedef short bf16x8 __attribute__((ext_vector_type(8)));
typedef float f32x4 __attribute__((ext_vector_type(4)));
typedef float f32x2 __attribute__((ext_vector_type(2)));
typedef unsigned u32x4 __attribute__((ext_vector_type(4)));
typedef unsigned u32x2 __attribute__((ext_vector_type(2)));

constexpr int BATCH = 2, SEQ = 8192, DM = 2048, DEPTH = 4, DFF = 5504, NUP = 2 * DFF;
constexpr int MTOK = BATCH * SEQ;
constexpr int NIN = 12836, NINP = 13056;
constexpr int P1W = 6656;
constexpr int SM0 = 6656;
constexpr int GT0 = 6912;
constexpr float EPS = 1e-6f;
constexpr int C_AQ = 0, C_AK = 512, C_AV = 1024, C_AZ = 1536, C_BQ = 2048, C_BKC = 2560, C_BVC = 2816, C_BKS = 3072, C_BVS = 3328, C_BKW = 3584, C_BVW = 3840, C_CZ = 4096, C_CX = 5120;
constexpr int S_AA = 0, S_AB = 4, S_BG = 8, S_DT = 20, SMW = 64;

constexpr size_t MiB = 1u << 20;
constexpr size_t WS_CTL = 0, CTL_BYTES = 2 * MiB;
constexpr size_t WS_WUP1 = 2 * MiB;
constexpr size_t WS_WDN1 = WS_WUP1 + (size_t)NUP * DM * 2;
constexpr size_t WS_WIN = WS_WDN1 + (size_t)DM * DFF * 2;
constexpr size_t WS_WPM = WS_WIN + (size_t)NINP * DM * 2;
constexpr size_t WS_WO = WS_WPM + (size_t)DM * DM * 2;
constexpr size_t WS_WUP2 = WS_WO + (size_t)DM * DM * 2;
constexpr size_t WS_WDN2 = WS_WUP2 + (size_t)NUP * DM * 2;
constexpr size_t WS_WCK = WS_WDN2 + (size_t)DM * DFF * 2;
constexpr size_t WS_WCV = WS_WCK + 128 * 4096 * 2;
constexpr size_t WS_CONST = WS_WCV + 128 * 4096 * 2;
constexpr size_t WS_WEND = WS_CONST + 4096;
static_assert(WS_WEND <= 212 * MiB, "weights region");
constexpr size_t WS_XB = 212 * MiB;
constexpr size_t WS_P1 = 276 * MiB;
constexpr size_t WS_ACT = WS_P1;
constexpr size_t WS_GATE = 484 * MiB;
constexpr size_t WS_SMALL = 676 * MiB;
constexpr size_t WS_MERGED = 680 * MiB;
constexpr size_t WS_YCAT = 744 * MiB;
constexpr size_t WS_GW = 808 * MiB;
constexpr size_t GDN_CH_BYTES = 73728;
constexpr size_t WS_GL = 880 * MiB;
constexpr size_t WS_GO = 881 * MiB;
constexpr size_t WS_SX = 913 * MiB;
constexpr size_t WS_SDT = 961 * MiB;
constexpr size_t WS_SAC = 962 * MiB;
constexpr size_t WS_SST = 963 * MiB;
constexpr size_t WS_SCD = 1027 * MiB;
constexpr size_t WS_SRC = 1028 * MiB;
constexpr size_t WS_QN = 1029 * MiB;
constexpr size_t WS_KS = 1045 * MiB;
constexpr size_t WS_KW = 1053 * MiB;
constexpr size_t WS_VST = 1061 * MiB;
constexpr size_t WS_VWT = 1069 * MiB;
constexpr size_t WS_KCMP = 1077 * MiB;
constexpr size_t WS_VCMPT = 1078 * MiB;
constexpr size_t WS_SELM = 1079 * MiB;
constexpr size_t WS_YB = 1080 * MiB;
constexpr size_t WS_MTMP = 1112 * MiB;
constexpr size_t WS_END = 1240 * MiB;
static_assert(WS_P1 + (size_t)MTOK * P1W * 2 <= WS_GATE && WS_GATE + (size_t)MTOK * 6144 * 2 <= WS_SMALL && WS_SMALL + (size_t)MTOK * SMW * 4 <= WS_MERGED && WS_MERGED + (size_t)MTOK * DM * 2 <= WS_YCAT && WS_YCAT + (size_t)MTOK * 2048 * 2 <= WS_GW, "ws map 1");
static_assert(WS_GW + 1024 * GDN_CH_BYTES <= WS_GL && WS_GO + (size_t)MTOK * 512 * 4 <= WS_SX && WS_SX + (size_t)MTOK * 1536 * 2 <= WS_SDT && WS_SDT + (size_t)MTOK * 16 * 4 <= WS_SAC && WS_SAC + (size_t)MTOK * 16 * 4 <= WS_SST && WS_SST + (size_t)2 * 64 * 16 * 64 * 128 * 4 <= WS_SCD, "ws map 2");
static_assert(WS_SRC + (size_t)MTOK * 2 * 4 <= WS_QN && WS_QN + (size_t)4 * SEQ * 256 * 2 <= WS_KS && WS_KS + (size_t)4 * SEQ * 128 * 2 <= WS_KW && WS_KW + (size_t)4 * SEQ * 128 * 2 <= WS_VST && WS_VST + (size_t)4 * SEQ * 128 * 2 <= WS_VWT && WS_VWT + (size_t)4 * SEQ * 128 * 2 <= WS_KCMP, "ws map 3");
static_assert(WS_KCMP + 4 * 512 * 128 * 2 <= WS_VCMPT && WS_VCMPT + 4 * 512 * 128 * 2 <= WS_SELM && WS_SELM + (size_t)4 * SEQ * 16 <= WS_YB && WS_YB + (size_t)MTOK * 512 * 4 <= WS_END && WS_XB + (size_t)MTOK * DM * 2 <= WS_P1 && (size_t)MTOK * DFF * 2 <= (size_t)MTOK * P1W * 2, "ws map 4");

constexpr int CW_BAR = 1024;
constexpr int CW_RS = 16384;
constexpr int NRS = 13;
constexpr int CW_WQ = 8192;
static_assert(CW_RS * 4 + NRS * MTOK * 8 <= (int)CTL_BYTES, "ctl");

constexpr int RING_BYTES = 131072;
constexpr int MISC_OFF = RING_BYTES + 12288;
constexpr int LDS_BYTES = 147456;

DEV unsigned f2bf(float f) { unsigned u = __builtin_bit_cast(unsigned, f); return (u + 0x7fffu + ((u >> 16) & 1u)) >> 16; }
DEV float bf2f(unsigned b) { return __builtin_bit_cast(float, (b & 0xffffu) << 16); }
DEV unsigned pk2(float lo, float hi) { return f2bf(lo) | (f2bf(hi) << 16); }
DEV float bflo(unsigned w) { return __builtin_bit_cast(float, w << 16); }
DEV float bfhi(unsigned w) { return __builtin_bit_cast(float, w & 0xffff0000u); }
DEV float sigmoidf_(float x) { return 1.0f / (1.0f + __expf(-x)); }
DEV float siluf_(float x) { return x / (1.0f + __expf(-x)); }
DEV float softplusf_(float x) {
    const float e = __expf(-fabsf(x)), u = 1.0f + e, d = u - 1.0f;
    const float lp = d == 0.f ? e : __logf(u) * (e / d);
    return fmaxf(x, 0.f) + lp;
}
#ifndef CPU_EMU
template <int M, class T> DEV T shx(T v) {
    static_assert(sizeof(T) == 4, "shx: 32-bit values");
    const int iv = __builtin_bit_cast(int, v);
    if constexpr (M < 32) return __builtin_bit_cast(T, __builtin_amdgcn_ds_swizzle(iv, 0x1f | (M << 10)));
    else { unsigned z = 0u; asm volatile("" : "+v"(z)); const unsigned ln = __builtin_amdgcn_mbcnt_hi(~0u, __builtin_amdgcn_mbcnt_lo(~0u, z));
        return __builtin_bit_cast(T, __builtin_amdgcn_ds_bpermute((int)((ln ^ 32u) << 2), iv)); }
}
#endif
DEV float wave_sum(float v) { v += shx<1>(v); v += shx<2>(v); v += shx<4>(v); v += shx<8>(v); v += shx<16>(v); v += shx<32>(v); return v; }
DEV void wave_sum4(float (&v)[4]) {
#pragma unroll
    for (int q = 0; q < 4; ++q) v[q] += shx<1>(v[q]);
#pragma unroll
    for (int q = 0; q < 4; ++q) v[q] += shx<2>(v[q]);
#pragma unroll
    for (int q = 0; q < 4; ++q) v[q] += shx<4>(v[q]);
#pragma unroll
    for (int q = 0; q < 4; ++q) v[q] += shx<8>(v[q]);
#pragma unroll
    for (int q = 0; q < 4; ++q) v[q] += shx<16>(v[q]);
#pragma unroll
    for (int q = 0; q < 4; ++q) v[q] += shx<32>(v[q]);
}
DEV float sum16(float v) { v += shx<1>(v); v += shx<2>(v); v += shx<4>(v); v += shx<8>(v); return v; }
DEV float max16(float v) { v = fmaxf(v, shx<1>(v)); v = fmaxf(v, shx<2>(v)); v = fmaxf(v, shx<4>(v)); v = fmaxf(v, shx<8>(v)); return v; }
#ifndef CPU_EMU
DEV float opaque_zero() { float z = 0.f; asm volatile("" : "+v"(z)); return z; }
#endif
#define ZERO4 ((f32x4){zf_, zf_, zf_, zf_})
DEV f32x4 mfma16(bf16x8 a, bf16x8 b, f32x4 c) { return __builtin_amdgcn_mfma_f32_16x16x32_bf16(a, b, c, 0, 0, 0); }
DEV bf16x8 frag_g(const bf16* base, int pitch, int row0, int k0, int lane) { return *(const bf16x8*)(base + (size_t)(row0 + (lane & 15)) * pitch + k0 + 8 * (lane >> 4)); }
DEV bf16x8 frag_l(const LAS bf16* base, int pitch, int row0, int k0, int lane) { return *(const LAS bf16x8*)(base + (row0 + (lane & 15)) * pitch + k0 + 8 * (lane >> 4)); }
#ifndef CPU_EMU
DEV const LAS void* lds_vbase(const LAS void* p) { unsigned a = (unsigned)(size_t)p; asm volatile("" : "+v"(a)); return (const LAS void*)(size_t)a; }
#endif

struct Params {
    const float* in[30];
    float* out;
    unsigned char* ws;
    int lo, hi;
    int use_bar, pad;
};
enum { I_X = 0, I_REL, I_GF1, I_WUP1, I_WDN1, I_GMIX, I_WIN, I_GCONV, I_GALOG, I_GDTB, I_GNORM, I_NQN, I_NKN, I_NPEK, I_NPEV, I_NWCK, I_NWCV,
       I_SCW, I_SCB, I_SDTB, I_SALOG, I_SD, I_SNORM, I_PA, I_PB, I_PC, I_WO, I_GF2, I_WUP2, I_WDN2 };

#define XB_TMO      128
#define XB_XCNT(j)  (256  + 64 * (j))
#define XB_XSUB(j)  (1280 + 64 * (j))
#define XB_XGEN(j)  (2304 + 64 * (j))
#define XB_TOP      3328
#define XB_TOPGEN   3392
#define XCD_BAR_WORDS 3456
#define XB_SPIN_CAP (1u << 22)
#ifndef CPU_EMU
DEV unsigned xb_ld(unsigned* p)              { return __hip_atomic_load(p, __ATOMIC_RELAXED, __HIP_MEMORY_SCOPE_AGENT); }
DEV unsigned xb_add(unsigned* p, unsigned v) { return __hip_atomic_fetch_add(p, v, __ATOMIC_RELAXED, __HIP_MEMORY_SCOPE_AGENT); }
DEV unsigned xb_xcc_id() { return (unsigned)__builtin_amdgcn_s_getreg((3 << 11) | 20) & 0xFu; }
#define XB_SPIN(cond, bar) do { unsigned _sp = 0; while (cond) { __builtin_amdgcn_s_sleep(1); \
    if ((++_sp & 255u) == 0u) { if (xb_ld(&(bar)[XB_TMO])) break; if (_sp > XB_SPIN_CAP) { atomicAdd(&(bar)[XB_TMO], 1u); break; } } } } while (0)
struct XcdBarrier { unsigned* bar; unsigned x; volatile LAS unsigned* st; };
DEV XcdBarrier xcd_barrier_post(unsigned* bar, volatile LAS unsigned* st) {
    XcdBarrier b; b.bar = bar; b.x = xb_xcc_id(); b.st = st;
    if (threadIdx.x == 0) (void)xb_add(&bar[XB_XCNT(b.x)], 1u);
    return b;
}
DEV void xcd_barrier_complete(unsigned* bar, unsigned x, unsigned& nloc, unsigned& nx) {
    const unsigned G = gridDim.x * gridDim.y * gridDim.z;
    unsigned sum, cnt, mine, sp = 0u;
    for (;;) {
        sum = 0u; cnt = 0u; mine = 0u;
#pragma unroll
        for (unsigned j = 0; j < 16; ++j) { const unsigned c = xb_ld(&bar[XB_XCNT(j)]); sum += c; cnt += (c > 0u) ? 1u : 0u; mine = (j == x) ? c : mine; }
        if (sum == G) break;
        __builtin_amdgcn_s_sleep(1);
        if ((++sp & 255u) == 0u) { if (xb_ld(&bar[XB_TMO])) break; if (sp > XB_SPIN_CAP) { atomicAdd(&bar[XB_TMO], 1u); break; } }
    }
    nloc = mine > 0u ? mine : 1u; nx = cnt > 0u ? cnt : 1u;
}
DEV void xcd_barrier(const XcdBarrier& b) {
    asm volatile("s_waitcnt vmcnt(0)" ::: "memory");
    __syncthreads();
    if (threadIdx.x == 0) {
        unsigned* bar = b.bar;
        __builtin_amdgcn_s_waitcnt(0);
        unsigned nloc = b.st[0], nx = b.st[1];
        if (nloc == 0u) { xcd_barrier_complete(bar, b.x, nloc, nx); b.st[0] = nloc; b.st[1] = nx; }
        const unsigned old = xb_add(&bar[XB_XSUB(b.x)], 1u);
        const unsigned gen = old / nloc;
        if (old + 1u == (gen + 1u) * nloc) {
            __builtin_amdgcn_fence(__ATOMIC_RELEASE, "agent");
            asm volatile("s_waitcnt vmcnt(0)" ::: "memory");
            const unsigned og = xb_add(&bar[XB_TOP], 1u);
            const unsigned tg = og / nx;
            if (og + 1u == (tg + 1u) * nx) xb_add(&bar[XB_TOPGEN], 1u);
            else XB_SPIN(xb_ld(&bar[XB_TOPGEN]) == tg, bar);
            __builtin_amdgcn_fence(__ATOMIC_ACQUIRE, "agent");
            xb_add(&bar[XB_XGEN(b.x)], 1u);
            asm volatile("s_waitcnt vmcnt(0)" ::: "memory");
        } else {
            XB_SPIN(xb_ld(&bar[XB_XGEN(b.x)]) == gen, bar);
            __builtin_amdgcn_fence(__ATOMIC_ACQUIRE, "agent");
            asm volatile("s_waitcnt vmcnt(0)" ::: "memory");
        }
    }
    __syncthreads();
}
#endif

namespace pg8 {
constexpr int BM = 256, BK = 64, HALF = 128, HTB = HALF * BK * 2, STAGE_BYTES = 8 * HTB, NXCD = 8, WGM = 8;
__host__ __device__ __forceinline__ int lds_byte(int r, int c) { const int st = (r >> 4) * 2 + (c >> 5), rr = r & 15, cc = c & 31, ob = rr * 64 + cc * 2; return st * 1024 + (ob ^ (((ob >> 9) & 1) << 5)); }
__host__ __device__ __forceinline__ void stage_rc(int b, int& R, int& C) { const int st = b / 1024, sb = b % 1024, swz = sb ^ (((sb >> 9) & 1) << 5); R = (st >> 1) * 16 + swz / 64; C = (st & 1) * 32 + (swz % 64) / 2; }
__host__ __device__ __forceinline__ int perm32(int rho) { const int n = rho >> 4, i = rho & 15; return 8 * (i >> 2) + 4 * n + (i & 3); }
struct Unit { int pm, pn, koff, seg; };
struct Gemm { const bf16* A; const bf16* Bt; int M, N, K, lda, ldb; };
struct StaticOrder {
    int nM, nN, nwg, G, c;
    __host__ __device__ void init(int M, int N, int G_, int c_) { nM = M / BM; nN = N / BM; nwg = nM * nN; G = G_; c = c_; }
    __host__ __device__ bool next(int i, Unit& u) const {
        const long L = (long)i * G + c; if (L >= nwg) return false;
        int wgid = (int)L; { const int q = nwg / NXCD, r = nwg % NXCD, xcd = wgid % NXCD, off = wgid / NXCD; wgid = (xcd < r ? xcd * (q + 1) : r * (q + 1) + (xcd - r) * q) + off; }
        const int nig = WGM * nN, gid = wgid / nig, fm = gid * WGM, gsz = (nM - fm) < WGM ? (nM - fm) : WGM;
        u.pm = fm + ((wgid % nig) % gsz); u.pn = (wgid % nig) / gsz; u.koff = 0; u.seg = 0; return true;
    }
};
struct SegOrder {
    StaticOrder S; int kseg;
    __host__ __device__ void init(int M, int N, int G_, int c_, int kseg_) { S.init(M, N, G_, c_); kseg = kseg_; }
    __host__ __device__ bool next(int i, Unit& u) const { if (!S.next(i >> 2, u)) return false; u.seg = i & 3; u.koff = u.seg * kseg; return true; }
};
#ifndef CPU_EMU
DEV unsigned cvt_pk_bf16(float lo, float hi) { unsigned r; asm volatile("s_nop 1\n\tv_cvt_pk_bf16_f32 %0, %1, %2" : "=v"(r) : "v"(lo), "v"(hi)); return r; }
#endif
DEV unsigned long long rss_fix(float ss) { return (unsigned long long)(ss * 16777216.0f + 0.5f); }
DEV float rss_val(unsigned long long v) { return (float)v * (1.0f / 16777216.0f); }

struct EpiSwiGLU {
    static constexpr bool PERM = true, SEGACC = false;
    bf16* act; const unsigned long long* rss;
    DEV void operator()(const f32x4 (&acc)[2][2][4][2], const Unit& u, int wr, int wc, int fr, int fq) const {
        const int row0 = u.pm * BM + wr * 64 + fr, col0 = u.pn * HALF + wc * 32 + 8 * fq;
        unsigned long long rv[8];
#pragma unroll
        for (int i = 0; i < 8; ++i) rv[i] = rss[row0 + (i >> 2) * HALF + (i & 3) * 16];
        CFENCE();
#pragma unroll
        for (int ai = 0; ai < 2; ++ai)
#pragma unroll
            for (int m = 0; m < 4; ++m) {
                const int row = row0 + ai * HALF + m * 16;
                const float rs = rsqrtf(rss_val(rv[ai * 4 + m]) * (1.0f / DM) + EPS);
                float o[8];
#pragma unroll
                for (int n = 0; n < 2; ++n)
#pragma unroll
                    for (int j = 0; j < 4; ++j) { const float a = acc[ai][0][m][n][j] * rs, b = acc[ai][1][m][n][j] * rs; o[4 * n + j] = a * b * __builtin_amdgcn_rcpf(1.0f + __expf(-a)); }
                u32x4 w; w.x = cvt_pk_bf16(o[0], o[1]); w.y = cvt_pk_bf16(o[2], o[3]); w.z = cvt_pk_bf16(o[4], o[5]); w.w = cvt_pk_bf16(o[6], o[7]);
                *(u32x4*)(act + (size_t)row * DFF + col0) = w;
            }
    }
};
struct EpiResidual {
    static constexpr bool PERM = true, SEGACC = false;
    float* x; bf16* xb; unsigned long long* rss_out; float alpha;
    DEV void operator()(const f32x4 (&acc)[2][2][4][2], const Unit& u, int wr, int wc, int fr, int fq) const {
        const int row0 = u.pm * BM + wr * 64 + fr, col0 = u.pn * BM + wc * 32 + 8 * fq;
#pragma unroll
        for (int aim = 0; aim < 4; ++aim) {
            const int ai = aim >> 1, m0 = (aim & 1) * 2;
            f32x4 xv[2][2][2];
#pragma unroll
            for (int mm = 0; mm < 2; ++mm)
#pragma unroll
                for (int bj = 0; bj < 2; ++bj) { const float* xp = x + (size_t)(row0 + ai * HALF + (m0 + mm) * 16) * DM + col0 + bj * HALF; xv[mm][bj][0] = *(const f32x4*)xp; xv[mm][bj][1] = *(const f32x4*)(xp + 4); }
            CFENCE();
#pragma unroll
            for (int mm = 0; mm < 2; ++mm) {
                const int m = m0 + mm, row = row0 + ai * HALF + m * 16; float ss = 0.f;
#pragma unroll
                for (int bj = 0; bj < 2; ++bj) {
                    float* xp = x + (size_t)row * DM + col0 + bj * HALF;
                    const f32x4 x0 = xv[mm][bj][0] + acc[ai][bj][m][0] * alpha, x1 = xv[mm][bj][1] + acc[ai][bj][m][1] * alpha;
                    *(f32x4*)xp = x0; *(f32x4*)(xp + 4) = x1;
                    ss += (x0[0] * x0[0] + x0[1] * x0[1]) + (x0[2] * x0[2] + x0[3] * x0[3]) + (x1[0] * x1[0] + x1[1] * x1[1]) + (x1[2] * x1[2] + x1[3] * x1[3]);
                    u32x4 w; w.x = cvt_pk_bf16(x0[0], x0[1]); w.y = cvt_pk_bf16(x0[2], x0[3]); w.z = cvt_pk_bf16(x1[0], x1[1]); w.w = cvt_pk_bf16(x1[2], x1[3]);
                    *(u32x4*)(xb + (size_t)row * DM + col0 + bj * HALF) = w;
                }
                ss += shx<16>(ss); ss += shx<32>(ss);
                if (fq == 0) atomicAdd(rss_out + row, rss_fix(ss));
            }
            CFENCE();
        }
    }
};
struct EpiWin {
    static constexpr bool PERM = true, SEGACC = false;
    bf16* p1; float* small; bf16* gate; const unsigned long long* rss;
    DEV void operator()(const f32x4 (&acc)[2][2][4][2], const Unit& u, int wr, int wc, int fr, int fq) const {
        const int row0 = u.pm * BM + wr * 64 + fr, cl0 = wc * 32 + 8 * fq;
        unsigned long long rv[8];
#pragma unroll
        for (int i = 0; i < 8; ++i) rv[i] = rss[row0 + (i >> 2) * HALF + (i & 3) * 16];
        CFENCE();
#pragma unroll
        for (int ai = 0; ai < 2; ++ai)
#pragma unroll
            for (int m = 0; m < 4; ++m) {
                const int row = row0 + ai * HALF + m * 16;
                const float rs = rsqrtf(rss_val(rv[ai * 4 + m]) * (1.0f / DM) + EPS);
#pragma unroll
                for (int bj = 0; bj < 2; ++bj) {
                    f32x4 v0 = acc[ai][bj][m][0] * rs, v1 = acc[ai][bj][m][1] * rs;
                    const int cl = cl0 + bj * HALF;
                    if (u.pn < 26) {
                        u32x4 w; w.x = cvt_pk_bf16(v0[0], v0[1]); w.y = cvt_pk_bf16(v0[2], v0[3]); w.z = cvt_pk_bf16(v1[0], v1[1]); w.w = cvt_pk_bf16(v1[2], v1[3]);
                        *(u32x4*)(p1 + (size_t)row * P1W + u.pn * BM + cl) = w;
                    } else if (u.pn == 26) {
                        if (cl < SMW) { float* sp = small + (size_t)row * SMW + cl; *(f32x4*)sp = v0; *(f32x4*)(sp + 4) = v1; }
                    } else {
#pragma unroll
                        for (int j = 0; j < 4; ++j) { v0[j] = fminf(__builtin_amdgcn_rcpf(1.0f + __expf(-v0[j])), 1.0f); v1[j] = fminf(__builtin_amdgcn_rcpf(1.0f + __expf(-v1[j])), 1.0f); }
                        u32x4 w; w.x = cvt_pk_bf16(v0[0], v0[1]); w.y = cvt_pk_bf16(v0[2], v0[3]); w.z = cvt_pk_bf16(v1[0], v1[1]); w.w = cvt_pk_bf16(v1[2], v1[3]);
                        *(u32x4*)(gate + (size_t)row * 6144 + (u.pn - 27) * BM + cl) = w;
                    }
                }
            }
    }
};
struct EpiMergeSeg {
    static constexpr bool PERM = true, SEGACC = true;
    bf16* merged; const bf16* gate; const float* rc;
    DEV void seg(f32x4 (&acc)[2][2][4][2], const Unit& u, int wr, int wc, int fr, int fq) const {
        const int row0 = u.pm * BM + wr * 64 + fr, col0 = u.pn * BM + wc * 32 + 8 * fq, sg = u.seg;
        f32x2 rcv[8];
#pragma unroll
        for (int i = 0; i < 8; ++i) rcv[i] = *(const f32x2*)(rc + (size_t)(row0 + (i >> 2) * HALF + (i & 3) * 16) * 2);
        const int offa = sg == 0 ? 0 : (sg == 1 ? DM : 2 * DM), offb = sg == 0 ? DM : 2 * DM;
#pragma unroll
        for (int aim = 0; aim < 4; ++aim) {
            const int ai = aim >> 1, m0 = (aim & 1) * 2;
            u32x4 wa[2][2], wb[2][2];
            if (sg != 2) {
#pragma unroll
                for (int mm = 0; mm < 2; ++mm)
#pragma unroll
                    for (int bj = 0; bj < 2; ++bj) { const bf16* gp = gate + (size_t)(row0 + ai * HALF + (m0 + mm) * 16) * 6144 + col0 + bj * HALF; wa[mm][bj] = *(const u32x4*)(gp + offa); wb[mm][bj] = *(const u32x4*)(gp + offb); }
            }
            CFENCE();
#pragma unroll
            for (int mm = 0; mm < 2; ++mm) {
                const int m = m0 + mm, row = row0 + ai * HALF + m * 16;
                const float r0 = rcv[ai * 4 + m][0], r1 = rcv[ai * 4 + m][1];
#pragma unroll
                for (int bj = 0; bj < 2; ++bj) {
                    float f[8];
                    if (sg == 2) { const float q = fmaxf(r0, 1e-20f) / fmaxf(r1, 1e-20f);
#pragma unroll
                        for (int j = 0; j < 8; ++j) f[j] = q; }
                    else {
                        const u32x4 a4 = wa[mm][bj], b4 = wb[mm][bj];
                        const float na[8] = {bflo(a4.x), bfhi(a4.x), bflo(a4.y), bfhi(a4.y), bflo(a4.z), bfhi(a4.z), bflo(a4.w), bfhi(a4.w)};
                        const float nb[8] = {bflo(b4.x), bfhi(b4.x), bflo(b4.y), bfhi(b4.y), bflo(b4.z), bfhi(b4.z), bflo(b4.w), bfhi(b4.w)};
#pragma unroll
                        for (int j = 0; j < 8; ++j) {
                            if (sg == 0) f[j] = fmaxf(na[j], 1e-20f) * __builtin_amdgcn_rcpf(fmaxf(nb[j], 1e-20f));
                            else if (sg == 1) f[j] = fmaxf(na[j], 1e-20f) * __builtin_amdgcn_rcpf(fmaxf(nb[j] * r0, 1e-20f));
                            else f[j] = fmaxf(na[j] * r1, 1e-20f); }
                    }
                    f32x4 v0 = acc[ai][bj][m][0], v1 = acc[ai][bj][m][1];
#pragma unroll
                    for (int j = 0; j < 4; ++j) { v0[j] *= f[j]; v1[j] *= f[4 + j]; }
                    if (sg < 3) { acc[ai][bj][m][0] = v0; acc[ai][bj][m][1] = v1; }
                    else { u32x4 o; o.x = cvt_pk_bf16(v0[0], v0[1]); o.y = cvt_pk_bf16(v0[2], v0[3]); o.z = cvt_pk_bf16(v1[0], v1[1]); o.w = cvt_pk_bf16(v1[2], v1[3]);
                        *(u32x4*)(merged + (size_t)row * DM + col0 + bj * HALF) = o; }
                }
            }
            CFENCE();
        }
    }
};

#ifndef CPU_EMU
template <class Epi, class Sched>
DEV void gemm_phase(LAS unsigned char* lds, const int tid, const Gemm g, const Sched& S, const Epi& E) {
    const int wid = __builtin_amdgcn_readfirstlane(tid >> 6), lane = tid & 63, wr = wid >> 2, wc = wid & 3, fr = lane & 15, fq = lane >> 4;
    const int K = g.K, nt = K / BK;
    const float zf_ = opaque_zero();
    unsigned voffA[2], voffB[2];
#pragma unroll
    for (int i = 0; i < 2; ++i) { int R, C; stage_rc(tid * 16 + i * 8192, R, C); const int Rb = Epi::PERM ? ((R & ~31) + perm32(R & 31)) : R;
        voffA[i] = (unsigned)(R * g.lda + C) * 2u; voffB[i] = (unsigned)(Rb * g.ldb + C) * 2u; }
    const size_t kstep = (size_t)(BK * 2);
    const size_t hA = (size_t)HALF * g.lda * 2, hB = (size_t)HALF * g.ldb * 2;
    const size_t tA = 2 * hA, tB = 2 * hB;
    const unsigned ldsw = (unsigned)wid * 1024u;
    const int aoff = lds_byte(wr * 64 + fr, fq * 8), boff = lds_byte(wc * 32 + fr, fq * 8);
#define PG8_SA(b, h) (((b) * 2 + (h)) * HTB)
#define PG8_SB(b, h) ((4 + (b) * 2 + (h)) * HTB)
#define PG8_STAGE(bufoff, gbase, voff) do { _Pragma("unroll") for (int _i = 0; _i < 2; ++_i) \
        __builtin_amdgcn_global_load_lds((const unsigned*)((const char*)(gbase) + (voff)[_i]), (LAS unsigned*)(lds + (bufoff) + ldsw + _i * 8192), 16, 0, 0); } while (0)
#define PG8_LDA(dst, b, h) do { _Pragma("unroll") for (int m = 0; m < 4; ++m) _Pragma("unroll") for (int k = 0; k < 2; ++k) dst[m][k] = *(const LAS bf16x8*)(lds + PG8_SA(b, h) + aoff + m * 2048 + k * 1024); } while (0)
#define PG8_LDB(dst, b, h) do { _Pragma("unroll") for (int n = 0; n < 2; ++n) _Pragma("unroll") for (int k = 0; k < 2; ++k) dst[n][k] = *(const LAS bf16x8*)(lds + PG8_SB(b, h) + boff + n * 2048 + k * 1024); } while (0)
#define PG8_MMA(ai, bj, At, Bt) do { __builtin_amdgcn_s_setprio(1); _Pragma("unroll") for (int m = 0; m < 4; ++m) _Pragma("unroll") for (int n = 0; n < 2; ++n) _Pragma("unroll") for (int k = 0; k < 2; ++k) \
        acc[ai][bj][m][n] = __builtin_amdgcn_mfma_f32_16x16x32_bf16(Bt[n][k], At[m][k], acc[ai][bj][m][n], 0, 0, 0); __builtin_amdgcn_s_setprio(0); } while (0)
#define PG8_WAIT_V(n) asm volatile("s_waitcnt vmcnt(" #n ")" ::: "memory")
#define PG8_WAIT_L(n) asm volatile("s_waitcnt lgkmcnt(" #n ")" ::: "memory")
#define PG8_BAR __builtin_amdgcn_s_barrier()
#define PG8_SCHED __builtin_amdgcn_sched_barrier(0)
    Unit cur, nxt; int ui = 0;
    if (!S.next(0, cur)) return;
    f32x4 acc[2][2][4][2];
#pragma unroll
    for (int a = 0; a < 2; ++a)
#pragma unroll
        for (int b = 0; b < 2; ++b)
#pragma unroll
            for (int m = 0; m < 4; ++m)
#pragma unroll
                for (int n = 0; n < 2; ++n) acc[a][b][m][n] = ZERO4;
    bf16x8 At[4][2], B0[2][2], B1[2][2];
    const char* cA = (const char*)g.A + (size_t)cur.pm * tA + (size_t)cur.koff * 2; const char* cB = (const char*)g.Bt + (size_t)cur.pn * tB + (size_t)cur.koff * 2;
    PG8_STAGE(PG8_SB(0, 0), cB, voffB); PG8_STAGE(PG8_SB(0, 1), cB + hB, voffB); PG8_STAGE(PG8_SA(0, 0), cA, voffA); PG8_STAGE(PG8_SA(0, 1), cA + hA, voffA);
    if (wr == 1) PG8_BAR;
    PG8_WAIT_V(2); PG8_BAR;
    PG8_STAGE(PG8_SB(1, 0), cB + kstep, voffB); PG8_STAGE(PG8_SA(1, 0), cA + kstep, voffA); PG8_STAGE(PG8_SB(1, 1), cB + hB + kstep, voffB);
    PG8_WAIT_V(6); PG8_BAR;
    for (;;) {
        const bool has_next = S.next(ui + 1, nxt);
        const char* nA = has_next ? (const char*)g.A + (size_t)nxt.pm * tA + (size_t)nxt.koff * 2 : cA; const char* nB = has_next ? (const char*)g.Bt + (size_t)nxt.pn * tB + (size_t)nxt.koff * 2 : cB;
        for (int t = 0; t < nt; t += 2) {
            const bool last = (t == nt - 2);
            const char* a1 = cA + (size_t)(t + 1) * kstep;
            const char* a2 = last ? nA : cA + (size_t)(t + 2) * kstep; const char* b2 = last ? nB : cB + (size_t)(t + 2) * kstep;
            const char* a3 = a2 + kstep; const char* b3 = b2 + kstep;
            PG8_LDB(B0, 0, 0); PG8_LDB(B1, 0, 1); PG8_SCHED; PG8_LDA(At, 0, 0); PG8_STAGE(PG8_SA(1, 1), a1 + hA, voffA);
            PG8_WAIT_V(8); PG8_WAIT_L(0); PG8_BAR; PG8_MMA(0, 0, At, B0); PG8_MMA(0, 1, At, B1); PG8_BAR; PG8_SCHED;
            PG8_LDA(At, 0, 1); PG8_STAGE(PG8_SB(0, 0), b2, voffB); PG8_STAGE(PG8_SB(0, 1), b2 + hB, voffB); PG8_STAGE(PG8_SA(0, 0), a2, voffA);
            PG8_WAIT_V(8); PG8_WAIT_L(0); PG8_BAR; PG8_MMA(1, 0, At, B0); PG8_MMA(1, 1, At, B1); PG8_BAR; PG8_SCHED;
            PG8_LDB(B0, 1, 0); PG8_LDB(B1, 1, 1); PG8_SCHED; PG8_LDA(At, 1, 0); PG8_STAGE(PG8_SA(0, 1), a2 + hA, voffA);
            PG8_WAIT_V(8); PG8_WAIT_L(0); PG8_BAR; PG8_MMA(0, 0, At, B0); PG8_MMA(0, 1, At, B1); PG8_BAR; PG8_SCHED;
            PG8_LDA(At, 1, 1); PG8_STAGE(PG8_SB(1, 0), b3, voffB); PG8_STAGE(PG8_SB(1, 1), b3 + hB, voffB); PG8_STAGE(PG8_SA(1, 0), a3, voffA);
            PG8_WAIT_V(8); PG8_WAIT_L(0); PG8_BAR; PG8_MMA(1, 0, At, B0); PG8_MMA(1, 1, At, B1); PG8_BAR; PG8_SCHED;
        }
        if (wr == 0) PG8_BAR;
        if constexpr (Epi::SEGACC) E.seg(acc, cur, wr, wc, fr, fq); else E(acc, cur, wr, wc, fr, fq);
        if (!has_next) break;
        if (!(Epi::SEGACC && nxt.seg != 0)) {
#pragma unroll
        for (int a = 0; a < 2; ++a)
#pragma unroll
            for (int b = 0; b < 2; ++b)
#pragma unroll
                for (int m = 0; m < 4; ++m)
#pragma unroll
                    for (int n = 0; n < 2; ++n) acc[a][b][m][n] = ZERO4;
        }
        cur = nxt; cA = nA; cB = nB; ++ui;
        if (wr == 1) PG8_BAR;
    }
    PG8_WAIT_V(0);
    PG8_BAR;
#undef PG8_SA
#undef PG8_SB
#undef PG8_STAGE
#undef PG8_LDA
#undef PG8_LDB
#undef PG8_MMA
#undef PG8_WAIT_V
#undef PG8_WAIT_L
#undef PG8_BAR
#undef PG8_SCHED
}
#endif
}

#ifndef CPU_EMU
typedef const __attribute__((address_space(4))) Params* KParams;
#else
typedef const Params* KParams;
#endif
struct Frame {
    LAS unsigned char* lds;
    int tid, lane, wave, G, bid;
    KParams p;
    unsigned char* ws;
};
DEV const float* lin(const Frame& F, int idx, int layer, size_t per_layer) { return F.p->in[idx] + (size_t)layer * per_layer; }
#define WSP(T, off) ((T*)(F.ws + (off)))

DEV int up_dest(int n) { return n < DFF ? (n >> 7) * 256 + (n & 127) : ((n - DFF) >> 7) * 256 + 128 + ((n - DFF) & 127); }
DEV int win_dest(int n) {
    if (n < 2048) return n;
    if (n < 2052) return SM0 + S_AA + (n - 2048);
    if (n < 2056) return SM0 + S_AB + (n - 2052);
    if (n < 4104) return C_BQ + (n - 2056);
    if (n < 4116) return SM0 + S_BG + (n - 4104);
    if (n < 6676) return C_CZ + (n - 4116);
    if (n < 6692) return SM0 + S_DT + (n - 6676);
    return GT0 + (n - 6692);
}
struct XItem { const float* W; const float* ks; bf16* WT; int K, N, ldt, koff, mode, r; };
DEV void xitem_load(const XItem& it, int lane, float (&v)[32]) {
    const int nblk = (it.N + 31) / 32, kb = it.r / nblk, nb = it.r % nblk, k0 = 64 * kb, n0 = 32 * nb;
    const int nn = n0 + (lane & 31);
    const float* src = it.W + (size_t)(k0 + (lane >> 5)) * it.N + (nn < it.N ? nn : it.N - 1);
#pragma unroll
    for (int i = 0; i < 32; ++i) v[i] = src[(size_t)(2 * i) * it.N];
}
DEV void xitem_to_lds(LAS float* scr, int lane, const float (&v)[32]) {
#pragma unroll
    for (int i = 0; i < 32; ++i) scr[(2 * i + (lane >> 5)) * 33 + (lane & 31)] = v[i];
    LDS_WAIT(); CFENCE();
}
DEV void xitem_store(const XItem& it, LAS float* scr, int lane) {
    const int nblk = (it.N + 31) / 32, kb = it.r / nblk, nb = it.r % nblk, k0 = 64 * kb, n0 = 32 * nb;
    const int c = lane & 7;
    f32x4 ks0 = (f32x4){1.f, 1.f, 1.f, 1.f}, ks1 = ks0;
    if (it.ks) { ks0 = *(const f32x4*)(it.ks + k0 + 8 * c); ks1 = *(const f32x4*)(it.ks + k0 + 8 * c + 4); }
#pragma unroll
    for (int j = 0; j < 4; ++j) { const int n = (lane >> 3) + 8 * j; const LAS float* s = scr + (8 * c) * 33 + n;
        u32x4 o; o.x = pk2(s[0 * 33] * ks0[0], s[1 * 33] * ks0[1]); o.y = pk2(s[2 * 33] * ks0[2], s[3 * 33] * ks0[3]); o.z = pk2(s[4 * 33] * ks1[0], s[5 * 33] * ks1[1]); o.w = pk2(s[6 * 33] * ks1[2], s[7 * 33] * ks1[3]);
        const int ng = n0 + n;
        if (ng < it.N) { const int dr = it.mode == 0 ? ng : (it.mode == 1 ? up_dest(ng) : win_dest(ng)); *(u32x4*)(it.WT + (size_t)dr * it.ldt + it.koff + k0 + 8 * c) = o; } }
    LDS_WAIT(); CFENCE();
}
constexpr int XI_UP = (DM / 64) * (NUP / 32), XI_DN = (DFF / 64) * (DM / 32), XI_IN = (DM / 64) * ((NIN + 31) / 32), XI_P5 = (512 / 64) * (DM / 32), XI_P10 = (1024 / 64) * (DM / 32), XI_OO = (DM / 64) * (DM / 32), XI_CK = (4096 / 64) * (128 / 32);
constexpr int XI_TOTAL = 2 * XI_UP + 2 * XI_DN + XI_IN + 2 * XI_P5 + XI_P10 + XI_OO + 2 * XI_CK;
DEV XItem xitem_decode(Frame& F, int l, int idx) {
    XItem t; int r = idx; t.ks = nullptr; t.koff = 0; t.mode = 0;
    if (r < XI_UP) { t.W = lin(F, I_WUP1, l, (size_t)DM * NUP); t.K = DM; t.N = NUP; t.WT = WSP(bf16, WS_WUP1); t.ldt = DM; t.ks = lin(F, I_GF1, l, DM); t.mode = 1; }
    else if ((r -= XI_UP) < XI_UP) { t.W = lin(F, I_WUP2, l, (size_t)DM * NUP); t.K = DM; t.N = NUP; t.WT = WSP(bf16, WS_WUP2); t.ldt = DM; t.ks = lin(F, I_GF2, l, DM); t.mode = 1; }
    else if ((r -= XI_UP) < XI_DN) { t.W = lin(F, I_WDN1, l, (size_t)DFF * DM); t.K = DFF; t.N = DM; t.WT = WSP(bf16, WS_WDN1); t.ldt = DFF; }
    else if ((r -= XI_DN) < XI_DN) { t.W = lin(F, I_WDN2, l, (size_t)DFF * DM); t.K = DFF; t.N = DM; t.WT = WSP(bf16, WS_WDN2); t.ldt = DFF; }
    else if ((r -= XI_DN) < XI_IN) { t.W = lin(F, I_WIN, l, (size_t)DM * NIN); t.K = DM; t.N = NIN; t.WT = WSP(bf16, WS_WIN); t.ldt = DM; t.ks = lin(F, I_GMIX, l, DM); t.mode = 2; }
    else if ((r -= XI_IN) < XI_P5) { t.W = lin(F, I_PA, l, (size_t)512 * DM); t.K = 512; t.N = DM; t.WT = WSP(bf16, WS_WPM); t.ldt = DM; }
    else if ((r -= XI_P5) < XI_P5) { t.W = lin(F, I_PB, l, (size_t)512 * DM); t.K = 512; t.N = DM; t.WT = WSP(bf16, WS_WPM); t.ldt = DM; t.koff = 512; }
    else if ((r -= XI_P5) < XI_P10) { t.W = lin(F, I_PC, l, (size_t)1024 * DM); t.K = 1024; t.N = DM; t.WT = WSP(bf16, WS_WPM); t.ldt = DM; t.koff = 1024; t.ks = lin(F, I_SNORM, l, 1024); }
    else if ((r -= XI_P10) < XI_OO) { t.W = lin(F, I_WO, l, (size_t)DM * DM); t.K = DM; t.N = DM; t.WT = WSP(bf16, WS_WO); t.ldt = DM; }
    else if ((r -= XI_OO) < XI_CK) { t.W = lin(F, I_NWCK, l, (size_t)4096 * 128); t.K = 4096; t.N = 128; t.WT = WSP(bf16, WS_WCK); t.ldt = 4096; }
    else { r -= XI_CK; t.W = lin(F, I_NWCV, l, (size_t)4096 * 128); t.K = 4096; t.N = 128; t.WT = WSP(bf16, WS_WCV); t.ldt = 4096; }
    t.r = r; return t;
}
DEV void phase_convert(Frame& F, int l) {
    LAS float* scr = (LAS float*)(F.lds + F.wave * 16384);
    const int gw = F.bid * 8 + F.wave, NGW = F.G * 8;
    if (gw < XI_TOTAL) {
        float v[32]; XItem cur = xitem_decode(F, l, gw); xitem_load(cur, F.lane, v);
        for (int it = gw; it < XI_TOTAL; it += NGW) {
            xitem_to_lds(scr, F.lane, v);
            const bool has_next = it + NGW < XI_TOTAL; XItem nxt = cur;
            if (has_next) { nxt = xitem_decode(F, l, it + NGW); xitem_load(nxt, F.lane, v); }
            xitem_store(cur, scr, F.lane);
            cur = nxt;
        }
    }
    { bf16* w = WSP(bf16, WS_WIN) + (size_t)(SM0 + 36) * DM; const int n16 = (GT0 - SM0 - 36) * DM / 8;
      const unsigned zu = __builtin_bit_cast(unsigned, opaque_zero());
      for (int i = F.bid * 512 + F.tid; i < n16; i += F.G * 512) ((u32x4*)w)[i] = (u32x4){zu, zu, zu, zu}; }
    { const float* pek = lin(F, I_NPEK, l, 4096); const float* pev = lin(F, I_NPEV, l, 4096); float* cst = WSP(float, WS_CONST);
      for (int it = gw; it < 256; it += NGW) { const int e = it & 127; const float* pe = it < 128 ? pek : pev; const float* w = it < 128 ? lin(F, I_NWCK, l, (size_t)4096 * 128) : lin(F, I_NWCV, l, (size_t)4096 * 128); float s = 0.f;
          for (int k = F.lane; k < 4096; k += 64) s += pe[k] * w[(size_t)k * 128 + e];
          s = wave_sum(s); if (F.lane == 0) cst[it] = s; } }
    if (l == 0) {
        const float* x = F.p->in[I_X]; float* out = F.p->out; bf16* xb = WSP(bf16, WS_XB); unsigned long long* rss = WSP(unsigned long long, WS_CTL) + CW_RS / 2;
        for (int m = gw; m < MTOK; m += NGW) {
            const f32x4* xr = (const f32x4*)(x + (size_t)m * DM) + F.lane; f32x4* orow = (f32x4*)(out + (size_t)m * DM) + F.lane; u32x2* br = (u32x2*)(xb + (size_t)m * DM) + F.lane; float ss = 0.f;
#pragma unroll
            for (int j = 0; j < 8; ++j) { const f32x4 v = xr[64 * j]; orow[64 * j] = v; ss += (v[0] * v[0] + v[1] * v[1]) + (v[2] * v[2] + v[3] * v[3]); u32x2 w; w.x = pk2(v[0], v[1]); w.y = pk2(v[2], v[3]); br[64 * j] = w; }
            ss = wave_sum(ss); if (F.lane == 0) rss[m] = pg8::rss_fix(ss);
        }
    }
}

DEV void nsa_prep_job(Frame& F, int l, int job) {
    const int b = job >> 8, g = (job >> 7) & 1, j = job & 127, bg = b * 2 + g, t0 = 64 * j;
    const bf16* p1 = WSP(bf16, WS_P1);
    const float* qn = lin(F, I_NQN, l, 128); const float* kn = lin(F, I_NKN, l, 128);
    bf16* QN = WSP(bf16, WS_QN); bf16* KS = WSP(bf16, WS_KS); bf16* KW = WSP(bf16, WS_KW); bf16* VST = WSP(bf16, WS_VST); bf16* VWT = WSP(bf16, WS_VWT);
    const float gq0 = qn[2 * F.lane], gq1 = qn[2 * F.lane + 1], gk0 = kn[2 * F.lane], gk1 = kn[2 * F.lane + 1];
    unsigned wv[8][4];
#pragma unroll
    for (int i = 0; i < 8; ++i) { const size_t row = (size_t)(b * SEQ + t0 + 8 * F.wave + i) * P1W;
#pragma unroll
        for (int v = 0; v < 4; ++v) { const int col = v < 2 ? C_BQ + (g * 2 + v) * 128 : (v == 2 ? C_BKS + g * 128 : C_BKW + g * 128); wv[i][v] = *(const unsigned*)(p1 + row + col + 2 * F.lane); } }
    CFENCE();
#pragma unroll
    for (int i = 0; i < 8; ++i) {
        const int t = t0 + 8 * F.wave + i;
        float ssv[4];
#pragma unroll
        for (int v = 0; v < 4; ++v) { const float x0 = bflo(wv[i][v]), x1 = bfhi(wv[i][v]); ssv[v] = x0 * x0 + x1 * x1; }
        wave_sum4(ssv);
#pragma unroll
        for (int v = 0; v < 4; ++v) {
            const unsigned w = wv[i][v];
            const float x0 = bflo(w), x1 = bfhi(w);
            const float ss = ssv[v];
            float r = rsqrtf(ss * (1.0f / 128.0f) + EPS);
            unsigned o;
            if (v < 2) { r *= 0.08838834764831845f * 1.4426950408889634f;     o = pk2(x0 * r * gq0, x1 * r * gq1); *(unsigned*)(QN + ((size_t)(bg * SEQ + t) * 2 + v) * 128 + 2 * F.lane) = o; }
            else { o = pk2(x0 * r * gk0, x1 * r * gk1); *(unsigned*)((v == 2 ? KS : KW) + (size_t)(bg * SEQ + t) * 128 + 2 * F.lane) = o; }
        }
    }
    LAS bf16* tl = (LAS bf16*)F.lds;
    for (int i = F.tid; i < 2 * 64 * 64; i += 512) {
        const int v = i >> 12, r = (i >> 6) & 63, c2 = i & 63;
        const unsigned w = *(const unsigned*)(p1 + (size_t)(b * SEQ + t0 + r) * P1W + (v ? C_BVW : C_BVS) + g * 128 + 2 * c2);
        *(LAS unsigned*)(tl + (v * 64 + r) * 130 + 2 * c2) = w;
    }
    __syncthreads();
    for (int i = F.tid; i < 2 * 128 * 8; i += 512) {
        const int v = i >> 10, d = i & 127, tc = (i >> 7) & 7;
        const LAS bf16* s = tl + (v * 64 + 8 * tc) * 130 + d;
        u32x4 o; o.x = s[0] | ((unsigned)s[130] << 16); o.y = s[260] | ((unsigned)s[390] << 16); o.z = s[520] | ((unsigned)s[650] << 16); o.w = s[780] | ((unsigned)s[910] << 16);
        *(u32x4*)((v ? VWT : VST) + ((size_t)(bg * 128 + j) * 128 + d) * 64 + 8 * tc) = o;
    }
    __syncthreads();
}

DEV void gdn_prep_job(Frame& F, int l, int job) {
    const int b = job >> 9, h = (job >> 7) & 3, c = job & 127, t0 = 64 * c;
    const bf16* p1 = WSP(bf16, WS_P1); const float* small = WSP(float, WS_SMALL);
    const float* convw = lin(F, I_GCONV, l, 4 * 1536);
    LAS float* Qs = (LAS float*)F.lds;
    LAS float* Ks = Qs + 64 * 132;
    LAS float* Vs = Ks + 64 * 132;
    LAS float* Mm = Vs + 64 * 132;
    LAS float* At = Mm + 64 * 68;
    LAS float* beta = At + 64 * 68;
    LAS float* gc = beta + 64;
    LAS float* eg = gc + 64;
    const int tid = F.tid;
    {
        const int ch = tid & 127, tg = tid >> 7;
#pragma unroll
        for (int v = 0; v < 3; ++v) {
            const int cc = v * 512 + h * 128 + ch;
            const float w0 = convw[cc], w1 = convw[1536 + cc], w2 = convw[2 * 1536 + cc], w3 = convw[3 * 1536 + cc];
            const int col = (v == 0 ? C_AQ : (v == 1 ? C_AK : C_AV)) + h * 128 + ch;
            float xin[19];
            { const int tt = t0 + 16 * tg;
#pragma unroll
              for (int i = 0; i < 19; ++i) { const int t = tt - 3 + i; xin[i] = t >= 0 ? bf2f(p1[(size_t)(b * SEQ + t) * P1W + col]) : 0.f; } }
            LAS float* dst = v == 0 ? Qs : (v == 1 ? Ks : Vs);
#pragma unroll
            for (int i = 0; i < 16; ++i) {
                const float y = w0 * xin[i] + w1 * xin[i + 1] + w2 * xin[i + 2] + w3 * xin[i + 3];
                dst[(16 * tg + i) * 132 + ch] = siluf_(y);
            }
        }
        if (tid < 64) {
            const size_t row = (size_t)(b * SEQ + t0 + tid);
            const float a = small[row * SMW + S_AA + h], bb = small[row * SMW + S_AB + h];
            beta[tid] = sigmoidf_(bb);
            gc[tid] = -__expf(lin(F, I_GALOG, l, 4)[h]) * softplusf_(a + lin(F, I_GDTB, l, 4)[h]);
        }
    }
    __syncthreads();
    for (int i4 = 0; i4 < 4; ++i4) {
        float x0[4], x1[4], ssv[4];
#pragma unroll
        for (int q = 0; q < 4; ++q) { const int r = F.wave * 16 + 4 * i4 + q;
            const LAS float* p = (r < 64 ? Qs + r * 132 : Ks + (r - 64) * 132); x0[q] = p[F.lane]; x1[q] = p[F.lane + 64]; ssv[q] = x0[q] * x0[q] + x1[q] * x1[q]; }
        wave_sum4(ssv);
#pragma unroll
        for (int q = 0; q < 4; ++q) { const int r = F.wave * 16 + 4 * i4 + q; LAS float* p = (r < 64 ? Qs + r * 132 : Ks + (r - 64) * 132);
            float sc = rsqrtf(ssv[q] + EPS); if (r < 64) sc *= 0.08838834764831845f;
            p[F.lane] = x0[q] * sc; p[F.lane + 64] = x1[q] * sc; }
    }
    if (tid == 0) { float s = 0.f; for (int i = 0; i < 64; ++i) { s += gc[i]; gc[i] = s; eg[i] = __expf(s); } }
    for (int i = tid; i < 64 * 68; i += 512) At[i] = 0.f;
    __syncthreads();
    for (int tj = F.wave; tj < 20; tj += 8) {
        const int kind = tj >= 10 ? 1 : 0, idx = tj - 10 * kind;
        const int mt = idx >= 6 ? 3 : (idx >= 3 ? 2 : (idx >= 1 ? 1 : 0)), nt = idx - mt * (mt + 1) / 2;
        const int fr = F.lane & 15, fq = F.lane >> 4;
        const LAS float* ap = (kind ? Qs : Ks) + (16 * mt + fr) * 132 + 4 * fq; const LAS float* bp = Ks + (16 * nt + fr) * 132 + 4 * fq;
        f32x4 acc = (f32x4){0.f, 0.f, 0.f, 0.f};
#pragma unroll
        for (int sg = 0; sg < 8; ++sg) { const f32x4 a4 = *(const LAS f32x4*)(ap + 16 * sg), b4 = *(const LAS f32x4*)(bp + 16 * sg);
#pragma unroll
            for (int j = 0; j < 4; ++j) acc = __builtin_amdgcn_mfma_f32_16x16x4f32(a4[j], b4[j], acc, 0, 0, 0); }
        const int j = 16 * nt + fr; const float gj = gc[j];
#pragma unroll
        for (int r = 0; r < 4; ++r) { const int i = 16 * mt + 4 * fq + r; const float dec = j <= i ? __expf(gc[i] - gj) : 0.f;
            if (kind) At[i * 68 + j] = acc[r] * dec; else Mm[i * 68 + j] = j < i ? beta[i] * acc[r] * dec : 0.f; }
    }
    __syncthreads();
    unsigned char* cb = F.ws + WS_GW + (size_t)job * GDN_CH_BYTES;
    bf16* gW = (bf16*)cb; bf16* gQD = (bf16*)(cb + 16384); bf16* gKDT = (bf16*)(cb + 32768); bf16* gUT = (bf16*)(cb + 49152); bf16* gAT = (bf16*)(cb + 65536);
    float sol[64];
    if (tid < 256) {
        const int cidx = tid & 127; const bool isw = tid >= 128;
        const LAS float* src = (isw ? Ks : Vs) + cidx;
        const LAS float* MmL = (const LAS float*)lds_vbase(Mm); const LAS float* betaL = (const LAS float*)lds_vbase(beta); const LAS float* egL = (const LAS float*)lds_vbase(eg);
#pragma unroll
        for (int i = 0; i < 64; ++i) sol[i] = 0.f;
#pragma unroll
        for (int i = 0; i < 64; ++i) {
            float r = src[i * 132] * betaL[i] * (isw ? egL[i] : 1.0f), r1 = 0.f, r2 = 0.f, r3 = 0.f;
#pragma unroll
            for (int j4 = 0; j4 < (i + 3) / 4; ++j4) { const f32x4 mv = *(const LAS f32x4*)(MmL + i * 68 + 4 * j4);
                r -= mv[0] * sol[4 * j4]; r1 -= mv[1] * sol[4 * j4 + 1]; r2 -= mv[2] * sol[4 * j4 + 2]; r3 -= mv[3] * sol[4 * j4 + 3]; }
            r = (r + r1) + (r2 + r3);
            sol[i] = r;
            asm volatile("" : "+v"(sol[i]) :: "memory");
        }
    } else {
        const int t2 = tid - 256;
        const float gl = gc[63];
        for (int i = t2; i < 64 * 16; i += 256) { const int r = i >> 4, c8 = (i & 15) * 8; const float e = eg[r]; const LAS float* s = Qs + r * 132 + c8;
            u32x4 o; o.x = pk2(s[0] * e, s[1] * e); o.y = pk2(s[2] * e, s[3] * e); o.z = pk2(s[4] * e, s[5] * e); o.w = pk2(s[6] * e, s[7] * e); *(u32x4*)(gQD + r * 128 + c8) = o; }
        for (int i = t2; i < 128 * 8; i += 256) { const int dk = i & 127, i8 = (i >> 7) * 8; float v[8];
#pragma unroll
            for (int q = 0; q < 8; ++q) v[q] = Ks[(i8 + q) * 132 + dk] * __expf(gl - gc[i8 + q]);
            u32x4 o; o.x = pk2(v[0], v[1]); o.y = pk2(v[2], v[3]); o.z = pk2(v[4], v[5]); o.w = pk2(v[6], v[7]); *(u32x4*)(gKDT + dk * 64 + i8) = o; }
        for (int i = t2; i < 64 * 8; i += 256) { const int r = i >> 3, c8 = (i & 7) * 8; const LAS float* s = At + r * 68 + c8;
            u32x4 o; o.x = pk2(s[0], s[1]); o.y = pk2(s[2], s[3]); o.z = pk2(s[4], s[5]); o.w = pk2(s[6], s[7]); *(u32x4*)(gAT + r * 64 + c8) = o; }
        if (t2 == 0) WSP(float, WS_GL)[job] = __expf(gl);
    }
    __syncthreads();
    LAS bf16* Wl = (LAS bf16*)Qs;
    if (tid < 128) {
#pragma unroll
        for (int q = 0; q < 8; ++q) { u32x4 o; o.x = pk2(sol[8 * q], sol[8 * q + 1]); o.y = pk2(sol[8 * q + 2], sol[8 * q + 3]); o.z = pk2(sol[8 * q + 4], sol[8 * q + 5]); o.w = pk2(sol[8 * q + 6], sol[8 * q + 7]);
            *(u32x4*)(gUT + tid * 64 + 8 * q) = o; }
    } else if (tid < 256) {
#pragma unroll
        for (int i = 0; i < 64; ++i) Wl[i * 136 + (tid - 128)] = (bf16)f2bf(sol[i]);
    }
    __syncthreads();
    for (int i = tid; i < 64 * 16; i += 512) { const int r = i >> 4, c8 = (i & 15) * 8; *(u32x4*)(gW + r * 128 + c8) = *(const LAS u32x4*)(Wl + r * 136 + c8); }
    __syncthreads();
}

DEV void ssd_prep_job(Frame& F, int l, int job) {
    const int b = job >> 7, c = (job >> 1) & 63, g = job & 1, t0 = 128 * c;
    const float zf_ = opaque_zero();
    const bf16* p1 = WSP(bf16, WS_P1); const float* small = WSP(float, WS_SMALL);
    const float* cw = lin(F, I_SCW, l, 4 * 1536); const float* cbias = lin(F, I_SCB, l, 1536);
    bf16* SX = WSP(bf16, WS_SX); float* SDT = WSP(float, WS_SDT); float* SAC = WSP(float, WS_SAC); float* SST = WSP(float, WS_SST); float* SCD = WSP(float, WS_SCD);
    LAS bf16* BT = (LAS bf16*)F.lds;
    LAS bf16* XT = BT + 128 * 136;
    LAS float* dts = (LAS float*)(XT + 64 * 136);
    LAS float* acs = dts + 128 * 8;
    const int tid = F.tid;
    for (int i = tid; i < 1024; i += 512) { const int tl = i >> 3, hh = i & 7, h = 8 * g + hh; const size_t row = (size_t)(b * SEQ + t0 + tl);
        const float dt = softplusf_(small[row * SMW + S_DT + h] + lin(F, I_SDTB, l, 16)[h]);
        dts[i] = dt; acs[i] = dt * (-__expf(lin(F, I_SALOG, l, 16)[h])); }
    __syncthreads();
    if (tid < 8) { float s = 0.f; for (int tl = 0; tl < 128; ++tl) { s += acs[tl * 8 + tid]; acs[tl * 8 + tid] = s; } }
    __syncthreads();
    for (int i = tid; i < 1024; i += 512) { const int tl = i >> 3, hh = i & 7; const size_t row = (size_t)(b * SEQ + t0 + tl); SDT[row * 16 + 8 * g + hh] = dts[i]; SAC[row * 16 + 8 * g + hh] = acs[i]; }
    if (tid < 8) SCD[(size_t)(b * 64 + c) * 16 + 8 * g + tid] = __expf(acs[127 * 8 + tid]);
    {
        const int ch = tid & 255, half = tid >> 8; const int cc = 1024 + (ch < 128 ? g * 128 + ch : 256 + g * 128 + (ch - 128));
        const float w0 = cw[cc], w1 = cw[1536 + cc], w2 = cw[2 * 1536 + cc], w3 = cw[3 * 1536 + cc], bs = cbias[cc];
        const int col = C_CX + cc;
        for (int q = 0; q < 4; ++q) {
            const int ts = t0 + 64 * half + 16 * q; float xin[19];
#pragma unroll
            for (int i = 0; i < 19; ++i) { const int t = ts - 3 + i; xin[i] = t >= 0 ? bf2f(p1[(size_t)(b * SEQ + t) * P1W + col]) : 0.f; }
#pragma unroll
            for (int i = 0; i < 16; ++i) { const int tl = 64 * half + 16 * q + i; const size_t row = (size_t)(b * SEQ + t0 + tl);
                const float y = siluf_(w0 * xin[i] + w1 * xin[i + 1] + w2 * xin[i + 2] + w3 * xin[i + 3] + bs); const bf16 yb = (bf16)f2bf(y);
                SX[row * 1536 + cc] = yb; if (ch < 128) BT[ch * 136 + tl] = yb; }
        }
    }
    for (int hh = 0; hh < 8; ++hh) {
        const int h = 8 * g + hh;
        __syncthreads();
        {
            const int ch = tid & 63, tg = tid >> 6; const int cc = h * 64 + ch;
            const float w0 = cw[cc], w1 = cw[1536 + cc], w2 = cw[2 * 1536 + cc], w3 = cw[3 * 1536 + cc], bs = cbias[cc];
            const int col = C_CX + cc; const int ts = t0 + 16 * tg;
            float xin[19];
#pragma unroll
            for (int i = 0; i < 19; ++i) { const int t = ts - 3 + i; xin[i] = t >= 0 ? bf2f(p1[(size_t)(b * SEQ + t) * P1W + col]) : 0.f; }
            const float al = acs[127 * 8 + hh];
#pragma unroll
            for (int i = 0; i < 16; ++i) { const int tl = 16 * tg + i; const size_t row = (size_t)(b * SEQ + t0 + tl);
                const float y = siluf_(w0 * xin[i] + w1 * xin[i + 1] + w2 * xin[i + 2] + w3 * xin[i + 3] + bs); const bf16 yb = (bf16)f2bf(y);
                SX[row * 1536 + cc] = yb;
                XT[ch * 136 + tl] = (bf16)f2bf(bf2f(yb) * dts[tl * 8 + hh] * __expf(al - acs[tl * 8 + hh])); }
        }
        __syncthreads();
        {
            const int mt = F.wave & 3, nb = (F.wave >> 2) * 4;
            bf16x8 a[4];
#pragma unroll
            for (int ks = 0; ks < 4; ++ks) a[ks] = frag_l(XT, 136, 16 * mt, 32 * ks, F.lane);
            float* dst = SST + ((size_t)((b * 64 + c) * 16 + h) * 64) * 128;
#pragma unroll
            for (int q = 0; q < 4; ++q) { f32x4 acc = ZERO4;
#pragma unroll
                for (int ks = 0; ks < 4; ++ks) acc = mfma16(a[ks], frag_l(BT, 136, 16 * (nb + q), 32 * ks, F.lane), acc);
#pragma unroll
                for (int r = 0; r < 4; ++r) dst[(size_t)(16 * mt + 4 * (F.lane >> 4) + r) * 128 + 16 * (nb + q) + (F.lane & 15)] = acc[r]; }
        }
    }
    __syncthreads();
}

DEV void nsa_compress_job(Frame& F, int l, int job) {
    const int kv = job >> 4, bg = (job >> 2) & 3, rt = job & 3, b = bg >> 1, g = bg & 1, i0 = 128 * rt;
    const float zf_ = opaque_zero();
    const bf16* p1 = WSP(bf16, WS_P1); const bf16* Wt = WSP(bf16, kv ? WS_WCV : WS_WCK); const float* cst = WSP(float, WS_CONST) + kv * 128;
    const int col0 = (kv ? C_BVC : C_BKC) + g * 128;
    LAS bf16* As = (LAS bf16*)F.lds;
    LAS bf16* Bs = As + 128 * 72;
    LAS float* Cs = (LAS float*)(Bs + 128 * 72);
    const int tid = F.tid, wm = F.wave >> 1, wn = F.wave & 1;
    f32x4 acc[2][4];
#pragma unroll
    for (int i = 0; i < 2; ++i)
#pragma unroll
        for (int j = 0; j < 4; ++j) acc[i][j] = ZERO4;
    u32x4 ra[2], rb[2];
#define LOADK(ks_) do { _Pragma("unroll") for (int q = 0; q < 2; ++q) { const int ch = tid + 512 * q, r = ch >> 3, c8 = (ch & 7) * 8; \
            int t = 16 * (i0 + r) + ((ks_) >> 1); if (t > SEQ - 1) t = SEQ - 1;     \
            ra[q] = *(const u32x4*)(p1 + (size_t)(b * SEQ + t) * P1W + col0 + ((ks_) & 1) * 64 + c8); \
            rb[q] = *(const u32x4*)(Wt + (size_t)r * 4096 + 64 * (ks_) + c8); } } while (0)
    LOADK(0);
    for (int ks = 0; ks < 64; ++ks) {
        __syncthreads();
#pragma unroll
        for (int q = 0; q < 2; ++q) { const int ch = tid + 512 * q, r = ch >> 3, c8 = (ch & 7) * 8; *(LAS u32x4*)(As + r * 72 + c8) = ra[q]; *(LAS u32x4*)(Bs + r * 72 + c8) = rb[q]; }
        __syncthreads();
        if (ks + 1 < 64) LOADK(ks + 1);
#pragma unroll
        for (int k2 = 0; k2 < 2; ++k2) {
            bf16x8 a0 = frag_l(As, 72, 32 * wm, 32 * k2, F.lane), a1 = frag_l(As, 72, 32 * wm + 16, 32 * k2, F.lane);
#pragma unroll
            for (int j = 0; j < 4; ++j) { const bf16x8 bb = frag_l(Bs, 72, 64 * wn + 16 * j, 32 * k2, F.lane); acc[0][j] = mfma16(a0, bb, acc[0][j]); acc[1][j] = mfma16(a1, bb, acc[1][j]); }
        }
    }
    __syncthreads();
#pragma unroll
    for (int i = 0; i < 2; ++i)
#pragma unroll
        for (int j = 0; j < 4; ++j)
#pragma unroll
            for (int r = 0; r < 4; ++r) { const int col = 64 * wn + 16 * j + (F.lane & 15); Cs[(32 * wm + 16 * i + 4 * (F.lane >> 4) + r) * 132 + col] = acc[i][j][r] + cst[col]; }
    __syncthreads();
    if (kv == 0) {
        const float* kn = lin(F, I_NKN, l, 128); bf16* KC = WSP(bf16, WS_KCMP);
        const int r = tid >> 2, q = tid & 3; const LAS float* s = Cs + r * 132 + 32 * q; float ss = 0.f;
#pragma unroll
        for (int e = 0; e < 32; ++e) ss += s[e] * s[e];
        ss += shx<1>(ss); ss += shx<2>(ss);
        const float rs = rsqrtf(ss * (1.0f / 128.0f) + EPS);
        bf16* dst = KC + ((size_t)bg * 512 + i0 + r) * 128 + 32 * q;
#pragma unroll
        for (int e = 0; e < 32; e += 2) *(unsigned*)(dst + e) = pk2(s[e] * rs * kn[32 * q + e], s[e + 1] * rs * kn[32 * q + e + 1]);
    } else {
        bf16* VC = WSP(bf16, WS_VCMPT); const int e = tid & 127, q = tid >> 7;
#pragma unroll
        for (int i8 = 0; i8 < 4; ++i8) { const LAS float* s = Cs + (32 * q + 8 * i8) * 132 + e;
            u32x4 o; o.x = pk2(s[0], s[132]); o.y = pk2(s[264], s[396]); o.z = pk2(s[528], s[660]); o.w = pk2(s[792], s[924]);
            *(u32x4*)(VC + ((size_t)bg * 128 + e) * 512 + i0 + 32 * q + 8 * i8) = o; }
    }
    __syncthreads();
}
#undef LOADK

constexpr int AL_KT = 0, AL_VT = 17408, AL_KT1 = 35840, AL_UW = 53248, AL_TB = 54272, AL_SM = 60608, AL_PS = 61696, AL_IMP = 78336, AL_VT1 = 111104, AL_END = 129536;
static_assert(AL_KT1 + 17408 <= AL_UW && AL_UW + 128 <= AL_TB && AL_END <= MISC_OFF, "attention LDS map");
DEV int rel_bucket_dev(int n) {
    if (n < 16) return n;
    int k = 16;
    k += (n >= 21); k += (n >= 27); k += (n >= 35); k += (n >= 46); k += (n >= 59); k += (n >= 77); k += (n >= 99); k += (n >= 128);
    k += (n >= 166); k += (n >= 216); k += (n >= 280); k += (n >= 363); k += (n >= 470); k += (n >= 609); k += (n >= 790);
    return k;
}
DEV void attn_fill_bias(Frame& F, int g) {
    LAS float* tb = (LAS float*)(F.lds + AL_TB); const float* rt = F.p->in[I_REL];
    for (int i = F.tid; i < 2 * 792; i += 512) { const int hg = i / 792, d = i - hg * 792; tb[i] = rt[rel_bucket_dev(d) * 4 + 2 * g + hg] * 1.4426950408889634f; }
}
DEV void attn_load_tile(u32x4 (&rk)[2], u32x4 (&rv)[2], const bf16* ksrc, const bf16* vsrc, int vpitch, int tid) {
#pragma unroll
    for (int q = 0; q < 2; ++q) { const int ch = tid + 512 * q; rk[q] = *(const u32x4*)(ksrc + (size_t)ch * 8); rv[q] = *(const u32x4*)(vsrc + (size_t)(ch >> 3) * vpitch + (ch & 7) * 8); }
}
DEV void attn_store_tile(LAS unsigned char* lds, int buf, const u32x4 (&rk)[2], const u32x4 (&rv)[2], int tid) {
    LAS bf16* Kt = (LAS bf16*)(lds + (buf ? AL_KT1 : AL_KT)); LAS bf16* Vt = (LAS bf16*)(lds + (buf ? AL_VT1 : AL_VT));
#pragma unroll
    for (int q = 0; q < 2; ++q) { const int ch = tid + 512 * q; *(LAS u32x4*)(Kt + (ch >> 4) * 136 + (ch & 15) * 8) = rk[q]; *(LAS u32x4*)(Vt + (ch >> 3) * 72 + (ch & 7) * 8) = rv[q]; }
}
template <int MODE, int PATH = 0>
DEV unsigned attn_scores(LAS unsigned char* lds, int buf, const bf16x8 (&qf)[4], int lane, int n0, int tok, int hg, unsigned selbit, f32x4 (&s)[4]) {
    const float zf_ = opaque_zero();
    const LAS bf16* Kt = (const LAS bf16*)(lds + (buf ? AL_KT1 : AL_KT)); const LAS float* tb = (const LAS float*)(lds + AL_TB) + hg * 792;
#pragma unroll
    for (int nt = 0; nt < 4; ++nt) { s[nt] = ZERO4;
#pragma unroll
        for (int ks = 0; ks < 4; ++ks) s[nt] = mfma16(frag_l(Kt, 136, 16 * nt, 32 * ks, lane), qf[ks], s[nt]); }
    if (PATH == 1) {
        const float bf = tb[790]; const bool ok = selbit != 0u;
#pragma unroll
        for (int nt = 0; nt < 4; ++nt)
#pragma unroll
            for (int r = 0; r < 4; ++r) s[nt][r] = ok ? s[nt][r] + bf : -1e30f;
        return ok ? 0xffffu : 0u;
    }
    if (PATH == 2) {
        const bool ok = MODE == 2 ? true : (selbit != 0u);
        const LAS float* tp = tb + (tok - n0 - 4 * (lane >> 4));
#pragma unroll
        for (int nt = 0; nt < 4; ++nt)
#pragma unroll
            for (int r = 0; r < 4; ++r) s[nt][r] = ok ? s[nt][r] + tp[-16 * nt - r] : -1e30f;
        return ok ? 0xffffu : 0u;
    }
    unsigned vm = 0u;
#pragma unroll
    for (int nh = 0; nh < 2; ++nh) {
        float bv[8];
#pragma unroll
        for (int q = 0; q < 8; ++q) { const int nt = 2 * nh + (q >> 2), r = q & 3; const int n = n0 + 16 * nt + 4 * (lane >> 4) + r; const int dist = MODE == 0 ? tok - (16 * n + 31) : tok - n;
            int di = dist < 0 ? 0 : dist; di = di > 790 ? 790 : di; bv[q] = tb[di]; }
#pragma unroll
        for (int q = 0; q < 8; ++q) asm volatile("" : "+v"(bv[q]));
#pragma unroll
        for (int q = 0; q < 8; ++q) { const int nt = 2 * nh + (q >> 2), r = q & 3; const int n = n0 + 16 * nt + 4 * (lane >> 4) + r; int dist; bool ok;
            if (MODE == 0) { dist = tok - (16 * n + 31); ok = dist >= 0 && n < 511; }
            else if (MODE == 1) { dist = tok - n; ok = dist >= 0 && selbit != 0u; }
            else { dist = tok - n; ok = dist >= 0 && dist < 512; }
            s[nt][r] = ok ? s[nt][r] + bv[q] : -1e30f;
            vm |= (ok ? 1u : 0u) << (4 * nt + r); }
    }
    return vm;
}
DEV float fq_max(float v) {
    const auto a = __builtin_amdgcn_permlane16_swap(__builtin_bit_cast(unsigned, v), __builtin_bit_cast(unsigned, v), false, false);
    const float m = fmaxf(__builtin_bit_cast(float, a[0]), __builtin_bit_cast(float, a[1]));
    const auto b = __builtin_amdgcn_permlane32_swap(__builtin_bit_cast(unsigned, m), __builtin_bit_cast(unsigned, m), false, false);
    return fmaxf(__builtin_bit_cast(float, b[0]), __builtin_bit_cast(float, b[1]));
}
DEV float fq_sum(float v) {
    const auto a = __builtin_amdgcn_permlane16_swap(__builtin_bit_cast(unsigned, v), __builtin_bit_cast(unsigned, v), false, false);
    const float m = __builtin_bit_cast(float, a[0]) + __builtin_bit_cast(float, a[1]);
    const auto b = __builtin_amdgcn_permlane32_swap(__builtin_bit_cast(unsigned, m), __builtin_bit_cast(unsigned, m), false, false);
    return __builtin_bit_cast(float, b[0]) + __builtin_bit_cast(float, b[1]);
}
DEV float attn_online(const f32x4 (&s)[4], unsigned vm, float& m, float& l, f32x4 (&p)[4]) {
    float mx = fmaxf(fmaxf(fmaxf(s[0][0], s[0][1]), fmaxf(s[0][2], s[0][3])), fmaxf(fmaxf(s[1][0], s[1][1]), fmaxf(s[1][2], s[1][3])));
    mx = fmaxf(mx, fmaxf(fmaxf(fmaxf(s[2][0], s[2][1]), fmaxf(s[2][2], s[2][3])), fmaxf(fmaxf(s[3][0], s[3][1]), fmaxf(s[3][2], s[3][3]))));
    mx = fmaxf(mx, shx<16>(mx)); mx = fmaxf(mx, shx<32>(mx));
    const float mn = fmaxf(m, mx), sc = __builtin_amdgcn_exp2f(m - mn); float rs = 0.f;
#pragma unroll
    for (int nt = 0; nt < 4; ++nt)
#pragma unroll
        for (int r = 0; r < 4; ++r) { const float pv = ((vm >> (4 * nt + r)) & 1u) ? __builtin_amdgcn_exp2f(s[nt][r] - mn) : 0.f; p[nt][r] = pv; rs += pv; }
    rs += shx<16>(rs); rs += shx<32>(rs);
    l = l * sc + rs; m = mn;
    return sc;
}
DEV void attn_pv(LAS unsigned char* lds, int buf, int lane, const f32x4 (&p)[4], f32x4 (&o)[8]) {
    const LAS bf16* Vt = (const LAS bf16*)(lds + (buf ? AL_VT1 : AL_VT)) + (lane & 15) * 72 + 4 * (lane >> 4);
#pragma unroll
    for (int ks = 0; ks < 2; ++ks) {
        u32x4 pw; pw.x = pg8::cvt_pk_bf16(p[2 * ks][0], p[2 * ks][1]); pw.y = pg8::cvt_pk_bf16(p[2 * ks][2], p[2 * ks][3]); pw.z = pg8::cvt_pk_bf16(p[2 * ks + 1][0], p[2 * ks + 1][1]); pw.w = pg8::cvt_pk_bf16(p[2 * ks + 1][2], p[2 * ks + 1][3]);
        const bf16x8 pb = __builtin_bit_cast(bf16x8, pw);
#pragma unroll
        for (int dt = 0; dt < 8; ++dt) {
            const u32x2 v0 = *(const LAS u32x2*)(Vt + 16 * dt * 72 + 32 * ks), v1 = *(const LAS u32x2*)(Vt + 16 * dt * 72 + 32 * ks + 16);
            u32x4 vw; vw.x = v0.x; vw.y = v0.y; vw.z = v1.x; vw.w = v1.y;
            o[dt] = mfma16(__builtin_bit_cast(bf16x8, vw), pb, o[dt]); }
    }
}
DEV void attn_load_q(Frame& F, int bg, int t0, bf16x8 (&qf)[4]) {
    const bf16* QN = WSP(bf16, WS_QN); const int rho = F.lane & 15;
    const bf16* src = QN + ((size_t)(bg * SEQ + t0 + 8 * F.wave + (rho & 7)) * 2 + (rho >> 3)) * 128 + 8 * (F.lane >> 4);
#pragma unroll
    for (int ks = 0; ks < 4; ++ks) qf[ks] = *(const bf16x8*)(src + 32 * ks);
}

DEV void sel_step(Frame& F, const bf16* KS, const bf16* VS, int j, int jn, int jnn, int qt, int cb, const u32x4 (&st_k)[2], const u32x4 (&st_v)[2], u32x4 (&ld_k)[2], u32x4 (&ld_v)[2],
                  const bf16x8 (&qf)[4], const u32x4& smw, const unsigned (&wum)[4], int tok, int hg, float& m, float& l, f32x4 (&o)[8]) {
    const int lane = F.lane;
    if (jnn <= qt) attn_load_tile(ld_k, ld_v, KS + (size_t)jnn * 64 * 128, VS + (size_t)jnn * 128 * 64, 64, F.tid);
    const unsigned wsel = j < 32 ? wum[0] : (j < 64 ? wum[1] : (j < 96 ? wum[2] : wum[3]));
    if ((wsel >> (j & 31)) & 1u) {
        const unsigned w = j < 32 ? smw.x : (j < 64 ? smw.y : (j < 96 ? smw.z : smw.w)); const unsigned selbit = (w >> (j & 31)) & 1u;
        f32x4 s[4], p[4];
        const unsigned vm = (j <= qt - 14) ? attn_scores<1, 1>(F.lds, cb, qf, lane, 64 * j, tok, hg, selbit, s) : ((j >= qt - 11 && j < qt) ? attn_scores<1, 2>(F.lds, cb, qf, lane, 64 * j, tok, hg, selbit, s) : attn_scores<1, 0>(F.lds, cb, qf, lane, 64 * j, tok, hg, selbit, s));
        const float sc = attn_online(s, vm, m, l, p);
        if (__ballot(sc != 1.0f) != 0ull) {
#pragma unroll
            for (int dt = 0; dt < 8; ++dt) o[dt] = o[dt] * sc; }
        attn_pv(F.lds, cb, lane, p, o);
    }
    if (jn <= qt) attn_store_tile(F.lds, cb ^ 1, st_k, st_v, F.tid);
    __syncthreads();
}
DEV int sel_next(int j, int qt, const unsigned (&um)[4]) {
    int jn = j + 1;
    while (jn <= qt) { const unsigned w = jn < 32 ? um[0] : (jn < 64 ? um[1] : (jn < 96 ? um[2] : um[3])); if ((w >> (jn & 31)) & 1u) break; ++jn; }
    return jn;
}
DEV void nsa_job(Frame& F, int job) {
    const int bg = job >> 7, qt = job & 127, b = bg >> 1, g = bg & 1, t0 = 64 * qt, tid = F.tid, lane = F.lane, wave = F.wave;
    const float zf_ = opaque_zero();
    const int fq = lane >> 4, fr = lane & 15, hg = fr >> 3, tok = t0 + 8 * wave + (fr & 7);
    const float* small = WSP(float, WS_SMALL); const size_t row = (size_t)(b * SEQ + tok);
    LAS float* PS = (LAS float*)(F.lds + AL_PS) + wave * (8 * 65); LAS float* IMP = (LAS float*)(F.lds + AL_IMP);
    LAS unsigned* SM = (LAS unsigned*)(F.lds + AL_SM);
    LAS unsigned* UW = (LAS unsigned*)(F.lds + AL_UW);
    __syncthreads();
    attn_fill_bias(F, g);
    for (int i = tid; i < 64 * 128; i += 512) IMP[i] = 0.f;
    if (lane < 8) PS[lane * 65] = 0.f;
    bf16x8 qf[4]; attn_load_q(F, bg, t0, qf);
    f32x4 tot[8];
    u32x4 rk[2], rv[2];
    for (int dr_ = 0; dr_ < (DBG_NSA == 1 ? 2 : 1); ++dr_) {
        if (dr_ == 1) { WAVE_SYNC(); if (lane < 8) PS[lane * 65] = 0.f; WAVE_SYNC(); }
        const int ntiles = (4 * qt + 2) / 64 + 1;
        const bf16* KC = WSP(bf16, WS_KCMP) + (size_t)bg * 512 * 128; const bf16* VC = WSP(bf16, WS_VCMPT) + (size_t)bg * 128 * 512;
        float m = -1e30f, l = 0.f;
        attn_load_tile(rk, rv, KC, VC, 512, tid); attn_store_tile(F.lds, 0, rk, rv, tid); __syncthreads();
        for (int j = 0; j < ntiles; ++j) {
            if (j + 1 < ntiles) attn_load_tile(rk, rv, KC + (size_t)(j + 1) * 64 * 128, VC + (j + 1) * 64, 512, tid);
            f32x4 s[4], p[4];
            const unsigned vm = attn_scores<0>(F.lds, j & 1, qf, lane, 64 * j, tok, hg, 0u, s);
            (void)attn_online(s, vm, m, l, p);
            if (j + 1 < ntiles) attn_store_tile(F.lds, (j + 1) & 1, rk, rv, tid);
            __syncthreads();
        }
        const float il = l > 0.f ? 1.0f / l : 0.f;
        f32x4 o[8];
#pragma unroll
        for (int dt = 0; dt < 8; ++dt) o[dt] = ZERO4;
        attn_load_tile(rk, rv, KC, VC, 512, tid); attn_store_tile(F.lds, 0, rk, rv, tid); __syncthreads();
        for (int j = 0; j < ntiles; ++j) {
            if (j + 1 < ntiles) attn_load_tile(rk, rv, KC + (size_t)(j + 1) * 64 * 128, VC + (j + 1) * 64, 512, tid);
            f32x4 s[4], p[4];
            const unsigned vm = attn_scores<0>(F.lds, j & 1, qf, lane, 64 * j, tok, hg, 0u, s);
#pragma unroll
            for (int nt = 0; nt < 4; ++nt)
#pragma unroll
                for (int r = 0; r < 4; ++r) {
                    const float pv = ((vm >> (4 * nt + r)) & 1u) ? __builtin_amdgcn_exp2f(s[nt][r] - m) * il : 0.f; p[nt][r] = pv;
                    const float ps = pv + shx<8>(pv);
                    if (fr < 8) PS[fr * 65 + 1 + 16 * nt + 4 * fq + r] = ps;
                }
            WAVE_SYNC();
#pragma unroll
            for (int q = 0; q < 2; ++q) { const int idx = lane + 64 * q, tk = idx >> 4, bl = idx & 15; const LAS float* ps = PS + tk * 65 + 4 * bl;
                IMP[(8 * wave + tk) * 128 + 16 * j + bl] = ps[0] + 2.0f * ps[1] + 2.0f * ps[2] + 2.0f * ps[3] + ps[4]; }
            WAVE_SYNC();
            if (lane < 8) PS[lane * 65] = PS[lane * 65 + 64];
            WAVE_SYNC();
            attn_pv(F.lds, j & 1, lane, p, o);
            if (j + 1 < ntiles) attn_store_tile(F.lds, (j + 1) & 1, rk, rv, tid);
            __syncthreads();
        }
        const float gt = (DBG_NSAZ & 1) ? zf_ : sigmoidf_(small[row * SMW + S_BG + (2 * g + hg) * 3 + 0]);
#pragma unroll
        for (int dt = 0; dt < 8; ++dt) tot[dt] = o[dt] * gt;
    }
    unsigned wum[4] = {0u, 0u, 0u, 0u};
    for (int dr_ = 0; dr_ < (DBG_NSA == 4 ? 2 : 1); ++dr_) {
        const int cur = qt;
        for (int tk = 0; tk < 8; ++tk) {
            const LAS float* rowp = IMP + (8 * wave + tk) * 128;
            const int b0 = lane, b1 = lane + 64;
            const float s0 = b0 > cur ? -1e4f : ((b0 == 0 || b0 >= cur - 1) ? 1e4f : rowp[b0]);
            const float s1 = b1 > cur ? -1e4f : ((b1 == 0 || b1 >= cur - 1) ? 1e4f : rowp[b1]);
            unsigned k0 = __builtin_bit_cast(unsigned, s0), k1 = __builtin_bit_cast(unsigned, s1);
            k0 = (k0 & 0x80000000u) ? ~k0 : (k0 | 0x80000000u); k1 = (k1 & 0x80000000u) ? ~k1 : (k1 | 0x80000000u);
            unsigned prefix = 0u; int need = 16;
            for (int bit = 31; bit >= 0; --bit) {
                const unsigned cand = (prefix | (1u << bit)) >> bit;
                const int cnt = __builtin_popcountll(__ballot((k0 >> bit) == cand)) + __builtin_popcountll(__ballot((k1 >> bit) == cand));
                if (cnt >= need) prefix |= (1u << bit); else need -= cnt;
            }
            const unsigned long long e0 = __ballot(k0 == prefix), e1 = __ballot(k1 == prefix);
            const int r0 = (int)__builtin_amdgcn_mbcnt_hi((unsigned)(e0 >> 32), __builtin_amdgcn_mbcnt_lo((unsigned)e0, 0u));
            const int r1 = __builtin_popcountll(e0) + (int)__builtin_amdgcn_mbcnt_hi((unsigned)(e1 >> 32), __builtin_amdgcn_mbcnt_lo((unsigned)e1, 0u));
            const bool sel0 = k0 > prefix || (k0 == prefix && r0 < need), sel1 = k1 > prefix || (k1 == prefix && r1 < need);
            const unsigned long long m0 = __ballot(sel0), m1 = __ballot(sel1);
            const unsigned w0 = (unsigned)m0, w1 = (unsigned)(m0 >> 32), w2 = (unsigned)m1, w3 = (unsigned)(m1 >> 32);
            wum[0] |= w0; wum[1] |= w1; wum[2] |= w2; wum[3] |= w3;
            if (lane == 0) { SM[(8 * wave + tk) * 4 + 0] = w0; SM[(8 * wave + tk) * 4 + 1] = w1; SM[(8 * wave + tk) * 4 + 2] = w2; SM[(8 * wave + tk) * 4 + 3] = w3; }
        }
        if (lane == 0) { UW[wave * 4 + 0] = wum[0]; UW[wave * 4 + 1] = wum[1]; UW[wave * 4 + 2] = wum[2]; UW[wave * 4 + 3] = wum[3]; }
    }
    __syncthreads();
    const u32x4 smw = *(const LAS u32x4*)(SM + (8 * wave + (fr & 7)) * 4);
    unsigned um[4];
#pragma unroll
    for (int w = 0; w < 4; ++w) { unsigned v = 0u;
#pragma unroll
        for (int q = 0; q < 8; ++q) v |= UW[q * 4 + w];
        um[w] = __builtin_amdgcn_readfirstlane(v); }
    const bf16* KS = WSP(bf16, WS_KS) + (size_t)bg * SEQ * 128; const bf16* VS = WSP(bf16, WS_VST) + (size_t)bg * 128 * 8192;
    const bf16* KW = WSP(bf16, WS_KW) + (size_t)bg * SEQ * 128; const bf16* VW = WSP(bf16, WS_VWT) + (size_t)bg * 128 * 8192;
    for (int dr_ = 0; dr_ < (DBG_NSA == 2 ? 2 : 1); ++dr_) {
        float m = -1e30f, l = 0.f; f32x4 o[8];
#pragma unroll
        for (int dt = 0; dt < 8; ++dt) o[dt] = ZERO4;
        u32x4 rk2[2], rv2[2];
        int j = 0, jn = sel_next(0, qt, um), cb = 0;
        attn_load_tile(rk, rv, KS, VS, 64, tid); attn_store_tile(F.lds, 0, rk, rv, tid);
        if (jn <= qt) attn_load_tile(rk, rv, KS + (size_t)jn * 64 * 128, VS + (size_t)jn * 128 * 64, 64, tid);
        __syncthreads();
        while (j <= qt) {
            int jnn = jn <= qt ? sel_next(jn, qt, um) : jn;
            sel_step(F, KS, VS, j, jn, jnn, qt, cb, rk, rv, rk2, rv2, qf, smw, wum, tok, hg, m, l, o);
            cb ^= 1; j = jn; jn = jnn;
            if (j > qt) break;
            jnn = jn <= qt ? sel_next(jn, qt, um) : jn;
            sel_step(F, KS, VS, j, jn, jnn, qt, cb, rk2, rv2, rk, rv, qf, smw, wum, tok, hg, m, l, o);
            cb ^= 1; j = jn; jn = jnn;
        }
        const float gt = ((DBG_NSA == 2 && dr_ == 0) || (DBG_NSAZ & 2)) ? zf_ * l : sigmoidf_(small[row * SMW + S_BG + (2 * g + hg) * 3 + 1]) / l;
#pragma unroll
        for (int dt = 0; dt < 8; ++dt) tot[dt] = tot[dt] + o[dt] * gt;
    }
    for (int dr_ = 0; dr_ < (DBG_NSA == 3 ? 2 : 1); ++dr_) {
        float m = -1e30f, l = 0.f; f32x4 o[8];
#pragma unroll
        for (int dt = 0; dt < 8; ++dt) o[dt] = ZERO4;
        const int j0 = qt >= 8 ? qt - 8 : 0;
        attn_load_tile(rk, rv, KW + (size_t)j0 * 64 * 128, VW + (size_t)j0 * 128 * 64, 64, tid); attn_store_tile(F.lds, 0, rk, rv, tid); __syncthreads();
        for (int j = j0; j <= qt; ++j) {
            const int cb = (j - j0) & 1;
            if (j + 1 <= qt) attn_load_tile(rk, rv, KW + (size_t)(j + 1) * 64 * 128, VW + (size_t)(j + 1) * 128 * 64, 64, tid);
            f32x4 s[4], p[4];
            const unsigned vm = (j >= qt - 7 && j < qt) ? attn_scores<2, 2>(F.lds, cb, qf, lane, 64 * j, tok, hg, 0u, s) : attn_scores<2, 0>(F.lds, cb, qf, lane, 64 * j, tok, hg, 0u, s);
            const float sc = attn_online(s, vm, m, l, p);
#pragma unroll
            for (int dt = 0; dt < 8; ++dt) o[dt] = o[dt] * sc;
            attn_pv(F.lds, cb, lane, p, o);
            if (j + 1 <= qt) attn_store_tile(F.lds, cb ^ 1, rk, rv, tid);
            __syncthreads();
        }
        const float gt = ((DBG_NSA == 3 && dr_ == 0) || (DBG_NSAZ & 4)) ? zf_ * l : sigmoidf_(small[row * SMW + S_BG + (2 * g + hg) * 3 + 2]) / l;
#pragma unroll
        for (int dt = 0; dt < 8; ++dt) tot[dt] = tot[dt] + o[dt] * gt;
    }
    {
        bf16* YC = WSP(bf16, WS_YCAT);
#pragma unroll
        for (int dt = 0; dt < 8; ++dt) { const int cidx = (2 * g + hg) * 128 + 16 * dt + 4 * fq;
            f32x4 y = tot[dt]; if (DBG_ZERO & 2) y = ZERO4;
            u32x2 w; w.x = pk2(y[0], y[1]); w.y = pk2(y[2], y[3]); *(u32x2*)(YC + row * 2048 + 512 + cidx) = w; }
    }
    __syncthreads();
}

DEV void gdn_scan_job(Frame& F, int job) {
    const int bh = job >> 3, sl = job & 7, b = bh >> 2, h = bh & 3, lane = F.lane, wave = F.wave, fq = lane >> 4, fr = lane & 15;
    LAS bf16* St = (LAS bf16*)F.lds;
    LAS bf16* Vn = St + 16 * 136;
    const float* GL = WSP(float, WS_GL); float* GO = WSP(float, WS_GO);
    const float zf_ = opaque_zero();
    __syncthreads();
    for (int i = F.tid; i < 16 * 136 / 2; i += 512) ((LAS unsigned*)St)[i] = 0u;
    f32x4 S = ZERO4;
    const int mt = wave & 3;
    __syncthreads();
    const int o1 = (wave < 4 ? 0 : 8192) + (16 * mt + fr) * 128 + 8 * fq;
    const int oA = 32768 + (16 * mt + fr) * 64 + 8 * fq;
    const int oK = 16384 + (16 * wave + fr) * 64 + 8 * fq;
    const int oU = 24576 + (16 * sl + fr) * 64 + 16 * mt + 4 * fq;
    const bf16* rec = (const bf16*)(F.ws + WS_GW + (size_t)(bh * 128) * GDN_CH_BYTES);
    bf16x8 a1[4], aA[2], aK[2], n1[4], nA[2], nK[2]; u32x2 uu, nu; float gl, ngl;
#define GLOAD(A1, AA, AK, UU, G, c_) do { const bf16* r_ = rec + (size_t)(c_) * (GDN_CH_BYTES / 2); \
        _Pragma("unroll") for (int ks = 0; ks < 4; ++ks) A1[ks] = *(const bf16x8*)(r_ + o1 + 32 * ks); \
        AA[0] = *(const bf16x8*)(r_ + oA); AA[1] = *(const bf16x8*)(r_ + oA + 32); AK[0] = *(const bf16x8*)(r_ + oK); AK[1] = *(const bf16x8*)(r_ + oK + 32); \
        UU = *(const u32x2*)(r_ + oU); G = GL[bh * 128 + (c_)]; } while (0)
    GLOAD(a1, aA, aK, uu, gl, 0);
    for (int c = 0; c < 128; ++c) {
        const int cn = c + 1 < 128 ? c + 1 : c;
        GLOAD(n1, nA, nK, nu, ngl, cn);
        f32x4 d1 = ZERO4;
#pragma unroll
        for (int ks = 0; ks < 4; ++ks) d1 = mfma16(a1[ks], frag_l(St, 136, 0, 32 * ks, lane), d1);
        if (wave < 4) {
            const float v0 = bflo(uu.x) - d1[0], v1 = bfhi(uu.x) - d1[1], v2 = bflo(uu.y) - d1[2], v3 = bfhi(uu.y) - d1[3];
            u32x2 w; w.x = pk2(v0, v1); w.y = pk2(v2, v3);
            *(LAS u32x2*)(Vn + fr * 72 + 16 * mt + 4 * fq) = w;
        }
        LDS_WAIT(); __builtin_amdgcn_s_barrier(); CFENCE();
        const bf16x8 bv0 = frag_l(Vn, 72, 0, 0, lane), bv1 = frag_l(Vn, 72, 0, 32, lane);
        if (wave >= 4) {
            d1 = mfma16(aA[0], bv0, d1); d1 = mfma16(aA[1], bv1, d1);
#pragma unroll
            for (int r = 0; r < 4; ++r) GO[(size_t)(b * SEQ + 64 * c + 16 * mt + 4 * fq + r) * 512 + h * 128 + 16 * sl + fr] = d1[r];
        }
        f32x4 dk = ZERO4;
        dk = mfma16(aK[0], bv0, dk); dk = mfma16(aK[1], bv1, dk);
        S = S * gl + dk;
        { u32x2 w; w.x = pk2(S[0], S[1]); w.y = pk2(S[2], S[3]); *(LAS u32x2*)(St + fr * 136 + 16 * wave + 4 * fq) = w; }
        LDS_WAIT(); __builtin_amdgcn_s_barrier(); CFENCE();
#pragma unroll
        for (int ks = 0; ks < 4; ++ks) a1[ks] = n1[ks];
        aA[0] = nA[0]; aA[1] = nA[1]; aK[0] = nK[0]; aK[1] = nK[1]; uu = nu; gl = ngl;
    }
#undef GLOAD
    __syncthreads();
}

DEV void ssd_scan_part(Frame& F, int part, int nparts) {
    float* __restrict__ SST = WSP(float, WS_SST); const float* __restrict__ SCD = WSP(float, WS_SCD);
    constexpr int PER_B = 16 * 64 * 128;
    for (int e = part * 512 + F.tid; e < 2 * PER_B; e += nparts * 512) {
        const int b = e / PER_B, r = e - b * PER_B, h = r >> 13;
        float* p = SST + (size_t)(b * 64) * PER_B + r; const float* cdp = SCD + (b * 64) * 16 + h;
        float s = 0.f;
#pragma unroll
        for (int hb = 0; hb < 2; ++hb) {
            float v[32], cd[32];
#pragma unroll
            for (int c = 0; c < 32; ++c) { v[c] = p[(size_t)(32 * hb + c) * PER_B]; cd[c] = cdp[(32 * hb + c) * 16]; }
#pragma unroll
            for (int c = 0; c < 32; ++c) { p[(size_t)(32 * hb + c) * PER_B] = s; s = s * cd[c] + v[c]; }
        }
    }
}

DEV void gdn_final_rows(Frame& F, int l, int w0, int nw) {
    const float* GO = WSP(float, WS_GO); const bf16* p1 = WSP(bf16, WS_P1); bf16* YC = WSP(bf16, WS_YCAT); const float* gn = lin(F, I_GNORM, l, 128);
    const int lane = F.lane, dv0 = (lane & 15) * 8;
    float gv[8];
#pragma unroll
    for (int j = 0; j < 8; ++j) gv[j] = gn[dv0 + j];
    for (int row = w0; row < MTOK; row += nw) {
        const f32x4 a = *(const f32x4*)(GO + (size_t)row * 512 + lane * 8), bq = *(const f32x4*)(GO + (size_t)row * 512 + lane * 8 + 4);
        float ss = (a[0] * a[0] + a[1] * a[1]) + (a[2] * a[2] + a[3] * a[3]) + (bq[0] * bq[0] + bq[1] * bq[1]) + (bq[2] * bq[2] + bq[3] * bq[3]);
        ss = sum16(ss);
        const float rs = rsqrtf(ss * (1.0f / 128.0f) + EPS);
        const u32x4 zw = *(const u32x4*)(p1 + (size_t)row * P1W + C_AZ + lane * 8);
        const float z[8] = {bflo(zw.x), bfhi(zw.x), bflo(zw.y), bfhi(zw.y), bflo(zw.z), bfhi(zw.z), bflo(zw.w), bfhi(zw.w)};
        const float o[8] = {a[0], a[1], a[2], a[3], bq[0], bq[1], bq[2], bq[3]};
        float y[8];
#pragma unroll
        for (int j = 0; j < 8; ++j) y[j] = (DBG_ZERO & 1) ? opaque_zero() : o[j] * rs * gv[j] * siluf_(z[j]);
        u32x4 w; w.x = pk2(y[0], y[1]); w.y = pk2(y[2], y[3]); w.z = pk2(y[4], y[5]); w.w = pk2(y[6], y[7]);
        *(u32x4*)(YC + (size_t)row * 2048 + lane * 8) = w;
    }
}

DEV void ssd_out_job(Frame& F, int l, int job) {
    const int b = job >> 7, c = (job >> 1) & 63, g = job & 1, t0 = 128 * c, tid = F.tid, lane = F.lane, wave = F.wave, fq = lane >> 4, fr = lane & 15;
    const bf16* SX = WSP(bf16, WS_SX); const bf16* p1 = WSP(bf16, WS_P1); const float* SDT = WSP(float, WS_SDT); const float* SAC = WSP(float, WS_SAC); const float* SST = WSP(float, WS_SST);
    bf16* YC = WSP(bf16, WS_YCAT); float* RC = WSP(float, WS_SRC);
    const float zf_ = opaque_zero();
    LAS bf16* Cs = (LAS bf16*)F.lds;
    LAS bf16* Bs = Cs + 128 * 136;
    LAS bf16* XdT = Bs + 128 * 136;
    LAS bf16* SiT = XdT + 64 * 136;
    LAS bf16* Pw = SiT + 64 * 136;
    LAS float* acs = (LAS float*)(Pw + 8 * 16 * 136);
    __syncthreads();
    for (int i = tid; i < 2 * 128 * 16; i += 512) { const int v = i >> 11, r = (i >> 4) & 127, c8 = (i & 15) * 8;
        const u32x4 w = *(const u32x4*)(SX + (size_t)(b * SEQ + t0 + r) * 1536 + 1024 + (v ? 256 : 0) + g * 128 + c8);
        *(LAS u32x4*)((v ? Cs : Bs) + r * 136 + c8) = w; }
    for (int i = tid; i < 1024; i += 512) { const size_t row = (size_t)(b * SEQ + t0 + (i >> 3)); acs[i] = SAC[row * 16 + 8 * g + (i & 7)]; }
    __syncthreads();
    f32x4 cb[8];
    {
        bf16x8 ca[4];
#pragma unroll
        for (int ks = 0; ks < 4; ++ks) ca[ks] = frag_l(Cs, 136, 16 * wave, 32 * ks, lane);
#pragma unroll
        for (int nt = 0; nt < 8; ++nt) { cb[nt] = ZERO4;
#pragma unroll
            for (int ks = 0; ks < 4; ++ks) cb[nt] = mfma16(ca[ks], frag_l(Bs, 136, 16 * nt, 32 * ks, lane), cb[nt]); }
    }
    float ssq[4] = {0.f, 0.f, 0.f, 0.f};
    LAS bf16* pw = Pw + wave * 16 * 136;
    const float* dsk = lin(F, I_SD, l, 16);
    for (int hh = 0; hh < 8; ++hh) {
        const int h = 8 * g + hh;
        __syncthreads();
        for (int i = tid; i < 64 * 128; i += 512) { const int p = i & 63, s = i >> 6;
            XdT[p * 136 + s] = (bf16)f2bf(bf2f(SX[(size_t)(b * SEQ + t0 + s) * 1536 + h * 64 + p]) * SDT[(size_t)(b * SEQ + t0 + s) * 16 + h]); }
        { const float* sin = SST + ((size_t)((b * 64 + c) * 16 + h) * 64) * 128;
          for (int i = tid; i < 64 * 32; i += 512) { const int p = i >> 5, n4 = (i & 31) * 4; const f32x4 v = *(const f32x4*)(sin + p * 128 + n4);
              u32x2 w; w.x = pk2(v[0], v[1]); w.y = pk2(v[2], v[3]); *(LAS u32x2*)(SiT + p * 136 + n4) = w; } }
        float al[4];
#pragma unroll
        for (int r = 0; r < 4; ++r) al[r] = acs[(16 * wave + 4 * fq + r) * 8 + hh];
#pragma unroll
        for (int nt = 0; nt < 8; ++nt) { const int s = 16 * nt + fr; const float as = acs[s * 8 + hh];
#pragma unroll
            for (int r = 0; r < 4; ++r) { const int li = 16 * wave + 4 * fq + r; const float v = s <= li ? cb[nt][r] * __expf(al[r] - as) : 0.f; pw[(4 * fq + r) * 136 + s] = (bf16)f2bf(v); } }
        __syncthreads();
        f32x4 y[4], ys[4];
#pragma unroll
        for (int nt = 0; nt < 4; ++nt) { y[nt] = ZERO4; ys[nt] = ZERO4; }
#pragma unroll
        for (int ks = 0; ks < 4; ++ks) { const bf16x8 pa = frag_l(pw, 136, 0, 32 * ks, lane), cc = frag_l(Cs, 136, 16 * wave, 32 * ks, lane);
#pragma unroll
            for (int nt = 0; nt < 4; ++nt) { y[nt] = mfma16(pa, frag_l(XdT, 136, 16 * nt, 32 * ks, lane), y[nt]); ys[nt] = mfma16(cc, frag_l(SiT, 136, 16 * nt, 32 * ks, lane), ys[nt]); } }
        const float dh = dsk[h];
        unsigned short xv[4][4], zv[4][4];
#pragma unroll
        for (int r = 0; r < 4; ++r) { const size_t row = (size_t)(b * SEQ + t0 + 16 * wave + 4 * fq + r);
#pragma unroll
            for (int nt = 0; nt < 4; ++nt) { xv[r][nt] = SX[row * 1536 + h * 64 + 16 * nt + fr]; zv[r][nt] = p1[row * P1W + C_CZ + h * 64 + 16 * nt + fr]; } }
        CFENCE();
#pragma unroll
        for (int r = 0; r < 4; ++r) { const size_t row = (size_t)(b * SEQ + t0 + 16 * wave + 4 * fq + r); const float ea = __expf(al[r]);
#pragma unroll
            for (int nt = 0; nt < 4; ++nt) { const int p = 16 * nt + fr;
                const float xs = bf2f(xv[r][nt]); const float z = bf2f(zv[r][nt]);
                const float v = (DBG_ZERO & 4) ? zf_ : (y[nt][r] + ea * ys[nt][r] + xs * dh) * siluf_(z);
                ssq[r] += v * v; YC[row * 2048 + 1024 + h * 64 + p] = (bf16)f2bf(v); } }
    }
#pragma unroll
    for (int r = 0; r < 4; ++r) { const float s = sum16(ssq[r]); if (fr == 0) RC[(size_t)(b * SEQ + t0 + 16 * wave + 4 * fq + r) * 2 + g] = rsqrtf(s * (1.0f / 512.0f) + EPS); }
    __syncthreads();
}

constexpr int NPH = 12;
#ifndef CPU_EMU
DEV unsigned long long launder64(unsigned long long v) {
    unsigned lo = __builtin_amdgcn_readfirstlane((unsigned)v), hi = __builtin_amdgcn_readfirstlane((unsigned)(v >> 32));
    asm volatile("" : "+s"(lo), "+s"(hi));
    return ((unsigned long long)hi << 32) | lo;
}
DEV bool phase_begin(Frame& F, const Params& prm, int wave0) {
    F.ws = (unsigned char*)launder64((unsigned long long)prm.ws);
    F.p = (KParams)launder64((unsigned long long)__builtin_amdgcn_kernarg_segment_ptr());
    unsigned z = 0u; asm volatile("" : "+v"(z)); const int ln = (int)__builtin_amdgcn_mbcnt_hi(~0u, __builtin_amdgcn_mbcnt_lo(~0u, z));
    int wv = wave0; asm volatile("" : "+s"(wv)); F.wave = wv; F.lane = ln; F.tid = wv * 64 + ln;
    int bi = __builtin_amdgcn_readfirstlane(blockIdx.x); asm volatile("" : "+s"(bi)); F.bid = bi;
    int gg = __builtin_amdgcn_readfirstlane(gridDim.x); asm volatile("" : "+s"(gg)); F.G = gg;
    unsigned la = __builtin_amdgcn_readfirstlane((unsigned)(size_t)F.lds); asm volatile("" : "+s"(la)); F.lds = (LAS unsigned char*)(size_t)la;
    return true;
}
DEV void job_begin(Frame& F) { int t = F.tid; asm volatile("" : "+v"(t)); F.tid = t; F.lane = t & 63; }
__global__ void __launch_bounds__(512, 2) hybrid_fwd(Params prm) {
    extern __shared__ __attribute__((aligned(16))) unsigned char lds_raw[];
    Frame F;
    F.lds = (LAS unsigned char*)lds_raw; F.tid = threadIdx.x; F.lane = F.tid & 63; F.wave = __builtin_amdgcn_readfirstlane(F.tid >> 6);
    const int wave0 = F.wave;
    F.G = gridDim.x; F.bid = blockIdx.x; F.p = (KParams)__builtin_amdgcn_kernarg_segment_ptr(); F.ws = prm.ws;
    volatile LAS unsigned* MISC = (volatile LAS unsigned*)(F.lds + MISC_OFF);
    if (F.tid < 64) MISC[F.tid] = 0u;
    __syncthreads();
    unsigned* ctl = (unsigned*)(F.ws + WS_CTL);
    XcdBarrier bar; bar.bar = ctl + CW_BAR; bar.x = 0; bar.st = nullptr;
    if (prm.use_bar) bar = xcd_barrier_post(ctl + CW_BAR, MISC + 8);
    const int lo = prm.lo, hi = prm.hi;
    for (int l = 0; l < DEPTH; ++l) {
#define IN(k) (lo <= l * NPH + (k) && l * NPH + (k) < hi && phase_begin(F, prm, wave0))
#define REP_BEGIN(k) for (int rep_ = 0; rep_ < ((DBG_REP == (k)) ? 2 : 1); ++rep_) {
#define REP_END(k) if (DBG_REP == (k) && rep_ == 0) { XcdBarrier bb_ = bar; bb_.bar = (unsigned*)launder64((unsigned long long)bar.bar); xcd_barrier(bb_); } }
#define SEAM(k) do { if (l * NPH + (k) + 1 < hi && prm.use_bar) { XcdBarrier bb_ = bar; bb_.bar = (unsigned*)launder64((unsigned long long)bar.bar); { unsigned x_ = __builtin_amdgcn_readfirstlane(bar.x); asm volatile("" : "+s"(x_)); bb_.x = x_; } xcd_barrier(bb_); } } while (0)
#define RSB(i) (WSP(unsigned long long, WS_CTL) + CW_RS / 2 + (size_t)(3 * l + (i)) * MTOK)
#define XB WSP(bf16, WS_XB)
#define ACT WSP(bf16, WS_ACT)
        if (IN(0)) { REP_BEGIN(0) phase_convert(F, l); REP_END(0) SEAM(0); }
        if (IN(1)) { REP_BEGIN(1) pg8::Gemm g{XB, WSP(bf16, WS_WUP1), MTOK, NUP, DM, DM, DM}; pg8::StaticOrder S; S.init(MTOK, NUP, F.G, F.bid);
            pg8::EpiSwiGLU E{ACT, RSB(0)}; pg8::gemm_phase<pg8::EpiSwiGLU, pg8::StaticOrder>(F.lds, F.tid, g, S, E); REP_END(1) SEAM(1); }
        if (IN(2)) { pg8::Gemm g{ACT, WSP(bf16, WS_WDN1), MTOK, DM, DFF, DFF, DFF}; pg8::StaticOrder S; S.init(MTOK, DM, F.G, F.bid);
            pg8::EpiResidual E{prm.out, XB, RSB(1), 0.5f}; pg8::gemm_phase<pg8::EpiResidual, pg8::StaticOrder>(F.lds, F.tid, g, S, E); SEAM(2); }
        if (IN(3)) { REP_BEGIN(3) pg8::Gemm g{XB, WSP(bf16, WS_WIN), MTOK, NINP, DM, DM, DM}; pg8::StaticOrder S; S.init(MTOK, NINP, F.G, F.bid);
            pg8::EpiWin E{WSP(bf16, WS_P1), WSP(float, WS_SMALL), WSP(bf16, WS_GATE), RSB(1)}; pg8::gemm_phase<pg8::EpiWin, pg8::StaticOrder>(F.lds, F.tid, g, S, E); REP_END(3) SEAM(3); }
        if (IN(4)) {
            REP_BEGIN(4)
            {
                unsigned* ctr = WSP(unsigned, WS_CTL) + CW_WQ + 64 * (8 + l * 2 + rep_);
                LAS unsigned* jslot = (LAS unsigned*)(F.lds + MISC_OFF + 128);
                for (;;) {
                    __syncthreads();
                    if (F.tid == 0) *jslot = __hip_atomic_fetch_add(ctr, 1u, __ATOMIC_RELAXED, __HIP_MEMORY_SCOPE_AGENT);
                    __syncthreads();
                    const int j = (int)*jslot;
                    if (j >= 32 + 1024 + 256 + 512) break;
                    job_begin(F);
                    if (j < 32) nsa_compress_job(F, l, j);
                    else if (j < 32 + 256) ssd_prep_job(F, l, j - 32);
                    else if (j < 32 + 256 + 1024) gdn_prep_job(F, l, j - 32 - 256);
                    else nsa_prep_job(F, l, j - 32 - 256 - 1024);
                }
            }
            REP_END(4)
            SEAM(4);
        }
        if (IN(5)) {
            REP_BEGIN(5)
            if (F.bid < 64) gdn_scan_job(F, (F.bid & 7) * 8 + (F.bid >> 3));
            else if (rep_ == 0) ssd_scan_part(F, F.bid - 64, F.G - 64);
            {
                unsigned* ctr = WSP(unsigned, WS_CTL) + CW_WQ + 64 * (16 + (l * 2 + rep_) * 8);
                LAS unsigned* jslot = (LAS unsigned*)(F.lds + MISC_OFF + 128);
                const unsigned myq = xb_xcc_id() & 7u;
                for (;;) {
                    __syncthreads();
                    if (F.tid == 0) {
                        unsigned got = 0xffffffffu;
                        for (unsigned t = 0; t < 8u && got == 0xffffffffu; ++t) { const unsigned q = (myq + t) & 7u;
                            if (__hip_atomic_load(ctr + 64 * q, __ATOMIC_RELAXED, __HIP_MEMORY_SCOPE_AGENT) >= 64u) continue;
                            const unsigned k = __hip_atomic_fetch_add(ctr + 64 * q, 1u, __ATOMIC_RELAXED, __HIP_MEMORY_SCOPE_AGENT);
                            if (k < 64u) got = (q >> 1) * 128u + (127u - (2u * k + (q & 1u))); }
                        *jslot = got;
                    }
                    __syncthreads();
                    const unsigned j = *jslot;
                    if (j == 0xffffffffu) break;
                    job_begin(F);
                    nsa_job(F, (int)j);
                }
            }
            REP_END(5)
            SEAM(5);
        }
        if (IN(7)) {
            REP_BEGIN(7)
            for (int j = F.bid; j < 256; j += F.G) { job_begin(F); ssd_out_job(F, l, j); }
            job_begin(F);
            gdn_final_rows(F, l, F.bid * 8 + F.wave, F.G * 8);
            REP_END(7)
            SEAM(7);
        }
        if (IN(8)) { REP_BEGIN(8) pg8::Gemm g{WSP(bf16, WS_YCAT), WSP(bf16, WS_WPM), MTOK, DM, 512, DM, DM}; pg8::SegOrder S; S.init(MTOK, DM, F.G, F.bid, 512);
            pg8::EpiMergeSeg E{WSP(bf16, WS_MERGED), WSP(bf16, WS_GATE), WSP(float, WS_SRC)}; pg8::gemm_phase<pg8::EpiMergeSeg, pg8::SegOrder>(F.lds, F.tid, g, S, E); REP_END(8) SEAM(8); }
        if (IN(9)) { pg8::Gemm g{WSP(bf16, WS_MERGED), WSP(bf16, WS_WO), MTOK, DM, DM, DM, DM}; pg8::StaticOrder S; S.init(MTOK, DM, F.G, F.bid);
            pg8::EpiResidual E{prm.out, XB, RSB(2), 1.0f}; pg8::gemm_phase<pg8::EpiResidual, pg8::StaticOrder>(F.lds, F.tid, g, S, E); SEAM(9); }
        if (IN(10)) { pg8::Gemm g{XB, WSP(bf16, WS_WUP2), MTOK, NUP, DM, DM, DM}; pg8::StaticOrder S; S.init(MTOK, NUP, F.G, F.bid);
            pg8::EpiSwiGLU E{ACT, RSB(2)}; pg8::gemm_phase<pg8::EpiSwiGLU, pg8::StaticOrder>(F.lds, F.tid, g, S, E); SEAM(10); }
        if (IN(11)) { pg8::Gemm g{ACT, WSP(bf16, WS_WDN2), MTOK, DM, DFF, DFF, DFF}; pg8::StaticOrder S; S.init(MTOK, DM, F.G, F.bid);
            pg8::EpiResidual E{prm.out, XB, RSB(3), 0.5f}; pg8::gemm_phase<pg8::EpiResidual, pg8::StaticOrder>(F.lds, F.tid, g, S, E); SEAM(11); }
#undef IN
#undef SEAM
#undef REP_BEGIN
#undef REP_END
#undef RSB
#undef XB
#undef ACT
    }
}

#ifndef DBG_DUMP
#define DBG_DUMP 0
#endif
#ifndef DBG_STOP
#define DBG_STOP 48
#endif
__global__ void dbg_dump_bf16(const unsigned short* src, size_t n, float* out, size_t nout) {
    for (size_t i = (size_t)blockIdx.x * blockDim.x + threadIdx.x; i < nout; i += (size_t)gridDim.x * blockDim.x) { float s = 0.f; for (size_t k = i; k < n; k += nout) s += __builtin_bit_cast(float, (unsigned)src[k] << 16); out[i] = s; }
}
__global__ void dbg_dump_f32(const float* src, size_t n, float* out, size_t nout) {
    for (size_t i = (size_t)blockIdx.x * blockDim.x + threadIdx.x; i < nout; i += (size_t)gridDim.x * blockDim.x) { float s = 0.f; for (size_t k = i; k < n; k += nout) s += src[k]; out[i] = s; }
}
#ifndef N_LAUNCH_MODE
#define N_LAUNCH_MODE 0
#endif
extern "C" void kernel_launch(void* const* d_in, const int* in_sizes, int n_in, void* d_out, int out_size, void* d_ws, size_t ws_size, hipStream_t stream) {
    static int grid = 0;
    if (grid == 0) {
        if (n_in != 30 || out_size != MTOK * DM || ws_size < WS_END) { fprintf(stderr, "kernel_launch: unexpected shapes (n_in %d out %d ws %zu, need %zu)\n", n_in, out_size, ws_size, (size_t)WS_END); grid = -1; return; }
        int dev = 0, cus = 0, per_cu = 0;
        if (hipGetDevice(&dev) != hipSuccess || hipDeviceGetAttribute(&cus, hipDeviceAttributeMultiprocessorCount, dev) != hipSuccess) { grid = -1; return; }
        if (hipFuncSetAttribute((const void*)hybrid_fwd, hipFuncAttributeMaxDynamicSharedMemorySize, LDS_BYTES) != hipSuccess) { fprintf(stderr, "kernel_launch: hipFuncSetAttribute failed\n"); grid = -1; return; }
        if (hipOccupancyMaxActiveBlocksPerMultiprocessor(&per_cu, (const void*)hybrid_fwd, 512, LDS_BYTES) != hipSuccess || per_cu < 1) { fprintf(stderr, "kernel_launch: occupancy query says %d\n", per_cu); }
        (void)hipGetLastError();
        grid = cus;
    }
    if (grid < 0) return;
    (void)hipMemsetAsync((char*)d_ws + WS_CTL, 0, CTL_BYTES, stream);
    Params p{};
    for (int i = 0; i < 30; ++i) p.in[i] = (const float*)d_in[i];
    p.out = (float*)d_out; p.ws = (unsigned char*)d_ws; p.pad = 0;
    if (N_LAUNCH_MODE == 0) { p.lo = 0; p.hi = DEPTH * NPH; p.use_bar = 1; hipLaunchKernelGGL(hybrid_fwd, dim3(grid), dim3(512), LDS_BYTES, stream, p); }
    else { for (int ph = 0; ph < (DBG_DUMP ? DBG_STOP : DEPTH * NPH); ++ph) { p.lo = ph; p.hi = ph + 1; p.use_bar = 0; hipLaunchKernelGGL(hybrid_fwd, dim3(grid), dim3(512), LDS_BYTES, stream, p); } }
    if (DBG_DUMP) {
        const size_t nout = (size_t)MTOK * DM; char* w = (char*)d_ws;
        if (DBG_DUMP == 1) hipLaunchKernelGGL(dbg_dump_bf16, dim3(2048), dim3(256), 0, stream, (const unsigned short*)(w + WS_P1), (size_t)MTOK * P1W, (float*)d_out, nout);
        if (DBG_DUMP == 2) hipLaunchKernelGGL(dbg_dump_f32, dim3(2048), dim3(256), 0, stream, (const float*)(w + WS_SMALL), (size_t)MTOK * SMW, (float*)d_out, nout);
        if (DBG_DUMP == 3) hipLaunchKernelGGL(dbg_dump_bf16, dim3(2048), dim3(256), 0, stream, (const unsigned short*)(w + WS_GW), (size_t)1024 * GDN_CH_BYTES / 2, (float*)d_out, nout);
        if (DBG_DUMP == 4) hipLaunchKernelGGL(dbg_dump_f32, dim3(2048), dim3(256), 0, stream, (const float*)(w + WS_SST), (size_t)2 * 64 * 16 * 64 * 128, (float*)d_out, nout);
        if (DBG_DUMP == 5) hipLaunchKernelGGL(dbg_dump_f32, dim3(2048), dim3(256), 0, stream, (const float*)(w + WS_GO), (size_t)MTOK * 512, (float*)d_out, nout);
        if (DBG_DUMP == 6) hipLaunchKernelGGL(dbg_dump_bf16, dim3(2048), dim3(256), 0, stream, (const unsigned short*)(w + WS_YCAT), (size_t)MTOK * 2048, (float*)d_out, nout);
        if (DBG_DUMP == 7) hipLaunchKernelGGL(dbg_dump_bf16, dim3(2048), dim3(256), 0, stream, (const unsigned short*)(w + WS_MERGED), (size_t)MTOK * 2048, (float*)d_out, nout);
        if (DBG_DUMP == 8) hipLaunchKernelGGL(dbg_dump_bf16, dim3(2048), dim3(256), 0, stream, (const unsigned short*)(w + WS_SX), (size_t)MTOK * 1536, (float*)d_out, nout);
        if (DBG_DUMP == 9) hipLaunchKernelGGL(dbg_dump_bf16, dim3(2048), dim3(256), 0, stream, (const unsigned short*)(w + WS_GATE), (size_t)MTOK * 6144, (float*)d_out, nout);
        if (DBG_DUMP == 11) hipLaunchKernelGGL(dbg_dump_f32, dim3(2048), dim3(256), 0, stream, (const float*)(w + WS_SRC), (size_t)MTOK * 2, (float*)d_out, nout);
        if (DBG_DUMP == 12) hipLaunchKernelGGL(dbg_dump_bf16, dim3(2048), dim3(256), 0, stream, (const unsigned short*)(w + WS_WPM), (size_t)DM * DM, (float*)d_out, nout);
        if (DBG_DUMP == 13) hipLaunchKernelGGL(dbg_dump_f32, dim3(2048), dim3(256), 0, stream, (const float*)(w + WS_MTMP), (size_t)MTOK * DM, (float*)d_out, nout);
        if (DBG_DUMP == 15) hipLaunchKernelGGL(dbg_dump_bf16, dim3(2048), dim3(256), 0, stream, (const unsigned short*)(w + WS_ACT), (size_t)MTOK * DFF, (float*)d_out, nout);
        if (DBG_DUMP == 16) hipLaunchKernelGGL(dbg_dump_bf16, dim3(2048), dim3(256), 0, stream, (const unsigned short*)(w + WS_XB), (size_t)MTOK * DM, (float*)d_out, nout);
        if (DBG_DUMP == 17) hipLaunchKernelGGL(dbg_dump_bf16, dim3(2048), dim3(256), 0, stream, (const unsigned short*)(w + WS_WIN), (size_t)NINP * DM, (float*)d_out, nout);
        if (DBG_DUMP == 18) hipLaunchKernelGGL(dbg_dump_f32, dim3(2048), dim3(256), 0, stream, (const float*)(w + WS_CTL) + CW_RS, (size_t)NRS * MTOK, (float*)d_out, nout);
        if (DBG_DUMP == 10) hipLaunchKernelGGL(dbg_dump_f32, dim3(2048), dim3(256), 0, stream, (const float*)(w + WS_YB), (size_t)MTOK * 512, (float*)d_out, nout);
    }
}
#endif
```

```cpp
#include <hip/hip_runtime.h>
#include <cstdio>
#include <cstdint>

#ifndef CPU_EMU
#define DEV __device__ __forceinline__
#define LAS __attribute__((address_space(3)))
#define VM_WAIT() asm volatile("s_waitcnt vmcnt(0)" ::: "memory")
#define LDS_WAIT() asm volatile("s_waitcnt lgkmcnt(0)" ::: "memory")
#define CFENCE() asm volatile("" ::: "memory")
#define WAVE_SYNC() do { asm volatile("" ::: "memory"); __builtin_amdgcn_wave_barrier(); asm volatile("" ::: "memory"); } while (0)
#endif

#define DBG_DUMP 0
#define DBG_NSAZ 0
#define DBG_NSA 0
#define DBG_REP (-1)
#define DBG_STOP 48
#define DBG_TMASK 0
#define DBG_TAMP 8
#define DBG_AJOB 0
#define DBG_TEPI 0
#ifndef DBG_ZERO
#define DBG_ZERO 0
#endif
typedef unsigned short bf16;
typedef short bf16x8 __attribute__((ext_vector_type(8)));
typedef float f32x4 __attribute__((ext_vector_type(4)));
typedef float f32x2 __attribute__((ext_vector_type(2)));
typedef unsigned u32x4 __attribute__((ext_vector_type(4)));
typedef unsigned u32x2 __attribute__((ext_vector_type(2)));

constexpr int BATCH = 2, SEQ = 8192, DM = 2048, DEPTH = 4, DFF = 5504, NUP = 2 * DFF;
constexpr int MTOK = BATCH * SEQ;
constexpr int NIN = 12836, NINP = 13056;
constexpr int P1W = 6656;
constexpr int SM0 = 6656;
constexpr int GT0 = 6912;
constexpr float EPS = 1e-6f;
constexpr int C_AQ = 0, C_AK = 512, C_AV = 1024, C_AZ = 1536, C_BQ = 2048, C_BKC = 2560, C_BVC = 2816, C_BKS = 3072, C_BVS = 3328, C_BKW = 3584, C_BVW = 3840, C_CZ = 4096, C_CX = 5120;
constexpr int S_AA = 0, S_AB = 4, S_BG = 8, S_DT = 20, SMW = 64;

constexpr size_t MiB = 1u << 20;
constexpr size_t WS_CTL = 0, CTL_BYTES = 2 * MiB;
constexpr size_t WS_WUP1 = 2 * MiB;
constexpr size_t WS_WDN1 = WS_WUP1 + (size_t)NUP * DM * 2;
constexpr size_t WS_WIN = WS_WDN1 + (size_t)DM * DFF * 2;
constexpr size_t WS_WPM = WS_WIN + (size_t)NINP * DM * 2;
constexpr size_t WS_WO = WS_WPM + (size_t)DM * DM * 2;
constexpr size_t WS_WUP2 = WS_WO + (size_t)DM * DM * 2;
constexpr size_t WS_WDN2 = WS_WUP2 + (size_t)NUP * DM * 2;
constexpr size_t WS_WCK = WS_WDN2 + (size_t)DM * DFF * 2;
constexpr size_t WS_WCV = WS_WCK + 128 * 4096 * 2;
constexpr size_t WS_CONST = WS_WCV + 128 * 4096 * 2;
constexpr size_t WS_WEND = WS_CONST + 4096;
static_assert(WS_WEND <= 212 * MiB, "weights region");
constexpr size_t WS_XB = 212 * MiB;
constexpr size_t WS_P1 = 276 * MiB;
constexpr size_t WS_ACT = WS_P1;
constexpr size_t WS_GATE = 484 * MiB;
constexpr size_t WS_SMALL = 676 * MiB;
constexpr size_t WS_MERGED = 680 * MiB;
constexpr size_t WS_YCAT = 744 * MiB;
constexpr size_t WS_GW = 808 * MiB;
constexpr size_t GDN_CH_BYTES = 73728;
constexpr size_t WS_GL = 880 * MiB;
constexpr size_t WS_GO = 881 * MiB;
constexpr size_t WS_SX = 913 * MiB;
constexpr size_t WS_SDT = 961 * MiB;
constexpr size_t WS_SAC = 962 * MiB;
constexpr size_t WS_SST = 963 * MiB;
constexpr size_t WS_SCD = 1027 * MiB;
constexpr size_t WS_SRC = 1028 * MiB;
constexpr size_t WS_QN = 1029 * MiB;
constexpr size_t WS_KS = 1045 * MiB;
constexpr size_t WS_KW = 1053 * MiB;
constexpr size_t WS_VST = 1061 * MiB;
constexpr size_t WS_VWT = 1069 * MiB;
constexpr size_t WS_KCMP = 1077 * MiB;
constexpr size_t WS_VCMPT = 1078 * MiB;
constexpr size_t WS_SELM = 1079 * MiB;
constexpr size_t WS_YB = 1080 * MiB;
constexpr size_t WS_MTMP = 1112 * MiB;
constexpr size_t WS_END = 1240 * MiB;
static_assert(WS_P1 + (size_t)MTOK * P1W * 2 <= WS_GATE && WS_GATE + (size_t)MTOK * 6144 * 2 <= WS_SMALL && WS_SMALL + (size_t)MTOK * SMW * 4 <= WS_MERGED && WS_MERGED + (size_t)MTOK * DM * 2 <= WS_YCAT && WS_YCAT + (size_t)MTOK * 2048 * 2 <= WS_GW, "ws map 1");
static_assert(WS_GW + 1024 * GDN_CH_BYTES <= WS_GL && WS_GO + (size_t)MTOK * 512 * 4 <= WS_SX && WS_SX + (size_t)MTOK * 1536 * 2 <= WS_SDT && WS_SDT + (size_t)MTOK * 16 * 4 <= WS_SAC && WS_SAC + (size_t)MTOK * 16 * 4 <= WS_SST && WS_SST + (size_t)2 * 64 * 16 * 64 * 128 * 4 <= WS_SCD, "ws map 2");
static_assert(WS_SRC + (size_t)MTOK * 2 * 4 <= WS_QN && WS_QN + (size_t)4 * SEQ * 256 * 2 <= WS_KS && WS_KS + (size_t)4 * SEQ * 128 * 2 <= WS_KW && WS_KW + (size_t)4 * SEQ * 128 * 2 <= WS_VST && WS_VST + (size_t)4 * SEQ * 128 * 2 <= WS_VWT && WS_VWT + (size_t)4 * SEQ * 128 * 2 <= WS_KCMP, "ws map 3");
static_assert(WS_KCMP + 4 * 512 * 128 * 2 <= WS_VCMPT && WS_VCMPT + 4 * 512 * 128 * 2 <= WS_SELM && WS_SELM + (size_t)4 * SEQ * 16 <= WS_YB && WS_YB + (size_t)MTOK * 512 * 4 <= WS_END && WS_XB + (size_t)MTOK * DM * 2 <= WS_P1 && (size_t)MTOK * DFF * 2 <= (size_t)MTOK * P1W * 2, "ws map 4");

constexpr int CW_BAR = 1024;
constexpr int CW_RS = 16384;
constexpr int NRS = 13;
constexpr int CW_WQ = 8192;
static_assert(CW_RS * 4 + NRS * MTOK * 8 <= (int)CTL_BYTES, "ctl");

constexpr int RING_BYTES = 131072;
constexpr int MISC_OFF = RING_BYTES + 12288;
constexpr int LDS_BYTES = 147456;

DEV unsigned f2bf(float f) { unsigned u = __builtin_bit_cast(unsigned, f); return (u + 0x7fffu + ((u >> 16) & 1u)) >> 16; }
DEV float bf2f(unsigned b) { return __builtin_bit_cast(float, (b & 0xffffu) << 16); }
DEV unsigned pk2(float lo, float hi) { return f2bf(lo) | (f2bf(hi) << 16); }
DEV float bflo(unsigned w) { return __builtin_bit_cast(float, w << 16); }
DEV float bfhi(unsigned w) { return __builtin_bit_cast(float, w & 0xffff0000u); }
DEV float sigmoidf_(float x) { return 1.0f / (1.0f + __expf(-x)); }
DEV float siluf_(float x) { return x / (1.0f + __expf(-x)); }
DEV float softplusf_(float x) {
    const float e = __expf(-fabsf(x)), u = 1.0f + e, d = u - 1.0f;
    const float lp = d == 0.f ? e : __logf(u) * (e / d);
    return fmaxf(x, 0.f) + lp;
}
#ifndef CPU_EMU
template <int M, class T> DEV T shx(T v) {
    static_assert(sizeof(T) == 4, "shx: 32-bit values");
    const int iv = __builtin_bit_cast(int, v);
    if constexpr (M < 32) return __builtin_bit_cast(T, __builtin_amdgcn_ds_swizzle(iv, 0x1f | (M << 10)));
    else { unsigned z = 0u; asm volatile("" : "+v"(z)); const unsigned ln = __builtin_amdgcn_mbcnt_hi(~0u, __builtin_amdgcn_mbcnt_lo(~0u, z));
        return __builtin_bit_cast(T, __builtin_amdgcn_ds_bpermute((int)((ln ^ 32u) << 2), iv)); }
}
#endif
DEV float wave_sum(float v) { v += shx<1>(v); v += shx<2>(v); v += shx<4>(v); v += shx<8>(v); v += shx<16>(v); v += shx<32>(v); return v; }
DEV void wave_sum4(float (&v)[4]) {
#pragma unroll
    for (int q = 0; q < 4; ++q) v[q] += shx<1>(v[q]);
#pragma unroll
    for (int q = 0; q < 4; ++q) v[q] += shx<2>(v[q]);
#pragma unroll
    for (int q = 0; q < 4; ++q) v[q] += shx<4>(v[q]);
#pragma unroll
    for (int q = 0; q < 4; ++q) v[q] += shx<8>(v[q]);
#pragma unroll
    for (int q = 0; q < 4; ++q) v[q] += shx<16>(v[q]);
#pragma unroll
    for (int q = 0; q < 4; ++q) v[q] += shx<32>(v[q]);
}
DEV float sum16(float v) { v += shx<1>(v); v += shx<2>(v); v += shx<4>(v); v += shx<8>(v); return v; }
DEV float max16(float v) { v = fmaxf(v, shx<1>(v)); v = fmaxf(v, shx<2>(v)); v = fmaxf(v, shx<4>(v)); v = fmaxf(v, shx<8>(v)); return v; }
#ifndef CPU_EMU
DEV float opaque_zero() { float z = 0.f; asm volatile("" : "+v"(z)); return z; }
#endif
#define ZERO4 ((f32x4){zf_, zf_, zf_, zf_})
DEV f32x4 mfma16(bf16x8 a, bf16x8 b, f32x4 c) { return __builtin_amdgcn_mfma_f32_16x16x32_bf16(a, b, c, 0, 0, 0); }
DEV bf16x8 frag_g(const bf16* base, int pitch, int row0, int k0, int lane) { return *(const bf16x8*)(base + (size_t)(row0 + (lane & 15)) * pitch + k0 + 8 * (lane >> 4)); }
DEV bf16x8 frag_l(const LAS bf16* base, int pitch, int row0, int k0, int lane) { return *(const LAS bf16x8*)(base + (row0 + (lane & 15)) * pitch + k0 + 8 * (lane >> 4)); }
#ifndef CPU_EMU
DEV const LAS void* lds_vbase(const LAS void* p) { unsigned a = (unsigned)(size_t)p; asm volatile("" : "+v"(a)); return (const LAS void*)(size_t)a; }
#endif

struct Params {
    const float* in[30];
    float* out;
    unsigned char* ws;
    int lo, hi;
    int use_bar, pad;
};
enum { I_X = 0, I_REL, I_GF1, I_WUP1, I_WDN1, I_GMIX, I_WIN, I_GCONV, I_GALOG, I_GDTB, I_GNORM, I_NQN, I_NKN, I_NPEK, I_NPEV, I_NWCK, I_NWCV,
       I_SCW, I_SCB, I_SDTB, I_SALOG, I_SD, I_SNORM, I_PA, I_PB, I_PC, I_WO, I_GF2, I_WUP2, I_WDN2 };

#define XB_TMO      128
#define XB_XCNT(j)  (256  + 64 * (j))
#define XB_XSUB(j)  (1280 + 64 * (j))
#define XB_XGEN(j)  (2304 + 64 * (j))
#define XB_TOP      3328
#define XB_TOPGEN   3392
#define XCD_BAR_WORDS 3456
#define XB_SPIN_CAP (1u << 22)
#ifndef CPU_EMU
DEV unsigned xb_ld(unsigned* p)              { return __hip_atomic_load(p, __ATOMIC_RELAXED, __HIP_MEMORY_SCOPE_AGENT); }
DEV unsigned xb_add(unsigned* p, unsigned v) { return __hip_atomic_fetch_add(p, v, __ATOMIC_RELAXED, __HIP_MEMORY_SCOPE_AGENT); }
DEV unsigned xb_xcc_id() { return (unsigned)__builtin_amdgcn_s_getreg((3 << 11) | 20) & 0xFu; }
#define XB_SPIN(cond, bar) do { unsigned _sp = 0; while (cond) { __builtin_amdgcn_s_sleep(1); \
    if ((++_sp & 255u) == 0u) { if (xb_ld(&(bar)[XB_TMO])) break; if (_sp > XB_SPIN_CAP) { atomicAdd(&(bar)[XB_TMO], 1u); break; } } } } while (0)
struct XcdBarrier { unsigned* bar; unsigned x; volatile LAS unsigned* st; };
DEV XcdBarrier xcd_barrier_post(unsigned* bar, volatile LAS unsigned* st) {
    XcdBarrier b; b.bar = bar; b.x = xb_xcc_id(); b.st = st;
    if (threadIdx.x == 0) (void)xb_add(&bar[XB_XCNT(b.x)], 1u);
    return b;
}
DEV void xcd_barrier_complete(unsigned* bar, unsigned x, unsigned& nloc, unsigned& nx) {
    const unsigned G = gridDim.x * gridDim.y * gridDim.z;
    unsigned sum, cnt, mine, sp = 0u;
    for (;;) {
        sum = 0u; cnt = 0u; mine = 0u;
#pragma unroll
        for (unsigned j = 0; j < 16; ++j) { const unsigned c = xb_ld(&bar[XB_XCNT(j)]); sum += c; cnt += (c > 0u) ? 1u : 0u; mine = (j == x) ? c : mine; }
        if (sum == G) break;
        __builtin_amdgcn_s_sleep(1);
        if ((++sp & 255u) == 0u) { if (xb_ld(&bar[XB_TMO])) break; if (sp > XB_SPIN_CAP) { atomicAdd(&bar[XB_TMO], 1u); break; } }
    }
    nloc = mine > 0u ? mine : 1u; nx = cnt > 0u ? cnt : 1u;
}
DEV void xcd_barrier(const XcdBarrier& b) {
    asm volatile("s_waitcnt vmcnt(0)" ::: "memory");
    __syncthreads();
    if (threadIdx.x == 0) {
        unsigned* bar = b.bar;
        __builtin_amdgcn_s_waitcnt(0);
        unsigned nloc = b.st[0], nx = b.st[1];
        if (nloc == 0u) { xcd_barrier_complete(bar, b.x, nloc, nx); b.st[0] = nloc; b.st[1] = nx; }
        const unsigned old = xb_add(&bar[XB_XSUB(b.x)], 1u);
        const unsigned gen = old / nloc;
        if (old + 1u == (gen + 1u) * nloc) {
            __builtin_amdgcn_fence(__ATOMIC_RELEASE, "agent");
            asm volatile("s_waitcnt vmcnt(0)" ::: "memory");
            const unsigned og = xb_add(&bar[XB_TOP], 1u);
            const unsigned tg = og / nx;
            if (og + 1u == (tg + 1u) * nx) xb_add(&bar[XB_TOPGEN], 1u);
            else XB_SPIN(xb_ld(&bar[XB_TOPGEN]) == tg, bar);
            __builtin_amdgcn_fence(__ATOMIC_ACQUIRE, "agent");
            xb_add(&bar[XB_XGEN(b.x)], 1u);
            asm volatile("s_waitcnt vmcnt(0)" ::: "memory");
        } else {
            XB_SPIN(xb_ld(&bar[XB_XGEN(b.x)]) == gen, bar);
            __builtin_amdgcn_fence(__ATOMIC_ACQUIRE, "agent");
            asm volatile("s_waitcnt vmcnt(0)" ::: "memory");
        }
    }
    __syncthreads();
}
#endif

namespace pg8 {
constexpr int BM = 256, BK = 64, HALF = 128, HTB = HALF * BK * 2, STAGE_BYTES = 8 * HTB, NXCD = 8, WGM = 8;
__host__ __device__ __forceinline__ int lds_byte(int r, int c) { const int st = (r >> 4) * 2 + (c >> 5), rr = r & 15, cc = c & 31, ob = rr * 64 + cc * 2; return st * 1024 + (ob ^ (((ob >> 9) & 1) << 5)); }
__host__ __device__ __forceinline__ void stage_rc(int b, int& R, int& C) { const int st = b / 1024, sb = b % 1024, swz = sb ^ (((sb >> 9) & 1) << 5); R = (st >> 1) * 16 + swz / 64; C = (st & 1) * 32 + (swz % 64) / 2; }
__host__ __device__ __forceinline__ int perm32(int rho) { const int n = rho >> 4, i = rho & 15; return 8 * (i >> 2) + 4 * n + (i & 3); }
struct Unit { int pm, pn, koff, seg; };
struct Gemm { const bf16* A; const bf16* Bt; int M, N, K, lda, ldb; };
struct StaticOrder {
    int nM, nN, nwg, G, c;
    __host__ __device__ void init(int M, int N, int G_, int c_) { nM = M / BM; nN = N / BM; nwg = nM * nN; G = G_; c = c_; }
    __host__ __device__ bool next(int i, Unit& u) const {
        const long L = (long)i * G + c; if (L >= nwg) return false;
        int wgid = (int)L; { const int q = nwg / NXCD, r = nwg % NXCD, xcd = wgid % NXCD, off = wgid / NXCD; wgid = (xcd < r ? xcd * (q + 1) : r * (q + 1) + (xcd - r) * q) + off; }
        const int nig = WGM * nN, gid = wgid / nig, fm = gid * WGM, gsz = (nM - fm) < WGM ? (nM - fm) : WGM;
        u.pm = fm + ((wgid % nig) % gsz); u.pn = (wgid % nig) / gsz; u.koff = 0; u.seg = 0; return true;
    }
};
struct SegOrder {
    StaticOrder S; int kseg;
    __host__ __device__ void init(int M, int N, int G_, int c_, int kseg_) { S.init(M, N, G_, c_); kseg = kseg_; }
    __host__ __device__ bool next(int i, Unit& u) const { if (!S.next(i >> 2, u)) return false; u.seg = i & 3; u.koff = u.seg * kseg; return true; }
};
#ifndef CPU_EMU
DEV unsigned cvt_pk_bf16(float lo, float hi) { unsigned r; asm volatile("s_nop 1\n\tv_cvt_pk_bf16_f32 %0, %1, %2" : "=v"(r) : "v"(lo), "v"(hi)); return r; }
#endif
DEV unsigned long long rss_fix(float ss) { return (unsigned long long)(ss * 16777216.0f + 0.5f); }
DEV float rss_val(unsigned long long v) { return (float)v * (1.0f / 16777216.0f); }

struct EpiSwiGLU {
    static constexpr bool PERM = true, SEGACC = false;
    bf16* act; const unsigned long long* rss;
    DEV void operator()(const f32x4 (&acc)[2][2][4][2], const Unit& u, int wr, int wc, int fr, int fq) const {
        const int row0 = u.pm * BM + wr * 64 + fr, col0 = u.pn * HALF + wc * 32 + 8 * fq;
        unsigned long long rv[8];
#pragma unroll
        for (int i = 0; i < 8; ++i) rv[i] = rss[row0 + (i >> 2) * HALF + (i & 3) * 16];
        CFENCE();
#pragma unroll
        for (int ai = 0; ai < 2; ++ai)
#pragma unroll
            for (int m = 0; m < 4; ++m) {
                const int row = row0 + ai * HALF + m * 16;
                const float rs = rsqrtf(rss_val(rv[ai * 4 + m]) * (1.0f / DM) + EPS);
                float o[8];
#pragma unroll
                for (int n = 0; n < 2; ++n)
#pragma unroll
                    for (int j = 0; j < 4; ++j) { const float a = acc[ai][0][m][n][j] * rs, b = acc[ai][1][m][n][j] * rs; o[4 * n + j] = a * b * __builtin_amdgcn_rcpf(1.0f + __expf(-a)); }
                u32x4 w; w.x = cvt_pk_bf16(o[0], o[1]); w.y = cvt_pk_bf16(o[2], o[3]); w.z = cvt_pk_bf16(o[4], o[5]); w.w = cvt_pk_bf16(o[6], o[7]);
                *(u32x4*)(act + (size_t)row * DFF + col0) = w;
            }
    }
};
struct EpiResidual {
    static constexpr bool PERM = true, SEGACC = false;
    float* x; bf16* xb; unsigned long long* rss_out; float alpha;
    DEV void operator()(const f32x4 (&acc)[2][2][4][2], const Unit& u, int wr, int wc, int fr, int fq) const {
        const int row0 = u.pm * BM + wr * 64 + fr, col0 = u.pn * BM + wc * 32 + 8 * fq;
#pragma unroll
        for (int aim = 0; aim < 4; ++aim) {
            const int ai = aim >> 1, m0 = (aim & 1) * 2;
            f32x4 xv[2][2][2];
#pragma unroll
            for (int mm = 0; mm < 2; ++mm)
#pragma unroll
                for (int bj = 0; bj < 2; ++bj) { const float* xp = x + (size_t)(row0 + ai * HALF + (m0 + mm) * 16) * DM + col0 + bj * HALF; xv[mm][bj][0] = *(const f32x4*)xp; xv[mm][bj][1] = *(const f32x4*)(xp + 4); }
            CFENCE();
#pragma unroll
            for (int mm = 0; mm < 2; ++mm) {
                const int m = m0 + mm, row = row0 + ai * HALF + m * 16; float ss = 0.f;
#pragma unroll
                for (int bj = 0; bj < 2; ++bj) {
                    float* xp = x + (size_t)row * DM + col0 + bj * HALF;
                    const f32x4 x0 = xv[mm][bj][0] + acc[ai][bj][m][0] * alpha, x1 = xv[mm][bj][1] + acc[ai][bj][m][1] * alpha;
                    *(f32x4*)xp = x0; *(f32x4*)(xp + 4) = x1;
                    ss += (x0[0] * x0[0] + x0[1] * x0[1]) + (x0[2] * x0[2] + x0[3] * x0[3]) + (x1[0] * x1[0] + x1[1] * x1[1]) + (x1[2] * x1[2] + x1[3] * x1[3]);
                    u32x4 w; w.x = cvt_pk_bf16(x0[0], x0[1]); w.y = cvt_pk_bf16(x0[2], x0[3]); w.z = cvt_pk_bf16(x1[0], x1[1]); w.w = cvt_pk_bf16(x1[2], x1[3]);
                    *(u32x4*)(xb + (size_t)row * DM + col0 + bj * HALF) = w;
                }
                ss += shx<16>(ss); ss += shx<32>(ss);
                if (fq == 0) atomicAdd(rss_out + row, rss_fix(ss));
            }
            CFENCE();
        }
    }
};
struct EpiWin {
    static constexpr bool PERM = true, SEGACC = false;
    bf16* p1; float* small; bf16* gate; const unsigned long long* rss;
    DEV void operator()(const f32x4 (&acc)[2][2][4][2], const Unit& u, int wr, int wc, int fr, int fq) const {
        const int row0 = u.pm * BM + wr * 64 + fr, cl0 = wc * 32 + 8 * fq;
        unsigned long long rv[8];
#pragma unroll
        for (int i = 0; i < 8; ++i) rv[i] = rss[row0 + (i >> 2) * HALF + (i & 3) * 16];
        CFENCE();
#pragma unroll
        for (int ai = 0; ai < 2; ++ai)
#pragma unroll
            for (int m = 0; m < 4; ++m) {
                const int row = row0 + ai * HALF + m * 16;
                const float rs = rsqrtf(rss_val(rv[ai * 4 + m]) * (1.0f / DM) + EPS);
#pragma unroll
                for (int bj = 0; bj < 2; ++bj) {
                    f32x4 v0 = acc[ai][bj][m][0] * rs, v1 = acc[ai][bj][m][1] * rs;
                    const int cl = cl0 + bj * HALF;
                    if (u.pn < 26) {
                        u32x4 w; w.x = cvt_pk_bf16(v0[0], v0[1]); w.y = cvt_pk_bf16(v0[2], v0[3]); w.z = cvt_pk_bf16(v1[0], v1[1]); w.w = cvt_pk_bf16(v1[2], v1[3]);
                        *(u32x4*)(p1 + (size_t)row * P1W + u.pn * BM + cl) = w;
                    } else if (u.pn == 26) {
                        if (cl < SMW) { float* sp = small + (size_t)row * SMW + cl; *(f32x4*)sp = v0; *(f32x4*)(sp + 4) = v1; }
                    } else {
#pragma unroll
                        for (int j = 0; j < 4; ++j) { v0[j] = fminf(__builtin_amdgcn_rcpf(1.0f + __expf(-v0[j])), 1.0f); v1[j] = fminf(__builtin_amdgcn_rcpf(1.0f + __expf(-v1[j])), 1.0f); }
                        u32x4 w; w.x = cvt_pk_bf16(v0[0], v0[1]); w.y = cvt_pk_bf16(v0[2], v0[3]); w.z = cvt_pk_bf16(v1[0], v1[1]); w.w = cvt_pk_bf16(v1[2], v1[3]);
                        *(u32x4*)(gate + (size_t)row * 6144 + (u.pn - 27) * BM + cl) = w;
                    }
                }
            }
    }
};
struct EpiMergeSeg {
    static constexpr bool PERM = true, SEGACC = true;
    bf16* merged; const bf16* gate; const float* rc;
    DEV void seg(f32x4 (&acc)[2][2][4][2], const Unit& u, int wr, int wc, int fr, int fq) const {
        const int row0 = u.pm * BM + wr * 64 + fr, col0 = u.pn * BM + wc * 32 + 8 * fq, sg = u.seg;
        f32x2 rcv[8];
#pragma unroll
        for (int i = 0; i < 8; ++i) rcv[i] = *(const f32x2*)(rc + (size_t)(row0 + (i >> 2) * HALF + (i & 3) * 16) * 2);
        const int offa = sg == 0 ? 0 : (sg == 1 ? DM : 2 * DM), offb = sg == 0 ? DM : 2 * DM;
#pragma unroll
        for (int aim = 0; aim < 4; ++aim) {
            const int ai = aim >> 1, m0 = (aim & 1) * 2;
            u32x4 wa[2][2], wb[2][2];
            if (sg != 2) {
#pragma unroll
                for (int mm = 0; mm < 2; ++mm)
#pragma unroll
                    for (int bj = 0; bj < 2; ++bj) { const bf16* gp = gate + (size_t)(row0 + ai * HALF + (m0 + mm) * 16) * 6144 + col0 + bj * HALF; wa[mm][bj] = *(const u32x4*)(gp + offa); wb[mm][bj] = *(const u32x4*)(gp + offb); }
            }
            CFENCE();
#pragma unroll
            for (int mm = 0; mm < 2; ++mm) {
                const int m = m0 + mm, row = row0 + ai * HALF + m * 16;
                const float r0 = rcv[ai * 4 + m][0], r1 = rcv[ai * 4 + m][1];
#pragma unroll
                for (int bj = 0; bj < 2; ++bj) {
                    float f[8];
                    if (sg == 2) { const float q = fmaxf(r0, 1e-20f) / fmaxf(r1, 1e-20f);
#pragma unroll
                        for (int j = 0; j < 8; ++j) f[j] = q; }
                    else {
                        const u32x4 a4 = wa[mm][bj], b4 = wb[mm][bj];
                        const float na[8] = {bflo(a4.x), bfhi(a4.x), bflo(a4.y), bfhi(a4.y), bflo(a4.z), bfhi(a4.z), bflo(a4.w), bfhi(a4.w)};
                        const float nb[8] = {bflo(b4.x), bfhi(b4.x), bflo(b4.y), bfhi(b4.y), bflo(b4.z), bfhi(b4.z), bflo(b4.w), bfhi(b4.w)};
#pragma unroll
                        for (int j = 0; j < 8; ++j) {
                            if (sg == 0) f[j] = fmaxf(na[j], 1e-20f) * __builtin_amdgcn_rcpf(fmaxf(nb[j], 1e-20f));
                            else if (sg == 1) f[j] = fmaxf(na[j], 1e-20f) * __builtin_amdgcn_rcpf(fmaxf(nb[j] * r0, 1e-20f));
                            else f[j] = fmaxf(na[j] * r1, 1e-20f); }
                    }
                    f32x4 v0 = acc[ai][bj][m][0], v1 = acc[ai][bj][m][1];
#pragma unroll
                    for (int j = 0; j < 4; ++j) { v0[j] *= f[j]; v1[j] *= f[4 + j]; }
                    if (sg < 3) { acc[ai][bj][m][0] = v0; acc[ai][bj][m][1] = v1; }
                    else { u32x4 o; o.x = cvt_pk_bf16(v0[0], v0[1]); o.y = cvt_pk_bf16(v0[2], v0[3]); o.z = cvt_pk_bf16(v1[0], v1[1]); o.w = cvt_pk_bf16(v1[2], v1[3]);
                        *(u32x4*)(merged + (size_t)row * DM + col0 + bj * HALF) = o; }
                }
            }
            CFENCE();
        }
    }
};

#ifndef CPU_EMU
template <class Epi, class Sched>
DEV void gemm_phase(LAS unsigned char* lds, const int tid, const Gemm g, const Sched& S, const Epi& E) {
    const int wid = __builtin_amdgcn_readfirstlane(tid >> 6), lane = tid & 63, wr = wid >> 2, wc = wid & 3, fr = lane & 15, fq = lane >> 4;
    const int K = g.K, nt = K / BK;
    const float zf_ = opaque_zero();
    unsigned voffA[2], voffB[2];
#pragma unroll
    for (int i = 0; i < 2; ++i) { int R, C; stage_rc(tid * 16 + i * 8192, R, C); const int Rb = Epi::PERM ? ((R & ~31) + perm32(R & 31)) : R;
        voffA[i] = (unsigned)(R * g.lda + C) * 2u; voffB[i] = (unsigned)(Rb * g.ldb + C) * 2u; }
    const size_t kstep = (size_t)(BK * 2);
    const size_t hA = (size_t)HALF * g.lda * 2, hB = (size_t)HALF * g.ldb * 2;
    const size_t tA = 2 * hA, tB = 2 * hB;
    const unsigned ldsw = (unsigned)wid * 1024u;
    const int aoff = lds_byte(wr * 64 + fr, fq * 8), boff = lds_byte(wc * 32 + fr, fq * 8);
#define PG8_SA(b, h) (((b) * 2 + (h)) * HTB)
#define PG8_SB(b, h) ((4 + (b) * 2 + (h)) * HTB)
#define PG8_STAGE(bufoff, gbase, voff) do { _Pragma("unroll") for (int _i = 0; _i < 2; ++_i) \
        __builtin_amdgcn_global_load_lds((const unsigned*)((const char*)(gbase) + (voff)[_i]), (LAS unsigned*)(lds + (bufoff) + ldsw + _i * 8192), 16, 0, 0); } while (0)
#define PG8_LDA(dst, b, h) do { _Pragma("unroll") for (int m = 0; m < 4; ++m) _Pragma("unroll") for (int k = 0; k < 2; ++k) dst[m][k] = *(const LAS bf16x8*)(lds + PG8_SA(b, h) + aoff + m * 2048 + k * 1024); } while (0)
#define PG8_LDB(dst, b, h) do { _Pragma("unroll") for (int n = 0; n < 2; ++n) _Pragma("unroll") for (int k = 0; k < 2; ++k) dst[n][k] = *(const LAS bf16x8*)(lds + PG8_SB(b, h) + boff + n * 2048 + k * 1024); } while (0)
#define PG8_MMA(ai, bj, At, Bt) do { __builtin_amdgcn_s_setprio(1); _Pragma("unroll") for (int m = 0; m < 4; ++m) _Pragma("unroll") for (int n = 0; n < 2; ++n) _Pragma("unroll") for (int k = 0; k < 2; ++k) \
        acc[ai][bj][m][n] = __builtin_amdgcn_mfma_f32_16x16x32_bf16(Bt[n][k], At[m][k], acc[ai][bj][m][n], 0, 0, 0); __builtin_amdgcn_s_setprio(0); } while (0)
#define PG8_WAIT_V(n) asm volatile("s_waitcnt vmcnt(" #n ")" ::: "memory")
#define PG8_WAIT_L(n) asm volatile("s_waitcnt lgkmcnt(" #n ")" ::: "memory")
#define PG8_BAR __builtin_amdgcn_s_barrier()
#define PG8_SCHED __builtin_amdgcn_sched_barrier(0)
    Unit cur, nxt; int ui = 0;
    if (!S.next(0, cur)) return;
    f32x4 acc[2][2][4][2];
#pragma unroll
    for (int a = 0; a < 2; ++a)
#pragma unroll
        for (int b = 0; b < 2; ++b)
#pragma unroll
            for (int m = 0; m < 4; ++m)
#pragma unroll
                for (int n = 0; n < 2; ++n) acc[a][b][m][n] = ZERO4;
    bf16x8 At[4][2], B0[2][2], B1[2][2];
    const char* cA = (const char*)g.A + (size_t)cur.pm * tA + (size_t)cur.koff * 2; const char* cB = (const char*)g.Bt + (size_t)cur.pn * tB + (size_t)cur.koff * 2;
    PG8_STAGE(PG8_SB(0, 0), cB, voffB); PG8_STAGE(PG8_SB(0, 1), cB + hB, voffB); PG8_STAGE(PG8_SA(0, 0), cA, voffA); PG8_STAGE(PG8_SA(0, 1), cA + hA, voffA);
    if (wr == 1) PG8_BAR;
    PG8_WAIT_V(2); PG8_BAR;
    PG8_STAGE(PG8_SB(1, 0), cB + kstep, voffB); PG8_STAGE(PG8_SA(1, 0), cA + kstep, voffA); PG8_STAGE(PG8_SB(1, 1), cB + hB + kstep, voffB);
    PG8_WAIT_V(6); PG8_BAR;
    for (;;) {
        const bool has_next = S.next(ui + 1, nxt);
        const char* nA = has_next ? (const char*)g.A + (size_t)nxt.pm * tA + (size_t)nxt.koff * 2 : cA; const char* nB = has_next ? (const char*)g.Bt + (size_t)nxt.pn * tB + (size_t)nxt.koff * 2 : cB;
        for (int t = 0; t < nt; t += 2) {
            const bool last = (t == nt - 2);
            const char* a1 = cA + (size_t)(t + 1) * kstep;
            const char* a2 = last ? nA : cA + (size_t)(t + 2) * kstep; const char* b2 = last ? nB : cB + (size_t)(t + 2) * kstep;
            const char* a3 = a2 + kstep; const char* b3 = b2 + kstep;
            PG8_LDB(B0, 0, 0); PG8_LDB(B1, 0, 1); PG8_SCHED; PG8_LDA(At, 0, 0); PG8_STAGE(PG8_SA(1, 1), a1 + hA, voffA);
            PG8_WAIT_V(8); PG8_WAIT_L(0); PG8_BAR; PG8_MMA(0, 0, At, B0); PG8_MMA(0, 1, At, B1); PG8_BAR; PG8_SCHED;
            PG8_LDA(At, 0, 1); PG8_STAGE(PG8_SB(0, 0), b2, voffB); PG8_STAGE(PG8_SB(0, 1), b2 + hB, voffB); PG8_STAGE(PG8_SA(0, 0), a2, voffA);
            PG8_WAIT_V(8); PG8_WAIT_L(0); PG8_BAR; PG8_MMA(1, 0, At, B0); PG8_MMA(1, 1, At, B1); PG8_BAR; PG8_SCHED;
            PG8_LDB(B0, 1, 0); PG8_LDB(B1, 1, 1); PG8_SCHED; PG8_LDA(At, 1, 0); PG8_STAGE(PG8_SA(0, 1), a2 + hA, voffA);
            PG8_WAIT_V(8); PG8_WAIT_L(0); PG8_BAR; PG8_MMA(0, 0, At, B0); PG8_MMA(0, 1, At, B1); PG8_BAR; PG8_SCHED;
            PG8_LDA(At, 1, 1); PG8_STAGE(PG8_SB(1, 0), b3, voffB); PG8_STAGE(PG8_SB(1, 1), b3 + hB, voffB); PG8_STAGE(PG8_SA(1, 0), a3, voffA);
            PG8_WAIT_V(8); PG8_WAIT_L(0); PG8_BAR; PG8_MMA(1, 0, At, B0); PG8_MMA(1, 1, At, B1); PG8_BAR; PG8_SCHED;
        }
        if (DBG_TMASK && DBG_TEPI && tid == 0 && blockIdx.x == 0) { volatile LAS unsigned* m_ = (volatile LAS unsigned*)(lds + MISC_OFF); if (m_[68]) m_[65] = (unsigned)__builtin_amdgcn_s_memrealtime(); }
        if (wr == 0) PG8_BAR;
        if constexpr (Epi::SEGACC) E.seg(acc, cur, wr, wc, fr, fq); else E(acc, cur, wr, wc, fr, fq);
        if (DBG_TMASK && DBG_TEPI && tid == 0 && blockIdx.x == 0) { volatile LAS unsigned* m_ = (volatile LAS unsigned*)(lds + MISC_OFF); if (m_[68]) m_[66] = m_[66] + ((unsigned)__builtin_amdgcn_s_memrealtime() - m_[65]); }
        if (!has_next) break;
        if (!(Epi::SEGACC && nxt.seg != 0)) {
#pragma unroll
        for (int a = 0; a < 2; ++a)
#pragma unroll
            for (int b = 0; b < 2; ++b)
#pragma unroll
                for (int m = 0; m < 4; ++m)
#pragma unroll
                    for (int n = 0; n < 2; ++n) acc[a][b][m][n] = ZERO4;
        }
        cur = nxt; cA = nA; cB = nB; ++ui;
        if (wr == 1) PG8_BAR;
    }
    PG8_WAIT_V(0);
    PG8_BAR;
#undef PG8_SA
#undef PG8_SB
#undef PG8_STAGE
#undef PG8_LDA
#undef PG8_LDB
#undef PG8_MMA
#undef PG8_WAIT_V
#undef PG8_WAIT_L
#undef PG8_BAR
#undef PG8_SCHED
}
#endif
}

#ifndef CPU_EMU
typedef const __attribute__((address_space(4))) Params* KParams;
#else
typedef const Params* KParams;
#endif
struct Frame {
    LAS unsigned char* lds;
    int tid, lane, wave, G, bid;
    KParams p;
    unsigned char* ws;
};
DEV const float* lin(const Frame& F, int idx, int layer, size_t per_layer) { return F.p->in[idx] + (size_t)layer * per_layer; }
#define WSP(T, off) ((T*)(F.ws + (off)))

DEV int up_dest(int n) { return n < DFF ? (n >> 7) * 256 + (n & 127) : ((n - DFF) >> 7) * 256 + 128 + ((n - DFF) & 127); }
DEV int win_dest(int n) {
    if (n < 2048) return n;
    if (n < 2052) return SM0 + S_AA + (n - 2048);
    if (n < 2056) return SM0 + S_AB + (n - 2052);
    if (n < 4104) return C_BQ + (n - 2056);
    if (n < 4116) return SM0 + S_BG + (n - 4104);
    if (n < 6676) return C_CZ + (n - 4116);
    if (n < 6692) return SM0 + S_DT + (n - 6676);
    return GT0 + (n - 6692);
}
struct XItem { const float* W; const float* ks; bf16* WT; int K, N, ldt, koff, mode, r; };
DEV void xitem_load(const XItem& it, int lane, float (&v)[32]) {
    const int nblk = (it.N + 31) / 32, kb = it.r / nblk, nb = it.r % nblk, k0 = 64 * kb, n0 = 32 * nb;
    const int nn = n0 + (lane & 31);
    const float* src = it.W + (size_t)(k0 + (lane >> 5)) * it.N + (nn < it.N ? nn : it.N - 1);
#pragma unroll
    for (int i = 0; i < 32; ++i) v[i] = src[(size_t)(2 * i) * it.N];
}
DEV void xitem_to_lds(LAS float* scr, int lane, const float (&v)[32]) {
#pragma unroll
    for (int i = 0; i < 32; ++i) scr[(2 * i + (lane >> 5)) * 33 + (lane & 31)] = v[i];
    LDS_WAIT(); CFENCE();
}
DEV void xitem_store(const XItem& it, LAS float* scr, int lane) {
    const int nblk = (it.N + 31) / 32, kb = it.r / nblk, nb = it.r % nblk, k0 = 64 * kb, n0 = 32 * nb;
    const int c = lane & 7;
    f32x4 ks0 = (f32x4){1.f, 1.f, 1.f, 1.f}, ks1 = ks0;
    if (it.ks) { ks0 = *(const f32x4*)(it.ks + k0 + 8 * c); ks1 = *(const f32x4*)(it.ks + k0 + 8 * c + 4); }
#pragma unroll
    for (int j = 0; j < 4; ++j) { const int n = (lane >> 3) + 8 * j; const LAS float* s = scr + (8 * c) * 33 + n;
        u32x4 o; o.x = pk2(s[0 * 33] * ks0[0], s[1 * 33] * ks0[1]); o.y = pk2(s[2 * 33] * ks0[2], s[3 * 33] * ks0[3]); o.z = pk2(s[4 * 33] * ks1[0], s[5 * 33] * ks1[1]); o.w = pk2(s[6 * 33] * ks1[2], s[7 * 33] * ks1[3]);
        const int ng = n0 + n;
        if (ng < it.N) { const int dr = it.mode == 0 ? ng : (it.mode == 1 ? up_dest(ng) : win_dest(ng)); *(u32x4*)(it.WT + (size_t)dr * it.ldt + it.koff + k0 + 8 * c) = o; } }
    LDS_WAIT(); CFENCE();
}
constexpr int XI_UP = (DM / 64) * (NUP / 32), XI_DN = (DFF / 64) * (DM / 32), XI_IN = (DM / 64) * ((NIN + 31) / 32), XI_P5 = (512 / 64) * (DM / 32), XI_P10 = (1024 / 64) * (DM / 32), XI_OO = (DM / 64) * (DM / 32), XI_CK = (4096 / 64) * (128 / 32);
constexpr int XI_TOTAL = 2 * XI_UP + 2 * XI_DN + XI_IN + 2 * XI_P5 + XI_P10 + XI_OO + 2 * XI_CK;
DEV XItem xitem_decode(Frame& F, int l, int idx) {
    XItem t; int r = idx; t.ks = nullptr; t.koff = 0; t.mode = 0;
    if (r < XI_UP) { t.W = lin(F, I_WUP1, l, (size_t)DM * NUP); t.K = DM; t.N = NUP; t.WT = WSP(bf16, WS_WUP1); t.ldt = DM; t.ks = lin(F, I_GF1, l, DM); t.mode = 1; }
    else if ((r -= XI_UP) < XI_UP) { t.W = lin(F, I_WUP2, l, (size_t)DM * NUP); t.K = DM; t.N = NUP; t.WT = WSP(bf16, WS_WUP2); t.ldt = DM; t.ks = lin(F, I_GF2, l, DM); t.mode = 1; }
    else if ((r -= XI_UP) < XI_DN) { t.W = lin(F, I_WDN1, l, (size_t)DFF * DM); t.K = DFF; t.N = DM; t.WT = WSP(bf16, WS_WDN1); t.ldt = DFF; }
    else if ((r -= XI_DN) < XI_DN) { t.W = lin(F, I_WDN2, l, (size_t)DFF * DM); t.K = DFF; t.N = DM; t.WT = WSP(bf16, WS_WDN2); t.ldt = DFF; }
    else if ((r -= XI_DN) < XI_IN) { t.W = lin(F, I_WIN, l, (size_t)DM * NIN); t.K = DM; t.N = NIN; t.WT = WSP(bf16, WS_WIN); t.ldt = DM; t.ks = lin(F, I_GMIX, l, DM); t.mode = 2; }
    else if ((r -= XI_IN) < XI_P5) { t.W = lin(F, I_PA, l, (size_t)512 * DM); t.K = 512; t.N = DM; t.WT = WSP(bf16, WS_WPM); t.ldt = DM; }
    else if ((r -= XI_P5) < XI_P5) { t.W = lin(F, I_PB, l, (size_t)512 * DM); t.K = 512; t.N = DM; t.WT = WSP(bf16, WS_WPM); t.ldt = DM; t.koff = 512; }
    else if ((r -= XI_P5) < XI_P10) { t.W = lin(F, I_PC, l, (size_t)1024 * DM); t.K = 1024; t.N = DM; t.WT = WSP(bf16, WS_WPM); t.ldt = DM; t.koff = 1024; t.ks = lin(F, I_SNORM, l, 1024); }
    else if ((r -= XI_P10) < XI_OO) { t.W = lin(F, I_WO, l, (size_t)DM * DM); t.K = DM; t.N = DM; t.WT = WSP(bf16, WS_WO); t.ldt = DM; }
    else if ((r -= XI_OO) < XI_CK) { t.W = lin(F, I_NWCK, l, (size_t)4096 * 128); t.K = 4096; t.N = 128; t.WT = WSP(bf16, WS_WCK); t.ldt = 4096; }
    else { r -= XI_CK; t.W = lin(F, I_NWCV, l, (size_t)4096 * 128); t.K = 4096; t.N = 128; t.WT = WSP(bf16, WS_WCV); t.ldt = 4096; }
    t.r = r; return t;
}
DEV void phase_convert(Frame& F, int l) {
    LAS float* scr = (LAS float*)(F.lds + F.wave * 16384);
    const int gw = F.bid * 8 + F.wave, NGW = F.G * 8;
    if (gw < XI_TOTAL) {
        float v[32]; XItem cur = xitem_decode(F, l, gw); xitem_load(cur, F.lane, v);
        for (int it = gw; it < XI_TOTAL; it += NGW) {
            xitem_to_lds(scr, F.lane, v);
            const bool has_next = it + NGW < XI_TOTAL; XItem nxt = cur;
            if (has_next) { nxt = xitem_decode(F, l, it + NGW); xitem_load(nxt, F.lane, v); }
            xitem_store(cur, scr, F.lane);
            cur = nxt;
        }
    }
    { bf16* w = WSP(bf16, WS_WIN) + (size_t)(SM0 + 36) * DM; const int n16 = (GT0 - SM0 - 36) * DM / 8;
      const unsigned zu = __builtin_bit_cast(unsigned, opaque_zero());
      for (int i = F.bid * 512 + F.tid; i < n16; i += F.G * 512) ((u32x4*)w)[i] = (u32x4){zu, zu, zu, zu}; }
    { const float* pek = lin(F, I_NPEK, l, 4096); const float* pev = lin(F, I_NPEV, l, 4096); float* cst = WSP(float, WS_CONST);
      for (int it = gw; it < 256; it += NGW) { const int e = it & 127; const float* pe = it < 128 ? pek : pev; const float* w = it < 128 ? lin(F, I_NWCK, l, (size_t)4096 * 128) : lin(F, I_NWCV, l, (size_t)4096 * 128); float s = 0.f;
          for (int k = F.lane; k < 4096; k += 64) s += pe[k] * w[(size_t)k * 128 + e];
          s = wave_sum(s); if (F.lane == 0) cst[it] = s; } }
    if (l == 0) {
        const float* x = F.p->in[I_X]; float* out = F.p->out; bf16* xb = WSP(bf16, WS_XB); unsigned long long* rss = WSP(unsigned long long, WS_CTL) + CW_RS / 2;
        for (int m = gw; m < MTOK; m += NGW) {
            const f32x4* xr = (const f32x4*)(x + (size_t)m * DM) + F.lane; f32x4* orow = (f32x4*)(out + (size_t)m * DM) + F.lane; u32x2* br = (u32x2*)(xb + (size_t)m * DM) + F.lane; float ss = 0.f;
#pragma unroll
            for (int j = 0; j < 8; ++j) { const f32x4 v = xr[64 * j]; orow[64 * j] = v; ss += (v[0] * v[0] + v[1] * v[1]) + (v[2] * v[2] + v[3] * v[3]); u32x2 w; w.x = pk2(v[0], v[1]); w.y = pk2(v[2], v[3]); br[64 * j] = w; }
            ss = wave_sum(ss); if (F.lane == 0) rss[m] = pg8::rss_fix(ss);
        }
    }
}

DEV void nsa_prep_job(Frame& F, int l, int job) {
    const int b = job >> 8, g = (job >> 7) & 1, j = job & 127, bg = b * 2 + g, t0 = 64 * j;
    const bf16* p1 = WSP(bf16, WS_P1);
    const float* qn = lin(F, I_NQN, l, 128); const float* kn = lin(F, I_NKN, l, 128);
    bf16* QN = WSP(bf16, WS_QN); bf16* KS = WSP(bf16, WS_KS); bf16* KW = WSP(bf16, WS_KW); bf16* VST = WSP(bf16, WS_VST); bf16* VWT = WSP(bf16, WS_VWT);
    {
        const int v = F.lane >> 4, l16 = F.lane & 15;
        const int col = (v < 2 ? C_BQ + (g * 2 + v) * 128 : (v == 2 ? C_BKS + g * 128 : C_BKW + g * 128)) + 8 * l16;
        const float* gp = (v < 2 ? qn : kn) + 8 * l16; const f32x4 ga = *(const f32x4*)gp, gb = *(const f32x4*)(gp + 4);
        const float gg[8] = {ga[0], ga[1], ga[2], ga[3], gb[0], gb[1], gb[2], gb[3]};
        u32x4 wv[8];
#pragma unroll
        for (int i = 0; i < 8; ++i) wv[i] = *(const u32x4*)(p1 + (size_t)(b * SEQ + t0 + 8 * F.wave + i) * P1W + col);
        CFENCE();
#pragma unroll
        for (int i = 0; i < 8; ++i) {
            const int t = t0 + 8 * F.wave + i;
            const float x[8] = {bflo(wv[i].x), bfhi(wv[i].x), bflo(wv[i].y), bfhi(wv[i].y), bflo(wv[i].z), bfhi(wv[i].z), bflo(wv[i].w), bfhi(wv[i].w)};
            float ss = ((x[0] * x[0] + x[1] * x[1]) + (x[2] * x[2] + x[3] * x[3])) + ((x[4] * x[4] + x[5] * x[5]) + (x[6] * x[6] + x[7] * x[7]));
            ss = sum16(ss);
            float r = rsqrtf(ss * (1.0f / 128.0f) + EPS);
            if (v < 2) r *= 0.08838834764831845f * 1.4426950408889634f;
            u32x4 o; o.x = pk2(x[0] * r * gg[0], x[1] * r * gg[1]); o.y = pk2(x[2] * r * gg[2], x[3] * r * gg[3]); o.z = pk2(x[4] * r * gg[4], x[5] * r * gg[5]); o.w = pk2(x[6] * r * gg[6], x[7] * r * gg[7]);
            bf16* dst = v < 2 ? QN + ((size_t)(bg * SEQ + t) * 2 + v) * 128 : (v == 2 ? KS : KW) + (size_t)(bg * SEQ + t) * 128;
            *(u32x4*)(dst + 8 * l16) = o;
        }
    }
    LAS bf16* tl = (LAS bf16*)F.lds;
    {
        u32x4 vv[4];
#pragma unroll
        for (int q = 0; q < 4; ++q) { const int i = F.tid + 512 * q, v = i >> 10, r = (i >> 4) & 63, c8 = (i & 15) * 8;
            vv[q] = *(const u32x4*)(p1 + (size_t)(b * SEQ + t0 + r) * P1W + (v ? C_BVW : C_BVS) + g * 128 + c8); }
#pragma unroll
        for (int q = 0; q < 4; ++q) { const int i = F.tid + 512 * q, v = i >> 10, r = (i >> 4) & 63, c8 = (i & 15) * 8; LAS unsigned* d = (LAS unsigned*)(tl + (v * 64 + r) * 130 + c8);
            d[0] = vv[q].x; d[1] = vv[q].y; d[2] = vv[q].z; d[3] = vv[q].w; }
    }
    __syncthreads();
    for (int i = F.tid; i < 2 * 128 * 8; i += 512) {
        const int v = i >> 10, d = i & 127, tc = (i >> 7) & 7;
        const LAS bf16* s = tl + (v * 64 + 8 * tc) * 130 + d;
        u32x4 o; o.x = s[0] | ((unsigned)s[130] << 16); o.y = s[260] | ((unsigned)s[390] << 16); o.z = s[520] | ((unsigned)s[650] << 16); o.w = s[780] | ((unsigned)s[910] << 16);
        *(u32x4*)((v ? VWT : VST) + ((size_t)(bg * 128 + j) * 128 + d) * 64 + 8 * tc) = o;
    }
    __syncthreads();
}

DEV void conv_load11(u32x4 (&xin)[11], const bf16* p1, int b, int ts, int col) {
#pragma unroll
    for (int i = 0; i < 11; ++i) { const int t = ts - 3 + i; const int tc = t < 0 ? 0 : t;
        u32x4 v = *(const u32x4*)(p1 + (size_t)(b * SEQ + tc) * P1W + col);
        if (t < 0) v = (u32x4){0u, 0u, 0u, 0u};
        xin[i] = v; }
}
DEV void gdn_prep_job(Frame& F, int l, int job) {
    const int b = job >> 9, h = (job >> 7) & 3, c = job & 127, t0 = 64 * c;
    const bf16* p1 = WSP(bf16, WS_P1); const float* small = WSP(float, WS_SMALL);
    const float* convw = lin(F, I_GCONV, l, 4 * 1536);
    LAS float* Qs = (LAS float*)F.lds;
    LAS float* Ks = Qs + 64 * 132;
    LAS float* Vs = Ks + 64 * 132;
    LAS float* Mm = Vs + 64 * 132;
    LAS float* At = Mm + 64 * 68;
    LAS float* beta = At + 64 * 68;
    LAS float* gc = beta + 64;
    LAS float* eg = gc + 64;
    const int tid = F.tid;
    {
        if (tid < 384) {
            const int v = tid >> 7, s = tid & 15, tg = (tid >> 4) & 7, cc = v * 512 + h * 128 + 8 * s;
            u32x4 xin[11]; conv_load11(xin, p1, b, t0 + 8 * tg, (v == 0 ? C_AQ : (v == 1 ? C_AK : C_AV)) + h * 128 + 8 * s);
            f32x4 w[4][2];
#pragma unroll
            for (int k = 0; k < 4; ++k) { w[k][0] = *(const f32x4*)(convw + k * 1536 + cc); w[k][1] = *(const f32x4*)(convw + k * 1536 + cc + 4); }
            float y[8][8];
#pragma unroll
            for (int j = 0; j < 8; ++j) {
                float x[11];
#pragma unroll
                for (int i = 0; i < 11; ++i) { const unsigned wd = j < 2 ? xin[i].x : (j < 4 ? xin[i].y : (j < 6 ? xin[i].z : xin[i].w)); x[i] = (j & 1) ? bfhi(wd) : bflo(wd); }
                const float w0 = w[0][j >> 2][j & 3], w1 = w[1][j >> 2][j & 3], w2 = w[2][j >> 2][j & 3], w3 = w[3][j >> 2][j & 3];
#pragma unroll
                for (int i = 0; i < 8; ++i) y[i][j] = siluf_(w0 * x[i] + w1 * x[i + 1] + w2 * x[i + 2] + w3 * x[i + 3]);
            }
            LAS float* dst = (v == 0 ? Qs : (v == 1 ? Ks : Vs)) + (8 * tg) * 132 + 8 * s;
#pragma unroll
            for (int i = 0; i < 8; ++i) { *(LAS f32x4*)(dst + i * 132) = (f32x4){y[i][0], y[i][1], y[i][2], y[i][3]}; *(LAS f32x4*)(dst + i * 132 + 4) = (f32x4){y[i][4], y[i][5], y[i][6], y[i][7]}; }
        }
        if (tid < 64) {
            const size_t row = (size_t)(b * SEQ + t0 + tid);
            const float a = small[row * SMW + S_AA + h], bb = small[row * SMW + S_AB + h];
            beta[tid] = sigmoidf_(bb);
            gc[tid] = -__expf(lin(F, I_GALOG, l, 4)[h]) * softplusf_(a + lin(F, I_GDTB, l, 4)[h]);
        }
    }
    __syncthreads();
    for (int i4 = 0; i4 < 4; ++i4) {
        float x0[4], x1[4], ssv[4];
#pragma unroll
        for (int q = 0; q < 4; ++q) { const int r = F.wave * 16 + 4 * i4 + q;
            const LAS float* p = (r < 64 ? Qs + r * 132 : Ks + (r - 64) * 132); x0[q] = p[F.lane]; x1[q] = p[F.lane + 64]; ssv[q] = x0[q] * x0[q] + x1[q] * x1[q]; }
        wave_sum4(ssv);
#pragma unroll
        for (int q = 0; q < 4; ++q) { const int r = F.wave * 16 + 4 * i4 + q; LAS float* p = (r < 64 ? Qs + r * 132 : Ks + (r - 64) * 132);
            float sc = rsqrtf(ssv[q] + EPS); if (r < 64) sc *= 0.08838834764831845f;
            p[F.lane] = x0[q] * sc; p[F.lane + 64] = x1[q] * sc; }
    }
    if (tid < 64) {
        float sc = gc[tid];
#pragma unroll
        for (int d = 1; d < 64; d <<= 1) { const float t = __builtin_bit_cast(float, __builtin_amdgcn_ds_bpermute((tid - d) * 4, __builtin_bit_cast(int, sc))); if (tid >= d) sc += t; }
        gc[tid] = sc; eg[tid] = __expf(sc);
    }
    for (int i = tid; i < 64 * 68; i += 512) At[i] = 0.f;
    __syncthreads();
    for (int tj = F.wave; tj < 20; tj += 8) {
        const int kind = tj >= 10 ? 1 : 0, idx = tj - 10 * kind;
        const int mt = idx >= 6 ? 3 : (idx >= 3 ? 2 : (idx >= 1 ? 1 : 0)), nt = idx - mt * (mt + 1) / 2;
        const int fr = F.lane & 15, fq = F.lane >> 4;
        const LAS float* ap = (kind ? Qs : Ks) + (16 * mt + fr) * 132 + 4 * fq; const LAS float* bp = Ks + (16 * nt + fr) * 132 + 4 * fq;
        f32x4 acc = (f32x4){0.f, 0.f, 0.f, 0.f};
#pragma unroll
        for (int sg = 0; sg < 8; ++sg) { const f32x4 a4 = *(const LAS f32x4*)(ap + 16 * sg), b4 = *(const LAS f32x4*)(bp + 16 * sg);
#pragma unroll
            for (int j = 0; j < 4; ++j) acc = __builtin_amdgcn_mfma_f32_16x16x4f32(a4[j], b4[j], acc, 0, 0, 0); }
        const int j = 16 * nt + fr; const float gj = gc[j];
#pragma unroll
        for (int r = 0; r < 4; ++r) { const int i = 16 * mt + 4 * fq + r; const float dec = j <= i ? __expf(gc[i] - gj) : 0.f;
            if (kind) At[i * 68 + j] = acc[r] * dec; else Mm[i * 68 + j] = j < i ? beta[i] * acc[r] * dec : 0.f; }
    }
    __syncthreads();
    unsigned char* cb = F.ws + WS_GW + (size_t)job * GDN_CH_BYTES;
    bf16* gW = (bf16*)cb; bf16* gQD = (bf16*)(cb + 16384); bf16* gKDT = (bf16*)(cb + 32768); bf16* gUT = (bf16*)(cb + 49152); bf16* gAT = (bf16*)(cb + 65536);
    float sol[64];
    if (tid < 256) {
        const int cidx = tid & 127; const bool isw = tid >= 128;
        const LAS float* src = (isw ? Ks : Vs) + cidx;
        const LAS float* MmL = (const LAS float*)lds_vbase(Mm); const LAS float* betaL = (const LAS float*)lds_vbase(beta); const LAS float* egL = (const LAS float*)lds_vbase(eg);
#pragma unroll
        for (int i = 0; i < 64; ++i) sol[i] = 0.f;
#pragma unroll
        for (int i = 0; i < 64; ++i) {
            float r = src[i * 132] * betaL[i] * (isw ? egL[i] : 1.0f), r1 = 0.f, r2 = 0.f, r3 = 0.f;
#pragma unroll
            for (int j4 = 0; j4 < (i + 3) / 4; ++j4) { const f32x4 mv = *(const LAS f32x4*)(MmL + i * 68 + 4 * j4);
                r -= mv[0] * sol[4 * j4]; r1 -= mv[1] * sol[4 * j4 + 1]; r2 -= mv[2] * sol[4 * j4 + 2]; r3 -= mv[3] * sol[4 * j4 + 3]; }
            r = (r + r1) + (r2 + r3);
            sol[i] = r;
            asm volatile("" : "+v"(sol[i]) :: "memory");
        }
    } else {
        const int t2 = tid - 256;
        const float gl = gc[63];
        for (int i = t2; i < 64 * 16; i += 256) { const int r = i >> 4, c8 = (i & 15) * 8; const float e = eg[r]; const LAS float* s = Qs + r * 132 + c8;
            u32x4 o; o.x = pk2(s[0] * e, s[1] * e); o.y = pk2(s[2] * e, s[3] * e); o.z = pk2(s[4] * e, s[5] * e); o.w = pk2(s[6] * e, s[7] * e); *(u32x4*)(gQD + r * 128 + c8) = o; }
        for (int i = t2; i < 128 * 8; i += 256) { const int dk = i & 127, i8 = (i >> 7) * 8; float v[8];
#pragma unroll
            for (int q = 0; q < 8; ++q) v[q] = Ks[(i8 + q) * 132 + dk] * __expf(gl - gc[i8 + q]);
            u32x4 o; o.x = pk2(v[0], v[1]); o.y = pk2(v[2], v[3]); o.z = pk2(v[4], v[5]); o.w = pk2(v[6], v[7]); *(u32x4*)(gKDT + dk * 64 + i8) = o; }
        for (int i = t2; i < 64 * 8; i += 256) { const int r = i >> 3, c8 = (i & 7) * 8; const LAS float* s = At + r * 68 + c8;
            u32x4 o; o.x = pk2(s[0], s[1]); o.y = pk2(s[2], s[3]); o.z = pk2(s[4], s[5]); o.w = pk2(s[6], s[7]); *(u32x4*)(gAT + r * 64 + c8) = o; }
        if (t2 == 0) WSP(float, WS_GL)[job] = __expf(gl);
    }
    __syncthreads();
    LAS bf16* Wl = (LAS bf16*)Qs;
    if (tid < 128) {
#pragma unroll
        for (int q = 0; q < 8; ++q) { u32x4 o; o.x = pk2(sol[8 * q], sol[8 * q + 1]); o.y = pk2(sol[8 * q + 2], sol[8 * q + 3]); o.z = pk2(sol[8 * q + 4], sol[8 * q + 5]); o.w = pk2(sol[8 * q + 6], sol[8 * q + 7]);
            *(u32x4*)(gUT + tid * 64 + 8 * q) = o; }
    } else if (tid < 256) {
#pragma unroll
        for (int i = 0; i < 64; ++i) Wl[i * 136 + (tid - 128)] = (bf16)f2bf(sol[i]);
    }
    __syncthreads();
    for (int i = tid; i < 64 * 16; i += 512) { const int r = i >> 4, c8 = (i & 15) * 8; *(u32x4*)(gW + r * 128 + c8) = *(const LAS u32x4*)(Wl + r * 136 + c8); }
    __syncthreads();
}

DEV void ssd_conv8(const u32x4 (&xin)[11], const float* cw, const float* cbias, int cc, float (&y)[8][8]) {
    f32x4 w[4][2], bs[2];
#pragma unroll
    for (int k = 0; k < 4; ++k) { w[k][0] = *(const f32x4*)(cw + k * 1536 + cc); w[k][1] = *(const f32x4*)(cw + k * 1536 + cc + 4); }
    bs[0] = *(const f32x4*)(cbias + cc); bs[1] = *(const f32x4*)(cbias + cc + 4);
#pragma unroll
    for (int j = 0; j < 8; ++j) {
        float x[11];
#pragma unroll
        for (int i = 0; i < 11; ++i) { const unsigned wd = j < 2 ? xin[i].x : (j < 4 ? xin[i].y : (j < 6 ? xin[i].z : xin[i].w)); x[i] = (j & 1) ? bfhi(wd) : bflo(wd); }
        const float w0 = w[0][j >> 2][j & 3], w1 = w[1][j >> 2][j & 3], w2 = w[2][j >> 2][j & 3], w3 = w[3][j >> 2][j & 3], bj = bs[j >> 2][j & 3];
#pragma unroll
        for (int i = 0; i < 8; ++i) y[i][j] = siluf_(w0 * x[i] + w1 * x[i + 1] + w2 * x[i + 2] + w3 * x[i + 3] + bj);
    }
}
DEV bf16x8 frag_sw(const LAS bf16* M, int row, int chunk) { return *(const LAS bf16x8*)(M + row * 136 + 8 * (chunk ^ ((row >> 3) & 7))); }
DEV void ssd_prep_pass(Frame& F, const u32x4 (&xin)[11], const float* cw, const float* cbias, int cc, bf16* SX, float* dst0, LAS bf16* BT, LAS bf16* XT, const LAS float* dts, const LAS float* acs,
                       size_t row0, int s, int tg, int hh0) {
    const float zf_ = opaque_zero();
    {
        float y[8][8]; ssd_conv8(xin, cw, cbias, cc, y);
#pragma unroll
        for (int i = 0; i < 8; ++i) { u32x4 o; o.x = pk2(y[i][0], y[i][1]); o.y = pk2(y[i][2], y[i][3]); o.z = pk2(y[i][4], y[i][5]); o.w = pk2(y[i][6], y[i][7]);
            *(u32x4*)(SX + (row0 + i) * 1536 + cc) = o; }
        const int hh = hh0 + (s >> 3); const float al = acs[127 * 8 + hh]; float f[8];
#pragma unroll
        for (int i = 0; i < 8; ++i) f[i] = dts[(8 * tg + i) * 8 + hh] * __expf(al - acs[(8 * tg + i) * 8 + hh]);
#pragma unroll
        for (int j = 0; j < 8; ++j) { float v[8];
#pragma unroll
            for (int i = 0; i < 8; ++i) v[i] = bf2f(f2bf(y[i][j])) * f[i];
            u32x4 o; o.x = pk2(v[0], v[1]); o.y = pk2(v[2], v[3]); o.z = pk2(v[4], v[5]); o.w = pk2(v[6], v[7]);
            *(LAS u32x4*)(XT + (8 * s + j) * 136 + 8 * (tg ^ (s & 7))) = o; }
    }
    __syncthreads();
    {
        const int hp = F.wave >> 1, nh = F.wave & 1, fr = F.lane & 15, fq = F.lane >> 4;
        const LAS bf16* XTh = XT + hp * 64 * 136;
        float* dst = dst0 + (size_t)hp * 64 * 128;
#pragma unroll
        for (int mt = 0; mt < 4; ++mt) {
            bf16x8 a[4];
#pragma unroll
            for (int ks = 0; ks < 4; ++ks) a[ks] = frag_sw(XTh, 16 * mt + fr, 4 * ks + fq);
#pragma unroll
            for (int q = 0; q < 4; ++q) { const int nq = 4 * nh + q; f32x4 acc = ZERO4;
#pragma unroll
                for (int ks = 0; ks < 4; ++ks) acc = mfma16(frag_sw(BT, 16 * nq + fr, 4 * ks + fq), a[ks], acc);
                *(f32x4*)(dst + (size_t)(16 * mt + fr) * 128 + 16 * nq + 4 * fq) = acc; }
        }
    }
    __syncthreads();
}
DEV void ssd_prep_job(Frame& F, int l, int job) {
    const int b = job >> 7, c = (job >> 1) & 63, g = job & 1, t0 = 128 * c;
    const bf16* p1 = WSP(bf16, WS_P1); const float* small = WSP(float, WS_SMALL);
    const float* cw = lin(F, I_SCW, l, 4 * 1536); const float* cbias = lin(F, I_SCB, l, 1536);
    bf16* SX = WSP(bf16, WS_SX); float* SDT = WSP(float, WS_SDT); float* SAC = WSP(float, WS_SAC); float* SST = WSP(float, WS_SST); float* SCD = WSP(float, WS_SCD);
    LAS bf16* BT = (LAS bf16*)F.lds;
    LAS bf16* XT = BT + 128 * 136;
    LAS float* dts = (LAS float*)(XT + 4 * 64 * 136);
    LAS float* acs = dts + 128 * 8;
    const int tid = F.tid, s = tid & 31, tg = tid >> 5, ts = t0 + 8 * tg;
    const int ccA = 1024 + (s < 16 ? g * 128 + 8 * s : 256 + g * 128 + 8 * (s - 16));
    const int ccX = g * 512 + 8 * s;
    const size_t row0 = (size_t)(b * SEQ + ts);
    u32x4 xa[11], xb[11];
    conv_load11(xa, p1, b, ts, C_CX + ccA); conv_load11(xb, p1, b, ts, C_CX + ccX);
    for (int i = tid; i < 1024; i += 512) { const int tl = i >> 3, hh = i & 7, h = 8 * g + hh; const size_t row = (size_t)(b * SEQ + t0 + tl);
        const float dt = softplusf_(small[row * SMW + S_DT + h] + lin(F, I_SDTB, l, 16)[h]);
        dts[i] = dt; acs[i] = dt * (-__expf(lin(F, I_SALOG, l, 16)[h])); }
    __syncthreads();
    {
        const int hh = F.wave, ln = F.lane; const float v0 = acs[(2 * ln) * 8 + hh], v1 = acs[(2 * ln + 1) * 8 + hh];
        float sc = v0 + v1;
#pragma unroll
        for (int d = 1; d < 64; d <<= 1) { const float t = __builtin_bit_cast(float, __builtin_amdgcn_ds_bpermute((ln - d) * 4, __builtin_bit_cast(int, sc))); if (ln >= d) sc += t; }
        float ex = __builtin_bit_cast(float, __builtin_amdgcn_ds_bpermute((ln - 1) * 4, __builtin_bit_cast(int, sc))); if (ln == 0) ex = 0.f;
        const float a0 = ex + v0; acs[(2 * ln) * 8 + hh] = a0; acs[(2 * ln + 1) * 8 + hh] = a0 + v1;
    }
    __syncthreads();
    for (int i = tid; i < 1024; i += 512) { const int tl = i >> 3, hh = i & 7; const size_t row = (size_t)(b * SEQ + t0 + tl); SDT[row * 16 + 8 * g + hh] = dts[i]; SAC[row * 16 + 8 * g + hh] = acs[i]; }
    if (tid < 8) SCD[(size_t)(b * 64 + c) * 16 + 8 * g + tid] = __expf(acs[127 * 8 + tid]);
    {
        float y[8][8]; ssd_conv8(xa, cw, cbias, ccA, y);
#pragma unroll
        for (int i = 0; i < 8; ++i) { u32x4 o; o.x = pk2(y[i][0], y[i][1]); o.y = pk2(y[i][2], y[i][3]); o.z = pk2(y[i][4], y[i][5]); o.w = pk2(y[i][6], y[i][7]);
            *(u32x4*)(SX + (row0 + i) * 1536 + ccA) = o; }
        if (s < 16) {
#pragma unroll
            for (int j = 0; j < 8; ++j) { u32x4 o; o.x = pk2(y[0][j], y[1][j]); o.y = pk2(y[2][j], y[3][j]); o.z = pk2(y[4][j], y[5][j]); o.w = pk2(y[6][j], y[7][j]);
                *(LAS u32x4*)(BT + (8 * s + j) * 136 + 8 * (tg ^ (s & 7))) = o; }
        }
    }
    conv_load11(xa, p1, b, ts, C_CX + ccX + 256);
    float* dst0 = SST + ((size_t)((b * 64 + c) * 16 + 8 * g) * 64) * 128;
    ssd_prep_pass(F, xb, cw, cbias, ccX, SX, dst0, BT, XT, dts, acs, row0, s, tg, 0);
    ssd_prep_pass(F, xa, cw, cbias, ccX + 256, SX, dst0 + (size_t)4 * 64 * 128, BT, XT, dts, acs, row0, s, tg, 4);
}

DEV void nsa_compress_job(Frame& F, int l, int job) {
    const int kv = job >> 4, bg = (job >> 2) & 3, rt = job & 3, b = bg >> 1, g = bg & 1, i0 = 128 * rt;
    const float zf_ = opaque_zero();
    const bf16* p1 = WSP(bf16, WS_P1); const bf16* Wt = WSP(bf16, kv ? WS_WCV : WS_WCK); const float* cst = WSP(float, WS_CONST) + kv * 128;
    const int col0 = (kv ? C_BVC : C_BKC) + g * 128;
    LAS bf16* As = (LAS bf16*)F.lds;
    LAS bf16* Bs = As + 128 * 72;
    LAS float* Cs = (LAS float*)(Bs + 128 * 72);
    const int tid = F.tid, wm = F.wave >> 1, wn = F.wave & 1;
    f32x4 acc[2][4];
#pragma unroll
    for (int i = 0; i < 2; ++i)
#pragma unroll
        for (int j = 0; j < 4; ++j) acc[i][j] = ZERO4;
    u32x4 ra[2], rb[2];
#define LOADK(ks_) do { _Pragma("unroll") for (int q = 0; q < 2; ++q) { const int ch = tid + 512 * q, r = ch >> 3, c8 = (ch & 7) * 8; \
            int t = 16 * (i0 + r) + ((ks_) >> 1); if (t > SEQ - 1) t = SEQ - 1;     \
            ra[q] = *(const u32x4*)(p1 + (size_t)(b * SEQ + t) * P1W + col0 + ((ks_) & 1) * 64 + c8); \
            rb[q] = *(const u32x4*)(Wt + (size_t)r * 4096 + 64 * (ks_) + c8); } } while (0)
    LOADK(0);
    for (int ks = 0; ks < 64; ++ks) {
        __syncthreads();
#pragma unroll
        for (int q = 0; q < 2; ++q) { const int ch = tid + 512 * q, r = ch >> 3, c8 = (ch & 7) * 8; *(LAS u32x4*)(As + r * 72 + c8) = ra[q]; *(LAS u32x4*)(Bs + r * 72 + c8) = rb[q]; }
        __syncthreads();
        if (ks + 1 < 64) LOADK(ks + 1);
#pragma unroll
        for (int k2 = 0; k2 < 2; ++k2) {
            bf16x8 a0 = frag_l(As, 72, 32 * wm, 32 * k2, F.lane), a1 = frag_l(As, 72, 32 * wm + 16, 32 * k2, F.lane);
#pragma unroll
            for (int j = 0; j < 4; ++j) { const bf16x8 bb = frag_l(Bs, 72, 64 * wn + 16 * j, 32 * k2, F.lane); acc[0][j] = mfma16(a0, bb, acc[0][j]); acc[1][j] = mfma16(a1, bb, acc[1][j]); }
        }
    }
    __syncthreads();
#pragma unroll
    for (int i = 0; i < 2; ++i)
#pragma unroll
        for (int j = 0; j < 4; ++j)
#pragma unroll
            for (int r = 0; r < 4; ++r) { const int col = 64 * wn + 16 * j + (F.lane & 15); Cs[(32 * wm + 16 * i + 4 * (F.lane >> 4) + r) * 132 + col] = acc[i][j][r] + cst[col]; }
    __syncthreads();
    if (kv == 0) {
        const float* kn = lin(F, I_NKN, l, 128); bf16* KC = WSP(bf16, WS_KCMP);
        const int r = tid >> 2, q = tid & 3; const LAS float* s = Cs + r * 132 + 32 * q; float ss = 0.f;
#pragma unroll
        for (int e = 0; e < 32; ++e) ss += s[e] * s[e];
        ss += shx<1>(ss); ss += shx<2>(ss);
        const float rs = rsqrtf(ss * (1.0f / 128.0f) + EPS);
        bf16* dst = KC + ((size_t)bg * 512 + i0 + r) * 128 + 32 * q;
#pragma unroll
        for (int e = 0; e < 32; e += 2) *(unsigned*)(dst + e) = pk2(s[e] * rs * kn[32 * q + e], s[e + 1] * rs * kn[32 * q + e + 1]);
    } else {
        bf16* VC = WSP(bf16, WS_VCMPT); const int e = tid & 127, q = tid >> 7;
#pragma unroll
        for (int i8 = 0; i8 < 4; ++i8) { const LAS float* s = Cs + (32 * q + 8 * i8) * 132 + e;
            u32x4 o; o.x = pk2(s[0], s[132]); o.y = pk2(s[264], s[396]); o.z = pk2(s[528], s[660]); o.w = pk2(s[792], s[924]);
            *(u32x4*)(VC + ((size_t)bg * 128 + e) * 512 + i0 + 32 * q + 8 * i8) = o; }
    }
    __syncthreads();
}
#undef LOADK

constexpr int AL_KT = 0, AL_VT = 17408, AL_KT1 = 35840, AL_UW = 53248, AL_TB = 54272, AL_SM = 60608, AL_PS = 61696, AL_IMP = 78336, AL_VT1 = 111104, AL_END = 129536;
static_assert(AL_KT1 + 17408 <= AL_UW && AL_UW + 128 <= AL_TB && AL_END <= MISC_OFF, "attention LDS map");
DEV int rel_bucket_dev(int n) {
    if (n < 16) return n;
    int k = 16;
    k += (n >= 21); k += (n >= 27); k += (n >= 35); k += (n >= 46); k += (n >= 59); k += (n >= 77); k += (n >= 99); k += (n >= 128);
    k += (n >= 166); k += (n >= 216); k += (n >= 280); k += (n >= 363); k += (n >= 470); k += (n >= 609); k += (n >= 790);
    return k;
}
DEV void attn_fill_bias(Frame& F, int g) {
    LAS float* tb = (LAS float*)(F.lds + AL_TB); const float* rt = F.p->in[I_REL];
    for (int i = F.tid; i < 2 * 792; i += 512) { const int hg = i / 792, d = i - hg * 792; tb[i] = rt[rel_bucket_dev(d) * 4 + 2 * g + hg] * 1.4426950408889634f; }
}
DEV void attn_load_tile(u32x4 (&rk)[2], u32x4 (&rv)[2], const bf16* ksrc, const bf16* vsrc, int vpitch, int tid) {
#pragma unroll
    for (int q = 0; q < 2; ++q) { const int ch = tid + 512 * q; rk[q] = *(const u32x4*)(ksrc + (size_t)ch * 8); rv[q] = *(const u32x4*)(vsrc + (size_t)(ch >> 3) * vpitch + (ch & 7) * 8); }
}
DEV void attn_store_tile(LAS unsigned char* lds, int buf, const u32x4 (&rk)[2], const u32x4 (&rv)[2], int tid) {
    LAS bf16* Kt = (LAS bf16*)(lds + (buf ? AL_KT1 : AL_KT)); LAS bf16* Vt = (LAS bf16*)(lds + (buf ? AL_VT1 : AL_VT));
#pragma unroll
    for (int q = 0; q < 2; ++q) { const int ch = tid + 512 * q; *(LAS u32x4*)(Kt + (ch >> 4) * 136 + (ch & 15) * 8) = rk[q]; *(LAS u32x4*)(Vt + (ch >> 3) * 72 + (ch & 7) * 8) = rv[q]; }
}
template <int MODE, int PATH = 0>
DEV unsigned attn_scores(LAS unsigned char* lds, int buf, const bf16x8 (&qf)[4], int lane, int n0, int tok, int hg, unsigned selbit, f32x4 (&s)[4]) {
    const float zf_ = opaque_zero();
    const LAS bf16* Kt = (const LAS bf16*)(lds + (buf ? AL_KT1 : AL_KT)); const LAS float* tb = (const LAS float*)(lds + AL_TB) + hg * 792;
#pragma unroll
    for (int nt = 0; nt < 4; ++nt) { s[nt] = ZERO4;
#pragma unroll
        for (int ks = 0; ks < 4; ++ks) s[nt] = mfma16(frag_l(Kt, 136, 16 * nt, 32 * ks, lane), qf[ks], s[nt]); }
    if (PATH == 1) {
        const float bf = tb[790]; const bool ok = selbit != 0u;
#pragma unroll
        for (int nt = 0; nt < 4; ++nt)
#pragma unroll
            for (int r = 0; r < 4; ++r) s[nt][r] = ok ? s[nt][r] + bf : -1e30f;
        return ok ? 0xffffu : 0u;
    }
    if (PATH == 2) {
        const bool ok = MODE == 2 ? true : (selbit != 0u);
        const LAS float* tp = tb + (tok - n0 - 4 * (lane >> 4));
#pragma unroll
        for (int nt = 0; nt < 4; ++nt)
#pragma unroll
            for (int r = 0; r < 4; ++r) s[nt][r] = ok ? s[nt][r] + tp[-16 * nt - r] : -1e30f;
        return ok ? 0xffffu : 0u;
    }
    unsigned vm = 0u;
#pragma unroll
    for (int nh = 0; nh < 2; ++nh) {
        float bv[8];
#pragma unroll
        for (int q = 0; q < 8; ++q) { const int nt = 2 * nh + (q >> 2), r = q & 3; const int n = n0 + 16 * nt + 4 * (lane >> 4) + r; const int dist = MODE == 0 ? tok - (16 * n + 31) : tok - n;
            int di = dist < 0 ? 0 : dist; di = di > 790 ? 790 : di; bv[q] = tb[di]; }
#pragma unroll
        for (int q = 0; q < 8; ++q) asm volatile("" : "+v"(bv[q]));
#pragma unroll
        for (int q = 0; q < 8; ++q) { const int nt = 2 * nh + (q >> 2), r = q & 3; const int n = n0 + 16 * nt + 4 * (lane >> 4) + r; int dist; bool ok;
            if (MODE == 0) { dist = tok - (16 * n + 31); ok = dist >= 0 && n < 511; }
            else if (MODE == 1) { dist = tok - n; ok = dist >= 0 && selbit != 0u; }
            else { dist = tok - n; ok = dist >= 0 && dist < 512; }
            s[nt][r] = ok ? s[nt][r] + bv[q] : -1e30f;
            vm |= (ok ? 1u : 0u) << (4 * nt + r); }
    }
    return vm;
}
DEV float fq_max(float v) {
    const auto a = __builtin_amdgcn_permlane16_swap(__builtin_bit_cast(unsigned, v), __builtin_bit_cast(unsigned, v), false, false);
    const float m = fmaxf(__builtin_bit_cast(float, a[0]), __builtin_bit_cast(float, a[1]));
    const auto b = __builtin_amdgcn_permlane32_swap(__builtin_bit_cast(unsigned, m), __builtin_bit_cast(unsigned, m), false, false);
    return fmaxf(__builtin_bit_cast(float, b[0]), __builtin_bit_cast(float, b[1]));
}
DEV float fq_sum(float v) {
    const auto a = __builtin_amdgcn_permlane16_swap(__builtin_bit_cast(unsigned, v), __builtin_bit_cast(unsigned, v), false, false);
    const float m = __builtin_bit_cast(float, a[0]) + __builtin_bit_cast(float, a[1]);
    const auto b = __builtin_amdgcn_permlane32_swap(__builtin_bit_cast(unsigned, m), __builtin_bit_cast(unsigned, m), false, false);
    return __builtin_bit_cast(float, b[0]) + __builtin_bit_cast(float, b[1]);
}
DEV float attn_online(const f32x4 (&s)[4], unsigned vm, float& m, float& l, f32x4 (&p)[4]) {
    float mx = fmaxf(fmaxf(fmaxf(s[0][0], s[0][1]), fmaxf(s[0][2], s[0][3])), fmaxf(fmaxf(s[1][0], s[1][1]), fmaxf(s[1][2], s[1][3])));
    mx = fmaxf(mx, fmaxf(fmaxf(fmaxf(s[2][0], s[2][1]), fmaxf(s[2][2], s[2][3])), fmaxf(fmaxf(s[3][0], s[3][1]), fmaxf(s[3][2], s[3][3]))));
    mx = fmaxf(mx, shx<16>(mx)); mx = fmaxf(mx, shx<32>(mx));
    const float mn = fmaxf(m, mx), sc = __builtin_amdgcn_exp2f(m - mn); float rs = 0.f;
#pragma unroll
    for (int nt = 0; nt < 4; ++nt)
#pragma unroll
        for (int r = 0; r < 4; ++r) { const float pv = ((vm >> (4 * nt + r)) & 1u) ? __builtin_amdgcn_exp2f(s[nt][r] - mn) : 0.f; p[nt][r] = pv; rs += pv; }
    rs += shx<16>(rs); rs += shx<32>(rs);
    l = l * sc + rs; m = mn;
    return sc;
}
DEV void attn_pv(LAS unsigned char* lds, int buf, int lane, const f32x4 (&p)[4], f32x4 (&o)[8]) {
    const LAS bf16* Vt = (const LAS bf16*)(lds + (buf ? AL_VT1 : AL_VT)) + (lane & 15) * 72 + 4 * (lane >> 4);
#pragma unroll
    for (int ks = 0; ks < 2; ++ks) {
        u32x4 pw; pw.x = pg8::cvt_pk_bf16(p[2 * ks][0], p[2 * ks][1]); pw.y = pg8::cvt_pk_bf16(p[2 * ks][2], p[2 * ks][3]); pw.z = pg8::cvt_pk_bf16(p[2 * ks + 1][0], p[2 * ks + 1][1]); pw.w = pg8::cvt_pk_bf16(p[2 * ks + 1][2], p[2 * ks + 1][3]);
        const bf16x8 pb = __builtin_bit_cast(bf16x8, pw);
#pragma unroll
        for (int dt = 0; dt < 8; ++dt) {
            const u32x2 v0 = *(const LAS u32x2*)(Vt + 16 * dt * 72 + 32 * ks), v1 = *(const LAS u32x2*)(Vt + 16 * dt * 72 + 32 * ks + 16);
            u32x4 vw; vw.x = v0.x; vw.y = v0.y; vw.z = v1.x; vw.w = v1.y;
            o[dt] = mfma16(__builtin_bit_cast(bf16x8, vw), pb, o[dt]); }
    }
}
DEV void attn_load_q(Frame& F, int bg, int t0, bf16x8 (&qf)[4]) {
    const bf16* QN = WSP(bf16, WS_QN); const int rho = F.lane & 15;
    const bf16* src = QN + ((size_t)(bg * SEQ + t0 + 8 * F.wave + (rho & 7)) * 2 + (rho >> 3)) * 128 + 8 * (F.lane >> 4);
#pragma unroll
    for (int ks = 0; ks < 4; ++ks) qf[ks] = *(const bf16x8*)(src + 32 * ks);
}

DEV void sel_step(Frame& F, const bf16* KS, const bf16* VS, int j, int jn, int jnn, int qt, int cb, const u32x4 (&st_k)[2], const u32x4 (&st_v)[2], u32x4 (&ld_k)[2], u32x4 (&ld_v)[2],
                  const bf16x8 (&qf)[4], const u32x4& smw, const unsigned (&wum)[4], int tok, int hg, float& m, float& l, f32x4 (&o)[8]) {
    const int lane = F.lane;
    if (jnn <= qt) attn_load_tile(ld_k, ld_v, KS + (size_t)jnn * 64 * 128, VS + (size_t)jnn * 128 * 64, 64, F.tid);
    const unsigned wsel = j < 32 ? wum[0] : (j < 64 ? wum[1] : (j < 96 ? wum[2] : wum[3]));
    if ((wsel >> (j & 31)) & 1u) {
        const unsigned w = j < 32 ? smw.x : (j < 64 ? smw.y : (j < 96 ? smw.z : smw.w)); const unsigned selbit = (w >> (j & 31)) & 1u;
        f32x4 s[4], p[4];
        const unsigned vm = (j <= qt - 14) ? attn_scores<1, 1>(F.lds, cb, qf, lane, 64 * j, tok, hg, selbit, s) : ((j >= qt - 11 && j < qt) ? attn_scores<1, 2>(F.lds, cb, qf, lane, 64 * j, tok, hg, selbit, s) : attn_scores<1, 0>(F.lds, cb, qf, lane, 64 * j, tok, hg, selbit, s));
        const float sc = attn_online(s, vm, m, l, p);
        if (__ballot(sc != 1.0f) != 0ull) {
#pragma unroll
            for (int dt = 0; dt < 8; ++dt) o[dt] = o[dt] * sc; }
        attn_pv(F.lds, cb, lane, p, o);
    }
    if (jn <= qt) attn_store_tile(F.lds, cb ^ 1, st_k, st_v, F.tid);
    __syncthreads();
}
DEV int sel_next(int j, int qt, const unsigned (&um)[4]) {
    int jn = j + 1;
    while (jn <= qt) { const unsigned w = jn < 32 ? um[0] : (jn < 64 ? um[1] : (jn < 96 ? um[2] : um[3])); if ((w >> (jn & 31)) & 1u) break; ++jn; }
    return jn;
}
#define NST(k) do { if (DBG_AJOB >= 10 && F.tid == 0) { volatile LAS unsigned* m_ = (volatile LAS unsigned*)(F.lds + MISC_OFF); const unsigned t_ = (unsigned)__builtin_amdgcn_s_memrealtime(); \
        if (DBG_AJOB == (k)) atomicAdd(WSP(unsigned, WS_CTL) + 460000, t_ - m_[70]); m_[70] = t_; } } while (0)
DEV void nsa_job(Frame& F, int job) {
    const int bg = job >> 7, qt = job & 127, b = bg >> 1, g = bg & 1, t0 = 64 * qt, tid = F.tid, lane = F.lane, wave = F.wave;
    const float zf_ = opaque_zero();
    const int fq = lane >> 4, fr = lane & 15, hg = fr >> 3, tok = t0 + 8 * wave + (fr & 7);
    const float* small = WSP(float, WS_SMALL); const size_t row = (size_t)(b * SEQ + tok);
    LAS float* PS = (LAS float*)(F.lds + AL_PS) + wave * (8 * 65); LAS float* IMP = (LAS float*)(F.lds + AL_IMP);
    LAS unsigned* SM = (LAS unsigned*)(F.lds + AL_SM);
    LAS unsigned* UW = (LAS unsigned*)(F.lds + AL_UW);
    __syncthreads();
    NST(0);
    attn_fill_bias(F, g);
    for (int i = tid; i < 64 * 128; i += 512) IMP[i] = 0.f;
    if (lane < 8) PS[lane * 65] = 0.f;
    bf16x8 qf[4]; attn_load_q(F, bg, t0, qf);
    f32x4 tot[8];
    u32x4 rk[2], rv[2];
    NST(10);
    for (int dr_ = 0; dr_ < (DBG_NSA == 1 ? 2 : 1); ++dr_) {
        if (dr_ == 1) { WAVE_SYNC(); if (lane < 8) PS[lane * 65] = 0.f; WAVE_SYNC(); }
        const int ntiles = (4 * qt + 2) / 64 + 1;
        const bf16* KC = WSP(bf16, WS_KCMP) + (size_t)bg * 512 * 128; const bf16* VC = WSP(bf16, WS_VCMPT) + (size_t)bg * 128 * 512;
        float m = -1e30f, l = 0.f;
        attn_load_tile(rk, rv, KC, VC, 512, tid); attn_store_tile(F.lds, 0, rk, rv, tid); __syncthreads();
        for (int j = 0; j < ntiles; ++j) {
            if (j + 1 < ntiles) attn_load_tile(rk, rv, KC + (size_t)(j + 1) * 64 * 128, VC + (j + 1) * 64, 512, tid);
            f32x4 s[4], p[4];
            const unsigned vm = attn_scores<0>(F.lds, j & 1, qf, lane, 64 * j, tok, hg, 0u, s);
            (void)attn_online(s, vm, m, l, p);
            if (j + 1 < ntiles) attn_store_tile(F.lds, (j + 1) & 1, rk, rv, tid);
            __syncthreads();
        }
        const float il = l > 0.f ? 1.0f / l : 0.f;
        f32x4 o[8];
#pragma unroll
        for (int dt = 0; dt < 8; ++dt) o[dt] = ZERO4;
        attn_load_tile(rk, rv, KC, VC, 512, tid); attn_store_tile(F.lds, 0, rk, rv, tid); __syncthreads();
        for (int j = 0; j < ntiles; ++j) {
            if (j + 1 < ntiles) attn_load_tile(rk, rv, KC + (size_t)(j + 1) * 64 * 128, VC + (j + 1) * 64, 512, tid);
            f32x4 s[4], p[4];
            const unsigned vm = attn_scores<0>(F.lds, j & 1, qf, lane, 64 * j, tok, hg, 0u, s);
#pragma unroll
            for (int nt = 0; nt < 4; ++nt)
#pragma unroll
                for (int r = 0; r < 4; ++r) {
                    const float pv = ((vm >> (4 * nt + r)) & 1u) ? __builtin_amdgcn_exp2f(s[nt][r] - m) * il : 0.f; p[nt][r] = pv;
                    const float ps = pv + shx<8>(pv);
                    if (fr < 8) PS[fr * 65 + 1 + 16 * nt + 4 * fq + r] = ps;
                }
            WAVE_SYNC();
#pragma unroll
            for (int q = 0; q < 2; ++q) { const int idx = lane + 64 * q, tk = idx >> 4, bl = idx & 15; const LAS float* ps = PS + tk * 65 + 4 * bl;
                IMP[(8 * wave + tk) * 128 + 16 * j + bl] = ps[0] + 2.0f * ps[1] + 2.0f * ps[2] + 2.0f * ps[3] + ps[4]; }
            WAVE_SYNC();
            if (lane < 8) PS[lane * 65] = PS[lane * 65 + 64];
            WAVE_SYNC();
            attn_pv(F.lds, j & 1, lane, p, o);
            if (j + 1 < ntiles) attn_store_tile(F.lds, (j + 1) & 1, rk, rv, tid);
            __syncthreads();
        }
        const float gt = (DBG_NSAZ & 1) ? zf_ : sigmoidf_(small[row * SMW + S_BG + (2 * g + hg) * 3 + 0]);
#pragma unroll
        for (int dt = 0; dt < 8; ++dt) tot[dt] = o[dt] * gt;
    }
    NST(11);
    unsigned wum[4] = {0u, 0u, 0u, 0u};
    for (int dr_ = 0; dr_ < (DBG_NSA == 4 ? 2 : 1); ++dr_) {
        const int cur = qt;
        for (int tk = 0; tk < 8; ++tk) {
            const LAS float* rowp = IMP + (8 * wave + tk) * 128;
            const int b0 = lane, b1 = lane + 64;
            const float s0 = b0 > cur ? -1e4f : ((b0 == 0 || b0 >= cur - 1) ? 1e4f : rowp[b0]);
            const float s1 = b1 > cur ? -1e4f : ((b1 == 0 || b1 >= cur - 1) ? 1e4f : rowp[b1]);
            unsigned k0 = __builtin_bit_cast(unsigned, s0), k1 = __builtin_bit_cast(unsigned, s1);
            k0 = (k0 & 0x80000000u) ? ~k0 : (k0 | 0x80000000u); k1 = (k1 & 0x80000000u) ? ~k1 : (k1 | 0x80000000u);
            unsigned prefix = 0u; int need = 16;
            for (int bit = 31; bit >= 0; --bit) {
                const unsigned cand = (prefix | (1u << bit)) >> bit;
                const int cnt = __builtin_popcountll(__ballot((k0 >> bit) == cand)) + __builtin_popcountll(__ballot((k1 >> bit) == cand));
                if (cnt >= need) prefix |= (1u << bit); else need -= cnt;
            }
            const unsigned long long e0 = __ballot(k0 == prefix), e1 = __ballot(k1 == prefix);
            const int r0 = (int)__builtin_amdgcn_mbcnt_hi((unsigned)(e0 >> 32), __builtin_amdgcn_mbcnt_lo((unsigned)e0, 0u));
            const int r1 = __builtin_popcountll(e0) + (int)__builtin_amdgcn_mbcnt_hi((unsigned)(e1 >> 32), __builtin_amdgcn_mbcnt_lo((unsigned)e1, 0u));
            const bool sel0 = k0 > prefix || (k0 == prefix && r0 < need), sel1 = k1 > prefix || (k1 == prefix && r1 < need);
            const unsigned long long m0 = __ballot(sel0), m1 = __ballot(sel1);
            const unsigned w0 = (unsigned)m0, w1 = (unsigned)(m0 >> 32), w2 = (unsigned)m1, w3 = (unsigned)(m1 >> 32);
            wum[0] |= w0; wum[1] |= w1; wum[2] |= w2; wum[3] |= w3;
            if (lane == 0) { SM[(8 * wave + tk) * 4 + 0] = w0; SM[(8 * wave + tk) * 4 + 1] = w1; SM[(8 * wave + tk) * 4 + 2] = w2; SM[(8 * wave + tk) * 4 + 3] = w3; }
        }
        if (lane == 0) { UW[wave * 4 + 0] = wum[0]; UW[wave * 4 + 1] = wum[1]; UW[wave * 4 + 2] = wum[2]; UW[wave * 4 + 3] = wum[3]; }
    }
    __syncthreads();
    const u32x4 smw = *(const LAS u32x4*)(SM + (8 * wave + (fr & 7)) * 4);
    unsigned um[4];
#pragma unroll
    for (int w = 0; w < 4; ++w) { unsigned v = 0u;
#pragma unroll
        for (int q = 0; q < 8; ++q) v |= UW[q * 4 + w];
        um[w] = __builtin_amdgcn_readfirstlane(v); }
    const bf16* KS = WSP(bf16, WS_KS) + (size_t)bg * SEQ * 128; const bf16* VS = WSP(bf16, WS_VST) + (size_t)bg * 128 * 8192;
    const bf16* KW = WSP(bf16, WS_KW) + (size_t)bg * SEQ * 128; const bf16* VW = WSP(bf16, WS_VWT) + (size_t)bg * 128 * 8192;
    NST(12);
    for (int dr_ = 0; dr_ < (DBG_NSA == 2 ? 2 : 1); ++dr_) {
        float m = -1e30f, l = 0.f; f32x4 o[8];
#pragma unroll
        for (int dt = 0; dt < 8; ++dt) o[dt] = ZERO4;
        u32x4 rk2[2], rv2[2];
        int j = 0, jn = sel_next(0, qt, um), cb = 0;
        attn_load_tile(rk, rv, KS, VS, 64, tid); attn_store_tile(F.lds, 0, rk, rv, tid);
        if (jn <= qt) attn_load_tile(rk, rv, KS + (size_t)jn * 64 * 128, VS + (size_t)jn * 128 * 64, 64, tid);
        __syncthreads();
        while (j <= qt) {
            int jnn = jn <= qt ? sel_next(jn, qt, um) : jn;
            sel_step(F, KS, VS, j, jn, jnn, qt, cb, rk, rv, rk2, rv2, qf, smw, wum, tok, hg, m, l, o);
            cb ^= 1; j = jn; jn = jnn;
            if (j > qt) break;
            jnn = jn <= qt ? sel_next(jn, qt, um) : jn;
            sel_step(F, KS, VS, j, jn, jnn, qt, cb, rk2, rv2, rk, rv, qf, smw, wum, tok, hg, m, l, o);
            cb ^= 1; j = jn; jn = jnn;
        }
        const float gt = ((DBG_NSA == 2 && dr_ == 0) || (DBG_NSAZ & 2)) ? zf_ * l : sigmoidf_(small[row * SMW + S_BG + (2 * g + hg) * 3 + 1]) / l;
#pragma unroll
        for (int dt = 0; dt < 8; ++dt) tot[dt] = tot[dt] + o[dt] * gt;
    }
    NST(13);
    for (int dr_ = 0; dr_ < (DBG_NSA == 3 ? 2 : 1); ++dr_) {
        float m = -1e30f, l = 0.f; f32x4 o[8];
#pragma unroll
        for (int dt = 0; dt < 8; ++dt) o[dt] = ZERO4;
        const int j0 = qt >= 8 ? qt - 8 : 0;
        attn_load_tile(rk, rv, KW + (size_t)j0 * 64 * 128, VW + (size_t)j0 * 128 * 64, 64, tid); attn_store_tile(F.lds, 0, rk, rv, tid); __syncthreads();
        for (int j = j0; j <= qt; ++j) {
            const int cb = (j - j0) & 1;
            if (j + 1 <= qt) attn_load_tile(rk, rv, KW + (size_t)(j + 1) * 64 * 128, VW + (size_t)(j + 1) * 128 * 64, 64, tid);
            f32x4 s[4], p[4];
            const unsigned vm = (j >= qt - 7 && j < qt) ? attn_scores<2, 2>(F.lds, cb, qf, lane, 64 * j, tok, hg, 0u, s) : attn_scores<2, 0>(F.lds, cb, qf, lane, 64 * j, tok, hg, 0u, s);
            const float sc = attn_online(s, vm, m, l, p);
#pragma unroll
            for (int dt = 0; dt < 8; ++dt) o[dt] = o[dt] * sc;
            attn_pv(F.lds, cb, lane, p, o);
            if (j + 1 <= qt) attn_store_tile(F.lds, cb ^ 1, rk, rv, tid);
            __syncthreads();
        }
        const float gt = ((DBG_NSA == 3 && dr_ == 0) || (DBG_NSAZ & 4)) ? zf_ * l : sigmoidf_(small[row * SMW + S_BG + (2 * g + hg) * 3 + 2]) / l;
#pragma unroll
        for (int dt = 0; dt < 8; ++dt) tot[dt] = tot[dt] + o[dt] * gt;
    }
    NST(14);
    {
        bf16* YC = WSP(bf16, WS_YCAT);
#pragma unroll
        for (int dt = 0; dt < 8; ++dt) { const int cidx = (2 * g + hg) * 128 + 16 * dt + 4 * fq;
            f32x4 y = tot[dt]; if (DBG_ZERO & 2) y = ZERO4;
            u32x2 w; w.x = pk2(y[0], y[1]); w.y = pk2(y[2], y[3]); *(u32x2*)(YC + row * 2048 + 512 + cidx) = w; }
    }
    __syncthreads();
    NST(15);
}
#undef NST

DEV void gdn_scan_job(Frame& F, int job) {
    const int bh = job >> 3, sl = job & 7, b = bh >> 2, h = bh & 3, lane = F.lane, wave = F.wave, fq = lane >> 4, fr = lane & 15;
    LAS bf16* St = (LAS bf16*)F.lds;
    LAS bf16* Vn = St + 16 * 136;
    const float* GL = WSP(float, WS_GL); float* GO = WSP(float, WS_GO);
    const float zf_ = opaque_zero();
    __syncthreads();
    for (int i = F.tid; i < 16 * 136 / 2; i += 512) ((LAS unsigned*)St)[i] = 0u;
    f32x4 S = ZERO4;
    const int mt = wave & 3;
    __syncthreads();
    const int o1 = (wave < 4 ? 0 : 8192) + (16 * mt + fr) * 128 + 8 * fq;
    const int oA = 32768 + (16 * mt + fr) * 64 + 8 * fq;
    const int oK = 16384 + (16 * wave + fr) * 64 + 8 * fq;
    const int oU = 24576 + (16 * sl + fr) * 64 + 16 * mt + 4 * fq;
    const bf16* rec = (const bf16*)(F.ws + WS_GW + (size_t)(bh * 128) * GDN_CH_BYTES);
    bf16x8 a1A[4], aAA[2], aKA[2], a1B[4], aAB[2], aKB[2], a1C[4], aAC[2], aKC[2]; u32x2 uuA, uuB, uuC; float glA, glB, glC;
#define GLOAD(A1, AA, AK, UU, G, c_) do { const bf16* r_ = rec + (size_t)(c_) * (GDN_CH_BYTES / 2); \
        _Pragma("unroll") for (int ks = 0; ks < 4; ++ks) A1[ks] = *(const bf16x8*)(r_ + o1 + 32 * ks); \
        AA[0] = *(const bf16x8*)(r_ + oA); AA[1] = *(const bf16x8*)(r_ + oA + 32); AK[0] = *(const bf16x8*)(r_ + oK); AK[1] = *(const bf16x8*)(r_ + oK + 32); \
        UU = *(const u32x2*)(r_ + oU); G = GL[bh * 128 + (c_)]; } while (0)
#define GSTEP(a1, aA, aK, uu, gl, n1, nA, nK, nu, ngl, c_) do { \
        { const int cn_ = (c_) + 2 < 128 ? (c_) + 2 : 127; GLOAD(n1, nA, nK, nu, ngl, cn_); } \
          \
        f32x4 d1 = ZERO4; \
        _Pragma("unroll") for (int ks = 0; ks < 4; ++ks) d1 = mfma16(a1[ks], frag_l(St, 136, 0, 32 * ks, lane), d1); \
        if (wave < 4) { \
            const float v0 = bflo(uu.x) - d1[0], v1 = bfhi(uu.x) - d1[1], v2 = bflo(uu.y) - d1[2], v3 = bfhi(uu.y) - d1[3]; \
            u32x2 w; w.x = pk2(v0, v1); w.y = pk2(v2, v3); \
            *(LAS u32x2*)(Vn + fr * 72 + 16 * mt + 4 * fq) = w; \
        } \
        LDS_WAIT(); __builtin_amdgcn_s_barrier(); CFENCE(); \
          \
        const bf16x8 bv0 = frag_l(Vn, 72, 0, 0, lane), bv1 = frag_l(Vn, 72, 0, 32, lane); \
        if (wave >= 4) { \
            d1 = mfma16(aA[0], bv0, d1); d1 = mfma16(aA[1], bv1, d1); \
            _Pragma("unroll") for (int r = 0; r < 4; ++r) GO[(size_t)(b * SEQ + 64 * (c_) + 16 * mt + 4 * fq + r) * 512 + h * 128 + 16 * sl + fr] = d1[r]; \
        } \
        f32x4 dk = ZERO4; \
        dk = mfma16(aK[0], bv0, dk); dk = mfma16(aK[1], bv1, dk); \
        S = S * gl + dk; \
        { u32x2 w; w.x = pk2(S[0], S[1]); w.y = pk2(S[2], S[3]); *(LAS u32x2*)(St + fr * 136 + 16 * wave + 4 * fq) = w; } \
        LDS_WAIT(); __builtin_amdgcn_s_barrier(); CFENCE(); } while (0)
    GLOAD(a1A, aAA, aKA, uuA, glA, 0); GLOAD(a1B, aAB, aKB, uuB, glB, 1);
    for (int c = 0; c < 128; c += 3) {
        GSTEP(a1A, aAA, aKA, uuA, glA, a1C, aAC, aKC, uuC, glC, c);
        if (c + 1 < 128) GSTEP(a1B, aAB, aKB, uuB, glB, a1A, aAA, aKA, uuA, glA, c + 1);
        if (c + 2 < 128) GSTEP(a1C, aAC, aKC, uuC, glC, a1B, aAB, aKB, uuB, glB, c + 2);
    }
#undef GSTEP
#undef GLOAD
    __syncthreads();
}

DEV void ssd_scan_part(Frame& F, int part, int nparts) {
    float* __restrict__ SST = WSP(float, WS_SST); const float* __restrict__ SCD = WSP(float, WS_SCD);
    constexpr int PER_B = 16 * 64 * 128;
    for (int e = part * 512 + F.tid; e < 2 * PER_B; e += nparts * 512) {
        const int b = e / PER_B, r = e - b * PER_B, h = r >> 13;
        float* p = SST + (size_t)(b * 64) * PER_B + r; const float* cdp = SCD + (b * 64) * 16 + h;
        float s = 0.f;
#pragma unroll
        for (int hb = 0; hb < 2; ++hb) {
            float v[32], cd[32];
#pragma unroll
            for (int c = 0; c < 32; ++c) { v[c] = p[(size_t)(32 * hb + c) * PER_B]; cd[c] = cdp[(32 * hb + c) * 16]; }
#pragma unroll
            for (int c = 0; c < 32; ++c) { p[(size_t)(32 * hb + c) * PER_B] = s; s = s * cd[c] + v[c]; }
        }
    }
}

DEV void gdn_final_rows(Frame& F, int l, int w0, int nw) {
    const float* GO = WSP(float, WS_GO); const bf16* p1 = WSP(bf16, WS_P1); bf16* YC = WSP(bf16, WS_YCAT); const float* gn = lin(F, I_GNORM, l, 128);
    const int lane = F.lane, dv0 = (lane & 15) * 8;
    float gv[8];
#pragma unroll
    for (int j = 0; j < 8; ++j) gv[j] = gn[dv0 + j];
    for (int row = w0; row < MTOK; row += nw) {
        const f32x4 a = *(const f32x4*)(GO + (size_t)row * 512 + lane * 8), bq = *(const f32x4*)(GO + (size_t)row * 512 + lane * 8 + 4);
        float ss = (a[0] * a[0] + a[1] * a[1]) + (a[2] * a[2] + a[3] * a[3]) + (bq[0] * bq[0] + bq[1] * bq[1]) + (bq[2] * bq[2] + bq[3] * bq[3]);
        ss = sum16(ss);
        const float rs = rsqrtf(ss * (1.0f / 128.0f) + EPS);
        const u32x4 zw = *(const u32x4*)(p1 + (size_t)row * P1W + C_AZ + lane * 8);
        const float z[8] = {bflo(zw.x), bfhi(zw.x), bflo(zw.y), bfhi(zw.y), bflo(zw.z), bfhi(zw.z), bflo(zw.w), bfhi(zw.w)};
        const float o[8] = {a[0], a[1], a[2], a[3], bq[0], bq[1], bq[2], bq[3]};
        float y[8];
#pragma unroll
        for (int j = 0; j < 8; ++j) y[j] = (DBG_ZERO & 1) ? opaque_zero() : o[j] * rs * gv[j] * siluf_(z[j]);
        u32x4 w; w.x = pk2(y[0], y[1]); w.y = pk2(y[2], y[3]); w.z = pk2(y[4], y[5]); w.w = pk2(y[6], y[7]);
        *(u32x4*)(YC + (size_t)row * 2048 + lane * 8) = w;
    }
}

DEV void ssd_out_job(Frame& F, int l, int job) {
    const int b = job >> 7, c = (job >> 1) & 63, g = job & 1, t0 = 128 * c, tid = F.tid, lane = F.lane, wave = F.wave, fq = lane >> 4, fr = lane & 15;
    const bf16* SX = WSP(bf16, WS_SX); const bf16* p1 = WSP(bf16, WS_P1); const float* SDT = WSP(float, WS_SDT); const float* SAC = WSP(float, WS_SAC); const float* SST = WSP(float, WS_SST);
    bf16* YC = WSP(bf16, WS_YCAT); float* RC = WSP(float, WS_SRC);
    const float zf_ = opaque_zero();
    LAS bf16* Cs = (LAS bf16*)F.lds;
    LAS bf16* Bs = Cs + 128 * 136;
    LAS bf16* XdT = Bs + 128 * 136;
    LAS bf16* SiT = XdT + 64 * 136;
    LAS bf16* Pw = SiT + 64 * 136;
    LAS float* acs = (LAS float*)(Pw + 8 * 16 * 136);
    __syncthreads();
    for (int i = tid; i < 2 * 128 * 16; i += 512) { const int v = i >> 11, r = (i >> 4) & 127, c8 = (i & 15) * 8;
        const u32x4 w = *(const u32x4*)(SX + (size_t)(b * SEQ + t0 + r) * 1536 + 1024 + (v ? 256 : 0) + g * 128 + c8);
        *(LAS u32x4*)((v ? Cs : Bs) + r * 136 + c8) = w; }
    for (int i = tid; i < 1024; i += 512) { const size_t row = (size_t)(b * SEQ + t0 + (i >> 3)); acs[i] = SAC[row * 16 + 8 * g + (i & 7)]; }
    __syncthreads();
    f32x4 cb[8];
    {
        bf16x8 ca[4];
#pragma unroll
        for (int ks = 0; ks < 4; ++ks) ca[ks] = frag_l(Cs, 136, 16 * wave, 32 * ks, lane);
#pragma unroll
        for (int nt = 0; nt < 8; ++nt) { cb[nt] = ZERO4;
#pragma unroll
            for (int ks = 0; ks < 4; ++ks) cb[nt] = mfma16(ca[ks], frag_l(Bs, 136, 16 * nt, 32 * ks, lane), cb[nt]); }
    }
    float ssq = 0.f;
    LAS bf16* pw = Pw + wave * 16 * 136;
    const float* dsk = lin(F, I_SD, l, 16);
    const int sp = tid & 7, tp = tid >> 3; const size_t rp0 = (size_t)(b * SEQ + t0 + 2 * tp);
    const size_t rowl = (size_t)(b * SEQ + t0 + 16 * wave + fr);
    u32x4 x0, x1; float d0, d1; f32x4 sv[4];
#define SSD_LOADH(h_) do { x0 = *(const u32x4*)(SX + rp0 * 1536 + (h_) * 64 + 8 * sp); x1 = *(const u32x4*)(SX + (rp0 + 1) * 1536 + (h_) * 64 + 8 * sp); d0 = SDT[rp0 * 16 + (h_)]; d1 = SDT[(rp0 + 1) * 16 + (h_)]; \
        const float* sin_ = SST + ((size_t)((b * 64 + c) * 16 + (h_)) * 64) * 128; _Pragma("unroll") for (int q = 0; q < 4; ++q) sv[q] = *(const f32x4*)(sin_ + (size_t)(tid + 512 * q) * 4); } while (0)
    SSD_LOADH(8 * g);
    for (int hh = 0; hh < 8; ++hh) {
        const int h = 8 * g + hh;
        __syncthreads();
        {
            const unsigned xw0[4] = {x0.x, x0.y, x0.z, x0.w}, xw1[4] = {x1.x, x1.y, x1.z, x1.w};
#pragma unroll
            for (int j = 0; j < 8; ++j) { const float a = ((j & 1) ? bfhi(xw0[j >> 1]) : bflo(xw0[j >> 1])) * d0, bb = ((j & 1) ? bfhi(xw1[j >> 1]) : bflo(xw1[j >> 1])) * d1;
                *(LAS unsigned*)(XdT + (8 * sp + j) * 136 + 2 * tp) = pk2(a, bb); }
#pragma unroll
            for (int q = 0; q < 4; ++q) { const int i = tid + 512 * q, p = i >> 5, n4 = (i & 31) * 4; u32x2 w; w.x = pk2(sv[q][0], sv[q][1]); w.y = pk2(sv[q][2], sv[q][3]); *(LAS u32x2*)(SiT + p * 136 + n4) = w; }
        }
        float al[4];
#pragma unroll
        for (int r = 0; r < 4; ++r) al[r] = acs[(16 * wave + 4 * fq + r) * 8 + hh];
#pragma unroll
        for (int nt = 0; nt < 8; ++nt) { const int s = 16 * nt + fr; const float as = acs[s * 8 + hh];
#pragma unroll
            for (int r = 0; r < 4; ++r) { const int li = 16 * wave + 4 * fq + r; const float v = s <= li ? cb[nt][r] * __expf(al[r] - as) : 0.f; pw[(4 * fq + r) * 136 + s] = (bf16)f2bf(v); } }
        u32x2 xv[4], zv[4];
#pragma unroll
        for (int nt = 0; nt < 4; ++nt) { xv[nt] = *(const u32x2*)(SX + rowl * 1536 + h * 64 + 16 * nt + 4 * fq); zv[nt] = *(const u32x2*)(p1 + rowl * P1W + C_CZ + h * 64 + 16 * nt + 4 * fq); }
        if (hh + 1 < 8) SSD_LOADH(h + 1);
        __syncthreads();
        f32x4 y[4], ys[4];
#pragma unroll
        for (int nt = 0; nt < 4; ++nt) { y[nt] = ZERO4; ys[nt] = ZERO4; }
#pragma unroll
        for (int ks = 0; ks < 4; ++ks) { const bf16x8 pa = frag_l(pw, 136, 0, 32 * ks, lane), cc = frag_l(Cs, 136, 16 * wave, 32 * ks, lane);
#pragma unroll
            for (int nt = 0; nt < 4; ++nt) { y[nt] = mfma16(frag_l(XdT, 136, 16 * nt, 32 * ks, lane), pa, y[nt]); ys[nt] = mfma16(frag_l(SiT, 136, 16 * nt, 32 * ks, lane), cc, ys[nt]); } }
        const float dh = dsk[h], ea = __expf(acs[(16 * wave + fr) * 8 + hh]);
#pragma unroll
        for (int nt = 0; nt < 4; ++nt) {
            const float xs[4] = {bflo(xv[nt].x), bfhi(xv[nt].x), bflo(xv[nt].y), bfhi(xv[nt].y)}, zz[4] = {bflo(zv[nt].x), bfhi(zv[nt].x), bflo(zv[nt].y), bfhi(zv[nt].y)};
            float v[4];
#pragma unroll
            for (int r = 0; r < 4; ++r) { v[r] = (DBG_ZERO & 4) ? zf_ : (y[nt][r] + ea * ys[nt][r] + xs[r] * dh) * siluf_(zz[r]); ssq += v[r] * v[r]; }
            u32x2 w; w.x = pk2(v[0], v[1]); w.y = pk2(v[2], v[3]); *(u32x2*)(YC + rowl * 2048 + 1024 + h * 64 + 16 * nt + 4 * fq) = w;
        }
    }
#undef SSD_LOADH
    { float s = ssq; s += shx<16>(s); s += shx<32>(s); if (fq == 0) RC[rowl * 2 + g] = rsqrtf(s * (1.0f / 512.0f) + EPS); }
    __syncthreads();
}

constexpr int NPH = 12;
#ifndef CPU_EMU
DEV unsigned long long launder64(unsigned long long v) {
    unsigned lo = __builtin_amdgcn_readfirstlane((unsigned)v), hi = __builtin_amdgcn_readfirstlane((unsigned)(v >> 32));
    asm volatile("" : "+s"(lo), "+s"(hi));
    return ((unsigned long long)hi << 32) | lo;
}
DEV bool phase_begin(Frame& F, const Params& prm, int wave0) {
    F.ws = (unsigned char*)launder64((unsigned long long)prm.ws);
    F.p = (KParams)launder64((unsigned long long)__builtin_amdgcn_kernarg_segment_ptr());
    unsigned z = 0u; asm volatile("" : "+v"(z)); const int ln = (int)__builtin_amdgcn_mbcnt_hi(~0u, __builtin_amdgcn_mbcnt_lo(~0u, z));
    int wv = wave0; asm volatile("" : "+s"(wv)); F.wave = wv; F.lane = ln; F.tid = wv * 64 + ln;
    int bi = __builtin_amdgcn_readfirstlane(blockIdx.x); asm volatile("" : "+s"(bi)); F.bid = bi;
    int gg = __builtin_amdgcn_readfirstlane(gridDim.x); asm volatile("" : "+s"(gg)); F.G = gg;
    unsigned la = __builtin_amdgcn_readfirstlane((unsigned)(size_t)F.lds); asm volatile("" : "+s"(la)); F.lds = (LAS unsigned char*)(size_t)la;
    return true;
}
DEV void job_begin(Frame& F) { int t = F.tid; asm volatile("" : "+v"(t)); F.tid = t; F.lane = t & 63; }
__global__ void __launch_bounds__(512, 2) hybrid_fwd(Params prm) {
    extern __shared__ __attribute__((aligned(16))) unsigned char lds_raw[];
    Frame F;
    F.lds = (LAS unsigned char*)lds_raw; F.tid = threadIdx.x; F.lane = F.tid & 63; F.wave = __builtin_amdgcn_readfirstlane(F.tid >> 6);
    const int wave0 = F.wave;
    F.G = gridDim.x; F.bid = blockIdx.x; F.p = (KParams)__builtin_amdgcn_kernarg_segment_ptr(); F.ws = prm.ws;
    volatile LAS unsigned* MISC = (volatile LAS unsigned*)(F.lds + MISC_OFF);
    if (F.tid < 64) MISC[F.tid] = 0u;
    if (DBG_TMASK && F.tid < 8) MISC[64 + F.tid] = 0u;
    __syncthreads();
    unsigned* ctl = (unsigned*)(F.ws + WS_CTL);
    XcdBarrier bar; bar.bar = ctl + CW_BAR; bar.x = 0; bar.st = nullptr;
    if (prm.use_bar) bar = xcd_barrier_post(ctl + CW_BAR, MISC + 8);
    const int lo = prm.lo, hi = prm.hi;
    for (int l = 0; l < DEPTH; ++l) {
#define IN(k) (lo <= l * NPH + (k) && l * NPH + (k) < hi && phase_begin(F, prm, wave0))
#define REP_BEGIN(k) for (int rep_ = 0; rep_ < ((DBG_REP == (k)) ? 2 : 1); ++rep_) {
#define REP_END(k) if (DBG_REP == (k) && rep_ == 0) { XcdBarrier bb_ = bar; bb_.bar = (unsigned*)launder64((unsigned long long)bar.bar); xcd_barrier(bb_); } }
#define SEAM(k) do { if (l * NPH + (k) + 1 < hi && prm.use_bar) { XcdBarrier bb_ = bar; bb_.bar = (unsigned*)launder64((unsigned long long)bar.bar); { unsigned x_ = __builtin_amdgcn_readfirstlane(bar.x); asm volatile("" : "+s"(x_)); bb_.x = x_; } xcd_barrier(bb_); } } while (0)
#define TB(k) do { if (((DBG_TMASK >> (k)) & 1) && F.bid == 0 && F.tid == 0) { volatile LAS unsigned* m_ = (volatile LAS unsigned*)(F.lds + MISC_OFF); m_[64] = (unsigned)__builtin_amdgcn_s_memrealtime(); m_[68] = 1u; } } while (0)
#define TE(k) do { if (((DBG_TMASK >> (k)) & 1) && F.bid == 0 && F.tid == 0) { volatile LAS unsigned* m_ = (volatile LAS unsigned*)(F.lds + MISC_OFF); if (!DBG_TEPI) m_[66] = m_[66] + ((unsigned)__builtin_amdgcn_s_memrealtime() - m_[64]); m_[68] = 0u; } } while (0)
#define JT(ty, call) do { if (DBG_AJOB == (ty) && F.tid == 0) { volatile LAS unsigned* m_ = (volatile LAS unsigned*)(F.lds + MISC_OFF); m_[70] = (unsigned)__builtin_amdgcn_s_memrealtime(); } \
        call; if (DBG_AJOB == (ty) && F.tid == 0) { volatile LAS unsigned* m_ = (volatile LAS unsigned*)(F.lds + MISC_OFF); atomicAdd(WSP(unsigned, WS_CTL) + 460000, (unsigned)__builtin_amdgcn_s_memrealtime() - m_[70]); } } while (0)
#define RSB(i) (WSP(unsigned long long, WS_CTL) + CW_RS / 2 + (size_t)(3 * l + (i)) * MTOK)
#define XB WSP(bf16, WS_XB)
#define ACT WSP(bf16, WS_ACT)
        if (IN(0)) { TB(0); REP_BEGIN(0) phase_convert(F, l); REP_END(0) SEAM(0); TE(0); }
        if (IN(1)) { TB(1); REP_BEGIN(1) pg8::Gemm g{XB, WSP(bf16, WS_WUP1), MTOK, NUP, DM, DM, DM}; pg8::StaticOrder S; S.init(MTOK, NUP, F.G, F.bid);
            pg8::EpiSwiGLU E{ACT, RSB(0)}; pg8::gemm_phase<pg8::EpiSwiGLU, pg8::StaticOrder>(F.lds, F.tid, g, S, E); REP_END(1) SEAM(1); TE(1); }
        if (IN(2)) { TB(2); pg8::Gemm g{ACT, WSP(bf16, WS_WDN1), MTOK, DM, DFF, DFF, DFF}; pg8::StaticOrder S; S.init(MTOK, DM, F.G, F.bid);
            pg8::EpiResidual E{prm.out, XB, RSB(1), 0.5f}; pg8::gemm_phase<pg8::EpiResidual, pg8::StaticOrder>(F.lds, F.tid, g, S, E); SEAM(2); TE(2); }
        if (IN(3)) { TB(3); REP_BEGIN(3) pg8::Gemm g{XB, WSP(bf16, WS_WIN), MTOK, NINP, DM, DM, DM}; pg8::StaticOrder S; S.init(MTOK, NINP, F.G, F.bid);
            pg8::EpiWin E{WSP(bf16, WS_P1), WSP(float, WS_SMALL), WSP(bf16, WS_GATE), RSB(1)}; pg8::gemm_phase<pg8::EpiWin, pg8::StaticOrder>(F.lds, F.tid, g, S, E); REP_END(3) SEAM(3); TE(3); }
        if (IN(4)) { TB(4);
            REP_BEGIN(4)
            {
                unsigned* ctr = WSP(unsigned, WS_CTL) + CW_WQ + 64 * (8 + l * 2 + rep_);
                LAS unsigned* jslot = (LAS unsigned*)(F.lds + MISC_OFF + 128);
                for (;;) {
                    __syncthreads();
                    if (F.tid == 0) *jslot = __hip_atomic_fetch_add(ctr, 1u, __ATOMIC_RELAXED, __HIP_MEMORY_SCOPE_AGENT);
                    __syncthreads();
                    const int j = (int)*jslot;
                    if (j >= 32 + 1024 + 256 + 512) break;
                    job_begin(F);
                    if (j < 32) JT(1, nsa_compress_job(F, l, j));
                    else if (j < 32 + 256) JT(2, ssd_prep_job(F, l, j - 32));
                    else if (j < 32 + 256 + 1024) JT(3, gdn_prep_job(F, l, j - 32 - 256));
                    else JT(4, nsa_prep_job(F, l, j - 32 - 256 - 1024));
                }
            }
            REP_END(4)
            SEAM(4); TE(4);
        }
        if (IN(5)) { TB(5);
            REP_BEGIN(5)
            if (F.bid < 64) JT(6, gdn_scan_job(F, (F.bid & 7) * 8 + (F.bid >> 3)));
            else if (rep_ == 0) JT(7, ssd_scan_part(F, F.bid - 64, F.G - 64));
            {
                unsigned* ctr = WSP(unsigned, WS_CTL) + CW_WQ + 64 * (16 + (l * 2 + rep_) * 8);
                LAS unsigned* jslot = (LAS unsigned*)(F.lds + MISC_OFF + 128);
                const unsigned myq = xb_xcc_id() & 7u;
                for (;;) {
                    __syncthreads();
                    if (F.tid == 0) {
                        unsigned got = 0xffffffffu;
                        for (unsigned t = 0; t < 8u && got == 0xffffffffu; ++t) { const unsigned q = (myq + t) & 7u;
                            if (__hip_atomic_load(ctr + 64 * q, __ATOMIC_RELAXED, __HIP_MEMORY_SCOPE_AGENT) >= 64u) continue;
                            const unsigned k = __hip_atomic_fetch_add(ctr + 64 * q, 1u, __ATOMIC_RELAXED, __HIP_MEMORY_SCOPE_AGENT);
                            if (k < 64u) got = (q >> 1) * 128u + (127u - (2u * k + (q & 1u))); }
                        *jslot = got;
                    }
                    __syncthreads();
                    const unsigned j = *jslot;
                    if (j == 0xffffffffu) break;
                    job_begin(F);
                    JT(5, nsa_job(F, (int)j));
                }
            }
            REP_END(5)
            SEAM(5); TE(5);
        }
        if (IN(7)) { TB(7);
            REP_BEGIN(7)
            for (int j = F.bid; j < 256; j += F.G) { job_begin(F); JT(8, ssd_out_job(F, l, j)); }
            job_begin(F);
            JT(9, gdn_final_rows(F, l, F.bid * 8 + F.wave, F.G * 8));
            REP_END(7)
            SEAM(7); TE(7);
        }
        if (IN(8)) { TB(8); REP_BEGIN(8) pg8::Gemm g{WSP(bf16, WS_YCAT), WSP(bf16, WS_WPM), MTOK, DM, 512, DM, DM}; pg8::SegOrder S; S.init(MTOK, DM, F.G, F.bid, 512);
            pg8::EpiMergeSeg E{WSP(bf16, WS_MERGED), WSP(bf16, WS_GATE), WSP(float, WS_SRC)}; pg8::gemm_phase<pg8::EpiMergeSeg, pg8::SegOrder>(F.lds, F.tid, g, S, E); REP_END(8) SEAM(8); TE(8); }
        if (IN(9)) { TB(9); pg8::Gemm g{WSP(bf16, WS_MERGED), WSP(bf16, WS_WO), MTOK, DM, DM, DM, DM}; pg8::StaticOrder S; S.init(MTOK, DM, F.G, F.bid);
            pg8::EpiResidual E{prm.out, XB, RSB(2), 1.0f}; pg8::gemm_phase<pg8::EpiResidual, pg8::StaticOrder>(F.lds, F.tid, g, S, E); SEAM(9); TE(9); }
        if (IN(10)) { TB(10); pg8::Gemm g{XB, WSP(bf16, WS_WUP2), MTOK, NUP, DM, DM, DM}; pg8::StaticOrder S; S.init(MTOK, NUP, F.G, F.bid);
            pg8::EpiSwiGLU E{ACT, RSB(2)}; pg8::gemm_phase<pg8::EpiSwiGLU, pg8::StaticOrder>(F.lds, F.tid, g, S, E); SEAM(10); TE(10); }
        if (IN(11)) { TB(11); pg8::Gemm g{ACT, WSP(bf16, WS_WDN2), MTOK, DM, DFF, DFF, DFF}; pg8::StaticOrder S; S.init(MTOK, DM, F.G, F.bid);
            pg8::EpiResidual E{prm.out, XB, RSB(3), 0.5f}; pg8::gemm_phase<pg8::EpiResidual, pg8::StaticOrder>(F.lds, F.tid, g, S, E); SEAM(11); TE(11); }
#undef IN
#undef SEAM
#undef TB
#undef JT
#undef TE
#undef REP_BEGIN
#undef REP_END
#undef RSB
#undef XB
#undef ACT
    }
    if (DBG_AJOB) {
        XcdBarrier bb_ = bar; bb_.bar = (unsigned*)launder64((unsigned long long)bar.bar); xcd_barrier(bb_);
        if (blockIdx.x == 0 && wave0 == 0 && __builtin_amdgcn_mbcnt_hi(~0u, __builtin_amdgcn_mbcnt_lo(~0u, 0u)) == 0u) {
            const unsigned a_ = __hip_atomic_load((unsigned*)(prm.ws + WS_CTL) + 460000, __ATOMIC_RELAXED, __HIP_MEMORY_SCOPE_AGENT); const unsigned t0_ = (unsigned)__builtin_amdgcn_s_memrealtime();
            while ((unsigned)__builtin_amdgcn_s_memrealtime() - t0_ < a_ / 32u) __builtin_amdgcn_s_sleep(32);
        }
    }
    if (DBG_TMASK && blockIdx.x == 0 && wave0 == 0 && __builtin_amdgcn_mbcnt_hi(~0u, __builtin_amdgcn_mbcnt_lo(~0u, 0u)) == 0u) {
        volatile LAS unsigned* m_ = (volatile LAS unsigned*)(F.lds + MISC_OFF); const unsigned a_ = m_[66]; const unsigned t0_ = (unsigned)__builtin_amdgcn_s_memrealtime();
        while ((unsigned)__builtin_amdgcn_s_memrealtime() - t0_ < (unsigned)DBG_TAMP * a_) __builtin_amdgcn_s_sleep(32);
    }
}

#ifndef DBG_DUMP
#define DBG_DUMP 0
#endif
#ifndef DBG_STOP
#define DBG_STOP 48
#endif
__global__ void dbg_dump_bf16(const unsigned short* src, size_t n, float* out, size_t nout) {
    for (size_t i = (size_t)blockIdx.x * blockDim.x + threadIdx.x; i < nout; i += (size_t)gridDim.x * blockDim.x) { float s = 0.f; for (size_t k = i; k < n; k += nout) s += __builtin_bit_cast(float, (unsigned)src[k] << 16); out[i] = s; }
}
__global__ void dbg_dump_f32(const float* src, size_t n, float* out, size_t nout) {
    for (size_t i = (size_t)blockIdx.x * blockDim.x + threadIdx.x; i < nout; i += (size_t)gridDim.x * blockDim.x) { float s = 0.f; for (size_t k = i; k < n; k += nout) s += src[k]; out[i] = s; }
}
#ifndef N_LAUNCH_MODE
#define N_LAUNCH_MODE 0
#endif
extern "C" void kernel_launch(void* const* d_in, const int* in_sizes, int n_in, void* d_out, int out_size, void* d_ws, size_t ws_size, hipStream_t stream) {
    static int grid = 0;
    if (grid == 0) {
        if (n_in != 30 || out_size != MTOK * DM || ws_size < WS_END) { fprintf(stderr, "kernel_launch: unexpected shapes (n_in %d out %d ws %zu, need %zu)\n", n_in, out_size, ws_size, (size_t)WS_END); grid = -1; return; }
        int dev = 0, cus = 0, per_cu = 0;
        if (hipGetDevice(&dev) != hipSuccess || hipDeviceGetAttribute(&cus, hipDeviceAttributeMultiprocessorCount, dev) != hipSuccess) { grid = -1; return; }
        if (hipFuncSetAttribute((const void*)hybrid_fwd, hipFuncAttributeMaxDynamicSharedMemorySize, LDS_BYTES) != hipSuccess) { fprintf(stderr, "kernel_launch: hipFuncSetAttribute failed\n"); grid = -1; return; }
        if (hipOccupancyMaxActiveBlocksPerMultiprocessor(&per_cu, (const void*)hybrid_fwd, 512, LDS_BYTES) != hipSuccess || per_cu < 1) { fprintf(stderr, "kernel_launch: occupancy query says %d\n", per_cu); }
        (void)hipGetLastError();
        grid = cus;
    }
    if (grid < 0) return;
    (void)hipMemsetAsync((char*)d_ws + WS_CTL, 0, CTL_BYTES, stream);
    Params p{};
    for (int i = 0; i < 30; ++i) p.in[i] = (const float*)d_in[i];
    p.out = (float*)d_out; p.ws = (unsigned char*)d_ws; p.pad = 0;
    if (N_LAUNCH_MODE == 0) { p.lo = 0; p.hi = DEPTH * NPH; p.use_bar = 1; hipLaunchKernelGGL(hybrid_fwd, dim3(grid), dim3(512), LDS_BYTES, stream, p); }
    else { for (int ph = 0; ph < (DBG_DUMP ? DBG_STOP : DEPTH * NPH); ++ph) { p.lo = ph; p.hi = ph + 1; p.use_bar = 0; hipLaunchKernelGGL(hybrid_fwd, dim3(grid), dim3(512), LDS_BYTES, stream, p); } }
    if (DBG_DUMP) {
        const size_t nout = (size_t)MTOK * DM; char* w = (char*)d_ws;
        if (DBG_DUMP == 1) hipLaunchKernelGGL(dbg_dump_bf16, dim3(2048), dim3(256), 0, stream, (const unsigned short*)(w + WS_P1), (size_t)MTOK * P1W, (float*)d_out, nout);
        if (DBG_DUMP == 2) hipLaunchKernelGGL(dbg_dump_f32, dim3(2048), dim3(256), 0, stream, (const float*)(w + WS_SMALL), (size_t)MTOK * SMW, (float*)d_out, nout);
        if (DBG_DUMP == 3) hipLaunchKernelGGL(dbg_dump_bf16, dim3(2048), dim3(256), 0, stream, (const unsigned short*)(w + WS_GW), (size_t)1024 * GDN_CH_BYTES / 2, (float*)d_out, nout);
        if (DBG_DUMP == 4) hipLaunchKernelGGL(dbg_dump_f32, dim3(2048), dim3(256), 0, stream, (const float*)(w + WS_SST), (size_t)2 * 64 * 16 * 64 * 128, (float*)d_out, nout);
        if (DBG_DUMP == 5) hipLaunchKernelGGL(dbg_dump_f32, dim3(2048), dim3(256), 0, stream, (const float*)(w + WS_GO), (size_t)MTOK * 512, (float*)d_out, nout);
        if (DBG_DUMP == 6) hipLaunchKernelGGL(dbg_dump_bf16, dim3(2048), dim3(256), 0, stream, (const unsigned short*)(w + WS_YCAT), (size_t)MTOK * 2048, (float*)d_out, nout);
        if (DBG_DUMP == 7) hipLaunchKernelGGL(dbg_dump_bf16, dim3(2048), dim3(256), 0, stream, (const unsigned short*)(w + WS_MERGED), (size_t)MTOK * 2048, (float*)d_out, nout);
        if (DBG_DUMP == 8) hipLaunchKernelGGL(dbg_dump_bf16, dim3(2048), dim3(256), 0, stream, (const unsigned short*)(w + WS_SX), (size_t)MTOK * 1536, (float*)d_out, nout);
        if (DBG_DUMP == 9) hipLaunchKernelGGL(dbg_dump_bf16, dim3(2048), dim3(256), 0, stream, (const unsigned short*)(w + WS_GATE), (size_t)MTOK * 6144, (float*)d_out, nout);
        if (DBG_DUMP == 11) hipLaunchKernelGGL(dbg_dump_f32, dim3(2048), dim3(256), 0, stream, (const float*)(w + WS_SRC), (size_t)MTOK * 2, (float*)d_out, nout);
        if (DBG_DUMP == 12) hipLaunchKernelGGL(dbg_dump_bf16, dim3(2048), dim3(256), 0, stream, (const unsigned short*)(w + WS_WPM), (size_t)DM * DM, (float*)d_out, nout);
        if (DBG_DUMP == 13) hipLaunchKernelGGL(dbg_dump_f32, dim3(2048), dim3(256), 0, stream, (const float*)(w + WS_MTMP), (size_t)MTOK * DM, (float*)d_out, nout);
        if (DBG_DUMP == 15) hipLaunchKernelGGL(dbg_dump_bf16, dim3(2048), dim3(256), 0, stream, (const unsigned short*)(w + WS_ACT), (size_t)MTOK * DFF, (float*)d_out, nout);
        if (DBG_DUMP == 16) hipLaunchKernelGGL(dbg_dump_bf16, dim3(2048), dim3(256), 0, stream, (const unsigned short*)(w + WS_XB), (size_t)MTOK * DM, (float*)d_out, nout);
        if (DBG_DUMP == 17) hipLaunchKernelGGL(dbg_dump_bf16, dim3(2048), dim3(256), 0, stream, (const unsigned short*)(w + WS_WIN), (size_t)NINP * DM, (float*)d_out, nout);
        if (DBG_DUMP == 18) hipLaunchKernelGGL(dbg_dump_f32, dim3(2048), dim3(256), 0, stream, (const float*)(w + WS_CTL) + CW_RS, (size_t)NRS * MTOK, (float*)d_out, nout);
        if (DBG_DUMP == 10) hipLaunchKernelGGL(dbg_dump_f32, dim3(2048), dim3(256), 0, stream, (const float*)(w + WS_YB), (size_t)MTOK * 512, (float*)d_out, nout);
    }
}
#endif
```

```cpp
#include <hip/hip_runtime.h>
#include <cstdio>
#include <cstdint>

#ifndef CPU_EMU
#define DEV __device__ __forceinline__
#define LAS __attribute__((address_space(3)))
#define VM_WAIT() asm volatile("s_waitcnt vmcnt(0)" ::: "memory")
#define LDS_WAIT() asm volatile("s_waitcnt lgkmcnt(0)" ::: "memory")
#define CFENCE() asm volatile("" ::: "memory")
#define WAVE_SYNC() do { asm volatile("" ::: "memory"); __builtin_amdgcn_wave_barrier(); asm volatile("" ::: "memory"); } while (0)
#endif

#define DBG_DUMP 0
#define DBG_NSAZ 0
#define DBG_NSA 0
#define DBG_REP (-1)
#define DBG_STOP 48
#define DBG_TMASK 0
#define DBG_TAMP 8
#define DBG_AJOB 0
#define DBG_TEPI 0
#ifndef DBG_ZERO
#define DBG_ZERO 0
#endif
typedef unsigned short bf16;
typedef short bf16x8 __attribute__((ext_vector_type(8)));
typedef float f32x4 __attribute__((ext_vector_type(4)));
typedef float f32x2 __attribute__((ext_vector_type(2)));
typedef unsigned u32x4 __attribute__((ext_vector_type(4)));
typedef unsigned u32x2 __attribute__((ext_vector_type(2)));

constexpr int BATCH = 2, SEQ = 8192, DM = 2048, DEPTH = 4, DFF = 5504, NUP = 2 * DFF;
constexpr int MTOK = BATCH * SEQ;
constexpr int NIN = 12836, NINP = 13056;
constexpr int P1W = 6656;
constexpr int SM0 = 6656;
constexpr int GT0 = 6912;
constexpr float EPS = 1e-6f;
constexpr int C_AQ = 0, C_AK = 512, C_AV = 1024, C_AZ = 1536, C_BQ = 2048, C_BKC = 2560, C_BVC = 2816, C_BKS = 3072, C_BVS = 3328, C_BKW = 3584, C_BVW = 3840, C_CZ = 4096, C_CX = 5120;
constexpr int S_AA = 0, S_AB = 4, S_BG = 8, S_DT = 20, SMW = 64;

constexpr size_t MiB = 1u << 20;
constexpr size_t WS_CTL = 0, CTL_BYTES = 2 * MiB;
constexpr size_t WS_WUP1 = 2 * MiB;
constexpr size_t WS_WDN1 = WS_WUP1 + (size_t)NUP * DM * 2;
constexpr size_t WS_WIN = WS_WDN1 + (size_t)DM * DFF * 2;
constexpr size_t WS_WPM = WS_WIN + (size_t)NINP * DM * 2;
constexpr size_t WS_WO = WS_WPM + (size_t)DM * DM * 2;
constexpr size_t WS_WUP2 = WS_WO + (size_t)DM * DM * 2;
constexpr size_t WS_WDN2 = WS_WUP2 + (size_t)NUP * DM * 2;
constexpr size_t WS_WCK = WS_WDN2 + (size_t)DM * DFF * 2;
constexpr size_t WS_WCV = WS_WCK + 128 * 4096 * 2;
constexpr size_t WS_CONST = WS_WCV + 128 * 4096 * 2;
constexpr size_t WS_WEND = WS_CONST + 4096;
static_assert(WS_WEND <= 212 * MiB, "weights region");
constexpr size_t WS_XB = 212 * MiB;
constexpr size_t WS_P1 = 276 * MiB;
constexpr size_t WS_ACT = WS_P1;
constexpr size_t WS_GATE = 484 * MiB;
constexpr size_t WS_SMALL = 676 * MiB;
constexpr size_t WS_MERGED = 680 * MiB;
constexpr size_t WS_YCAT = 744 * MiB;
constexpr size_t WS_GW = 808 * MiB;
constexpr size_t GDN_CH_BYTES = 73728;
constexpr size_t WS_GL = 880 * MiB;
constexpr size_t WS_GO = 881 * MiB;
constexpr size_t WS_SX = 913 * MiB;
constexpr size_t WS_SDT = 961 * MiB;
constexpr size_t WS_SAC = 962 * MiB;
constexpr size_t WS_SST = 963 * MiB;
constexpr size_t WS_SCD = 1027 * MiB;
constexpr size_t WS_SRC = 1028 * MiB;
constexpr size_t WS_QN = 1029 * MiB;
constexpr size_t WS_KS = 1045 * MiB;
constexpr size_t WS_KW = 1053 * MiB;
constexpr size_t WS_VST = 1061 * MiB;
constexpr size_t WS_VWT = 1069 * MiB;
constexpr size_t WS_KCMP = 1077 * MiB;
constexpr size_t WS_VCMPT = 1078 * MiB;
constexpr size_t WS_SELM = 1079 * MiB;
constexpr size_t WS_YB = 1080 * MiB;
constexpr size_t WS_MTMP = 1112 * MiB;
constexpr size_t WS_END = 1240 * MiB;
static_assert(WS_P1 + (size_t)MTOK * P1W * 2 <= WS_GATE && WS_GATE + (size_t)MTOK * 6144 * 2 <= WS_SMALL && WS_SMALL + (size_t)MTOK * SMW * 4 <= WS_MERGED && WS_MERGED + (size_t)MTOK * DM * 2 <= WS_YCAT && WS_YCAT + (size_t)MTOK * 2048 * 2 <= WS_GW, "ws map 1");
static_assert(WS_GW + 1024 * GDN_CH_BYTES <= WS_GL && WS_GO + (size_t)MTOK * 512 * 4 <= WS_SX && WS_SX + (size_t)MTOK * 1536 * 2 <= WS_SDT && WS_SDT + (size_t)MTOK * 16 * 4 <= WS_SAC && WS_SAC + (size_t)MTOK * 16 * 4 <= WS_SST && WS_SST + (size_t)2 * 64 * 16 * 64 * 128 * 4 <= WS_SCD, "ws map 2");
static_assert(WS_SRC + (size_t)MTOK * 2 * 4 <= WS_QN && WS_QN + (size_t)4 * SEQ * 256 * 2 <= WS_KS && WS_KS + (size_t)4 * SEQ * 128 * 2 <= WS_KW && WS_KW + (size_t)4 * SEQ * 128 * 2 <= WS_VST && WS_VST + (size_t)4 * SEQ * 128 * 2 <= WS_VWT && WS_VWT + (size_t)4 * SEQ * 128 * 2 <= WS_KCMP, "ws map 3");
static_assert(WS_KCMP + 4 * 512 * 128 * 2 <= WS_VCMPT && WS_VCMPT + 4 * 512 * 128 * 2 <= WS_SELM && WS_SELM + (size_t)4 * SEQ * 16 <= WS_YB && WS_YB + (size_t)MTOK * 512 * 4 <= WS_END && WS_XB + (size_t)MTOK * DM * 2 <= WS_P1 && (size_t)MTOK * DFF * 2 <= (size_t)MTOK * P1W * 2, "ws map 4");

constexpr int CW_BAR = 1024;
constexpr int CW_RS = 16384;
constexpr int NRS = 13;
constexpr int CW_WQ = 8192;
static_assert(CW_RS * 4 + NRS * MTOK * 8 <= (int)CTL_BYTES, "ctl");

constexpr int RING_BYTES = 131072;
constexpr int MISC_OFF = RING_BYTES + 12288;
constexpr int LDS_BYTES = 147456;

DEV unsigned f2bf(float f) { unsigned u = __builtin_bit_cast(unsigned, f); return (u + 0x7fffu + ((u >> 16) & 1u)) >> 16; }
DEV float bf2f(unsigned b) { return __builtin_bit_cast(float, (b & 0xffffu) << 16); }
DEV unsigned pk2(float lo, float hi) { return f2bf(lo) | (f2bf(hi) << 16); }
DEV float bflo(unsigned w) { return __builtin_bit_cast(float, w << 16); }
DEV float bfhi(unsigned w) { return __builtin_bit_cast(float, w & 0xffff0000u); }
DEV float sigmoidf_(float x) { return 1.0f / (1.0f + __expf(-x)); }
DEV float siluf_(float x) { return x / (1.0f + __expf(-x)); }
DEV float softplusf_(float x) {
    const float e = __expf(-fabsf(x)), u = 1.0f + e, d = u - 1.0f;
    const float lp = d == 0.f ? e : __logf(u) * (e / d);
    return fmaxf(x, 0.f) + lp;
}
#ifndef CPU_EMU
template <int M, class T> DEV T shx(T v) {
    static_assert(sizeof(T) == 4, "shx: 32-bit values");
    const int iv = __builtin_bit_cast(int, v);
    if constexpr (M < 32) return __builtin_bit_cast(T, __builtin_amdgcn_ds_swizzle(iv, 0x1f | (M << 10)));
    else { unsigned z = 0u; asm volatile("" : "+v"(z)); const unsigned ln = __builtin_amdgcn_mbcnt_hi(~0u, __builtin_amdgcn_mbcnt_lo(~0u, z));
        return __builtin_bit_cast(T, __builtin_amdgcn_ds_bpermute((int)((ln ^ 32u) << 2), iv)); }
}
#endif
DEV float wave_sum(float v) { v += shx<1>(v); v += shx<2>(v); v += shx<4>(v); v += shx<8>(v); v += shx<16>(v); v += shx<32>(v); return v; }
DEV void wave_sum4(float (&v)[4]) {
#pragma unroll
    for (int q = 0; q < 4; ++q) v[q] += shx<1>(v[q]);
#pragma unroll
    for (int q = 0; q < 4; ++q) v[q] += shx<2>(v[q]);
#pragma unroll
    for (int q = 0; q < 4; ++q) v[q] += shx<4>(v[q]);
#pragma unroll
    for (int q = 0; q < 4; ++q) v[q] += shx<8>(v[q]);
#pragma unroll
    for (int q = 0; q < 4; ++q) v[q] += shx<16>(v[q]);
#pragma unroll
    for (int q = 0; q < 4; ++q) v[q] += shx<32>(v[q]);
}
DEV float sum16(float v) { v += shx<1>(v); v += shx<2>(v); v += shx<4>(v); v += shx<8>(v); return v; }
DEV float max16(float v) { v = fmaxf(v, shx<1>(v)); v = fmaxf(v, shx<2>(v)); v = fmaxf(v, shx<4>(v)); v = fmaxf(v, shx<8>(v)); return v; }
#ifndef CPU_EMU
DEV float opaque_zero() { float z = 0.f; asm volatile("" : "+v"(z)); return z; }
#endif
#define ZERO4 ((f32x4){zf_, zf_, zf_, zf_})
DEV f32x4 mfma16(bf16x8 a, bf16x8 b, f32x4 c) { return __builtin_amdgcn_mfma_f32_16x16x32_bf16(a, b, c, 0, 0, 0); }
DEV bf16x8 frag_g(const bf16* base, int pitch, int row0, int k0, int lane) { return *(const bf16x8*)(base + (size_t)(row0 + (lane & 15)) * pitch + k0 + 8 * (lane >> 4)); }
DEV bf16x8 frag_l(const LAS bf16* base, int pitch, int row0, int k0, int lane) { return *(const LAS bf16x8*)(base + (row0 + (lane & 15)) * pitch + k0 + 8 * (lane >> 4)); }
#ifndef CPU_EMU
DEV const LAS void* lds_vbase(const LAS void* p) { unsigned a = (unsigned)(size_t)p; asm volatile("" : "+v"(a)); return (const LAS void*)(size_t)a; }
#endif

struct Params {
    const float* in[30];
    float* out;
    unsigned char* ws;
    int lo, hi;
    int use_bar, pad;
};
enum { I_X = 0, I_REL, I_GF1, I_WUP1, I_WDN1, I_GMIX, I_WIN, I_GCONV, I_GALOG, I_GDTB, I_GNORM, I_NQN, I_NKN, I_NPEK, I_NPEV, I_NWCK, I_NWCV,
       I_SCW, I_SCB, I_SDTB, I_SALOG, I_SD, I_SNORM, I_PA, I_PB, I_PC, I_WO, I_GF2, I_WUP2, I_WDN2 };

#define XB_TMO      128
#define XB_XCNT(j)  (256  + 64 * (j))
#define XB_XSUB(j)  (1280 + 64 * (j))
#define XB_XGEN(j)  (2304 + 64 * (j))
#define XB_TOP      3328
#define XB_TOPGEN   3392
#define XCD_BAR_WORDS 3456
#define XB_SPIN_CAP (1u << 22)
#ifndef CPU_EMU
DEV unsigned xb_ld(unsigned* p)              { return __hip_atomic_load(p, __ATOMIC_RELAXED, __HIP_MEMORY_SCOPE_AGENT); }
DEV unsigned xb_add(unsigned* p, unsigned v) { return __hip_atomic_fetch_add(p, v, __ATOMIC_RELAXED, __HIP_MEMORY_SCOPE_AGENT); }
DEV unsigned xb_xcc_id() { return (unsigned)__builtin_amdgcn_s_getreg((3 << 11) | 20) & 0xFu; }
#define XB_SPIN(cond, bar) do { unsigned _sp = 0; while (cond) { __builtin_amdgcn_s_sleep(1); \
    if ((++_sp & 255u) == 0u) { if (xb_ld(&(bar)[XB_TMO])) break; if (_sp > XB_SPIN_CAP) { atomicAdd(&(bar)[XB_TMO], 1u); break; } } } } while (0)
struct XcdBarrier { unsigned* bar; unsigned x; volatile LAS unsigned* st; };
DEV XcdBarrier xcd_barrier_post(unsigned* bar, volatile LAS unsigned* st) {
    XcdBarrier b; b.bar = bar; b.x = xb_xcc_id(); b.st = st;
    if (threadIdx.x == 0) (void)xb_add(&bar[XB_XCNT(b.x)], 1u);
    return b;
}
DEV void xcd_barrier_complete(unsigned* bar, unsigned x, unsigned& nloc, unsigned& nx) {
    const unsigned G = gridDim.x * gridDim.y * gridDim.z;
    unsigned sum, cnt, mine, sp = 0u;
    for (;;) {
        sum = 0u; cnt = 0u; mine = 0u;
#pragma unroll
        for (unsigned j = 0; j < 16; ++j) { const unsigned c = xb_ld(&bar[XB_XCNT(j)]); sum += c; cnt += (c > 0u) ? 1u : 0u; mine = (j == x) ? c : mine; }
        if (sum == G) break;
        __builtin_amdgcn_s_sleep(1);
        if ((++sp & 255u) == 0u) { if (xb_ld(&bar[XB_TMO])) break; if (sp > XB_SPIN_CAP) { atomicAdd(&bar[XB_TMO], 1u); break; } }
    }
    nloc = mine > 0u ? mine : 1u; nx = cnt > 0u ? cnt : 1u;
}
DEV void xcd_barrier(const XcdBarrier& b) {
    asm volatile("s_waitcnt vmcnt(0)" ::: "memory");
    __syncthreads();
    if (threadIdx.x == 0) {
        unsigned* bar = b.bar;
        __builtin_amdgcn_s_waitcnt(0);
        unsigned nloc = b.st[0], nx = b.st[1];
        if (nloc == 0u) { xcd_barrier_complete(bar, b.x, nloc, nx); b.st[0] = nloc; b.st[1] = nx; }
        const unsigned old = xb_add(&bar[XB_XSUB(b.x)], 1u);
        const unsigned gen = old / nloc;
        if (old + 1u == (gen + 1u) * nloc) {
            __builtin_amdgcn_fence(__ATOMIC_RELEASE, "agent");
            asm volatile("s_waitcnt vmcnt(0)" ::: "memory");
            const unsigned og = xb_add(&bar[XB_TOP], 1u);
            const unsigned tg = og / nx;
            if (og + 1u == (tg + 1u) * nx) xb_add(&bar[XB_TOPGEN], 1u);
            else XB_SPIN(xb_ld(&bar[XB_TOPGEN]) == tg, bar);
            __builtin_amdgcn_fence(__ATOMIC_ACQUIRE, "agent");
            xb_add(&bar[XB_XGEN(b.x)], 1u);
            asm volatile("s_waitcnt vmcnt(0)" ::: "memory");
        } else {
            XB_SPIN(xb_ld(&bar[XB_XGEN(b.x)]) == gen, bar);
            __builtin_amdgcn_fence(__ATOMIC_ACQUIRE, "agent");
            asm volatile("s_waitcnt vmcnt(0)" ::: "memory");
        }
    }
    __syncthreads();
}
#endif

namespace pg8 {
constexpr int BM = 256, BK = 64, HALF = 128, HTB = HALF * BK * 2, STAGE_BYTES = 8 * HTB, NXCD = 8, WGM = 8;
__host__ __device__ __forceinline__ int lds_byte(int r, int c) { const int st = (r >> 4) * 2 + (c >> 5), rr = r & 15, cc = c & 31, ob = rr * 64 + cc * 2; return st * 1024 + (ob ^ (((ob >> 9) & 1) << 5)); }
__host__ __device__ __forceinline__ void stage_rc(int b, int& R, int& C) { const int st = b / 1024, sb = b % 1024, swz = sb ^ (((sb >> 9) & 1) << 5); R = (st >> 1) * 16 + swz / 64; C = (st & 1) * 32 + (swz % 64) / 2; }
__host__ __device__ __forceinline__ int perm32(int rho) { const int n = rho >> 4, i = rho & 15; return 8 * (i >> 2) + 4 * n + (i & 3); }
struct Unit { int pm, pn, koff, seg; };
struct Gemm { const bf16* A; const bf16* Bt; int M, N, K, lda, ldb; };
struct StaticOrder {
    int nM, nN, nwg, G, c;
    __host__ __device__ void init(int M, int N, int G_, int c_) { nM = M / BM; nN = N / BM; nwg = nM * nN; G = G_; c = c_; }
    __host__ __device__ bool next(int i, Unit& u) const {
        const long L = (long)i * G + c; if (L >= nwg) return false;
        int wgid = (int)L; { const int q = nwg / NXCD, r = nwg % NXCD, xcd = wgid % NXCD, off = wgid / NXCD; wgid = (xcd < r ? xcd * (q + 1) : r * (q + 1) + (xcd - r) * q) + off; }
        const int nig = WGM * nN, gid = wgid / nig, fm = gid * WGM, gsz = (nM - fm) < WGM ? (nM - fm) : WGM;
        u.pm = fm + ((wgid % nig) % gsz); u.pn = (wgid % nig) / gsz; u.koff = 0; u.seg = 0; return true;
    }
};
struct SegOrder {
    StaticOrder S; int kseg;
    __host__ __device__ void init(int M, int N, int G_, int c_, int kseg_) { S.init(M, N, G_, c_); kseg = kseg_; }
    __host__ __device__ bool next(int i, Unit& u) const { if (!S.next(i >> 2, u)) return false; u.seg = i & 3; u.koff = u.seg * kseg; return true; }
};
#ifndef CPU_EMU
DEV unsigned cvt_pk_bf16(float lo, float hi) { unsigned r; asm volatile("s_nop 1\n\tv_cvt_pk_bf16_f32 %0, %1, %2" : "=v"(r) : "v"(lo), "v"(hi)); return r; }
#endif
DEV unsigned long long rss_fix(float ss) { return (unsigned long long)(ss * 16777216.0f + 0.5f); }
DEV float rss_val(unsigned long long v) { return (float)v * (1.0f / 16777216.0f); }

struct EpiSwiGLU {
    static constexpr bool PERM = true, SEGACC = false;
    bf16* act; const unsigned long long* rss;
    DEV void operator()(const f32x4 (&acc)[2][2][4][2], const Unit& u, int wr, int wc, int fr, int fq) const {
        const int row0 = u.pm * BM + wr * 64 + fr, col0 = u.pn * HALF + wc * 32 + 8 * fq;
        unsigned long long rv[8];
#pragma unroll
        for (int i = 0; i < 8; ++i) rv[i] = rss[row0 + (i >> 2) * HALF + (i & 3) * 16];
        CFENCE();
#pragma unroll
        for (int ai = 0; ai < 2; ++ai)
#pragma unroll
            for (int m = 0; m < 4; ++m) {
                const int row = row0 + ai * HALF + m * 16;
                const float rs = rsqrtf(rss_val(rv[ai * 4 + m]) * (1.0f / DM) + EPS);
                float o[8];
#pragma unroll
                for (int n = 0; n < 2; ++n)
#pragma unroll
                    for (int j = 0; j < 4; ++j) { const float a = acc[ai][0][m][n][j] * rs, b = acc[ai][1][m][n][j] * rs; o[4 * n + j] = a * b * __builtin_amdgcn_rcpf(1.0f + __expf(-a)); }
                u32x4 w; w.x = cvt_pk_bf16(o[0], o[1]); w.y = cvt_pk_bf16(o[2], o[3]); w.z = cvt_pk_bf16(o[4], o[5]); w.w = cvt_pk_bf16(o[6], o[7]);
                *(u32x4*)(act + (size_t)row * DFF + col0) = w;
            }
    }
};
struct EpiResidual {
    static constexpr bool PERM = true, SEGACC = false;
    float* x; bf16* xb; unsigned long long* rss_out; float alpha;
    DEV void operator()(const f32x4 (&acc)[2][2][4][2], const Unit& u, int wr, int wc, int fr, int fq) const {
        const int row0 = u.pm * BM + wr * 64 + fr, col0 = u.pn * BM + wc * 32 + 8 * fq;
#pragma unroll
        for (int aim = 0; aim < 4; ++aim) {
            const int ai = aim >> 1, m0 = (aim & 1) * 2;
            f32x4 xv[2][2][2];
#pragma unroll
            for (int mm = 0; mm < 2; ++mm)
#pragma unroll
                for (int bj = 0; bj < 2; ++bj) { const float* xp = x + (size_t)(row0 + ai * HALF + (m0 + mm) * 16) * DM + col0 + bj * HALF; xv[mm][bj][0] = *(const f32x4*)xp; xv[mm][bj][1] = *(const f32x4*)(xp + 4); }
            CFENCE();
#pragma unroll
            for (int mm = 0; mm < 2; ++mm) {
                const int m = m0 + mm, row = row0 + ai * HALF + m * 16; float ss = 0.f;
#pragma unroll
                for (int bj = 0; bj < 2; ++bj) {
                    float* xp = x + (size_t)row * DM + col0 + bj * HALF;
                    const f32x4 x0 = xv[mm][bj][0] + acc[ai][bj][m][0] * alpha, x1 = xv[mm][bj][1] + acc[ai][bj][m][1] * alpha;
                    *(f32x4*)xp = x0; *(f32x4*)(xp + 4) = x1;
                    ss += (x0[0] * x0[0] + x0[1] * x0[1]) + (x0[2] * x0[2] + x0[3] * x0[3]) + (x1[0] * x1[0] + x1[1] * x1[1]) + (x1[2] * x1[2] + x1[3] * x1[3]);
                    u32x4 w; w.x = cvt_pk_bf16(x0[0], x0[1]); w.y = cvt_pk_bf16(x0[2], x0[3]); w.z = cvt_pk_bf16(x1[0], x1[1]); w.w = cvt_pk_bf16(x1[2], x1[3]);
                    *(u32x4*)(xb + (size_t)row * DM + col0 + bj * HALF) = w;
                }
                ss += shx<16>(ss); ss += shx<32>(ss);
                if (fq == 0) atomicAdd(rss_out + row, rss_fix(ss));
            }
            CFENCE();
        }
    }
};
struct EpiWin {
    static constexpr bool PERM = true, SEGACC = false;
    bf16* p1; float* small; bf16* gate; const unsigned long long* rss;
    DEV void operator()(const f32x4 (&acc)[2][2][4][2], const Unit& u, int wr, int wc, int fr, int fq) const {
        const int row0 = u.pm * BM + wr * 64 + fr, cl0 = wc * 32 + 8 * fq;
        unsigned long long rv[8];
#pragma unroll
        for (int i = 0; i < 8; ++i) rv[i] = rss[row0 + (i >> 2) * HALF + (i & 3) * 16];
        CFENCE();
#pragma unroll
        for (int ai = 0; ai < 2; ++ai)
#pragma unroll
            for (int m = 0; m < 4; ++m) {
                const int row = row0 + ai * HALF + m * 16;
                const float rs = rsqrtf(rss_val(rv[ai * 4 + m]) * (1.0f / DM) + EPS);
#pragma unroll
                for (int bj = 0; bj < 2; ++bj) {
                    f32x4 v0 = acc[ai][bj][m][0] * rs, v1 = acc[ai][bj][m][1] * rs;
                    const int cl = cl0 + bj * HALF;
                    if (u.pn < 26) {
                        u32x4 w; w.x = cvt_pk_bf16(v0[0], v0[1]); w.y = cvt_pk_bf16(v0[2], v0[3]); w.z = cvt_pk_bf16(v1[0], v1[1]); w.w = cvt_pk_bf16(v1[2], v1[3]);
                        *(u32x4*)(p1 + (size_t)row * P1W + u.pn * BM + cl) = w;
                    } else if (u.pn == 26) {
                        if (cl < SMW) { float* sp = small + (size_t)row * SMW + cl; *(f32x4*)sp = v0; *(f32x4*)(sp + 4) = v1; }
                    } else {
#pragma unroll
                        for (int j = 0; j < 4; ++j) { v0[j] = fminf(__builtin_amdgcn_rcpf(1.0f + __expf(-v0[j])), 1.0f); v1[j] = fminf(__builtin_amdgcn_rcpf(1.0f + __expf(-v1[j])), 1.0f); }
                        u32x4 w; w.x = cvt_pk_bf16(v0[0], v0[1]); w.y = cvt_pk_bf16(v0[2], v0[3]); w.z = cvt_pk_bf16(v1[0], v1[1]); w.w = cvt_pk_bf16(v1[2], v1[3]);
                        *(u32x4*)(gate + (size_t)row * 6144 + (u.pn - 27) * BM + cl) = w;
                    }
                }
            }
    }
};
struct EpiMergeSeg {
    static constexpr bool PERM = true, SEGACC = true;
    bf16* merged; const bf16* gate; const float* rc;
    DEV void seg(f32x4 (&acc)[2][2][4][2], const Unit& u, int wr, int wc, int fr, int fq) const {
        const int row0 = u.pm * BM + wr * 64 + fr, col0 = u.pn * BM + wc * 32 + 8 * fq, sg = u.seg;
        f32x2 rcv[8];
#pragma unroll
        for (int i = 0; i < 8; ++i) rcv[i] = *(const f32x2*)(rc + (size_t)(row0 + (i >> 2) * HALF + (i & 3) * 16) * 2);
        const int offa = sg == 0 ? 0 : (sg == 1 ? DM : 2 * DM), offb = sg == 0 ? DM : 2 * DM;
#pragma unroll
        for (int aim = 0; aim < 4; ++aim) {
            const int ai = aim >> 1, m0 = (aim & 1) * 2;
            u32x4 wa[2][2], wb[2][2];
            if (sg != 2) {
#pragma unroll
                for (int mm = 0; mm < 2; ++mm)
#pragma unroll
                    for (int bj = 0; bj < 2; ++bj) { const bf16* gp = gate + (size_t)(row0 + ai * HALF + (m0 + mm) * 16) * 6144 + col0 + bj * HALF; wa[mm][bj] = *(const u32x4*)(gp + offa); wb[mm][bj] = *(const u32x4*)(gp + offb); }
            }
            CFENCE();
#pragma unroll
            for (int mm = 0; mm < 2; ++mm) {
                const int m = m0 + mm, row = row0 + ai * HALF + m * 16;
                const float r0 = rcv[ai * 4 + m][0], r1 = rcv[ai * 4 + m][1];
#pragma unroll
                for (int bj = 0; bj < 2; ++bj) {
                    float f[8];
                    if (sg == 2) { const float q = fmaxf(r0, 1e-20f) / fmaxf(r1, 1e-20f);
#pragma unroll
                        for (int j = 0; j < 8; ++j) f[j] = q; }
                    else {
                        const u32x4 a4 = wa[mm][bj], b4 = wb[mm][bj];
                        const float na[8] = {bflo(a4.x), bfhi(a4.x), bflo(a4.y), bfhi(a4.y), bflo(a4.z), bfhi(a4.z), bflo(a4.w), bfhi(a4.w)};
                        const float nb[8] = {bflo(b4.x), bfhi(b4.x), bflo(b4.y), bfhi(b4.y), bflo(b4.z), bfhi(b4.z), bflo(b4.w), bfhi(b4.w)};
#pragma unroll
                        for (int j = 0; j < 8; ++j) {
                            if (sg == 0) f[j] = fmaxf(na[j], 1e-20f) * __builtin_amdgcn_rcpf(fmaxf(nb[j], 1e-20f));
                            else if (sg == 1) f[j] = fmaxf(na[j], 1e-20f) * __builtin_amdgcn_rcpf(fmaxf(nb[j] * r0, 1e-20f));
                            else f[j] = fmaxf(na[j] * r1, 1e-20f); }
                    }
                    f32x4 v0 = acc[ai][bj][m][0], v1 = acc[ai][bj][m][1];
#pragma unroll
                    for (int j = 0; j < 4; ++j) { v0[j] *= f[j]; v1[j] *= f[4 + j]; }
                    if (sg < 3) { acc[ai][bj][m][0] = v0; acc[ai][bj][m][1] = v1; }
                    else { u32x4 o; o.x = cvt_pk_bf16(v0[0], v0[1]); o.y = cvt_pk_bf16(v0[2], v0[3]); o.z = cvt_pk_bf16(v1[0], v1[1]); o.w = cvt_pk_bf16(v1[2], v1[3]);
                        *(u32x4*)(merged + (size_t)row * DM + col0 + bj * HALF) = o; }
                }
            }
            CFENCE();
        }
    }
};

#ifndef CPU_EMU
template <class Epi, class Sched>
DEV void gemm_phase(LAS unsigned char* lds, const int tid, const Gemm g, const Sched& S, const Epi& E) {
    const int wid = __builtin_amdgcn_readfirstlane(tid >> 6), lane = tid & 63, wr = wid >> 2, wc = wid & 3, fr = lane & 15, fq = lane >> 4;
    const int K = g.K, nt = K / BK;
    const float zf_ = opaque_zero();
    unsigned voffA[2], voffB[2];
#pragma unroll
    for (int i = 0; i < 2; ++i) { int R, C; stage_rc(tid * 16 + i * 8192, R, C); const int Rb = Epi::PERM ? ((R & ~31) + perm32(R & 31)) : R;
        voffA[i] = (unsigned)(R * g.lda + C) * 2u; voffB[i] = (unsigned)(Rb * g.ldb + C) * 2u; }
    const size_t kstep = (size_t)(BK * 2);
    const size_t hA = (size_t)HALF * g.lda * 2, hB = (size_t)HALF * g.ldb * 2;
    const size_t tA = 2 * hA, tB = 2 * hB;
    const unsigned ldsw = (unsigned)wid * 1024u;
    const int aoff = lds_byte(wr * 64 + fr, fq * 8), boff = lds_byte(wc * 32 + fr, fq * 8);
#define PG8_SA(b, h) (((b) * 2 + (h)) * HTB)
#define PG8_SB(b, h) ((4 + (b) * 2 + (h)) * HTB)
#define PG8_STAGE(bufoff, gbase, voff) do { _Pragma("unroll") for (int _i = 0; _i < 2; ++_i) \
        __builtin_amdgcn_global_load_lds((const unsigned*)((const char*)(gbase) + (voff)[_i]), (LAS unsigned*)(lds + (bufoff) + ldsw + _i * 8192), 16, 0, 0); } while (0)
#define PG8_LDA(dst, b, h) do { _Pragma("unroll") for (int m = 0; m < 4; ++m) _Pragma("unroll") for (int k = 0; k < 2; ++k) dst[m][k] = *(const LAS bf16x8*)(lds + PG8_SA(b, h) + aoff + m * 2048 + k * 1024); } while (0)
#define PG8_LDB(dst, b, h) do { _Pragma("unroll") for (int n = 0; n < 2; ++n) _Pragma("unroll") for (int k = 0; k < 2; ++k) dst[n][k] = *(const LAS bf16x8*)(lds + PG8_SB(b, h) + boff + n * 2048 + k * 1024); } while (0)
#define PG8_MMA(ai, bj, At, Bt) do { __builtin_amdgcn_s_setprio(1); _Pragma("unroll") for (int m = 0; m < 4; ++m) _Pragma("unroll") for (int n = 0; n < 2; ++n) _Pragma("unroll") for (int k = 0; k < 2; ++k) \
        acc[ai][bj][m][n] = __builtin_amdgcn_mfma_f32_16x16x32_bf16(Bt[n][k], At[m][k], acc[ai][bj][m][n], 0, 0, 0); __builtin_amdgcn_s_setprio(0); } while (0)
#define PG8_WAIT_V(n) asm volatile("s_waitcnt vmcnt(" #n ")" ::: "memory")
#define PG8_WAIT_L(n) asm volatile("s_waitcnt lgkmcnt(" #n ")" ::: "memory")
#define PG8_BAR __builtin_amdgcn_s_barrier()
#define PG8_SCHED __builtin_amdgcn_sched_barrier(0)
    Unit cur, nxt; int ui = 0;
    if (!S.next(0, cur)) return;
    f32x4 acc[2][2][4][2];
#pragma unroll
    for (int a = 0; a < 2; ++a)
#pragma unroll
        for (int b = 0; b < 2; ++b)
#pragma unroll
            for (int m = 0; m < 4; ++m)
#pragma unroll
                for (int n = 0; n < 2; ++n) acc[a][b][m][n] = ZERO4;
    bf16x8 At[4][2], B0[2][2], B1[2][2];
    const char* cA = (const char*)g.A + (size_t)cur.pm * tA + (size_t)cur.koff * 2; const char* cB = (const char*)g.Bt + (size_t)cur.pn * tB + (size_t)cur.koff * 2;
    PG8_STAGE(PG8_SB(0, 0), cB, voffB); PG8_STAGE(PG8_SB(0, 1), cB + hB, voffB); PG8_STAGE(PG8_SA(0, 0), cA, voffA); PG8_STAGE(PG8_SA(0, 1), cA + hA, voffA);
    if (wr == 1) PG8_BAR;
    PG8_WAIT_V(2); PG8_BAR;
    PG8_STAGE(PG8_SB(1, 0), cB + kstep, voffB); PG8_STAGE(PG8_SA(1, 0), cA + kstep, voffA); PG8_STAGE(PG8_SB(1, 1), cB + hB + kstep, voffB);
    PG8_WAIT_V(6); PG8_BAR;
    for (;;) {
        const bool has_next = S.next(ui + 1, nxt);
        const char* nA = has_next ? (const char*)g.A + (size_t)nxt.pm * tA + (size_t)nxt.koff * 2 : cA; const char* nB = has_next ? (const char*)g.Bt + (size_t)nxt.pn * tB + (size_t)nxt.koff * 2 : cB;
        for (int t = 0; t < nt; t += 2) {
            const bool last = (t == nt - 2);
            const char* a1 = cA + (size_t)(t + 1) * kstep;
            const char* a2 = last ? nA : cA + (size_t)(t + 2) * kstep; const char* b2 = last ? nB : cB + (size_t)(t + 2) * kstep;
            const char* a3 = a2 + kstep; const char* b3 = b2 + kstep;
            PG8_LDB(B0, 0, 0); PG8_LDB(B1, 0, 1); PG8_SCHED; PG8_LDA(At, 0, 0); PG8_STAGE(PG8_SA(1, 1), a1 + hA, voffA);
            PG8_WAIT_V(8); PG8_WAIT_L(0); PG8_BAR; PG8_MMA(0, 0, At, B0); PG8_MMA(0, 1, At, B1); PG8_BAR; PG8_SCHED;
            PG8_LDA(At, 0, 1); PG8_STAGE(PG8_SB(0, 0), b2, voffB); PG8_STAGE(PG8_SB(0, 1), b2 + hB, voffB); PG8_STAGE(PG8_SA(0, 0), a2, voffA);
            PG8_WAIT_V(8); PG8_WAIT_L(0); PG8_BAR; PG8_MMA(1, 0, At, B0); PG8_MMA(1, 1, At, B1); PG8_BAR; PG8_SCHED;
            PG8_LDB(B0, 1, 0); PG8_LDB(B1, 1, 1); PG8_SCHED; PG8_LDA(At, 1, 0); PG8_STAGE(PG8_SA(0, 1), a2 + hA, voffA);
            PG8_WAIT_V(8); PG8_WAIT_L(0); PG8_BAR; PG8_MMA(0, 0, At, B0); PG8_MMA(0, 1, At, B1); PG8_BAR; PG8_SCHED;
            PG8_LDA(At, 1, 1); PG8_STAGE(PG8_SB(1, 0), b3, voffB); PG8_STAGE(PG8_SB(1, 1), b3 + hB, voffB); PG8_STAGE(PG8_SA(1, 0), a3, voffA);
            PG8_WAIT_V(8); PG8_WAIT_L(0); PG8_BAR; PG8_MMA(1, 0, At, B0); PG8_MMA(1, 1, At, B1); PG8_BAR; PG8_SCHED;
        }
        if (DBG_TMASK && DBG_TEPI && tid == 0 && blockIdx.x == 0) { volatile LAS unsigned* m_ = (volatile LAS unsigned*)(lds + MISC_OFF); if (m_[68]) m_[65] = (unsigned)__builtin_amdgcn_s_memrealtime(); }
        if (wr == 0) PG8_BAR;
        if constexpr (Epi::SEGACC) E.seg(acc, cur, wr, wc, fr, fq); else E(acc, cur, wr, wc, fr, fq);
        if (DBG_TMASK && DBG_TEPI && tid == 0 && blockIdx.x == 0) { volatile LAS unsigned* m_ = (volatile LAS unsigned*)(lds + MISC_OFF); if (m_[68]) m_[66] = m_[66] + ((unsigned)__builtin_amdgcn_s_memrealtime() - m_[65]); }
        if (!has_next) break;
        if (!(Epi::SEGACC && nxt.seg != 0)) {
#pragma unroll
        for (int a = 0; a < 2; ++a)
#pragma unroll
            for (int b = 0; b < 2; ++b)
#pragma unroll
                for (int m = 0; m < 4; ++m)
#pragma unroll
                    for (int n = 0; n < 2; ++n) acc[a][b][m][n] = ZERO4;
        }
        cur = nxt; cA = nA; cB = nB; ++ui;
        if (wr == 1) PG8_BAR;
    }
    PG8_WAIT_V(0);
    PG8_BAR;
#undef PG8_SA
#undef PG8_SB
#undef PG8_STAGE
#undef PG8_LDA
#undef PG8_LDB
#undef PG8_MMA
#undef PG8_WAIT_V
#undef PG8_WAIT_L
#undef PG8_BAR
#undef PG8_SCHED
}
#endif
}

#ifndef CPU_EMU
typedef const __attribute__((address_space(4))) Params* KParams;
#else
typedef const Params* KParams;
#endif
struct Frame {
    LAS unsigned char* lds;
    int tid, lane, wave, G, bid;
    KParams p;
    unsigned char* ws;
};
DEV const float* lin(const Frame& F, int idx, int layer, size_t per_layer) { return F.p->in[idx] + (size_t)layer * per_layer; }
#define WSP(T, off) ((T*)(F.ws + (off)))

DEV int up_dest(int n) { return n < DFF ? (n >> 7) * 256 + (n & 127) : ((n - DFF) >> 7) * 256 + 128 + ((n - DFF) & 127); }
DEV int win_dest(int n) {
    if (n < 2048) return n;
    if (n < 2052) return SM0 + S_AA + (n - 2048);
    if (n < 2056) return SM0 + S_AB + (n - 2052);
    if (n < 4104) return C_BQ + (n - 2056);
    if (n < 4116) return SM0 + S_BG + (n - 4104);
    if (n < 6676) return C_CZ + (n - 4116);
    if (n < 6692) return SM0 + S_DT + (n - 6676);
    return GT0 + (n - 6692);
}
struct XItem { const float* W; const float* ks; bf16* WT; int K, N, ldt, koff, mode, r; };
DEV void xitem_load(const XItem& it, int lane, float (&v)[32]) {
    const int nblk = (it.N + 31) / 32, kb = it.r / nblk, nb = it.r % nblk, k0 = 64 * kb, n0 = 32 * nb;
    const int nn = n0 + (lane & 31);
    const float* src = it.W + (size_t)(k0 + (lane >> 5)) * it.N + (nn < it.N ? nn : it.N - 1);
#pragma unroll
    for (int i = 0; i < 32; ++i) v[i] = src[(size_t)(2 * i) * it.N];
}
DEV void xitem_to_lds(LAS float* scr, int lane, const float (&v)[32]) {
#pragma unroll
    for (int i = 0; i < 32; ++i) scr[(2 * i + (lane >> 5)) * 33 + (lane & 31)] = v[i];
    LDS_WAIT(); CFENCE();
}
DEV void xitem_store(const XItem& it, LAS float* scr, int lane) {
    const int nblk = (it.N + 31) / 32, kb = it.r / nblk, nb = it.r % nblk, k0 = 64 * kb, n0 = 32 * nb;
    const int c = lane & 7;
    f32x4 ks0 = (f32x4){1.f, 1.f, 1.f, 1.f}, ks1 = ks0;
    if (it.ks) { ks0 = *(const f32x4*)(it.ks + k0 + 8 * c); ks1 = *(const f32x4*)(it.ks + k0 + 8 * c + 4); }
#pragma unroll
    for (int j = 0; j < 4; ++j) { const int n = (lane >> 3) + 8 * j; const LAS float* s = scr + (8 * c) * 33 + n;
        u32x4 o; o.x = pk2(s[0 * 33] * ks0[0], s[1 * 33] * ks0[1]); o.y = pk2(s[2 * 33] * ks0[2], s[3 * 33] * ks0[3]); o.z = pk2(s[4 * 33] * ks1[0], s[5 * 33] * ks1[1]); o.w = pk2(s[6 * 33] * ks1[2], s[7 * 33] * ks1[3]);
        const int ng = n0 + n;
        if (ng < it.N) { const int dr = it.mode == 0 ? ng : (it.mode == 1 ? up_dest(ng) : win_dest(ng)); *(u32x4*)(it.WT + (size_t)dr * it.ldt + it.koff + k0 + 8 * c) = o; } }
    LDS_WAIT(); CFENCE();
}
constexpr int XI_UP = (DM / 64) * (NUP / 32), XI_DN = (DFF / 64) * (DM / 32), XI_IN = (DM / 64) * ((NIN + 31) / 32), XI_P5 = (512 / 64) * (DM / 32), XI_P10 = (1024 / 64) * (DM / 32), XI_OO = (DM / 64) * (DM / 32), XI_CK = (4096 / 64) * (128 / 32);
constexpr int XI_TOTAL = 2 * XI_UP + 2 * XI_DN + XI_IN + 2 * XI_P5 + XI_P10 + XI_OO + 2 * XI_CK;
DEV XItem xitem_decode(Frame& F, int l, int idx) {
    XItem t; int r = idx; t.ks = nullptr; t.koff = 0; t.mode = 0;
    if (r < XI_UP) { t.W = lin(F, I_WUP1, l, (size_t)DM * NUP); t.K = DM; t.N = NUP; t.WT = WSP(bf16, WS_WUP1); t.ldt = DM; t.ks = lin(F, I_GF1, l, DM); t.mode = 1; }
    else if ((r -= XI_UP) < XI_UP) { t.W = lin(F, I_WUP2, l, (size_t)DM * NUP); t.K = DM; t.N = NUP; t.WT = WSP(bf16, WS_WUP2); t.ldt = DM; t.ks = lin(F, I_GF2, l, DM); t.mode = 1; }
    else if ((r -= XI_UP) < XI_DN) { t.W = lin(F, I_WDN1, l, (size_t)DFF * DM); t.K = DFF; t.N = DM; t.WT = WSP(bf16, WS_WDN1); t.ldt = DFF; }
    else if ((r -= XI_DN) < XI_DN) { t.W = lin(F, I_WDN2, l, (size_t)DFF * DM); t.K = DFF; t.N = DM; t.WT = WSP(bf16, WS_WDN2); t.ldt = DFF; }
    else if ((r -= XI_DN) < XI_IN) { t.W = lin(F, I_WIN, l, (size_t)DM * NIN); t.K = DM; t.N = NIN; t.WT = WSP(bf16, WS_WIN); t.ldt = DM; t.ks = lin(F, I_GMIX, l, DM); t.mode = 2; }
    else if ((r -= XI_IN) < XI_P5) { t.W = lin(F, I_PA, l, (size_t)512 * DM); t.K = 512; t.N = DM; t.WT = WSP(bf16, WS_WPM); t.ldt = DM; }
    else if ((r -= XI_P5) < XI_P5) { t.W = lin(F, I_PB, l, (size_t)512 * DM); t.K = 512; t.N = DM; t.WT = WSP(bf16, WS_WPM); t.ldt = DM; t.koff = 512; }
    else if ((r -= XI_P5) < XI_P10) { t.W = lin(F, I_PC, l, (size_t)1024 * DM); t.K = 1024; t.N = DM; t.WT = WSP(bf16, WS_WPM); t.ldt = DM; t.koff = 1024; t.ks = lin(F, I_SNORM, l, 1024); }
    else if ((r -= XI_P10) < XI_OO) { t.W = lin(F, I_WO, l, (size_t)DM * DM); t.K = DM; t.N = DM; t.WT = WSP(bf16, WS_WO); t.ldt = DM; }
    else if ((r -= XI_OO) < XI_CK) { t.W = lin(F, I_NWCK, l, (size_t)4096 * 128); t.K = 4096; t.N = 128; t.WT = WSP(bf16, WS_WCK); t.ldt = 4096; }
    else { r -= XI_CK; t.W = lin(F, I_NWCV, l, (size_t)4096 * 128); t.K = 4096; t.N = 128; t.WT = WSP(bf16, WS_WCV); t.ldt = 4096; }
    t.r = r; return t;
}
DEV void phase_convert(Frame& F, int l) {
    LAS float* scr = (LAS float*)(F.lds + F.wave * 16384);
    const int gw = F.bid * 8 + F.wave, NGW = F.G * 8;
    if (gw < XI_TOTAL) {
        float v[32]; XItem cur = xitem_decode(F, l, gw); xitem_load(cur, F.lane, v);
        for (int it = gw; it < XI_TOTAL; it += NGW) {
            xitem_to_lds(scr, F.lane, v);
            const bool has_next = it + NGW < XI_TOTAL; XItem nxt = cur;
            if (has_next) { nxt = xitem_decode(F, l, it + NGW); xitem_load(nxt, F.lane, v); }
            xitem_store(cur, scr, F.lane);
            cur = nxt;
        }
    }
    { bf16* w = WSP(bf16, WS_WIN) + (size_t)(SM0 + 36) * DM; const int n16 = (GT0 - SM0 - 36) * DM / 8;
      const unsigned zu = __builtin_bit_cast(unsigned, opaque_zero());
      for (int i = F.bid * 512 + F.tid; i < n16; i += F.G * 512) ((u32x4*)w)[i] = (u32x4){zu, zu, zu, zu}; }
    { const float* pek = lin(F, I_NPEK, l, 4096); const float* pev = lin(F, I_NPEV, l, 4096); float* cst = WSP(float, WS_CONST);
      for (int it = gw; it < 256; it += NGW) { const int e = it & 127; const float* pe = it < 128 ? pek : pev; const float* w = it < 128 ? lin(F, I_NWCK, l, (size_t)4096 * 128) : lin(F, I_NWCV, l, (size_t)4096 * 128); float s = 0.f;
          for (int k = F.lane; k < 4096; k += 64) s += pe[k] * w[(size_t)k * 128 + e];
          s = wave_sum(s); if (F.lane == 0) cst[it] = s; } }
    if (l == 0) {
        const float* x = F.p->in[I_X]; float* out = F.p->out; bf16* xb = WSP(bf16, WS_XB); unsigned long long* rss = WSP(unsigned long long, WS_CTL) + CW_RS / 2;
        for (int m = gw; m < MTOK; m += NGW) {
            const f32x4* xr = (const f32x4*)(x + (size_t)m * DM) + F.lane; f32x4* orow = (f32x4*)(out + (size_t)m * DM) + F.lane; u32x2* br = (u32x2*)(xb + (size_t)m * DM) + F.lane; float ss = 0.f;
#pragma unroll
            for (int j = 0; j < 8; ++j) { const f32x4 v = xr[64 * j]; orow[64 * j] = v; ss += (v[0] * v[0] + v[1] * v[1]) + (v[2] * v[2] + v[3] * v[3]); u32x2 w; w.x = pk2(v[0], v[1]); w.y = pk2(v[2], v[3]); br[64 * j] = w; }
            ss = wave_sum(ss); if (F.lane == 0) rss[m] = pg8::rss_fix(ss);
        }
    }
}

DEV void nsa_prep_job(Frame& F, int l, int job) {
    const int b = job >> 8, g = (job >> 7) & 1, j = job & 127, bg = b * 2 + g, t0 = 64 * j;
    const bf16* p1 = WSP(bf16, WS_P1);
    const float* qn = lin(F, I_NQN, l, 128); const float* kn = lin(F, I_NKN, l, 128);
    bf16* QN = WSP(bf16, WS_QN); bf16* KS = WSP(bf16, WS_KS); bf16* KW = WSP(bf16, WS_KW); bf16* VST = WSP(bf16, WS_VST); bf16* VWT = WSP(bf16, WS_VWT);
    {
        const int v = F.lane >> 4, l16 = F.lane & 15;
        const int col = (v < 2 ? C_BQ + (g * 2 + v) * 128 : (v == 2 ? C_BKS + g * 128 : C_BKW + g * 128)) + 8 * l16;
        const float* gp = (v < 2 ? qn : kn) + 8 * l16; const f32x4 ga = *(const f32x4*)gp, gb = *(const f32x4*)(gp + 4);
        const float gg[8] = {ga[0], ga[1], ga[2], ga[3], gb[0], gb[1], gb[2], gb[3]};
        u32x4 wv[8];
#pragma unroll
        for (int i = 0; i < 8; ++i) wv[i] = *(const u32x4*)(p1 + (size_t)(b * SEQ + t0 + 8 * F.wave + i) * P1W + col);
        CFENCE();
#pragma unroll
        for (int i = 0; i < 8; ++i) {
            const int t = t0 + 8 * F.wave + i;
            const float x[8] = {bflo(wv[i].x), bfhi(wv[i].x), bflo(wv[i].y), bfhi(wv[i].y), bflo(wv[i].z), bfhi(wv[i].z), bflo(wv[i].w), bfhi(wv[i].w)};
            float ss = ((x[0] * x[0] + x[1] * x[1]) + (x[2] * x[2] + x[3] * x[3])) + ((x[4] * x[4] + x[5] * x[5]) + (x[6] * x[6] + x[7] * x[7]));
            ss = sum16(ss);
            float r = rsqrtf(ss * (1.0f / 128.0f) + EPS);
            if (v < 2) r *= 0.08838834764831845f * 1.4426950408889634f;
            u32x4 o; o.x = pk2(x[0] * r * gg[0], x[1] * r * gg[1]); o.y = pk2(x[2] * r * gg[2], x[3] * r * gg[3]); o.z = pk2(x[4] * r * gg[4], x[5] * r * gg[5]); o.w = pk2(x[6] * r * gg[6], x[7] * r * gg[7]);
            bf16* dst = v < 2 ? QN + ((size_t)(bg * SEQ + t) * 2 + v) * 128 : (v == 2 ? KS : KW) + (size_t)(bg * SEQ + t) * 128;
            *(u32x4*)(dst + 8 * l16) = o;
        }
    }
    LAS bf16* tl = (LAS bf16*)F.lds;
    {
        u32x4 vv[4];
#pragma unroll
        for (int q = 0; q < 4; ++q) { const int i = F.tid + 512 * q, v = i >> 10, r = (i >> 4) & 63, c8 = (i & 15) * 8;
            vv[q] = *(const u32x4*)(p1 + (size_t)(b * SEQ + t0 + r) * P1W + (v ? C_BVW : C_BVS) + g * 128 + c8); }
#pragma unroll
        for (int q = 0; q < 4; ++q) { const int i = F.tid + 512 * q, v = i >> 10, r = (i >> 4) & 63, c8 = (i & 15) * 8; LAS unsigned* d = (LAS unsigned*)(tl + (v * 64 + r) * 130 + c8);
            d[0] = vv[q].x; d[1] = vv[q].y; d[2] = vv[q].z; d[3] = vv[q].w; }
    }
    __syncthreads();
    for (int i = F.tid; i < 2 * 128 * 8; i += 512) {
        const int v = i >> 10, d = i & 127, tc = (i >> 7) & 7;
        const LAS bf16* s = tl + (v * 64 + 8 * tc) * 130 + d;
        u32x4 o; o.x = s[0] | ((unsigned)s[130] << 16); o.y = s[260] | ((unsigned)s[390] << 16); o.z = s[520] | ((unsigned)s[650] << 16); o.w = s[780] | ((unsigned)s[910] << 16);
        *(u32x4*)((v ? VWT : VST) + ((size_t)(bg * 128 + j) * 128 + d) * 64 + 8 * tc) = o;
    }
    __syncthreads();
}

DEV void conv_load11(u32x4 (&xin)[11], const bf16* p1, int b, int ts, int col) {
#pragma unroll
    for (int i = 0; i < 11; ++i) { const int t = ts - 3 + i; const int tc = t < 0 ? 0 : t;
        u32x4 v = *(const u32x4*)(p1 + (size_t)(b * SEQ + tc) * P1W + col);
        if (t < 0) v = (u32x4){0u, 0u, 0u, 0u};
        xin[i] = v; }
}
DEV void gdn_prep_job(Frame& F, int l, int job) {
    const int b = job >> 9, h = (job >> 7) & 3, c = job & 127, t0 = 64 * c;
    const bf16* p1 = WSP(bf16, WS_P1); const float* small = WSP(float, WS_SMALL);
    const float* convw = lin(F, I_GCONV, l, 4 * 1536);
    LAS float* Qs = (LAS float*)F.lds;
    LAS float* Ks = Qs + 64 * 132;
    LAS float* Vs = Ks + 64 * 132;
    LAS float* Mm = Vs + 64 * 132;
    LAS float* At = Mm + 64 * 68;
    LAS float* beta = At + 64 * 68;
    LAS float* gc = beta + 64;
    LAS float* eg = gc + 64;
    const int tid = F.tid;
    {
        if (tid < 384) {
            const int v = tid >> 7, s = tid & 15, tg = (tid >> 4) & 7, cc = v * 512 + h * 128 + 8 * s;
            u32x4 xin[11]; conv_load11(xin, p1, b, t0 + 8 * tg, (v == 0 ? C_AQ : (v == 1 ? C_AK : C_AV)) + h * 128 + 8 * s);
            f32x4 w[4][2];
#pragma unroll
            for (int k = 0; k < 4; ++k) { w[k][0] = *(const f32x4*)(convw + k * 1536 + cc); w[k][1] = *(const f32x4*)(convw + k * 1536 + cc + 4); }
            float y[8][8];
#pragma unroll
            for (int j = 0; j < 8; ++j) {
                float x[11];
#pragma unroll
                for (int i = 0; i < 11; ++i) { const unsigned wd = j < 2 ? xin[i].x : (j < 4 ? xin[i].y : (j < 6 ? xin[i].z : xin[i].w)); x[i] = (j & 1) ? bfhi(wd) : bflo(wd); }
                const float w0 = w[0][j >> 2][j & 3], w1 = w[1][j >> 2][j & 3], w2 = w[2][j >> 2][j & 3], w3 = w[3][j >> 2][j & 3];
#pragma unroll
                for (int i = 0; i < 8; ++i) y[i][j] = siluf_(w0 * x[i] + w1 * x[i + 1] + w2 * x[i + 2] + w3 * x[i + 3]);
            }
            LAS float* dst = (v == 0 ? Qs : (v == 1 ? Ks : Vs)) + (8 * tg) * 132 + 8 * s;
#pragma unroll
            for (int i = 0; i < 8; ++i) { *(LAS f32x4*)(dst + i * 132) = (f32x4){y[i][0], y[i][1], y[i][2], y[i][3]}; *(LAS f32x4*)(dst + i * 132 + 4) = (f32x4){y[i][4], y[i][5], y[i][6], y[i][7]}; }
        }
        if (tid < 64) {
            const size_t row = (size_t)(b * SEQ + t0 + tid);
            const float a = small[row * SMW + S_AA + h], bb = small[row * SMW + S_AB + h];
            beta[tid] = sigmoidf_(bb);
            gc[tid] = -__expf(lin(F, I_GALOG, l, 4)[h]) * softplusf_(a + lin(F, I_GDTB, l, 4)[h]);
        }
    }
    __syncthreads();
    for (int i4 = 0; i4 < 4; ++i4) {
        float x0[4], x1[4], ssv[4];
#pragma unroll
        for (int q = 0; q < 4; ++q) { const int r = F.wave * 16 + 4 * i4 + q;
            const LAS float* p = (r < 64 ? Qs + r * 132 : Ks + (r - 64) * 132); x0[q] = p[F.lane]; x1[q] = p[F.lane + 64]; ssv[q] = x0[q] * x0[q] + x1[q] * x1[q]; }
        wave_sum4(ssv);
#pragma unroll
        for (int q = 0; q < 4; ++q) { const int r = F.wave * 16 + 4 * i4 + q; LAS float* p = (r < 64 ? Qs + r * 132 : Ks + (r - 64) * 132);
            float sc = rsqrtf(ssv[q] + EPS); if (r < 64) sc *= 0.08838834764831845f;
            p[F.lane] = x0[q] * sc; p[F.lane + 64] = x1[q] * sc; }
    }
    if (tid < 64) {
        float sc = gc[tid];
#pragma unroll
        for (int d = 1; d < 64; d <<= 1) { const float t = __builtin_bit_cast(float, __builtin_amdgcn_ds_bpermute((tid - d) * 4, __builtin_bit_cast(int, sc))); if (tid >= d) sc += t; }
        gc[tid] = sc; eg[tid] = __expf(sc);
    }
    for (int i = tid; i < 64 * 68; i += 512) At[i] = 0.f;
    __syncthreads();
    for (int tj = F.wave; tj < 20; tj += 8) {
        const int kind = tj >= 10 ? 1 : 0, idx = tj - 10 * kind;
        const int mt = idx >= 6 ? 3 : (idx >= 3 ? 2 : (idx >= 1 ? 1 : 0)), nt = idx - mt * (mt + 1) / 2;
        const int fr = F.lane & 15, fq = F.lane >> 4;
        const LAS float* ap = (kind ? Qs : Ks) + (16 * mt + fr) * 132 + 4 * fq; const LAS float* bp = Ks + (16 * nt + fr) * 132 + 4 * fq;
        f32x4 acc = (f32x4){0.f, 0.f, 0.f, 0.f};
#pragma unroll
        for (int sg = 0; sg < 8; ++sg) { const f32x4 a4 = *(const LAS f32x4*)(ap + 16 * sg), b4 = *(const LAS f32x4*)(bp + 16 * sg);
#pragma unroll
            for (int j = 0; j < 4; ++j) acc = __builtin_amdgcn_mfma_f32_16x16x4f32(a4[j], b4[j], acc, 0, 0, 0); }
        const int j = 16 * nt + fr; const float gj = gc[j];
#pragma unroll
        for (int r = 0; r < 4; ++r) { const int i = 16 * mt + 4 * fq + r; const float dec = j <= i ? __expf(gc[i] - gj) : 0.f;
            if (kind) At[i * 68 + j] = acc[r] * dec; else Mm[i * 68 + j] = j < i ? beta[i] * acc[r] * dec : 0.f; }
    }
    __syncthreads();
    unsigned char* cb = F.ws + WS_GW + (size_t)job * GDN_CH_BYTES;
    bf16* gW = (bf16*)cb; bf16* gQD = (bf16*)(cb + 16384); bf16* gKDT = (bf16*)(cb + 32768); bf16* gUT = (bf16*)(cb + 49152); bf16* gAT = (bf16*)(cb + 65536);
    float sol[64];
    if (tid < 256) {
        const int cidx = tid & 127; const bool isw = tid >= 128;
        const LAS float* src = (isw ? Ks : Vs) + cidx;
        const LAS float* MmL = (const LAS float*)lds_vbase(Mm); const LAS float* betaL = (const LAS float*)lds_vbase(beta); const LAS float* egL = (const LAS float*)lds_vbase(eg);
#pragma unroll
        for (int i = 0; i < 64; ++i) sol[i] = 0.f;
#pragma unroll
        for (int i = 0; i < 64; ++i) {
            float r = src[i * 132] * betaL[i] * (isw ? egL[i] : 1.0f), r1 = 0.f, r2 = 0.f, r3 = 0.f;
#pragma unroll
            for (int j4 = 0; j4 < (i + 3) / 4; ++j4) { const f32x4 mv = *(const LAS f32x4*)(MmL + i * 68 + 4 * j4);
                r -= mv[0] * sol[4 * j4]; r1 -= mv[1] * sol[4 * j4 + 1]; r2 -= mv[2] * sol[4 * j4 + 2]; r3 -= mv[3] * sol[4 * j4 + 3]; }
            r = (r + r1) + (r2 + r3);
            sol[i] = r;
            asm volatile("" : "+v"(sol[i]) :: "memory");
        }
    } else {
        const int t2 = tid - 256;
        const float gl = gc[63];
        for (int i = t2; i < 64 * 16; i += 256) { const int r = i >> 4, c8 = (i & 15) * 8; const float e = eg[r]; const LAS float* s = Qs + r * 132 + c8;
            u32x4 o; o.x = pk2(s[0] * e, s[1] * e); o.y = pk2(s[2] * e, s[3] * e); o.z = pk2(s[4] * e, s[5] * e); o.w = pk2(s[6] * e, s[7] * e); *(u32x4*)(gQD + r * 128 + c8) = o; }
        for (int i = t2; i < 128 * 8; i += 256) { const int dk = i & 127, i8 = (i >> 7) * 8; float v[8];
#pragma unroll
            for (int q = 0; q < 8; ++q) v[q] = Ks[(i8 + q) * 132 + dk] * __expf(gl - gc[i8 + q]);
            u32x4 o; o.x = pk2(v[0], v[1]); o.y = pk2(v[2], v[3]); o.z = pk2(v[4], v[5]); o.w = pk2(v[6], v[7]); *(u32x4*)(gKDT + dk * 64 + i8) = o; }
        for (int i = t2; i < 64 * 8; i += 256) { const int r = i >> 3, c8 = (i & 7) * 8; const LAS float* s = At + r * 68 + c8;
            u32x4 o; o.x = pk2(s[0], s[1]); o.y = pk2(s[2], s[3]); o.z = pk2(s[4], s[5]); o.w = pk2(s[6], s[7]); *(u32x4*)(gAT + r * 64 + c8) = o; }
        if (t2 == 0) WSP(float, WS_GL)[job] = __expf(gl);
    }
    __syncthreads();
    LAS bf16* Wl = (LAS bf16*)Qs;
    if (tid < 128) {
#pragma unroll
        for (int q = 0; q < 8; ++q) { u32x4 o; o.x = pk2(sol[8 * q], sol[8 * q + 1]); o.y = pk2(sol[8 * q + 2], sol[8 * q + 3]); o.z = pk2(sol[8 * q + 4], sol[8 * q + 5]); o.w = pk2(sol[8 * q + 6], sol[8 * q + 7]);
            *(u32x4*)(gUT + tid * 64 + 8 * q) = o; }
    } else if (tid < 256) {
#pragma unroll
        for (int i = 0; i < 64; ++i) Wl[i * 136 + (tid - 128)] = (bf16)f2bf(sol[i]);
    }
    __syncthreads();
    for (int i = tid; i < 64 * 16; i += 512) { const int r = i >> 4, c8 = (i & 15) * 8; *(u32x4*)(gW + r * 128 + c8) = *(const LAS u32x4*)(Wl + r * 136 + c8); }
    __syncthreads();
}

DEV void ssd_conv8(const u32x4 (&xin)[11], const float* cw, const float* cbias, int cc, float (&y)[8][8]) {
    f32x4 w[4][2], bs[2];
#pragma unroll
    for (int k = 0; k < 4; ++k) { w[k][0] = *(const f32x4*)(cw + k * 1536 + cc); w[k][1] = *(const f32x4*)(cw + k * 1536 + cc + 4); }
    bs[0] = *(const f32x4*)(cbias + cc); bs[1] = *(const f32x4*)(cbias + cc + 4);
#pragma unroll
    for (int j = 0; j < 8; ++j) {
        float x[11];
#pragma unroll
        for (int i = 0; i < 11; ++i) { const unsigned wd = j < 2 ? xin[i].x : (j < 4 ? xin[i].y : (j < 6 ? xin[i].z : xin[i].w)); x[i] = (j & 1) ? bfhi(wd) : bflo(wd); }
        const float w0 = w[0][j >> 2][j & 3], w1 = w[1][j >> 2][j & 3], w2 = w[2][j >> 2][j & 3], w3 = w[3][j >> 2][j & 3], bj = bs[j >> 2][j & 3];
#pragma unroll
        for (int i = 0; i < 8; ++i) y[i][j] = siluf_(w0 * x[i] + w1 * x[i + 1] + w2 * x[i + 2] + w3 * x[i + 3] + bj);
    }
}
DEV bf16x8 frag_sw(const LAS bf16* M, int row, int chunk) { return *(const LAS bf16x8*)(M + row * 136 + 8 * (chunk ^ ((row >> 3) & 7))); }
DEV void ssd_prep_pass(Frame& F, const u32x4 (&xin)[11], const float* cw, const float* cbias, int cc, bf16* SX, float* dst0, LAS bf16* BT, LAS bf16* XT, const LAS float* dts, const LAS float* acs,
                       size_t row0, int s, int tg, int hh0) {
    const float zf_ = opaque_zero();
    {
        float y[8][8]; ssd_conv8(xin, cw, cbias, cc, y);
#pragma unroll
        for (int i = 0; i < 8; ++i) { u32x4 o; o.x = pk2(y[i][0], y[i][1]); o.y = pk2(y[i][2], y[i][3]); o.z = pk2(y[i][4], y[i][5]); o.w = pk2(y[i][6], y[i][7]);
            *(u32x4*)(SX + (row0 + i) * 1536 + cc) = o; }
        const int hh = hh0 + (s >> 3); const float al = acs[127 * 8 + hh]; float f[8];
#pragma unroll
        for (int i = 0; i < 8; ++i) f[i] = dts[(8 * tg + i) * 8 + hh] * __expf(al - acs[(8 * tg + i) * 8 + hh]);
#pragma unroll
        for (int j = 0; j < 8; ++j) { float v[8];
#pragma unroll
            for (int i = 0; i < 8; ++i) v[i] = bf2f(f2bf(y[i][j])) * f[i];
            u32x4 o; o.x = pk2(v[0], v[1]); o.y = pk2(v[2], v[3]); o.z = pk2(v[4], v[5]); o.w = pk2(v[6], v[7]);
            *(LAS u32x4*)(XT + (8 * s + j) * 136 + 8 * (tg ^ (s & 7))) = o; }
    }
    __syncthreads();
    {
        const int hp = F.wave >> 1, nh = F.wave & 1, fr = F.lane & 15, fq = F.lane >> 4;
        const LAS bf16* XTh = XT + hp * 64 * 136;
        float* dst = dst0 + (size_t)hp * 64 * 128;
#pragma unroll
        for (int mt = 0; mt < 4; ++mt) {
            bf16x8 a[4];
#pragma unroll
            for (int ks = 0; ks < 4; ++ks) a[ks] = frag_sw(XTh, 16 * mt + fr, 4 * ks + fq);
#pragma unroll
            for (int q = 0; q < 4; ++q) { const int nq = 4 * nh + q; f32x4 acc = ZERO4;
#pragma unroll
                for (int ks = 0; ks < 4; ++ks) acc = mfma16(frag_sw(BT, 16 * nq + fr, 4 * ks + fq), a[ks], acc);
                *(f32x4*)(dst + (size_t)(16 * mt + fr) * 128 + 16 * nq + 4 * fq) = acc; }
        }
    }
    __syncthreads();
}
DEV void ssd_prep_job(Frame& F, int l, int job) {
    const int b = job >> 7, c = (job >> 1) & 63, g = job & 1, t0 = 128 * c;
    const bf16* p1 = WSP(bf16, WS_P1); const float* small = WSP(float, WS_SMALL);
    const float* cw = lin(F, I_SCW, l, 4 * 1536); const float* cbias = lin(F, I_SCB, l, 1536);
    bf16* SX = WSP(bf16, WS_SX); float* SDT = WSP(float, WS_SDT); float* SAC = WSP(float, WS_SAC); float* SST = WSP(float, WS_SST); float* SCD = WSP(float, WS_SCD);
    LAS bf16* BT = (LAS bf16*)F.lds;
    LAS bf16* XT = BT + 128 * 136;
    LAS float* dts = (LAS float*)(XT + 4 * 64 * 136);
    LAS float* acs = dts + 128 * 8;
    const int tid = F.tid, s = tid & 31, tg = tid >> 5, ts = t0 + 8 * tg;
    const int ccA = 1024 + (s < 16 ? g * 128 + 8 * s : 256 + g * 128 + 8 * (s - 16));
    const int ccX = g * 512 + 8 * s;
    const size_t row0 = (size_t)(b * SEQ + ts);
    u32x4 xa[11], xb[11];
    conv_load11(xa, p1, b, ts, C_CX + ccA); conv_load11(xb, p1, b, ts, C_CX + ccX);
    for (int i = tid; i < 1024; i += 512) { const int tl = i >> 3, hh = i & 7, h = 8 * g + hh; const size_t row = (size_t)(b * SEQ + t0 + tl);
        const float dt = softplusf_(small[row * SMW + S_DT + h] + lin(F, I_SDTB, l, 16)[h]);
        dts[i] = dt; acs[i] = dt * (-__expf(lin(F, I_SALOG, l, 16)[h])); }
    __syncthreads();
    {
        const int hh = F.wave, ln = F.lane; const float v0 = acs[(2 * ln) * 8 + hh], v1 = acs[(2 * ln + 1) * 8 + hh];
        float sc = v0 + v1;
#pragma unroll
        for (int d = 1; d < 64; d <<= 1) { const float t = __builtin_bit_cast(float, __builtin_amdgcn_ds_bpermute((ln - d) * 4, __builtin_bit_cast(int, sc))); if (ln >= d) sc += t; }
        float ex = __builtin_bit_cast(float, __builtin_amdgcn_ds_bpermute((ln - 1) * 4, __builtin_bit_cast(int, sc))); if (ln == 0) ex = 0.f;
        const float a0 = ex + v0; acs[(2 * ln) * 8 + hh] = a0; acs[(2 * ln + 1) * 8 + hh] = a0 + v1;
    }
    __syncthreads();
    for (int i = tid; i < 1024; i += 512) { const int tl = i >> 3, hh = i & 7; const size_t row = (size_t)(b * SEQ + t0 + tl); SDT[row * 16 + 8 * g + hh] = dts[i]; SAC[row * 16 + 8 * g + hh] = acs[i]; }
    if (tid < 8) SCD[(size_t)(b * 64 + c) * 16 + 8 * g + tid] = __expf(acs[127 * 8 + tid]);
    {
        float y[8][8]; ssd_conv8(xa, cw, cbias, ccA, y);
#pragma unroll
        for (int i = 0; i < 8; ++i) { u32x4 o; o.x = pk2(y[i][0], y[i][1]); o.y = pk2(y[i][2], y[i][3]); o.z = pk2(y[i][4], y[i][5]); o.w = pk2(y[i][6], y[i][7]);
            *(u32x4*)(SX + (row0 + i) * 1536 + ccA) = o; }
        if (s < 16) {
#pragma unroll
            for (int j = 0; j < 8; ++j) { u32x4 o; o.x = pk2(y[0][j], y[1][j]); o.y = pk2(y[2][j], y[3][j]); o.z = pk2(y[4][j], y[5][j]); o.w = pk2(y[6][j], y[7][j]);
                *(LAS u32x4*)(BT + (8 * s + j) * 136 + 8 * (tg ^ (s & 7))) = o; }
        }
    }
    conv_load11(xa, p1, b, ts, C_CX + ccX + 256);
    float* dst0 = SST + ((size_t)((b * 64 + c) * 16 + 8 * g) * 64) * 128;
    ssd_prep_pass(F, xb, cw, cbias, ccX, SX, dst0, BT, XT, dts, acs, row0, s, tg, 0);
    ssd_prep_pass(F, xa, cw, cbias, ccX + 256, SX, dst0 + (size_t)4 * 64 * 128, BT, XT, dts, acs, row0, s, tg, 4);
}

DEV void nsa_compress_job(Frame& F, int l, int job) {
    const int kv = job >> 4, bg = (job >> 2) & 3, rt = job & 3, b = bg >> 1, g = bg & 1, i0 = 128 * rt;
    const float zf_ = opaque_zero();
    const bf16* p1 = WSP(bf16, WS_P1); const bf16* Wt = WSP(bf16, kv ? WS_WCV : WS_WCK); const float* cst = WSP(float, WS_CONST) + kv * 128;
    const int col0 = (kv ? C_BVC : C_BKC) + g * 128;
    LAS bf16* As = (LAS bf16*)F.lds;
    LAS bf16* Bs = As + 128 * 72;
    LAS float* Cs = (LAS float*)(Bs + 128 * 72);
    const int tid = F.tid, wm = F.wave >> 1, wn = F.wave & 1;
    f32x4 acc[2][4];
#pragma unroll
    for (int i = 0; i < 2; ++i)
#pragma unroll
        for (int j = 0; j < 4; ++j) acc[i][j] = ZERO4;
    u32x4 ra[2], rb[2];
#define LOADK(ks_) do { _Pragma("unroll") for (int q = 0; q < 2; ++q) { const int ch = tid + 512 * q, r = ch >> 3, c8 = (ch & 7) * 8; \
            int t = 16 * (i0 + r) + ((ks_) >> 1); if (t > SEQ - 1) t = SEQ - 1;     \
            ra[q] = *(const u32x4*)(p1 + (size_t)(b * SEQ + t) * P1W + col0 + ((ks_) & 1) * 64 + c8); \
            rb[q] = *(const u32x4*)(Wt + (size_t)r * 4096 + 64 * (ks_) + c8); } } while (0)
    LOADK(0);
    for (int ks = 0; ks < 64; ++ks) {
        __syncthreads();
#pragma unroll
        for (int q = 0; q < 2; ++q) { const int ch = tid + 512 * q, r = ch >> 3, c8 = (ch & 7) * 8; *(LAS u32x4*)(As + r * 72 + c8) = ra[q]; *(LAS u32x4*)(Bs + r * 72 + c8) = rb[q]; }
        __syncthreads();
        if (ks + 1 < 64) LOADK(ks + 1);
#pragma unroll
        for (int k2 = 0; k2 < 2; ++k2) {
            bf16x8 a0 = frag_l(As, 72, 32 * wm, 32 * k2, F.lane), a1 = frag_l(As, 72, 32 * wm + 16, 32 * k2, F.lane);
#pragma unroll
            for (int j = 0; j < 4; ++j) { const bf16x8 bb = frag_l(Bs, 72, 64 * wn + 16 * j, 32 * k2, F.lane); acc[0][j] = mfma16(a0, bb, acc[0][j]); acc[1][j] = mfma16(a1, bb, acc[1][j]); }
        }
    }
    __syncthreads();
#pragma unroll
    for (int i = 0; i < 2; ++i)
#pragma unroll
        for (int j = 0; j < 4; ++j)
#pragma unroll
            for (int r = 0; r < 4; ++r) { const int col = 64 * wn + 16 * j + (F.lane & 15); Cs[(32 * wm + 16 * i + 4 * (F.lane >> 4) + r) * 132 + col] = acc[i][j][r] + cst[col]; }
    __syncthreads();
    if (kv == 0) {
        const float* kn = lin(F, I_NKN, l, 128); bf16* KC = WSP(bf16, WS_KCMP);
        const int r = tid >> 2, q = tid & 3; const LAS float* s = Cs + r * 132 + 32 * q; float ss = 0.f;
#pragma unroll
        for (int e = 0; e < 32; ++e) ss += s[e] * s[e];
        ss += shx<1>(ss); ss += shx<2>(ss);
        const float rs = rsqrtf(ss * (1.0f / 128.0f) + EPS);
        bf16* dst = KC + ((size_t)bg * 512 + i0 + r) * 128 + 32 * q;
#pragma unroll
        for (int e = 0; e < 32; e += 2) *(unsigned*)(dst + e) = pk2(s[e] * rs * kn[32 * q + e], s[e + 1] * rs * kn[32 * q + e + 1]);
    } else {
        bf16* VC = WSP(bf16, WS_VCMPT); const int e = tid & 127, q = tid >> 7;
#pragma unroll
        for (int i8 = 0; i8 < 4; ++i8) { const LAS float* s = Cs + (32 * q + 8 * i8) * 132 + e;
            u32x4 o; o.x = pk2(s[0], s[132]); o.y = pk2(s[264], s[396]); o.z = pk2(s[528], s[660]); o.w = pk2(s[792], s[924]);
            *(u32x4*)(VC + ((size_t)bg * 128 + e) * 512 + i0 + 32 * q + 8 * i8) = o; }
    }
    __syncthreads();
}
#undef LOADK

constexpr int AL_KT = 0, AL_VT = 17408, AL_KT1 = 35840, AL_UW = 53248, AL_TB = 54272, AL_SM = 60608, AL_PS = 61696, AL_IMP = 78336, AL_VT1 = 111104, AL_END = 129536;
static_assert(AL_KT1 + 17408 <= AL_UW && AL_UW + 128 <= AL_TB && AL_END <= MISC_OFF, "attention LDS map");
DEV int rel_bucket_dev(int n) {
    if (n < 16) return n;
    int k = 16;
    k += (n >= 21); k += (n >= 27); k += (n >= 35); k += (n >= 46); k += (n >= 59); k += (n >= 77); k += (n >= 99); k += (n >= 128);
    k += (n >= 166); k += (n >= 216); k += (n >= 280); k += (n >= 363); k += (n >= 470); k += (n >= 609); k += (n >= 790);
    return k;
}
DEV void attn_fill_bias(Frame& F, int g) {
    LAS float* tb = (LAS float*)(F.lds + AL_TB); const float* rt = F.p->in[I_REL];
    for (int i = F.tid; i < 2 * 792; i += 512) { const int hg = i / 792, d = i - hg * 792; tb[i] = rt[rel_bucket_dev(d) * 4 + 2 * g + hg] * 1.4426950408889634f; }
}
DEV void attn_load_tile(u32x4 (&rk)[2], u32x4 (&rv)[2], const bf16* ksrc, const bf16* vsrc, int vpitch, int tid) {
#pragma unroll
    for (int q = 0; q < 2; ++q) { const int ch = tid + 512 * q; rk[q] = *(const u32x4*)(ksrc + (size_t)ch * 8); rv[q] = *(const u32x4*)(vsrc + (size_t)(ch >> 3) * vpitch + (ch & 7) * 8); }
}
DEV void attn_store_tile(LAS unsigned char* lds, int buf, const u32x4 (&rk)[2], const u32x4 (&rv)[2], int tid) {
    LAS bf16* Kt = (LAS bf16*)(lds + (buf ? AL_KT1 : AL_KT)); LAS bf16* Vt = (LAS bf16*)(lds + (buf ? AL_VT1 : AL_VT));
#pragma unroll
    for (int q = 0; q < 2; ++q) { const int ch = tid + 512 * q; *(LAS u32x4*)(Kt + (ch >> 4) * 136 + (ch & 15) * 8) = rk[q]; *(LAS u32x4*)(Vt + (ch >> 3) * 72 + (ch & 7) * 8) = rv[q]; }
}
template <int MODE, int PATH = 0>
DEV unsigned attn_scores(LAS unsigned char* lds, int buf, const bf16x8 (&qf)[4], int lane, int n0, int tok, int hg, unsigned selbit, f32x4 (&s)[4]) {
    const float zf_ = opaque_zero();
    const LAS bf16* Kt = (const LAS bf16*)(lds + (buf ? AL_KT1 : AL_KT)); const LAS float* tb = (const LAS float*)(lds + AL_TB) + hg * 792;
#pragma unroll
    for (int nt = 0; nt < 4; ++nt) { s[nt] = ZERO4;
#pragma unroll
        for (int ks = 0; ks < 4; ++ks) s[nt] = mfma16(frag_l(Kt, 136, 16 * nt, 32 * ks, lane), qf[ks], s[nt]); }
    if (PATH == 1) {
        const float bf = tb[790]; const bool ok = selbit != 0u;
#pragma unroll
        for (int nt = 0; nt < 4; ++nt)
#pragma unroll
            for (int r = 0; r < 4; ++r) s[nt][r] = ok ? s[nt][r] + bf : -1e30f;
        return ok ? 0xffffu : 0u;
    }
    if (PATH == 2) {
        const bool ok = MODE == 2 ? true : (selbit != 0u);
        const LAS float* tp = tb + (tok - n0 - 4 * (lane >> 4));
#pragma unroll
        for (int nt = 0; nt < 4; ++nt)
#pragma unroll
            for (int r = 0; r < 4; ++r) s[nt][r] = ok ? s[nt][r] + tp[-16 * nt - r] : -1e30f;
        return ok ? 0xffffu : 0u;
    }
    unsigned vm = 0u;
#pragma unroll
    for (int nh = 0; nh < 2; ++nh) {
        float bv[8];
#pragma unroll
        for (int q = 0; q < 8; ++q) { const int nt = 2 * nh + (q >> 2), r = q & 3; const int n = n0 + 16 * nt + 4 * (lane >> 4) + r; const int dist = MODE == 0 ? tok - (16 * n + 31) : tok - n;
            int di = dist < 0 ? 0 : dist; di = di > 790 ? 790 : di; bv[q] = tb[di]; }
#pragma unroll
        for (int q = 0; q < 8; ++q) asm volatile("" : "+v"(bv[q]));
#pragma unroll
        for (int q = 0; q < 8; ++q) { const int nt = 2 * nh + (q >> 2), r = q & 3; const int n = n0 + 16 * nt + 4 * (lane >> 4) + r; int dist; bool ok;
            if (MODE == 0) { dist = tok - (16 * n + 31); ok = dist >= 0 && n < 511; }
            else if (MODE == 1) { dist = tok - n; ok = dist >= 0 && selbit != 0u; }
            else { dist = tok - n; ok = dist >= 0 && dist < 512; }
            s[nt][r] = ok ? s[nt][r] + bv[q] : -1e30f;
            vm |= (ok ? 1u : 0u) << (4 * nt + r); }
    }
    return vm;
}
DEV float fq_max(float v) {
    const auto a = __builtin_amdgcn_permlane16_swap(__builtin_bit_cast(unsigned, v), __builtin_bit_cast(unsigned, v), false, false);
    const float m = fmaxf(__builtin_bit_cast(float, a[0]), __builtin_bit_cast(float, a[1]));
    const auto b = __builtin_amdgcn_permlane32_swap(__builtin_bit_cast(unsigned, m), __builtin_bit_cast(unsigned, m), false, false);
    return fmaxf(__builtin_bit_cast(float, b[0]), __builtin_bit_cast(float, b[1]));
}
DEV float fq_sum(float v) {
    const auto a = __builtin_amdgcn_permlane16_swap(__builtin_bit_cast(unsigned, v), __builtin_bit_cast(unsigned, v), false, false);
    const float m = __builtin_bit_cast(float, a[0]) + __builtin_bit_cast(float, a[1]);
    const auto b = __builtin_amdgcn_permlane32_swap(__builtin_bit_cast(unsigned, m), __builtin_bit_cast(unsigned, m), false, false);
    return __builtin_bit_cast(float, b[0]) + __builtin_bit_cast(float, b[1]);
}
DEV float attn_online(const f32x4 (&s)[4], unsigned vm, float& m, float& l, f32x4 (&p)[4]) {
    float mx = fmaxf(fmaxf(fmaxf(s[0][0], s[0][1]), fmaxf(s[0][2], s[0][3])), fmaxf(fmaxf(s[1][0], s[1][1]), fmaxf(s[1][2], s[1][3])));
    mx = fmaxf(mx, fmaxf(fmaxf(fmaxf(s[2][0], s[2][1]), fmaxf(s[2][2], s[2][3])), fmaxf(fmaxf(s[3][0], s[3][1]), fmaxf(s[3][2], s[3][3]))));
    mx = fmaxf(mx, shx<16>(mx)); mx = fmaxf(mx, shx<32>(mx));
    const float mn = fmaxf(m, mx), sc = __builtin_amdgcn_exp2f(m - mn); float rs = 0.f;
#pragma unroll
    for (int nt = 0; nt < 4; ++nt)
#pragma unroll
        for (int r = 0; r < 4; ++r) { const float pv = ((vm >> (4 * nt + r)) & 1u) ? __builtin_amdgcn_exp2f(s[nt][r] - mn) : 0.f; p[nt][r] = pv; rs += pv; }
    rs += shx<16>(rs); rs += shx<32>(rs);
    l = l * sc + rs; m = mn;
    return sc;
}
DEV void attn_pv(LAS unsigned char* lds, int buf, int lane, const f32x4 (&p)[4], f32x4 (&o)[8]) {
    const LAS bf16* Vt = (const LAS bf16*)(lds + (buf ? AL_VT1 : AL_VT)) + (lane & 15) * 72 + 4 * (lane >> 4);
#pragma unroll
    for (int ks = 0; ks < 2; ++ks) {
        u32x4 pw; pw.x = pg8::cvt_pk_bf16(p[2 * ks][0], p[2 * ks][1]); pw.y = pg8::cvt_pk_bf16(p[2 * ks][2], p[2 * ks][3]); pw.z = pg8::cvt_pk_bf16(p[2 * ks + 1][0], p[2 * ks + 1][1]); pw.w = pg8::cvt_pk_bf16(p[2 * ks + 1][2], p[2 * ks + 1][3]);
        const bf16x8 pb = __builtin_bit_cast(bf16x8, pw);
#pragma unroll
        for (int dt = 0; dt < 8; ++dt) {
            const u32x2 v0 = *(const LAS u32x2*)(Vt + 16 * dt * 72 + 32 * ks), v1 = *(const LAS u32x2*)(Vt + 16 * dt * 72 + 32 * ks + 16);
            u32x4 vw; vw.x = v0.x; vw.y = v0.y; vw.z = v1.x; vw.w = v1.y;
            o[dt] = mfma16(__builtin_bit_cast(bf16x8, vw), pb, o[dt]); }
    }
}
DEV void attn_load_q(Frame& F, int bg, int t0, bf16x8 (&qf)[4]) {
    const bf16* QN = WSP(bf16, WS_QN); const int rho = F.lane & 15;
    const bf16* src = QN + ((size_t)(bg * SEQ + t0 + 8 * F.wave + (rho & 7)) * 2 + (rho >> 3)) * 128 + 8 * (F.lane >> 4);
#pragma unroll
    for (int ks = 0; ks < 4; ++ks) qf[ks] = *(const bf16x8*)(src + 32 * ks);
}

DEV void sel_step(Frame& F, const bf16* KS, const bf16* VS, int j, int jn, int jnn, int qt, int cb, const u32x4 (&st_k)[2], const u32x4 (&st_v)[2], u32x4 (&ld_k)[2], u32x4 (&ld_v)[2],
                  const bf16x8 (&qf)[4], const u32x4& smw, const unsigned (&wum)[4], int tok, int hg, float& m, float& l, f32x4 (&o)[8]) {
    const int lane = F.lane;
    if (jnn <= qt) attn_load_tile(ld_k, ld_v, KS + (size_t)jnn * 64 * 128, VS + (size_t)jnn * 128 * 64, 64, F.tid);
    const unsigned wsel = j < 32 ? wum[0] : (j < 64 ? wum[1] : (j < 96 ? wum[2] : wum[3]));
    if ((wsel >> (j & 31)) & 1u) {
        const unsigned w = j < 32 ? smw.x : (j < 64 ? smw.y : (j < 96 ? smw.z : smw.w)); const unsigned selbit = (w >> (j & 31)) & 1u;
        f32x4 s[4], p[4];
        const unsigned vm = (j <= qt - 14) ? attn_scores<1, 1>(F.lds, cb, qf, lane, 64 * j, tok, hg, selbit, s) : ((j >= qt - 11 && j < qt) ? attn_scores<1, 2>(F.lds, cb, qf, lane, 64 * j, tok, hg, selbit, s) : attn_scores<1, 0>(F.lds, cb, qf, lane, 64 * j, tok, hg, selbit, s));
        const float sc = attn_online(s, vm, m, l, p);
        if (__ballot(sc != 1.0f) != 0ull) {
#pragma unroll
            for (int dt = 0; dt < 8; ++dt) o[dt] = o[dt] * sc; }
        attn_pv(F.lds, cb, lane, p, o);
    }
    if (jn <= qt) attn_store_tile(F.lds, cb ^ 1, st_k, st_v, F.tid);
    __syncthreads();
}
DEV int sel_next(int j, int qt, const unsigned (&um)[4]) {
    int jn = j + 1;
    while (jn <= qt) { const unsigned w = jn < 32 ? um[0] : (jn < 64 ? um[1] : (jn < 96 ? um[2] : um[3])); if ((w >> (jn & 31)) & 1u) break; ++jn; }
    return jn;
}
#define NST(k) do { if (DBG_AJOB >= 10 && F.tid == 0) { volatile LAS unsigned* m_ = (volatile LAS unsigned*)(F.lds + MISC_OFF); const unsigned t_ = (unsigned)__builtin_amdgcn_s_memrealtime(); \
        if (DBG_AJOB == (k)) atomicAdd(WSP(unsigned, WS_CTL) + 460000, t_ - m_[70]); m_[70] = t_; } } while (0)
DEV void nsa_job(Frame& F, int job) {
    const int bg = job >> 7, qt = job & 127, b = bg >> 1, g = bg & 1, t0 = 64 * qt, tid = F.tid, lane = F.lane, wave = F.wave;
    const float zf_ = opaque_zero();
    const int fq = lane >> 4, fr = lane & 15, hg = fr >> 3, tok = t0 + 8 * wave + (fr & 7);
    const float* small = WSP(float, WS_SMALL); const size_t row = (size_t)(b * SEQ + tok);
    LAS float* PS = (LAS float*)(F.lds + AL_PS) + wave * (8 * 65); LAS float* IMP = (LAS float*)(F.lds + AL_IMP);
    LAS unsigned* SM = (LAS unsigned*)(F.lds + AL_SM);
    LAS unsigned* UW = (LAS unsigned*)(F.lds + AL_UW);
    __syncthreads();
    NST(0);
    attn_fill_bias(F, g);
    for (int i = tid; i < 64 * 128; i += 512) IMP[i] = 0.f;
    if (lane < 8) PS[lane * 65] = 0.f;
    bf16x8 qf[4]; attn_load_q(F, bg, t0, qf);
    f32x4 tot[8];
    u32x4 rk[2], rv[2];
    NST(10);
    for (int dr_ = 0; dr_ < (DBG_NSA == 1 ? 2 : 1); ++dr_) {
        if (dr_ == 1) { WAVE_SYNC(); if (lane < 8) PS[lane * 65] = 0.f; WAVE_SYNC(); }
        const int ntiles = (4 * qt + 2) / 64 + 1;
        const bf16* KC = WSP(bf16, WS_KCMP) + (size_t)bg * 512 * 128; const bf16* VC = WSP(bf16, WS_VCMPT) + (size_t)bg * 128 * 512;
        float m = -1e30f, l = 0.f;
        attn_load_tile(rk, rv, KC, VC, 512, tid); attn_store_tile(F.lds, 0, rk, rv, tid); __syncthreads();
        for (int j = 0; j < ntiles; ++j) {
            if (j + 1 < ntiles) attn_load_tile(rk, rv, KC + (size_t)(j + 1) * 64 * 128, VC + (j + 1) * 64, 512, tid);
            f32x4 s[4], p[4];
            const unsigned vm = attn_scores<0>(F.lds, j & 1, qf, lane, 64 * j, tok, hg, 0u, s);
            (void)attn_online(s, vm, m, l, p);
            if (j + 1 < ntiles) attn_store_tile(F.lds, (j + 1) & 1, rk, rv, tid);
            __syncthreads();
        }
        const float il = l > 0.f ? 1.0f / l : 0.f;
        f32x4 o[8];
#pragma unroll
        for (int dt = 0; dt < 8; ++dt) o[dt] = ZERO4;
        attn_load_tile(rk, rv, KC, VC, 512, tid); attn_store_tile(F.lds, 0, rk, rv, tid); __syncthreads();
        for (int j = 0; j < ntiles; ++j) {
            if (j + 1 < ntiles) attn_load_tile(rk, rv, KC + (size_t)(j + 1) * 64 * 128, VC + (j + 1) * 64, 512, tid);
            f32x4 s[4], p[4];
            const unsigned vm = attn_scores<0>(F.lds, j & 1, qf, lane, 64 * j, tok, hg, 0u, s);
#pragma unroll
            for (int nt = 0; nt < 4; ++nt)
#pragma unroll
                for (int r = 0; r < 4; ++r) {
                    const float pv = ((vm >> (4 * nt + r)) & 1u) ? __builtin_amdgcn_exp2f(s[nt][r] - m) * il : 0.f; p[nt][r] = pv;
                    const float ps = pv + shx<8>(pv);
                    if (fr < 8) PS[fr * 65 + 1 + 16 * nt + 4 * fq + r] = ps;
                }
            WAVE_SYNC();
#pragma unroll
            for (int q = 0; q < 2; ++q) { const int idx = lane + 64 * q, tk = idx >> 4, bl = idx & 15; const LAS float* ps = PS + tk * 65 + 4 * bl;
                IMP[(8 * wave + tk) * 128 + 16 * j + bl] = ps[0] + 2.0f * ps[1] + 2.0f * ps[2] + 2.0f * ps[3] + ps[4]; }
            WAVE_SYNC();
            if (lane < 8) PS[lane * 65] = PS[lane * 65 + 64];
            WAVE_SYNC();
            attn_pv(F.lds, j & 1, lane, p, o);
            if (j + 1 < ntiles) attn_store_tile(F.lds, (j + 1) & 1, rk, rv, tid);
            __syncthreads();
        }
        const float gt = (DBG_NSAZ & 1) ? zf_ : sigmoidf_(small[row * SMW + S_BG + (2 * g + hg) * 3 + 0]);
#pragma unroll
        for (int dt = 0; dt < 8; ++dt) tot[dt] = o[dt] * gt;
    }
    NST(11);
    unsigned wum[4] = {0u, 0u, 0u, 0u};
    for (int dr_ = 0; dr_ < (DBG_NSA == 4 ? 2 : 1); ++dr_) {
        const int cur = qt;
        for (int tk = 0; tk < 8; ++tk) {
            const LAS float* rowp = IMP + (8 * wave + tk) * 128;
            const int b0 = lane, b1 = lane + 64;
            const float s0 = b0 > cur ? -1e4f : ((b0 == 0 || b0 >= cur - 1) ? 1e4f : rowp[b0]);
            const float s1 = b1 > cur ? -1e4f : ((b1 == 0 || b1 >= cur - 1) ? 1e4f : rowp[b1]);
            unsigned k0 = __builtin_bit_cast(unsigned, s0), k1 = __builtin_bit_cast(unsigned, s1);
            k0 = (k0 & 0x80000000u) ? ~k0 : (k0 | 0x80000000u); k1 = (k1 & 0x80000000u) ? ~k1 : (k1 | 0x80000000u);
            unsigned prefix = 0u; int need = 16;
            for (int bit = 31; bit >= 0; --bit) {
                const unsigned cand = (prefix | (1u << bit)) >> bit;
                const int cnt = __builtin_popcountll(__ballot((k0 >> bit) == cand)) + __builtin_popcountll(__ballot((k1 >> bit) == cand));
                if (cnt >= need) prefix |= (1u << bit); else need -= cnt;
            }
            const unsigned long long e0 = __ballot(k0 == prefix), e1 = __ballot(k1 == prefix);
            const int r0 = (int)__builtin_amdgcn_mbcnt_hi((unsigned)(e0 >> 32), __builtin_amdgcn_mbcnt_lo((unsigned)e0, 0u));
            const int r1 = __builtin_popcountll(e0) + (int)__builtin_amdgcn_mbcnt_hi((unsigned)(e1 >> 32), __builtin_amdgcn_mbcnt_lo((unsigned)e1, 0u));
            const bool sel0 = k0 > prefix || (k0 == prefix && r0 < need), sel1 = k1 > prefix || (k1 == prefix && r1 < need);
            const unsigned long long m0 = __ballot(sel0), m1 = __ballot(sel1);
            const unsigned w0 = (unsigned)m0, w1 = (unsigned)(m0 >> 32), w2 = (unsigned)m1, w3 = (unsigned)(m1 >> 32);
            wum[0] |= w0; wum[1] |= w1; wum[2] |= w2; wum[3] |= w3;
            if (lane == 0) { SM[(8 * wave + tk) * 4 + 0] = w0; SM[(8 * wave + tk) * 4 + 1] = w1; SM[(8 * wave + tk) * 4 + 2] = w2; SM[(8 * wave + tk) * 4 + 3] = w3; }
        }
        if (lane == 0) { UW[wave * 4 + 0] = wum[0]; UW[wave * 4 + 1] = wum[1]; UW[wave * 4 + 2] = wum[2]; UW[wave * 4 + 3] = wum[3]; }
    }
    __syncthreads();
    const u32x4 smw = *(const LAS u32x4*)(SM + (8 * wave + (fr & 7)) * 4);
    unsigned um[4];
#pragma unroll
    for (int w = 0; w < 4; ++w) { unsigned v = 0u;
#pragma unroll
        for (int q = 0; q < 8; ++q) v |= UW[q * 4 + w];
        um[w] = __builtin_amdgcn_readfirstlane(v); }
    const bf16* KS = WSP(bf16, WS_KS) + (size_t)bg * SEQ * 128; const bf16* VS = WSP(bf16, WS_VST) + (size_t)bg * 128 * 8192;
    const bf16* KW = WSP(bf16, WS_KW) + (size_t)bg * SEQ * 128; const bf16* VW = WSP(bf16, WS_VWT) + (size_t)bg * 128 * 8192;
    NST(12);
    for (int dr_ = 0; dr_ < (DBG_NSA == 2 ? 2 : 1); ++dr_) {
        float m = -1e30f, l = 0.f; f32x4 o[8];
#pragma unroll
        for (int dt = 0; dt < 8; ++dt) o[dt] = ZERO4;
        u32x4 rk2[2], rv2[2];
        int j = 0, jn = sel_next(0, qt, um), cb = 0;
        attn_load_tile(rk, rv, KS, VS, 64, tid); attn_store_tile(F.lds, 0, rk, rv, tid);
        if (jn <= qt) attn_load_tile(rk, rv, KS + (size_t)jn * 64 * 128, VS + (size_t)jn * 128 * 64, 64, tid);
        __syncthreads();
        while (j <= qt) {
            int jnn = jn <= qt ? sel_next(jn, qt, um) : jn;
            sel_step(F, KS, VS, j, jn, jnn, qt, cb, rk, rv, rk2, rv2, qf, smw, wum, tok, hg, m, l, o);
            cb ^= 1; j = jn; jn = jnn;
            if (j > qt) break;
            jnn = jn <= qt ? sel_next(jn, qt, um) : jn;
            sel_step(F, KS, VS, j, jn, jnn, qt, cb, rk2, rv2, rk, rv, qf, smw, wum, tok, hg, m, l, o);
            cb ^= 1; j = jn; jn = jnn;
        }
        const float gt = ((DBG_NSA == 2 && dr_ == 0) || (DBG_NSAZ & 2)) ? zf_ * l : sigmoidf_(small[row * SMW + S_BG + (2 * g + hg) * 3 + 1]) / l;
#pragma unroll
        for (int dt = 0; dt < 8; ++dt) tot[dt] = tot[dt] + o[dt] * gt;
    }
    NST(13);
    for (int dr_ = 0; dr_ < (DBG_NSA == 3 ? 2 : 1); ++dr_) {
        float m = -1e30f, l = 0.f; f32x4 o[8];
#pragma unroll
        for (int dt = 0; dt < 8; ++dt) o[dt] = ZERO4;
        const int j0 = qt >= 8 ? qt - 8 : 0;
        attn_load_tile(rk, rv, KW + (size_t)j0 * 64 * 128, VW + (size_t)j0 * 128 * 64, 64, tid); attn_store_tile(F.lds, 0, rk, rv, tid); __syncthreads();
        for (int j = j0; j <= qt; ++j) {
            const int cb = (j - j0) & 1;
            if (j + 1 <= qt) attn_load_tile(rk, rv, KW + (size_t)(j + 1) * 64 * 128, VW + (size_t)(j + 1) * 128 * 64, 64, tid);
            f32x4 s[4], p[4];
            const unsigned vm = (j >= qt - 7 && j < qt) ? attn_scores<2, 2>(F.lds, cb, qf, lane, 64 * j, tok, hg, 0u, s) : attn_scores<2, 0>(F.lds, cb, qf, lane, 64 * j, tok, hg, 0u, s);
            const float sc = attn_online(s, vm, m, l, p);
#pragma unroll
            for (int dt = 0; dt < 8; ++dt) o[dt] = o[dt] * sc;
            attn_pv(F.lds, cb, lane, p, o);
            if (j + 1 <= qt) attn_store_tile(F.lds, cb ^ 1, rk, rv, tid);
            __syncthreads();
        }
        const float gt = ((DBG_NSA == 3 && dr_ == 0) || (DBG_NSAZ & 4)) ? zf_ * l : sigmoidf_(small[row * SMW + S_BG + (2 * g + hg) * 3 + 2]) / l;
#pragma unroll
        for (int dt = 0; dt < 8; ++dt) tot[dt] = tot[dt] + o[dt] * gt;
    }
    NST(14);
    {
        bf16* YC = WSP(bf16, WS_YCAT);
#pragma unroll
        for (int dt = 0; dt < 8; ++dt) { const int cidx = (2 * g + hg) * 128 + 16 * dt + 4 * fq;
            f32x4 y = tot[dt]; if (DBG_ZERO & 2) y = ZERO4;
            u32x2 w; w.x = pk2(y[0], y[1]); w.y = pk2(y[2], y[3]); *(u32x2*)(YC + row * 2048 + 512 + cidx) = w; }
    }
    __syncthreads();
    NST(15);
}
#undef NST

DEV void gdn_scan_job(Frame& F, int job) {
    const int bh = job >> 3, sl = job & 7, b = bh >> 2, h = bh & 3, lane = F.lane, wave = F.wave, fq = lane >> 4, fr = lane & 15;
    LAS bf16* St = (LAS bf16*)F.lds;
    LAS bf16* Vn = St + 16 * 136;
    const float* GL = WSP(float, WS_GL); float* GO = WSP(float, WS_GO);
    const float zf_ = opaque_zero();
    __syncthreads();
    for (int i = F.tid; i < 16 * 136 / 2; i += 512) ((LAS unsigned*)St)[i] = 0u;
    f32x4 S = ZERO4;
    const int mt = wave & 3;
    __syncthreads();
    const int o1 = (wave < 4 ? 0 : 8192) + (16 * mt + fr) * 128 + 8 * fq;
    const int oA = 32768 + (16 * mt + fr) * 64 + 8 * fq;
    const int oK = 16384 + (16 * wave + fr) * 64 + 8 * fq;
    const int oU = 24576 + (16 * sl + fr) * 64 + 16 * mt + 4 * fq;
    const bf16* rec = (const bf16*)(F.ws + WS_GW + (size_t)(bh * 128) * GDN_CH_BYTES);
    bf16x8 a1[4], aA[2], aK[2], n1[4], nA[2], nK[2]; u32x2 uu, nu; float gl, ngl;
#define GLOAD(A1, AA, AK, UU, G, c_) do { const bf16* r_ = rec + (size_t)(c_) * (GDN_CH_BYTES / 2); \
        _Pragma("unroll") for (int ks = 0; ks < 4; ++ks) A1[ks] = *(const bf16x8*)(r_ + o1 + 32 * ks); \
        AA[0] = *(const bf16x8*)(r_ + oA); AA[1] = *(const bf16x8*)(r_ + oA + 32); AK[0] = *(const bf16x8*)(r_ + oK); AK[1] = *(const bf16x8*)(r_ + oK + 32); \
        UU = *(const u32x2*)(r_ + oU); G = GL[bh * 128 + (c_)]; } while (0)
    GLOAD(a1, aA, aK, uu, gl, 0);
    for (int c = 0; c < 128; ++c) {
        const int cn = c + 1 < 128 ? c + 1 : c;
        GLOAD(n1, nA, nK, nu, ngl, cn);
        f32x4 d1 = ZERO4;
#pragma unroll
        for (int ks = 0; ks < 4; ++ks) d1 = mfma16(a1[ks], frag_l(St, 136, 0, 32 * ks, lane), d1);
        if (wave < 4) {
            const float v0 = bflo(uu.x) - d1[0], v1 = bfhi(uu.x) - d1[1], v2 = bflo(uu.y) - d1[2], v3 = bfhi(uu.y) - d1[3];
            u32x2 w; w.x = pk2(v0, v1); w.y = pk2(v2, v3);
            *(LAS u32x2*)(Vn + fr * 72 + 16 * mt + 4 * fq) = w;
        }
        LDS_WAIT(); __builtin_amdgcn_s_barrier(); CFENCE();
        const bf16x8 bv0 = frag_l(Vn, 72, 0, 0, lane), bv1 = frag_l(Vn, 72, 0, 32, lane);
        if (wave >= 4) {
            d1 = mfma16(aA[0], bv0, d1); d1 = mfma16(aA[1], bv1, d1);
#pragma unroll
            for (int r = 0; r < 4; ++r) GO[(size_t)(b * SEQ + 64 * c + 16 * mt + 4 * fq + r) * 512 + h * 128 + 16 * sl + fr] = d1[r];
        }
        f32x4 dk = ZERO4;
        dk = mfma16(aK[0], bv0, dk); dk = mfma16(aK[1], bv1, dk);
        S = S * gl + dk;
        { u32x2 w; w.x = pk2(S[0], S[1]); w.y = pk2(S[2], S[3]); *(LAS u32x2*)(St + fr * 136 + 16 * wave + 4 * fq) = w; }
        LDS_WAIT(); __builtin_amdgcn_s_barrier(); CFENCE();
#pragma unroll
        for (int ks = 0; ks < 4; ++ks) a1[ks] = n1[ks];
        aA[0] = nA[0]; aA[1] = nA[1]; aK[0] = nK[0]; aK[1] = nK[1]; uu = nu; gl = ngl;
    }
#undef GLOAD
    __syncthreads();
}

DEV void ssd_scan_part(Frame& F, int part, int nparts) {
    float* __restrict__ SST = WSP(float, WS_SST); const float* __restrict__ SCD = WSP(float, WS_SCD);
    constexpr int PER_B = 16 * 64 * 128;
    for (int e = part * 512 + F.tid; e < 2 * PER_B; e += nparts * 512) {
        const int b = e / PER_B, r = e - b * PER_B, h = r >> 13;
        float* p = SST + (size_t)(b * 64) * PER_B + r; const float* cdp = SCD + (b * 64) * 16 + h;
        float s = 0.f;
#pragma unroll
        for (int hb = 0; hb < 2; ++hb) {
            float v[32], cd[32];
#pragma unroll
            for (int c = 0; c < 32; ++c) { v[c] = p[(size_t)(32 * hb + c) * PER_B]; cd[c] = cdp[(32 * hb + c) * 16]; }
#pragma unroll
            for (int c = 0; c < 32; ++c) { p[(size_t)(32 * hb + c) * PER_B] = s; s = s * cd[c] + v[c]; }
        }
    }
}

DEV void gdn_final_rows(Frame& F, int l, int w0, int nw) {
    const float* GO = WSP(float, WS_GO); const bf16* p1 = WSP(bf16, WS_P1); bf16* YC = WSP(bf16, WS_YCAT); const float* gn = lin(F, I_GNORM, l, 128);
    const int lane = F.lane, dv0 = (lane & 15) * 8;
    float gv[8];
#pragma unroll
    for (int j = 0; j < 8; ++j) gv[j] = gn[dv0 + j];
    for (int row = w0; row < MTOK; row += nw) {
        const f32x4 a = *(const f32x4*)(GO + (size_t)row * 512 + lane * 8), bq = *(const f32x4*)(GO + (size_t)row * 512 + lane * 8 + 4);
        float ss = (a[0] * a[0] + a[1] * a[1]) + (a[2] * a[2] + a[3] * a[3]) + (bq[0] * bq[0] + bq[1] * bq[1]) + (bq[2] * bq[2] + bq[3] * bq[3]);
        ss = sum16(ss);
        const float rs = rsqrtf(ss * (1.0f / 128.0f) + EPS);
        const u32x4 zw = *(const u32x4*)(p1 + (size_t)row * P1W + C_AZ + lane * 8);
        const float z[8] = {bflo(zw.x), bfhi(zw.x), bflo(zw.y), bfhi(zw.y), bflo(zw.z), bfhi(zw.z), bflo(zw.w), bfhi(zw.w)};
        const float o[8] = {a[0], a[1], a[2], a[3], bq[0], bq[1], bq[2], bq[3]};
        float y[8];
#pragma unroll
        for (int j = 0; j < 8; ++j) y[j] = (DBG_ZERO & 1) ? opaque_zero() : o[j] * rs * gv[j] * siluf_(z[j]);
        u32x4 w; w.x = pk2(y[0], y[1]); w.y = pk2(y[2], y[3]); w.z = pk2(y[4], y[5]); w.w = pk2(y[6], y[7]);
        *(u32x4*)(YC + (size_t)row * 2048 + lane * 8) = w;
    }
}

DEV void ssd_out_job(Frame& F, int l, int job) {
    const int b = job >> 7, c = (job >> 1) & 63, g = job & 1, t0 = 128 * c, tid = F.tid, lane = F.lane, wave = F.wave, fq = lane >> 4, fr = lane & 15;
    const bf16* SX = WSP(bf16, WS_SX); const bf16* p1 = WSP(bf16, WS_P1); const float* SDT = WSP(float, WS_SDT); const float* SAC = WSP(float, WS_SAC); const float* SST = WSP(float, WS_SST);
    bf16* YC = WSP(bf16, WS_YCAT); float* RC = WSP(float, WS_SRC);
    const float zf_ = opaque_zero();
    LAS bf16* Cs = (LAS bf16*)F.lds;
    LAS bf16* Bs = Cs + 128 * 136;
    LAS bf16* XdT = Bs + 128 * 136;
    LAS bf16* SiT = XdT + 64 * 136;
    LAS bf16* Pw = SiT + 64 * 136;
    LAS float* acs = (LAS float*)(Pw + 8 * 16 * 136);
    __syncthreads();
    for (int i = tid; i < 2 * 128 * 16; i += 512) { const int v = i >> 11, r = (i >> 4) & 127, c8 = (i & 15) * 8;
        const u32x4 w = *(const u32x4*)(SX + (size_t)(b * SEQ + t0 + r) * 1536 + 1024 + (v ? 256 : 0) + g * 128 + c8);
        *(LAS u32x4*)((v ? Cs : Bs) + r * 136 + c8) = w; }
    for (int i = tid; i < 1024; i += 512) { const size_t row = (size_t)(b * SEQ + t0 + (i >> 3)); acs[i] = SAC[row * 16 + 8 * g + (i & 7)]; }
    __syncthreads();
    f32x4 cb[8];
    {
        bf16x8 ca[4];
#pragma unroll
        for (int ks = 0; ks < 4; ++ks) ca[ks] = frag_l(Cs, 136, 16 * wave, 32 * ks, lane);
#pragma unroll
        for (int nt = 0; nt < 8; ++nt) { cb[nt] = ZERO4;
#pragma unroll
            for (int ks = 0; ks < 4; ++ks) cb[nt] = mfma16(ca[ks], frag_l(Bs, 136, 16 * nt, 32 * ks, lane), cb[nt]); }
    }
    float ssq = 0.f;
    LAS bf16* pw = Pw + wave * 16 * 136;
    const float* dsk = lin(F, I_SD, l, 16);
    const int sp = tid & 7, tp = tid >> 3; const size_t rp0 = (size_t)(b * SEQ + t0 + 2 * tp);
    const size_t rowl = (size_t)(b * SEQ + t0 + 16 * wave + fr);
    u32x4 x0, x1; float d0, d1; f32x4 sv[4];
#define SSD_LOADH(h_) do { x0 = *(const u32x4*)(SX + rp0 * 1536 + (h_) * 64 + 8 * sp); x1 = *(const u32x4*)(SX + (rp0 + 1) * 1536 + (h_) * 64 + 8 * sp); d0 = SDT[rp0 * 16 + (h_)]; d1 = SDT[(rp0 + 1) * 16 + (h_)]; \
        const float* sin_ = SST + ((size_t)((b * 64 + c) * 16 + (h_)) * 64) * 128; _Pragma("unroll") for (int q = 0; q < 4; ++q) sv[q] = *(const f32x4*)(sin_ + (size_t)(tid + 512 * q) * 4); } while (0)
    SSD_LOADH(8 * g);
    for (int hh = 0; hh < 8; ++hh) {
        const int h = 8 * g + hh;
        __syncthreads();
        {
            const unsigned xw0[4] = {x0.x, x0.y, x0.z, x0.w}, xw1[4] = {x1.x, x1.y, x1.z, x1.w};
#pragma unroll
            for (int j = 0; j < 8; ++j) { const float a = ((j & 1) ? bfhi(xw0[j >> 1]) : bflo(xw0[j >> 1])) * d0, bb = ((j & 1) ? bfhi(xw1[j >> 1]) : bflo(xw1[j >> 1])) * d1;
                *(LAS unsigned*)(XdT + (8 * sp + j) * 136 + 2 * tp) = pk2(a, bb); }
#pragma unroll
            for (int q = 0; q < 4; ++q) { const int i = tid + 512 * q, p = i >> 5, n4 = (i & 31) * 4; u32x2 w; w.x = pk2(sv[q][0], sv[q][1]); w.y = pk2(sv[q][2], sv[q][3]); *(LAS u32x2*)(SiT + p * 136 + n4) = w; }
        }
        float al[4];
#pragma unroll
        for (int r = 0; r < 4; ++r) al[r] = acs[(16 * wave + 4 * fq + r) * 8 + hh];
#pragma unroll
        for (int nt = 0; nt < 8; ++nt) { const int s = 16 * nt + fr; const float as = acs[s * 8 + hh];
#pragma unroll
            for (int r = 0; r < 4; ++r) { const int li = 16 * wave + 4 * fq + r; const float v = s <= li ? cb[nt][r] * __expf(al[r] - as) : 0.f; pw[(4 * fq + r) * 136 + s] = (bf16)f2bf(v); } }
        u32x2 xv[4], zv[4];
#pragma unroll
        for (int nt = 0; nt < 4; ++nt) { xv[nt] = *(const u32x2*)(SX + rowl * 1536 + h * 64 + 16 * nt + 4 * fq); zv[nt] = *(const u32x2*)(p1 + rowl * P1W + C_CZ + h * 64 + 16 * nt + 4 * fq); }
        if (hh + 1 < 8) SSD_LOADH(h + 1);
        __syncthreads();
        f32x4 y[4], ys[4];
#pragma unroll
        for (int nt = 0; nt < 4; ++nt) { y[nt] = ZERO4; ys[nt] = ZERO4; }
#pragma unroll
        for (int ks = 0; ks < 4; ++ks) { const bf16x8 pa = frag_l(pw, 136, 0, 32 * ks, lane), cc = frag_l(Cs, 136, 16 * wave, 32 * ks, lane);
#pragma unroll
            for (int nt = 0; nt < 4; ++nt) { y[nt] = mfma16(frag_l(XdT, 136, 16 * nt, 32 * ks, lane), pa, y[nt]); ys[nt] = mfma16(frag_l(SiT, 136, 16 * nt, 32 * ks, lane), cc, ys[nt]); } }
        const float dh = dsk[h], ea = __expf(acs[(16 * wave + fr) * 8 + hh]);
#pragma unroll
        for (int nt = 0; nt < 4; ++nt) {
            const float xs[4] = {bflo(xv[nt].x), bfhi(xv[nt].x), bflo(xv[nt].y), bfhi(xv[nt].y)}, zz[4] = {bflo(zv[nt].x), bfhi(zv[nt].x), bflo(zv[nt].y), bfhi(zv[nt].y)};
            float v[4];
#pragma unroll
            for (int r = 0; r < 4; ++r) { v[r] = (DBG_ZERO & 4) ? zf_ : (y[nt][r] + ea * ys[nt][r] + xs[r] * dh) * siluf_(zz[r]); ssq += v[r] * v[r]; }
            u32x2 w; w.x = pk2(v[0], v[1]); w.y = pk2(v[2], v[3]); *(u32x2*)(YC + rowl * 2048 + 1024 + h * 64 + 16 * nt + 4 * fq) = w;
        }
    }
#undef SSD_LOADH
    { float s = ssq; s += shx<16>(s); s += shx<32>(s); if (fq == 0) RC[rowl * 2 + g] = rsqrtf(s * (1.0f / 512.0f) + EPS); }
    __syncthreads();
}

constexpr int NPH = 12;
#ifndef CPU_EMU
DEV unsigned long long launder64(unsigned long long v) {
    unsigned lo = __builtin_amdgcn_readfirstlane((unsigned)v), hi = __builtin_amdgcn_readfirstlane((unsigned)(v >> 32));
    asm volatile("" : "+s"(lo), "+s"(hi));
    return ((unsigned long long)hi << 32) | lo;
}
DEV bool phase_begin(Frame& F, const Params& prm, int wave0) {
    F.ws = (unsigned char*)launder64((unsigned long long)prm.ws);
    F.p = (KParams)launder64((unsigned long long)__builtin_amdgcn_kernarg_segment_ptr());
    unsigned z = 0u; asm volatile("" : "+v"(z)); const int ln = (int)__builtin_amdgcn_mbcnt_hi(~0u, __builtin_amdgcn_mbcnt_lo(~0u, z));
    int wv = wave0; asm volatile("" : "+s"(wv)); F.wave = wv; F.lane = ln; F.tid = wv * 64 + ln;
    int bi = __builtin_amdgcn_readfirstlane(blockIdx.x); asm volatile("" : "+s"(bi)); F.bid = bi;
    int gg = __builtin_amdgcn_readfirstlane(gridDim.x); asm volatile("" : "+s"(gg)); F.G = gg;
    unsigned la = __builtin_amdgcn_readfirstlane((unsigned)(size_t)F.lds); asm volatile("" : "+s"(la)); F.lds = (LAS unsigned char*)(size_t)la;
    return true;
}
DEV void job_begin(Frame& F) { int t = F.tid; asm volatile("" : "+v"(t)); F.tid = t; F.lane = t & 63; }
__global__ void __launch_bounds__(512, 2) hybrid_fwd(Params prm) {
    extern __shared__ __attribute__((aligned(16))) unsigned char lds_raw[];
    Frame F;
    F.lds = (LAS unsigned char*)lds_raw; F.tid = threadIdx.x; F.lane = F.tid & 63; F.wave = __builtin_amdgcn_readfirstlane(F.tid >> 6);
    const int wave0 = F.wave;
    F.G = gridDim.x; F.bid = blockIdx.x; F.p = (KParams)__builtin_amdgcn_kernarg_segment_ptr(); F.ws = prm.ws;
    volatile LAS unsigned* MISC = (volatile LAS unsigned*)(F.lds + MISC_OFF);
    if (F.tid < 64) MISC[F.tid] = 0u;
    if (DBG_TMASK && F.tid < 8) MISC[64 + F.tid] = 0u;
    __syncthreads();
    unsigned* ctl = (unsigned*)(F.ws + WS_CTL);
    XcdBarrier bar; bar.bar = ctl + CW_BAR; bar.x = 0; bar.st = nullptr;
    if (prm.use_bar) bar = xcd_barrier_post(ctl + CW_BAR, MISC + 8);
    const int lo = prm.lo, hi = prm.hi;
    for (int l = 0; l < DEPTH; ++l) {
#define IN(k) (lo <= l * NPH + (k) && l * NPH + (k) < hi && phase_begin(F, prm, wave0))
#define REP_BEGIN(k) for (int rep_ = 0; rep_ < ((DBG_REP == (k)) ? 2 : 1); ++rep_) {
#define REP_END(k) if (DBG_REP == (k) && rep_ == 0) { XcdBarrier bb_ = bar; bb_.bar = (unsigned*)launder64((unsigned long long)bar.bar); xcd_barrier(bb_); } }
#define SEAM(k) do { if (l * NPH + (k) + 1 < hi && prm.use_bar) { XcdBarrier bb_ = bar; bb_.bar = (unsigned*)launder64((unsigned long long)bar.bar); { unsigned x_ = __builtin_amdgcn_readfirstlane(bar.x); asm volatile("" : "+s"(x_)); bb_.x = x_; } xcd_barrier(bb_); } } while (0)
#define TB(k) do { if (((DBG_TMASK >> (k)) & 1) && F.bid == 0 && F.tid == 0) { volatile LAS unsigned* m_ = (volatile LAS unsigned*)(F.lds + MISC_OFF); m_[64] = (unsigned)__builtin_amdgcn_s_memrealtime(); m_[68] = 1u; } } while (0)
#define TE(k) do { if (((DBG_TMASK >> (k)) & 1) && F.bid == 0 && F.tid == 0) { volatile LAS unsigned* m_ = (volatile LAS unsigned*)(F.lds + MISC_OFF); if (!DBG_TEPI) m_[66] = m_[66] + ((unsigned)__builtin_amdgcn_s_memrealtime() - m_[64]); m_[68] = 0u; } } while (0)
#define JT(ty, call) do { if (DBG_AJOB == (ty) && F.tid == 0) { volatile LAS unsigned* m_ = (volatile LAS unsigned*)(F.lds + MISC_OFF); m_[70] = (unsigned)__builtin_amdgcn_s_memrealtime(); } \
        call; if (DBG_AJOB == (ty) && F.tid == 0) { volatile LAS unsigned* m_ = (volatile LAS unsigned*)(F.lds + MISC_OFF); atomicAdd(WSP(unsigned, WS_CTL) + 460000, (unsigned)__builtin_amdgcn_s_memrealtime() - m_[70]); } } while (0)
#define RSB(i) (WSP(unsigned long long, WS_CTL) + CW_RS / 2 + (size_t)(3 * l + (i)) * MTOK)
#define XB WSP(bf16, WS_XB)
#define ACT WSP(bf16, WS_ACT)
        if (IN(0)) { TB(0); REP_BEGIN(0) phase_convert(F, l); REP_END(0) SEAM(0); TE(0); }
        if (IN(1)) { TB(1); REP_BEGIN(1) pg8::Gemm g{XB, WSP(bf16, WS_WUP1), MTOK, NUP, DM, DM, DM}; pg8::StaticOrder S; S.init(MTOK, NUP, F.G, F.bid);
            pg8::EpiSwiGLU E{ACT, RSB(0)}; pg8::gemm_phase<pg8::EpiSwiGLU, pg8::StaticOrder>(F.lds, F.tid, g, S, E); REP_END(1) SEAM(1); TE(1); }
        if (IN(2)) { TB(2); pg8::Gemm g{ACT, WSP(bf16, WS_WDN1), MTOK, DM, DFF, DFF, DFF}; pg8::StaticOrder S; S.init(MTOK, DM, F.G, F.bid);
            pg8::EpiResidual E{prm.out, XB, RSB(1), 0.5f}; pg8::gemm_phase<pg8::EpiResidual, pg8::StaticOrder>(F.lds, F.tid, g, S, E); SEAM(2); TE(2); }
        if (IN(3)) { TB(3); REP_BEGIN(3) pg8::Gemm g{XB, WSP(bf16, WS_WIN), MTOK, NINP, DM, DM, DM}; pg8::StaticOrder S; S.init(MTOK, NINP, F.G, F.bid);
            pg8::EpiWin E{WSP(bf16, WS_P1), WSP(float, WS_SMALL), WSP(bf16, WS_GATE), RSB(1)}; pg8::gemm_phase<pg8::EpiWin, pg8::StaticOrder>(F.lds, F.tid, g, S, E); REP_END(3) SEAM(3); TE(3); }
        if (IN(4)) { TB(4);
            REP_BEGIN(4)
            {
                unsigned* ctr = WSP(unsigned, WS_CTL) + CW_WQ + 64 * (8 + l * 2 + rep_);
                LAS unsigned* jslot = (LAS unsigned*)(F.lds + MISC_OFF + 128);
                for (;;) {
                    __syncthreads();
                    if (F.tid == 0) *jslot = __hip_atomic_fetch_add(ctr, 1u, __ATOMIC_RELAXED, __HIP_MEMORY_SCOPE_AGENT);
                    __syncthreads();
                    const int j = (int)*jslot;
                    if (j >= 32 + 1024 + 256 + 512) break;
                    job_begin(F);
                    if (j < 32) JT(1, nsa_compress_job(F, l, j));
                    else if (j < 32 + 256) JT(2, ssd_prep_job(F, l, j - 32));
                    else if (j < 32 + 256 + 1024) JT(3, gdn_prep_job(F, l, j - 32 - 256));
                    else JT(4, nsa_prep_job(F, l, j - 32 - 256 - 1024));
                }
            }
            REP_END(4)
            SEAM(4); TE(4);
        }
        if (IN(5)) { TB(5);
            REP_BEGIN(5)
            if (F.bid < 64) JT(6, gdn_scan_job(F, (F.bid & 7) * 8 + (F.bid >> 3)));
            {
                unsigned* ctr = WSP(unsigned, WS_CTL) + CW_WQ + 64 * (16 + (l * 2 + rep_) * 8);
                LAS unsigned* jslot = (LAS unsigned*)(F.lds + MISC_OFF + 128);
                const unsigned myq = xb_xcc_id() & 7u;
                for (;;) {
                    __syncthreads();
                    if (F.tid == 0) {
                        unsigned got = 0xffffffffu;
                        for (unsigned t = 0; t < 8u && got == 0xffffffffu; ++t) { const unsigned q = (myq + t) & 7u;
                            if (__hip_atomic_load(ctr + 64 * q, __ATOMIC_RELAXED, __HIP_MEMORY_SCOPE_AGENT) >= 64u) continue;
                            const unsigned k = __hip_atomic_fetch_add(ctr + 64 * q, 1u, __ATOMIC_RELAXED, __HIP_MEMORY_SCOPE_AGENT);
                            if (k < 64u) { const unsigned kk = k < 8u ? 63u - k : k - 8u;
                                got = (q >> 1) * 128u + (127u - (2u * kk + (q & 1u))); } }
                        *jslot = got;
                    }
                    __syncthreads();
                    const unsigned j = *jslot;
                    if (j == 0xffffffffu) break;
                    job_begin(F);
                    JT(5, nsa_job(F, (int)j));
                }
                if (rep_ == 0) {
                    unsigned* ctr2 = WSP(unsigned, WS_CTL) + CW_WQ + 64 * (80 + l);
                    for (;;) {
                        __syncthreads();
                        if (F.tid == 0) *jslot = __hip_atomic_fetch_add(ctr2, 1u, __ATOMIC_RELAXED, __HIP_MEMORY_SCOPE_AGENT);
                        __syncthreads();
                        const unsigned s = *jslot;
                        if (s >= 512u) break;
                        JT(7, ssd_scan_part(F, (int)s, 512));
                    }
                }
            }
            REP_END(5)
            SEAM(5); TE(5);
        }
        if (IN(7)) { TB(7);
            REP_BEGIN(7)
            for (int j = F.bid; j < 256; j += F.G) { job_begin(F); JT(8, ssd_out_job(F, l, j)); }
            job_begin(F);
            JT(9, gdn_final_rows(F, l, F.bid * 8 + F.wave, F.G * 8));
            REP_END(7)
            SEAM(7); TE(7);
        }
        if (IN(8)) { TB(8); REP_BEGIN(8) pg8::Gemm g{WSP(bf16, WS_YCAT), WSP(bf16, WS_WPM), MTOK, DM, 512, DM, DM}; pg8::SegOrder S; S.init(MTOK, DM, F.G, F.bid, 512);
            pg8::EpiMergeSeg E{WSP(bf16, WS_MERGED), WSP(bf16, WS_GATE), WSP(float, WS_SRC)}; pg8::gemm_phase<pg8::EpiMergeSeg, pg8::SegOrder>(F.lds, F.tid, g, S, E); REP_END(8) SEAM(8); TE(8); }
        if (IN(9)) { TB(9); pg8::Gemm g{WSP(bf16, WS_MERGED), WSP(bf16, WS_WO), MTOK, DM, DM, DM, DM}; pg8::StaticOrder S; S.init(MTOK, DM, F.G, F.bid);
            pg8::EpiResidual E{prm.out, XB, RSB(2), 1.0f}; pg8::gemm_phase<pg8::EpiResidual, pg8::StaticOrder>(F.lds, F.tid, g, S, E); SEAM(9); TE(9); }
        if (IN(10)) { TB(10); pg8::Gemm g{XB, WSP(bf16, WS_WUP2), MTOK, NUP, DM, DM, DM}; pg8::StaticOrder S; S.init(MTOK, NUP, F.G, F.bid);
            pg8::EpiSwiGLU E{ACT, RSB(2)}; pg8::gemm_phase<pg8::EpiSwiGLU, pg8::StaticOrder>(F.lds, F.tid, g, S, E); SEAM(10); TE(10); }
        if (IN(11)) { TB(11); pg8::Gemm g{ACT, WSP(bf16, WS_WDN2), MTOK, DM, DFF, DFF, DFF}; pg8::StaticOrder S; S.init(MTOK, DM, F.G, F.bid);
            pg8::EpiResidual E{prm.out, XB, RSB(3), 0.5f}; pg8::gemm_phase<pg8::EpiResidual, pg8::StaticOrder>(F.lds, F.tid, g, S, E); SEAM(11); TE(11); }
#undef IN
#undef SEAM
#undef TB
#undef JT
#undef TE
#undef REP_BEGIN
#undef REP_END
#undef RSB
#undef XB
#undef ACT
    }
    if (DBG_AJOB) {
        XcdBarrier bb_ = bar; bb_.bar = (unsigned*)launder64((unsigned long long)bar.bar); xcd_barrier(bb_);
        if (blockIdx.x == 0 && wave0 == 0 && __builtin_amdgcn_mbcnt_hi(~0u, __builtin_amdgcn_mbcnt_lo(~0u, 0u)) == 0u) {
            const unsigned a_ = __hip_atomic_load((unsigned*)(prm.ws + WS_CTL) + 460000, __ATOMIC_RELAXED, __HIP_MEMORY_SCOPE_AGENT); const unsigned t0_ = (unsigned)__builtin_amdgcn_s_memrealtime();
            while ((unsigned)__builtin_amdgcn_s_memrealtime() - t0_ < a_ / 32u) __builtin_amdgcn_s_sleep(32);
        }
    }
    if (DBG_TMASK && blockIdx.x == 0 && wave0 == 0 && __builtin_amdgcn_mbcnt_hi(~0u, __builtin_amdgcn_mbcnt_lo(~0u, 0u)) == 0u) {
        volatile LAS unsigned* m_ = (volatile LAS unsigned*)(F.lds + MISC_OFF); const unsigned a_ = m_[66]; const unsigned t0_ = (unsigned)__builtin_amdgcn_s_memrealtime();
        while ((unsigned)__builtin_amdgcn_s_memrealtime() - t0_ < (unsigned)DBG_TAMP * a_) __builtin_amdgcn_s_sleep(32);
    }
}

#ifndef DBG_DUMP
#define DBG_DUMP 0
#endif
#ifndef DBG_STOP
#define DBG_STOP 48
#endif
__global__ void dbg_dump_bf16(const unsigned short* src, size_t n, float* out, size_t nout) {
    for (size_t i = (size_t)blockIdx.x * blockDim.x + threadIdx.x; i < nout; i += (size_t)gridDim.x * blockDim.x) { float s = 0.f; for (size_t k = i; k < n; k += nout) s += __builtin_bit_cast(float, (unsigned)src[k] << 16); out[i] = s; }
}
__global__ void dbg_dump_f32(const float* src, size_t n, float* out, size_t nout) {
    for (size_t i = (size_t)blockIdx.x * blockDim.x + threadIdx.x; i < nout; i += (size_t)gridDim.x * blockDim.x) { float s = 0.f; for (size_t k = i; k < n; k += nout) s += src[k]; out[i] = s; }
}
#ifndef N_LAUNCH_MODE
#define N_LAUNCH_MODE 0
#endif
extern "C" void kernel_launch(void* const* d_in, const int* in_sizes, int n_in, void* d_out, int out_size, void* d_ws, size_t ws_size, hipStream_t stream) {
    static int grid = 0;
    if (grid == 0) {
        if (n_in != 30 || out_size != MTOK * DM || ws_size < WS_END) { fprintf(stderr, "kernel_launch: unexpected shapes (n_in %d out %d ws %zu, need %zu)\n", n_in, out_size, ws_size, (size_t)WS_END); grid = -1; return; }
        int dev = 0, cus = 0, per_cu = 0;
        if (hipGetDevice(&dev) != hipSuccess || hipDeviceGetAttribute(&cus, hipDeviceAttributeMultiprocessorCount, dev) != hipSuccess) { grid = -1; return; }
        if (hipFuncSetAttribute((const void*)hybrid_fwd, hipFuncAttributeMaxDynamicSharedMemorySize, LDS_BYTES) != hipSuccess) { fprintf(stderr, "kernel_launch: hipFuncSetAttribute failed\n"); grid = -1; return; }
        if (hipOccupancyMaxActiveBlocksPerMultiprocessor(&per_cu, (const void*)hybrid_fwd, 512, LDS_BYTES) != hipSuccess || per_cu < 1) { fprintf(stderr, "kernel_launch: occupancy query says %d\n", per_cu); }
        (void)hipGetLastError();
        grid = cus;
    }
    if (grid < 0) return;
    (void)hipMemsetAsync((char*)d_ws + WS_CTL, 0, CTL_BYTES, stream);
    Params p{};
    for (int i = 0; i < 30; ++i) p.in[i] = (const float*)d_in[i];
    p.out = (float*)d_out; p.ws = (unsigned char*)d_ws; p.pad = 0;
    if (N_LAUNCH_MODE == 0) { p.lo = 0; p.hi = DEPTH * NPH; p.use_bar = 1; hipLaunchKernelGGL(hybrid_fwd, dim3(grid), dim3(512), LDS_BYTES, stream, p); }
    else { for (int ph = 0; ph < (DBG_DUMP ? DBG_STOP : DEPTH * NPH); ++ph) { p.lo = ph; p.hi = ph + 1; p.use_bar = 0; hipLaunchKernelGGL(hybrid_fwd, dim3(grid), dim3(512), LDS_BYTES, stream, p); } }
    if (DBG_DUMP) {
        const size_t nout = (size_t)MTOK * DM; char* w = (char*)d_ws;
        if (DBG_DUMP == 1) hipLaunchKernelGGL(dbg_dump_bf16, dim3(2048), dim3(256), 0, stream, (const unsigned short*)(w + WS_P1), (size_t)MTOK * P1W, (float*)d_out, nout);
        if (DBG_DUMP == 2) hipLaunchKernelGGL(dbg_dump_f32, dim3(2048), dim3(256), 0, stream, (const float*)(w + WS_SMALL), (size_t)MTOK * SMW, (float*)d_out, nout);
        if (DBG_DUMP == 3) hipLaunchKernelGGL(dbg_dump_bf16, dim3(2048), dim3(256), 0, stream, (const unsigned short*)(w + WS_GW), (size_t)1024 * GDN_CH_BYTES / 2, (float*)d_out, nout);
        if (DBG_DUMP == 4) hipLaunchKernelGGL(dbg_dump_f32, dim3(2048), dim3(256), 0, stream, (const float*)(w + WS_SST), (size_t)2 * 64 * 16 * 64 * 128, (float*)d_out, nout);
        if (DBG_DUMP == 5) hipLaunchKernelGGL(dbg_dump_f32, dim3(2048), dim3(256), 0, stream, (const float*)(w + WS_GO), (size_t)MTOK * 512, (float*)d_out, nout);
        if (DBG_DUMP == 6) hipLaunchKernelGGL(dbg_dump_bf16, dim3(2048), dim3(256), 0, stream, (const unsigned short*)(w + WS_YCAT), (size_t)MTOK * 2048, (float*)d_out, nout);
        if (DBG_DUMP == 7) hipLaunchKernelGGL(dbg_dump_bf16, dim3(2048), dim3(256), 0, stream, (const unsigned short*)(w + WS_MERGED), (size_t)MTOK * 2048, (float*)d_out, nout);
        if (DBG_DUMP == 8) hipLaunchKernelGGL(dbg_dump_bf16, dim3(2048), dim3(256), 0, stream, (const unsigned short*)(w + WS_SX), (size_t)MTOK * 1536, (float*)d_out, nout);
        if (DBG_DUMP == 9) hipLaunchKernelGGL(dbg_dump_bf16, dim3(2048), dim3(256), 0, stream, (const unsigned short*)(w + WS_GATE), (size_t)MTOK * 6144, (float*)d_out, nout);
        if (DBG_DUMP == 11) hipLaunchKernelGGL(dbg_dump_f32, dim3(2048), dim3(256), 0, stream, (const float*)(w + WS_SRC), (size_t)MTOK * 2, (float*)d_out, nout);
        if (DBG_DUMP == 12) hipLaunchKernelGGL(dbg_dump_bf16, dim3(2048), dim3(256), 0, stream, (const unsigned short*)(w + WS_WPM), (size_t)DM * DM, (float*)d_out, nout);
        if (DBG_DUMP == 13) hipLaunchKernelGGL(dbg_dump_f32, dim3(2048), dim3(256), 0, stream, (const float*)(w + WS_MTMP), (size_t)MTOK * DM, (float*)d_out, nout);
        if (DBG_DUMP == 15) hipLaunchKernelGGL(dbg_dump_bf16, dim3(2048), dim3(256), 0, stream, (const unsigned short*)(w + WS_ACT), (size_t)MTOK * DFF, (float*)d_out, nout);
        if (DBG_DUMP == 16) hipLaunchKernelGGL(dbg_dump_bf16, dim3(2048), dim3(256), 0, stream, (const unsigned short*)(w + WS_XB), (size_t)MTOK * DM, (float*)d_out, nout);
        if (DBG_DUMP == 17) hipLaunchKernelGGL(dbg_dump_bf16, dim3(2048), dim3(256), 0, stream, (const unsigned short*)(w + WS_WIN), (size_t)NINP * DM, (float*)d_out, nout);
        if (DBG_DUMP == 18) hipLaunchKernelGGL(dbg_dump_f32, dim3(2048), dim3(256), 0, stream, (const float*)(w + WS_CTL) + CW_RS, (size_t)NRS * MTOK, (float*)d_out, nout);
        if (DBG_DUMP == 10) hipLaunchKernelGGL(dbg_dump_f32, dim3(2048), dim3(256), 0, stream, (const float*)(w + WS_YB), (size_t)MTOK * 512, (float*)d_out, nout);
    }
}
#endif
```

```cpp
#include <hip/hip_runtime.h>
#include <cstdio>
#include <cstdint>

#ifndef CPU_EMU
#define DEV __device__ __forceinline__
#define LAS __attribute__((address_space(3)))
#define VM_WAIT() asm volatile("s_waitcnt vmcnt(0)" ::: "memory")
#define LDS_WAIT() asm volatile("s_waitcnt lgkmcnt(0)" ::: "memory")
#define CFENCE() asm volatile("" ::: "memory")
#define WAVE_SYNC() do { asm volatile("" ::: "memory"); __builtin_amdgcn_wave_barrier(); asm volatile("" ::: "memory"); } while (0)
#endif

#define DBG_DUMP 0
#define DBG_NSAZ 0
#define DBG_NSA 0
#define DBG_REP (-1)
#define DBG_STOP 48
#define DBG_TMASK 0
#define DBG_TAMP 8
#define DBG_AJOB 0
#define DBG_TEPI 0
#ifndef DBG_ZERO
#define DBG_ZERO 0
#endif
typedef unsigned short bf16;
typedef short bf16x8 __attribute__((ext_vector_type(8)));
typedef float f32x4 __attribute__((ext_vector_type(4)));
typedef float f32x2 __attribute__((ext_vector_type(2)));
typedef unsigned u32x4 __attribute__((ext_vector_type(4)));
typedef unsigned u32x2 __attribute__((ext_vector_type(2)));

constexpr int BATCH = 2, SEQ = 8192, DM = 2048, DEPTH = 4, DFF = 5504, NUP = 2 * DFF;
constexpr int MTOK = BATCH * SEQ;
constexpr int NIN = 12836, NINP = 13056;
constexpr int P1W = 6656;
constexpr int SM0 = 6656;
constexpr int GT0 = 6912;
constexpr float EPS = 1e-6f;
constexpr int C_AQ = 0, C_AK = 512, C_AV = 1024, C_AZ = 1536, C_BQ = 2048, C_BKC = 2560, C_BVC = 2816, C_BKS = 3072, C_BVS = 3328, C_BKW = 3584, C_BVW = 3840, C_CZ = 4096, C_CX = 5120;
constexpr int S_AA = 0, S_AB = 4, S_BG = 8, S_DT = 20, SMW = 64;

constexpr size_t MiB = 1u << 20;
constexpr size_t WS_CTL = 0, CTL_BYTES = 2 * MiB;
constexpr size_t WS_WUP1 = 2 * MiB;
constexpr size_t WS_WDN1 = WS_WUP1 + (size_t)NUP * DM * 2;
constexpr size_t WS_WIN = WS_WDN1 + (size_t)DM * DFF * 2;
constexpr size_t WS_WPM = WS_WIN + (size_t)NINP * DM * 2;
constexpr size_t WS_WO = WS_WPM + (size_t)DM * DM * 2;
constexpr size_t WS_WUP2 = WS_WO + (size_t)DM * DM * 2;
constexpr size_t WS_WDN2 = WS_WUP2 + (size_t)NUP * DM * 2;
constexpr size_t WS_WCK = WS_WDN2 + (size_t)DM * DFF * 2;
constexpr size_t WS_WCV = WS_WCK + 128 * 4096 * 2;
constexpr size_t WS_CONST = WS_WCV + 128 * 4096 * 2;
constexpr size_t WS_WEND = WS_CONST + 4096;
static_assert(WS_WEND <= 212 * MiB, "weights region");
constexpr size_t WS_XB = 212 * MiB;
constexpr size_t WS_P1 = 276 * MiB;
constexpr size_t WS_ACT = WS_P1;
constexpr size_t WS_GATE = 484 * MiB;
constexpr size_t WS_SMALL = 676 * MiB;
constexpr size_t WS_MERGED = 680 * MiB;
constexpr size_t WS_YCAT = 744 * MiB;
constexpr size_t WS_GW = 808 * MiB;
constexpr size_t GDN_CH_BYTES = 73728;
constexpr size_t WS_GL = 880 * MiB;
constexpr size_t WS_GO = 881 * MiB;
constexpr size_t WS_SX = 913 * MiB;
constexpr size_t WS_SDT = 961 * MiB;
constexpr size_t WS_SAC = 962 * MiB;
constexpr size_t WS_SST = 963 * MiB;
constexpr size_t WS_SCD = 1027 * MiB;
constexpr size_t WS_SRC = 1028 * MiB;
constexpr size_t WS_QN = 1029 * MiB;
constexpr size_t WS_KS = 1045 * MiB;
constexpr size_t WS_KW = 1053 * MiB;
constexpr size_t WS_VST = 1061 * MiB;
constexpr size_t WS_VWT = 1069 * MiB;
constexpr size_t WS_KCMP = 1077 * MiB;
constexpr size_t WS_VCMPT = 1078 * MiB;
constexpr size_t WS_SELM = 1079 * MiB;
constexpr size_t WS_YB = 1080 * MiB;
constexpr size_t WS_MTMP = 1112 * MiB;
constexpr size_t WS_END = 1240 * MiB;
static_assert(WS_P1 + (size_t)MTOK * P1W * 2 <= WS_GATE && WS_GATE + (size_t)MTOK * 6144 * 2 <= WS_SMALL && WS_SMALL + (size_t)MTOK * SMW * 4 <= WS_MERGED && WS_MERGED + (size_t)MTOK * DM * 2 <= WS_YCAT && WS_YCAT + (size_t)MTOK * 2048 * 2 <= WS_GW, "ws map 1");
static_assert(WS_GW + 1024 * GDN_CH_BYTES <= WS_GL && WS_GO + (size_t)MTOK * 512 * 4 <= WS_SX && WS_SX + (size_t)MTOK * 1536 * 2 <= WS_SDT && WS_SDT + (size_t)MTOK * 16 * 4 <= WS_SAC && WS_SAC + (size_t)MTOK * 16 * 4 <= WS_SST && WS_SST + (size_t)2 * 64 * 16 * 64 * 128 * 4 <= WS_SCD, "ws map 2");
static_assert(WS_SRC + (size_t)MTOK * 2 * 4 <= WS_QN && WS_QN + (size_t)4 * SEQ * 256 * 2 <= WS_KS && WS_KS + (size_t)4 * SEQ * 128 * 2 <= WS_KW && WS_KW + (size_t)4 * SEQ * 128 * 2 <= WS_VST && WS_VST + (size_t)4 * SEQ * 128 * 2 <= WS_VWT && WS_VWT + (size_t)4 * SEQ * 128 * 2 <= WS_KCMP, "ws map 3");
static_assert(WS_KCMP + 4 * 512 * 128 * 2 <= WS_VCMPT && WS_VCMPT + 4 * 512 * 128 * 2 <= WS_SELM && WS_SELM + (size_t)4 * SEQ * 16 <= WS_YB && WS_YB + (size_t)MTOK * 512 * 4 <= WS_END && WS_XB + (size_t)MTOK * DM * 2 <= WS_P1 && (size_t)MTOK * DFF * 2 <= (size_t)MTOK * P1W * 2, "ws map 4");

constexpr int CW_BAR = 1024;
constexpr int CW_RS = 16384;
constexpr int NRS = 13;
constexpr int CW_WQ = 8192;
static_assert(CW_RS * 4 + NRS * MTOK * 8 <= (int)CTL_BYTES, "ctl");

constexpr int RING_BYTES = 131072;
constexpr int MISC_OFF = RING_BYTES + 12288;
constexpr int LDS_BYTES = 147456;

DEV unsigned f2bf(float f) { unsigned u = __builtin_bit_cast(unsigned, f); return (u + 0x7fffu + ((u >> 16) & 1u)) >> 16; }
DEV float bf2f(unsigned b) { return __builtin_bit_cast(float, (b & 0xffffu) << 16); }
DEV unsigned pk2(float lo, float hi) { return f2bf(lo) | (f2bf(hi) << 16); }
DEV float bflo(unsigned w) { return __builtin_bit_cast(float, w << 16); }
DEV float bfhi(unsigned w) { return __builtin_bit_cast(float, w & 0xffff0000u); }
DEV float sigmoidf_(float x) { return 1.0f / (1.0f + __expf(-x)); }
DEV float siluf_(float x) { return x / (1.0f + __expf(-x)); }
DEV float softplusf_(float x) {
    const float e = __expf(-fabsf(x)), u = 1.0f + e, d = u - 1.0f;
    const float lp = d == 0.f ? e : __logf(u) * (e / d);
    return fmaxf(x, 0.f) + lp;
}
#ifndef CPU_EMU
template <int M, class T> DEV T shx(T v) {
    static_assert(sizeof(T) == 4, "shx: 32-bit values");
    const int iv = __builtin_bit_cast(int, v);
    if constexpr (M < 32) return __builtin_bit_cast(T, __builtin_amdgcn_ds_swizzle(iv, 0x1f | (M << 10)));
    else { unsigned z = 0u; asm volatile("" : "+v"(z)); const unsigned ln = __builtin_amdgcn_mbcnt_hi(~0u, __builtin_amdgcn_mbcnt_lo(~0u, z));
        return __builtin_bit_cast(T, __builtin_amdgcn_ds_bpermute((int)((ln ^ 32u) << 2), iv)); }
}
#endif
DEV float wave_sum(float v) { v += shx<1>(v); v += shx<2>(v); v += shx<4>(v); v += shx<8>(v); v += shx<16>(v); v += shx<32>(v); return v; }
DEV void wave_sum4(float (&v)[4]) {
#pragma unroll
    for (int q = 0; q < 4; ++q) v[q] += shx<1>(v[q]);
#pragma unroll
    for (int q = 0; q < 4; ++q) v[q] += shx<2>(v[q]);
#pragma unroll
    for (int q = 0; q < 4; ++q) v[q] += shx<4>(v[q]);
#pragma unroll
    for (int q = 0; q < 4; ++q) v[q] += shx<8>(v[q]);
#pragma unroll
    for (int q = 0; q < 4; ++q) v[q] += shx<16>(v[q]);
#pragma unroll
    for (int q = 0; q < 4; ++q) v[q] += shx<32>(v[q]);
}
DEV float sum16(float v) { v += shx<1>(v); v += shx<2>(v); v += shx<4>(v); v += shx<8>(v); return v; }
DEV float max16(float v) { v = fmaxf(v, shx<1>(v)); v = fmaxf(v, shx<2>(v)); v = fmaxf(v, shx<4>(v)); v = fmaxf(v, shx<8>(v)); return v; }
#ifndef CPU_EMU
DEV float opaque_zero() { float z = 0.f; asm volatile("" : "+v"(z)); return z; }
#endif
#define ZERO4 ((f32x4){zf_, zf_, zf_, zf_})
DEV f32x4 mfma16(bf16x8 a, bf16x8 b, f32x4 c) { return __builtin_amdgcn_mfma_f32_16x16x32_bf16(a, b, c, 0, 0, 0); }
DEV bf16x8 frag_g(const bf16* base, int pitch, int row0, int k0, int lane) { return *(const bf16x8*)(base + (size_t)(row0 + (lane & 15)) * pitch + k0 + 8 * (lane >> 4)); }
DEV bf16x8 frag_l(const LAS bf16* base, int pitch, int row0, int k0, int lane) { return *(const LAS bf16x8*)(base + (row0 + (lane & 15)) * pitch + k0 + 8 * (lane >> 4)); }
#ifndef CPU_EMU
DEV const LAS void* lds_vbase(const LAS void* p) { unsigned a = (unsigned)(size_t)p; asm volatile("" : "+v"(a)); return (const LAS void*)(size_t)a; }
#endif

struct Params {
    const float* in[30];
    float* out;
    unsigned char* ws;
    int lo, hi;
    int use_bar, pad;
};
enum { I_X = 0, I_REL, I_GF1, I_WUP1, I_WDN1, I_GMIX, I_WIN, I_GCONV, I_GALOG, I_GDTB, I_GNORM, I_NQN, I_NKN, I_NPEK, I_NPEV, I_NWCK, I_NWCV,
       I_SCW, I_SCB, I_SDTB, I_SALOG, I_SD, I_SNORM, I_PA, I_PB, I_PC, I_WO, I_GF2, I_WUP2, I_WDN2 };

#define XB_TMO      128
#define XB_XCNT(j)  (256  + 64 * (j))
#define XB_XSUB(j)  (1280 + 64 * (j))
#define XB_XGEN(j)  (2304 + 64 * (j))
#define XB_TOP      3328
#define XB_TOPGEN   3392
#define XCD_BAR_WORDS 3456
#define XB_SPIN_CAP (1u << 22)
#ifndef CPU_EMU
DEV unsigned xb_ld(unsigned* p)              { return __hip_atomic_load(p, __ATOMIC_RELAXED, __HIP_MEMORY_SCOPE_AGENT); }
DEV unsigned xb_add(unsigned* p, unsigned v) { return __hip_atomic_fetch_add(p, v, __ATOMIC_RELAXED, __HIP_MEMORY_SCOPE_AGENT); }
DEV unsigned xb_xcc_id() { return (unsigned)__builtin_amdgcn_s_getreg((3 << 11) | 20) & 0xFu; }
#define XB_SPIN(cond, bar) do { unsigned _sp = 0; while (cond) { __builtin_amdgcn_s_sleep(1); \
    if ((++_sp & 255u) == 0u) { if (xb_ld(&(bar)[XB_TMO])) break; if (_sp > XB_SPIN_CAP) { atomicAdd(&(bar)[XB_TMO], 1u); break; } } } } while (0)
struct XcdBarrier { unsigned* bar; unsigned x; volatile LAS unsigned* st; };
DEV XcdBarrier xcd_barrier_post(unsigned* bar, volatile LAS unsigned* st) {
    XcdBarrier b; b.bar = bar; b.x = xb_xcc_id(); b.st = st;
    if (threadIdx.x == 0) (void)xb_add(&bar[XB_XCNT(b.x)], 1u);
    return b;
}
DEV void xcd_barrier_complete(unsigned* bar, unsigned x, unsigned& nloc, unsigned& nx) {
    const unsigned G = gridDim.x * gridDim.y * gridDim.z;
    unsigned sum, cnt, mine, sp = 0u;
    for (;;) {
        sum = 0u; cnt = 0u; mine = 0u;
#pragma unroll
        for (unsigned j = 0; j < 16; ++j) { const unsigned c = xb_ld(&bar[XB_XCNT(j)]); sum += c; cnt += (c > 0u) ? 1u : 0u; mine = (j == x) ? c : mine; }
        if (sum == G) break;
        __builtin_amdgcn_s_sleep(1);
        if ((++sp & 255u) == 0u) { if (xb_ld(&bar[XB_TMO])) break; if (sp > XB_SPIN_CAP) { atomicAdd(&bar[XB_TMO], 1u); break; } }
    }
    nloc = mine > 0u ? mine : 1u; nx = cnt > 0u ? cnt : 1u;
}
DEV void xcd_barrier(const XcdBarrier& b) {
    asm volatile("s_waitcnt vmcnt(0)" ::: "memory");
    __syncthreads();
    if (threadIdx.x == 0) {
        unsigned* bar = b.bar;
        __builtin_amdgcn_s_waitcnt(0);
        unsigned nloc = b.st[0], nx = b.st[1];
        if (nloc == 0u) { xcd_barrier_complete(bar, b.x, nloc, nx); b.st[0] = nloc; b.st[1] = nx; }
        const unsigned old = xb_add(&bar[XB_XSUB(b.x)], 1u);
        const unsigned gen = old / nloc;
        if (old + 1u == (gen + 1u) * nloc) {
            __builtin_amdgcn_fence(__ATOMIC_RELEASE, "agent");
            asm volatile("s_waitcnt vmcnt(0)" ::: "memory");
            const unsigned og = xb_add(&bar[XB_TOP], 1u);
            const unsigned tg = og / nx;
            if (og + 1u == (tg + 1u) * nx) xb_add(&bar[XB_TOPGEN], 1u);
            else XB_SPIN(xb_ld(&bar[XB_TOPGEN]) == tg, bar);
            __builtin_amdgcn_fence(__ATOMIC_ACQUIRE, "agent");
            xb_add(&bar[XB_XGEN(b.x)], 1u);
            asm volatile("s_waitcnt vmcnt(0)" ::: "memory");
        } else {
            XB_SPIN(xb_ld(&bar[XB_XGEN(b.x)]) == gen, bar);
            __builtin_amdgcn_fence(__ATOMIC_ACQUIRE, "agent");
            asm volatile("s_waitcnt vmcnt(0)" ::: "memory");
        }
    }
    __syncthreads();
}
#endif

namespace pg8 {
constexpr int BM = 256, BK = 64, HALF = 128, HTB = HALF * BK * 2, STAGE_BYTES = 8 * HTB, NXCD = 8, WGM = 8;
__host__ __device__ __forceinline__ int lds_byte(int r, int c) { const int st = (r >> 4) * 2 + (c >> 5), rr = r & 15, cc = c & 31, ob = rr * 64 + cc * 2; return st * 1024 + (ob ^ (((ob >> 9) & 1) << 5)); }
__host__ __device__ __forceinline__ void stage_rc(int b, int& R, int& C) { const int st = b / 1024, sb = b % 1024, swz = sb ^ (((sb >> 9) & 1) << 5); R = (st >> 1) * 16 + swz / 64; C = (st & 1) * 32 + (swz % 64) / 2; }
__host__ __device__ __forceinline__ int perm32(int rho) { const int n = rho >> 4, i = rho & 15; return 8 * (i >> 2) + 4 * n + (i & 3); }
struct Unit { int pm, pn, koff, seg; };
struct Gemm { const bf16* A; const bf16* Bt; int M, N, K, lda, ldb; };
struct StaticOrder {
    int nM, nN, nwg, G, c;
    __host__ __device__ void init(int M, int N, int G_, int c_) { nM = M / BM; nN = N / BM; nwg = nM * nN; G = G_; c = c_; }
    __host__ __device__ bool next(int i, Unit& u) const {
        const long L = (long)i * G + c; if (L >= nwg) return false;
        int wgid = (int)L; { const int q = nwg / NXCD, r = nwg % NXCD, xcd = wgid % NXCD, off = wgid / NXCD; wgid = (xcd < r ? xcd * (q + 1) : r * (q + 1) + (xcd - r) * q) + off; }
        const int nig = WGM * nN, gid = wgid / nig, fm = gid * WGM, gsz = (nM - fm) < WGM ? (nM - fm) : WGM;
        u.pm = fm + ((wgid % nig) % gsz); u.pn = (wgid % nig) / gsz; u.koff = 0; u.seg = 0; return true;
    }
};
struct SegOrder {
    StaticOrder S; int kseg;
    __host__ __device__ void init(int M, int N, int G_, int c_, int kseg_) { S.init(M, N, G_, c_); kseg = kseg_; }
    __host__ __device__ bool next(int i, Unit& u) const { if (!S.next(i >> 2, u)) return false; u.seg = i & 3; u.koff = u.seg * kseg; return true; }
};
#ifndef CPU_EMU
DEV unsigned cvt_pk_bf16(float lo, float hi) { unsigned r; asm volatile("s_nop 1\n\tv_cvt_pk_bf16_f32 %0, %1, %2" : "=v"(r) : "v"(lo), "v"(hi)); return r; }
#endif
DEV unsigned long long rss_fix(float ss) { return (unsigned long long)(ss * 16777216.0f + 0.5f); }
DEV float rss_val(unsigned long long v) { return (float)v * (1.0f / 16777216.0f); }

struct EpiSwiGLU {
    static constexpr bool PERM = true, SEGACC = false;
    bf16* act; const unsigned long long* rss;
    DEV void operator()(const f32x4 (&acc)[2][2][4][2], const Unit& u, int wr, int wc, int fr, int fq) const {
        const int row0 = u.pm * BM + wr * 64 + fr, col0 = u.pn * HALF + wc * 32 + 8 * fq;
        unsigned long long rv[8];
#pragma unroll
        for (int i = 0; i < 8; ++i) rv[i] = rss[row0 + (i >> 2) * HALF + (i & 3) * 16];
        CFENCE();
#pragma unroll
        for (int ai = 0; ai < 2; ++ai)
#pragma unroll
            for (int m = 0; m < 4; ++m) {
                const int row = row0 + ai * HALF + m * 16;
                const float rs = rsqrtf(rss_val(rv[ai * 4 + m]) * (1.0f / DM) + EPS);
                float o[8];
#pragma unroll
                for (int n = 0; n < 2; ++n)
#pragma unroll
                    for (int j = 0; j < 4; ++j) { const float a = acc[ai][0][m][n][j] * rs, b = acc[ai][1][m][n][j] * rs; o[4 * n + j] = a * b * __builtin_amdgcn_rcpf(1.0f + __expf(-a)); }
                u32x4 w; w.x = cvt_pk_bf16(o[0], o[1]); w.y = cvt_pk_bf16(o[2], o[3]); w.z = cvt_pk_bf16(o[4], o[5]); w.w = cvt_pk_bf16(o[6], o[7]);
                *(u32x4*)(act + (size_t)row * DFF + col0) = w;
            }
    }
};
struct EpiResidual {
    static constexpr bool PERM = true, SEGACC = false;
    float* out; bf16* xb; unsigned long long* rss_out; float alpha;
    DEV void operator()(const f32x4 (&acc)[2][2][4][2], const Unit& u, int wr, int wc, int fr, int fq) const {
        const int row0 = u.pm * BM + wr * 64 + fr, col0 = u.pn * BM + wc * 32 + 8 * fq;
#pragma unroll
        for (int ai = 0; ai < 2; ++ai) {
            u32x4 xv[4][2];
#pragma unroll
            for (int m = 0; m < 4; ++m)
#pragma unroll
                for (int bj = 0; bj < 2; ++bj) xv[m][bj] = *(const u32x4*)(xb + (size_t)(row0 + ai * HALF + m * 16) * DM + col0 + bj * HALF);
            CFENCE();
#pragma unroll
            for (int m = 0; m < 4; ++m) {
                const int row = row0 + ai * HALF + m * 16; float ss = 0.f;
#pragma unroll
                for (int bj = 0; bj < 2; ++bj) {
                    const u32x4 xw = xv[m][bj];
                    const f32x4 x0 = (f32x4){bflo(xw.x), bfhi(xw.x), bflo(xw.y), bfhi(xw.y)} + acc[ai][bj][m][0] * alpha, x1 = (f32x4){bflo(xw.z), bfhi(xw.z), bflo(xw.w), bfhi(xw.w)} + acc[ai][bj][m][1] * alpha;
                    if (out) { float* xp = out + (size_t)row * DM + col0 + bj * HALF; *(f32x4*)xp = x0; *(f32x4*)(xp + 4) = x1; }
                    ss += (x0[0] * x0[0] + x0[1] * x0[1]) + (x0[2] * x0[2] + x0[3] * x0[3]) + (x1[0] * x1[0] + x1[1] * x1[1]) + (x1[2] * x1[2] + x1[3] * x1[3]);
                    u32x4 w; w.x = cvt_pk_bf16(x0[0], x0[1]); w.y = cvt_pk_bf16(x0[2], x0[3]); w.z = cvt_pk_bf16(x1[0], x1[1]); w.w = cvt_pk_bf16(x1[2], x1[3]);
                    *(u32x4*)(xb + (size_t)row * DM + col0 + bj * HALF) = w;
                }
                ss += shx<16>(ss); ss += shx<32>(ss);
                if (fq == 0) atomicAdd(rss_out + row, rss_fix(ss));
            }
            CFENCE();
        }
    }
};
struct EpiWin {
    static constexpr bool PERM = true, SEGACC = false;
    bf16* p1; float* small; bf16* gate; const unsigned long long* rss;
    DEV void operator()(const f32x4 (&acc)[2][2][4][2], const Unit& u, int wr, int wc, int fr, int fq) const {
        const int row0 = u.pm * BM + wr * 64 + fr, cl0 = wc * 32 + 8 * fq;
        unsigned long long rv[8];
#pragma unroll
        for (int i = 0; i < 8; ++i) rv[i] = rss[row0 + (i >> 2) * HALF + (i & 3) * 16];
        CFENCE();
#pragma unroll
        for (int ai = 0; ai < 2; ++ai)
#pragma unroll
            for (int m = 0; m < 4; ++m) {
                const int row = row0 + ai * HALF + m * 16;
                const float rs = rsqrtf(rss_val(rv[ai * 4 + m]) * (1.0f / DM) + EPS);
#pragma unroll
                for (int bj = 0; bj < 2; ++bj) {
                    f32x4 v0 = acc[ai][bj][m][0] * rs, v1 = acc[ai][bj][m][1] * rs;
                    const int cl = cl0 + bj * HALF;
                    if (u.pn < 26) {
                        u32x4 w; w.x = cvt_pk_bf16(v0[0], v0[1]); w.y = cvt_pk_bf16(v0[2], v0[3]); w.z = cvt_pk_bf16(v1[0], v1[1]); w.w = cvt_pk_bf16(v1[2], v1[3]);
                        *(u32x4*)(p1 + (size_t)row * P1W + u.pn * BM + cl) = w;
                    } else if (u.pn == 26) {
                        if (cl < SMW) { float* sp = small + (size_t)row * SMW + cl; *(f32x4*)sp = v0; *(f32x4*)(sp + 4) = v1; }
                    } else {
#pragma unroll
                        for (int j = 0; j < 4; ++j) { v0[j] = fminf(__builtin_amdgcn_rcpf(1.0f + __expf(-v0[j])), 1.0f); v1[j] = fminf(__builtin_amdgcn_rcpf(1.0f + __expf(-v1[j])), 1.0f); }
                        u32x4 w; w.x = cvt_pk_bf16(v0[0], v0[1]); w.y = cvt_pk_bf16(v0[2], v0[3]); w.z = cvt_pk_bf16(v1[0], v1[1]); w.w = cvt_pk_bf16(v1[2], v1[3]);
                        *(u32x4*)(gate + (size_t)row * 6144 + (u.pn - 27) * BM + cl) = w;
                    }
                }
            }
    }
};
struct EpiMergeSeg {
    static constexpr bool PERM = true, SEGACC = true;
    bf16* merged; const bf16* gate; const float* rc;
    DEV void seg(f32x4 (&acc)[2][2][4][2], const Unit& u, int wr, int wc, int fr, int fq) const {
        const int row0 = u.pm * BM + wr * 64 + fr, col0 = u.pn * BM + wc * 32 + 8 * fq, sg = u.seg;
        f32x2 rcv[8];
#pragma unroll
        for (int i = 0; i < 8; ++i) rcv[i] = *(const f32x2*)(rc + (size_t)(row0 + (i >> 2) * HALF + (i & 3) * 16) * 2);
        const int offa = sg == 0 ? 0 : (sg == 1 ? DM : 2 * DM), offb = sg == 0 ? DM : 2 * DM;
#pragma unroll
        for (int aim = 0; aim < 4; ++aim) {
            const int ai = aim >> 1, m0 = (aim & 1) * 2;
            u32x4 wa[2][2], wb[2][2];
            if (sg != 2) {
#pragma unroll
                for (int mm = 0; mm < 2; ++mm)
#pragma unroll
                    for (int bj = 0; bj < 2; ++bj) { const bf16* gp = gate + (size_t)(row0 + ai * HALF + (m0 + mm) * 16) * 6144 + col0 + bj * HALF; wa[mm][bj] = *(const u32x4*)(gp + offa); wb[mm][bj] = *(const u32x4*)(gp + offb); }
            }
            CFENCE();
#pragma unroll
            for (int mm = 0; mm < 2; ++mm) {
                const int m = m0 + mm, row = row0 + ai * HALF + m * 16;
                const float r0 = rcv[ai * 4 + m][0], r1 = rcv[ai * 4 + m][1];
#pragma unroll
                for (int bj = 0; bj < 2; ++bj) {
                    float f[8];
                    if (sg == 2) { const float q = fmaxf(r0, 1e-20f) / fmaxf(r1, 1e-20f);
#pragma unroll
                        for (int j = 0; j < 8; ++j) f[j] = q; }
                    else {
                        const u32x4 a4 = wa[mm][bj], b4 = wb[mm][bj];
                        const float na[8] = {bflo(a4.x), bfhi(a4.x), bflo(a4.y), bfhi(a4.y), bflo(a4.z), bfhi(a4.z), bflo(a4.w), bfhi(a4.w)};
                        const float nb[8] = {bflo(b4.x), bfhi(b4.x), bflo(b4.y), bfhi(b4.y), bflo(b4.z), bfhi(b4.z), bflo(b4.w), bfhi(b4.w)};
#pragma unroll
                        for (int j = 0; j < 8; ++j) {
                            if (sg == 0) f[j] = fmaxf(na[j], 1e-20f) * __builtin_amdgcn_rcpf(fmaxf(nb[j], 1e-20f));
                            else if (sg == 1) f[j] = fmaxf(na[j], 1e-20f) * __builtin_amdgcn_rcpf(fmaxf(nb[j] * r0, 1e-20f));
                            else f[j] = fmaxf(na[j] * r1, 1e-20f); }
                    }
                    f32x4 v0 = acc[ai][bj][m][0], v1 = acc[ai][bj][m][1];
#pragma unroll
                    for (int j = 0; j < 4; ++j) { v0[j] *= f[j]; v1[j] *= f[4 + j]; }
                    if (sg < 3) { acc[ai][bj][m][0] = v0; acc[ai][bj][m][1] = v1; }
                    else { u32x4 o; o.x = cvt_pk_bf16(v0[0], v0[1]); o.y = cvt_pk_bf16(v0[2], v0[3]); o.z = cvt_pk_bf16(v1[0], v1[1]); o.w = cvt_pk_bf16(v1[2], v1[3]);
                        *(u32x4*)(merged + (size_t)row * DM + col0 + bj * HALF) = o; }
                }
            }
            CFENCE();
        }
    }
};

#ifndef CPU_EMU
template <class Epi, class Sched>
DEV void gemm_phase(LAS unsigned char* lds, const int tid, const Gemm g, const Sched& S, const Epi& E) {
    const int wid = __builtin_amdgcn_readfirstlane(tid >> 6), lane = tid & 63, wr = wid >> 2, wc = wid & 3, fr = lane & 15, fq = lane >> 4;
    const int K = g.K, nt = K / BK;
    const float zf_ = opaque_zero();
    unsigned voffA[2], voffB[2];
#pragma unroll
    for (int i = 0; i < 2; ++i) { int R, C; stage_rc(tid * 16 + i * 8192, R, C); const int Rb = Epi::PERM ? ((R & ~31) + perm32(R & 31)) : R;
        voffA[i] = (unsigned)(R * g.lda + C) * 2u; voffB[i] = (unsigned)(Rb * g.ldb + C) * 2u; }
    const size_t kstep = (size_t)(BK * 2);
    const size_t hA = (size_t)HALF * g.lda * 2, hB = (size_t)HALF * g.ldb * 2;
    const size_t tA = 2 * hA, tB = 2 * hB;
    const unsigned ldsw = (unsigned)wid * 1024u;
    const int aoff = lds_byte(wr * 64 + fr, fq * 8), boff = lds_byte(wc * 32 + fr, fq * 8);
#define PG8_SA(b, h) (((b) * 2 + (h)) * HTB)
#define PG8_SB(b, h) ((4 + (b) * 2 + (h)) * HTB)
#define PG8_STAGE(bufoff, gbase, voff) do { _Pragma("unroll") for (int _i = 0; _i < 2; ++_i) \
        __builtin_amdgcn_global_load_lds((const unsigned*)((const char*)(gbase) + (voff)[_i]), (LAS unsigned*)(lds + (bufoff) + ldsw + _i * 8192), 16, 0, 0); } while (0)
#define PG8_LDA(dst, b, h) do { _Pragma("unroll") for (int m = 0; m < 4; ++m) _Pragma("unroll") for (int k = 0; k < 2; ++k) dst[m][k] = *(const LAS bf16x8*)(lds + PG8_SA(b, h) + aoff + m * 2048 + k * 1024); } while (0)
#define PG8_LDB(dst, b, h) do { _Pragma("unroll") for (int n = 0; n < 2; ++n) _Pragma("unroll") for (int k = 0; k < 2; ++k) dst[n][k] = *(const LAS bf16x8*)(lds + PG8_SB(b, h) + boff + n * 2048 + k * 1024); } while (0)
#define PG8_MMA(ai, bj, At, Bt) do { __builtin_amdgcn_s_setprio(1); _Pragma("unroll") for (int m = 0; m < 4; ++m) _Pragma("unroll") for (int n = 0; n < 2; ++n) _Pragma("unroll") for (int k = 0; k < 2; ++k) \
        acc[ai][bj][m][n] = __builtin_amdgcn_mfma_f32_16x16x32_bf16(Bt[n][k], At[m][k], acc[ai][bj][m][n], 0, 0, 0); __builtin_amdgcn_s_setprio(0); } while (0)
#define PG8_WAIT_V(n) asm volatile("s_waitcnt vmcnt(" #n ")" ::: "memory")
#define PG8_WAIT_L(n) asm volatile("s_waitcnt lgkmcnt(" #n ")" ::: "memory")
#define PG8_BAR __builtin_amdgcn_s_barrier()
#define PG8_SCHED __builtin_amdgcn_sched_barrier(0)
    Unit cur, nxt; int ui = 0;
    if (!S.next(0, cur)) return;
    f32x4 acc[2][2][4][2];
#pragma unroll
    for (int a = 0; a < 2; ++a)
#pragma unroll
        for (int b = 0; b < 2; ++b)
#pragma unroll
            for (int m = 0; m < 4; ++m)
#pragma unroll
                for (int n = 0; n < 2; ++n) acc[a][b][m][n] = ZERO4;
    bf16x8 At[4][2], B0[2][2], B1[2][2];
    const char* cA = (const char*)g.A + (size_t)cur.pm * tA + (size_t)cur.koff * 2; const char* cB = (const char*)g.Bt + (size_t)cur.pn * tB + (size_t)cur.koff * 2;
    PG8_STAGE(PG8_SB(0, 0), cB, voffB); PG8_STAGE(PG8_SB(0, 1), cB + hB, voffB); PG8_STAGE(PG8_SA(0, 0), cA, voffA); PG8_STAGE(PG8_SA(0, 1), cA + hA, voffA);
    if (wr == 1) PG8_BAR;
    PG8_WAIT_V(2); PG8_BAR;
    PG8_STAGE(PG8_SB(1, 0), cB + kstep, voffB); PG8_STAGE(PG8_SA(1, 0), cA + kstep, voffA); PG8_STAGE(PG8_SB(1, 1), cB + hB + kstep, voffB);
    PG8_WAIT_V(6); PG8_BAR;
    for (;;) {
        const bool has_next = S.next(ui + 1, nxt);
        const char* nA = has_next ? (const char*)g.A + (size_t)nxt.pm * tA + (size_t)nxt.koff * 2 : cA; const char* nB = has_next ? (const char*)g.Bt + (size_t)nxt.pn * tB + (size_t)nxt.koff * 2 : cB;
        for (int t = 0; t < nt; t += 2) {
            const bool last = (t == nt - 2);
            const char* a1 = cA + (size_t)(t + 1) * kstep;
            const char* a2 = last ? nA : cA + (size_t)(t + 2) * kstep; const char* b2 = last ? nB : cB + (size_t)(t + 2) * kstep;
            const char* a3 = a2 + kstep; const char* b3 = b2 + kstep;
            PG8_LDB(B0, 0, 0); PG8_LDB(B1, 0, 1); PG8_SCHED; PG8_LDA(At, 0, 0); PG8_STAGE(PG8_SA(1, 1), a1 + hA, voffA);
            PG8_WAIT_V(8); PG8_WAIT_L(0); PG8_BAR; PG8_MMA(0, 0, At, B0); PG8_MMA(0, 1, At, B1); PG8_BAR; PG8_SCHED;
            PG8_LDA(At, 0, 1); PG8_STAGE(PG8_SB(0, 0), b2, voffB); PG8_STAGE(PG8_SB(0, 1), b2 + hB, voffB); PG8_STAGE(PG8_SA(0, 0), a2, voffA);
            PG8_WAIT_V(8); PG8_WAIT_L(0); PG8_BAR; PG8_MMA(1, 0, At, B0); PG8_MMA(1, 1, At, B1); PG8_BAR; PG8_SCHED;
            PG8_LDB(B0, 1, 0); PG8_LDB(B1, 1, 1); PG8_SCHED; PG8_LDA(At, 1, 0); PG8_STAGE(PG8_SA(0, 1), a2 + hA, voffA);
            PG8_WAIT_V(8); PG8_WAIT_L(0); PG8_BAR; PG8_MMA(0, 0, At, B0); PG8_MMA(0, 1, At, B1); PG8_BAR; PG8_SCHED;
            PG8_LDA(At, 1, 1); PG8_STAGE(PG8_SB(1, 0), b3, voffB); PG8_STAGE(PG8_SB(1, 1), b3 + hB, voffB); PG8_STAGE(PG8_SA(1, 0), a3, voffA);
            PG8_WAIT_V(8); PG8_WAIT_L(0); PG8_BAR; PG8_MMA(1, 0, At, B0); PG8_MMA(1, 1, At, B1); PG8_BAR; PG8_SCHED;
        }
        if (DBG_TMASK && DBG_TEPI && tid == 0 && blockIdx.x == 0) { volatile LAS unsigned* m_ = (volatile LAS unsigned*)(lds + MISC_OFF); if (m_[68]) m_[65] = (unsigned)__builtin_amdgcn_s_memrealtime(); }
        if (wr == 0) PG8_BAR;
        if constexpr (Epi::SEGACC) E.seg(acc, cur, wr, wc, fr, fq); else E(acc, cur, wr, wc, fr, fq);
        if (DBG_TMASK && DBG_TEPI && tid == 0 && blockIdx.x == 0) { volatile LAS unsigned* m_ = (volatile LAS unsigned*)(lds + MISC_OFF); if (m_[68]) m_[66] = m_[66] + ((unsigned)__builtin_amdgcn_s_memrealtime() - m_[65]); }
        if (!has_next) break;
        if (!(Epi::SEGACC && nxt.seg != 0)) {
#pragma unroll
        for (int a = 0; a < 2; ++a)
#pragma unroll
            for (int b = 0; b < 2; ++b)
#pragma unroll
                for (int m = 0; m < 4; ++m)
#pragma unroll
                    for (int n = 0; n < 2; ++n) acc[a][b][m][n] = ZERO4;
        }
        cur = nxt; cA = nA; cB = nB; ++ui;
        if (wr == 1) PG8_BAR;
    }
    PG8_WAIT_V(0);
    PG8_BAR;
#undef PG8_SA
#undef PG8_SB
#undef PG8_STAGE
#undef PG8_LDA
#undef PG8_LDB
#undef PG8_MMA
#undef PG8_WAIT_V
#undef PG8_WAIT_L
#undef PG8_BAR
#undef PG8_SCHED
}
#endif
}

#ifndef CPU_EMU
typedef const __attribute__((address_space(4))) Params* KParams;
#else
typedef const Params* KParams;
#endif
struct Frame {
    LAS unsigned char* lds;
    int tid, lane, wave, G, bid;
    KParams p;
    unsigned char* ws;
};
DEV const float* lin(const Frame& F, int idx, int layer, size_t per_layer) { return F.p->in[idx] + (size_t)layer * per_layer; }
#define WSP(T, off) ((T*)(F.ws + (off)))

DEV int up_dest(int n) { return n < DFF ? (n >> 7) * 256 + (n & 127) : ((n - DFF) >> 7) * 256 + 128 + ((n - DFF) & 127); }
DEV int win_dest(int n) {
    if (n < 2048) return n;
    if (n < 2052) return SM0 + S_AA + (n - 2048);
    if (n < 2056) return SM0 + S_AB + (n - 2052);
    if (n < 4104) return C_BQ + (n - 2056);
    if (n < 4116) return SM0 + S_BG + (n - 4104);
    if (n < 6676) return C_CZ + (n - 4116);
    if (n < 6692) return SM0 + S_DT + (n - 6676);
    return GT0 + (n - 6692);
}
struct XItem { const float* W; const float* ks; bf16* WT; int K, N, ldt, koff, mode, r; };
DEV void xitem_load(const XItem& it, int lane, float (&v)[32]) {
    const int nblk = (it.N + 31) / 32, kb = it.r / nblk, nb = it.r % nblk, k0 = 64 * kb, n0 = 32 * nb;
    const int nn = n0 + (lane & 31);
    const float* src = it.W + (size_t)(k0 + (lane >> 5)) * it.N + (nn < it.N ? nn : it.N - 1);
#pragma unroll
    for (int i = 0; i < 32; ++i) v[i] = src[(size_t)(2 * i) * it.N];
}
DEV void xitem_to_lds(LAS float* scr, int lane, const float (&v)[32]) {
#pragma unroll
    for (int i = 0; i < 32; ++i) scr[(2 * i + (lane >> 5)) * 33 + (lane & 31)] = v[i];
    LDS_WAIT(); CFENCE();
}
DEV void xitem_store(const XItem& it, LAS float* scr, int lane) {
    const int nblk = (it.N + 31) / 32, kb = it.r / nblk, nb = it.r % nblk, k0 = 64 * kb, n0 = 32 * nb;
    const int c = lane & 7;
    f32x4 ks0 = (f32x4){1.f, 1.f, 1.f, 1.f}, ks1 = ks0;
    if (it.ks) { ks0 = *(const f32x4*)(it.ks + k0 + 8 * c); ks1 = *(const f32x4*)(it.ks + k0 + 8 * c + 4); }
#pragma unroll
    for (int j = 0; j < 4; ++j) { const int n = (lane >> 3) + 8 * j; const LAS float* s = scr + (8 * c) * 33 + n;
        u32x4 o; o.x = pk2(s[0 * 33] * ks0[0], s[1 * 33] * ks0[1]); o.y = pk2(s[2 * 33] * ks0[2], s[3 * 33] * ks0[3]); o.z = pk2(s[4 * 33] * ks1[0], s[5 * 33] * ks1[1]); o.w = pk2(s[6 * 33] * ks1[2], s[7 * 33] * ks1[3]);
        const int ng = n0 + n;
        if (ng < it.N) { const int dr = it.mode == 0 ? ng : (it.mode == 1 ? up_dest(ng) : win_dest(ng)); *(u32x4*)(it.WT + (size_t)dr * it.ldt + it.koff + k0 + 8 * c) = o; } }
    LDS_WAIT(); CFENCE();
}
constexpr int XI_UP = (DM / 64) * (NUP / 32), XI_DN = (DFF / 64) * (DM / 32), XI_IN = (DM / 64) * ((NIN + 31) / 32), XI_P5 = (512 / 64) * (DM / 32), XI_P10 = (1024 / 64) * (DM / 32), XI_OO = (DM / 64) * (DM / 32), XI_CK = (4096 / 64) * (128 / 32);
constexpr int XI_TOTAL = 2 * XI_UP + 2 * XI_DN + XI_IN + 2 * XI_P5 + XI_P10 + XI_OO + 2 * XI_CK;
DEV XItem xitem_decode(Frame& F, int l, int idx) {
    XItem t; int r = idx; t.ks = nullptr; t.koff = 0; t.mode = 0;
    if (r < XI_UP) { t.W = lin(F, I_WUP1, l, (size_t)DM * NUP); t.K = DM; t.N = NUP; t.WT = WSP(bf16, WS_WUP1); t.ldt = DM; t.ks = lin(F, I_GF1, l, DM); t.mode = 1; }
    else if ((r -= XI_UP) < XI_UP) { t.W = lin(F, I_WUP2, l, (size_t)DM * NUP); t.K = DM; t.N = NUP; t.WT = WSP(bf16, WS_WUP2); t.ldt = DM; t.ks = lin(F, I_GF2, l, DM); t.mode = 1; }
    else if ((r -= XI_UP) < XI_DN) { t.W = lin(F, I_WDN1, l, (size_t)DFF * DM); t.K = DFF; t.N = DM; t.WT = WSP(bf16, WS_WDN1); t.ldt = DFF; }
    else if ((r -= XI_DN) < XI_DN) { t.W = lin(F, I_WDN2, l, (size_t)DFF * DM); t.K = DFF; t.N = DM; t.WT = WSP(bf16, WS_WDN2); t.ldt = DFF; }
    else if ((r -= XI_DN) < XI_IN) { t.W = lin(F, I_WIN, l, (size_t)DM * NIN); t.K = DM; t.N = NIN; t.WT = WSP(bf16, WS_WIN); t.ldt = DM; t.ks = lin(F, I_GMIX, l, DM); t.mode = 2; }
    else if ((r -= XI_IN) < XI_P5) { t.W = lin(F, I_PA, l, (size_t)512 * DM); t.K = 512; t.N = DM; t.WT = WSP(bf16, WS_WPM); t.ldt = DM; }
    else if ((r -= XI_P5) < XI_P5) { t.W = lin(F, I_PB, l, (size_t)512 * DM); t.K = 512; t.N = DM; t.WT = WSP(bf16, WS_WPM); t.ldt = DM; t.koff = 512; }
    else if ((r -= XI_P5) < XI_P10) { t.W = lin(F, I_PC, l, (size_t)1024 * DM); t.K = 1024; t.N = DM; t.WT = WSP(bf16, WS_WPM); t.ldt = DM; t.koff = 1024; t.ks = lin(F, I_SNORM, l, 1024); }
    else if ((r -= XI_P10) < XI_OO) { t.W = lin(F, I_WO, l, (size_t)DM * DM); t.K = DM; t.N = DM; t.WT = WSP(bf16, WS_WO); t.ldt = DM; }
    else if ((r -= XI_OO) < XI_CK) { t.W = lin(F, I_NWCK, l, (size_t)4096 * 128); t.K = 4096; t.N = 128; t.WT = WSP(bf16, WS_WCK); t.ldt = 4096; }
    else { r -= XI_CK; t.W = lin(F, I_NWCV, l, (size_t)4096 * 128); t.K = 4096; t.N = 128; t.WT = WSP(bf16, WS_WCV); t.ldt = 4096; }
    t.r = r; return t;
}
DEV void phase_convert(Frame& F, int l) {
    LAS float* scr = (LAS float*)(F.lds + F.wave * 16384);
    const int gw = F.bid * 8 + F.wave, NGW = F.G * 8;
    if (gw < XI_TOTAL) {
        float v[32]; XItem cur = xitem_decode(F, l, gw); xitem_load(cur, F.lane, v);
        for (int it = gw; it < XI_TOTAL; it += NGW) {
            xitem_to_lds(scr, F.lane, v);
            const bool has_next = it + NGW < XI_TOTAL; XItem nxt = cur;
            if (has_next) { nxt = xitem_decode(F, l, it + NGW); xitem_load(nxt, F.lane, v); }
            xitem_store(cur, scr, F.lane);
            cur = nxt;
        }
    }
    { bf16* w = WSP(bf16, WS_WIN) + (size_t)(SM0 + 36) * DM; const int n16 = (GT0 - SM0 - 36) * DM / 8;
      const unsigned zu = __builtin_bit_cast(unsigned, opaque_zero());
      for (int i = F.bid * 512 + F.tid; i < n16; i += F.G * 512) ((u32x4*)w)[i] = (u32x4){zu, zu, zu, zu}; }
    { const float* pek = lin(F, I_NPEK, l, 4096); const float* pev = lin(F, I_NPEV, l, 4096); float* cst = WSP(float, WS_CONST);
      for (int it = gw; it < 256; it += NGW) { const int e = it & 127; const float* pe = it < 128 ? pek : pev; const float* w = it < 128 ? lin(F, I_NWCK, l, (size_t)4096 * 128) : lin(F, I_NWCV, l, (size_t)4096 * 128); float s = 0.f;
          for (int k = F.lane; k < 4096; k += 64) s += pe[k] * w[(size_t)k * 128 + e];
          s = wave_sum(s); if (F.lane == 0) cst[it] = s; } }
    if (l == 0) {
        const float* x = F.p->in[I_X]; bf16* xb = WSP(bf16, WS_XB); unsigned long long* rss = WSP(unsigned long long, WS_CTL) + CW_RS / 2;
        for (int m = gw; m < MTOK; m += NGW) {
            const f32x4* xr = (const f32x4*)(x + (size_t)m * DM) + F.lane; u32x2* br = (u32x2*)(xb + (size_t)m * DM) + F.lane; float ss = 0.f;
#pragma unroll
            for (int j = 0; j < 8; ++j) { const f32x4 v = xr[64 * j]; ss += (v[0] * v[0] + v[1] * v[1]) + (v[2] * v[2] + v[3] * v[3]); u32x2 w; w.x = pk2(v[0], v[1]); w.y = pk2(v[2], v[3]); br[64 * j] = w; }
            ss = wave_sum(ss); if (F.lane == 0) rss[m] = pg8::rss_fix(ss);
        }
    }
}

DEV void nsa_prep_job(Frame& F, int l, int job) {
    const int b = job >> 8, g = (job >> 7) & 1, j = job & 127, bg = b * 2 + g, t0 = 64 * j;
    const bf16* p1 = WSP(bf16, WS_P1);
    const float* qn = lin(F, I_NQN, l, 128); const float* kn = lin(F, I_NKN, l, 128);
    bf16* QN = WSP(bf16, WS_QN); bf16* KS = WSP(bf16, WS_KS); bf16* KW = WSP(bf16, WS_KW); bf16* VST = WSP(bf16, WS_VST); bf16* VWT = WSP(bf16, WS_VWT);
    {
        const int v = F.lane >> 4, l16 = F.lane & 15;
        const int col = (v < 2 ? C_BQ + (g * 2 + v) * 128 : (v == 2 ? C_BKS + g * 128 : C_BKW + g * 128)) + 8 * l16;
        const float* gp = (v < 2 ? qn : kn) + 8 * l16; const f32x4 ga = *(const f32x4*)gp, gb = *(const f32x4*)(gp + 4);
        const float gg[8] = {ga[0], ga[1], ga[2], ga[3], gb[0], gb[1], gb[2], gb[3]};
        u32x4 wv[8];
#pragma unroll
        for (int i = 0; i < 8; ++i) wv[i] = *(const u32x4*)(p1 + (size_t)(b * SEQ + t0 + 8 * F.wave + i) * P1W + col);
        CFENCE();
#pragma unroll
        for (int i = 0; i < 8; ++i) {
            const int t = t0 + 8 * F.wave + i;
            const float x[8] = {bflo(wv[i].x), bfhi(wv[i].x), bflo(wv[i].y), bfhi(wv[i].y), bflo(wv[i].z), bfhi(wv[i].z), bflo(wv[i].w), bfhi(wv[i].w)};
            float ss = ((x[0] * x[0] + x[1] * x[1]) + (x[2] * x[2] + x[3] * x[3])) + ((x[4] * x[4] + x[5] * x[5]) + (x[6] * x[6] + x[7] * x[7]));
            ss = sum16(ss);
            float r = rsqrtf(ss * (1.0f / 128.0f) + EPS);
            if (v < 2) r *= 0.08838834764831845f * 1.4426950408889634f;
            u32x4 o; o.x = pk2(x[0] * r * gg[0], x[1] * r * gg[1]); o.y = pk2(x[2] * r * gg[2], x[3] * r * gg[3]); o.z = pk2(x[4] * r * gg[4], x[5] * r * gg[5]); o.w = pk2(x[6] * r * gg[6], x[7] * r * gg[7]);
            bf16* dst = v < 2 ? QN + ((size_t)(bg * SEQ + t) * 2 + v) * 128 : (v == 2 ? KS : KW) + (size_t)(bg * SEQ + t) * 128;
            *(u32x4*)(dst + 8 * l16) = o;
        }
    }
    LAS bf16* tl = (LAS bf16*)F.lds;
    {
        u32x4 vv[4];
#pragma unroll
        for (int q = 0; q < 4; ++q) { const int i = F.tid + 512 * q, v = i >> 10, r = (i >> 4) & 63, c8 = (i & 15) * 8;
            vv[q] = *(const u32x4*)(p1 + (size_t)(b * SEQ + t0 + r) * P1W + (v ? C_BVW : C_BVS) + g * 128 + c8); }
#pragma unroll
        for (int q = 0; q < 4; ++q) { const int i = F.tid + 512 * q, v = i >> 10, r = (i >> 4) & 63, c8 = (i & 15) * 8; LAS unsigned* d = (LAS unsigned*)(tl + (v * 64 + r) * 130 + c8);
            d[0] = vv[q].x; d[1] = vv[q].y; d[2] = vv[q].z; d[3] = vv[q].w; }
    }
    __syncthreads();
    for (int i = F.tid; i < 2 * 128 * 8; i += 512) {
        const int v = i >> 10, d = i & 127, tc = (i >> 7) & 7;
        const LAS bf16* s = tl + (v * 64 + 8 * tc) * 130 + d;
        u32x4 o; o.x = s[0] | ((unsigned)s[130] << 16); o.y = s[260] | ((unsigned)s[390] << 16); o.z = s[520] | ((unsigned)s[650] << 16); o.w = s[780] | ((unsigned)s[910] << 16);
        *(u32x4*)((v ? VWT : VST) + ((size_t)(bg * 128 + j) * 128 + d) * 64 + 8 * tc) = o;
    }
    __syncthreads();
}

DEV void conv_load11(u32x4 (&xin)[11], const bf16* p1, int b, int ts, int col) {
#pragma unroll
    for (int i = 0; i < 11; ++i) { const int t = ts - 3 + i; const int tc = t < 0 ? 0 : t;
        u32x4 v = *(const u32x4*)(p1 + (size_t)(b * SEQ + tc) * P1W + col);
        if (t < 0) v = (u32x4){0u, 0u, 0u, 0u};
        xin[i] = v; }
}
DEV void gdn_prep_job(Frame& F, int l, int job) {
    const int b = job >> 9, h = (job >> 7) & 3, c = job & 127, t0 = 64 * c;
    const bf16* p1 = WSP(bf16, WS_P1); const float* small = WSP(float, WS_SMALL);
    const float* convw = lin(F, I_GCONV, l, 4 * 1536);
    LAS float* Qs = (LAS float*)F.lds;
    LAS float* Ks = Qs + 64 * 132;
    LAS float* Vs = Ks + 64 * 132;
    LAS float* Mm = Vs + 64 * 132;
    LAS float* At = Mm + 64 * 68;
    LAS float* beta = At + 64 * 68;
    LAS float* gc = beta + 64;
    LAS float* eg = gc + 64;
    const int tid = F.tid;
    {
        if (tid < 384) {
            const int v = tid >> 7, s = tid & 15, tg = (tid >> 4) & 7, cc = v * 512 + h * 128 + 8 * s;
            u32x4 xin[11]; conv_load11(xin, p1, b, t0 + 8 * tg, (v == 0 ? C_AQ : (v == 1 ? C_AK : C_AV)) + h * 128 + 8 * s);
            f32x4 w[4][2];
#pragma unroll
            for (int k = 0; k < 4; ++k) { w[k][0] = *(const f32x4*)(convw + k * 1536 + cc); w[k][1] = *(const f32x4*)(convw + k * 1536 + cc + 4); }
            float y[8][8];
#pragma unroll
            for (int j = 0; j < 8; ++j) {
                float x[11];
#pragma unroll
                for (int i = 0; i < 11; ++i) { const unsigned wd = j < 2 ? xin[i].x : (j < 4 ? xin[i].y : (j < 6 ? xin[i].z : xin[i].w)); x[i] = (j & 1) ? bfhi(wd) : bflo(wd); }
                const float w0 = w[0][j >> 2][j & 3], w1 = w[1][j >> 2][j & 3], w2 = w[2][j >> 2][j & 3], w3 = w[3][j >> 2][j & 3];
#pragma unroll
                for (int i = 0; i < 8; ++i) y[i][j] = siluf_(w0 * x[i] + w1 * x[i + 1] + w2 * x[i + 2] + w3 * x[i + 3]);
            }
            LAS float* dst = (v == 0 ? Qs : (v == 1 ? Ks : Vs)) + (8 * tg) * 132 + 8 * s;
#pragma unroll
            for (int i = 0; i < 8; ++i) { *(LAS f32x4*)(dst + i * 132) = (f32x4){y[i][0], y[i][1], y[i][2], y[i][3]}; *(LAS f32x4*)(dst + i * 132 + 4) = (f32x4){y[i][4], y[i][5], y[i][6], y[i][7]}; }
        }
        if (tid < 64) {
            const size_t row = (size_t)(b * SEQ + t0 + tid);
            const float a = small[row * SMW + S_AA + h], bb = small[row * SMW + S_AB + h];
            beta[tid] = sigmoidf_(bb);
            gc[tid] = -__expf(lin(F, I_GALOG, l, 4)[h]) * softplusf_(a + lin(F, I_GDTB, l, 4)[h]);
        }
    }
    __syncthreads();
    for (int i4 = 0; i4 < 4; ++i4) {
        float x0[4], x1[4], ssv[4];
#pragma unroll
        for (int q = 0; q < 4; ++q) { const int r = F.wave * 16 + 4 * i4 + q;
            const LAS float* p = (r < 64 ? Qs + r * 132 : Ks + (r - 64) * 132); x0[q] = p[F.lane]; x1[q] = p[F.lane + 64]; ssv[q] = x0[q] * x0[q] + x1[q] * x1[q]; }
        wave_sum4(ssv);
#pragma unroll
        for (int q = 0; q < 4; ++q) { const int r = F.wave * 16 + 4 * i4 + q; LAS float* p = (r < 64 ? Qs + r * 132 : Ks + (r - 64) * 132);
            float sc = rsqrtf(ssv[q] + EPS); if (r < 64) sc *= 0.08838834764831845f;
            p[F.lane] = x0[q] * sc; p[F.lane + 64] = x1[q] * sc; }
    }
    if (tid < 64) {
        float sc = gc[tid];
#pragma unroll
        for (int d = 1; d < 64; d <<= 1) { const float t = __builtin_bit_cast(float, __builtin_amdgcn_ds_bpermute((tid - d) * 4, __builtin_bit_cast(int, sc))); if (tid >= d) sc += t; }
        gc[tid] = sc; eg[tid] = __expf(sc);
    }
    for (int i = tid; i < 64 * 68; i += 512) At[i] = 0.f;
    __syncthreads();
    for (int tj = F.wave; tj < 20; tj += 8) {
        const int kind = tj >= 10 ? 1 : 0, idx = tj - 10 * kind;
        const int mt = idx >= 6 ? 3 : (idx >= 3 ? 2 : (idx >= 1 ? 1 : 0)), nt = idx - mt * (mt + 1) / 2;
        const int fr = F.lane & 15, fq = F.lane >> 4;
        const LAS float* ap = (kind ? Qs : Ks) + (16 * mt + fr) * 132 + 4 * fq; const LAS float* bp = Ks + (16 * nt + fr) * 132 + 4 * fq;
        f32x4 acc = (f32x4){0.f, 0.f, 0.f, 0.f};
#pragma unroll
        for (int sg = 0; sg < 8; ++sg) { const f32x4 a4 = *(const LAS f32x4*)(ap + 16 * sg), b4 = *(const LAS f32x4*)(bp + 16 * sg);
#pragma unroll
            for (int j = 0; j < 4; ++j) acc = __builtin_amdgcn_mfma_f32_16x16x4f32(a4[j], b4[j], acc, 0, 0, 0); }
        const int j = 16 * nt + fr; const float gj = gc[j];
#pragma unroll
        for (int r = 0; r < 4; ++r) { const int i = 16 * mt + 4 * fq + r; const float dec = j <= i ? __expf(gc[i] - gj) : 0.f;
            if (kind) At[i * 68 + j] = acc[r] * dec; else Mm[i * 68 + j] = j < i ? beta[i] * acc[r] * dec : 0.f; }
    }
    __syncthreads();
    unsigned char* cb = F.ws + WS_GW + (size_t)job * GDN_CH_BYTES;
    bf16* gW = (bf16*)cb; bf16* gQD = (bf16*)(cb + 16384); bf16* gKDT = (bf16*)(cb + 32768); bf16* gUT = (bf16*)(cb + 49152); bf16* gAT = (bf16*)(cb + 65536);
    float sol[64];
    if (tid < 256) {
        const int cidx = tid & 127; const bool isw = tid >= 128;
        const LAS float* src = (isw ? Ks : Vs) + cidx;
        const LAS float* MmL = (const LAS float*)lds_vbase(Mm); const LAS float* betaL = (const LAS float*)lds_vbase(beta); const LAS float* egL = (const LAS float*)lds_vbase(eg);
#pragma unroll
        for (int i = 0; i < 64; ++i) sol[i] = 0.f;
#pragma unroll
        for (int i = 0; i < 64; ++i) {
            float r = src[i * 132] * betaL[i] * (isw ? egL[i] : 1.0f), r1 = 0.f, r2 = 0.f, r3 = 0.f;
#pragma unroll
            for (int j4 = 0; j4 < (i + 3) / 4; ++j4) { const f32x4 mv = *(const LAS f32x4*)(MmL + i * 68 + 4 * j4);
                r -= mv[0] * sol[4 * j4]; r1 -= mv[1] * sol[4 * j4 + 1]; r2 -= mv[2] * sol[4 * j4 + 2]; r3 -= mv[3] * sol[4 * j4 + 3]; }
            r = (r + r1) + (r2 + r3);
            sol[i] = r;
            asm volatile("" : "+v"(sol[i]) :: "memory");
        }
    } else {
        const int t2 = tid - 256;
        const float gl = gc[63];
        for (int i = t2; i < 64 * 16; i += 256) { const int r = i >> 4, c8 = (i & 15) * 8; const float e = eg[r]; const LAS float* s = Qs + r * 132 + c8;
            u32x4 o; o.x = pk2(s[0] * e, s[1] * e); o.y = pk2(s[2] * e, s[3] * e); o.z = pk2(s[4] * e, s[5] * e); o.w = pk2(s[6] * e, s[7] * e); *(u32x4*)(gQD + r * 128 + c8) = o; }
        for (int i = t2; i < 128 * 8; i += 256) { const int dk = i & 127, i8 = (i >> 7) * 8; float v[8];
#pragma unroll
            for (int q = 0; q < 8; ++q) v[q] = Ks[(i8 + q) * 132 + dk] * __expf(gl - gc[i8 + q]);
            u32x4 o; o.x = pk2(v[0], v[1]); o.y = pk2(v[2], v[3]); o.z = pk2(v[4], v[5]); o.w = pk2(v[6], v[7]); *(u32x4*)(gKDT + dk * 64 + i8) = o; }
        for (int i = t2; i < 64 * 8; i += 256) { const int r = i >> 3, c8 = (i & 7) * 8; const LAS float* s = At + r * 68 + c8;
            u32x4 o; o.x = pk2(s[0], s[1]); o.y = pk2(s[2], s[3]); o.z = pk2(s[4], s[5]); o.w = pk2(s[6], s[7]); *(u32x4*)(gAT + r * 64 + c8) = o; }
        if (t2 == 0) WSP(float, WS_GL)[job] = __expf(gl);
    }
    __syncthreads();
    LAS bf16* Wl = (LAS bf16*)Qs;
    if (tid < 128) {
#pragma unroll
        for (int q = 0; q < 8; ++q) { u32x4 o; o.x = pk2(sol[8 * q], sol[8 * q + 1]); o.y = pk2(sol[8 * q + 2], sol[8 * q + 3]); o.z = pk2(sol[8 * q + 4], sol[8 * q + 5]); o.w = pk2(sol[8 * q + 6], sol[8 * q + 7]);
            *(u32x4*)(gUT + tid * 64 + 8 * q) = o; }
    } else if (tid < 256) {
#pragma unroll
        for (int i = 0; i < 64; ++i) Wl[i * 136 + (tid - 128)] = (bf16)f2bf(sol[i]);
    }
    __syncthreads();
    for (int i = tid; i < 64 * 16; i += 512) { const int r = i >> 4, c8 = (i & 15) * 8; *(u32x4*)(gW + r * 128 + c8) = *(const LAS u32x4*)(Wl + r * 136 + c8); }
    __syncthreads();
}

DEV void ssd_conv8(const u32x4 (&xin)[11], const float* cw, const float* cbias, int cc, float (&y)[8][8]) {
    f32x4 w[4][2], bs[2];
#pragma unroll
    for (int k = 0; k < 4; ++k) { w[k][0] = *(const f32x4*)(cw + k * 1536 + cc); w[k][1] = *(const f32x4*)(cw + k * 1536 + cc + 4); }
    bs[0] = *(const f32x4*)(cbias + cc); bs[1] = *(const f32x4*)(cbias + cc + 4);
#pragma unroll
    for (int j = 0; j < 8; ++j) {
        float x[11];
#pragma unroll
        for (int i = 0; i < 11; ++i) { const unsigned wd = j < 2 ? xin[i].x : (j < 4 ? xin[i].y : (j < 6 ? xin[i].z : xin[i].w)); x[i] = (j & 1) ? bfhi(wd) : bflo(wd); }
        const float w0 = w[0][j >> 2][j & 3], w1 = w[1][j >> 2][j & 3], w2 = w[2][j >> 2][j & 3], w3 = w[3][j >> 2][j & 3], bj = bs[j >> 2][j & 3];
#pragma unroll
        for (int i = 0; i < 8; ++i) y[i][j] = siluf_(w0 * x[i] + w1 * x[i + 1] + w2 * x[i + 2] + w3 * x[i + 3] + bj);
    }
}
DEV bf16x8 frag_sw(const LAS bf16* M, int row, int chunk) { return *(const LAS bf16x8*)(M + row * 136 + 8 * (chunk ^ ((row >> 3) & 7))); }
DEV void ssd_prep_pass(Frame& F, const u32x4 (&xin)[11], const float* cw, const float* cbias, int cc, bf16* SX, float* dst0, LAS bf16* BT, LAS bf16* XT, const LAS float* dts, const LAS float* acs,
                       size_t row0, int s, int tg, int hh0) {
    const float zf_ = opaque_zero();
    {
        float y[8][8]; ssd_conv8(xin, cw, cbias, cc, y);
#pragma unroll
        for (int i = 0; i < 8; ++i) { u32x4 o; o.x = pk2(y[i][0], y[i][1]); o.y = pk2(y[i][2], y[i][3]); o.z = pk2(y[i][4], y[i][5]); o.w = pk2(y[i][6], y[i][7]);
            *(u32x4*)(SX + (row0 + i) * 1536 + cc) = o; }
        const int hh = hh0 + (s >> 3); const float al = acs[127 * 8 + hh]; float f[8];
#pragma unroll
        for (int i = 0; i < 8; ++i) f[i] = dts[(8 * tg + i) * 8 + hh] * __expf(al - acs[(8 * tg + i) * 8 + hh]);
#pragma unroll
        for (int j = 0; j < 8; ++j) { float v[8];
#pragma unroll
            for (int i = 0; i < 8; ++i) v[i] = bf2f(f2bf(y[i][j])) * f[i];
            u32x4 o; o.x = pk2(v[0], v[1]); o.y = pk2(v[2], v[3]); o.z = pk2(v[4], v[5]); o.w = pk2(v[6], v[7]);
            *(LAS u32x4*)(XT + (8 * s + j) * 136 + 8 * (tg ^ (s & 7))) = o; }
    }
    __syncthreads();
    {
        const int hp = F.wave >> 1, nh = F.wave & 1, fr = F.lane & 15, fq = F.lane >> 4;
        const LAS bf16* XTh = XT + hp * 64 * 136;
        float* dst = dst0 + (size_t)hp * 64 * 128;
#pragma unroll
        for (int mt = 0; mt < 4; ++mt) {
            bf16x8 a[4];
#pragma unroll
            for (int ks = 0; ks < 4; ++ks) a[ks] = frag_sw(XTh, 16 * mt + fr, 4 * ks + fq);
#pragma unroll
            for (int q = 0; q < 4; ++q) { const int nq = 4 * nh + q; f32x4 acc = ZERO4;
#pragma unroll
                for (int ks = 0; ks < 4; ++ks) acc = mfma16(frag_sw(BT, 16 * nq + fr, 4 * ks + fq), a[ks], acc);
                *(f32x4*)(dst + (size_t)(16 * mt + fr) * 128 + 16 * nq + 4 * fq) = acc; }
        }
    }
    __syncthreads();
}
DEV void ssd_prep_job(Frame& F, int l, int job) {
    const int b = job >> 7, c = (job >> 1) & 63, g = job & 1, t0 = 128 * c;
    const bf16* p1 = WSP(bf16, WS_P1); const float* small = WSP(float, WS_SMALL);
    const float* cw = lin(F, I_SCW, l, 4 * 1536); const float* cbias = lin(F, I_SCB, l, 1536);
    bf16* SX = WSP(bf16, WS_SX); float* SDT = WSP(float, WS_SDT); float* SAC = WSP(float, WS_SAC); float* SST = WSP(float, WS_SST); float* SCD = WSP(float, WS_SCD);
    LAS bf16* BT = (LAS bf16*)F.lds;
    LAS bf16* XT = BT + 128 * 136;
    LAS float* dts = (LAS float*)(XT + 4 * 64 * 136);
    LAS float* acs = dts + 128 * 8;
    const int tid = F.tid, s = tid & 31, tg = tid >> 5, ts = t0 + 8 * tg;
    const int ccA = 1024 + (s < 16 ? g * 128 + 8 * s : 256 + g * 128 + 8 * (s - 16));
    const int ccX = g * 512 + 8 * s;
    const size_t row0 = (size_t)(b * SEQ + ts);
    u32x4 xa[11], xb[11];
    conv_load11(xa, p1, b, ts, C_CX + ccA); conv_load11(xb, p1, b, ts, C_CX + ccX);
    for (int i = tid; i < 1024; i += 512) { const int tl = i >> 3, hh = i & 7, h = 8 * g + hh; const size_t row = (size_t)(b * SEQ + t0 + tl);
        const float dt = softplusf_(small[row * SMW + S_DT + h] + lin(F, I_SDTB, l, 16)[h]);
        dts[i] = dt; acs[i] = dt * (-__expf(lin(F, I_SALOG, l, 16)[h])); }
    __syncthreads();
    {
        const int hh = F.wave, ln = F.lane; const float v0 = acs[(2 * ln) * 8 + hh], v1 = acs[(2 * ln + 1) * 8 + hh];
        float sc = v0 + v1;
#pragma unroll
        for (int d = 1; d < 64; d <<= 1) { const float t = __builtin_bit_cast(float, __builtin_amdgcn_ds_bpermute((ln - d) * 4, __builtin_bit_cast(int, sc))); if (ln >= d) sc += t; }
        float ex = __builtin_bit_cast(float, __builtin_amdgcn_ds_bpermute((ln - 1) * 4, __builtin_bit_cast(int, sc))); if (ln == 0) ex = 0.f;
        const float a0 = ex + v0; acs[(2 * ln) * 8 + hh] = a0; acs[(2 * ln + 1) * 8 + hh] = a0 + v1;
    }
    __syncthreads();
    for (int i = tid; i < 1024; i += 512) { const int tl = i >> 3, hh = i & 7; const size_t row = (size_t)(b * SEQ + t0 + tl); SDT[row * 16 + 8 * g + hh] = dts[i]; SAC[row * 16 + 8 * g + hh] = acs[i]; }
    if (tid < 8) SCD[(size_t)(b * 64 + c) * 16 + 8 * g + tid] = __expf(acs[127 * 8 + tid]);
    {
        float y[8][8]; ssd_conv8(xa, cw, cbias, ccA, y);
#pragma unroll
        for (int i = 0; i < 8; ++i) { u32x4 o; o.x = pk2(y[i][0], y[i][1]); o.y = pk2(y[i][2], y[i][3]); o.z = pk2(y[i][4], y[i][5]); o.w = pk2(y[i][6], y[i][7]);
            *(u32x4*)(SX + (row0 + i) * 1536 + ccA) = o; }
        if (s < 16) {
#pragma unroll
            for (int j = 0; j < 8; ++j) { u32x4 o; o.x = pk2(y[0][j], y[1][j]); o.y = pk2(y[2][j], y[3][j]); o.z = pk2(y[4][j], y[5][j]); o.w = pk2(y[6][j], y[7][j]);
                *(LAS u32x4*)(BT + (8 * s + j) * 136 + 8 * (tg ^ (s & 7))) = o; }
        }
    }
    conv_load11(xa, p1, b, ts, C_CX + ccX + 256);
    float* dst0 = SST + ((size_t)((b * 64 + c) * 16 + 8 * g) * 64) * 128;
    ssd_prep_pass(F, xb, cw, cbias, ccX, SX, dst0, BT, XT, dts, acs, row0, s, tg, 0);
    ssd_prep_pass(F, xa, cw, cbias, ccX + 256, SX, dst0 + (size_t)4 * 64 * 128, BT, XT, dts, acs, row0, s, tg, 4);
}

DEV void nsa_compress_job(Frame& F, int l, int job) {
    const int kv = job >> 4, bg = (job >> 2) & 3, rt = job & 3, b = bg >> 1, g = bg & 1, i0 = 128 * rt;
    const float zf_ = opaque_zero();
    const bf16* p1 = WSP(bf16, WS_P1); const bf16* Wt = WSP(bf16, kv ? WS_WCV : WS_WCK); const float* cst = WSP(float, WS_CONST) + kv * 128;
    const int col0 = (kv ? C_BVC : C_BKC) + g * 128;
    LAS bf16* As = (LAS bf16*)F.lds;
    LAS bf16* Bs = As + 128 * 72;
    LAS float* Cs = (LAS float*)(Bs + 128 * 72);
    const int tid = F.tid, wm = F.wave >> 1, wn = F.wave & 1;
    f32x4 acc[2][4];
#pragma unroll
    for (int i = 0; i < 2; ++i)
#pragma unroll
        for (int j = 0; j < 4; ++j) acc[i][j] = ZERO4;
    u32x4 ra[2], rb[2];
#define LOADK(ks_) do { _Pragma("unroll") for (int q = 0; q < 2; ++q) { const int ch = tid + 512 * q, r = ch >> 3, c8 = (ch & 7) * 8; \
            int t = 16 * (i0 + r) + ((ks_) >> 1); if (t > SEQ - 1) t = SEQ - 1;     \
            ra[q] = *(const u32x4*)(p1 + (size_t)(b * SEQ + t) * P1W + col0 + ((ks_) & 1) * 64 + c8); \
            rb[q] = *(const u32x4*)(Wt + (size_t)r * 4096 + 64 * (ks_) + c8); } } while (0)
    LOADK(0);
    for (int ks = 0; ks < 64; ++ks) {
        __syncthreads();
#pragma unroll
        for (int q = 0; q < 2; ++q) { const int ch = tid + 512 * q, r = ch >> 3, c8 = (ch & 7) * 8; *(LAS u32x4*)(As + r * 72 + c8) = ra[q]; *(LAS u32x4*)(Bs + r * 72 + c8) = rb[q]; }
        __syncthreads();
        if (ks + 1 < 64) LOADK(ks + 1);
#pragma unroll
        for (int k2 = 0; k2 < 2; ++k2) {
            bf16x8 a0 = frag_l(As, 72, 32 * wm, 32 * k2, F.lane), a1 = frag_l(As, 72, 32 * wm + 16, 32 * k2, F.lane);
#pragma unroll
            for (int j = 0; j < 4; ++j) { const bf16x8 bb = frag_l(Bs, 72, 64 * wn + 16 * j, 32 * k2, F.lane); acc[0][j] = mfma16(a0, bb, acc[0][j]); acc[1][j] = mfma16(a1, bb, acc[1][j]); }
        }
    }
    __syncthreads();
#pragma unroll
    for (int i = 0; i < 2; ++i)
#pragma unroll
        for (int j = 0; j < 4; ++j)
#pragma unroll
            for (int r = 0; r < 4; ++r) { const int col = 64 * wn + 16 * j + (F.lane & 15); Cs[(32 * wm + 16 * i + 4 * (F.lane >> 4) + r) * 132 + col] = acc[i][j][r] + cst[col]; }
    __syncthreads();
    if (kv == 0) {
        const float* kn = lin(F, I_NKN, l, 128); bf16* KC = WSP(bf16, WS_KCMP);
        const int r = tid >> 2, q = tid & 3; const LAS float* s = Cs + r * 132 + 32 * q; float ss = 0.f;
#pragma unroll
        for (int e = 0; e < 32; ++e) ss += s[e] * s[e];
        ss += shx<1>(ss); ss += shx<2>(ss);
        const float rs = rsqrtf(ss * (1.0f / 128.0f) + EPS);
        bf16* dst = KC + ((size_t)bg * 512 + i0 + r) * 128 + 32 * q;
#pragma unroll
        for (int e = 0; e < 32; e += 2) *(unsigned*)(dst + e) = pk2(s[e] * rs * kn[32 * q + e], s[e + 1] * rs * kn[32 * q + e + 1]);
    } else {
        bf16* VC = WSP(bf16, WS_VCMPT); const int e = tid & 127, q = tid >> 7;
#pragma unroll
        for (int i8 = 0; i8 < 4; ++i8) { const LAS float* s = Cs + (32 * q + 8 * i8) * 132 + e;
            u32x4 o; o.x = pk2(s[0], s[132]); o.y = pk2(s[264], s[396]); o.z = pk2(s[528], s[660]); o.w = pk2(s[792], s[924]);
            *(u32x4*)(VC + ((size_t)bg * 128 + e) * 512 + i0 + 32 * q + 8 * i8) = o; }
    }
    __syncthreads();
}
#undef LOADK

constexpr int AL_KT = 0, AL_VT = 17408, AL_KT1 = 35840, AL_UW = 53248, AL_TB = 54272, AL_SM = 60608, AL_PS = 61696, AL_IMP = 78336, AL_VT1 = 111104, AL_END = 129536;
static_assert(AL_KT1 + 17408 <= AL_UW && AL_UW + 128 <= AL_TB && AL_END <= MISC_OFF, "attention LDS map");
DEV int rel_bucket_dev(int n) {
    if (n < 16) return n;
    int k = 16;
    k += (n >= 21); k += (n >= 27); k += (n >= 35); k += (n >= 46); k += (n >= 59); k += (n >= 77); k += (n >= 99); k += (n >= 128);
    k += (n >= 166); k += (n >= 216); k += (n >= 280); k += (n >= 363); k += (n >= 470); k += (n >= 609); k += (n >= 790);
    return k;
}
DEV void attn_fill_bias(Frame& F, int g) {
    LAS float* tb = (LAS float*)(F.lds + AL_TB); const float* rt = F.p->in[I_REL];
    for (int i = F.tid; i < 2 * 792; i += 512) { const int hg = i / 792, d = i - hg * 792; tb[i] = rt[rel_bucket_dev(d) * 4 + 2 * g + hg] * 1.4426950408889634f; }
}
DEV void attn_load_tile(u32x4 (&rk)[2], u32x4 (&rv)[2], const bf16* ksrc, const bf16* vsrc, int vpitch, int tid) {
#pragma unroll
    for (int q = 0; q < 2; ++q) { const int ch = tid + 512 * q; rk[q] = *(const u32x4*)(ksrc + (size_t)ch * 8); rv[q] = *(const u32x4*)(vsrc + (size_t)(ch >> 3) * vpitch + (ch & 7) * 8); }
}
DEV void attn_store_tile(LAS unsigned char* lds, int buf, const u32x4 (&rk)[2], const u32x4 (&rv)[2], int tid) {
    LAS bf16* Kt = (LAS bf16*)(lds + (buf ? AL_KT1 : AL_KT)); LAS bf16* Vt = (LAS bf16*)(lds + (buf ? AL_VT1 : AL_VT));
#pragma unroll
    for (int q = 0; q < 2; ++q) { const int ch = tid + 512 * q; *(LAS u32x4*)(Kt + (ch >> 4) * 136 + (ch & 15) * 8) = rk[q]; *(LAS u32x4*)(Vt + (ch >> 3) * 72 + (ch & 7) * 8) = rv[q]; }
}
template <int MODE, int PATH = 0>
DEV unsigned attn_scores(LAS unsigned char* lds, int buf, const bf16x8 (&qf)[4], int lane, int n0, int tok, int hg, unsigned selbit, f32x4 (&s)[4]) {
    const float zf_ = opaque_zero();
    const LAS bf16* Kt = (const LAS bf16*)(lds + (buf ? AL_KT1 : AL_KT)); const LAS float* tb = (const LAS float*)(lds + AL_TB) + hg * 792;
#pragma unroll
    for (int nt = 0; nt < 4; ++nt) { s[nt] = ZERO4;
#pragma unroll
        for (int ks = 0; ks < 4; ++ks) s[nt] = mfma16(frag_l(Kt, 136, 16 * nt, 32 * ks, lane), qf[ks], s[nt]); }
    if (PATH == 1) {
        const float bf = tb[790]; const bool ok = selbit != 0u;
#pragma unroll
        for (int nt = 0; nt < 4; ++nt)
#pragma unroll
            for (int r = 0; r < 4; ++r) s[nt][r] = ok ? s[nt][r] + bf : -1e30f;
        return ok ? 0xffffu : 0u;
    }
    if (PATH == 2) {
        const bool ok = MODE == 2 ? true : (selbit != 0u);
        const LAS float* tp = tb + (tok - n0 - 4 * (lane >> 4));
#pragma unroll
        for (int nt = 0; nt < 4; ++nt)
#pragma unroll
            for (int r = 0; r < 4; ++r) s[nt][r] = ok ? s[nt][r] + tp[-16 * nt - r] : -1e30f;
        return ok ? 0xffffu : 0u;
    }
    unsigned vm = 0u;
#pragma unroll
    for (int nh = 0; nh < 2; ++nh) {
        float bv[8];
#pragma unroll
        for (int q = 0; q < 8; ++q) { const int nt = 2 * nh + (q >> 2), r = q & 3; const int n = n0 + 16 * nt + 4 * (lane >> 4) + r; const int dist = MODE == 0 ? tok - (16 * n + 31) : tok - n;
            int di = dist < 0 ? 0 : dist; di = di > 790 ? 790 : di; bv[q] = tb[di]; }
#pragma unroll
        for (int q = 0; q < 8; ++q) asm volatile("" : "+v"(bv[q]));
#pragma unroll
        for (int q = 0; q < 8; ++q) { const int nt = 2 * nh + (q >> 2), r = q & 3; const int n = n0 + 16 * nt + 4 * (lane >> 4) + r; int dist; bool ok;
            if (MODE == 0) { dist = tok - (16 * n + 31); ok = dist >= 0 && n < 511; }
            else if (MODE == 1) { dist = tok - n; ok = dist >= 0 && selbit != 0u; }
            else { dist = tok - n; ok = dist >= 0 && dist < 512; }
            s[nt][r] = ok ? s[nt][r] + bv[q] : -1e30f;
            vm |= (ok ? 1u : 0u) << (4 * nt + r); }
    }
    return vm;
}
DEV float fq_max(float v) {
    const auto a = __builtin_amdgcn_permlane16_swap(__builtin_bit_cast(unsigned, v), __builtin_bit_cast(unsigned, v), false, false);
    const float m = fmaxf(__builtin_bit_cast(float, a[0]), __builtin_bit_cast(float, a[1]));
    const auto b = __builtin_amdgcn_permlane32_swap(__builtin_bit_cast(unsigned, m), __builtin_bit_cast(unsigned, m), false, false);
    return fmaxf(__builtin_bit_cast(float, b[0]), __builtin_bit_cast(float, b[1]));
}
DEV float fq_sum(float v) {
    const auto a = __builtin_amdgcn_permlane16_swap(__builtin_bit_cast(unsigned, v), __builtin_bit_cast(unsigned, v), false, false);
    const float m = __builtin_bit_cast(float, a[0]) + __builtin_bit_cast(float, a[1]);
    const auto b = __builtin_amdgcn_permlane32_swap(__builtin_bit_cast(unsigned, m), __builtin_bit_cast(unsigned, m), false, false);
    return __builtin_bit_cast(float, b[0]) + __builtin_bit_cast(float, b[1]);
}
DEV float attn_online(const f32x4 (&s)[4], unsigned vm, float& m, float& l, f32x4 (&p)[4]) {
    float mx = fmaxf(fmaxf(fmaxf(s[0][0], s[0][1]), fmaxf(s[0][2], s[0][3])), fmaxf(fmaxf(s[1][0], s[1][1]), fmaxf(s[1][2], s[1][3])));
    mx = fmaxf(mx, fmaxf(fmaxf(fmaxf(s[2][0], s[2][1]), fmaxf(s[2][2], s[2][3])), fmaxf(fmaxf(s[3][0], s[3][1]), fmaxf(s[3][2], s[3][3]))));
    mx = fmaxf(mx, shx<16>(mx)); mx = fmaxf(mx, shx<32>(mx));
    const float mn = fmaxf(m, mx), sc = __builtin_amdgcn_exp2f(m - mn); float rs = 0.f;
#pragma unroll
    for (int nt = 0; nt < 4; ++nt)
#pragma unroll
        for (int r = 0; r < 4; ++r) { const float pv = ((vm >> (4 * nt + r)) & 1u) ? __builtin_amdgcn_exp2f(s[nt][r] - mn) : 0.f; p[nt][r] = pv; rs += pv; }
    rs += shx<16>(rs); rs += shx<32>(rs);
    l = l * sc + rs; m = mn;
    return sc;
}
DEV void attn_pv(LAS unsigned char* lds, int buf, int lane, const f32x4 (&p)[4], f32x4 (&o)[8]) {
    const LAS bf16* Vt = (const LAS bf16*)(lds + (buf ? AL_VT1 : AL_VT)) + (lane & 15) * 72 + 4 * (lane >> 4);
#pragma unroll
    for (int ks = 0; ks < 2; ++ks) {
        u32x4 pw; pw.x = pg8::cvt_pk_bf16(p[2 * ks][0], p[2 * ks][1]); pw.y = pg8::cvt_pk_bf16(p[2 * ks][2], p[2 * ks][3]); pw.z = pg8::cvt_pk_bf16(p[2 * ks + 1][0], p[2 * ks + 1][1]); pw.w = pg8::cvt_pk_bf16(p[2 * ks + 1][2], p[2 * ks + 1][3]);
        const bf16x8 pb = __builtin_bit_cast(bf16x8, pw);
#pragma unroll
        for (int dt = 0; dt < 8; ++dt) {
            const u32x2 v0 = *(const LAS u32x2*)(Vt + 16 * dt * 72 + 32 * ks), v1 = *(const LAS u32x2*)(Vt + 16 * dt * 72 + 32 * ks + 16);
            u32x4 vw; vw.x = v0.x; vw.y = v0.y; vw.z = v1.x; vw.w = v1.y;
            o[dt] = mfma16(__builtin_bit_cast(bf16x8, vw), pb, o[dt]); }
    }
}
DEV void attn_load_q(Frame& F, int bg, int t0, bf16x8 (&qf)[4]) {
    const bf16* QN = WSP(bf16, WS_QN); const int rho = F.lane & 15;
    const bf16* src = QN + ((size_t)(bg * SEQ + t0 + 8 * F.wave + (rho & 7)) * 2 + (rho >> 3)) * 128 + 8 * (F.lane >> 4);
#pragma unroll
    for (int ks = 0; ks < 4; ++ks) qf[ks] = *(const bf16x8*)(src + 32 * ks);
}

DEV void sel_step(Frame& F, const bf16* KS, const bf16* VS, int j, int jn, int jnn, int qt, int cb, const u32x4 (&st_k)[2], const u32x4 (&st_v)[2], u32x4 (&ld_k)[2], u32x4 (&ld_v)[2],
                  const bf16x8 (&qf)[4], const u32x4& smw, const unsigned (&wum)[4], int tok, int hg, float& m, float& l, f32x4 (&o)[8]) {
    const int lane = F.lane;
    if (jnn <= qt) attn_load_tile(ld_k, ld_v, KS + (size_t)jnn * 64 * 128, VS + (size_t)jnn * 128 * 64, 64, F.tid);
    const unsigned wsel = j < 32 ? wum[0] : (j < 64 ? wum[1] : (j < 96 ? wum[2] : wum[3]));
    if ((wsel >> (j & 31)) & 1u) {
        const unsigned w = j < 32 ? smw.x : (j < 64 ? smw.y : (j < 96 ? smw.z : smw.w)); const unsigned selbit = (w >> (j & 31)) & 1u;
        f32x4 s[4], p[4];
        const unsigned vm = (j <= qt - 14) ? attn_scores<1, 1>(F.lds, cb, qf, lane, 64 * j, tok, hg, selbit, s) : ((j >= qt - 11 && j < qt) ? attn_scores<1, 2>(F.lds, cb, qf, lane, 64 * j, tok, hg, selbit, s) : attn_scores<1, 0>(F.lds, cb, qf, lane, 64 * j, tok, hg, selbit, s));
        const float sc = attn_online(s, vm, m, l, p);
        if (__ballot(sc != 1.0f) != 0ull) {
#pragma unroll
            for (int dt = 0; dt < 8; ++dt) o[dt] = o[dt] * sc; }
        attn_pv(F.lds, cb, lane, p, o);
    }
    if (jn <= qt) attn_store_tile(F.lds, cb ^ 1, st_k, st_v, F.tid);
    __syncthreads();
}
DEV int sel_next(int j, int qt, const unsigned (&um)[4]) {
    int jn = j + 1;
    while (jn <= qt) { const unsigned w = jn < 32 ? um[0] : (jn < 64 ? um[1] : (jn < 96 ? um[2] : um[3])); if ((w >> (jn & 31)) & 1u) break; ++jn; }
    return jn;
}
#define NST(k) do { if (DBG_AJOB >= 10 && F.tid == 0) { volatile LAS unsigned* m_ = (volatile LAS unsigned*)(F.lds + MISC_OFF); const unsigned t_ = (unsigned)__builtin_amdgcn_s_memrealtime(); \
        if (DBG_AJOB == (k)) atomicAdd(WSP(unsigned, WS_CTL) + 460000, t_ - m_[70]); m_[70] = t_; } } while (0)
DEV void nsa_job(Frame& F, int job) {
    const int bg = job >> 7, qt = job & 127, b = bg >> 1, g = bg & 1, t0 = 64 * qt, tid = F.tid, lane = F.lane, wave = F.wave;
    const float zf_ = opaque_zero();
    const int fq = lane >> 4, fr = lane & 15, hg = fr >> 3, tok = t0 + 8 * wave + (fr & 7);
    const float* small = WSP(float, WS_SMALL); const size_t row = (size_t)(b * SEQ + tok);
    LAS float* PS = (LAS float*)(F.lds + AL_PS) + wave * (8 * 65); LAS float* IMP = (LAS float*)(F.lds + AL_IMP);
    LAS unsigned* SM = (LAS unsigned*)(F.lds + AL_SM);
    LAS unsigned* UW = (LAS unsigned*)(F.lds + AL_UW);
    __syncthreads();
    NST(0);
    attn_fill_bias(F, g);
    for (int i = tid; i < 64 * 128; i += 512) IMP[i] = 0.f;
    if (lane < 8) PS[lane * 65] = 0.f;
    bf16x8 qf[4]; attn_load_q(F, bg, t0, qf);
    f32x4 tot[8];
    u32x4 rk[2], rv[2];
    NST(10);
    for (int dr_ = 0; dr_ < (DBG_NSA == 1 ? 2 : 1); ++dr_) {
        if (dr_ == 1) { WAVE_SYNC(); if (lane < 8) PS[lane * 65] = 0.f; WAVE_SYNC(); }
        const int ntiles = (4 * qt + 2) / 64 + 1;
        const bf16* KC = WSP(bf16, WS_KCMP) + (size_t)bg * 512 * 128; const bf16* VC = WSP(bf16, WS_VCMPT) + (size_t)bg * 128 * 512;
        float m = -1e30f, l = 0.f;
        attn_load_tile(rk, rv, KC, VC, 512, tid); attn_store_tile(F.lds, 0, rk, rv, tid); __syncthreads();
        for (int j = 0; j < ntiles; ++j) {
            if (j + 1 < ntiles) attn_load_tile(rk, rv, KC + (size_t)(j + 1) * 64 * 128, VC + (j + 1) * 64, 512, tid);
            f32x4 s[4], p[4];
            const unsigned vm = attn_scores<0>(F.lds, j & 1, qf, lane, 64 * j, tok, hg, 0u, s);
            (void)attn_online(s, vm, m, l, p);
            if (j + 1 < ntiles) attn_store_tile(F.lds, (j + 1) & 1, rk, rv, tid);
            __syncthreads();
        }
        const float il = l > 0.f ? 1.0f / l : 0.f;
        f32x4 o[8];
#pragma unroll
        for (int dt = 0; dt < 8; ++dt) o[dt] = ZERO4;
        attn_load_tile(rk, rv, KC, VC, 512, tid); attn_store_tile(F.lds, 0, rk, rv, tid); __syncthreads();
        for (int j = 0; j < ntiles; ++j) {
            if (j + 1 < ntiles) attn_load_tile(rk, rv, KC + (size_t)(j + 1) * 64 * 128, VC + (j + 1) * 64, 512, tid);
            f32x4 s[4], p[4];
            const unsigned vm = attn_scores<0>(F.lds, j & 1, qf, lane, 64 * j, tok, hg, 0u, s);
#pragma unroll
            for (int nt = 0; nt < 4; ++nt)
#pragma unroll
                for (int r = 0; r < 4; ++r) {
                    const float pv = ((vm >> (4 * nt + r)) & 1u) ? __builtin_amdgcn_exp2f(s[nt][r] - m) * il : 0.f; p[nt][r] = pv;
                    const float ps = pv + shx<8>(pv);
                    if (fr < 8) PS[fr * 65 + 1 + 16 * nt + 4 * fq + r] = ps;
                }
            WAVE_SYNC();
#pragma unroll
            for (int q = 0; q < 2; ++q) { const int idx = lane + 64 * q, tk = idx >> 4, bl = idx & 15; const LAS float* ps = PS + tk * 65 + 4 * bl;
                IMP[(8 * wave + tk) * 128 + 16 * j + bl] = ps[0] + 2.0f * ps[1] + 2.0f * ps[2] + 2.0f * ps[3] + ps[4]; }
            WAVE_SYNC();
            if (lane < 8) PS[lane * 65] = PS[lane * 65 + 64];
            WAVE_SYNC();
            attn_pv(F.lds, j & 1, lane, p, o);
            if (j + 1 < ntiles) attn_store_tile(F.lds, (j + 1) & 1, rk, rv, tid);
            __syncthreads();
        }
        const float gt = (DBG_NSAZ & 1) ? zf_ : sigmoidf_(small[row * SMW + S_BG + (2 * g + hg) * 3 + 0]);
#pragma unroll
        for (int dt = 0; dt < 8; ++dt) tot[dt] = o[dt] * gt;
    }
    NST(11);
    unsigned wum[4] = {0u, 0u, 0u, 0u};
    for (int dr_ = 0; dr_ < (DBG_NSA == 4 ? 2 : 1); ++dr_) {
        const int cur = qt;
        for (int tk = 0; tk < 8; ++tk) {
            const LAS float* rowp = IMP + (8 * wave + tk) * 128;
            const int b0 = lane, b1 = lane + 64;
            const float s0 = b0 > cur ? -1e4f : ((b0 == 0 || b0 >= cur - 1) ? 1e4f : rowp[b0]);
            const float s1 = b1 > cur ? -1e4f : ((b1 == 0 || b1 >= cur - 1) ? 1e4f : rowp[b1]);
            unsigned k0 = __builtin_bit_cast(unsigned, s0), k1 = __builtin_bit_cast(unsigned, s1);
            k0 = (k0 & 0x80000000u) ? ~k0 : (k0 | 0x80000000u); k1 = (k1 & 0x80000000u) ? ~k1 : (k1 | 0x80000000u);
            unsigned prefix = 0u; int need = 16;
            for (int bit = 31; bit >= 0; --bit) {
                const unsigned cand = (prefix | (1u << bit)) >> bit;
                const int cnt = __builtin_popcountll(__ballot((k0 >> bit) == cand)) + __builtin_popcountll(__ballot((k1 >> bit) == cand));
                if (cnt >= need) prefix |= (1u << bit); else need -= cnt;
            }
            const unsigned long long e0 = __ballot(k0 == prefix), e1 = __ballot(k1 == prefix);
            const int r0 = (int)__builtin_amdgcn_mbcnt_hi((unsigned)(e0 >> 32), __builtin_amdgcn_mbcnt_lo((unsigned)e0, 0u));
            const int r1 = __builtin_popcountll(e0) + (int)__builtin_amdgcn_mbcnt_hi((unsigned)(e1 >> 32), __builtin_amdgcn_mbcnt_lo((unsigned)e1, 0u));
            const bool sel0 = k0 > prefix || (k0 == prefix && r0 < need), sel1 = k1 > prefix || (k1 == prefix && r1 < need);
            const unsigned long long m0 = __ballot(sel0), m1 = __ballot(sel1);
            const unsigned w0 = (unsigned)m0, w1 = (unsigned)(m0 >> 32), w2 = (unsigned)m1, w3 = (unsigned)(m1 >> 32);
            wum[0] |= w0; wum[1] |= w1; wum[2] |= w2; wum[3] |= w3;
            if (lane == 0) { SM[(8 * wave + tk) * 4 + 0] = w0; SM[(8 * wave + tk) * 4 + 1] = w1; SM[(8 * wave + tk) * 4 + 2] = w2; SM[(8 * wave + tk) * 4 + 3] = w3; }
        }
        if (lane == 0) { UW[wave * 4 + 0] = wum[0]; UW[wave * 4 + 1] = wum[1]; UW[wave * 4 + 2] = wum[2]; UW[wave * 4 + 3] = wum[3]; }
    }
    __syncthreads();
    const u32x4 smw = *(const LAS u32x4*)(SM + (8 * wave + (fr & 7)) * 4);
    unsigned um[4];
#pragma unroll
    for (int w = 0; w < 4; ++w) { unsigned v = 0u;
#pragma unroll
        for (int q = 0; q < 8; ++q) v |= UW[q * 4 + w];
        um[w] = __builtin_amdgcn_readfirstlane(v); }
    const bf16* KS = WSP(bf16, WS_KS) + (size_t)bg * SEQ * 128; const bf16* VS = WSP(bf16, WS_VST) + (size_t)bg * 128 * 8192;
    const bf16* KW = WSP(bf16, WS_KW) + (size_t)bg * SEQ * 128; const bf16* VW = WSP(bf16, WS_VWT) + (size_t)bg * 128 * 8192;
    NST(12);
    for (int dr_ = 0; dr_ < (DBG_NSA == 2 ? 2 : 1); ++dr_) {
        float m = -1e30f, l = 0.f; f32x4 o[8];
#pragma unroll
        for (int dt = 0; dt < 8; ++dt) o[dt] = ZERO4;
        u32x4 rk2[2], rv2[2];
        int j = 0, jn = sel_next(0, qt, um), cb = 0;
        attn_load_tile(rk, rv, KS, VS, 64, tid); attn_store_tile(F.lds, 0, rk, rv, tid);
        if (jn <= qt) attn_load_tile(rk, rv, KS + (size_t)jn * 64 * 128, VS + (size_t)jn * 128 * 64, 64, tid);
        __syncthreads();
        while (j <= qt) {
            int jnn = jn <= qt ? sel_next(jn, qt, um) : jn;
            sel_step(F, KS, VS, j, jn, jnn, qt, cb, rk, rv, rk2, rv2, qf, smw, wum, tok, hg, m, l, o);
            cb ^= 1; j = jn; jn = jnn;
            if (j > qt) break;
            jnn = jn <= qt ? sel_next(jn, qt, um) : jn;
            sel_step(F, KS, VS, j, jn, jnn, qt, cb, rk2, rv2, rk, rv, qf, smw, wum, tok, hg, m, l, o);
            cb ^= 1; j = jn; jn = jnn;
        }
        const float gt = ((DBG_NSA == 2 && dr_ == 0) || (DBG_NSAZ & 2)) ? zf_ * l : sigmoidf_(small[row * SMW + S_BG + (2 * g + hg) * 3 + 1]) / l;
#pragma unroll
        for (int dt = 0; dt < 8; ++dt) tot[dt] = tot[dt] + o[dt] * gt;
    }
    NST(13);
    for (int dr_ = 0; dr_ < (DBG_NSA == 3 ? 2 : 1); ++dr_) {
        float m = -1e30f, l = 0.f; f32x4 o[8];
#pragma unroll
        for (int dt = 0; dt < 8; ++dt) o[dt] = ZERO4;
        const int j0 = qt >= 8 ? qt - 8 : 0;
        attn_load_tile(rk, rv, KW + (size_t)j0 * 64 * 128, VW + (size_t)j0 * 128 * 64, 64, tid); attn_store_tile(F.lds, 0, rk, rv, tid); __syncthreads();
        for (int j = j0; j <= qt; ++j) {
            const int cb = (j - j0) & 1;
            if (j + 1 <= qt) attn_load_tile(rk, rv, KW + (size_t)(j + 1) * 64 * 128, VW + (size_t)(j + 1) * 128 * 64, 64, tid);
            f32x4 s[4], p[4];
            const unsigned vm = (j >= qt - 7 && j < qt) ? attn_scores<2, 2>(F.lds, cb, qf, lane, 64 * j, tok, hg, 0u, s) : attn_scores<2, 0>(F.lds, cb, qf, lane, 64 * j, tok, hg, 0u, s);
            const float sc = attn_online(s, vm, m, l, p);
#pragma unroll
            for (int dt = 0; dt < 8; ++dt) o[dt] = o[dt] * sc;
            attn_pv(F.lds, cb, lane, p, o);
            if (j + 1 <= qt) attn_store_tile(F.lds, cb ^ 1, rk, rv, tid);
            __syncthreads();
        }
        const float gt = ((DBG_NSA == 3 && dr_ == 0) || (DBG_NSAZ & 4)) ? zf_ * l : sigmoidf_(small[row * SMW + S_BG + (2 * g + hg) * 3 + 2]) / l;
#pragma unroll
        for (int dt = 0; dt < 8; ++dt) tot[dt] = tot[dt] + o[dt] * gt;
    }
    NST(14);
    {
        bf16* YC = WSP(bf16, WS_YCAT);
#pragma unroll
        for (int dt = 0; dt < 8; ++dt) { const int cidx = (2 * g + hg) * 128 + 16 * dt + 4 * fq;
            f32x4 y = tot[dt]; if (DBG_ZERO & 2) y = ZERO4;
            u32x2 w; w.x = pk2(y[0], y[1]); w.y = pk2(y[2], y[3]); *(u32x2*)(YC + row * 2048 + 512 + cidx) = w; }
    }
    __syncthreads();
    NST(15);
}
#undef NST

DEV void gdn_scan_job(Frame& F, int job) {
    const int bh = job >> 3, sl = job & 7, b = bh >> 2, h = bh & 3, lane = F.lane, wave = F.wave, fq = lane >> 4, fr = lane & 15;
    LAS bf16* St = (LAS bf16*)F.lds;
    LAS bf16* Vn = St + 16 * 136;
    const float* GL = WSP(float, WS_GL); float* GO = WSP(float, WS_GO);
    const float zf_ = opaque_zero();
    __syncthreads();
    for (int i = F.tid; i < 16 * 136 / 2; i += 512) ((LAS unsigned*)St)[i] = 0u;
    f32x4 S = ZERO4;
    const int mt = wave & 3;
    __syncthreads();
    const int o1 = (wave < 4 ? 0 : 8192) + (16 * mt + fr) * 128 + 8 * fq;
    const int oA = 32768 + (16 * mt + fr) * 64 + 8 * fq;
    const int oK = 16384 + (16 * wave + fr) * 64 + 8 * fq;
    const int oU = 24576 + (16 * sl + fr) * 64 + 16 * mt + 4 * fq;
    const bf16* rec = (const bf16*)(F.ws + WS_GW + (size_t)(bh * 128) * GDN_CH_BYTES);
    bf16x8 a1[4], aA[2], aK[2], n1[4], nA[2], nK[2]; u32x2 uu, nu; float gl, ngl;
#define GLOAD(A1, AA, AK, UU, G, c_) do { const bf16* r_ = rec + (size_t)(c_) * (GDN_CH_BYTES / 2); \
        _Pragma("unroll") for (int ks = 0; ks < 4; ++ks) A1[ks] = *(const bf16x8*)(r_ + o1 + 32 * ks); \
        AA[0] = *(const bf16x8*)(r_ + oA); AA[1] = *(const bf16x8*)(r_ + oA + 32); AK[0] = *(const bf16x8*)(r_ + oK); AK[1] = *(const bf16x8*)(r_ + oK + 32); \
        UU = *(const u32x2*)(r_ + oU); G = GL[bh * 128 + (c_)]; } while (0)
    GLOAD(a1, aA, aK, uu, gl, 0);
    for (int c = 0; c < 128; ++c) {
        const int cn = c + 1 < 128 ? c + 1 : c;
        GLOAD(n1, nA, nK, nu, ngl, cn);
        f32x4 d1 = ZERO4;
#pragma unroll
        for (int ks = 0; ks < 4; ++ks) d1 = mfma16(a1[ks], frag_l(St, 136, 0, 32 * ks, lane), d1);
        if (wave < 4) {
            const float v0 = bflo(uu.x) - d1[0], v1 = bfhi(uu.x) - d1[1], v2 = bflo(uu.y) - d1[2], v3 = bfhi(uu.y) - d1[3];
            u32x2 w; w.x = pk2(v0, v1); w.y = pk2(v2, v3);
            *(LAS u32x2*)(Vn + fr * 72 + 16 * mt + 4 * fq) = w;
        }
        LDS_WAIT(); __builtin_amdgcn_s_barrier(); CFENCE();
        const bf16x8 bv0 = frag_l(Vn, 72, 0, 0, lane), bv1 = frag_l(Vn, 72, 0, 32, lane);
        if (wave >= 4) {
            d1 = mfma16(aA[0], bv0, d1); d1 = mfma16(aA[1], bv1, d1);
#pragma unroll
            for (int r = 0; r < 4; ++r) GO[(size_t)(b * SEQ + 64 * c + 16 * mt + 4 * fq + r) * 512 + h * 128 + 16 * sl + fr] = d1[r];
        }
        f32x4 dk = ZERO4;
        dk = mfma16(aK[0], bv0, dk); dk = mfma16(aK[1], bv1, dk);
        S = S * gl + dk;
        { u32x2 w; w.x = pk2(S[0], S[1]); w.y = pk2(S[2], S[3]); *(LAS u32x2*)(St + fr * 136 + 16 * wave + 4 * fq) = w; }
        LDS_WAIT(); __builtin_amdgcn_s_barrier(); CFENCE();
#pragma unroll
        for (int ks = 0; ks < 4; ++ks) a1[ks] = n1[ks];
        aA[0] = nA[0]; aA[1] = nA[1]; aK[0] = nK[0]; aK[1] = nK[1]; uu = nu; gl = ngl;
    }
#undef GLOAD
    __syncthreads();
}

DEV void ssd_scan_part(Frame& F, int part, int nparts) {
    float* __restrict__ SST = WSP(float, WS_SST); const float* __restrict__ SCD = WSP(float, WS_SCD);
    constexpr int PER_B = 16 * 64 * 128;
    for (int e = part * 512 + F.tid; e < 2 * PER_B; e += nparts * 512) {
        const int b = e / PER_B, r = e - b * PER_B, h = r >> 13;
        float* p = SST + (size_t)(b * 64) * PER_B + r; const float* cdp = SCD + (b * 64) * 16 + h;
        float s = 0.f;
#pragma unroll
        for (int hb = 0; hb < 2; ++hb) {
            float v[32], cd[32];
#pragma unroll
            for (int c = 0; c < 32; ++c) { v[c] = p[(size_t)(32 * hb + c) * PER_B]; cd[c] = cdp[(32 * hb + c) * 16]; }
#pragma unroll
            for (int c = 0; c < 32; ++c) { p[(size_t)(32 * hb + c) * PER_B] = s; s = s * cd[c] + v[c]; }
        }
    }
}

DEV void gdn_final_rows(Frame& F, int l, int w0, int nw) {
    const float* GO = WSP(float, WS_GO); const bf16* p1 = WSP(bf16, WS_P1); bf16* YC = WSP(bf16, WS_YCAT); const float* gn = lin(F, I_GNORM, l, 128);
    const int lane = F.lane, dv0 = (lane & 15) * 8;
    float gv[8];
#pragma unroll
    for (int j = 0; j < 8; ++j) gv[j] = gn[dv0 + j];
    for (int row = w0; row < MTOK; row += nw) {
        const f32x4 a = *(const f32x4*)(GO + (size_t)row * 512 + lane * 8), bq = *(const f32x4*)(GO + (size_t)row * 512 + lane * 8 + 4);
        float ss = (a[0] * a[0] + a[1] * a[1]) + (a[2] * a[2] + a[3] * a[3]) + (bq[0] * bq[0] + bq[1] * bq[1]) + (bq[2] * bq[2] + bq[3] * bq[3]);
        ss = sum16(ss);
        const float rs = rsqrtf(ss * (1.0f / 128.0f) + EPS);
        const u32x4 zw = *(const u32x4*)(p1 + (size_t)row * P1W + C_AZ + lane * 8);
        const float z[8] = {bflo(zw.x), bfhi(zw.x), bflo(zw.y), bfhi(zw.y), bflo(zw.z), bfhi(zw.z), bflo(zw.w), bfhi(zw.w)};
        const float o[8] = {a[0], a[1], a[2], a[3], bq[0], bq[1], bq[2], bq[3]};
        float y[8];
#pragma unroll
        for (int j = 0; j < 8; ++j) y[j] = (DBG_ZERO & 1) ? opaque_zero() : o[j] * rs * gv[j] * siluf_(z[j]);
        u32x4 w; w.x = pk2(y[0], y[1]); w.y = pk2(y[2], y[3]); w.z = pk2(y[4], y[5]); w.w = pk2(y[6], y[7]);
        *(u32x4*)(YC + (size_t)row * 2048 + lane * 8) = w;
    }
}

DEV void ssd_out_job(Frame& F, int l, int job) {
    const int b = job >> 7, c = (job >> 1) & 63, g = job & 1, t0 = 128 * c, tid = F.tid, lane = F.lane, wave = F.wave, fq = lane >> 4, fr = lane & 15;
    const bf16* SX = WSP(bf16, WS_SX); const bf16* p1 = WSP(bf16, WS_P1); const float* SDT = WSP(float, WS_SDT); const float* SAC = WSP(float, WS_SAC); const float* SST = WSP(float, WS_SST);
    bf16* YC = WSP(bf16, WS_YCAT); float* RC = WSP(float, WS_SRC);
    const float zf_ = opaque_zero();
    LAS bf16* Cs = (LAS bf16*)F.lds;
    LAS bf16* Bs = Cs + 128 * 136;
    LAS bf16* XdT = Bs + 128 * 136;
    LAS bf16* SiT = XdT + 64 * 136;
    LAS bf16* Pw = SiT + 64 * 136;
    LAS float* acs = (LAS float*)(Pw + 8 * 16 * 136);
    __syncthreads();
    for (int i = tid; i < 2 * 128 * 16; i += 512) { const int v = i >> 11, r = (i >> 4) & 127, c8 = (i & 15) * 8;
        const u32x4 w = *(const u32x4*)(SX + (size_t)(b * SEQ + t0 + r) * 1536 + 1024 + (v ? 256 : 0) + g * 128 + c8);
        *(LAS u32x4*)((v ? Cs : Bs) + r * 136 + c8) = w; }
    for (int i = tid; i < 1024; i += 512) { const size_t row = (size_t)(b * SEQ + t0 + (i >> 3)); acs[i] = SAC[row * 16 + 8 * g + (i & 7)]; }
    __syncthreads();
    f32x4 cb[8];
    {
        bf16x8 ca[4];
#pragma unroll
        for (int ks = 0; ks < 4; ++ks) ca[ks] = frag_l(Cs, 136, 16 * wave, 32 * ks, lane);
#pragma unroll
        for (int nt = 0; nt < 8; ++nt) { cb[nt] = ZERO4;
#pragma unroll
            for (int ks = 0; ks < 4; ++ks) cb[nt] = mfma16(ca[ks], frag_l(Bs, 136, 16 * nt, 32 * ks, lane), cb[nt]); }
    }
    float ssq = 0.f;
    LAS bf16* pw = Pw + wave * 16 * 136;
    const float* dsk = lin(F, I_SD, l, 16);
    const int sp = tid & 7, tp = tid >> 3; const size_t rp0 = (size_t)(b * SEQ + t0 + 2 * tp);
    const size_t rowl = (size_t)(b * SEQ + t0 + 16 * wave + fr);
    u32x4 x0, x1; float d0, d1; f32x4 sv[4];
#define SSD_LOADH(h_) do { x0 = *(const u32x4*)(SX + rp0 * 1536 + (h_) * 64 + 8 * sp); x1 = *(const u32x4*)(SX + (rp0 + 1) * 1536 + (h_) * 64 + 8 * sp); d0 = SDT[rp0 * 16 + (h_)]; d1 = SDT[(rp0 + 1) * 16 + (h_)]; \
        const float* sin_ = SST + ((size_t)((b * 64 + c) * 16 + (h_)) * 64) * 128; _Pragma("unroll") for (int q = 0; q < 4; ++q) sv[q] = *(const f32x4*)(sin_ + (size_t)(tid + 512 * q) * 4); } while (0)
    SSD_LOADH(8 * g);
    for (int hh = 0; hh < 8; ++hh) {
        const int h = 8 * g + hh;
        __syncthreads();
        {
            const unsigned xw0[4] = {x0.x, x0.y, x0.z, x0.w}, xw1[4] = {x1.x, x1.y, x1.z, x1.w};
#pragma unroll
            for (int j = 0; j < 8; ++j) { const float a = ((j & 1) ? bfhi(xw0[j >> 1]) : bflo(xw0[j >> 1])) * d0, bb = ((j & 1) ? bfhi(xw1[j >> 1]) : bflo(xw1[j >> 1])) * d1;
                *(LAS unsigned*)(XdT + (8 * sp + j) * 136 + 2 * tp) = pk2(a, bb); }
#pragma unroll
            for (int q = 0; q < 4; ++q) { const int i = tid + 512 * q, p = i >> 5, n4 = (i & 31) * 4; u32x2 w; w.x = pk2(sv[q][0], sv[q][1]); w.y = pk2(sv[q][2], sv[q][3]); *(LAS u32x2*)(SiT + p * 136 + n4) = w; }
        }
        float al[4];
#pragma unroll
        for (int r = 0; r < 4; ++r) al[r] = acs[(16 * wave + 4 * fq + r) * 8 + hh];
#pragma unroll
        for (int nt = 0; nt < 8; ++nt) { const int s = 16 * nt + fr; const float as = acs[s * 8 + hh];
#pragma unroll
            for (int r = 0; r < 4; ++r) { const int li = 16 * wave + 4 * fq + r; const float v = s <= li ? cb[nt][r] * __expf(al[r] - as) : 0.f; pw[(4 * fq + r) * 136 + s] = (bf16)f2bf(v); } }
        u32x2 xv[4], zv[4];
#pragma unroll
        for (int nt = 0; nt < 4; ++nt) { xv[nt] = *(const u32x2*)(SX + rowl * 1536 + h * 64 + 16 * nt + 4 * fq); zv[nt] = *(const u32x2*)(p1 + rowl * P1W + C_CZ + h * 64 + 16 * nt + 4 * fq); }
        if (hh + 1 < 8) SSD_LOADH(h + 1);
        __syncthreads();
        f32x4 y[4], ys[4];
#pragma unroll
        for (int nt = 0; nt < 4; ++nt) { y[nt] = ZERO4; ys[nt] = ZERO4; }
#pragma unroll
        for (int ks = 0; ks < 4; ++ks) { const bf16x8 pa = frag_l(pw, 136, 0, 32 * ks, lane), cc = frag_l(Cs, 136, 16 * wave, 32 * ks, lane);
#pragma unroll
            for (int nt = 0; nt < 4; ++nt) { y[nt] = mfma16(frag_l(XdT, 136, 16 * nt, 32 * ks, lane), pa, y[nt]); ys[nt] = mfma16(frag_l(SiT, 136, 16 * nt, 32 * ks, lane), cc, ys[nt]); } }
        const float dh = dsk[h], ea = __expf(acs[(16 * wave + fr) * 8 + hh]);
#pragma unroll
        for (int nt = 0; nt < 4; ++nt) {
            const float xs[4] = {bflo(xv[nt].x), bfhi(xv[nt].x), bflo(xv[nt].y), bfhi(xv[nt].y)}, zz[4] = {bflo(zv[nt].x), bfhi(zv[nt].x), bflo(zv[nt].y), bfhi(zv[nt].y)};
            float v[4];
#pragma unroll
            for (int r = 0; r < 4; ++r) { v[r] = (DBG_ZERO & 4) ? zf_ : (y[nt][r] + ea * ys[nt][r] + xs[r] * dh) * siluf_(zz[r]); ssq += v[r] * v[r]; }
            u32x2 w; w.x = pk2(v[0], v[1]); w.y = pk2(v[2], v[3]); *(u32x2*)(YC + rowl * 2048 + 1024 + h * 64 + 16 * nt + 4 * fq) = w;
        }
    }
#undef SSD_LOADH
    { float s = ssq; s += shx<16>(s); s += shx<32>(s); if (fq == 0) RC[rowl * 2 + g] = rsqrtf(s * (1.0f / 512.0f) + EPS); }
    __syncthreads();
}

constexpr int NPH = 12;
#ifndef CPU_EMU
DEV unsigned long long launder64(unsigned long long v) {
    unsigned lo = __builtin_amdgcn_readfirstlane((unsigned)v), hi = __builtin_amdgcn_readfirstlane((unsigned)(v >> 32));
    asm volatile("" : "+s"(lo), "+s"(hi));
    return ((unsigned long long)hi << 32) | lo;
}
DEV bool phase_begin(Frame& F, const Params& prm, int wave0) {
    F.ws = (unsigned char*)launder64((unsigned long long)prm.ws);
    F.p = (KParams)launder64((unsigned long long)__builtin_amdgcn_kernarg_segment_ptr());
    unsigned z = 0u; asm volatile("" : "+v"(z)); const int ln = (int)__builtin_amdgcn_mbcnt_hi(~0u, __builtin_amdgcn_mbcnt_lo(~0u, z));
    int wv = wave0; asm volatile("" : "+s"(wv)); F.wave = wv; F.lane = ln; F.tid = wv * 64 + ln;
    int bi = __builtin_amdgcn_readfirstlane(blockIdx.x); asm volatile("" : "+s"(bi)); F.bid = bi;
    int gg = __builtin_amdgcn_readfirstlane(gridDim.x); asm volatile("" : "+s"(gg)); F.G = gg;
    unsigned la = __builtin_amdgcn_readfirstlane((unsigned)(size_t)F.lds); asm volatile("" : "+s"(la)); F.lds = (LAS unsigned char*)(size_t)la;
    return true;
}
DEV void job_begin(Frame& F) { int t = F.tid; asm volatile("" : "+v"(t)); F.tid = t; F.lane = t & 63; }
__global__ void __launch_bounds__(512, 2) hybrid_fwd(Params prm) {
    extern __shared__ __attribute__((aligned(16))) unsigned char lds_raw[];
    Frame F;
    F.lds = (LAS unsigned char*)lds_raw; F.tid = threadIdx.x; F.lane = F.tid & 63; F.wave = __builtin_amdgcn_readfirstlane(F.tid >> 6);
    const int wave0 = F.wave;
    F.G = gridDim.x; F.bid = blockIdx.x; F.p = (KParams)__builtin_amdgcn_kernarg_segment_ptr(); F.ws = prm.ws;
    volatile LAS unsigned* MISC = (volatile LAS unsigned*)(F.lds + MISC_OFF);
    if (F.tid < 64) MISC[F.tid] = 0u;
    if (DBG_TMASK && F.tid < 8) MISC[64 + F.tid] = 0u;
    __syncthreads();
    unsigned* ctl = (unsigned*)(F.ws + WS_CTL);
    XcdBarrier bar; bar.bar = ctl + CW_BAR; bar.x = 0; bar.st = nullptr;
    if (prm.use_bar) bar = xcd_barrier_post(ctl + CW_BAR, MISC + 8);
    const int lo = prm.lo, hi = prm.hi;
    for (int l = 0; l < DEPTH; ++l) {
#define IN(k) (lo <= l * NPH + (k) && l * NPH + (k) < hi && phase_begin(F, prm, wave0))
#define REP_BEGIN(k) for (int rep_ = 0; rep_ < ((DBG_REP == (k)) ? 2 : 1); ++rep_) {
#define REP_END(k) if (DBG_REP == (k) && rep_ == 0) { XcdBarrier bb_ = bar; bb_.bar = (unsigned*)launder64((unsigned long long)bar.bar); xcd_barrier(bb_); } }
#define SEAM(k) do { if (l * NPH + (k) + 1 < hi && prm.use_bar) { XcdBarrier bb_ = bar; bb_.bar = (unsigned*)launder64((unsigned long long)bar.bar); { unsigned x_ = __builtin_amdgcn_readfirstlane(bar.x); asm volatile("" : "+s"(x_)); bb_.x = x_; } xcd_barrier(bb_); } } while (0)
#define TB(k) do { if (((DBG_TMASK >> (k)) & 1) && F.bid == 0 && F.tid == 0) { volatile LAS unsigned* m_ = (volatile LAS unsigned*)(F.lds + MISC_OFF); m_[64] = (unsigned)__builtin_amdgcn_s_memrealtime(); m_[68] = 1u; } } while (0)
#define TE(k) do { if (((DBG_TMASK >> (k)) & 1) && F.bid == 0 && F.tid == 0) { volatile LAS unsigned* m_ = (volatile LAS unsigned*)(F.lds + MISC_OFF); if (!DBG_TEPI) m_[66] = m_[66] + ((unsigned)__builtin_amdgcn_s_memrealtime() - m_[64]); m_[68] = 0u; } } while (0)
#define JT(ty, call) do { if (DBG_AJOB == (ty) && F.tid == 0) { volatile LAS unsigned* m_ = (volatile LAS unsigned*)(F.lds + MISC_OFF); m_[70] = (unsigned)__builtin_amdgcn_s_memrealtime(); } \
        call; if (DBG_AJOB == (ty) && F.tid == 0) { volatile LAS unsigned* m_ = (volatile LAS unsigned*)(F.lds + MISC_OFF); atomicAdd(WSP(unsigned, WS_CTL) + 460000, (unsigned)__builtin_amdgcn_s_memrealtime() - m_[70]); } } while (0)
#define RSB(i) (WSP(unsigned long long, WS_CTL) + CW_RS / 2 + (size_t)(3 * l + (i)) * MTOK)
#define XB WSP(bf16, WS_XB)
#define ACT WSP(bf16, WS_ACT)
        if (IN(0)) { TB(0); REP_BEGIN(0) phase_convert(F, l); REP_END(0) SEAM(0); TE(0); }
        if (IN(1)) { TB(1); REP_BEGIN(1) pg8::Gemm g{XB, WSP(bf16, WS_WUP1), MTOK, NUP, DM, DM, DM}; pg8::StaticOrder S; S.init(MTOK, NUP, F.G, F.bid);
            pg8::EpiSwiGLU E{ACT, RSB(0)}; pg8::gemm_phase<pg8::EpiSwiGLU, pg8::StaticOrder>(F.lds, F.tid, g, S, E); REP_END(1) SEAM(1); TE(1); }
        if (IN(2)) { TB(2); pg8::Gemm g{ACT, WSP(bf16, WS_WDN1), MTOK, DM, DFF, DFF, DFF}; pg8::StaticOrder S; S.init(MTOK, DM, F.G, F.bid);
            pg8::EpiResidual E{nullptr, XB, RSB(1), 0.5f}; pg8::gemm_phase<pg8::EpiResidual, pg8::StaticOrder>(F.lds, F.tid, g, S, E); SEAM(2); TE(2); }
        if (IN(3)) { TB(3); REP_BEGIN(3) pg8::Gemm g{XB, WSP(bf16, WS_WIN), MTOK, NINP, DM, DM, DM}; pg8::StaticOrder S; S.init(MTOK, NINP, F.G, F.bid);
            pg8::EpiWin E{WSP(bf16, WS_P1), WSP(float, WS_SMALL), WSP(bf16, WS_GATE), RSB(1)}; pg8::gemm_phase<pg8::EpiWin, pg8::StaticOrder>(F.lds, F.tid, g, S, E); REP_END(3) SEAM(3); TE(3); }
        if (IN(4)) { TB(4);
            REP_BEGIN(4)
            {
                unsigned* ctr = WSP(unsigned, WS_CTL) + CW_WQ + 64 * (8 + l * 2 + rep_);
                LAS unsigned* jslot = (LAS unsigned*)(F.lds + MISC_OFF + 128);
                for (;;) {
                    __syncthreads();
                    if (F.tid == 0) *jslot = __hip_atomic_fetch_add(ctr, 1u, __ATOMIC_RELAXED, __HIP_MEMORY_SCOPE_AGENT);
                    __syncthreads();
                    const int j = (int)*jslot;
                    if (j >= 32 + 1024 + 256 + 512) break;
                    job_begin(F);
                    if (j < 32) JT(1, nsa_compress_job(F, l, j));
                    else if (j < 32 + 256) JT(2, ssd_prep_job(F, l, j - 32));
                    else if (j < 32 + 256 + 1024) JT(3, gdn_prep_job(F, l, j - 32 - 256));
                    else JT(4, nsa_prep_job(F, l, j - 32 - 256 - 1024));
                }
            }
            REP_END(4)
            SEAM(4); TE(4);
        }
        if (IN(5)) { TB(5);
            REP_BEGIN(5)
            if (F.bid < 64) JT(6, gdn_scan_job(F, (F.bid & 7) * 8 + (F.bid >> 3)));
            {
                unsigned* ctr = WSP(unsigned, WS_CTL) + CW_WQ + 64 * (16 + (l * 2 + rep_) * 8);
                LAS unsigned* jslot = (LAS unsigned*)(F.lds + MISC_OFF + 128);
                const unsigned myq = xb_xcc_id() & 7u;
                for (;;) {
                    __syncthreads();
                    if (F.tid == 0) {
                        unsigned got = 0xffffffffu;
                        for (unsigned t = 0; t < 8u && got == 0xffffffffu; ++t) { const unsigned q = (myq + t) & 7u;
                            if (__hip_atomic_load(ctr + 64 * q, __ATOMIC_RELAXED, __HIP_MEMORY_SCOPE_AGENT) >= 64u) continue;
                            const unsigned k = __hip_atomic_fetch_add(ctr + 64 * q, 1u, __ATOMIC_RELAXED, __HIP_MEMORY_SCOPE_AGENT);
                            if (k < 64u) { const unsigned kk = k < 8u ? 63u - k : k - 8u;
                                got = (q >> 1) * 128u + (127u - (2u * kk + (q & 1u))); } }
                        *jslot = got;
                    }
                    __syncthreads();
                    const unsigned j = *jslot;
                    if (j == 0xffffffffu) break;
                    job_begin(F);
                    JT(5, nsa_job(F, (int)j));
                }
                if (rep_ == 0) {
                    unsigned* ctr2 = WSP(unsigned, WS_CTL) + CW_WQ + 64 * (80 + l);
                    for (;;) {
                        __syncthreads();
                        if (F.tid == 0) *jslot = __hip_atomic_fetch_add(ctr2, 1u, __ATOMIC_RELAXED, __HIP_MEMORY_SCOPE_AGENT);
                        __syncthreads();
                        const unsigned s = *jslot;
                        if (s >= 512u) break;
                        JT(7, ssd_scan_part(F, (int)s, 512));
                    }
                }
            }
            REP_END(5)
            SEAM(5); TE(5);
        }
        if (IN(7)) { TB(7);
            REP_BEGIN(7)
            for (int j = F.bid; j < 256; j += F.G) { job_begin(F); JT(8, ssd_out_job(F, l, j)); }
            job_begin(F);
            JT(9, gdn_final_rows(F, l, F.bid * 8 + F.wave, F.G * 8));
            REP_END(7)
            SEAM(7); TE(7);
        }
        if (IN(8)) { TB(8); REP_BEGIN(8) pg8::Gemm g{WSP(bf16, WS_YCAT), WSP(bf16, WS_WPM), MTOK, DM, 512, DM, DM}; pg8::SegOrder S; S.init(MTOK, DM, F.G, F.bid, 512);
            pg8::EpiMergeSeg E{WSP(bf16, WS_MERGED), WSP(bf16, WS_GATE), WSP(float, WS_SRC)}; pg8::gemm_phase<pg8::EpiMergeSeg, pg8::SegOrder>(F.lds, F.tid, g, S, E); REP_END(8) SEAM(8); TE(8); }
        if (IN(9)) { TB(9); pg8::Gemm g{WSP(bf16, WS_MERGED), WSP(bf16, WS_WO), MTOK, DM, DM, DM, DM}; pg8::StaticOrder S; S.init(MTOK, DM, F.G, F.bid);
            pg8::EpiResidual E{nullptr, XB, RSB(2), 1.0f}; pg8::gemm_phase<pg8::EpiResidual, pg8::StaticOrder>(F.lds, F.tid, g, S, E); SEAM(9); TE(9); }
        if (IN(10)) { TB(10); pg8::Gemm g{XB, WSP(bf16, WS_WUP2), MTOK, NUP, DM, DM, DM}; pg8::StaticOrder S; S.init(MTOK, NUP, F.G, F.bid);
            pg8::EpiSwiGLU E{ACT, RSB(2)}; pg8::gemm_phase<pg8::EpiSwiGLU, pg8::StaticOrder>(F.lds, F.tid, g, S, E); SEAM(10); TE(10); }
        if (IN(11)) { TB(11); pg8::Gemm g{ACT, WSP(bf16, WS_WDN2), MTOK, DM, DFF, DFF, DFF}; pg8::StaticOrder S; S.init(MTOK, DM, F.G, F.bid);
            pg8::EpiResidual E{l == DEPTH - 1 ? prm.out : nullptr, XB, RSB(3), 0.5f}; pg8::gemm_phase<pg8::EpiResidual, pg8::StaticOrder>(F.lds, F.tid, g, S, E); SEAM(11); TE(11); }
#undef IN
#undef SEAM
#undef TB
#undef JT
#undef TE
#undef REP_BEGIN
#undef REP_END
#undef RSB
#undef XB
#undef ACT
    }
    if (DBG_AJOB) {
        XcdBarrier bb_ = bar; bb_.bar = (unsigned*)launder64((unsigned long long)bar.bar); xcd_barrier(bb_);
        if (blockIdx.x == 0 && wave0 == 0 && __builtin_amdgcn_mbcnt_hi(~0u, __builtin_amdgcn_mbcnt_lo(~0u, 0u)) == 0u) {
            const unsigned a_ = __hip_atomic_load((unsigned*)(prm.ws + WS_CTL) + 460000, __ATOMIC_RELAXED, __HIP_MEMORY_SCOPE_AGENT); const unsigned t0_ = (unsigned)__builtin_amdgcn_s_memrealtime();
            while ((unsigned)__builtin_amdgcn_s_memrealtime() - t0_ < a_ / 32u) __builtin_amdgcn_s_sleep(32);
        }
    }
    if (DBG_TMASK && blockIdx.x == 0 && wave0 == 0 && __builtin_amdgcn_mbcnt_hi(~0u, __builtin_amdgcn_mbcnt_lo(~0u, 0u)) == 0u) {
        volatile LAS unsigned* m_ = (volatile LAS unsigned*)(F.lds + MISC_OFF); const unsigned a_ = m_[66]; const unsigned t0_ = (unsigned)__builtin_amdgcn_s_memrealtime();
        while ((unsigned)__builtin_amdgcn_s_memrealtime() - t0_ < (unsigned)DBG_TAMP * a_) __builtin_amdgcn_s_sleep(32);
    }
}

#ifndef DBG_DUMP
#define DBG_DUMP 0
#endif
#ifndef DBG_STOP
#define DBG_STOP 48
#endif
__global__ void dbg_dump_bf16(const unsigned short* src, size_t n, float* out, size_t nout) {
    for (size_t i = (size_t)blockIdx.x * blockDim.x + threadIdx.x; i < nout; i += (size_t)gridDim.x * blockDim.x) { float s = 0.f; for (size_t k = i; k < n; k += nout) s += __builtin_bit_cast(float, (unsigned)src[k] << 16); out[i] = s; }
}
__global__ void dbg_dump_f32(const float* src, size_t n, float* out, size_t nout) {
    for (size_t i = (size_t)blockIdx.x * blockDim.x + threadIdx.x; i < nout; i += (size_t)gridDim.x * blockDim.x) { float s = 0.f; for (size_t k = i; k < n; k += nout) s += src[k]; out[i] = s; }
}
#ifndef N_LAUNCH_MODE
#define N_LAUNCH_MODE 0
#endif
extern "C" void kernel_launch(void* const* d_in, const int* in_sizes, int n_in, void* d_out, int out_size, void* d_ws, size_t ws_size, hipStream_t stream) {
    static int grid = 0;
    if (grid == 0) {
        if (n_in != 30 || out_size != MTOK * DM || ws_size < WS_END) { fprintf(stderr, "kernel_launch: unexpected shapes (n_in %d out %d ws %zu, need %zu)\n", n_in, out_size, ws_size, (size_t)WS_END); grid = -1; return; }
        int dev = 0, cus = 0, per_cu = 0;
        if (hipGetDevice(&dev) != hipSuccess || hipDeviceGetAttribute(&cus, hipDeviceAttributeMultiprocessorCount, dev) != hipSuccess) { grid = -1; return; }
        if (hipFuncSetAttribute((const void*)hybrid_fwd, hipFuncAttributeMaxDynamicSharedMemorySize, LDS_BYTES) != hipSuccess) { fprintf(stderr, "kernel_launch: hipFuncSetAttribute failed\n"); grid = -1; return; }
        if (hipOccupancyMaxActiveBlocksPerMultiprocessor(&per_cu, (const void*)hybrid_fwd, 512, LDS_BYTES) != hipSuccess || per_cu < 1) { fprintf(stderr, "kernel_launch: occupancy query says %d\n", per_cu); }
        (void)hipGetLastError();
        grid = cus;
    }
    if (grid < 0) return;
    (void)hipMemsetAsync((char*)d_ws + WS_CTL, 0, CTL_BYTES, stream);
    Params p{};
    for (int i = 0; i < 30; ++i) p.in[i] = (const float*)d_in[i];
    p.out = (float*)d_out; p.ws = (unsigned char*)d_ws; p.pad = 0;
    if (N_LAUNCH_MODE == 0) { p.lo = 0; p.hi = DEPTH * NPH; p.use_bar = 1; hipLaunchKernelGGL(hybrid_fwd, dim3(grid), dim3(512), LDS_BYTES, stream, p); }
    else { for (int ph = 0; ph < (DBG_DUMP ? DBG_STOP : DEPTH * NPH); ++ph) { p.lo = ph; p.hi = ph + 1; p.use_bar = 0; hipLaunchKernelGGL(hybrid_fwd, dim3(grid), dim3(512), LDS_BYTES, stream, p); } }
    if (DBG_DUMP) {
        const size_t nout = (size_t)MTOK * DM; char* w = (char*)d_ws;
        if (DBG_DUMP == 1) hipLaunchKernelGGL(dbg_dump_bf16, dim3(2048), dim3(256), 0, stream, (const unsigned short*)(w + WS_P1), (size_t)MTOK * P1W, (float*)d_out, nout);
        if (DBG_DUMP == 2) hipLaunchKernelGGL(dbg_dump_f32, dim3(2048), dim3(256), 0, stream, (const float*)(w + WS_SMALL), (size_t)MTOK * SMW, (float*)d_out, nout);
        if (DBG_DUMP == 3) hipLaunchKernelGGL(dbg_dump_bf16, dim3(2048), dim3(256), 0, stream, (const unsigned short*)(w + WS_GW), (size_t)1024 * GDN_CH_BYTES / 2, (float*)d_out, nout);
        if (DBG_DUMP == 4) hipLaunchKernelGGL(dbg_dump_f32, dim3(2048), dim3(256), 0, stream, (const float*)(w + WS_SST), (size_t)2 * 64 * 16 * 64 * 128, (float*)d_out, nout);
        if (DBG_DUMP == 5) hipLaunchKernelGGL(dbg_dump_f32, dim3(2048), dim3(256), 0, stream, (const float*)(w + WS_GO), (size_t)MTOK * 512, (float*)d_out, nout);
        if (DBG_DUMP == 6) hipLaunchKernelGGL(dbg_dump_bf16, dim3(2048), dim3(256), 0, stream, (const unsigned short*)(w + WS_YCAT), (size_t)MTOK * 2048, (float*)d_out, nout);
        if (DBG_DUMP == 7) hipLaunchKernelGGL(dbg_dump_bf16, dim3(2048), dim3(256), 0, stream, (const unsigned short*)(w + WS_MERGED), (size_t)MTOK * 2048, (float*)d_out, nout);
        if (DBG_DUMP == 8) hipLaunchKernelGGL(dbg_dump_bf16, dim3(2048), dim3(256), 0, stream, (const unsigned short*)(w + WS_SX), (size_t)MTOK * 1536, (float*)d_out, nout);
        if (DBG_DUMP == 9) hipLaunchKernelGGL(dbg_dump_bf16, dim3(2048), dim3(256), 0, stream, (const unsigned short*)(w + WS_GATE), (size_t)MTOK * 6144, (float*)d_out, nout);
        if (DBG_DUMP == 11) hipLaunchKernelGGL(dbg_dump_f32, dim3(2048), dim3(256), 0, stream, (const float*)(w + WS_SRC), (size_t)MTOK * 2, (float*)d_out, nout);
        if (DBG_DUMP == 12) hipLaunchKernelGGL(dbg_dump_bf16, dim3(2048), dim3(256), 0, stream, (const unsigned short*)(w + WS_WPM), (size_t)DM * DM, (float*)d_out, nout);
        if (DBG_DUMP == 13) hipLaunchKernelGGL(dbg_dump_f32, dim3(2048), dim3(256), 0, stream, (const float*)(w + WS_MTMP), (size_t)MTOK * DM, (float*)d_out, nout);
        if (DBG_DUMP == 15) hipLaunchKernelGGL(dbg_dump_bf16, dim3(2048), dim3(256), 0, stream, (const unsigned short*)(w + WS_ACT), (size_t)MTOK * DFF, (float*)d_out, nout);
        if (DBG_DUMP == 16) hipLaunchKernelGGL(dbg_dump_bf16, dim3(2048), dim3(256), 0, stream, (const unsigned short*)(w + WS_XB), (size_t)MTOK * DM, (float*)d_out, nout);
        if (DBG_DUMP == 17) hipLaunchKernelGGL(dbg_dump_bf16, dim3(2048), dim3(256), 0, stream, (const unsigned short*)(w + WS_WIN), (size_t)NINP * DM, (float*)d_out, nout);
        if (DBG_DUMP == 18) hipLaunchKernelGGL(dbg_dump_f32, dim3(2048), dim3(256), 0, stream, (const float*)(w + WS_CTL) + CW_RS, (size_t)NRS * MTOK, (float*)d_out, nout);
        if (DBG_DUMP == 10) hipLaunchKernelGGL(dbg_dump_f32, dim3(2048), dim3(256), 0, stream, (const float*)(w + WS_YB), (size_t)MTOK * 512, (float*)d_out, nout);
    }
}
#endif
```

```cpp
#include <hip/hip_runtime.h>
#include <cstdio>
#include <cstdint>

#ifndef CPU_EMU
#define DEV __device__ __forceinline__
#define LAS __attribute__((address_space(3)))
#define VM_WAIT() asm volatile("s_waitcnt vmcnt(0)" ::: "memory")
#define LDS_WAIT() asm volatile("s_waitcnt lgkmcnt(0)" ::: "memory")
#define CFENCE() asm volatile("" ::: "memory")
#define WAVE_SYNC() do { asm volatile("" ::: "memory"); __builtin_amdgcn_wave_barrier(); asm volatile("" ::: "memory"); } while (0)
#endif

#define DBG_DUMP 0
#define DBG_NSAZ 0
#define DBG_NSA 0
#define DBG_REP (-1)
#define DBG_STOP 48
#define DBG_TMASK 0
#define DBG_TAMP 8
#define DBG_AJOB 0
#define DBG_TEPI 0
#ifndef DBG_ZERO
#define DBG_ZERO 0
#endif
typedef unsigned short bf16;
typedef short bf16x8 __attribute__((ext_vector_type(8)));
typedef float f32x4 __attribute__((ext_vector_type(4)));
typedef float f32x2 __attribute__((ext_vector_type(2)));
typedef unsigned u32x4 __attribute__((ext_vector_type(4)));
typedef unsigned u32x2 __attribute__((ext_vector_type(2)));

constexpr int BATCH = 2, SEQ = 8192, DM = 2048, DEPTH = 4, DFF = 5504, NUP = 2 * DFF;
constexpr int MTOK = BATCH * SEQ;
constexpr int NIN = 12836, NINP = 13056;
constexpr int P1W = 6656;
constexpr int SM0 = 6656;
constexpr int GT0 = 6912;
constexpr float EPS = 1e-6f;
constexpr int C_AQ = 0, C_AK = 512, C_AV = 1024, C_AZ = 1536, C_BQ = 2048, C_BKC = 2560, C_BVC = 2816, C_BKS = 3072, C_BVS = 3328, C_BKW = 3584, C_BVW = 3840, C_CZ = 4096, C_CX = 5120;
constexpr int S_AA = 0, S_AB = 4, S_BG = 8, S_DT = 20, SMW = 64;

constexpr size_t MiB = 1u << 20;
constexpr size_t WS_CTL = 0, CTL_BYTES = 2 * MiB;
constexpr size_t WS_WUP1 = 2 * MiB;
constexpr size_t WS_WDN1 = WS_WUP1 + (size_t)NUP * DM * 2;
constexpr size_t WS_WIN = WS_WDN1 + (size_t)DM * DFF * 2;
constexpr size_t WS_WPM = WS_WIN + (size_t)NINP * DM * 2;
constexpr size_t WS_WO = WS_WPM + (size_t)DM * DM * 2;
constexpr size_t WS_WUP2 = WS_WO + (size_t)DM * DM * 2;
constexpr size_t WS_WDN2 = WS_WUP2 + (size_t)NUP * DM * 2;
constexpr size_t WS_WCK = WS_WDN2 + (size_t)DM * DFF * 2;
constexpr size_t WS_WCV = WS_WCK + 128 * 4096 * 2;
constexpr size_t WS_CONST = WS_WCV + 128 * 4096 * 2;
constexpr size_t WS_WEND = WS_CONST + 4096;
static_assert(WS_WEND <= 212 * MiB, "weights region");
constexpr size_t WS_XB = 212 * MiB;
constexpr size_t WS_P1 = 276 * MiB;
constexpr size_t WS_ACT = WS_P1;
constexpr size_t WS_GATE = 484 * MiB;
constexpr size_t WS_SMALL = 676 * MiB;
constexpr size_t WS_MERGED = 680 * MiB;
constexpr size_t WS_YCAT = 744 * MiB;
constexpr size_t WS_GW = 808 * MiB;
constexpr size_t GDN_CH_BYTES = 73728;
constexpr size_t WS_GL = 880 * MiB;
constexpr size_t WS_GO = 881 * MiB;
constexpr size_t WS_SX = 913 * MiB;
constexpr size_t WS_SDT = 961 * MiB;
constexpr size_t WS_SAC = 962 * MiB;
constexpr size_t WS_SST = 963 * MiB;
constexpr size_t WS_SCD = 1027 * MiB;
constexpr size_t WS_SRC = 1028 * MiB;
constexpr size_t WS_QN = 1029 * MiB;
constexpr size_t WS_KS = 1045 * MiB;
constexpr size_t WS_KW = 1053 * MiB;
constexpr size_t WS_VST = 1061 * MiB;
constexpr size_t WS_VWT = 1069 * MiB;
constexpr size_t WS_KCMP = 1077 * MiB;
constexpr size_t WS_VCMPT = 1078 * MiB;
constexpr size_t WS_SELM = 1079 * MiB;
constexpr size_t WS_YB = 1080 * MiB;
constexpr size_t WS_MTMP = 1112 * MiB;
constexpr size_t WS_END = 1240 * MiB;
static_assert(WS_P1 + (size_t)MTOK * P1W * 2 <= WS_GATE && WS_GATE + (size_t)MTOK * 6144 * 2 <= WS_SMALL && WS_SMALL + (size_t)MTOK * SMW * 4 <= WS_MERGED && WS_MERGED + (size_t)MTOK * DM * 2 <= WS_YCAT && WS_YCAT + (size_t)MTOK * 2048 * 2 <= WS_GW, "ws map 1");
static_assert(WS_GW + 1024 * GDN_CH_BYTES <= WS_GL && WS_GO + (size_t)MTOK * 512 * 4 <= WS_SX && WS_SX + (size_t)MTOK * 1536 * 2 <= WS_SDT && WS_SDT + (size_t)MTOK * 16 * 4 <= WS_SAC && WS_SAC + (size_t)MTOK * 16 * 4 <= WS_SST && WS_SST + (size_t)2 * 64 * 16 * 64 * 128 * 4 <= WS_SCD, "ws map 2");
static_assert(WS_SRC + (size_t)MTOK * 2 * 4 <= WS_QN && WS_QN + (size_t)4 * SEQ * 256 * 2 <= WS_KS && WS_KS + (size_t)4 * SEQ * 128 * 2 <= WS_KW && WS_KW + (size_t)4 * SEQ * 128 * 2 <= WS_VST && WS_VST + (size_t)4 * SEQ * 128 * 2 <= WS_VWT && WS_VWT + (size_t)4 * SEQ * 128 * 2 <= WS_KCMP, "ws map 3");
static_assert(WS_KCMP + 4 * 512 * 128 * 2 <= WS_VCMPT && WS_VCMPT + 4 * 512 * 128 * 2 <= WS_SELM && WS_SELM + (size_t)4 * SEQ * 16 <= WS_YB && WS_YB + (size_t)MTOK * 512 * 4 <= WS_END && WS_XB + (size_t)MTOK * DM * 2 <= WS_P1 && (size_t)MTOK * DFF * 2 <= (size_t)MTOK * P1W * 2, "ws map 4");

constexpr int CW_BAR = 1024;
constexpr int CW_RS = 16384;
constexpr int NRS = 13;
constexpr int CW_WQ = 8192;
static_assert(CW_RS * 4 + NRS * MTOK * 8 <= (int)CTL_BYTES, "ctl");

constexpr int RING_BYTES = 131072;
constexpr int MISC_OFF = RING_BYTES + 12288;
constexpr int LDS_BYTES = 147456;

DEV unsigned f2bf(float f) { unsigned u = __builtin_bit_cast(unsigned, f); return (u + 0x7fffu + ((u >> 16) & 1u)) >> 16; }
DEV float bf2f(unsigned b) { return __builtin_bit_cast(float, (b & 0xffffu) << 16); }
DEV unsigned pk2(float lo, float hi) { return f2bf(lo) | (f2bf(hi) << 16); }
DEV float bflo(unsigned w) { return __builtin_bit_cast(float, w << 16); }
DEV float bfhi(unsigned w) { return __builtin_bit_cast(float, w & 0xffff0000u); }
DEV float sigmoidf_(float x) { return 1.0f / (1.0f + __expf(-x)); }
DEV float siluf_(float x) { return x / (1.0f + __expf(-x)); }
DEV float softplusf_(float x) {
    const float e = __expf(-fabsf(x)), u = 1.0f + e, d = u - 1.0f;
    const float lp = d == 0.f ? e : __logf(u) * (e / d);
    return fmaxf(x, 0.f) + lp;
}
#ifndef CPU_EMU
template <int M, class T> DEV T shx(T v) {
    static_assert(sizeof(T) == 4, "shx: 32-bit values");
    const int iv = __builtin_bit_cast(int, v);
    if constexpr (M < 32) return __builtin_bit_cast(T, __builtin_amdgcn_ds_swizzle(iv, 0x1f | (M << 10)));
    else { unsigned z = 0u; asm volatile("" : "+v"(z)); const unsigned ln = __builtin_amdgcn_mbcnt_hi(~0u, __builtin_amdgcn_mbcnt_lo(~0u, z));
        return __builtin_bit_cast(T, __builtin_amdgcn_ds_bpermute((int)((ln ^ 32u) << 2), iv)); }
}
#endif
DEV float wave_sum(float v) { v += shx<1>(v); v += shx<2>(v); v += shx<4>(v); v += shx<8>(v); v += shx<16>(v); v += shx<32>(v); return v; }
DEV void wave_sum4(float (&v)[4]) {
#pragma unroll
    for (int q = 0; q < 4; ++q) v[q] += shx<1>(v[q]);
#pragma unroll
    for (int q = 0; q < 4; ++q) v[q] += shx<2>(v[q]);
#pragma unroll
    for (int q = 0; q < 4; ++q) v[q] += shx<4>(v[q]);
#pragma unroll
    for (int q = 0; q < 4; ++q) v[q] += shx<8>(v[q]);
#pragma unroll
    for (int q = 0; q < 4; ++q) v[q] += shx<16>(v[q]);
#pragma unroll
    for (int q = 0; q < 4; ++q) v[q] += shx<32>(v[q]);
}
DEV float sum16(float v) { v += shx<1>(v); v += shx<2>(v); v += shx<4>(v); v += shx<8>(v); return v; }
DEV float max16(float v) { v = fmaxf(v, shx<1>(v)); v = fmaxf(v, shx<2>(v)); v = fmaxf(v, shx<4>(v)); v = fmaxf(v, shx<8>(v)); return v; }
#ifndef CPU_EMU
DEV float opaque_zero() { float z = 0.f; asm volatile("" : "+v"(z)); return z; }
#endif
#define ZERO4 ((f32x4){zf_, zf_, zf_, zf_})
DEV f32x4 mfma16(bf16x8 a, bf16x8 b, f32x4 c) { return __builtin_amdgcn_mfma_f32_16x16x32_bf16(a, b, c, 0, 0, 0); }
DEV bf16x8 frag_g(const bf16* base, int pitch, int row0, int k0, int lane) { return *(const bf16x8*)(base + (size_t)(row0 + (lane & 15)) * pitch + k0 + 8 * (lane >> 4)); }
DEV bf16x8 frag_l(const LAS bf16* base, int pitch, int row0, int k0, int lane) { return *(const LAS bf16x8*)(base + (row0 + (lane & 15)) * pitch + k0 + 8 * (lane >> 4)); }
#ifndef CPU_EMU
DEV const LAS void* lds_vbase(const LAS void* p) { unsigned a = (unsigned)(size_t)p; asm volatile("" : "+v"(a)); return (const LAS void*)(size_t)a; }
#endif

struct Params {
    const float* in[30];
    float* out;
    unsigned char* ws;
    int lo, hi;
    int use_bar, pad;
};
enum { I_X = 0, I_REL, I_GF1, I_WUP1, I_WDN1, I_GMIX, I_WIN, I_GCONV, I_GALOG, I_GDTB, I_GNORM, I_NQN, I_NKN, I_NPEK, I_NPEV, I_NWCK, I_NWCV,
       I_SCW, I_SCB, I_SDTB, I_SALOG, I_SD, I_SNORM, I_PA, I_PB, I_PC, I_WO, I_GF2, I_WUP2, I_WDN2 };

#define XB_TMO      128
#define XB_XCNT(j)  (256  + 64 * (j))
#define XB_XSUB(j)  (1280 + 64 * (j))
#define XB_XGEN(j)  (2304 + 64 * (j))
#define XB_TOP      3328
#define XB_TOPGEN   3392
#define XCD_BAR_WORDS 3456
#define XB_SPIN_CAP (1u << 22)
#ifndef CPU_EMU
DEV unsigned xb_ld(unsigned* p)              { return __hip_atomic_load(p, __ATOMIC_RELAXED, __HIP_MEMORY_SCOPE_AGENT); }
DEV unsigned xb_add(unsigned* p, unsigned v) { return __hip_atomic_fetch_add(p, v, __ATOMIC_RELAXED, __HIP_MEMORY_SCOPE_AGENT); }
DEV unsigned xb_xcc_id() { return (unsigned)__builtin_amdgcn_s_getreg((3 << 11) | 20) & 0xFu; }
#define XB_SPIN(cond, bar) do { unsigned _sp = 0; while (cond) { __builtin_amdgcn_s_sleep(1); \
    if ((++_sp & 255u) == 0u) { if (xb_ld(&(bar)[XB_TMO])) break; if (_sp > XB_SPIN_CAP) { atomicAdd(&(bar)[XB_TMO], 1u); break; } } } } while (0)
struct XcdBarrier { unsigned* bar; unsigned x; volatile LAS unsigned* st; };
DEV XcdBarrier xcd_barrier_post(unsigned* bar, volatile LAS unsigned* st) {
    XcdBarrier b; b.bar = bar; b.x = xb_xcc_id(); b.st = st;
    if (threadIdx.x == 0) (void)xb_add(&bar[XB_XCNT(b.x)], 1u);
    return b;
}
DEV void xcd_barrier_complete(unsigned* bar, unsigned x, unsigned& nloc, unsigned& nx) {
    const unsigned G = gridDim.x * gridDim.y * gridDim.z;
    unsigned sum, cnt, mine, sp = 0u;
    for (;;) {
        sum = 0u; cnt = 0u; mine = 0u;
#pragma unroll
        for (unsigned j = 0; j < 16; ++j) { const unsigned c = xb_ld(&bar[XB_XCNT(j)]); sum += c; cnt += (c > 0u) ? 1u : 0u; mine = (j == x) ? c : mine; }
        if (sum == G) break;
        __builtin_amdgcn_s_sleep(1);
        if ((++sp & 255u) == 0u) { if (xb_ld(&bar[XB_TMO])) break; if (sp > XB_SPIN_CAP) { atomicAdd(&bar[XB_TMO], 1u); break; } }
    }
    nloc = mine > 0u ? mine : 1u; nx = cnt > 0u ? cnt : 1u;
}
DEV void xcd_barrier(const XcdBarrier& b) {
    asm volatile("s_waitcnt vmcnt(0)" ::: "memory");
    __syncthreads();
    if (threadIdx.x == 0) {
        unsigned* bar = b.bar;
        __builtin_amdgcn_s_waitcnt(0);
        unsigned nloc = b.st[0], nx = b.st[1];
        if (nloc == 0u) { xcd_barrier_complete(bar, b.x, nloc, nx); b.st[0] = nloc; b.st[1] = nx; }
        const unsigned old = xb_add(&bar[XB_XSUB(b.x)], 1u);
        const unsigned gen = old / nloc;
        if (old + 1u == (gen + 1u) * nloc) {
            __builtin_amdgcn_fence(__ATOMIC_RELEASE, "agent");
            asm volatile("s_waitcnt vmcnt(0)" ::: "memory");
            const unsigned og = xb_add(&bar[XB_TOP], 1u);
            const unsigned tg = og / nx;
            if (og + 1u == (tg + 1u) * nx) xb_add(&bar[XB_TOPGEN], 1u);
            else XB_SPIN(xb_ld(&bar[XB_TOPGEN]) == tg, bar);
            __builtin_amdgcn_fence(__ATOMIC_ACQUIRE, "agent");
            xb_add(&bar[XB_XGEN(b.x)], 1u);
            asm volatile("s_waitcnt vmcnt(0)" ::: "memory");
        } else {
            XB_SPIN(xb_ld(&bar[XB_XGEN(b.x)]) == gen, bar);
            __builtin_amdgcn_fence(__ATOMIC_ACQUIRE, "agent");
            asm volatile("s_waitcnt vmcnt(0)" ::: "memory");
        }
    }
    __syncthreads();
}
#endif

namespace pg8 {
constexpr int BM = 256, BK = 64, HALF = 128, HTB = HALF * BK * 2, STAGE_BYTES = 8 * HTB, NXCD = 8, WGM = 8;
__host__ __device__ __forceinline__ int lds_byte(int r, int c) { const int st = (r >> 4) * 2 + (c >> 5), rr = r & 15, cc = c & 31, ob = rr * 64 + cc * 2; return st * 1024 + (ob ^ (((ob >> 9) & 1) << 5)); }
__host__ __device__ __forceinline__ void stage_rc(int b, int& R, int& C) { const int st = b / 1024, sb = b % 1024, swz = sb ^ (((sb >> 9) & 1) << 5); R = (st >> 1) * 16 + swz / 64; C = (st & 1) * 32 + (swz % 64) / 2; }
__host__ __device__ __forceinline__ int perm32(int rho) { const int n = rho >> 4, i = rho & 15; return 8 * (i >> 2) + 4 * n + (i & 3); }
struct Unit { int pm, pn, koff, seg; };
struct Gemm { const bf16* A; const bf16* Bt; int M, N, K, lda, ldb; };
struct StaticOrder {
    int nM, nN, nwg, G, c, wgm;
    __host__ __device__ void init(int M, int N, int G_, int c_, int wgm_ = WGM) { nM = M / BM; nN = N / BM; nwg = nM * nN; G = G_; c = c_; wgm = wgm_; }
    __host__ __device__ bool next(int i, Unit& u) const {
        const long L = (long)i * G + c; if (L >= nwg) return false;
        int wgid = (int)L; { const int q = nwg / NXCD, r = nwg % NXCD, xcd = wgid % NXCD, off = wgid / NXCD; wgid = (xcd < r ? xcd * (q + 1) : r * (q + 1) + (xcd - r) * q) + off; }
        const int nig = wgm * nN, gid = wgid / nig, fm = gid * wgm, gsz = (nM - fm) < wgm ? (nM - fm) : wgm;
        u.pm = fm + ((wgid % nig) % gsz); u.pn = (wgid % nig) / gsz; u.koff = 0; u.seg = 0; return true;
    }
};
struct SegOrder {
    StaticOrder S; int kseg;
    __host__ __device__ void init(int M, int N, int G_, int c_, int kseg_) { S.init(M, N, G_, c_); kseg = kseg_; }
    __host__ __device__ bool next(int i, Unit& u) const { if (!S.next(i >> 2, u)) return false; u.seg = i & 3; u.koff = u.seg * kseg; return true; }
};
#ifndef CPU_EMU
DEV unsigned cvt_pk_bf16(float lo, float hi) { unsigned r; asm volatile("s_nop 1\n\tv_cvt_pk_bf16_f32 %0, %1, %2" : "=v"(r) : "v"(lo), "v"(hi)); return r; }
#endif
DEV unsigned long long rss_fix(float ss) { return (unsigned long long)(ss * 16777216.0f + 0.5f); }
DEV float rss_val(unsigned long long v) { return (float)v * (1.0f / 16777216.0f); }

struct EpiSwiGLU {
    static constexpr bool PERM = true, SEGACC = false;
    bf16* act; const unsigned long long* rss;
    DEV void operator()(const f32x4 (&acc)[2][2][4][2], const Unit& u, int wr, int wc, int fr, int fq) const {
        const int row0 = u.pm * BM + wr * 64 + fr, col0 = u.pn * HALF + wc * 32 + 8 * fq;
        unsigned long long rv[8];
#pragma unroll
        for (int i = 0; i < 8; ++i) rv[i] = rss[row0 + (i >> 2) * HALF + (i & 3) * 16];
        CFENCE();
#pragma unroll
        for (int ai = 0; ai < 2; ++ai)
#pragma unroll
            for (int m = 0; m < 4; ++m) {
                const int row = row0 + ai * HALF + m * 16;
                const float rs = rsqrtf(rss_val(rv[ai * 4 + m]) * (1.0f / DM) + EPS);
                float o[8];
#pragma unroll
                for (int n = 0; n < 2; ++n)
#pragma unroll
                    for (int j = 0; j < 4; ++j) { const float a = acc[ai][0][m][n][j] * rs, b = acc[ai][1][m][n][j] * rs; o[4 * n + j] = a * b * __builtin_amdgcn_rcpf(1.0f + __expf(-a)); }
                u32x4 w; w.x = cvt_pk_bf16(o[0], o[1]); w.y = cvt_pk_bf16(o[2], o[3]); w.z = cvt_pk_bf16(o[4], o[5]); w.w = cvt_pk_bf16(o[6], o[7]);
                *(u32x4*)(act + (size_t)row * DFF + col0) = w;
            }
    }
};
struct EpiResidual {
    static constexpr bool PERM = true, SEGACC = false;
    float* out; bf16* xb; unsigned long long* rss_out; float alpha;
    DEV void operator()(const f32x4 (&acc)[2][2][4][2], const Unit& u, int wr, int wc, int fr, int fq) const {
        const int row0 = u.pm * BM + wr * 64 + fr, col0 = u.pn * BM + wc * 32 + 8 * fq;
#pragma unroll
        for (int ai = 0; ai < 2; ++ai) {
            u32x4 xv[4][2];
#pragma unroll
            for (int m = 0; m < 4; ++m)
#pragma unroll
                for (int bj = 0; bj < 2; ++bj) xv[m][bj] = *(const u32x4*)(xb + (size_t)(row0 + ai * HALF + m * 16) * DM + col0 + bj * HALF);
            CFENCE();
#pragma unroll
            for (int m = 0; m < 4; ++m) {
                const int row = row0 + ai * HALF + m * 16; float ss = 0.f;
#pragma unroll
                for (int bj = 0; bj < 2; ++bj) {
                    const u32x4 xw = xv[m][bj];
                    const f32x4 x0 = (f32x4){bflo(xw.x), bfhi(xw.x), bflo(xw.y), bfhi(xw.y)} + acc[ai][bj][m][0] * alpha, x1 = (f32x4){bflo(xw.z), bfhi(xw.z), bflo(xw.w), bfhi(xw.w)} + acc[ai][bj][m][1] * alpha;
                    if (out) { float* xp = out + (size_t)row * DM + col0 + bj * HALF; *(f32x4*)xp = x0; *(f32x4*)(xp + 4) = x1; }
                    ss += (x0[0] * x0[0] + x0[1] * x0[1]) + (x0[2] * x0[2] + x0[3] * x0[3]) + (x1[0] * x1[0] + x1[1] * x1[1]) + (x1[2] * x1[2] + x1[3] * x1[3]);
                    u32x4 w; w.x = cvt_pk_bf16(x0[0], x0[1]); w.y = cvt_pk_bf16(x0[2], x0[3]); w.z = cvt_pk_bf16(x1[0], x1[1]); w.w = cvt_pk_bf16(x1[2], x1[3]);
                    *(u32x4*)(xb + (size_t)row * DM + col0 + bj * HALF) = w;
                }
                ss += shx<16>(ss); ss += shx<32>(ss);
                if (fq == 0) atomicAdd(rss_out + row, rss_fix(ss));
            }
            CFENCE();
        }
    }
};
struct EpiWin {
    static constexpr bool PERM = true, SEGACC = false;
    bf16* p1; float* small; bf16* gate; const unsigned long long* rss;
    DEV void operator()(const f32x4 (&acc)[2][2][4][2], const Unit& u, int wr, int wc, int fr, int fq) const {
        const int row0 = u.pm * BM + wr * 64 + fr, cl0 = wc * 32 + 8 * fq;
        unsigned long long rv[8];
#pragma unroll
        for (int i = 0; i < 8; ++i) rv[i] = rss[row0 + (i >> 2) * HALF + (i & 3) * 16];
        CFENCE();
#pragma unroll
        for (int ai = 0; ai < 2; ++ai)
#pragma unroll
            for (int m = 0; m < 4; ++m) {
                const int row = row0 + ai * HALF + m * 16;
                const float rs = rsqrtf(rss_val(rv[ai * 4 + m]) * (1.0f / DM) + EPS);
#pragma unroll
                for (int bj = 0; bj < 2; ++bj) {
                    f32x4 v0 = acc[ai][bj][m][0] * rs, v1 = acc[ai][bj][m][1] * rs;
                    const int cl = cl0 + bj * HALF;
                    if (u.pn < 26) {
                        u32x4 w; w.x = cvt_pk_bf16(v0[0], v0[1]); w.y = cvt_pk_bf16(v0[2], v0[3]); w.z = cvt_pk_bf16(v1[0], v1[1]); w.w = cvt_pk_bf16(v1[2], v1[3]);
                        *(u32x4*)(p1 + (size_t)row * P1W + u.pn * BM + cl) = w;
                    } else if (u.pn == 26) {
                        if (cl < SMW) { float* sp = small + (size_t)row * SMW + cl; *(f32x4*)sp = v0; *(f32x4*)(sp + 4) = v1; }
                    } else {
#pragma unroll
                        for (int j = 0; j < 4; ++j) { v0[j] = fminf(__builtin_amdgcn_rcpf(1.0f + __expf(-v0[j])), 1.0f); v1[j] = fminf(__builtin_amdgcn_rcpf(1.0f + __expf(-v1[j])), 1.0f); }
                        u32x4 w; w.x = cvt_pk_bf16(v0[0], v0[1]); w.y = cvt_pk_bf16(v0[2], v0[3]); w.z = cvt_pk_bf16(v1[0], v1[1]); w.w = cvt_pk_bf16(v1[2], v1[3]);
                        *(u32x4*)(gate + (size_t)row * 6144 + (u.pn - 27) * BM + cl) = w;
                    }
                }
            }
    }
};
struct EpiMergeSeg {
    static constexpr bool PERM = true, SEGACC = true;
    bf16* merged; const bf16* gate; const float* rc;
    DEV void seg(f32x4 (&acc)[2][2][4][2], const Unit& u, int wr, int wc, int fr, int fq) const {
        const int row0 = u.pm * BM + wr * 64 + fr, col0 = u.pn * BM + wc * 32 + 8 * fq, sg = u.seg;
        f32x2 rcv[8];
#pragma unroll
        for (int i = 0; i < 8; ++i) rcv[i] = *(const f32x2*)(rc + (size_t)(row0 + (i >> 2) * HALF + (i & 3) * 16) * 2);
        const int offa = sg == 0 ? 0 : (sg == 1 ? DM : 2 * DM), offb = sg == 0 ? DM : 2 * DM;
#pragma unroll
        for (int aim = 0; aim < 4; ++aim) {
            const int ai = aim >> 1, m0 = (aim & 1) * 2;
            u32x4 wa[2][2], wb[2][2];
            if (sg != 2) {
#pragma unroll
                for (int mm = 0; mm < 2; ++mm)
#pragma unroll
                    for (int bj = 0; bj < 2; ++bj) { const bf16* gp = gate + (size_t)(row0 + ai * HALF + (m0 + mm) * 16) * 6144 + col0 + bj * HALF; wa[mm][bj] = *(const u32x4*)(gp + offa); wb[mm][bj] = *(const u32x4*)(gp + offb); }
            }
            CFENCE();
#pragma unroll
            for (int mm = 0; mm < 2; ++mm) {
                const int m = m0 + mm, row = row0 + ai * HALF + m * 16;
                const float r0 = rcv[ai * 4 + m][0], r1 = rcv[ai * 4 + m][1];
#pragma unroll
                for (int bj = 0; bj < 2; ++bj) {
                    float f[8];
                    if (sg == 2) { const float q = fmaxf(r0, 1e-20f) / fmaxf(r1, 1e-20f);
#pragma unroll
                        for (int j = 0; j < 8; ++j) f[j] = q; }
                    else {
                        const u32x4 a4 = wa[mm][bj], b4 = wb[mm][bj];
                        const float na[8] = {bflo(a4.x), bfhi(a4.x), bflo(a4.y), bfhi(a4.y), bflo(a4.z), bfhi(a4.z), bflo(a4.w), bfhi(a4.w)};
                        const float nb[8] = {bflo(b4.x), bfhi(b4.x), bflo(b4.y), bfhi(b4.y), bflo(b4.z), bfhi(b4.z), bflo(b4.w), bfhi(b4.w)};
#pragma unroll
                        for (int j = 0; j < 8; ++j) {
                            if (sg == 0) f[j] = fmaxf(na[j], 1e-20f) * __builtin_amdgcn_rcpf(fmaxf(nb[j], 1e-20f));
                            else if (sg == 1) f[j] = fmaxf(na[j], 1e-20f) * __builtin_amdgcn_rcpf(fmaxf(nb[j] * r0, 1e-20f));
                            else f[j] = fmaxf(na[j] * r1, 1e-20f); }
                    }
                    f32x4 v0 = acc[ai][bj][m][0], v1 = acc[ai][bj][m][1];
#pragma unroll
                    for (int j = 0; j < 4; ++j) { v0[j] *= f[j]; v1[j] *= f[4 + j]; }
                    if (sg < 3) { acc[ai][bj][m][0] = v0; acc[ai][bj][m][1] = v1; }
                    else { u32x4 o; o.x = cvt_pk_bf16(v0[0], v0[1]); o.y = cvt_pk_bf16(v0[2], v0[3]); o.z = cvt_pk_bf16(v1[0], v1[1]); o.w = cvt_pk_bf16(v1[2], v1[3]);
                        *(u32x4*)(merged + (size_t)row * DM + col0 + bj * HALF) = o; }
                }
            }
            CFENCE();
        }
    }
};

#ifndef CPU_EMU
template <class Epi, class Sched>
DEV void gemm_phase(LAS unsigned char* lds, const int tid, const Gemm g, const Sched& S, const Epi& E) {
    const int wid = __builtin_amdgcn_readfirstlane(tid >> 6), lane = tid & 63, wr = wid >> 2, wc = wid & 3, fr = lane & 15, fq = lane >> 4;
    const int K = g.K, nt = K / BK;
    const float zf_ = opaque_zero();
    unsigned voffA[2], voffB[2];
#pragma unroll
    for (int i = 0; i < 2; ++i) { int R, C; stage_rc(tid * 16 + i * 8192, R, C); const int Rb = Epi::PERM ? ((R & ~31) + perm32(R & 31)) : R;
        voffA[i] = (unsigned)(R * g.lda + C) * 2u; voffB[i] = (unsigned)(Rb * g.ldb + C) * 2u; }
    const size_t kstep = (size_t)(BK * 2);
    const size_t hA = (size_t)HALF * g.lda * 2, hB = (size_t)HALF * g.ldb * 2;
    const size_t tA = 2 * hA, tB = 2 * hB;
    const unsigned ldsw = (unsigned)wid * 1024u;
    const int aoff = lds_byte(wr * 64 + fr, fq * 8), boff = lds_byte(wc * 32 + fr, fq * 8);
#define PG8_SA(b, h) (((b) * 2 + (h)) * HTB)
#define PG8_SB(b, h) ((4 + (b) * 2 + (h)) * HTB)
#define PG8_STAGE(bufoff, gbase, voff) do { _Pragma("unroll") for (int _i = 0; _i < 2; ++_i) \
        __builtin_amdgcn_global_load_lds((const unsigned*)((const char*)(gbase) + (voff)[_i]), (LAS unsigned*)(lds + (bufoff) + ldsw + _i * 8192), 16, 0, 0); } while (0)
#define PG8_LDA(dst, b, h) do { _Pragma("unroll") for (int m = 0; m < 4; ++m) _Pragma("unroll") for (int k = 0; k < 2; ++k) dst[m][k] = *(const LAS bf16x8*)(lds + PG8_SA(b, h) + aoff + m * 2048 + k * 1024); } while (0)
#define PG8_LDB(dst, b, h) do { _Pragma("unroll") for (int n = 0; n < 2; ++n) _Pragma("unroll") for (int k = 0; k < 2; ++k) dst[n][k] = *(const LAS bf16x8*)(lds + PG8_SB(b, h) + boff + n * 2048 + k * 1024); } while (0)
#define PG8_MMA(ai, bj, At, Bt) do { __builtin_amdgcn_s_setprio(1); _Pragma("unroll") for (int m = 0; m < 4; ++m) _Pragma("unroll") for (int n = 0; n < 2; ++n) _Pragma("unroll") for (int k = 0; k < 2; ++k) \
        acc[ai][bj][m][n] = __builtin_amdgcn_mfma_f32_16x16x32_bf16(Bt[n][k], At[m][k], acc[ai][bj][m][n], 0, 0, 0); __builtin_amdgcn_s_setprio(0); } while (0)
#define PG8_WAIT_V(n) asm volatile("s_waitcnt vmcnt(" #n ")" ::: "memory")
#define PG8_WAIT_L(n) asm volatile("s_waitcnt lgkmcnt(" #n ")" ::: "memory")
#define PG8_BAR __builtin_amdgcn_s_barrier()
#define PG8_SCHED __builtin_amdgcn_sched_barrier(0)
    Unit cur, nxt; int ui = 0;
    if (!S.next(0, cur)) return;
    f32x4 acc[2][2][4][2];
#pragma unroll
    for (int a = 0; a < 2; ++a)
#pragma unroll
        for (int b = 0; b < 2; ++b)
#pragma unroll
            for (int m = 0; m < 4; ++m)
#pragma unroll
                for (int n = 0; n < 2; ++n) acc[a][b][m][n] = ZERO4;
    bf16x8 At[4][2], B0[2][2], B1[2][2];
    const char* cA = (const char*)g.A + (size_t)cur.pm * tA + (size_t)cur.koff * 2; const char* cB = (const char*)g.Bt + (size_t)cur.pn * tB + (size_t)cur.koff * 2;
    PG8_STAGE(PG8_SB(0, 0), cB, voffB); PG8_STAGE(PG8_SB(0, 1), cB + hB, voffB); PG8_STAGE(PG8_SA(0, 0), cA, voffA); PG8_STAGE(PG8_SA(0, 1), cA + hA, voffA);
    if (wr == 1) PG8_BAR;
    PG8_WAIT_V(2); PG8_BAR;
    PG8_STAGE(PG8_SB(1, 0), cB + kstep, voffB); PG8_STAGE(PG8_SA(1, 0), cA + kstep, voffA); PG8_STAGE(PG8_SB(1, 1), cB + hB + kstep, voffB);
    PG8_WAIT_V(6); PG8_BAR;
    for (;;) {
        const bool has_next = S.next(ui + 1, nxt);
        const char* nA = has_next ? (const char*)g.A + (size_t)nxt.pm * tA + (size_t)nxt.koff * 2 : cA; const char* nB = has_next ? (const char*)g.Bt + (size_t)nxt.pn * tB + (size_t)nxt.koff * 2 : cB;
        for (int t = 0; t < nt; t += 2) {
            const bool last = (t == nt - 2);
            const char* a1 = cA + (size_t)(t + 1) * kstep;
            const char* a2 = last ? nA : cA + (size_t)(t + 2) * kstep; const char* b2 = last ? nB : cB + (size_t)(t + 2) * kstep;
            const char* a3 = a2 + kstep; const char* b3 = b2 + kstep;
            PG8_LDB(B0, 0, 0); PG8_LDB(B1, 0, 1); PG8_SCHED; PG8_LDA(At, 0, 0); PG8_STAGE(PG8_SA(1, 1), a1 + hA, voffA);
            PG8_WAIT_V(8); PG8_WAIT_L(0); PG8_BAR; PG8_MMA(0, 0, At, B0); PG8_MMA(0, 1, At, B1); PG8_BAR; PG8_SCHED;
            PG8_LDA(At, 0, 1); PG8_STAGE(PG8_SB(0, 0), b2, voffB); PG8_STAGE(PG8_SB(0, 1), b2 + hB, voffB); PG8_STAGE(PG8_SA(0, 0), a2, voffA);
            PG8_WAIT_V(8); PG8_WAIT_L(0); PG8_BAR; PG8_MMA(1, 0, At, B0); PG8_MMA(1, 1, At, B1); PG8_BAR; PG8_SCHED;
            PG8_LDB(B0, 1, 0); PG8_LDB(B1, 1, 1); PG8_SCHED; PG8_LDA(At, 1, 0); PG8_STAGE(PG8_SA(0, 1), a2 + hA, voffA);
            PG8_WAIT_V(8); PG8_WAIT_L(0); PG8_BAR; PG8_MMA(0, 0, At, B0); PG8_MMA(0, 1, At, B1); PG8_BAR; PG8_SCHED;
            PG8_LDA(At, 1, 1); PG8_STAGE(PG8_SB(1, 0), b3, voffB); PG8_STAGE(PG8_SB(1, 1), b3 + hB, voffB); PG8_STAGE(PG8_SA(1, 0), a3, voffA);
            PG8_WAIT_V(8); PG8_WAIT_L(0); PG8_BAR; PG8_MMA(1, 0, At, B0); PG8_MMA(1, 1, At, B1); PG8_BAR; PG8_SCHED;
        }
        if (DBG_TMASK && DBG_TEPI && tid == 0 && blockIdx.x == 0) { volatile LAS unsigned* m_ = (volatile LAS unsigned*)(lds + MISC_OFF); if (m_[68]) m_[65] = (unsigned)__builtin_amdgcn_s_memrealtime(); }
        if (wr == 0) PG8_BAR;
        if constexpr (Epi::SEGACC) E.seg(acc, cur, wr, wc, fr, fq); else E(acc, cur, wr, wc, fr, fq);
        if (DBG_TMASK && DBG_TEPI && tid == 0 && blockIdx.x == 0) { volatile LAS unsigned* m_ = (volatile LAS unsigned*)(lds + MISC_OFF); if (m_[68]) m_[66] = m_[66] + ((unsigned)__builtin_amdgcn_s_memrealtime() - m_[65]); }
        if (!has_next) break;
        if (!(Epi::SEGACC && nxt.seg != 0)) {
#pragma unroll
        for (int a = 0; a < 2; ++a)
#pragma unroll
            for (int b = 0; b < 2; ++b)
#pragma unroll
                for (int m = 0; m < 4; ++m)
#pragma unroll
                    for (int n = 0; n < 2; ++n) acc[a][b][m][n] = ZERO4;
        }
        cur = nxt; cA = nA; cB = nB; ++ui;
        if (wr == 1) PG8_BAR;
    }
    PG8_WAIT_V(0);
    PG8_BAR;
#undef PG8_SA
#undef PG8_SB
#undef PG8_STAGE
#undef PG8_LDA
#undef PG8_LDB
#undef PG8_MMA
#undef PG8_WAIT_V
#undef PG8_WAIT_L
#undef PG8_BAR
#undef PG8_SCHED
}
#endif
}

#ifndef CPU_EMU
typedef const __attribute__((address_space(4))) Params* KParams;
#else
typedef const Params* KParams;
#endif
struct Frame {
    LAS unsigned char* lds;
    int tid, lane, wave, G, bid;
    KParams p;
    unsigned char* ws;
};
DEV const float* lin(const Frame& F, int idx, int layer, size_t per_layer) { return F.p->in[idx] + (size_t)layer * per_layer; }
#define WSP(T, off) ((T*)(F.ws + (off)))

DEV int up_dest(int n) { return n < DFF ? (n >> 7) * 256 + (n & 127) : ((n - DFF) >> 7) * 256 + 128 + ((n - DFF) & 127); }
DEV int win_dest(int n) {
    if (n < 2048) return n;
    if (n < 2052) return SM0 + S_AA + (n - 2048);
    if (n < 2056) return SM0 + S_AB + (n - 2052);
    if (n < 4104) return C_BQ + (n - 2056);
    if (n < 4116) return SM0 + S_BG + (n - 4104);
    if (n < 6676) return C_CZ + (n - 4116);
    if (n < 6692) return SM0 + S_DT + (n - 6676);
    return GT0 + (n - 6692);
}
struct XItem { const float* W; const float* ks; bf16* WT; int K, N, ldt, koff, mode, r; };
DEV void xitem_load(const XItem& it, int lane, float (&v)[32]) {
    const int nblk = (it.N + 31) / 32, kb = it.r / nblk, nb = it.r % nblk, k0 = 64 * kb, n0 = 32 * nb;
    const int nn = n0 + (lane & 31);
    const float* src = it.W + (size_t)(k0 + (lane >> 5)) * it.N + (nn < it.N ? nn : it.N - 1);
#pragma unroll
    for (int i = 0; i < 32; ++i) v[i] = src[(size_t)(2 * i) * it.N];
}
DEV void xitem_to_lds(LAS float* scr, int lane, const float (&v)[32]) {
#pragma unroll
    for (int i = 0; i < 32; ++i) scr[(2 * i + (lane >> 5)) * 33 + (lane & 31)] = v[i];
    LDS_WAIT(); CFENCE();
}
DEV void xitem_store(const XItem& it, LAS float* scr, int lane) {
    const int nblk = (it.N + 31) / 32, kb = it.r / nblk, nb = it.r % nblk, k0 = 64 * kb, n0 = 32 * nb;
    const int c = lane & 7;
    f32x4 ks0 = (f32x4){1.f, 1.f, 1.f, 1.f}, ks1 = ks0;
    if (it.ks) { ks0 = *(const f32x4*)(it.ks + k0 + 8 * c); ks1 = *(const f32x4*)(it.ks + k0 + 8 * c + 4); }
#pragma unroll
    for (int j = 0; j < 4; ++j) { const int n = (lane >> 3) + 8 * j; const LAS float* s = scr + (8 * c) * 33 + n;
        u32x4 o; o.x = pk2(s[0 * 33] * ks0[0], s[1 * 33] * ks0[1]); o.y = pk2(s[2 * 33] * ks0[2], s[3 * 33] * ks0[3]); o.z = pk2(s[4 * 33] * ks1[0], s[5 * 33] * ks1[1]); o.w = pk2(s[6 * 33] * ks1[2], s[7 * 33] * ks1[3]);
        const int ng = n0 + n;
        if (ng < it.N) { const int dr = it.mode == 0 ? ng : (it.mode == 1 ? up_dest(ng) : win_dest(ng)); *(u32x4*)(it.WT + (size_t)dr * it.ldt + it.koff + k0 + 8 * c) = o; } }
    LDS_WAIT(); CFENCE();
}
constexpr int XI_UP = (DM / 64) * (NUP / 32), XI_DN = (DFF / 64) * (DM / 32), XI_IN = (DM / 64) * ((NIN + 31) / 32), XI_P5 = (512 / 64) * (DM / 32), XI_P10 = (1024 / 64) * (DM / 32), XI_OO = (DM / 64) * (DM / 32), XI_CK = (4096 / 64) * (128 / 32);
constexpr int XI_TOTAL = 2 * XI_UP + 2 * XI_DN + XI_IN + 2 * XI_P5 + XI_P10 + XI_OO + 2 * XI_CK;
DEV XItem xitem_decode(Frame& F, int l, int idx) {
    XItem t; int r = idx; t.ks = nullptr; t.koff = 0; t.mode = 0;
    if (r < XI_UP) { t.W = lin(F, I_WUP1, l, (size_t)DM * NUP); t.K = DM; t.N = NUP; t.WT = WSP(bf16, WS_WUP1); t.ldt = DM; t.ks = lin(F, I_GF1, l, DM); t.mode = 1; }
    else if ((r -= XI_UP) < XI_UP) { t.W = lin(F, I_WUP2, l, (size_t)DM * NUP); t.K = DM; t.N = NUP; t.WT = WSP(bf16, WS_WUP2); t.ldt = DM; t.ks = lin(F, I_GF2, l, DM); t.mode = 1; }
    else if ((r -= XI_UP) < XI_DN) { t.W = lin(F, I_WDN1, l, (size_t)DFF * DM); t.K = DFF; t.N = DM; t.WT = WSP(bf16, WS_WDN1); t.ldt = DFF; }
    else if ((r -= XI_DN) < XI_DN) { t.W = lin(F, I_WDN2, l, (size_t)DFF * DM); t.K = DFF; t.N = DM; t.WT = WSP(bf16, WS_WDN2); t.ldt = DFF; }
    else if ((r -= XI_DN) < XI_IN) { t.W = lin(F, I_WIN, l, (size_t)DM * NIN); t.K = DM; t.N = NIN; t.WT = WSP(bf16, WS_WIN); t.ldt = DM; t.ks = lin(F, I_GMIX, l, DM); t.mode = 2; }
    else if ((r -= XI_IN) < XI_P5) { t.W = lin(F, I_PA, l, (size_t)512 * DM); t.K = 512; t.N = DM; t.WT = WSP(bf16, WS_WPM); t.ldt = DM; }
    else if ((r -= XI_P5) < XI_P5) { t.W = lin(F, I_PB, l, (size_t)512 * DM); t.K = 512; t.N = DM; t.WT = WSP(bf16, WS_WPM); t.ldt = DM; t.koff = 512; }
    else if ((r -= XI_P5) < XI_P10) { t.W = lin(F, I_PC, l, (size_t)1024 * DM); t.K = 1024; t.N = DM; t.WT = WSP(bf16, WS_WPM); t.ldt = DM; t.koff = 1024; t.ks = lin(F, I_SNORM, l, 1024); }
    else if ((r -= XI_P10) < XI_OO) { t.W = lin(F, I_WO, l, (size_t)DM * DM); t.K = DM; t.N = DM; t.WT = WSP(bf16, WS_WO); t.ldt = DM; }
    else if ((r -= XI_OO) < XI_CK) { t.W = lin(F, I_NWCK, l, (size_t)4096 * 128); t.K = 4096; t.N = 128; t.WT = WSP(bf16, WS_WCK); t.ldt = 4096; }
    else { r -= XI_CK; t.W = lin(F, I_NWCV, l, (size_t)4096 * 128); t.K = 4096; t.N = 128; t.WT = WSP(bf16, WS_WCV); t.ldt = 4096; }
    t.r = r; return t;
}
DEV void phase_convert(Frame& F, int l) {
    LAS float* scr = (LAS float*)(F.lds + F.wave * 16384);
    const int gw = F.bid * 8 + F.wave, NGW = F.G * 8;
    if (gw < XI_TOTAL) {
        float v[32]; XItem cur = xitem_decode(F, l, gw); xitem_load(cur, F.lane, v);
        for (int it = gw; it < XI_TOTAL; it += NGW) {
            xitem_to_lds(scr, F.lane, v);
            const bool has_next = it + NGW < XI_TOTAL; XItem nxt = cur;
            if (has_next) { nxt = xitem_decode(F, l, it + NGW); xitem_load(nxt, F.lane, v); }
            xitem_store(cur, scr, F.lane);
            cur = nxt;
        }
    }
    { bf16* w = WSP(bf16, WS_WIN) + (size_t)(SM0 + 36) * DM; const int n16 = (GT0 - SM0 - 36) * DM / 8;
      const unsigned zu = __builtin_bit_cast(unsigned, opaque_zero());
      for (int i = F.bid * 512 + F.tid; i < n16; i += F.G * 512) ((u32x4*)w)[i] = (u32x4){zu, zu, zu, zu}; }
    { const float* pek = lin(F, I_NPEK, l, 4096); const float* pev = lin(F, I_NPEV, l, 4096); float* cst = WSP(float, WS_CONST);
      for (int it = gw; it < 256; it += NGW) { const int e = it & 127; const float* pe = it < 128 ? pek : pev; const float* w = it < 128 ? lin(F, I_NWCK, l, (size_t)4096 * 128) : lin(F, I_NWCV, l, (size_t)4096 * 128); float s = 0.f;
          for (int k = F.lane; k < 4096; k += 64) s += pe[k] * w[(size_t)k * 128 + e];
          s = wave_sum(s); if (F.lane == 0) cst[it] = s; } }
    if (l == 0) {
        const float* x = F.p->in[I_X]; bf16* xb = WSP(bf16, WS_XB); unsigned long long* rss = WSP(unsigned long long, WS_CTL) + CW_RS / 2;
        for (int m = gw; m < MTOK; m += NGW) {
            const f32x4* xr = (const f32x4*)(x + (size_t)m * DM) + F.lane; u32x2* br = (u32x2*)(xb + (size_t)m * DM) + F.lane; float ss = 0.f;
#pragma unroll
            for (int j = 0; j < 8; ++j) { const f32x4 v = xr[64 * j]; ss += (v[0] * v[0] + v[1] * v[1]) + (v[2] * v[2] + v[3] * v[3]); u32x2 w; w.x = pk2(v[0], v[1]); w.y = pk2(v[2], v[3]); br[64 * j] = w; }
            ss = wave_sum(ss); if (F.lane == 0) rss[m] = pg8::rss_fix(ss);
        }
    }
}

DEV void nsa_prep_job(Frame& F, int l, int job) {
    const int b = job >> 8, g = (job >> 7) & 1, j = job & 127, bg = b * 2 + g, t0 = 64 * j;
    const bf16* p1 = WSP(bf16, WS_P1);
    const float* qn = lin(F, I_NQN, l, 128); const float* kn = lin(F, I_NKN, l, 128);
    bf16* QN = WSP(bf16, WS_QN); bf16* KS = WSP(bf16, WS_KS); bf16* KW = WSP(bf16, WS_KW); bf16* VST = WSP(bf16, WS_VST); bf16* VWT = WSP(bf16, WS_VWT);
    {
        const int v = F.lane >> 4, l16 = F.lane & 15;
        const int col = (v < 2 ? C_BQ + (g * 2 + v) * 128 : (v == 2 ? C_BKS + g * 128 : C_BKW + g * 128)) + 8 * l16;
        const float* gp = (v < 2 ? qn : kn) + 8 * l16; const f32x4 ga = *(const f32x4*)gp, gb = *(const f32x4*)(gp + 4);
        const float gg[8] = {ga[0], ga[1], ga[2], ga[3], gb[0], gb[1], gb[2], gb[3]};
        u32x4 wv[8];
#pragma unroll
        for (int i = 0; i < 8; ++i) wv[i] = *(const u32x4*)(p1 + (size_t)(b * SEQ + t0 + 8 * F.wave + i) * P1W + col);
        CFENCE();
#pragma unroll
        for (int i = 0; i < 8; ++i) {
            const int t = t0 + 8 * F.wave + i;
            const float x[8] = {bflo(wv[i].x), bfhi(wv[i].x), bflo(wv[i].y), bfhi(wv[i].y), bflo(wv[i].z), bfhi(wv[i].z), bflo(wv[i].w), bfhi(wv[i].w)};
            float ss = ((x[0] * x[0] + x[1] * x[1]) + (x[2] * x[2] + x[3] * x[3])) + ((x[4] * x[4] + x[5] * x[5]) + (x[6] * x[6] + x[7] * x[7]));
            ss = sum16(ss);
            float r = rsqrtf(ss * (1.0f / 128.0f) + EPS);
            if (v < 2) r *= 0.08838834764831845f * 1.4426950408889634f;
            u32x4 o; o.x = pk2(x[0] * r * gg[0], x[1] * r * gg[1]); o.y = pk2(x[2] * r * gg[2], x[3] * r * gg[3]); o.z = pk2(x[4] * r * gg[4], x[5] * r * gg[5]); o.w = pk2(x[6] * r * gg[6], x[7] * r * gg[7]);
            bf16* dst = v < 2 ? QN + ((size_t)(bg * SEQ + t) * 2 + v) * 128 : (v == 2 ? KS : KW) + (size_t)(bg * SEQ + t) * 128;
            *(u32x4*)(dst + 8 * l16) = o;
        }
    }
    LAS bf16* tl = (LAS bf16*)F.lds;
    {
        u32x4 vv[4];
#pragma unroll
        for (int q = 0; q < 4; ++q) { const int i = F.tid + 512 * q, v = i >> 10, r = (i >> 4) & 63, c8 = (i & 15) * 8;
            vv[q] = *(const u32x4*)(p1 + (size_t)(b * SEQ + t0 + r) * P1W + (v ? C_BVW : C_BVS) + g * 128 + c8); }
#pragma unroll
        for (int q = 0; q < 4; ++q) { const int i = F.tid + 512 * q, v = i >> 10, r = (i >> 4) & 63, c8 = (i & 15) * 8; LAS unsigned* d = (LAS unsigned*)(tl + (v * 64 + r) * 130 + c8);
            d[0] = vv[q].x; d[1] = vv[q].y; d[2] = vv[q].z; d[3] = vv[q].w; }
    }
    __syncthreads();
    for (int i = F.tid; i < 2 * 128 * 8; i += 512) {
        const int v = i >> 10, d = i & 127, tc = (i >> 7) & 7;
        const LAS bf16* s = tl + (v * 64 + 8 * tc) * 130 + d;
        u32x4 o; o.x = s[0] | ((unsigned)s[130] << 16); o.y = s[260] | ((unsigned)s[390] << 16); o.z = s[520] | ((unsigned)s[650] << 16); o.w = s[780] | ((unsigned)s[910] << 16);
        *(u32x4*)((v ? VWT : VST) + ((size_t)(bg * 128 + j) * 128 + d) * 64 + 8 * tc) = o;
    }
    __syncthreads();
}

DEV void conv_load11(u32x4 (&xin)[11], const bf16* p1, int b, int ts, int col) {
#pragma unroll
    for (int i = 0; i < 11; ++i) { const int t = ts - 3 + i; const int tc = t < 0 ? 0 : t;
        u32x4 v = *(const u32x4*)(p1 + (size_t)(b * SEQ + tc) * P1W + col);
        if (t < 0) v = (u32x4){0u, 0u, 0u, 0u};
        xin[i] = v; }
}
DEV void gdn_prep_job(Frame& F, int l, int job) {
    const int b = job >> 9, h = (job >> 7) & 3, c = job & 127, t0 = 64 * c;
    const bf16* p1 = WSP(bf16, WS_P1); const float* small = WSP(float, WS_SMALL);
    const float* convw = lin(F, I_GCONV, l, 4 * 1536);
    LAS float* Qs = (LAS float*)F.lds;
    LAS float* Ks = Qs + 64 * 132;
    LAS float* Vs = Ks + 64 * 132;
    LAS float* Mm = Vs + 64 * 132;
    LAS float* At = Mm + 64 * 68;
    LAS float* beta = At + 64 * 68;
    LAS float* gc = beta + 64;
    LAS float* eg = gc + 64;
    const int tid = F.tid;
    {
        if (tid < 384) {
            const int v = tid >> 7, s = tid & 15, tg = (tid >> 4) & 7, cc = v * 512 + h * 128 + 8 * s;
            u32x4 xin[11]; conv_load11(xin, p1, b, t0 + 8 * tg, (v == 0 ? C_AQ : (v == 1 ? C_AK : C_AV)) + h * 128 + 8 * s);
            f32x4 w[4][2];
#pragma unroll
            for (int k = 0; k < 4; ++k) { w[k][0] = *(const f32x4*)(convw + k * 1536 + cc); w[k][1] = *(const f32x4*)(convw + k * 1536 + cc + 4); }
            float y[8][8];
#pragma unroll
            for (int j = 0; j < 8; ++j) {
                float x[11];
#pragma unroll
                for (int i = 0; i < 11; ++i) { const unsigned wd = j < 2 ? xin[i].x : (j < 4 ? xin[i].y : (j < 6 ? xin[i].z : xin[i].w)); x[i] = (j & 1) ? bfhi(wd) : bflo(wd); }
                const float w0 = w[0][j >> 2][j & 3], w1 = w[1][j >> 2][j & 3], w2 = w[2][j >> 2][j & 3], w3 = w[3][j >> 2][j & 3];
#pragma unroll
                for (int i = 0; i < 8; ++i) y[i][j] = siluf_(w0 * x[i] + w1 * x[i + 1] + w2 * x[i + 2] + w3 * x[i + 3]);
            }
            LAS float* dst = (v == 0 ? Qs : (v == 1 ? Ks : Vs)) + (8 * tg) * 132 + 8 * s;
#pragma unroll
            for (int i = 0; i < 8; ++i) { *(LAS f32x4*)(dst + i * 132) = (f32x4){y[i][0], y[i][1], y[i][2], y[i][3]}; *(LAS f32x4*)(dst + i * 132 + 4) = (f32x4){y[i][4], y[i][5], y[i][6], y[i][7]}; }
        }
        if (tid < 64) {
            const size_t row = (size_t)(b * SEQ + t0 + tid);
            const float a = small[row * SMW + S_AA + h], bb = small[row * SMW + S_AB + h];
            beta[tid] = sigmoidf_(bb);
            gc[tid] = -__expf(lin(F, I_GALOG, l, 4)[h]) * softplusf_(a + lin(F, I_GDTB, l, 4)[h]);
        }
    }
    __syncthreads();
    for (int i4 = 0; i4 < 4; ++i4) {
        float x0[4], x1[4], ssv[4];
#pragma unroll
        for (int q = 0; q < 4; ++q) { const int r = F.wave * 16 + 4 * i4 + q;
            const LAS float* p = (r < 64 ? Qs + r * 132 : Ks + (r - 64) * 132); x0[q] = p[F.lane]; x1[q] = p[F.lane + 64]; ssv[q] = x0[q] * x0[q] + x1[q] * x1[q]; }
        wave_sum4(ssv);
#pragma unroll
        for (int q = 0; q < 4; ++q) { const int r = F.wave * 16 + 4 * i4 + q; LAS float* p = (r < 64 ? Qs + r * 132 : Ks + (r - 64) * 132);
            float sc = rsqrtf(ssv[q] + EPS); if (r < 64) sc *= 0.08838834764831845f;
            p[F.lane] = x0[q] * sc; p[F.lane + 64] = x1[q] * sc; }
    }
    if (tid < 64) {
        float sc = gc[tid];
#pragma unroll
        for (int d = 1; d < 64; d <<= 1) { const float t = __builtin_bit_cast(float, __builtin_amdgcn_ds_bpermute((tid - d) * 4, __builtin_bit_cast(int, sc))); if (tid >= d) sc += t; }
        gc[tid] = sc; eg[tid] = __expf(sc);
    }
    for (int i = tid; i < 64 * 68; i += 512) At[i] = 0.f;
    __syncthreads();
    for (int tj = F.wave; tj < 20; tj += 8) {
        const int kind = tj >= 10 ? 1 : 0, idx = tj - 10 * kind;
        const int mt = idx >= 6 ? 3 : (idx >= 3 ? 2 : (idx >= 1 ? 1 : 0)), nt = idx - mt * (mt + 1) / 2;
        const int fr = F.lane & 15, fq = F.lane >> 4;
        const LAS float* ap = (kind ? Qs : Ks) + (16 * mt + fr) * 132 + 4 * fq; const LAS float* bp = Ks + (16 * nt + fr) * 132 + 4 * fq;
        f32x4 acc = (f32x4){0.f, 0.f, 0.f, 0.f};
#pragma unroll
        for (int sg = 0; sg < 8; ++sg) { const f32x4 a4 = *(const LAS f32x4*)(ap + 16 * sg), b4 = *(const LAS f32x4*)(bp + 16 * sg);
#pragma unroll
            for (int j = 0; j < 4; ++j) acc = __builtin_amdgcn_mfma_f32_16x16x4f32(a4[j], b4[j], acc, 0, 0, 0); }
        const int j = 16 * nt + fr; const float gj = gc[j];
#pragma unroll
        for (int r = 0; r < 4; ++r) { const int i = 16 * mt + 4 * fq + r; const float dec = j <= i ? __expf(gc[i] - gj) : 0.f;
            if (kind) At[i * 68 + j] = acc[r] * dec; else Mm[i * 68 + j] = j < i ? beta[i] * acc[r] * dec : 0.f; }
    }
    __syncthreads();
    unsigned char* cb = F.ws + WS_GW + (size_t)job * GDN_CH_BYTES;
    bf16* gW = (bf16*)cb; bf16* gQD = (bf16*)(cb + 16384); bf16* gKDT = (bf16*)(cb + 32768); bf16* gUT = (bf16*)(cb + 49152); bf16* gAT = (bf16*)(cb + 65536);
    float sol[64];
    if (tid < 256) {
        const int cidx = tid & 127; const bool isw = tid >= 128;
        const LAS float* src = (isw ? Ks : Vs) + cidx;
        const LAS float* MmL = (const LAS float*)lds_vbase(Mm); const LAS float* betaL = (const LAS float*)lds_vbase(beta); const LAS float* egL = (const LAS float*)lds_vbase(eg);
#pragma unroll
        for (int i = 0; i < 64; ++i) sol[i] = 0.f;
#pragma unroll
        for (int i = 0; i < 64; ++i) {
            float r = src[i * 132] * betaL[i] * (isw ? egL[i] : 1.0f), r1 = 0.f, r2 = 0.f, r3 = 0.f;
#pragma unroll
            for (int j4 = 0; j4 < (i + 3) / 4; ++j4) { const f32x4 mv = *(const LAS f32x4*)(MmL + i * 68 + 4 * j4);
                r -= mv[0] * sol[4 * j4]; r1 -= mv[1] * sol[4 * j4 + 1]; r2 -= mv[2] * sol[4 * j4 + 2]; r3 -= mv[3] * sol[4 * j4 + 3]; }
            r = (r + r1) + (r2 + r3);
            sol[i] = r;
            asm volatile("" : "+v"(sol[i]) :: "memory");
        }
    } else {
        const int t2 = tid - 256;
        const float gl = gc[63];
        for (int i = t2; i < 64 * 16; i += 256) { const int r = i >> 4, c8 = (i & 15) * 8; const float e = eg[r]; const LAS float* s = Qs + r * 132 + c8;
            u32x4 o; o.x = pk2(s[0] * e, s[1] * e); o.y = pk2(s[2] * e, s[3] * e); o.z = pk2(s[4] * e, s[5] * e); o.w = pk2(s[6] * e, s[7] * e); *(u32x4*)(gQD + r * 128 + c8) = o; }
        for (int i = t2; i < 128 * 8; i += 256) { const int dk = i & 127, i8 = (i >> 7) * 8; float v[8];
#pragma unroll
            for (int q = 0; q < 8; ++q) v[q] = Ks[(i8 + q) * 132 + dk] * __expf(gl - gc[i8 + q]);
            u32x4 o; o.x = pk2(v[0], v[1]); o.y = pk2(v[2], v[3]); o.z = pk2(v[4], v[5]); o.w = pk2(v[6], v[7]); *(u32x4*)(gKDT + dk * 64 + i8) = o; }
        for (int i = t2; i < 64 * 8; i += 256) { const int r = i >> 3, c8 = (i & 7) * 8; const LAS float* s = At + r * 68 + c8;
            u32x4 o; o.x = pk2(s[0], s[1]); o.y = pk2(s[2], s[3]); o.z = pk2(s[4], s[5]); o.w = pk2(s[6], s[7]); *(u32x4*)(gAT + r * 64 + c8) = o; }
        if (t2 == 0) WSP(float, WS_GL)[job] = __expf(gl);
    }
    __syncthreads();
    LAS bf16* Wl = (LAS bf16*)Qs;
    if (tid < 128) {
#pragma unroll
        for (int q = 0; q < 8; ++q) { u32x4 o; o.x = pk2(sol[8 * q], sol[8 * q + 1]); o.y = pk2(sol[8 * q + 2], sol[8 * q + 3]); o.z = pk2(sol[8 * q + 4], sol[8 * q + 5]); o.w = pk2(sol[8 * q + 6], sol[8 * q + 7]);
            *(u32x4*)(gUT + tid * 64 + 8 * q) = o; }
    } else if (tid < 256) {
#pragma unroll
        for (int i = 0; i < 64; ++i) Wl[i * 136 + (tid - 128)] = (bf16)f2bf(sol[i]);
    }
    __syncthreads();
    for (int i = tid; i < 64 * 16; i += 512) { const int r = i >> 4, c8 = (i & 15) * 8; *(u32x4*)(gW + r * 128 + c8) = *(const LAS u32x4*)(Wl + r * 136 + c8); }
    __syncthreads();
}

DEV void ssd_conv8(const u32x4 (&xin)[11], const float* cw, const float* cbias, int cc, float (&y)[8][8]) {
    f32x4 w[4][2], bs[2];
#pragma unroll
    for (int k = 0; k < 4; ++k) { w[k][0] = *(const f32x4*)(cw + k * 1536 + cc); w[k][1] = *(const f32x4*)(cw + k * 1536 + cc + 4); }
    bs[0] = *(const f32x4*)(cbias + cc); bs[1] = *(const f32x4*)(cbias + cc + 4);
#pragma unroll
    for (int j = 0; j < 8; ++j) {
        float x[11];
#pragma unroll
        for (int i = 0; i < 11; ++i) { const unsigned wd = j < 2 ? xin[i].x : (j < 4 ? xin[i].y : (j < 6 ? xin[i].z : xin[i].w)); x[i] = (j & 1) ? bfhi(wd) : bflo(wd); }
        const float w0 = w[0][j >> 2][j & 3], w1 = w[1][j >> 2][j & 3], w2 = w[2][j >> 2][j & 3], w3 = w[3][j >> 2][j & 3], bj = bs[j >> 2][j & 3];
#pragma unroll
        for (int i = 0; i < 8; ++i) y[i][j] = siluf_(w0 * x[i] + w1 * x[i + 1] + w2 * x[i + 2] + w3 * x[i + 3] + bj);
    }
}
DEV bf16x8 frag_sw(const LAS bf16* M, int row, int chunk) { return *(const LAS bf16x8*)(M + row * 136 + 8 * (chunk ^ ((row >> 3) & 7))); }
DEV void ssd_prep_pass(Frame& F, const u32x4 (&xin)[11], const float* cw, const float* cbias, int cc, bf16* SX, float* dst0, LAS bf16* BT, LAS bf16* XT, const LAS float* dts, const LAS float* acs,
                       size_t row0, int s, int tg, int hh0) {
    const float zf_ = opaque_zero();
    {
        float y[8][8]; ssd_conv8(xin, cw, cbias, cc, y);
#pragma unroll
        for (int i = 0; i < 8; ++i) { u32x4 o; o.x = pk2(y[i][0], y[i][1]); o.y = pk2(y[i][2], y[i][3]); o.z = pk2(y[i][4], y[i][5]); o.w = pk2(y[i][6], y[i][7]);
            *(u32x4*)(SX + (row0 + i) * 1536 + cc) = o; }
        const int hh = hh0 + (s >> 3); const float al = acs[127 * 8 + hh]; float f[8];
#pragma unroll
        for (int i = 0; i < 8; ++i) f[i] = dts[(8 * tg + i) * 8 + hh] * __expf(al - acs[(8 * tg + i) * 8 + hh]);
#pragma unroll
        for (int j = 0; j < 8; ++j) { float v[8];
#pragma unroll
            for (int i = 0; i < 8; ++i) v[i] = bf2f(f2bf(y[i][j])) * f[i];
            u32x4 o; o.x = pk2(v[0], v[1]); o.y = pk2(v[2], v[3]); o.z = pk2(v[4], v[5]); o.w = pk2(v[6], v[7]);
            *(LAS u32x4*)(XT + (8 * s + j) * 136 + 8 * (tg ^ (s & 7))) = o; }
    }
    __syncthreads();
    {
        const int hp = F.wave >> 1, nh = F.wave & 1, fr = F.lane & 15, fq = F.lane >> 4;
        const LAS bf16* XTh = XT + hp * 64 * 136;
        float* dst = dst0 + (size_t)hp * 64 * 128;
#pragma unroll
        for (int mt = 0; mt < 4; ++mt) {
            bf16x8 a[4];
#pragma unroll
            for (int ks = 0; ks < 4; ++ks) a[ks] = frag_sw(XTh, 16 * mt + fr, 4 * ks + fq);
#pragma unroll
            for (int q = 0; q < 4; ++q) { const int nq = 4 * nh + q; f32x4 acc = ZERO4;
#pragma unroll
                for (int ks = 0; ks < 4; ++ks) acc = mfma16(frag_sw(BT, 16 * nq + fr, 4 * ks + fq), a[ks], acc);
                *(f32x4*)(dst + (size_t)(16 * mt + fr) * 128 + 16 * nq + 4 * fq) = acc; }
        }
    }
    __syncthreads();
}
DEV void ssd_prep_job(Frame& F, int l, int job) {
    const int b = job >> 7, c = (job >> 1) & 63, g = job & 1, t0 = 128 * c;
    const bf16* p1 = WSP(bf16, WS_P1); const float* small = WSP(float, WS_SMALL);
    const float* cw = lin(F, I_SCW, l, 4 * 1536); const float* cbias = lin(F, I_SCB, l, 1536);
    bf16* SX = WSP(bf16, WS_SX); float* SDT = WSP(float, WS_SDT); float* SAC = WSP(float, WS_SAC); float* SST = WSP(float, WS_SST); float* SCD = WSP(float, WS_SCD);
    LAS bf16* BT = (LAS bf16*)F.lds;
    LAS bf16* XT = BT + 128 * 136;
    LAS float* dts = (LAS float*)(XT + 4 * 64 * 136);
    LAS float* acs = dts + 128 * 8;
    const int tid = F.tid, s = tid & 31, tg = tid >> 5, ts = t0 + 8 * tg;
    const int ccA = 1024 + (s < 16 ? g * 128 + 8 * s : 256 + g * 128 + 8 * (s - 16));
    const int ccX = g * 512 + 8 * s;
    const size_t row0 = (size_t)(b * SEQ + ts);
    u32x4 xa[11], xb[11];
    conv_load11(xa, p1, b, ts, C_CX + ccA); conv_load11(xb, p1, b, ts, C_CX + ccX);
    for (int i = tid; i < 1024; i += 512) { const int tl = i >> 3, hh = i & 7, h = 8 * g + hh; const size_t row = (size_t)(b * SEQ + t0 + tl);
        const float dt = softplusf_(small[row * SMW + S_DT + h] + lin(F, I_SDTB, l, 16)[h]);
        dts[i] = dt; acs[i] = dt * (-__expf(lin(F, I_SALOG, l, 16)[h])); }
    __syncthreads();
    {
        const int hh = F.wave, ln = F.lane; const float v0 = acs[(2 * ln) * 8 + hh], v1 = acs[(2 * ln + 1) * 8 + hh];
        float sc = v0 + v1;
#pragma unroll
        for (int d = 1; d < 64; d <<= 1) { const float t = __builtin_bit_cast(float, __builtin_amdgcn_ds_bpermute((ln - d) * 4, __builtin_bit_cast(int, sc))); if (ln >= d) sc += t; }
        float ex = __builtin_bit_cast(float, __builtin_amdgcn_ds_bpermute((ln - 1) * 4, __builtin_bit_cast(int, sc))); if (ln == 0) ex = 0.f;
        const float a0 = ex + v0; acs[(2 * ln) * 8 + hh] = a0; acs[(2 * ln + 1) * 8 + hh] = a0 + v1;
    }
    __syncthreads();
    for (int i = tid; i < 1024; i += 512) { const int tl = i >> 3, hh = i & 7; const size_t row = (size_t)(b * SEQ + t0 + tl); SDT[row * 16 + 8 * g + hh] = dts[i]; SAC[row * 16 + 8 * g + hh] = acs[i]; }
    if (tid < 8) SCD[(size_t)(b * 64 + c) * 16 + 8 * g + tid] = __expf(acs[127 * 8 + tid]);
    {
        float y[8][8]; ssd_conv8(xa, cw, cbias, ccA, y);
#pragma unroll
        for (int i = 0; i < 8; ++i) { u32x4 o; o.x = pk2(y[i][0], y[i][1]); o.y = pk2(y[i][2], y[i][3]); o.z = pk2(y[i][4], y[i][5]); o.w = pk2(y[i][6], y[i][7]);
            *(u32x4*)(SX + (row0 + i) * 1536 + ccA) = o; }
        if (s < 16) {
#pragma unroll
            for (int j = 0; j < 8; ++j) { u32x4 o; o.x = pk2(y[0][j], y[1][j]); o.y = pk2(y[2][j], y[3][j]); o.z = pk2(y[4][j], y[5][j]); o.w = pk2(y[6][j], y[7][j]);
                *(LAS u32x4*)(BT + (8 * s + j) * 136 + 8 * (tg ^ (s & 7))) = o; }
        }
    }
    conv_load11(xa, p1, b, ts, C_CX + ccX + 256);
    float* dst0 = SST + ((size_t)((b * 64 + c) * 16 + 8 * g) * 64) * 128;
    ssd_prep_pass(F, xb, cw, cbias, ccX, SX, dst0, BT, XT, dts, acs, row0, s, tg, 0);
    ssd_prep_pass(F, xa, cw, cbias, ccX + 256, SX, dst0 + (size_t)4 * 64 * 128, BT, XT, dts, acs, row0, s, tg, 4);
}

DEV void nsa_compress_job(Frame& F, int l, int job) {
    const int kv = job >> 4, bg = (job >> 2) & 3, rt = job & 3, b = bg >> 1, g = bg & 1, i0 = 128 * rt;
    const float zf_ = opaque_zero();
    const bf16* p1 = WSP(bf16, WS_P1); const bf16* Wt = WSP(bf16, kv ? WS_WCV : WS_WCK); const float* cst = WSP(float, WS_CONST) + kv * 128;
    const int col0 = (kv ? C_BVC : C_BKC) + g * 128;
    LAS bf16* As = (LAS bf16*)F.lds;
    LAS bf16* Bs = As + 128 * 72;
    LAS float* Cs = (LAS float*)(Bs + 128 * 72);
    const int tid = F.tid, wm = F.wave >> 1, wn = F.wave & 1;
    f32x4 acc[2][4];
#pragma unroll
    for (int i = 0; i < 2; ++i)
#pragma unroll
        for (int j = 0; j < 4; ++j) acc[i][j] = ZERO4;
    u32x4 ra[2], rb[2];
#define LOADK(ks_) do { _Pragma("unroll") for (int q = 0; q < 2; ++q) { const int ch = tid + 512 * q, r = ch >> 3, c8 = (ch & 7) * 8; \
            int t = 16 * (i0 + r) + ((ks_) >> 1); if (t > SEQ - 1) t = SEQ - 1;     \
            ra[q] = *(const u32x4*)(p1 + (size_t)(b * SEQ + t) * P1W + col0 + ((ks_) & 1) * 64 + c8); \
            rb[q] = *(const u32x4*)(Wt + (size_t)r * 4096 + 64 * (ks_) + c8); } } while (0)
    LOADK(0);
    for (int ks = 0; ks < 64; ++ks) {
        __syncthreads();
#pragma unroll
        for (int q = 0; q < 2; ++q) { const int ch = tid + 512 * q, r = ch >> 3, c8 = (ch & 7) * 8; *(LAS u32x4*)(As + r * 72 + c8) = ra[q]; *(LAS u32x4*)(Bs + r * 72 + c8) = rb[q]; }
        __syncthreads();
        if (ks + 1 < 64) LOADK(ks + 1);
#pragma unroll
        for (int k2 = 0; k2 < 2; ++k2) {
            bf16x8 a0 = frag_l(As, 72, 32 * wm, 32 * k2, F.lane), a1 = frag_l(As, 72, 32 * wm + 16, 32 * k2, F.lane);
#pragma unroll
            for (int j = 0; j < 4; ++j) { const bf16x8 bb = frag_l(Bs, 72, 64 * wn + 16 * j, 32 * k2, F.lane); acc[0][j] = mfma16(a0, bb, acc[0][j]); acc[1][j] = mfma16(a1, bb, acc[1][j]); }
        }
    }
    __syncthreads();
#pragma unroll
    for (int i = 0; i < 2; ++i)
#pragma unroll
        for (int j = 0; j < 4; ++j)
#pragma unroll
            for (int r = 0; r < 4; ++r) { const int col = 64 * wn + 16 * j + (F.lane & 15); Cs[(32 * wm + 16 * i + 4 * (F.lane >> 4) + r) * 132 + col] = acc[i][j][r] + cst[col]; }
    __syncthreads();
    if (kv == 0) {
        const float* kn = lin(F, I_NKN, l, 128); bf16* KC = WSP(bf16, WS_KCMP);
        const int r = tid >> 2, q = tid & 3; const LAS float* s = Cs + r * 132 + 32 * q; float ss = 0.f;
#pragma unroll
        for (int e = 0; e < 32; ++e) ss += s[e] * s[e];
        ss += shx<1>(ss); ss += shx<2>(ss);
        const float rs = rsqrtf(ss * (1.0f / 128.0f) + EPS);
        bf16* dst = KC + ((size_t)bg * 512 + i0 + r) * 128 + 32 * q;
#pragma unroll
        for (int e = 0; e < 32; e += 2) *(unsigned*)(dst + e) = pk2(s[e] * rs * kn[32 * q + e], s[e + 1] * rs * kn[32 * q + e + 1]);
    } else {
        bf16* VC = WSP(bf16, WS_VCMPT); const int e = tid & 127, q = tid >> 7;
#pragma unroll
        for (int i8 = 0; i8 < 4; ++i8) { const LAS float* s = Cs + (32 * q + 8 * i8) * 132 + e;
            u32x4 o; o.x = pk2(s[0], s[132]); o.y = pk2(s[264], s[396]); o.z = pk2(s[528], s[660]); o.w = pk2(s[792], s[924]);
            *(u32x4*)(VC + ((size_t)bg * 128 + e) * 512 + i0 + 32 * q + 8 * i8) = o; }
    }
    __syncthreads();
}
#undef LOADK

constexpr int AL_KT = 0, AL_VT = 17408, AL_KT1 = 35840, AL_UW = 53248, AL_TB = 54272, AL_SM = 60608, AL_PS = 61696, AL_IMP = 78336, AL_VT1 = 111104, AL_END = 129536;
static_assert(AL_KT1 + 17408 <= AL_UW && AL_UW + 128 <= AL_TB && AL_END <= MISC_OFF, "attention LDS map");
DEV int rel_bucket_dev(int n) {
    if (n < 16) return n;
    int k = 16;
    k += (n >= 21); k += (n >= 27); k += (n >= 35); k += (n >= 46); k += (n >= 59); k += (n >= 77); k += (n >= 99); k += (n >= 128);
    k += (n >= 166); k += (n >= 216); k += (n >= 280); k += (n >= 363); k += (n >= 470); k += (n >= 609); k += (n >= 790);
    return k;
}
DEV void attn_fill_bias(Frame& F, int g) {
    LAS float* tb = (LAS float*)(F.lds + AL_TB); const float* rt = F.p->in[I_REL];
    for (int i = F.tid; i < 2 * 792; i += 512) { const int hg = i / 792, d = i - hg * 792; tb[i] = rt[rel_bucket_dev(d) * 4 + 2 * g + hg] * 1.4426950408889634f; }
}
DEV void attn_load_tile(u32x4 (&rk)[2], u32x4 (&rv)[2], const bf16* ksrc, const bf16* vsrc, int vpitch, int tid) {
#pragma unroll
    for (int q = 0; q < 2; ++q) { const int ch = tid + 512 * q; rk[q] = *(const u32x4*)(ksrc + (size_t)ch * 8); rv[q] = *(const u32x4*)(vsrc + (size_t)(ch >> 3) * vpitch + (ch & 7) * 8); }
}
DEV void attn_store_tile(LAS unsigned char* lds, int buf, const u32x4 (&rk)[2], const u32x4 (&rv)[2], int tid) {
    LAS bf16* Kt = (LAS bf16*)(lds + (buf ? AL_KT1 : AL_KT)); LAS bf16* Vt = (LAS bf16*)(lds + (buf ? AL_VT1 : AL_VT));
#pragma unroll
    for (int q = 0; q < 2; ++q) { const int ch = tid + 512 * q; *(LAS u32x4*)(Kt + (ch >> 4) * 136 + (ch & 15) * 8) = rk[q]; *(LAS u32x4*)(Vt + (ch >> 3) * 72 + (ch & 7) * 8) = rv[q]; }
}
template <int MODE, int PATH = 0>
DEV unsigned attn_scores(LAS unsigned char* lds, int buf, const bf16x8 (&qf)[4], int lane, int n0, int tok, int hg, unsigned selbit, f32x4 (&s)[4]) {
    const float zf_ = opaque_zero();
    const LAS bf16* Kt = (const LAS bf16*)(lds + (buf ? AL_KT1 : AL_KT)); const LAS float* tb = (const LAS float*)(lds + AL_TB) + hg * 792;
#pragma unroll
    for (int nt = 0; nt < 4; ++nt) { s[nt] = ZERO4;
#pragma unroll
        for (int ks = 0; ks < 4; ++ks) s[nt] = mfma16(frag_l(Kt, 136, 16 * nt, 32 * ks, lane), qf[ks], s[nt]); }
    if (PATH == 1) {
        const float bf = tb[790]; const bool ok = selbit != 0u;
#pragma unroll
        for (int nt = 0; nt < 4; ++nt)
#pragma unroll
            for (int r = 0; r < 4; ++r) s[nt][r] = ok ? s[nt][r] + bf : -1e30f;
        return ok ? 0xffffu : 0u;
    }
    if (PATH == 2) {
        const bool ok = MODE == 2 ? true : (selbit != 0u);
        const LAS float* tp = tb + (tok - n0 - 4 * (lane >> 4));
#pragma unroll
        for (int nt = 0; nt < 4; ++nt)
#pragma unroll
            for (int r = 0; r < 4; ++r) s[nt][r] = ok ? s[nt][r] + tp[-16 * nt - r] : -1e30f;
        return ok ? 0xffffu : 0u;
    }
    unsigned vm = 0u;
#pragma unroll
    for (int nh = 0; nh < 2; ++nh) {
        float bv[8];
#pragma unroll
        for (int q = 0; q < 8; ++q) { const int nt = 2 * nh + (q >> 2), r = q & 3; const int n = n0 + 16 * nt + 4 * (lane >> 4) + r; const int dist = MODE == 0 ? tok - (16 * n + 31) : tok - n;
            int di = dist < 0 ? 0 : dist; di = di > 790 ? 790 : di; bv[q] = tb[di]; }
#pragma unroll
        for (int q = 0; q < 8; ++q) asm volatile("" : "+v"(bv[q]));
#pragma unroll
        for (int q = 0; q < 8; ++q) { const int nt = 2 * nh + (q >> 2), r = q & 3; const int n = n0 + 16 * nt + 4 * (lane >> 4) + r; int dist; bool ok;
            if (MODE == 0) { dist = tok - (16 * n + 31); ok = dist >= 0 && n < 511; }
            else if (MODE == 1) { dist = tok - n; ok = dist >= 0 && selbit != 0u; }
            else { dist = tok - n; ok = dist >= 0 && dist < 512; }
            s[nt][r] = ok ? s[nt][r] + bv[q] : -1e30f;
            vm |= (ok ? 1u : 0u) << (4 * nt + r); }
    }
    return vm;
}
DEV float fq_max(float v) {
    const auto a = __builtin_amdgcn_permlane16_swap(__builtin_bit_cast(unsigned, v), __builtin_bit_cast(unsigned, v), false, false);
    const float m = fmaxf(__builtin_bit_cast(float, a[0]), __builtin_bit_cast(float, a[1]));
    const auto b = __builtin_amdgcn_permlane32_swap(__builtin_bit_cast(unsigned, m), __builtin_bit_cast(unsigned, m), false, false);
    return fmaxf(__builtin_bit_cast(float, b[0]), __builtin_bit_cast(float, b[1]));
}
DEV float fq_sum(float v) {
    const auto a = __builtin_amdgcn_permlane16_swap(__builtin_bit_cast(unsigned, v), __builtin_bit_cast(unsigned, v), false, false);
    const float m = __builtin_bit_cast(float, a[0]) + __builtin_bit_cast(float, a[1]);
    const auto b = __builtin_amdgcn_permlane32_swap(__builtin_bit_cast(unsigned, m), __builtin_bit_cast(unsigned, m), false, false);
    return __builtin_bit_cast(float, b[0]) + __builtin_bit_cast(float, b[1]);
}
DEV float attn_online(const f32x4 (&s)[4], unsigned vm, float& m, float& l, f32x4 (&p)[4]) {
    float mx = fmaxf(fmaxf(fmaxf(s[0][0], s[0][1]), fmaxf(s[0][2], s[0][3])), fmaxf(fmaxf(s[1][0], s[1][1]), fmaxf(s[1][2], s[1][3])));
    mx = fmaxf(mx, fmaxf(fmaxf(fmaxf(s[2][0], s[2][1]), fmaxf(s[2][2], s[2][3])), fmaxf(fmaxf(s[3][0], s[3][1]), fmaxf(s[3][2], s[3][3]))));
    mx = fmaxf(mx, shx<16>(mx)); mx = fmaxf(mx, shx<32>(mx));
    const float mn = fmaxf(m, mx), sc = __builtin_amdgcn_exp2f(m - mn); float rs = 0.f;
#pragma unroll
    for (int nt = 0; nt < 4; ++nt)
#pragma unroll
        for (int r = 0; r < 4; ++r) { const float pv = ((vm >> (4 * nt + r)) & 1u) ? __builtin_amdgcn_exp2f(s[nt][r] - mn) : 0.f; p[nt][r] = pv; rs += pv; }
    rs += shx<16>(rs); rs += shx<32>(rs);
    l = l * sc + rs; m = mn;
    return sc;
}
DEV void attn_pv(LAS unsigned char* lds, int buf, int lane, const f32x4 (&p)[4], f32x4 (&o)[8]) {
    const LAS bf16* Vt = (const LAS bf16*)(lds + (buf ? AL_VT1 : AL_VT)) + (lane & 15) * 72 + 4 * (lane >> 4);
#pragma unroll
    for (int ks = 0; ks < 2; ++ks) {
        u32x4 pw; pw.x = pg8::cvt_pk_bf16(p[2 * ks][0], p[2 * ks][1]); pw.y = pg8::cvt_pk_bf16(p[2 * ks][2], p[2 * ks][3]); pw.z = pg8::cvt_pk_bf16(p[2 * ks + 1][0], p[2 * ks + 1][1]); pw.w = pg8::cvt_pk_bf16(p[2 * ks + 1][2], p[2 * ks + 1][3]);
        const bf16x8 pb = __builtin_bit_cast(bf16x8, pw);
#pragma unroll
        for (int dt = 0; dt < 8; ++dt) {
            const u32x2 v0 = *(const LAS u32x2*)(Vt + 16 * dt * 72 + 32 * ks), v1 = *(const LAS u32x2*)(Vt + 16 * dt * 72 + 32 * ks + 16);
            u32x4 vw; vw.x = v0.x; vw.y = v0.y; vw.z = v1.x; vw.w = v1.y;
            o[dt] = mfma16(__builtin_bit_cast(bf16x8, vw), pb, o[dt]); }
    }
}
DEV void attn_load_q(Frame& F, int bg, int t0, bf16x8 (&qf)[4]) {
    const bf16* QN = WSP(bf16, WS_QN); const int rho = F.lane & 15;
    const bf16* src = QN + ((size_t)(bg * SEQ + t0 + 8 * F.wave + (rho & 7)) * 2 + (rho >> 3)) * 128 + 8 * (F.lane >> 4);
#pragma unroll
    for (int ks = 0; ks < 4; ++ks) qf[ks] = *(const bf16x8*)(src + 32 * ks);
}

DEV void sel_step(Frame& F, const bf16* KS, const bf16* VS, int j, int jn, int jnn, int qt, int cb, const u32x4 (&st_k)[2], const u32x4 (&st_v)[2], u32x4 (&ld_k)[2], u32x4 (&ld_v)[2],
                  const bf16x8 (&qf)[4], const u32x4& smw, const unsigned (&wum)[4], int tok, int hg, float& m, float& l, f32x4 (&o)[8]) {
    const int lane = F.lane;
    if (jnn <= qt) attn_load_tile(ld_k, ld_v, KS + (size_t)jnn * 64 * 128, VS + (size_t)jnn * 128 * 64, 64, F.tid);
    const unsigned wsel = j < 32 ? wum[0] : (j < 64 ? wum[1] : (j < 96 ? wum[2] : wum[3]));
    if ((wsel >> (j & 31)) & 1u) {
        const unsigned w = j < 32 ? smw.x : (j < 64 ? smw.y : (j < 96 ? smw.z : smw.w)); const unsigned selbit = (w >> (j & 31)) & 1u;
        f32x4 s[4], p[4];
        const unsigned vm = (j <= qt - 14) ? attn_scores<1, 1>(F.lds, cb, qf, lane, 64 * j, tok, hg, selbit, s) : ((j >= qt - 11 && j < qt) ? attn_scores<1, 2>(F.lds, cb, qf, lane, 64 * j, tok, hg, selbit, s) : attn_scores<1, 0>(F.lds, cb, qf, lane, 64 * j, tok, hg, selbit, s));
        const float sc = attn_online(s, vm, m, l, p);
        if (__ballot(sc != 1.0f) != 0ull) {
#pragma unroll
            for (int dt = 0; dt < 8; ++dt) o[dt] = o[dt] * sc; }
        attn_pv(F.lds, cb, lane, p, o);
    }
    if (jn <= qt) attn_store_tile(F.lds, cb ^ 1, st_k, st_v, F.tid);
    __syncthreads();
}
DEV int sel_next(int j, int qt, const unsigned (&um)[4]) {
    int jn = j + 1;
    while (jn <= qt) { const unsigned w = jn < 32 ? um[0] : (jn < 64 ? um[1] : (jn < 96 ? um[2] : um[3])); if ((w >> (jn & 31)) & 1u) break; ++jn; }
    return jn;
}
#define NST(k) do { if (DBG_AJOB >= 10 && F.tid == 0) { volatile LAS unsigned* m_ = (volatile LAS unsigned*)(F.lds + MISC_OFF); const unsigned t_ = (unsigned)__builtin_amdgcn_s_memrealtime(); \
        if (DBG_AJOB == (k)) atomicAdd(WSP(unsigned, WS_CTL) + 460000, t_ - m_[70]); m_[70] = t_; } } while (0)
DEV void nsa_job(Frame& F, int job) {
    const int bg = job >> 7, qt = job & 127, b = bg >> 1, g = bg & 1, t0 = 64 * qt, tid = F.tid, lane = F.lane, wave = F.wave;
    const float zf_ = opaque_zero();
    const int fq = lane >> 4, fr = lane & 15, hg = fr >> 3, tok = t0 + 8 * wave + (fr & 7);
    const float* small = WSP(float, WS_SMALL); const size_t row = (size_t)(b * SEQ + tok);
    LAS float* PS = (LAS float*)(F.lds + AL_PS) + wave * (8 * 65); LAS float* IMP = (LAS float*)(F.lds + AL_IMP);
    LAS unsigned* SM = (LAS unsigned*)(F.lds + AL_SM);
    LAS unsigned* UW = (LAS unsigned*)(F.lds + AL_UW);
    __syncthreads();
    NST(0);
    attn_fill_bias(F, g);
    for (int i = tid; i < 64 * 128; i += 512) IMP[i] = 0.f;
    if (lane < 8) PS[lane * 65] = 0.f;
    bf16x8 qf[4]; attn_load_q(F, bg, t0, qf);
    f32x4 tot[8];
    u32x4 rk[2], rv[2];
    NST(10);
    for (int dr_ = 0; dr_ < (DBG_NSA == 1 ? 2 : 1); ++dr_) {
        if (dr_ == 1) { WAVE_SYNC(); if (lane < 8) PS[lane * 65] = 0.f; WAVE_SYNC(); }
        const int ntiles = (4 * qt + 2) / 64 + 1;
        const bf16* KC = WSP(bf16, WS_KCMP) + (size_t)bg * 512 * 128; const bf16* VC = WSP(bf16, WS_VCMPT) + (size_t)bg * 128 * 512;
        float m = -1e30f, l = 0.f;
        attn_load_tile(rk, rv, KC, VC, 512, tid); attn_store_tile(F.lds, 0, rk, rv, tid); __syncthreads();
        for (int j = 0; j < ntiles; ++j) {
            if (j + 1 < ntiles) attn_load_tile(rk, rv, KC + (size_t)(j + 1) * 64 * 128, VC + (j + 1) * 64, 512, tid);
            f32x4 s[4], p[4];
            const unsigned vm = attn_scores<0>(F.lds, j & 1, qf, lane, 64 * j, tok, hg, 0u, s);
            (void)attn_online(s, vm, m, l, p);
            if (j + 1 < ntiles) attn_store_tile(F.lds, (j + 1) & 1, rk, rv, tid);
            __syncthreads();
        }
        const float il = l > 0.f ? 1.0f / l : 0.f;
        f32x4 o[8];
#pragma unroll
        for (int dt = 0; dt < 8; ++dt) o[dt] = ZERO4;
        attn_load_tile(rk, rv, KC, VC, 512, tid); attn_store_tile(F.lds, 0, rk, rv, tid); __syncthreads();
        for (int j = 0; j < ntiles; ++j) {
            if (j + 1 < ntiles) attn_load_tile(rk, rv, KC + (size_t)(j + 1) * 64 * 128, VC + (j + 1) * 64, 512, tid);
            f32x4 s[4], p[4];
            const unsigned vm = attn_scores<0>(F.lds, j & 1, qf, lane, 64 * j, tok, hg, 0u, s);
#pragma unroll
            for (int nt = 0; nt < 4; ++nt)
#pragma unroll
                for (int r = 0; r < 4; ++r) {
                    const float pv = ((vm >> (4 * nt + r)) & 1u) ? __builtin_amdgcn_exp2f(s[nt][r] - m) * il : 0.f; p[nt][r] = pv;
                    const float ps = pv + shx<8>(pv);
                    if (fr < 8) PS[fr * 65 + 1 + 16 * nt + 4 * fq + r] = ps;
                }
            WAVE_SYNC();
#pragma unroll
            for (int q = 0; q < 2; ++q) { const int idx = lane + 64 * q, tk = idx >> 4, bl = idx & 15; const LAS float* ps = PS + tk * 65 + 4 * bl;
                IMP[(8 * wave + tk) * 128 + 16 * j + bl] = ps[0] + 2.0f * ps[1] + 2.0f * ps[2] + 2.0f * ps[3] + ps[4]; }
            WAVE_SYNC();
            if (lane < 8) PS[lane * 65] = PS[lane * 65 + 64];
            WAVE_SYNC();
            attn_pv(F.lds, j & 1, lane, p, o);
            if (j + 1 < ntiles) attn_store_tile(F.lds, (j + 1) & 1, rk, rv, tid);
            __syncthreads();
        }
        const float gt = (DBG_NSAZ & 1) ? zf_ : sigmoidf_(small[row * SMW + S_BG + (2 * g + hg) * 3 + 0]);
#pragma unroll
        for (int dt = 0; dt < 8; ++dt) tot[dt] = o[dt] * gt;
    }
    NST(11);
    unsigned wum[4] = {0u, 0u, 0u, 0u};
    for (int dr_ = 0; dr_ < (DBG_NSA == 4 ? 2 : 1); ++dr_) {
        const int cur = qt;
        for (int tk = 0; tk < 8; ++tk) {
            const LAS float* rowp = IMP + (8 * wave + tk) * 128;
            const int b0 = lane, b1 = lane + 64;
            const float s0 = b0 > cur ? -1e4f : ((b0 == 0 || b0 >= cur - 1) ? 1e4f : rowp[b0]);
            const float s1 = b1 > cur ? -1e4f : ((b1 == 0 || b1 >= cur - 1) ? 1e4f : rowp[b1]);
            unsigned k0 = __builtin_bit_cast(unsigned, s0), k1 = __builtin_bit_cast(unsigned, s1);
            k0 = (k0 & 0x80000000u) ? ~k0 : (k0 | 0x80000000u); k1 = (k1 & 0x80000000u) ? ~k1 : (k1 | 0x80000000u);
            unsigned prefix = 0u; int need = 16;
            for (int bit = 31; bit >= 0; --bit) {
                const unsigned cand = (prefix | (1u << bit)) >> bit;
                const int cnt = __builtin_popcountll(__ballot((k0 >> bit) == cand)) + __builtin_popcountll(__ballot((k1 >> bit) == cand));
                if (cnt >= need) prefix |= (1u << bit); else need -= cnt;
            }
            const unsigned long long e0 = __ballot(k0 == prefix), e1 = __ballot(k1 == prefix);
            const int r0 = (int)__builtin_amdgcn_mbcnt_hi((unsigned)(e0 >> 32), __builtin_amdgcn_mbcnt_lo((unsigned)e0, 0u));
            const int r1 = __builtin_popcountll(e0) + (int)__builtin_amdgcn_mbcnt_hi((unsigned)(e1 >> 32), __builtin_amdgcn_mbcnt_lo((unsigned)e1, 0u));
            const bool sel0 = k0 > prefix || (k0 == prefix && r0 < need), sel1 = k1 > prefix || (k1 == prefix && r1 < need);
            const unsigned long long m0 = __ballot(sel0), m1 = __ballot(sel1);
            const unsigned w0 = (unsigned)m0, w1 = (unsigned)(m0 >> 32), w2 = (unsigned)m1, w3 = (unsigned)(m1 >> 32);
            wum[0] |= w0; wum[1] |= w1; wum[2] |= w2; wum[3] |= w3;
            if (lane == 0) { SM[(8 * wave + tk) * 4 + 0] = w0; SM[(8 * wave + tk) * 4 + 1] = w1; SM[(8 * wave + tk) * 4 + 2] = w2; SM[(8 * wave + tk) * 4 + 3] = w3; }
        }
        if (lane == 0) { UW[wave * 4 + 0] = wum[0]; UW[wave * 4 + 1] = wum[1]; UW[wave * 4 + 2] = wum[2]; UW[wave * 4 + 3] = wum[3]; }
    }
    __syncthreads();
    const u32x4 smw = *(const LAS u32x4*)(SM + (8 * wave + (fr & 7)) * 4);
    unsigned um[4];
#pragma unroll
    for (int w = 0; w < 4; ++w) { unsigned v = 0u;
#pragma unroll
        for (int q = 0; q < 8; ++q) v |= UW[q * 4 + w];
        um[w] = __builtin_amdgcn_readfirstlane(v); }
    const bf16* KS = WSP(bf16, WS_KS) + (size_t)bg * SEQ * 128; const bf16* VS = WSP(bf16, WS_VST) + (size_t)bg * 128 * 8192;
    const bf16* KW = WSP(bf16, WS_KW) + (size_t)bg * SEQ * 128; const bf16* VW = WSP(bf16, WS_VWT) + (size_t)bg * 128 * 8192;
    NST(12);
    for (int dr_ = 0; dr_ < (DBG_NSA == 2 ? 2 : 1); ++dr_) {
        float m = -1e30f, l = 0.f; f32x4 o[8];
#pragma unroll
        for (int dt = 0; dt < 8; ++dt) o[dt] = ZERO4;
        u32x4 rk2[2], rv2[2];
        int j = 0, jn = sel_next(0, qt, um), cb = 0;
        attn_load_tile(rk, rv, KS, VS, 64, tid); attn_store_tile(F.lds, 0, rk, rv, tid);
        if (jn <= qt) attn_load_tile(rk, rv, KS + (size_t)jn * 64 * 128, VS + (size_t)jn * 128 * 64, 64, tid);
        __syncthreads();
        while (j <= qt) {
            int jnn = jn <= qt ? sel_next(jn, qt, um) : jn;
            sel_step(F, KS, VS, j, jn, jnn, qt, cb, rk, rv, rk2, rv2, qf, smw, wum, tok, hg, m, l, o);
            cb ^= 1; j = jn; jn = jnn;
            if (j > qt) break;
            jnn = jn <= qt ? sel_next(jn, qt, um) : jn;
            sel_step(F, KS, VS, j, jn, jnn, qt, cb, rk2, rv2, rk, rv, qf, smw, wum, tok, hg, m, l, o);
            cb ^= 1; j = jn; jn = jnn;
        }
        const float gt = ((DBG_NSA == 2 && dr_ == 0) || (DBG_NSAZ & 2)) ? zf_ * l : sigmoidf_(small[row * SMW + S_BG + (2 * g + hg) * 3 + 1]) / l;
#pragma unroll
        for (int dt = 0; dt < 8; ++dt) tot[dt] = tot[dt] + o[dt] * gt;
    }
    NST(13);
    for (int dr_ = 0; dr_ < (DBG_NSA == 3 ? 2 : 1); ++dr_) {
        float m = -1e30f, l = 0.f; f32x4 o[8];
#pragma unroll
        for (int dt = 0; dt < 8; ++dt) o[dt] = ZERO4;
        const int j0 = qt >= 8 ? qt - 8 : 0;
        attn_load_tile(rk, rv, KW + (size_t)j0 * 64 * 128, VW + (size_t)j0 * 128 * 64, 64, tid); attn_store_tile(F.lds, 0, rk, rv, tid); __syncthreads();
        for (int j = j0; j <= qt; ++j) {
            const int cb = (j - j0) & 1;
            if (j + 1 <= qt) attn_load_tile(rk, rv, KW + (size_t)(j + 1) * 64 * 128, VW + (size_t)(j + 1) * 128 * 64, 64, tid);
            f32x4 s[4], p[4];
            const unsigned vm = (j >= qt - 7 && j < qt) ? attn_scores<2, 2>(F.lds, cb, qf, lane, 64 * j, tok, hg, 0u, s) : attn_scores<2, 0>(F.lds, cb, qf, lane, 64 * j, tok, hg, 0u, s);
            const float sc = attn_online(s, vm, m, l, p);
#pragma unroll
            for (int dt = 0; dt < 8; ++dt) o[dt] = o[dt] * sc;
            attn_pv(F.lds, cb, lane, p, o);
            if (j + 1 <= qt) attn_store_tile(F.lds, cb ^ 1, rk, rv, tid);
            __syncthreads();
        }
        const float gt = ((DBG_NSA == 3 && dr_ == 0) || (DBG_NSAZ & 4)) ? zf_ * l : sigmoidf_(small[row * SMW + S_BG + (2 * g + hg) * 3 + 2]) / l;
#pragma unroll
        for (int dt = 0; dt < 8; ++dt) tot[dt] = tot[dt] + o[dt] * gt;
    }
    NST(14);
    {
        bf16* YC = WSP(bf16, WS_YCAT);
#pragma unroll
        for (int dt = 0; dt < 8; ++dt) { const int cidx = (2 * g + hg) * 128 + 16 * dt + 4 * fq;
            f32x4 y = tot[dt]; if (DBG_ZERO & 2) y = ZERO4;
            u32x2 w; w.x = pk2(y[0], y[1]); w.y = pk2(y[2], y[3]); *(u32x2*)(YC + row * 2048 + 512 + cidx) = w; }
    }
    __syncthreads();
    NST(15);
}
#undef NST

DEV void gdn_scan_job(Frame& F, int job) {
    const int bh = job >> 3, sl = job & 7, b = bh >> 2, h = bh & 3, lane = F.lane, wave = F.wave, fq = lane >> 4, fr = lane & 15;
    LAS bf16* St = (LAS bf16*)F.lds;
    LAS bf16* Vn = St + 16 * 136;
    const float* GL = WSP(float, WS_GL); float* GO = WSP(float, WS_GO);
    const float zf_ = opaque_zero();
    __syncthreads();
    for (int i = F.tid; i < 16 * 136 / 2; i += 512) ((LAS unsigned*)St)[i] = 0u;
    f32x4 S = ZERO4;
    const int mt = wave & 3;
    __syncthreads();
    const int o1 = (wave < 4 ? 0 : 8192) + (16 * mt + fr) * 128 + 8 * fq;
    const int oA = 32768 + (16 * mt + fr) * 64 + 8 * fq;
    const int oK = 16384 + (16 * wave + fr) * 64 + 8 * fq;
    const int oU = 24576 + (16 * sl + fr) * 64 + 16 * mt + 4 * fq;
    const bf16* rec = (const bf16*)(F.ws + WS_GW + (size_t)(bh * 128) * GDN_CH_BYTES);
    bf16x8 a1[4], aA[2], aK[2], n1[4], nA[2], nK[2]; u32x2 uu, nu; float gl, ngl;
#define GLOAD(A1, AA, AK, UU, G, c_) do { const bf16* r_ = rec + (size_t)(c_) * (GDN_CH_BYTES / 2); \
        _Pragma("unroll") for (int ks = 0; ks < 4; ++ks) A1[ks] = *(const bf16x8*)(r_ + o1 + 32 * ks); \
        AA[0] = *(const bf16x8*)(r_ + oA); AA[1] = *(const bf16x8*)(r_ + oA + 32); AK[0] = *(const bf16x8*)(r_ + oK); AK[1] = *(const bf16x8*)(r_ + oK + 32); \
        UU = *(const u32x2*)(r_ + oU); G = GL[bh * 128 + (c_)]; } while (0)
    GLOAD(a1, aA, aK, uu, gl, 0);
    for (int c = 0; c < 128; ++c) {
        const int cn = c + 1 < 128 ? c + 1 : c;
        GLOAD(n1, nA, nK, nu, ngl, cn);
        f32x4 d1 = ZERO4;
#pragma unroll
        for (int ks = 0; ks < 4; ++ks) d1 = mfma16(a1[ks], frag_l(St, 136, 0, 32 * ks, lane), d1);
        if (wave < 4) {
            const float v0 = bflo(uu.x) - d1[0], v1 = bfhi(uu.x) - d1[1], v2 = bflo(uu.y) - d1[2], v3 = bfhi(uu.y) - d1[3];
            u32x2 w; w.x = pk2(v0, v1); w.y = pk2(v2, v3);
            *(LAS u32x2*)(Vn + fr * 72 + 16 * mt + 4 * fq) = w;
        }
        LDS_WAIT(); __builtin_amdgcn_s_barrier(); CFENCE();
        const bf16x8 bv0 = frag_l(Vn, 72, 0, 0, lane), bv1 = frag_l(Vn, 72, 0, 32, lane);
        if (wave >= 4) {
            d1 = mfma16(aA[0], bv0, d1); d1 = mfma16(aA[1], bv1, d1);
#pragma unroll
            for (int r = 0; r < 4; ++r) GO[(size_t)(b * SEQ + 64 * c + 16 * mt + 4 * fq + r) * 512 + h * 128 + 16 * sl + fr] = d1[r];
        }
        f32x4 dk = ZERO4;
        dk = mfma16(aK[0], bv0, dk); dk = mfma16(aK[1], bv1, dk);
        S = S * gl + dk;
        { u32x2 w; w.x = pk2(S[0], S[1]); w.y = pk2(S[2], S[3]); *(LAS u32x2*)(St + fr * 136 + 16 * wave + 4 * fq) = w; }
        LDS_WAIT(); __builtin_amdgcn_s_barrier(); CFENCE();
#pragma unroll
        for (int ks = 0; ks < 4; ++ks) a1[ks] = n1[ks];
        aA[0] = nA[0]; aA[1] = nA[1]; aK[0] = nK[0]; aK[1] = nK[1]; uu = nu; gl = ngl;
    }
#undef GLOAD
    __syncthreads();
}

DEV void ssd_scan_part(Frame& F, int part, int nparts) {
    float* __restrict__ SST = WSP(float, WS_SST); const float* __restrict__ SCD = WSP(float, WS_SCD);
    constexpr int PER_B = 16 * 64 * 128;
    for (int e = part * 512 + F.tid; e < 2 * PER_B; e += nparts * 512) {
        const int b = e / PER_B, r = e - b * PER_B, h = r >> 13;
        float* p = SST + (size_t)(b * 64) * PER_B + r; const float* cdp = SCD + (b * 64) * 16 + h;
        float s = 0.f;
#pragma unroll
        for (int hb = 0; hb < 2; ++hb) {
            float v[32], cd[32];
#pragma unroll
            for (int c = 0; c < 32; ++c) { v[c] = p[(size_t)(32 * hb + c) * PER_B]; cd[c] = cdp[(32 * hb + c) * 16]; }
#pragma unroll
            for (int c = 0; c < 32; ++c) { p[(size_t)(32 * hb + c) * PER_B] = s; s = s * cd[c] + v[c]; }
        }
    }
}

DEV void gdn_final_rows(Frame& F, int l, int w0, int nw) {
    const float* GO = WSP(float, WS_GO); const bf16* p1 = WSP(bf16, WS_P1); bf16* YC = WSP(bf16, WS_YCAT); const float* gn = lin(F, I_GNORM, l, 128);
    const int lane = F.lane, dv0 = (lane & 15) * 8;
    float gv[8];
#pragma unroll
    for (int j = 0; j < 8; ++j) gv[j] = gn[dv0 + j];
    for (int row = w0; row < MTOK; row += nw) {
        const f32x4 a = *(const f32x4*)(GO + (size_t)row * 512 + lane * 8), bq = *(const f32x4*)(GO + (size_t)row * 512 + lane * 8 + 4);
        float ss = (a[0] * a[0] + a[1] * a[1]) + (a[2] * a[2] + a[3] * a[3]) + (bq[0] * bq[0] + bq[1] * bq[1]) + (bq[2] * bq[2] + bq[3] * bq[3]);
        ss = sum16(ss);
        const float rs = rsqrtf(ss * (1.0f / 128.0f) + EPS);
        const u32x4 zw = *(const u32x4*)(p1 + (size_t)row * P1W + C_AZ + lane * 8);
        const float z[8] = {bflo(zw.x), bfhi(zw.x), bflo(zw.y), bfhi(zw.y), bflo(zw.z), bfhi(zw.z), bflo(zw.w), bfhi(zw.w)};
        const float o[8] = {a[0], a[1], a[2], a[3], bq[0], bq[1], bq[2], bq[3]};
        float y[8];
#pragma unroll
        for (int j = 0; j < 8; ++j) y[j] = (DBG_ZERO & 1) ? opaque_zero() : o[j] * rs * gv[j] * siluf_(z[j]);
        u32x4 w; w.x = pk2(y[0], y[1]); w.y = pk2(y[2], y[3]); w.z = pk2(y[4], y[5]); w.w = pk2(y[6], y[7]);
        *(u32x4*)(YC + (size_t)row * 2048 + lane * 8) = w;
    }
}

DEV void ssd_out_job(Frame& F, int l, int job) {
    const int b = job >> 7, c = (job >> 1) & 63, g = job & 1, t0 = 128 * c, tid = F.tid, lane = F.lane, wave = F.wave, fq = lane >> 4, fr = lane & 15;
    const bf16* SX = WSP(bf16, WS_SX); const bf16* p1 = WSP(bf16, WS_P1); const float* SDT = WSP(float, WS_SDT); const float* SAC = WSP(float, WS_SAC); const float* SST = WSP(float, WS_SST);
    bf16* YC = WSP(bf16, WS_YCAT); float* RC = WSP(float, WS_SRC);
    const float zf_ = opaque_zero();
    LAS bf16* Cs = (LAS bf16*)F.lds;
    LAS bf16* Bs = Cs + 128 * 136;
    LAS bf16* XdT = Bs + 128 * 136;
    LAS bf16* SiT = XdT + 64 * 136;
    LAS bf16* Pw = SiT + 64 * 136;
    LAS float* acs = (LAS float*)(Pw + 8 * 16 * 136);
    __syncthreads();
    for (int i = tid; i < 2 * 128 * 16; i += 512) { const int v = i >> 11, r = (i >> 4) & 127, c8 = (i & 15) * 8;
        const u32x4 w = *(const u32x4*)(SX + (size_t)(b * SEQ + t0 + r) * 1536 + 1024 + (v ? 256 : 0) + g * 128 + c8);
        *(LAS u32x4*)((v ? Cs : Bs) + r * 136 + c8) = w; }
    for (int i = tid; i < 1024; i += 512) { const size_t row = (size_t)(b * SEQ + t0 + (i >> 3)); acs[i] = SAC[row * 16 + 8 * g + (i & 7)]; }
    __syncthreads();
    f32x4 cb[8];
    {
        bf16x8 ca[4];
#pragma unroll
        for (int ks = 0; ks < 4; ++ks) ca[ks] = frag_l(Cs, 136, 16 * wave, 32 * ks, lane);
#pragma unroll
        for (int nt = 0; nt < 8; ++nt) { cb[nt] = ZERO4;
#pragma unroll
            for (int ks = 0; ks < 4; ++ks) cb[nt] = mfma16(ca[ks], frag_l(Bs, 136, 16 * nt, 32 * ks, lane), cb[nt]); }
    }
    float ssq = 0.f;
    LAS bf16* pw = Pw + wave * 16 * 136;
    const float* dsk = lin(F, I_SD, l, 16);
    const int sp = tid & 7, tp = tid >> 3; const size_t rp0 = (size_t)(b * SEQ + t0 + 2 * tp);
    const size_t rowl = (size_t)(b * SEQ + t0 + 16 * wave + fr);
    u32x4 x0, x1; float d0, d1; f32x4 sv[4];
#define SSD_LOADH(h_) do { x0 = *(const u32x4*)(SX + rp0 * 1536 + (h_) * 64 + 8 * sp); x1 = *(const u32x4*)(SX + (rp0 + 1) * 1536 + (h_) * 64 + 8 * sp); d0 = SDT[rp0 * 16 + (h_)]; d1 = SDT[(rp0 + 1) * 16 + (h_)]; \
        const float* sin_ = SST + ((size_t)((b * 64 + c) * 16 + (h_)) * 64) * 128; _Pragma("unroll") for (int q = 0; q < 4; ++q) sv[q] = *(const f32x4*)(sin_ + (size_t)(tid + 512 * q) * 4); } while (0)
    SSD_LOADH(8 * g);
    for (int hh = 0; hh < 8; ++hh) {
        const int h = 8 * g + hh;
        __syncthreads();
        {
            const unsigned xw0[4] = {x0.x, x0.y, x0.z, x0.w}, xw1[4] = {x1.x, x1.y, x1.z, x1.w};
#pragma unroll
            for (int j = 0; j < 8; ++j) { const float a = ((j & 1) ? bfhi(xw0[j >> 1]) : bflo(xw0[j >> 1])) * d0, bb = ((j & 1) ? bfhi(xw1[j >> 1]) : bflo(xw1[j >> 1])) * d1;
                *(LAS unsigned*)(XdT + (8 * sp + j) * 136 + 2 * tp) = pk2(a, bb); }
#pragma unroll
            for (int q = 0; q < 4; ++q) { const int i = tid + 512 * q, p = i >> 5, n4 = (i & 31) * 4; u32x2 w; w.x = pk2(sv[q][0], sv[q][1]); w.y = pk2(sv[q][2], sv[q][3]); *(LAS u32x2*)(SiT + p * 136 + n4) = w; }
        }
        float al[4];
#pragma unroll
        for (int r = 0; r < 4; ++r) al[r] = acs[(16 * wave + 4 * fq + r) * 8 + hh];
#pragma unroll
        for (int nt = 0; nt < 8; ++nt) { const int s = 16 * nt + fr; const float as = acs[s * 8 + hh];
#pragma unroll
            for (int r = 0; r < 4; ++r) { const int li = 16 * wave + 4 * fq + r; const float v = s <= li ? cb[nt][r] * __expf(al[r] - as) : 0.f; pw[(4 * fq + r) * 136 + s] = (bf16)f2bf(v); } }
        u32x2 xv[4], zv[4];
#pragma unroll
        for (int nt = 0; nt < 4; ++nt) { xv[nt] = *(const u32x2*)(SX + rowl * 1536 + h * 64 + 16 * nt + 4 * fq); zv[nt] = *(const u32x2*)(p1 + rowl * P1W + C_CZ + h * 64 + 16 * nt + 4 * fq); }
        if (hh + 1 < 8) SSD_LOADH(h + 1);
        __syncthreads();
        f32x4 y[4], ys[4];
#pragma unroll
        for (int nt = 0; nt < 4; ++nt) { y[nt] = ZERO4; ys[nt] = ZERO4; }
#pragma unroll
        for (int ks = 0; ks < 4; ++ks) { const bf16x8 pa = frag_l(pw, 136, 0, 32 * ks, lane), cc = frag_l(Cs, 136, 16 * wave, 32 * ks, lane);
#pragma unroll
            for (int nt = 0; nt < 4; ++nt) { y[nt] = mfma16(frag_l(XdT, 136, 16 * nt, 32 * ks, lane), pa, y[nt]); ys[nt] = mfma16(frag_l(SiT, 136, 16 * nt, 32 * ks, lane), cc, ys[nt]); } }
        const float dh = dsk[h], ea = __expf(acs[(16 * wave + fr) * 8 + hh]);
#pragma unroll
        for (int nt = 0; nt < 4; ++nt) {
            const float xs[4] = {bflo(xv[nt].x), bfhi(xv[nt].x), bflo(xv[nt].y), bfhi(xv[nt].y)}, zz[4] = {bflo(zv[nt].x), bfhi(zv[nt].x), bflo(zv[nt].y), bfhi(zv[nt].y)};
            float v[4];
#pragma unroll
            for (int r = 0; r < 4; ++r) { v[r] = (DBG_ZERO & 4) ? zf_ : (y[nt][r] + ea * ys[nt][r] + xs[r] * dh) * siluf_(zz[r]); ssq += v[r] * v[r]; }
            u32x2 w; w.x = pk2(v[0], v[1]); w.y = pk2(v[2], v[3]); *(u32x2*)(YC + rowl * 2048 + 1024 + h * 64 + 16 * nt + 4 * fq) = w;
        }
    }
#undef SSD_LOADH
    { float s = ssq; s += shx<16>(s); s += shx<32>(s); if (fq == 0) RC[rowl * 2 + g] = rsqrtf(s * (1.0f / 512.0f) + EPS); }
    __syncthreads();
}

constexpr int NPH = 12;
#ifndef CPU_EMU
DEV unsigned long long launder64(unsigned long long v) {
    unsigned lo = __builtin_amdgcn_readfirstlane((unsigned)v), hi = __builtin_amdgcn_readfirstlane((unsigned)(v >> 32));
    asm volatile("" : "+s"(lo), "+s"(hi));
    return ((unsigned long long)hi << 32) | lo;
}
DEV bool phase_begin(Frame& F, const Params& prm, int wave0) {
    F.ws = (unsigned char*)launder64((unsigned long long)prm.ws);
    F.p = (KParams)launder64((unsigned long long)__builtin_amdgcn_kernarg_segment_ptr());
    unsigned z = 0u; asm volatile("" : "+v"(z)); const int ln = (int)__builtin_amdgcn_mbcnt_hi(~0u, __builtin_amdgcn_mbcnt_lo(~0u, z));
    int wv = wave0; asm volatile("" : "+s"(wv)); F.wave = wv; F.lane = ln; F.tid = wv * 64 + ln;
    int bi = __builtin_amdgcn_readfirstlane(blockIdx.x); asm volatile("" : "+s"(bi)); F.bid = bi;
    int gg = __builtin_amdgcn_readfirstlane(gridDim.x); asm volatile("" : "+s"(gg)); F.G = gg;
    unsigned la = __builtin_amdgcn_readfirstlane((unsigned)(size_t)F.lds); asm volatile("" : "+s"(la)); F.lds = (LAS unsigned char*)(size_t)la;
    return true;
}
DEV void job_begin(Frame& F) { int t = F.tid; asm volatile("" : "+v"(t)); F.tid = t; F.lane = t & 63; }
__global__ void __launch_bounds__(512, 2) hybrid_fwd(Params prm) {
    extern __shared__ __attribute__((aligned(16))) unsigned char lds_raw[];
    Frame F;
    F.lds = (LAS unsigned char*)lds_raw; F.tid = threadIdx.x; F.lane = F.tid & 63; F.wave = __builtin_amdgcn_readfirstlane(F.tid >> 6);
    const int wave0 = F.wave;
    F.G = gridDim.x; F.bid = blockIdx.x; F.p = (KParams)__builtin_amdgcn_kernarg_segment_ptr(); F.ws = prm.ws;
    volatile LAS unsigned* MISC = (volatile LAS unsigned*)(F.lds + MISC_OFF);
    if (F.tid < 64) MISC[F.tid] = 0u;
    if (DBG_TMASK && F.tid < 8) MISC[64 + F.tid] = 0u;
    __syncthreads();
    unsigned* ctl = (unsigned*)(F.ws + WS_CTL);
    XcdBarrier bar; bar.bar = ctl + CW_BAR; bar.x = 0; bar.st = nullptr;
    if (prm.use_bar) bar = xcd_barrier_post(ctl + CW_BAR, MISC + 8);
    const int lo = prm.lo, hi = prm.hi;
    for (int l = 0; l < DEPTH; ++l) {
#define IN(k) (lo <= l * NPH + (k) && l * NPH + (k) < hi && phase_begin(F, prm, wave0))
#define REP_BEGIN(k) for (int rep_ = 0; rep_ < ((DBG_REP == (k)) ? 2 : 1); ++rep_) {
#define REP_END(k) if (DBG_REP == (k) && rep_ == 0) { XcdBarrier bb_ = bar; bb_.bar = (unsigned*)launder64((unsigned long long)bar.bar); xcd_barrier(bb_); } }
#define SEAM(k) do { if (l * NPH + (k) + 1 < hi && prm.use_bar) { XcdBarrier bb_ = bar; bb_.bar = (unsigned*)launder64((unsigned long long)bar.bar); { unsigned x_ = __builtin_amdgcn_readfirstlane(bar.x); asm volatile("" : "+s"(x_)); bb_.x = x_; } xcd_barrier(bb_); } } while (0)
#define TB(k) do { if (((DBG_TMASK >> (k)) & 1) && F.bid == 0 && F.tid == 0) { volatile LAS unsigned* m_ = (volatile LAS unsigned*)(F.lds + MISC_OFF); m_[64] = (unsigned)__builtin_amdgcn_s_memrealtime(); m_[68] = 1u; } } while (0)
#define TE(k) do { if (((DBG_TMASK >> (k)) & 1) && F.bid == 0 && F.tid == 0) { volatile LAS unsigned* m_ = (volatile LAS unsigned*)(F.lds + MISC_OFF); if (!DBG_TEPI) m_[66] = m_[66] + ((unsigned)__builtin_amdgcn_s_memrealtime() - m_[64]); m_[68] = 0u; } } while (0)
#define JT(ty, call) do { if (DBG_AJOB == (ty) && F.tid == 0) { volatile LAS unsigned* m_ = (volatile LAS unsigned*)(F.lds + MISC_OFF); m_[70] = (unsigned)__builtin_amdgcn_s_memrealtime(); } \
        call; if (DBG_AJOB == (ty) && F.tid == 0) { volatile LAS unsigned* m_ = (volatile LAS unsigned*)(F.lds + MISC_OFF); atomicAdd(WSP(unsigned, WS_CTL) + 460000, (unsigned)__builtin_amdgcn_s_memrealtime() - m_[70]); } } while (0)
#define RSB(i) (WSP(unsigned long long, WS_CTL) + CW_RS / 2 + (size_t)(3 * l + (i)) * MTOK)
#define XB WSP(bf16, WS_XB)
#define ACT WSP(bf16, WS_ACT)
        if (IN(0)) { TB(0); REP_BEGIN(0) phase_convert(F, l); REP_END(0) SEAM(0); TE(0); }
        if (IN(1)) { TB(1); REP_BEGIN(1) pg8::Gemm g{XB, WSP(bf16, WS_WUP1), MTOK, NUP, DM, DM, DM}; pg8::StaticOrder S; S.init(MTOK, NUP, F.G, F.bid);
            pg8::EpiSwiGLU E{ACT, RSB(0)}; pg8::gemm_phase<pg8::EpiSwiGLU, pg8::StaticOrder>(F.lds, F.tid, g, S, E); REP_END(1) SEAM(1); TE(1); }
        if (IN(2)) { TB(2); pg8::Gemm g{ACT, WSP(bf16, WS_WDN1), MTOK, DM, DFF, DFF, DFF}; pg8::StaticOrder S; S.init(MTOK, DM, F.G, F.bid, 4);
            pg8::EpiResidual E{nullptr, XB, RSB(1), 0.5f}; pg8::gemm_phase<pg8::EpiResidual, pg8::StaticOrder>(F.lds, F.tid, g, S, E); SEAM(2); TE(2); }
        if (IN(3)) { TB(3); REP_BEGIN(3) pg8::Gemm g{XB, WSP(bf16, WS_WIN), MTOK, NINP, DM, DM, DM}; pg8::StaticOrder S; S.init(MTOK, NINP, F.G, F.bid);
            pg8::EpiWin E{WSP(bf16, WS_P1), WSP(float, WS_SMALL), WSP(bf16, WS_GATE), RSB(1)}; pg8::gemm_phase<pg8::EpiWin, pg8::StaticOrder>(F.lds, F.tid, g, S, E); REP_END(3) SEAM(3); TE(3); }
        if (IN(4)) { TB(4);
            REP_BEGIN(4)
            {
                unsigned* ctr = WSP(unsigned, WS_CTL) + CW_WQ + 64 * (8 + l * 2 + rep_);
                LAS unsigned* jslot = (LAS unsigned*)(F.lds + MISC_OFF + 128);
                for (;;) {
                    __syncthreads();
                    if (F.tid == 0) *jslot = __hip_atomic_fetch_add(ctr, 1u, __ATOMIC_RELAXED, __HIP_MEMORY_SCOPE_AGENT);
                    __syncthreads();
                    const int j = (int)*jslot;
                    if (j >= 32 + 1024 + 256 + 512) break;
                    job_begin(F);
                    if (j < 32) JT(1, nsa_compress_job(F, l, j));
                    else if (j < 32 + 256) JT(2, ssd_prep_job(F, l, j - 32));
                    else if (j < 32 + 256 + 1024) JT(3, gdn_prep_job(F, l, j - 32 - 256));
                    else JT(4, nsa_prep_job(F, l, j - 32 - 256 - 1024));
                }
            }
            REP_END(4)
            SEAM(4); TE(4);
        }
        if (IN(5)) { TB(5);
            REP_BEGIN(5)
            if (F.bid < 64) JT(6, gdn_scan_job(F, (F.bid & 7) * 8 + (F.bid >> 3)));
            {
                unsigned* ctr = WSP(unsigned, WS_CTL) + CW_WQ + 64 * (16 + (l * 2 + rep_) * 8);
                LAS unsigned* jslot = (LAS unsigned*)(F.lds + MISC_OFF + 128);
                const unsigned myq = xb_xcc_id() & 7u;
                for (;;) {
                    __syncthreads();
                    if (F.tid == 0) {
                        unsigned got = 0xffffffffu;
                        for (unsigned t = 0; t < 8u && got == 0xffffffffu; ++t) { const unsigned q = (myq + t) & 7u;
                            if (__hip_atomic_load(ctr + 64 * q, __ATOMIC_RELAXED, __HIP_MEMORY_SCOPE_AGENT) >= 64u) continue;
                            const unsigned k = __hip_atomic_fetch_add(ctr + 64 * q, 1u, __ATOMIC_RELAXED, __HIP_MEMORY_SCOPE_AGENT);
                            if (k < 64u) { const unsigned kk = k < 8u ? 63u - k : k - 8u;
                                got = (q >> 1) * 128u + (127u - (2u * kk + (q & 1u))); } }
                        *jslot = got;
                    }
                    __syncthreads();
                    const unsigned j = *jslot;
                    if (j == 0xffffffffu) break;
                    job_begin(F);
                    JT(5, nsa_job(F, (int)j));
                }
                if (rep_ == 0) {
                    unsigned* ctr2 = WSP(unsigned, WS_CTL) + CW_WQ + 64 * (80 + l);
                    for (;;) {
                        __syncthreads();
                        if (F.tid == 0) *jslot = __hip_atomic_fetch_add(ctr2, 1u, __ATOMIC_RELAXED, __HIP_MEMORY_SCOPE_AGENT);
                        __syncthreads();
                        const unsigned s = *jslot;
                        if (s >= 512u) break;
                        JT(7, ssd_scan_part(F, (int)s, 512));
                    }
                }
            }
            REP_END(5)
            SEAM(5); TE(5);
        }
        if (IN(7)) { TB(7);
            REP_BEGIN(7)
            for (int j = F.bid; j < 256; j += F.G) { job_begin(F); JT(8, ssd_out_job(F, l, j)); }
            job_begin(F);
            JT(9, gdn_final_rows(F, l, F.bid * 8 + F.wave, F.G * 8));
            REP_END(7)
            SEAM(7); TE(7);
        }
        if (IN(8)) { TB(8); REP_BEGIN(8) pg8::Gemm g{WSP(bf16, WS_YCAT), WSP(bf16, WS_WPM), MTOK, DM, 512, DM, DM}; pg8::SegOrder S; S.init(MTOK, DM, F.G, F.bid, 512);
            pg8::EpiMergeSeg E{WSP(bf16, WS_MERGED), WSP(bf16, WS_GATE), WSP(float, WS_SRC)}; pg8::gemm_phase<pg8::EpiMergeSeg, pg8::SegOrder>(F.lds, F.tid, g, S, E); REP_END(8) SEAM(8); TE(8); }
        if (IN(9)) { TB(9); pg8::Gemm g{WSP(bf16, WS_MERGED), WSP(bf16, WS_WO), MTOK, DM, DM, DM, DM}; pg8::StaticOrder S; S.init(MTOK, DM, F.G, F.bid, 4);
            pg8::EpiResidual E{nullptr, XB, RSB(2), 1.0f}; pg8::gemm_phase<pg8::EpiResidual, pg8::StaticOrder>(F.lds, F.tid, g, S, E); SEAM(9); TE(9); }
        if (IN(10)) { TB(10); pg8::Gemm g{XB, WSP(bf16, WS_WUP2), MTOK, NUP, DM, DM, DM}; pg8::StaticOrder S; S.init(MTOK, NUP, F.G, F.bid);
            pg8::EpiSwiGLU E{ACT, RSB(2)}; pg8::gemm_phase<pg8::EpiSwiGLU, pg8::StaticOrder>(F.lds, F.tid, g, S, E); SEAM(10); TE(10); }
        if (IN(11)) { TB(11); pg8::Gemm g{ACT, WSP(bf16, WS_WDN2), MTOK, DM, DFF, DFF, DFF}; pg8::StaticOrder S; S.init(MTOK, DM, F.G, F.bid, 4);
            pg8::EpiResidual E{l == DEPTH - 1 ? prm.out : nullptr, XB, RSB(3), 0.5f}; pg8::gemm_phase<pg8::EpiResidual, pg8::StaticOrder>(F.lds, F.tid, g, S, E); SEAM(11); TE(11); }
#undef IN
#undef SEAM
#undef TB
#undef JT
#undef TE
#undef REP_BEGIN
#undef REP_END
#undef RSB
#undef XB
#undef ACT
    }
    if (DBG_AJOB) {
        XcdBarrier bb_ = bar; bb_.bar = (unsigned*)launder64((unsigned long long)bar.bar); xcd_barrier(bb_);
        if (blockIdx.x == 0 && wave0 == 0 && __builtin_amdgcn_mbcnt_hi(~0u, __builtin_amdgcn_mbcnt_lo(~0u, 0u)) == 0u) {
            const unsigned a_ = __hip_atomic_load((unsigned*)(prm.ws + WS_CTL) + 460000, __ATOMIC_RELAXED, __HIP_MEMORY_SCOPE_AGENT); const unsigned t0_ = (unsigned)__builtin_amdgcn_s_memrealtime();
            while ((unsigned)__builtin_amdgcn_s_memrealtime() - t0_ < a_ / 32u) __builtin_amdgcn_s_sleep(32);
        }
    }
    if (DBG_TMASK && blockIdx.x == 0 && wave0 == 0 && __builtin_amdgcn_mbcnt_hi(~0u, __builtin_amdgcn_mbcnt_lo(~0u, 0u)) == 0u) {
        volatile LAS unsigned* m_ = (volatile LAS unsigned*)(F.lds + MISC_OFF); const unsigned a_ = m_[66]; const unsigned t0_ = (unsigned)__builtin_amdgcn_s_memrealtime();
        while ((unsigned)__builtin_amdgcn_s_memrealtime() - t0_ < (unsigned)DBG_TAMP * a_) __builtin_amdgcn_s_sleep(32);
    }
}

#ifndef DBG_DUMP
#define DBG_DUMP 0
#endif
#ifndef DBG_STOP
#define DBG_STOP 48
#endif
__global__ void dbg_dump_bf16(const unsigned short* src, size_t n, float* out, size_t nout) {
    for (size_t i = (size_t)blockIdx.x * blockDim.x + threadIdx.x; i < nout; i += (size_t)gridDim.x * blockDim.x) { float s = 0.f; for (size_t k = i; k < n; k += nout) s += __builtin_bit_cast(float, (unsigned)src[k] << 16); out[i] = s; }
}
__global__ void dbg_dump_f32(const float* src, size_t n, float* out, size_t nout) {
    for (size_t i = (size_t)blockIdx.x * blockDim.x + threadIdx.x; i < nout; i += (size_t)gridDim.x * blockDim.x) { float s = 0.f; for (size_t k = i; k < n; k += nout) s += src[k]; out[i] = s; }
}
#ifndef N_LAUNCH_MODE
#define N_LAUNCH_MODE 0
#endif
extern "C" void kernel_launch(void* const* d_in, const int* in_sizes, int n_in, void* d_out, int out_size, void* d_ws, size_t ws_size, hipStream_t stream) {
    static int grid = 0;
    if (grid == 0) {
        if (n_in != 30 || out_size != MTOK * DM || ws_size < WS_END) { fprintf(stderr, "kernel_launch: unexpected shapes (n_in %d out %d ws %zu, need %zu)\n", n_in, out_size, ws_size, (size_t)WS_END); grid = -1; return; }
        int dev = 0, cus = 0, per_cu = 0;
        if (hipGetDevice(&dev) != hipSuccess || hipDeviceGetAttribute(&cus, hipDeviceAttributeMultiprocessorCount, dev) != hipSuccess) { grid = -1; return; }
        if (hipFuncSetAttribute((const void*)hybrid_fwd, hipFuncAttributeMaxDynamicSharedMemorySize, LDS_BYTES) != hipSuccess) { fprintf(stderr, "kernel_launch: hipFuncSetAttribute failed\n"); grid = -1; return; }
        if (hipOccupancyMaxActiveBlocksPerMultiprocessor(&per_cu, (const void*)hybrid_fwd, 512, LDS_BYTES) != hipSuccess || per_cu < 1) { fprintf(stderr, "kernel_launch: occupancy query says %d\n", per_cu); }
        (void)hipGetLastError();
        grid = cus;
    }
    if (grid < 0) return;
    (void)hipMemsetAsync((char*)d_ws + WS_CTL, 0, CTL_BYTES, stream);
    Params p{};
    for (int i = 0; i < 30; ++i) p.in[i] = (const float*)d_in[i];
    p.out = (float*)d_out; p.ws = (unsigned char*)d_ws; p.pad = 0;
    if (N_LAUNCH_MODE == 0) { p.lo = 0; p.hi = DEPTH * NPH; p.use_bar = 1; hipLaunchKernelGGL(hybrid_fwd, dim3(grid), dim3(512), LDS_BYTES, stream, p); }
    else { for (int ph = 0; ph < (DBG_DUMP ? DBG_STOP : DEPTH * NPH); ++ph) { p.lo = ph; p.hi = ph + 1; p.use_bar = 0; hipLaunchKernelGGL(hybrid_fwd, dim3(grid), dim3(512), LDS_BYTES, stream, p); } }
    if (DBG_DUMP) {
        const size_t nout = (size_t)MTOK * DM; char* w = (char*)d_ws;
        if (DBG_DUMP == 1) hipLaunchKernelGGL(dbg_dump_bf16, dim3(2048), dim3(256), 0, stream, (const unsigned short*)(w + WS_P1), (size_t)MTOK * P1W, (float*)d_out, nout);
        if (DBG_DUMP == 2) hipLaunchKernelGGL(dbg_dump_f32, dim3(2048), dim3(256), 0, stream, (const float*)(w + WS_SMALL), (size_t)MTOK * SMW, (float*)d_out, nout);
        if (DBG_DUMP == 3) hipLaunchKernelGGL(dbg_dump_bf16, dim3(2048), dim3(256), 0, stream, (const unsigned short*)(w + WS_GW), (size_t)1024 * GDN_CH_BYTES / 2, (float*)d_out, nout);
        if (DBG_DUMP == 4) hipLaunchKernelGGL(dbg_dump_f32, dim3(2048), dim3(256), 0, stream, (const float*)(w + WS_SST), (size_t)2 * 64 * 16 * 64 * 128, (float*)d_out, nout);
        if (DBG_DUMP == 5) hipLaunchKernelGGL(dbg_dump_f32, dim3(2048), dim3(256), 0, stream, (const float*)(w + WS_GO), (size_t)MTOK * 512, (float*)d_out, nout);
        if (DBG_DUMP == 6) hipLaunchKernelGGL(dbg_dump_bf16, dim3(2048), dim3(256), 0, stream, (const unsigned short*)(w + WS_YCAT), (size_t)MTOK * 2048, (float*)d_out, nout);
        if (DBG_DUMP == 7) hipLaunchKernelGGL(dbg_dump_bf16, dim3(2048), dim3(256), 0, stream, (const unsigned short*)(w + WS_MERGED), (size_t)MTOK * 2048, (float*)d_out, nout);
        if (DBG_DUMP == 8) hipLaunchKernelGGL(dbg_dump_bf16, dim3(2048), dim3(256), 0, stream, (const unsigned short*)(w + WS_SX), (size_t)MTOK * 1536, (float*)d_out, nout);
        if (DBG_DUMP == 9) hipLaunchKernelGGL(dbg_dump_bf16, dim3(2048), dim3(256), 0, stream, (const unsigned short*)(w + WS_GATE), (size_t)MTOK * 6144, (float*)d_out, nout);
        if (DBG_DUMP == 11) hipLaunchKernelGGL(dbg_dump_f32, dim3(2048), dim3(256), 0, stream, (const float*)(w + WS_SRC), (size_t)MTOK * 2, (float*)d_out, nout);
        if (DBG_DUMP == 12) hipLaunchKernelGGL(dbg_dump_bf16, dim3(2048), dim3(256), 0, stream, (const unsigned short*)(w + WS_WPM), (size_t)DM * DM, (float*)d_out, nout);
        if (DBG_DUMP == 13) hipLaunchKernelGGL(dbg_dump_f32, dim3(2048), dim3(256), 0, stream, (const float*)(w + WS_MTMP), (size_t)MTOK * DM, (float*)d_out, nout);
        if (DBG_DUMP == 15) hipLaunchKernelGGL(dbg_dump_bf16, dim3(2048), dim3(256), 0, stream, (const unsigned short*)(w + WS_ACT), (size_t)MTOK * DFF, (float*)d_out, nout);
        if (DBG_DUMP == 16) hipLaunchKernelGGL(dbg_dump_bf16, dim3(2048), dim3(256), 0, stream, (const unsigned short*)(w + WS_XB), (size_t)MTOK * DM, (float*)d_out, nout);
        if (DBG_DUMP == 17) hipLaunchKernelGGL(dbg_dump_bf16, dim3(2048), dim3(256), 0, stream, (const unsigned short*)(w + WS_WIN), (size_t)NINP * DM, (float*)d_out, nout);
        if (DBG_DUMP == 18) hipLaunchKernelGGL(dbg_dump_f32, dim3(2048), dim3(256), 0, stream, (const float*)(w + WS_CTL) + CW_RS, (size_t)NRS * MTOK, (float*)d_out, nout);
        if (DBG_DUMP == 10) hipLaunchKernelGGL(dbg_dump_f32, dim3(2048), dim3(256), 0, stream, (const float*)(w + WS_YB), (size_t)MTOK * 512, (float*)d_out, nout);
    }
}
#endif
```

```cpp
#include <hip/hip_runtime.h>
#include <cstdio>
#include <cstdint>

#ifndef CPU_EMU
#define DEV __device__ __forceinline__
#define LAS __attribute__((address_space(3)))
#define VM_WAIT() asm volatile("s_waitcnt vmcnt(0)" ::: "memory")
#define LDS_WAIT() asm volatile("s_waitcnt lgkmcnt(0)" ::: "memory")
#define CFENCE() asm volatile("" ::: "memory")
#define WAVE_SYNC() do { asm volatile("" ::: "memory"); __builtin_amdgcn_wave_barrier(); asm volatile("" ::: "memory"); } while (0)
#endif

#define DBG_DUMP 0
#define DBG_NSAZ 0
#define DBG_NSA 0
#define DBG_REP (-1)
#define DBG_STOP 48
#define DBG_TMASK 0
#define DBG_TAMP 8
#define DBG_AJOB 0
#define DBG_TEPI 0
#ifndef DBG_ZERO
#define DBG_ZERO 0
#endif
typedef unsigned short bf16;
#define GAS __attribute__((address_space(1)))
template <class T> __device__ __forceinline__ T* as_global(T* p) { return (T*)(GAS T*)(unsigned long long)p; }
typedef short bf16x8 __attribute__((ext_vector_type(8)));
typedef float f32x4 __attribute__((ext_vector_type(4)));
typedef float f32x2 __attribute__((ext_vector_type(2)));
typedef unsigned u32x4 __attribute__((ext_vector_type(4)));
typedef unsigned u32x2 __attribute__((ext_vector_type(2)));

constexpr int BATCH = 2, SEQ = 8192, DM = 2048, DEPTH = 4, DFF = 5504, NUP = 2 * DFF;
constexpr int MTOK = BATCH * SEQ;
constexpr int NIN = 12836, NINP = 13056;
constexpr int P1W = 6656;
constexpr int SM0 = 6656;
constexpr int GT0 = 6912;
constexpr float EPS = 1e-6f;
constexpr int C_AQ = 0, C_AK = 512, C_AV = 1024, C_AZ = 1536, C_BQ = 2048, C_BKC = 2560, C_BVC = 2816, C_BKS = 3072, C_BVS = 3328, C_BKW = 3584, C_BVW = 3840, C_CZ = 4096, C_CX = 5120;
constexpr int S_AA = 0, S_AB = 4, S_BG = 8, S_DT = 20, SMW = 64;

constexpr size_t MiB = 1u << 20;
constexpr size_t WS_CTL = 0, CTL_BYTES = 2 * MiB;
constexpr size_t WS_WUP1 = 2 * MiB;
constexpr size_t WS_WDN1 = WS_WUP1 + (size_t)NUP * DM * 2;
constexpr size_t WS_WIN = WS_WDN1 + (size_t)DM * DFF * 2;
constexpr size_t WS_WPM = WS_WIN + (size_t)NINP * DM * 2;
constexpr size_t WS_WO = WS_WPM + (size_t)DM * DM * 2;
constexpr size_t WS_WUP2 = WS_WO + (size_t)DM * DM * 2;
constexpr size_t WS_WDN2 = WS_WUP2 + (size_t)NUP * DM * 2;
constexpr size_t WS_WCK = WS_WDN2 + (size_t)DM * DFF * 2;
constexpr size_t WS_WCV = WS_WCK + 128 * 4096 * 2;
constexpr size_t WS_CONST = WS_WCV + 128 * 4096 * 2;
constexpr size_t WS_WEND = WS_CONST + 4096;
static_assert(WS_WEND <= 212 * MiB, "weights region");
constexpr size_t WS_XB = 212 * MiB;
constexpr size_t WS_P1 = 276 * MiB;
constexpr size_t WS_ACT = WS_P1;
constexpr size_t WS_GATE = 484 * MiB;
constexpr size_t WS_SMALL = 676 * MiB;
constexpr size_t WS_MERGED = 680 * MiB;
constexpr size_t WS_YCAT = 744 * MiB;
constexpr size_t WS_GW = 808 * MiB;
constexpr size_t GDN_CH_BYTES = 73728;
constexpr size_t WS_GL = 880 * MiB;
constexpr size_t WS_GO = 881 * MiB;
constexpr size_t WS_SX = 913 * MiB;
constexpr size_t WS_SDT = 961 * MiB;
constexpr size_t WS_SAC = 962 * MiB;
constexpr size_t WS_SST = 963 * MiB;
constexpr size_t WS_SCD = 1027 * MiB;
constexpr size_t WS_SRC = 1028 * MiB;
constexpr size_t WS_QN = 1029 * MiB;
constexpr size_t WS_KS = 1045 * MiB;
constexpr size_t WS_KW = 1053 * MiB;
constexpr size_t WS_VST = 1061 * MiB;
constexpr size_t WS_VWT = 1069 * MiB;
constexpr size_t WS_KCMP = 1077 * MiB;
constexpr size_t WS_VCMPT = 1078 * MiB;
constexpr size_t WS_SELM = 1079 * MiB;
constexpr size_t WS_YB = 1080 * MiB;
constexpr size_t WS_MTMP = 1112 * MiB;
constexpr size_t WS_END = 1240 * MiB;
static_assert(WS_P1 + (size_t)MTOK * P1W * 2 <= WS_GATE && WS_GATE + (size_t)MTOK * 6144 * 2 <= WS_SMALL && WS_SMALL + (size_t)MTOK * SMW * 4 <= WS_MERGED && WS_MERGED + (size_t)MTOK * DM * 2 <= WS_YCAT && WS_YCAT + (size_t)MTOK * 2048 * 2 <= WS_GW, "ws map 1");
static_assert(WS_GW + 1024 * GDN_CH_BYTES <= WS_GL && WS_GO + (size_t)MTOK * 512 * 4 <= WS_SX && WS_SX + (size_t)MTOK * 1536 * 2 <= WS_SDT && WS_SDT + (size_t)MTOK * 16 * 4 <= WS_SAC && WS_SAC + (size_t)MTOK * 16 * 4 <= WS_SST && WS_SST + (size_t)2 * 64 * 16 * 64 * 128 * 4 <= WS_SCD, "ws map 2");
static_assert(WS_SRC + (size_t)MTOK * 2 * 4 <= WS_QN && WS_QN + (size_t)4 * SEQ * 256 * 2 <= WS_KS && WS_KS + (size_t)4 * SEQ * 128 * 2 <= WS_KW && WS_KW + (size_t)4 * SEQ * 128 * 2 <= WS_VST && WS_VST + (size_t)4 * SEQ * 128 * 2 <= WS_VWT && WS_VWT + (size_t)4 * SEQ * 128 * 2 <= WS_KCMP, "ws map 3");
static_assert(WS_KCMP + 4 * 512 * 128 * 2 <= WS_VCMPT && WS_VCMPT + 4 * 512 * 128 * 2 <= WS_SELM && WS_SELM + (size_t)4 * SEQ * 16 <= WS_YB && WS_YB + (size_t)MTOK * 512 * 4 <= WS_END && WS_XB + (size_t)MTOK * DM * 2 <= WS_P1 && (size_t)MTOK * DFF * 2 <= (size_t)MTOK * P1W * 2, "ws map 4");

constexpr int CW_BAR = 1024;
constexpr int CW_RS = 16384;
constexpr int NRS = 13;
constexpr int CW_WQ = 8192;
static_assert(CW_RS * 4 + NRS * MTOK * 8 <= (int)CTL_BYTES, "ctl");

constexpr int RING_BYTES = 131072;
constexpr int MISC_OFF = RING_BYTES + 12288;
constexpr int LDS_BYTES = 147456;

DEV unsigned f2bf(float f) { unsigned u = __builtin_bit_cast(unsigned, f); return (u + 0x7fffu + ((u >> 16) & 1u)) >> 16; }
DEV float bf2f(unsigned b) { return __builtin_bit_cast(float, (b & 0xffffu) << 16); }
DEV unsigned pk2(float lo, float hi) { return f2bf(lo) | (f2bf(hi) << 16); }
DEV float bflo(unsigned w) { return __builtin_bit_cast(float, w << 16); }
DEV float bfhi(unsigned w) { return __builtin_bit_cast(float, w & 0xffff0000u); }
DEV float sigmoidf_(float x) { return 1.0f / (1.0f + __expf(-x)); }
DEV float siluf_(float x) { return x / (1.0f + __expf(-x)); }
DEV float softplusf_(float x) {
    const float e = __expf(-fabsf(x)), u = 1.0f + e, d = u - 1.0f;
    const float lp = d == 0.f ? e : __logf(u) * (e / d);
    return fmaxf(x, 0.f) + lp;
}
#ifndef CPU_EMU
template <int M, class T> DEV T shx(T v) {
    static_assert(sizeof(T) == 4, "shx: 32-bit values");
    const int iv = __builtin_bit_cast(int, v);
    if constexpr (M < 32) return __builtin_bit_cast(T, __builtin_amdgcn_ds_swizzle(iv, 0x1f | (M << 10)));
    else { unsigned z = 0u; asm volatile("" : "+v"(z)); const unsigned ln = __builtin_amdgcn_mbcnt_hi(~0u, __builtin_amdgcn_mbcnt_lo(~0u, z));
        return __builtin_bit_cast(T, __builtin_amdgcn_ds_bpermute((int)((ln ^ 32u) << 2), iv)); }
}
#endif
DEV float wave_sum(float v) { v += shx<1>(v); v += shx<2>(v); v += shx<4>(v); v += shx<8>(v); v += shx<16>(v); v += shx<32>(v); return v; }
DEV void wave_sum4(float (&v)[4]) {
#pragma unroll
    for (int q = 0; q < 4; ++q) v[q] += shx<1>(v[q]);
#pragma unroll
    for (int q = 0; q < 4; ++q) v[q] += shx<2>(v[q]);
#pragma unroll
    for (int q = 0; q < 4; ++q) v[q] += shx<4>(v[q]);
#pragma unroll
    for (int q = 0; q < 4; ++q) v[q] += shx<8>(v[q]);
#pragma unroll
    for (int q = 0; q < 4; ++q) v[q] += shx<16>(v[q]);
#pragma unroll
    for (int q = 0; q < 4; ++q) v[q] += shx<32>(v[q]);
}
DEV float sum16(float v) { v += shx<1>(v); v += shx<2>(v); v += shx<4>(v); v += shx<8>(v); return v; }
DEV float max16(float v) { v = fmaxf(v, shx<1>(v)); v = fmaxf(v, shx<2>(v)); v = fmaxf(v, shx<4>(v)); v = fmaxf(v, shx<8>(v)); return v; }
#ifndef CPU_EMU
DEV float opaque_zero() { float z = 0.f; asm volatile("" : "+v"(z)); return z; }
#endif
#define ZERO4 ((f32x4){zf_, zf_, zf_, zf_})
DEV f32x4 mfma16(bf16x8 a, bf16x8 b, f32x4 c) { return __builtin_amdgcn_mfma_f32_16x16x32_bf16(a, b, c, 0, 0, 0); }
DEV bf16x8 frag_g(const bf16* base, int pitch, int row0, int k0, int lane) { return *(const bf16x8*)(base + (size_t)(row0 + (lane & 15)) * pitch + k0 + 8 * (lane >> 4)); }
DEV bf16x8 frag_l(const LAS bf16* base, int pitch, int row0, int k0, int lane) { return *(const LAS bf16x8*)(base + (row0 + (lane & 15)) * pitch + k0 + 8 * (lane >> 4)); }
#ifndef CPU_EMU
DEV const LAS void* lds_vbase(const LAS void* p) { unsigned a = (unsigned)(size_t)p; asm volatile("" : "+v"(a)); return (const LAS void*)(size_t)a; }
#endif

struct Params {
    const float* in[30];
    float* out;
    unsigned char* ws;
    int lo, hi;
    int use_bar, pad;
};
enum { I_X = 0, I_REL, I_GF1, I_WUP1, I_WDN1, I_GMIX, I_WIN, I_GCONV, I_GALOG, I_GDTB, I_GNORM, I_NQN, I_NKN, I_NPEK, I_NPEV, I_NWCK, I_NWCV,
       I_SCW, I_SCB, I_SDTB, I_SALOG, I_SD, I_SNORM, I_PA, I_PB, I_PC, I_WO, I_GF2, I_WUP2, I_WDN2 };

#define XB_TMO      128
#define XB_XCNT(j)  (256  + 64 * (j))
#define XB_XSUB(j)  (1280 + 64 * (j))
#define XB_XGEN(j)  (2304 + 64 * (j))
#define XB_TOP      3328
#define XB_TOPGEN   3392
#define XCD_BAR_WORDS 3456
#define XB_SPIN_CAP (1u << 22)
#ifndef CPU_EMU
DEV unsigned xb_ld(unsigned* p)              { return __hip_atomic_load(p, __ATOMIC_RELAXED, __HIP_MEMORY_SCOPE_AGENT); }
DEV unsigned xb_add(unsigned* p, unsigned v) { return __hip_atomic_fetch_add(p, v, __ATOMIC_RELAXED, __HIP_MEMORY_SCOPE_AGENT); }
DEV unsigned xb_xcc_id() { return (unsigned)__builtin_amdgcn_s_getreg((3 << 11) | 20) & 0xFu; }
#define XB_SPIN(cond, bar) do { unsigned _sp = 0; while (cond) { __builtin_amdgcn_s_sleep(1); \
    if ((++_sp & 255u) == 0u) { if (xb_ld(&(bar)[XB_TMO])) break; if (_sp > XB_SPIN_CAP) { atomicAdd(&(bar)[XB_TMO], 1u); break; } } } } while (0)
struct XcdBarrier { unsigned* bar; unsigned x; volatile LAS unsigned* st; };
DEV XcdBarrier xcd_barrier_post(unsigned* bar, volatile LAS unsigned* st) {
    XcdBarrier b; b.bar = bar; b.x = xb_xcc_id(); b.st = st;
    if (threadIdx.x == 0) (void)xb_add(&bar[XB_XCNT(b.x)], 1u);
    return b;
}
DEV void xcd_barrier_complete(unsigned* bar, unsigned x, unsigned& nloc, unsigned& nx) {
    const unsigned G = gridDim.x * gridDim.y * gridDim.z;
    unsigned sum, cnt, mine, sp = 0u;
    for (;;) {
        sum = 0u; cnt = 0u; mine = 0u;
#pragma unroll
        for (unsigned j = 0; j < 16; ++j) { const unsigned c = xb_ld(&bar[XB_XCNT(j)]); sum += c; cnt += (c > 0u) ? 1u : 0u; mine = (j == x) ? c : mine; }
        if (sum == G) break;
        __builtin_amdgcn_s_sleep(1);
        if ((++sp & 255u) == 0u) { if (xb_ld(&bar[XB_TMO])) break; if (sp > XB_SPIN_CAP) { atomicAdd(&bar[XB_TMO], 1u); break; } }
    }
    nloc = mine > 0u ? mine : 1u; nx = cnt > 0u ? cnt : 1u;
}
DEV void xcd_barrier(const XcdBarrier& b) {
    asm volatile("s_waitcnt vmcnt(0)" ::: "memory");
    __syncthreads();
    if (threadIdx.x == 0) {
        unsigned* bar = b.bar;
        __builtin_amdgcn_s_waitcnt(0);
        unsigned nloc = b.st[0], nx = b.st[1];
        if (nloc == 0u) { xcd_barrier_complete(bar, b.x, nloc, nx); b.st[0] = nloc; b.st[1] = nx; }
        const unsigned old = xb_add(&bar[XB_XSUB(b.x)], 1u);
        const unsigned gen = old / nloc;
        if (old + 1u == (gen + 1u) * nloc) {
            __builtin_amdgcn_fence(__ATOMIC_RELEASE, "agent");
            asm volatile("s_waitcnt vmcnt(0)" ::: "memory");
            const unsigned og = xb_add(&bar[XB_TOP], 1u);
            const unsigned tg = og / nx;
            if (og + 1u == (tg + 1u) * nx) xb_add(&bar[XB_TOPGEN], 1u);
            else XB_SPIN(xb_ld(&bar[XB_TOPGEN]) == tg, bar);
            __builtin_amdgcn_fence(__ATOMIC_ACQUIRE, "agent");
            xb_add(&bar[XB_XGEN(b.x)], 1u);
            asm volatile("s_waitcnt vmcnt(0)" ::: "memory");
        } else {
            XB_SPIN(xb_ld(&bar[XB_XGEN(b.x)]) == gen, bar);
            __builtin_amdgcn_fence(__ATOMIC_ACQUIRE, "agent");
            asm volatile("s_waitcnt vmcnt(0)" ::: "memory");
        }
    }
    __syncthreads();
}
#endif

namespace pg8 {
constexpr int BM = 256, BK = 64, HALF = 128, HTB = HALF * BK * 2, STAGE_BYTES = 8 * HTB, NXCD = 8, WGM = 8;
__host__ __device__ __forceinline__ int lds_byte(int r, int c) { const int st = (r >> 4) * 2 + (c >> 5), rr = r & 15, cc = c & 31, ob = rr * 64 + cc * 2; return st * 1024 + (ob ^ (((ob >> 9) & 1) << 5)); }
__host__ __device__ __forceinline__ void stage_rc(int b, int& R, int& C) { const int st = b / 1024, sb = b % 1024, swz = sb ^ (((sb >> 9) & 1) << 5); R = (st >> 1) * 16 + swz / 64; C = (st & 1) * 32 + (swz % 64) / 2; }
__host__ __device__ __forceinline__ int perm32(int rho) { const int n = rho >> 4, i = rho & 15; return 8 * (i >> 2) + 4 * n + (i & 3); }
struct Unit { int pm, pn, koff, seg; };
struct Gemm { const bf16* A; const bf16* Bt; int M, N, K, lda, ldb; };
struct StaticOrder {
    int nM, nN, nwg, G, c, wgm;
    __host__ __device__ void init(int M, int N, int G_, int c_, int wgm_ = WGM) { nM = M / BM; nN = N / BM; nwg = nM * nN; G = G_; c = c_; wgm = wgm_; }
    __host__ __device__ bool next(int i, Unit& u) const {
        const long L = (long)i * G + c; if (L >= nwg) return false;
        int wgid = (int)L; { const int q = nwg / NXCD, r = nwg % NXCD, xcd = wgid % NXCD, off = wgid / NXCD; wgid = (xcd < r ? xcd * (q + 1) : r * (q + 1) + (xcd - r) * q) + off; }
        const int nig = wgm * nN, gid = wgid / nig, fm = gid * wgm, gsz = (nM - fm) < wgm ? (nM - fm) : wgm;
        u.pm = fm + ((wgid % nig) % gsz); u.pn = (wgid % nig) / gsz; u.koff = 0; u.seg = 0; return true;
    }
};
struct SegOrder {
    StaticOrder S; int kseg;
    __host__ __device__ void init(int M, int N, int G_, int c_, int kseg_) { S.init(M, N, G_, c_); kseg = kseg_; }
    __host__ __device__ bool next(int i, Unit& u) const { if (!S.next(i >> 2, u)) return false; u.seg = i & 3; u.koff = u.seg * kseg; return true; }
};
#ifndef CPU_EMU
DEV unsigned cvt_pk_bf16(float lo, float hi) { unsigned r; asm volatile("s_nop 1\n\tv_cvt_pk_bf16_f32 %0, %1, %2" : "=v"(r) : "v"(lo), "v"(hi)); return r; }
#endif
DEV unsigned long long rss_fix(float ss) { return (unsigned long long)(ss * 16777216.0f + 0.5f); }
DEV float rss_val(unsigned long long v) { return (float)v * (1.0f / 16777216.0f); }

struct EpiSwiGLU {
    static constexpr bool PERM = true, SEGACC = false;
    bf16* act; const unsigned long long* rss;
    DEV void operator()(const f32x4 (&acc)[2][2][4][2], const Unit& u, int wr, int wc, int fr, int fq) const {
        const int row0 = u.pm * BM + wr * 64 + fr, col0 = u.pn * HALF + wc * 32 + 8 * fq;
        unsigned long long rv[8];
#pragma unroll
        for (int i = 0; i < 8; ++i) rv[i] = rss[row0 + (i >> 2) * HALF + (i & 3) * 16];
        CFENCE();
#pragma unroll
        for (int ai = 0; ai < 2; ++ai)
#pragma unroll
            for (int m = 0; m < 4; ++m) {
                const int row = row0 + ai * HALF + m * 16;
                const float rs = rsqrtf(rss_val(rv[ai * 4 + m]) * (1.0f / DM) + EPS);
                float o[8];
#pragma unroll
                for (int n = 0; n < 2; ++n)
#pragma unroll
                    for (int j = 0; j < 4; ++j) { const float a = acc[ai][0][m][n][j] * rs, b = acc[ai][1][m][n][j] * rs; o[4 * n + j] = a * b * __builtin_amdgcn_rcpf(1.0f + __expf(-a)); }
                u32x4 w; w.x = cvt_pk_bf16(o[0], o[1]); w.y = cvt_pk_bf16(o[2], o[3]); w.z = cvt_pk_bf16(o[4], o[5]); w.w = cvt_pk_bf16(o[6], o[7]);
                *(u32x4*)(act + (size_t)row * DFF + col0) = w;
            }
    }
};
struct EpiResidual {
    static constexpr bool PERM = true, SEGACC = false;
    float* out; bf16* xb; unsigned long long* rss_out; float alpha;
    DEV void operator()(const f32x4 (&acc)[2][2][4][2], const Unit& u, int wr, int wc, int fr, int fq) const {
        const int row0 = u.pm * BM + wr * 64 + fr, col0 = u.pn * BM + wc * 32 + 8 * fq;
#pragma unroll
        for (int ai = 0; ai < 2; ++ai) {
            u32x4 xv[4][2];
#pragma unroll
            for (int m = 0; m < 4; ++m)
#pragma unroll
                for (int bj = 0; bj < 2; ++bj) xv[m][bj] = *(const u32x4*)(xb + (size_t)(row0 + ai * HALF + m * 16) * DM + col0 + bj * HALF);
            CFENCE();
#pragma unroll
            for (int m = 0; m < 4; ++m) {
                const int row = row0 + ai * HALF + m * 16; float ss = 0.f;
#pragma unroll
                for (int bj = 0; bj < 2; ++bj) {
                    const u32x4 xw = xv[m][bj];
                    const f32x4 x0 = (f32x4){bflo(xw.x), bfhi(xw.x), bflo(xw.y), bfhi(xw.y)} + acc[ai][bj][m][0] * alpha, x1 = (f32x4){bflo(xw.z), bfhi(xw.z), bflo(xw.w), bfhi(xw.w)} + acc[ai][bj][m][1] * alpha;
                    if (out) { float* xp = out + (size_t)row * DM + col0 + bj * HALF; *(f32x4*)xp = x0; *(f32x4*)(xp + 4) = x1; }
                    ss += (x0[0] * x0[0] + x0[1] * x0[1]) + (x0[2] * x0[2] + x0[3] * x0[3]) + (x1[0] * x1[0] + x1[1] * x1[1]) + (x1[2] * x1[2] + x1[3] * x1[3]);
                    u32x4 w; w.x = cvt_pk_bf16(x0[0], x0[1]); w.y = cvt_pk_bf16(x0[2], x0[3]); w.z = cvt_pk_bf16(x1[0], x1[1]); w.w = cvt_pk_bf16(x1[2], x1[3]);
                    *(u32x4*)(xb + (size_t)row * DM + col0 + bj * HALF) = w;
                }
                ss += shx<16>(ss); ss += shx<32>(ss);
                if (fq == 0) atomicAdd(rss_out + row, rss_fix(ss));
            }
            CFENCE();
        }
    }
};
struct EpiWin {
    static constexpr bool PERM = true, SEGACC = false;
    bf16* p1; float* small; bf16* gate; const unsigned long long* rss;
    DEV void operator()(const f32x4 (&acc)[2][2][4][2], const Unit& u, int wr, int wc, int fr, int fq) const {
        const int row0 = u.pm * BM + wr * 64 + fr, cl0 = wc * 32 + 8 * fq;
        unsigned long long rv[8];
#pragma unroll
        for (int i = 0; i < 8; ++i) rv[i] = rss[row0 + (i >> 2) * HALF + (i & 3) * 16];
        CFENCE();
#pragma unroll
        for (int ai = 0; ai < 2; ++ai)
#pragma unroll
            for (int m = 0; m < 4; ++m) {
                const int row = row0 + ai * HALF + m * 16;
                const float rs = rsqrtf(rss_val(rv[ai * 4 + m]) * (1.0f / DM) + EPS);
#pragma unroll
                for (int bj = 0; bj < 2; ++bj) {
                    f32x4 v0 = acc[ai][bj][m][0] * rs, v1 = acc[ai][bj][m][1] * rs;
                    const int cl = cl0 + bj * HALF;
                    if (u.pn < 26) {
                        u32x4 w; w.x = cvt_pk_bf16(v0[0], v0[1]); w.y = cvt_pk_bf16(v0[2], v0[3]); w.z = cvt_pk_bf16(v1[0], v1[1]); w.w = cvt_pk_bf16(v1[2], v1[3]);
                        *(u32x4*)(p1 + (size_t)row * P1W + u.pn * BM + cl) = w;
                    } else if (u.pn == 26) {
                        if (cl < SMW) { float* sp = small + (size_t)row * SMW + cl; *(f32x4*)sp = v0; *(f32x4*)(sp + 4) = v1; }
                    } else {
#pragma unroll
                        for (int j = 0; j < 4; ++j) { v0[j] = fminf(__builtin_amdgcn_rcpf(1.0f + __expf(-v0[j])), 1.0f); v1[j] = fminf(__builtin_amdgcn_rcpf(1.0f + __expf(-v1[j])), 1.0f); }
                        u32x4 w; w.x = cvt_pk_bf16(v0[0], v0[1]); w.y = cvt_pk_bf16(v0[2], v0[3]); w.z = cvt_pk_bf16(v1[0], v1[1]); w.w = cvt_pk_bf16(v1[2], v1[3]);
                        *(u32x4*)(gate + (size_t)row * 6144 + (u.pn - 27) * BM + cl) = w;
                    }
                }
            }
    }
};
struct EpiMergeSeg {
    static constexpr bool PERM = true, SEGACC = true;
    bf16* merged; const bf16* gate; const float* rc;
    DEV void seg(f32x4 (&acc)[2][2][4][2], const Unit& u, int wr, int wc, int fr, int fq) const {
        const int row0 = u.pm * BM + wr * 64 + fr, col0 = u.pn * BM + wc * 32 + 8 * fq, sg = u.seg;
        f32x2 rcv[8];
#pragma unroll
        for (int i = 0; i < 8; ++i) rcv[i] = *(const f32x2*)(rc + (size_t)(row0 + (i >> 2) * HALF + (i & 3) * 16) * 2);
        const int offa = sg == 0 ? 0 : (sg == 1 ? DM : 2 * DM), offb = sg == 0 ? DM : 2 * DM;
#pragma unroll
        for (int aim = 0; aim < 4; ++aim) {
            const int ai = aim >> 1, m0 = (aim & 1) * 2;
            u32x4 wa[2][2], wb[2][2];
            if (sg != 2) {
#pragma unroll
                for (int mm = 0; mm < 2; ++mm)
#pragma unroll
                    for (int bj = 0; bj < 2; ++bj) { const bf16* gp = gate + (size_t)(row0 + ai * HALF + (m0 + mm) * 16) * 6144 + col0 + bj * HALF; wa[mm][bj] = *(const u32x4*)(gp + offa); wb[mm][bj] = *(const u32x4*)(gp + offb); }
            }
            CFENCE();
#pragma unroll
            for (int mm = 0; mm < 2; ++mm) {
                const int m = m0 + mm, row = row0 + ai * HALF + m * 16;
                const float r0 = rcv[ai * 4 + m][0], r1 = rcv[ai * 4 + m][1];
#pragma unroll
                for (int bj = 0; bj < 2; ++bj) {
                    float f[8];
                    if (sg == 2) { const float q = fmaxf(r0, 1e-20f) / fmaxf(r1, 1e-20f);
#pragma unroll
                        for (int j = 0; j < 8; ++j) f[j] = q; }
                    else {
                        const u32x4 a4 = wa[mm][bj], b4 = wb[mm][bj];
                        const float na[8] = {bflo(a4.x), bfhi(a4.x), bflo(a4.y), bfhi(a4.y), bflo(a4.z), bfhi(a4.z), bflo(a4.w), bfhi(a4.w)};
                        const float nb[8] = {bflo(b4.x), bfhi(b4.x), bflo(b4.y), bfhi(b4.y), bflo(b4.z), bfhi(b4.z), bflo(b4.w), bfhi(b4.w)};
#pragma unroll
                        for (int j = 0; j < 8; ++j) {
                            if (sg == 0) f[j] = fmaxf(na[j], 1e-20f) * __builtin_amdgcn_rcpf(fmaxf(nb[j], 1e-20f));
                            else if (sg == 1) f[j] = fmaxf(na[j], 1e-20f) * __builtin_amdgcn_rcpf(fmaxf(nb[j] * r0, 1e-20f));
                            else f[j] = fmaxf(na[j] * r1, 1e-20f); }
                    }
                    f32x4 v0 = acc[ai][bj][m][0], v1 = acc[ai][bj][m][1];
#pragma unroll
                    for (int j = 0; j < 4; ++j) { v0[j] *= f[j]; v1[j] *= f[4 + j]; }
                    if (sg < 3) { acc[ai][bj][m][0] = v0; acc[ai][bj][m][1] = v1; }
                    else { u32x4 o; o.x = cvt_pk_bf16(v0[0], v0[1]); o.y = cvt_pk_bf16(v0[2], v0[3]); o.z = cvt_pk_bf16(v1[0], v1[1]); o.w = cvt_pk_bf16(v1[2], v1[3]);
                        *(u32x4*)(merged + (size_t)row * DM + col0 + bj * HALF) = o; }
                }
            }
            CFENCE();
        }
    }
};

#ifndef CPU_EMU
template <class Epi, class Sched>
DEV void gemm_phase(LAS unsigned char* lds, const int tid, const Gemm g, const Sched& S, const Epi& E) {
    const int wid = __builtin_amdgcn_readfirstlane(tid >> 6), lane = tid & 63, wr = wid >> 2, wc = wid & 3, fr = lane & 15, fq = lane >> 4;
    const int K = g.K, nt = K / BK;
    const float zf_ = opaque_zero();
    unsigned voffA[2], voffB[2];
#pragma unroll
    for (int i = 0; i < 2; ++i) { int R, C; stage_rc(tid * 16 + i * 8192, R, C); const int Rb = Epi::PERM ? ((R & ~31) + perm32(R & 31)) : R;
        voffA[i] = (unsigned)(R * g.lda + C) * 2u; voffB[i] = (unsigned)(Rb * g.ldb + C) * 2u; }
    const size_t kstep = (size_t)(BK * 2);
    const size_t hA = (size_t)HALF * g.lda * 2, hB = (size_t)HALF * g.ldb * 2;
    const size_t tA = 2 * hA, tB = 2 * hB;
    const unsigned ldsw = (unsigned)wid * 1024u;
    const int aoff = lds_byte(wr * 64 + fr, fq * 8), boff = lds_byte(wc * 32 + fr, fq * 8);
#define PG8_SA(b, h) (((b) * 2 + (h)) * HTB)
#define PG8_SB(b, h) ((4 + (b) * 2 + (h)) * HTB)
#define PG8_STAGE(bufoff, gbase, voff) do { _Pragma("unroll") for (int _i = 0; _i < 2; ++_i) \
        __builtin_amdgcn_global_load_lds((const unsigned*)((const char*)(gbase) + (voff)[_i]), (LAS unsigned*)(lds + (bufoff) + ldsw + _i * 8192), 16, 0, 0); } while (0)
#define PG8_LDA(dst, b, h) do { _Pragma("unroll") for (int m = 0; m < 4; ++m) _Pragma("unroll") for (int k = 0; k < 2; ++k) dst[m][k] = *(const LAS bf16x8*)(lds + PG8_SA(b, h) + aoff + m * 2048 + k * 1024); } while (0)
#define PG8_LDB(dst, b, h) do { _Pragma("unroll") for (int n = 0; n < 2; ++n) _Pragma("unroll") for (int k = 0; k < 2; ++k) dst[n][k] = *(const LAS bf16x8*)(lds + PG8_SB(b, h) + boff + n * 2048 + k * 1024); } while (0)
#define PG8_MMA(ai, bj, At, Bt) do { __builtin_amdgcn_s_setprio(1); _Pragma("unroll") for (int m = 0; m < 4; ++m) _Pragma("unroll") for (int n = 0; n < 2; ++n) _Pragma("unroll") for (int k = 0; k < 2; ++k) \
        acc[ai][bj][m][n] = __builtin_amdgcn_mfma_f32_16x16x32_bf16(Bt[n][k], At[m][k], acc[ai][bj][m][n], 0, 0, 0); __builtin_amdgcn_s_setprio(0); } while (0)
#define PG8_WAIT_V(n) asm volatile("s_waitcnt vmcnt(" #n ")" ::: "memory")
#define PG8_WAIT_L(n) asm volatile("s_waitcnt lgkmcnt(" #n ")" ::: "memory")
#define PG8_BAR __builtin_amdgcn_s_barrier()
#define PG8_SCHED __builtin_amdgcn_sched_barrier(0)
    Unit cur, nxt; int ui = 0;
    if (!S.next(0, cur)) return;
    f32x4 acc[2][2][4][2];
#pragma unroll
    for (int a = 0; a < 2; ++a)
#pragma unroll
        for (int b = 0; b < 2; ++b)
#pragma unroll
            for (int m = 0; m < 4; ++m)
#pragma unroll
                for (int n = 0; n < 2; ++n) acc[a][b][m][n] = ZERO4;
    bf16x8 At[4][2], B0[2][2], B1[2][2];
    const char* cA = (const char*)g.A + (size_t)cur.pm * tA + (size_t)cur.koff * 2; const char* cB = (const char*)g.Bt + (size_t)cur.pn * tB + (size_t)cur.koff * 2;
    PG8_STAGE(PG8_SB(0, 0), cB, voffB); PG8_STAGE(PG8_SB(0, 1), cB + hB, voffB); PG8_STAGE(PG8_SA(0, 0), cA, voffA); PG8_STAGE(PG8_SA(0, 1), cA + hA, voffA);
    if (wr == 1) PG8_BAR;
    PG8_WAIT_V(2); PG8_BAR;
    PG8_STAGE(PG8_SB(1, 0), cB + kstep, voffB); PG8_STAGE(PG8_SA(1, 0), cA + kstep, voffA); PG8_STAGE(PG8_SB(1, 1), cB + hB + kstep, voffB);
    PG8_WAIT_V(6); PG8_BAR;
    for (;;) {
        const bool has_next = S.next(ui + 1, nxt);
        const char* nA = has_next ? (const char*)g.A + (size_t)nxt.pm * tA + (size_t)nxt.koff * 2 : cA; const char* nB = has_next ? (const char*)g.Bt + (size_t)nxt.pn * tB + (size_t)nxt.koff * 2 : cB;
        for (int t = 0; t < nt; t += 2) {
            const bool last = (t == nt - 2);
            const char* a1 = cA + (size_t)(t + 1) * kstep;
            const char* a2 = last ? nA : cA + (size_t)(t + 2) * kstep; const char* b2 = last ? nB : cB + (size_t)(t + 2) * kstep;
            const char* a3 = a2 + kstep; const char* b3 = b2 + kstep;
            PG8_LDB(B0, 0, 0); PG8_LDB(B1, 0, 1); PG8_SCHED; PG8_LDA(At, 0, 0); PG8_STAGE(PG8_SA(1, 1), a1 + hA, voffA);
            PG8_WAIT_V(8); PG8_WAIT_L(0); PG8_BAR; PG8_MMA(0, 0, At, B0); PG8_MMA(0, 1, At, B1); PG8_BAR; PG8_SCHED;
            PG8_LDA(At, 0, 1); PG8_STAGE(PG8_SB(0, 0), b2, voffB); PG8_STAGE(PG8_SB(0, 1), b2 + hB, voffB); PG8_STAGE(PG8_SA(0, 0), a2, voffA);
            PG8_WAIT_V(8); PG8_WAIT_L(0); PG8_BAR; PG8_MMA(1, 0, At, B0); PG8_MMA(1, 1, At, B1); PG8_BAR; PG8_SCHED;
            PG8_LDB(B0, 1, 0); PG8_LDB(B1, 1, 1); PG8_SCHED; PG8_LDA(At, 1, 0); PG8_STAGE(PG8_SA(0, 1), a2 + hA, voffA);
            PG8_WAIT_V(8); PG8_WAIT_L(0); PG8_BAR; PG8_MMA(0, 0, At, B0); PG8_MMA(0, 1, At, B1); PG8_BAR; PG8_SCHED;
            PG8_LDA(At, 1, 1); PG8_STAGE(PG8_SB(1, 0), b3, voffB); PG8_STAGE(PG8_SB(1, 1), b3 + hB, voffB); PG8_STAGE(PG8_SA(1, 0), a3, voffA);
            PG8_WAIT_V(8); PG8_WAIT_L(0); PG8_BAR; PG8_MMA(1, 0, At, B0); PG8_MMA(1, 1, At, B1); PG8_BAR; PG8_SCHED;
        }
        if (DBG_TMASK && DBG_TEPI && tid == 0 && blockIdx.x == 0) { volatile LAS unsigned* m_ = (volatile LAS unsigned*)(lds + MISC_OFF); if (m_[68]) m_[65] = (unsigned)__builtin_amdgcn_s_memrealtime(); }
        if (wr == 0) PG8_BAR;
        if constexpr (Epi::SEGACC) E.seg(acc, cur, wr, wc, fr, fq); else E(acc, cur, wr, wc, fr, fq);
        if (DBG_TMASK && DBG_TEPI && tid == 0 && blockIdx.x == 0) { volatile LAS unsigned* m_ = (volatile LAS unsigned*)(lds + MISC_OFF); if (m_[68]) m_[66] = m_[66] + ((unsigned)__builtin_amdgcn_s_memrealtime() - m_[65]); }
        if (!has_next) break;
        if (!(Epi::SEGACC && nxt.seg != 0)) {
#pragma unroll
        for (int a = 0; a < 2; ++a)
#pragma unroll
            for (int b = 0; b < 2; ++b)
#pragma unroll
                for (int m = 0; m < 4; ++m)
#pragma unroll
                    for (int n = 0; n < 2; ++n) acc[a][b][m][n] = ZERO4;
        }
        cur = nxt; cA = nA; cB = nB; ++ui;
        if (wr == 1) PG8_BAR;
    }
    PG8_WAIT_V(0);
    PG8_BAR;
#undef PG8_SA
#undef PG8_SB
#undef PG8_STAGE
#undef PG8_LDA
#undef PG8_LDB
#undef PG8_MMA
#undef PG8_WAIT_V
#undef PG8_WAIT_L
#undef PG8_BAR
#undef PG8_SCHED
}
#endif
}

#ifndef CPU_EMU
typedef const __attribute__((address_space(4))) Params* KParams;
#else
typedef const Params* KParams;
#endif
struct Frame {
    LAS unsigned char* lds;
    int tid, lane, wave, G, bid;
    KParams p;
    unsigned char* ws;
};
DEV const float* lin(const Frame& F, int idx, int layer, size_t per_layer) { return as_global(F.p->in[idx]) + (size_t)layer * per_layer; }
#define WSP(T, off) ((T*)(F.ws + (off)))

DEV int up_dest(int n) { return n < DFF ? (n >> 7) * 256 + (n & 127) : ((n - DFF) >> 7) * 256 + 128 + ((n - DFF) & 127); }
DEV int win_dest(int n) {
    if (n < 2048) return n;
    if (n < 2052) return SM0 + S_AA + (n - 2048);
    if (n < 2056) return SM0 + S_AB + (n - 2052);
    if (n < 4104) return C_BQ + (n - 2056);
    if (n < 4116) return SM0 + S_BG + (n - 4104);
    if (n < 6676) return C_CZ + (n - 4116);
    if (n < 6692) return SM0 + S_DT + (n - 6676);
    return GT0 + (n - 6692);
}
struct XItem { const float* W; const float* ks; bf16* WT; int K, N, ldt, koff, mode, r; };
DEV void xitem_load(const XItem& it, int lane, float (&v)[32]) {
    const int nblk = (it.N + 31) / 32, kb = it.r / nblk, nb = it.r % nblk, k0 = 64 * kb, n0 = 32 * nb;
    const int nn = n0 + (lane & 31);
    const float* src = it.W + (size_t)(k0 + (lane >> 5)) * it.N + (nn < it.N ? nn : it.N - 1);
#pragma unroll
    for (int i = 0; i < 32; ++i) v[i] = src[(size_t)(2 * i) * it.N];
}
DEV void xitem_to_lds(LAS float* scr, int lane, const float (&v)[32]) {
#pragma unroll
    for (int i = 0; i < 32; ++i) scr[(2 * i + (lane >> 5)) * 33 + (lane & 31)] = v[i];
    LDS_WAIT(); CFENCE();
}
DEV void xitem_store(const XItem& it, LAS float* scr, int lane) {
    const int nblk = (it.N + 31) / 32, kb = it.r / nblk, nb = it.r % nblk, k0 = 64 * kb, n0 = 32 * nb;
    const int c = lane & 7;
    f32x4 ks0 = (f32x4){1.f, 1.f, 1.f, 1.f}, ks1 = ks0;
    if (it.ks) { ks0 = *(const f32x4*)(it.ks + k0 + 8 * c); ks1 = *(const f32x4*)(it.ks + k0 + 8 * c + 4); }
#pragma unroll
    for (int j = 0; j < 4; ++j) { const int n = (lane >> 3) + 8 * j; const LAS float* s = scr + (8 * c) * 33 + n;
        u32x4 o; o.x = pk2(s[0 * 33] * ks0[0], s[1 * 33] * ks0[1]); o.y = pk2(s[2 * 33] * ks0[2], s[3 * 33] * ks0[3]); o.z = pk2(s[4 * 33] * ks1[0], s[5 * 33] * ks1[1]); o.w = pk2(s[6 * 33] * ks1[2], s[7 * 33] * ks1[3]);
        const int ng = n0 + n;
        if (ng < it.N) { const int dr = it.mode == 0 ? ng : (it.mode == 1 ? up_dest(ng) : win_dest(ng)); *(u32x4*)(it.WT + (size_t)dr * it.ldt + it.koff + k0 + 8 * c) = o; } }
    LDS_WAIT(); CFENCE();
}
constexpr int XI_UP = (DM / 64) * (NUP / 32), XI_DN = (DFF / 64) * (DM / 32), XI_IN = (DM / 64) * ((NIN + 31) / 32), XI_P5 = (512 / 64) * (DM / 32), XI_P10 = (1024 / 64) * (DM / 32), XI_OO = (DM / 64) * (DM / 32), XI_CK = (4096 / 64) * (128 / 32);
constexpr int XI_TOTAL = 2 * XI_UP + 2 * XI_DN + XI_IN + 2 * XI_P5 + XI_P10 + XI_OO + 2 * XI_CK;
DEV XItem xitem_decode(Frame& F, int l, int idx) {
    XItem t; int r = idx; t.ks = nullptr; t.koff = 0; t.mode = 0;
    if (r < XI_UP) { t.W = lin(F, I_WUP1, l, (size_t)DM * NUP); t.K = DM; t.N = NUP; t.WT = WSP(bf16, WS_WUP1); t.ldt = DM; t.ks = lin(F, I_GF1, l, DM); t.mode = 1; }
    else if ((r -= XI_UP) < XI_UP) { t.W = lin(F, I_WUP2, l, (size_t)DM * NUP); t.K = DM; t.N = NUP; t.WT = WSP(bf16, WS_WUP2); t.ldt = DM; t.ks = lin(F, I_GF2, l, DM); t.mode = 1; }
    else if ((r -= XI_UP) < XI_DN) { t.W = lin(F, I_WDN1, l, (size_t)DFF * DM); t.K = DFF; t.N = DM; t.WT = WSP(bf16, WS_WDN1); t.ldt = DFF; }
    else if ((r -= XI_DN) < XI_DN) { t.W = lin(F, I_WDN2, l, (size_t)DFF * DM); t.K = DFF; t.N = DM; t.WT = WSP(bf16, WS_WDN2); t.ldt = DFF; }
    else if ((r -= XI_DN) < XI_IN) { t.W = lin(F, I_WIN, l, (size_t)DM * NIN); t.K = DM; t.N = NIN; t.WT = WSP(bf16, WS_WIN); t.ldt = DM; t.ks = lin(F, I_GMIX, l, DM); t.mode = 2; }
    else if ((r -= XI_IN) < XI_P5) { t.W = lin(F, I_PA, l, (size_t)512 * DM); t.K = 512; t.N = DM; t.WT = WSP(bf16, WS_WPM); t.ldt = DM; }
    else if ((r -= XI_P5) < XI_P5) { t.W = lin(F, I_PB, l, (size_t)512 * DM); t.K = 512; t.N = DM; t.WT = WSP(bf16, WS_WPM); t.ldt = DM; t.koff = 512; }
    else if ((r -= XI_P5) < XI_P10) { t.W = lin(F, I_PC, l, (size_t)1024 * DM); t.K = 1024; t.N = DM; t.WT = WSP(bf16, WS_WPM); t.ldt = DM; t.koff = 1024; t.ks = lin(F, I_SNORM, l, 1024); }
    else if ((r -= XI_P10) < XI_OO) { t.W = lin(F, I_WO, l, (size_t)DM * DM); t.K = DM; t.N = DM; t.WT = WSP(bf16, WS_WO); t.ldt = DM; }
    else if ((r -= XI_OO) < XI_CK) { t.W = lin(F, I_NWCK, l, (size_t)4096 * 128); t.K = 4096; t.N = 128; t.WT = WSP(bf16, WS_WCK); t.ldt = 4096; }
    else { r -= XI_CK; t.W = lin(F, I_NWCV, l, (size_t)4096 * 128); t.K = 4096; t.N = 128; t.WT = WSP(bf16, WS_WCV); t.ldt = 4096; }
    t.r = r; return t;
}
DEV void phase_convert(Frame& F, int l) {
    LAS float* scr = (LAS float*)(F.lds + F.wave * 16384);
    const int gw = F.bid * 8 + F.wave, NGW = F.G * 8;
    if (gw < XI_TOTAL) {
        float v[32]; XItem cur = xitem_decode(F, l, gw); xitem_load(cur, F.lane, v);
        for (int it = gw; it < XI_TOTAL; it += NGW) {
            xitem_to_lds(scr, F.lane, v);
            const bool has_next = it + NGW < XI_TOTAL; XItem nxt = cur;
            if (has_next) { nxt = xitem_decode(F, l, it + NGW); xitem_load(nxt, F.lane, v); }
            xitem_store(cur, scr, F.lane);
            cur = nxt;
        }
    }
    { bf16* w = WSP(bf16, WS_WIN) + (size_t)(SM0 + 36) * DM; const int n16 = (GT0 - SM0 - 36) * DM / 8;
      const unsigned zu = __builtin_bit_cast(unsigned, opaque_zero());
      for (int i = F.bid * 512 + F.tid; i < n16; i += F.G * 512) ((u32x4*)w)[i] = (u32x4){zu, zu, zu, zu}; }
    { const float* pek = lin(F, I_NPEK, l, 4096); const float* pev = lin(F, I_NPEV, l, 4096); float* cst = WSP(float, WS_CONST);
      for (int it = gw; it < 256; it += NGW) { const int e = it & 127; const float* pe = it < 128 ? pek : pev; const float* w = it < 128 ? lin(F, I_NWCK, l, (size_t)4096 * 128) : lin(F, I_NWCV, l, (size_t)4096 * 128); float s = 0.f;
          for (int k = F.lane; k < 4096; k += 64) s += pe[k] * w[(size_t)k * 128 + e];
          s = wave_sum(s); if (F.lane == 0) cst[it] = s; } }
    if (l == 0) {
        const float* x = as_global(F.p->in[I_X]); bf16* xb = WSP(bf16, WS_XB); unsigned long long* rss = WSP(unsigned long long, WS_CTL) + CW_RS / 2;
        for (int m = gw; m < MTOK; m += NGW) {
            const f32x4* xr = (const f32x4*)(x + (size_t)m * DM) + F.lane; u32x2* br = (u32x2*)(xb + (size_t)m * DM) + F.lane; float ss = 0.f;
#pragma unroll
            for (int j = 0; j < 8; ++j) { const f32x4 v = xr[64 * j]; ss += (v[0] * v[0] + v[1] * v[1]) + (v[2] * v[2] + v[3] * v[3]); u32x2 w; w.x = pk2(v[0], v[1]); w.y = pk2(v[2], v[3]); br[64 * j] = w; }
            ss = wave_sum(ss); if (F.lane == 0) rss[m] = pg8::rss_fix(ss);
        }
    }
}

DEV void nsa_prep_job(Frame& F, int l, int job) {
    const int b = job >> 8, g = (job >> 7) & 1, j = job & 127, bg = b * 2 + g, t0 = 64 * j;
    const bf16* p1 = WSP(bf16, WS_P1);
    const float* qn = lin(F, I_NQN, l, 128); const float* kn = lin(F, I_NKN, l, 128);
    bf16* QN = WSP(bf16, WS_QN); bf16* KS = WSP(bf16, WS_KS); bf16* KW = WSP(bf16, WS_KW); bf16* VST = WSP(bf16, WS_VST); bf16* VWT = WSP(bf16, WS_VWT);
    {
        const int v = F.lane >> 4, l16 = F.lane & 15;
        const int col = (v < 2 ? C_BQ + (g * 2 + v) * 128 : (v == 2 ? C_BKS + g * 128 : C_BKW + g * 128)) + 8 * l16;
        const float* gp = (v < 2 ? qn : kn) + 8 * l16; const f32x4 ga = *(const f32x4*)gp, gb = *(const f32x4*)(gp + 4);
        const float gg[8] = {ga[0], ga[1], ga[2], ga[3], gb[0], gb[1], gb[2], gb[3]};
        u32x4 wv[8];
#pragma unroll
        for (int i = 0; i < 8; ++i) wv[i] = *(const u32x4*)(p1 + (size_t)(b * SEQ + t0 + 8 * F.wave + i) * P1W + col);
        CFENCE();
#pragma unroll
        for (int i = 0; i < 8; ++i) {
            const int t = t0 + 8 * F.wave + i;
            const float x[8] = {bflo(wv[i].x), bfhi(wv[i].x), bflo(wv[i].y), bfhi(wv[i].y), bflo(wv[i].z), bfhi(wv[i].z), bflo(wv[i].w), bfhi(wv[i].w)};
            float ss = ((x[0] * x[0] + x[1] * x[1]) + (x[2] * x[2] + x[3] * x[3])) + ((x[4] * x[4] + x[5] * x[5]) + (x[6] * x[6] + x[7] * x[7]));
            ss = sum16(ss);
            float r = rsqrtf(ss * (1.0f / 128.0f) + EPS);
            if (v < 2) r *= 0.08838834764831845f * 1.4426950408889634f;
            u32x4 o; o.x = pk2(x[0] * r * gg[0], x[1] * r * gg[1]); o.y = pk2(x[2] * r * gg[2], x[3] * r * gg[3]); o.z = pk2(x[4] * r * gg[4], x[5] * r * gg[5]); o.w = pk2(x[6] * r * gg[6], x[7] * r * gg[7]);
            bf16* dst = v < 2 ? QN + ((size_t)(bg * SEQ + t) * 2 + v) * 128 : (v == 2 ? KS : KW) + (size_t)(bg * SEQ + t) * 128;
            *(u32x4*)(dst + 8 * l16) = o;
        }
    }
    LAS bf16* tl = (LAS bf16*)F.lds;
    {
        u32x4 vv[4];
#pragma unroll
        for (int q = 0; q < 4; ++q) { const int i = F.tid + 512 * q, v = i >> 10, r = (i >> 4) & 63, c8 = (i & 15) * 8;
            vv[q] = *(const u32x4*)(p1 + (size_t)(b * SEQ + t0 + r) * P1W + (v ? C_BVW : C_BVS) + g * 128 + c8); }
#pragma unroll
        for (int q = 0; q < 4; ++q) { const int i = F.tid + 512 * q, v = i >> 10, r = (i >> 4) & 63, c8 = (i & 15) * 8; LAS unsigned* d = (LAS unsigned*)(tl + (v * 64 + r) * 130 + c8);
            d[0] = vv[q].x; d[1] = vv[q].y; d[2] = vv[q].z; d[3] = vv[q].w; }
    }
    __syncthreads();
    for (int i = F.tid; i < 2 * 128 * 8; i += 512) {
        const int v = i >> 10, d = i & 127, tc = (i >> 7) & 7;
        const LAS bf16* s = tl + (v * 64 + 8 * tc) * 130 + d;
        u32x4 o; o.x = s[0] | ((unsigned)s[130] << 16); o.y = s[260] | ((unsigned)s[390] << 16); o.z = s[520] | ((unsigned)s[650] << 16); o.w = s[780] | ((unsigned)s[910] << 16);
        *(u32x4*)((v ? VWT : VST) + ((size_t)(bg * 128 + j) * 128 + d) * 64 + 8 * tc) = o;
    }
    __syncthreads();
}

DEV void conv_load11(u32x4 (&xin)[11], const bf16* p1, int b, int ts, int col) {
#pragma unroll
    for (int i = 0; i < 11; ++i) { const int t = ts - 3 + i; const int tc = t < 0 ? 0 : t;
        u32x4 v = *(const u32x4*)(p1 + (size_t)(b * SEQ + tc) * P1W + col);
        if (t < 0) v = (u32x4){0u, 0u, 0u, 0u};
        xin[i] = v; }
}
DEV void gdn_prep_job(Frame& F, int l, int job) {
    const int b = job >> 9, h = (job >> 7) & 3, c = job & 127, t0 = 64 * c;
    const bf16* p1 = WSP(bf16, WS_P1); const float* small = WSP(float, WS_SMALL);
    const float* convw = lin(F, I_GCONV, l, 4 * 1536);
    LAS float* Qs = (LAS float*)F.lds;
    LAS float* Ks = Qs + 64 * 132;
    LAS float* Vs = Ks + 64 * 132;
    LAS float* Mm = Vs + 64 * 132;
    LAS float* At = Mm + 64 * 68;
    LAS float* beta = At + 64 * 68;
    LAS float* gc = beta + 64;
    LAS float* eg = gc + 64;
    const int tid = F.tid;
    {
        if (tid < 384) {
            const int v = tid >> 7, s = tid & 15, tg = (tid >> 4) & 7, cc = v * 512 + h * 128 + 8 * s;
            u32x4 xin[11]; conv_load11(xin, p1, b, t0 + 8 * tg, (v == 0 ? C_AQ : (v == 1 ? C_AK : C_AV)) + h * 128 + 8 * s);
            f32x4 w[4][2];
#pragma unroll
            for (int k = 0; k < 4; ++k) { w[k][0] = *(const f32x4*)(convw + k * 1536 + cc); w[k][1] = *(const f32x4*)(convw + k * 1536 + cc + 4); }
            float y[8][8];
#pragma unroll
            for (int j = 0; j < 8; ++j) {
                float x[11];
#pragma unroll
                for (int i = 0; i < 11; ++i) { const unsigned wd = j < 2 ? xin[i].x : (j < 4 ? xin[i].y : (j < 6 ? xin[i].z : xin[i].w)); x[i] = (j & 1) ? bfhi(wd) : bflo(wd); }
                const float w0 = w[0][j >> 2][j & 3], w1 = w[1][j >> 2][j & 3], w2 = w[2][j >> 2][j & 3], w3 = w[3][j >> 2][j & 3];
#pragma unroll
                for (int i = 0; i < 8; ++i) y[i][j] = siluf_(w0 * x[i] + w1 * x[i + 1] + w2 * x[i + 2] + w3 * x[i + 3]);
            }
            LAS float* dst = (v == 0 ? Qs : (v == 1 ? Ks : Vs)) + (8 * tg) * 132 + 8 * s;
#pragma unroll
            for (int i = 0; i < 8; ++i) { *(LAS f32x4*)(dst + i * 132) = (f32x4){y[i][0], y[i][1], y[i][2], y[i][3]}; *(LAS f32x4*)(dst + i * 132 + 4) = (f32x4){y[i][4], y[i][5], y[i][6], y[i][7]}; }
        }
        if (tid < 64) {
            const size_t row = (size_t)(b * SEQ + t0 + tid);
            const float a = small[row * SMW + S_AA + h], bb = small[row * SMW + S_AB + h];
            beta[tid] = sigmoidf_(bb);
            gc[tid] = -__expf(lin(F, I_GALOG, l, 4)[h]) * softplusf_(a + lin(F, I_GDTB, l, 4)[h]);
        }
    }
    __syncthreads();
    for (int i4 = 0; i4 < 4; ++i4) {
        float x0[4], x1[4], ssv[4];
#pragma unroll
        for (int q = 0; q < 4; ++q) { const int r = F.wave * 16 + 4 * i4 + q;
            const LAS float* p = (r < 64 ? Qs + r * 132 : Ks + (r - 64) * 132); x0[q] = p[F.lane]; x1[q] = p[F.lane + 64]; ssv[q] = x0[q] * x0[q] + x1[q] * x1[q]; }
        wave_sum4(ssv);
#pragma unroll
        for (int q = 0; q < 4; ++q) { const int r = F.wave * 16 + 4 * i4 + q; LAS float* p = (r < 64 ? Qs + r * 132 : Ks + (r - 64) * 132);
            float sc = rsqrtf(ssv[q] + EPS); if (r < 64) sc *= 0.08838834764831845f;
            p[F.lane] = x0[q] * sc; p[F.lane + 64] = x1[q] * sc; }
    }
    if (tid < 64) {
        float sc = gc[tid];
#pragma unroll
        for (int d = 1; d < 64; d <<= 1) { const float t = __builtin_bit_cast(float, __builtin_amdgcn_ds_bpermute((tid - d) * 4, __builtin_bit_cast(int, sc))); if (tid >= d) sc += t; }
        gc[tid] = sc; eg[tid] = __expf(sc);
    }
    for (int i = tid; i < 64 * 68; i += 512) At[i] = 0.f;
    __syncthreads();
    for (int tj = F.wave; tj < 20; tj += 8) {
        const int kind = tj >= 10 ? 1 : 0, idx = tj - 10 * kind;
        const int mt = idx >= 6 ? 3 : (idx >= 3 ? 2 : (idx >= 1 ? 1 : 0)), nt = idx - mt * (mt + 1) / 2;
        const int fr = F.lane & 15, fq = F.lane >> 4;
        const LAS float* ap = (kind ? Qs : Ks) + (16 * mt + fr) * 132 + 4 * fq; const LAS float* bp = Ks + (16 * nt + fr) * 132 + 4 * fq;
        f32x4 acc = (f32x4){0.f, 0.f, 0.f, 0.f};
#pragma unroll
        for (int sg = 0; sg < 8; ++sg) { const f32x4 a4 = *(const LAS f32x4*)(ap + 16 * sg), b4 = *(const LAS f32x4*)(bp + 16 * sg);
#pragma unroll
            for (int j = 0; j < 4; ++j) acc = __builtin_amdgcn_mfma_f32_16x16x4f32(a4[j], b4[j], acc, 0, 0, 0); }
        const int j = 16 * nt + fr; const float gj = gc[j];
#pragma unroll
        for (int r = 0; r < 4; ++r) { const int i = 16 * mt + 4 * fq + r; const float dec = j <= i ? __expf(gc[i] - gj) : 0.f;
            if (kind) At[i * 68 + j] = acc[r] * dec; else Mm[i * 68 + j] = j < i ? beta[i] * acc[r] * dec : 0.f; }
    }
    __syncthreads();
    unsigned char* cb = F.ws + WS_GW + (size_t)job * GDN_CH_BYTES;
    bf16* gW = (bf16*)cb; bf16* gQD = (bf16*)(cb + 16384); bf16* gKDT = (bf16*)(cb + 32768); bf16* gUT = (bf16*)(cb + 49152); bf16* gAT = (bf16*)(cb + 65536);
    float sol[64];
    if (tid < 256) {
        const int cidx = tid & 127; const bool isw = tid >= 128;
        const LAS float* src = (isw ? Ks : Vs) + cidx;
        const LAS float* MmL = (const LAS float*)lds_vbase(Mm); const LAS float* betaL = (const LAS float*)lds_vbase(beta); const LAS float* egL = (const LAS float*)lds_vbase(eg);
#pragma unroll
        for (int i = 0; i < 64; ++i) sol[i] = 0.f;
#pragma unroll
        for (int i = 0; i < 64; ++i) {
            float r = src[i * 132] * betaL[i] * (isw ? egL[i] : 1.0f), r1 = 0.f, r2 = 0.f, r3 = 0.f;
#pragma unroll
            for (int j4 = 0; j4 < (i + 3) / 4; ++j4) { const f32x4 mv = *(const LAS f32x4*)(MmL + i * 68 + 4 * j4);
                r -= mv[0] * sol[4 * j4]; r1 -= mv[1] * sol[4 * j4 + 1]; r2 -= mv[2] * sol[4 * j4 + 2]; r3 -= mv[3] * sol[4 * j4 + 3]; }
            r = (r + r1) + (r2 + r3);
            sol[i] = r;
            asm volatile("" : "+v"(sol[i]) :: "memory");
        }
    } else {
        const int t2 = tid - 256;
        const float gl = gc[63];
        for (int i = t2; i < 64 * 16; i += 256) { const int r = i >> 4, c8 = (i & 15) * 8; const float e = eg[r]; const LAS float* s = Qs + r * 132 + c8;
            u32x4 o; o.x = pk2(s[0] * e, s[1] * e); o.y = pk2(s[2] * e, s[3] * e); o.z = pk2(s[4] * e, s[5] * e); o.w = pk2(s[6] * e, s[7] * e); *(u32x4*)(gQD + r * 128 + c8) = o; }
        for (int i = t2; i < 128 * 8; i += 256) { const int dk = i & 127, i8 = (i >> 7) * 8; float v[8];
#pragma unroll
            for (int q = 0; q < 8; ++q) v[q] = Ks[(i8 + q) * 132 + dk] * __expf(gl - gc[i8 + q]);
            u32x4 o; o.x = pk2(v[0], v[1]); o.y = pk2(v[2], v[3]); o.z = pk2(v[4], v[5]); o.w = pk2(v[6], v[7]); *(u32x4*)(gKDT + dk * 64 + i8) = o; }
        for (int i = t2; i < 64 * 8; i += 256) { const int r = i >> 3, c8 = (i & 7) * 8; const LAS float* s = At + r * 68 + c8;
            u32x4 o; o.x = pk2(s[0], s[1]); o.y = pk2(s[2], s[3]); o.z = pk2(s[4], s[5]); o.w = pk2(s[6], s[7]); *(u32x4*)(gAT + r * 64 + c8) = o; }
        if (t2 == 0) WSP(float, WS_GL)[job] = __expf(gl);
    }
    __syncthreads();
    LAS bf16* Wl = (LAS bf16*)Qs;
    if (tid < 128) {
#pragma unroll
        for (int q = 0; q < 8; ++q) { u32x4 o; o.x = pk2(sol[8 * q], sol[8 * q + 1]); o.y = pk2(sol[8 * q + 2], sol[8 * q + 3]); o.z = pk2(sol[8 * q + 4], sol[8 * q + 5]); o.w = pk2(sol[8 * q + 6], sol[8 * q + 7]);
            *(u32x4*)(gUT + tid * 64 + 8 * q) = o; }
    } else if (tid < 256) {
#pragma unroll
        for (int i = 0; i < 64; ++i) Wl[i * 136 + (tid - 128)] = (bf16)f2bf(sol[i]);
    }
    __syncthreads();
    for (int i = tid; i < 64 * 16; i += 512) { const int r = i >> 4, c8 = (i & 15) * 8; *(u32x4*)(gW + r * 128 + c8) = *(const LAS u32x4*)(Wl + r * 136 + c8); }
    __syncthreads();
}

DEV void ssd_conv8(const u32x4 (&xin)[11], const float* cw, const float* cbias, int cc, float (&y)[8][8]) {
    f32x4 w[4][2], bs[2];
#pragma unroll
    for (int k = 0; k < 4; ++k) { w[k][0] = *(const f32x4*)(cw + k * 1536 + cc); w[k][1] = *(const f32x4*)(cw + k * 1536 + cc + 4); }
    bs[0] = *(const f32x4*)(cbias + cc); bs[1] = *(const f32x4*)(cbias + cc + 4);
#pragma unroll
    for (int j = 0; j < 8; ++j) {
        float x[11];
#pragma unroll
        for (int i = 0; i < 11; ++i) { const unsigned wd = j < 2 ? xin[i].x : (j < 4 ? xin[i].y : (j < 6 ? xin[i].z : xin[i].w)); x[i] = (j & 1) ? bfhi(wd) : bflo(wd); }
        const float w0 = w[0][j >> 2][j & 3], w1 = w[1][j >> 2][j & 3], w2 = w[2][j >> 2][j & 3], w3 = w[3][j >> 2][j & 3], bj = bs[j >> 2][j & 3];
#pragma unroll
        for (int i = 0; i < 8; ++i) y[i][j] = siluf_(w0 * x[i] + w1 * x[i + 1] + w2 * x[i + 2] + w3 * x[i + 3] + bj);
    }
}
DEV bf16x8 frag_sw(const LAS bf16* M, int row, int chunk) { return *(const LAS bf16x8*)(M + row * 136 + 8 * (chunk ^ ((row >> 3) & 7))); }
DEV void ssd_prep_pass(Frame& F, const u32x4 (&xin)[11], const float* cw, const float* cbias, int cc, bf16* SX, float* dst0, LAS bf16* BT, LAS bf16* XT, const LAS float* dts, const LAS float* acs,
                       size_t row0, int s, int tg, int hh0) {
    const float zf_ = opaque_zero();
    {
        float y[8][8]; ssd_conv8(xin, cw, cbias, cc, y);
#pragma unroll
        for (int i = 0; i < 8; ++i) { u32x4 o; o.x = pk2(y[i][0], y[i][1]); o.y = pk2(y[i][2], y[i][3]); o.z = pk2(y[i][4], y[i][5]); o.w = pk2(y[i][6], y[i][7]);
            *(u32x4*)(SX + (row0 + i) * 1536 + cc) = o; }
        const int hh = hh0 + (s >> 3); const float al = acs[127 * 8 + hh]; float f[8];
#pragma unroll
        for (int i = 0; i < 8; ++i) f[i] = dts[(8 * tg + i) * 8 + hh] * __expf(al - acs[(8 * tg + i) * 8 + hh]);
#pragma unroll
        for (int j = 0; j < 8; ++j) { float v[8];
#pragma unroll
            for (int i = 0; i < 8; ++i) v[i] = bf2f(f2bf(y[i][j])) * f[i];
            u32x4 o; o.x = pk2(v[0], v[1]); o.y = pk2(v[2], v[3]); o.z = pk2(v[4], v[5]); o.w = pk2(v[6], v[7]);
            *(LAS u32x4*)(XT + (8 * s + j) * 136 + 8 * (tg ^ (s & 7))) = o; }
    }
    __syncthreads();
    {
        const int hp = F.wave >> 1, nh = F.wave & 1, fr = F.lane & 15, fq = F.lane >> 4;
        const LAS bf16* XTh = XT + hp * 64 * 136;
        float* dst = dst0 + (size_t)hp * 64 * 128;
#pragma unroll
        for (int mt = 0; mt < 4; ++mt) {
            bf16x8 a[4];
#pragma unroll
            for (int ks = 0; ks < 4; ++ks) a[ks] = frag_sw(XTh, 16 * mt + fr, 4 * ks + fq);
#pragma unroll
            for (int q = 0; q < 4; ++q) { const int nq = 4 * nh + q; f32x4 acc = ZERO4;
#pragma unroll
                for (int ks = 0; ks < 4; ++ks) acc = mfma16(frag_sw(BT, 16 * nq + fr, 4 * ks + fq), a[ks], acc);
                *(f32x4*)(dst + (size_t)(16 * mt + fr) * 128 + 16 * nq + 4 * fq) = acc; }
        }
    }
    __syncthreads();
}
DEV void ssd_prep_job(Frame& F, int l, int job) {
    const int b = job >> 7, c = (job >> 1) & 63, g = job & 1, t0 = 128 * c;
    const bf16* p1 = WSP(bf16, WS_P1); const float* small = WSP(float, WS_SMALL);
    const float* cw = lin(F, I_SCW, l, 4 * 1536); const float* cbias = lin(F, I_SCB, l, 1536);
    bf16* SX = WSP(bf16, WS_SX); float* SDT = WSP(float, WS_SDT); float* SAC = WSP(float, WS_SAC); float* SST = WSP(float, WS_SST); float* SCD = WSP(float, WS_SCD);
    LAS bf16* BT = (LAS bf16*)F.lds;
    LAS bf16* XT = BT + 128 * 136;
    LAS float* dts = (LAS float*)(XT + 4 * 64 * 136);
    LAS float* acs = dts + 128 * 8;
    const int tid = F.tid, s = tid & 31, tg = tid >> 5, ts = t0 + 8 * tg;
    const int ccA = 1024 + (s < 16 ? g * 128 + 8 * s : 256 + g * 128 + 8 * (s - 16));
    const int ccX = g * 512 + 8 * s;
    const size_t row0 = (size_t)(b * SEQ + ts);
    u32x4 xa[11], xb[11];
    conv_load11(xa, p1, b, ts, C_CX + ccA); conv_load11(xb, p1, b, ts, C_CX + ccX);
    for (int i = tid; i < 1024; i += 512) { const int tl = i >> 3, hh = i & 7, h = 8 * g + hh; const size_t row = (size_t)(b * SEQ + t0 + tl);
        const float dt = softplusf_(small[row * SMW + S_DT + h] + lin(F, I_SDTB, l, 16)[h]);
        dts[i] = dt; acs[i] = dt * (-__expf(lin(F, I_SALOG, l, 16)[h])); }
    __syncthreads();
    {
        const int hh = F.wave, ln = F.lane; const float v0 = acs[(2 * ln) * 8 + hh], v1 = acs[(2 * ln + 1) * 8 + hh];
        float sc = v0 + v1;
#pragma unroll
        for (int d = 1; d < 64; d <<= 1) { const float t = __builtin_bit_cast(float, __builtin_amdgcn_ds_bpermute((ln - d) * 4, __builtin_bit_cast(int, sc))); if (ln >= d) sc += t; }
        float ex = __builtin_bit_cast(float, __builtin_amdgcn_ds_bpermute((ln - 1) * 4, __builtin_bit_cast(int, sc))); if (ln == 0) ex = 0.f;
        const float a0 = ex + v0; acs[(2 * ln) * 8 + hh] = a0; acs[(2 * ln + 1) * 8 + hh] = a0 + v1;
    }
    __syncthreads();
    for (int i = tid; i < 1024; i += 512) { const int tl = i >> 3, hh = i & 7; const size_t row = (size_t)(b * SEQ + t0 + tl); SDT[row * 16 + 8 * g + hh] = dts[i]; SAC[row * 16 + 8 * g + hh] = acs[i]; }
    if (tid < 8) SCD[(size_t)(b * 64 + c) * 16 + 8 * g + tid] = __expf(acs[127 * 8 + tid]);
    {
        float y[8][8]; ssd_conv8(xa, cw, cbias, ccA, y);
#pragma unroll
        for (int i = 0; i < 8; ++i) { u32x4 o; o.x = pk2(y[i][0], y[i][1]); o.y = pk2(y[i][2], y[i][3]); o.z = pk2(y[i][4], y[i][5]); o.w = pk2(y[i][6], y[i][7]);
            *(u32x4*)(SX + (row0 + i) * 1536 + ccA) = o; }
        if (s < 16) {
#pragma unroll
            for (int j = 0; j < 8; ++j) { u32x4 o; o.x = pk2(y[0][j], y[1][j]); o.y = pk2(y[2][j], y[3][j]); o.z = pk2(y[4][j], y[5][j]); o.w = pk2(y[6][j], y[7][j]);
                *(LAS u32x4*)(BT + (8 * s + j) * 136 + 8 * (tg ^ (s & 7))) = o; }
        }
    }
    conv_load11(xa, p1, b, ts, C_CX + ccX + 256);
    float* dst0 = SST + ((size_t)((b * 64 + c) * 16 + 8 * g) * 64) * 128;
    ssd_prep_pass(F, xb, cw, cbias, ccX, SX, dst0, BT, XT, dts, acs, row0, s, tg, 0);
    ssd_prep_pass(F, xa, cw, cbias, ccX + 256, SX, dst0 + (size_t)4 * 64 * 128, BT, XT, dts, acs, row0, s, tg, 4);
}

DEV void nsa_compress_job(Frame& F, int l, int job) {
    const int kv = job >> 4, bg = (job >> 2) & 3, rt = job & 3, b = bg >> 1, g = bg & 1, i0 = 128 * rt;
    const float zf_ = opaque_zero();
    const bf16* p1 = WSP(bf16, WS_P1); const bf16* Wt = WSP(bf16, kv ? WS_WCV : WS_WCK); const float* cst = WSP(float, WS_CONST) + kv * 128;
    const int col0 = (kv ? C_BVC : C_BKC) + g * 128;
    LAS bf16* As = (LAS bf16*)F.lds;
    LAS bf16* Bs = As + 128 * 72;
    LAS float* Cs = (LAS float*)(Bs + 128 * 72);
    const int tid = F.tid, wm = F.wave >> 1, wn = F.wave & 1;
    f32x4 acc[2][4];
#pragma unroll
    for (int i = 0; i < 2; ++i)
#pragma unroll
        for (int j = 0; j < 4; ++j) acc[i][j] = ZERO4;
    u32x4 ra[2], rb[2];
#define LOADK(ks_) do { _Pragma("unroll") for (int q = 0; q < 2; ++q) { const int ch = tid + 512 * q, r = ch >> 3, c8 = (ch & 7) * 8; \
            int t = 16 * (i0 + r) + ((ks_) >> 1); if (t > SEQ - 1) t = SEQ - 1;     \
            ra[q] = *(const u32x4*)(p1 + (size_t)(b * SEQ + t) * P1W + col0 + ((ks_) & 1) * 64 + c8); \
            rb[q] = *(const u32x4*)(Wt + (size_t)r * 4096 + 64 * (ks_) + c8); } } while (0)
    LOADK(0);
    for (int ks = 0; ks < 64; ++ks) {
        __syncthreads();
#pragma unroll
        for (int q = 0; q < 2; ++q) { const int ch = tid + 512 * q, r = ch >> 3, c8 = (ch & 7) * 8; *(LAS u32x4*)(As + r * 72 + c8) = ra[q]; *(LAS u32x4*)(Bs + r * 72 + c8) = rb[q]; }
        __syncthreads();
        if (ks + 1 < 64) LOADK(ks + 1);
#pragma unroll
        for (int k2 = 0; k2 < 2; ++k2) {
            bf16x8 a0 = frag_l(As, 72, 32 * wm, 32 * k2, F.lane), a1 = frag_l(As, 72, 32 * wm + 16, 32 * k2, F.lane);
#pragma unroll
            for (int j = 0; j < 4; ++j) { const bf16x8 bb = frag_l(Bs, 72, 64 * wn + 16 * j, 32 * k2, F.lane); acc[0][j] = mfma16(a0, bb, acc[0][j]); acc[1][j] = mfma16(a1, bb, acc[1][j]); }
        }
    }
    __syncthreads();
#pragma unroll
    for (int i = 0; i < 2; ++i)
#pragma unroll
        for (int j = 0; j < 4; ++j)
#pragma unroll
            for (int r = 0; r < 4; ++r) { const int col = 64 * wn + 16 * j + (F.lane & 15); Cs[(32 * wm + 16 * i + 4 * (F.lane >> 4) + r) * 132 + col] = acc[i][j][r] + cst[col]; }
    __syncthreads();
    if (kv == 0) {
        const float* kn = lin(F, I_NKN, l, 128); bf16* KC = WSP(bf16, WS_KCMP);
        const int r = tid >> 2, q = tid & 3; const LAS float* s = Cs + r * 132 + 32 * q; float ss = 0.f;
#pragma unroll
        for (int e = 0; e < 32; ++e) ss += s[e] * s[e];
        ss += shx<1>(ss); ss += shx<2>(ss);
        const float rs = rsqrtf(ss * (1.0f / 128.0f) + EPS);
        bf16* dst = KC + ((size_t)bg * 512 + i0 + r) * 128 + 32 * q;
#pragma unroll
        for (int e = 0; e < 32; e += 2) *(unsigned*)(dst + e) = pk2(s[e] * rs * kn[32 * q + e], s[e + 1] * rs * kn[32 * q + e + 1]);
    } else {
        bf16* VC = WSP(bf16, WS_VCMPT); const int e = tid & 127, q = tid >> 7;
#pragma unroll
        for (int i8 = 0; i8 < 4; ++i8) { const LAS float* s = Cs + (32 * q + 8 * i8) * 132 + e;
            u32x4 o; o.x = pk2(s[0], s[132]); o.y = pk2(s[264], s[396]); o.z = pk2(s[528], s[660]); o.w = pk2(s[792], s[924]);
            *(u32x4*)(VC + ((size_t)bg * 128 + e) * 512 + i0 + 32 * q + 8 * i8) = o; }
    }
    __syncthreads();
}
#undef LOADK

constexpr int AL_KT = 0, AL_VT = 18432, AL_KT1 = 36864, AL_UW = 55296, AL_TB = 56320, AL_SM = 62656, AL_PS = 63744, AL_IMP = 80384, AL_VT1 = 113152, AL_END = 131584;
constexpr int KT_LD = 144;
static_assert(AL_KT + 64 * KT_LD * 2 <= AL_VT && AL_VT + 128 * 72 * 2 <= AL_KT1 && AL_KT1 + 64 * KT_LD * 2 <= AL_UW && AL_UW + 128 <= AL_TB && AL_END <= MISC_OFF, "attention LDS map");
DEV int rel_bucket_dev(int n) {
    if (n < 16) return n;
    int k = 16;
    k += (n >= 21); k += (n >= 27); k += (n >= 35); k += (n >= 46); k += (n >= 59); k += (n >= 77); k += (n >= 99); k += (n >= 128);
    k += (n >= 166); k += (n >= 216); k += (n >= 280); k += (n >= 363); k += (n >= 470); k += (n >= 609); k += (n >= 790);
    return k;
}
DEV void attn_fill_bias(Frame& F, int g) {
    LAS float* tb = (LAS float*)(F.lds + AL_TB); const float* rt = as_global(F.p->in[I_REL]);
    for (int i = F.tid; i < 2 * 792; i += 512) { const int hg = i / 792, d = i - hg * 792; tb[i] = rt[rel_bucket_dev(d) * 4 + 2 * g + hg] * 1.4426950408889634f; }
}
DEV void attn_load_tile(u32x4 (&rk)[2], u32x4 (&rv)[2], const bf16* ksrc, const bf16* vsrc, int vpitch, int tid) {
#pragma unroll
    for (int q = 0; q < 2; ++q) { const int ch = tid + 512 * q; rk[q] = *(const u32x4*)(ksrc + (size_t)ch * 8); rv[q] = *(const u32x4*)(vsrc + (size_t)(ch >> 3) * vpitch + (ch & 7) * 8); }
}
DEV void attn_store_tile(LAS unsigned char* lds, int buf, const u32x4 (&rk)[2], const u32x4 (&rv)[2], int tid) {
    LAS bf16* Kt = (LAS bf16*)(lds + (buf ? AL_KT1 : AL_KT)); LAS bf16* Vt = (LAS bf16*)(lds + (buf ? AL_VT1 : AL_VT));
#pragma unroll
    for (int q = 0; q < 2; ++q) { const int ch = tid + 512 * q; *(LAS u32x4*)(Kt + (ch >> 4) * KT_LD + (ch & 15) * 8) = rk[q]; *(LAS u32x4*)(Vt + (ch >> 3) * 72 + (ch & 7) * 8) = rv[q]; }
}
template <int MODE, int PATH = 0>
DEV unsigned attn_scores(LAS unsigned char* lds, int buf, const bf16x8 (&qf)[4], int lane, int n0, int tok, int hg, unsigned selbit, f32x4 (&s)[4]) {
    const float zf_ = opaque_zero();
    const LAS bf16* Kt = (const LAS bf16*)(lds + (buf ? AL_KT1 : AL_KT)); const LAS float* tb = (const LAS float*)(lds + AL_TB) + hg * 792;
    {
        bf16x8 ka[4], kb[4];
#define AT_LOADK(K_, nt_) do { _Pragma("unroll") for (int ks = 0; ks < 4; ++ks) K_[ks] = frag_l(Kt, KT_LD, 16 * (nt_), 32 * ks, lane); } while (0)
#define AT_PIN4(K_) asm volatile("" : "+v"(K_[0]), "+v"(K_[1]), "+v"(K_[2]), "+v"(K_[3]))
#define AT_MMAK(K_, nt_) do { s[nt_] = ZERO4; __builtin_amdgcn_s_setprio(1); _Pragma("unroll") for (int ks = 0; ks < 4; ++ks) s[nt_] = mfma16(K_[ks], qf[ks], s[nt_]); __builtin_amdgcn_s_setprio(0); } while (0)
        AT_LOADK(ka, 0); AT_LOADK(kb, 1);
        AT_PIN4(ka); AT_MMAK(ka, 0); AT_LOADK(ka, 2);
        AT_PIN4(kb); AT_MMAK(kb, 1); AT_LOADK(kb, 3);
        AT_PIN4(ka); AT_MMAK(ka, 2);
        AT_PIN4(kb); AT_MMAK(kb, 3);
#undef AT_LOADK
#undef AT_MMAK
    }
    if (PATH == 1) {
        const bool ok = selbit != 0u;
        return ok ? 0xffffu : 0u;
    }
    if (PATH == 2) {
        const bool ok = MODE == 2 ? true : (selbit != 0u);
        const LAS float* tp = tb + (tok - n0 - 4 * (lane >> 4));
#pragma unroll
        for (int nt = 0; nt < 4; ++nt)
#pragma unroll
            for (int r = 0; r < 4; ++r) s[nt][r] = s[nt][r] + tp[-16 * nt - r];
        return ok ? 0xffffu : 0u;
    }
    unsigned vm = 0u;
#pragma unroll
    for (int nh = 0; nh < 2; ++nh) {
        float bv[8];
#pragma unroll
        for (int q = 0; q < 8; ++q) { const int nt = 2 * nh + (q >> 2), r = q & 3; const int n = n0 + 16 * nt + 4 * (lane >> 4) + r; const int dist = MODE == 0 ? tok - (16 * n + 31) : tok - n;
            int di = dist < 0 ? 0 : dist; di = di > 790 ? 790 : di; bv[q] = tb[di]; }
#pragma unroll
        for (int q = 0; q < 8; ++q) asm volatile("" : "+v"(bv[q]));
#pragma unroll
        for (int q = 0; q < 8; ++q) { const int nt = 2 * nh + (q >> 2), r = q & 3; const int n = n0 + 16 * nt + 4 * (lane >> 4) + r; int dist; bool ok;
            if (MODE == 0) { dist = tok - (16 * n + 31); ok = dist >= 0 && n < 511; }
            else if (MODE == 1) { dist = tok - n; ok = dist >= 0 && selbit != 0u; }
            else { dist = tok - n; ok = dist >= 0 && dist < 512; }
            s[nt][r] = ok ? s[nt][r] + bv[q] : -1e30f;
            vm |= (ok ? 1u : 0u) << (4 * nt + r); }
    }
    return vm;
}
DEV float fq_max(float v) {
    const auto a = __builtin_amdgcn_permlane16_swap(__builtin_bit_cast(unsigned, v), __builtin_bit_cast(unsigned, v), false, false);
    const float m = fmaxf(__builtin_bit_cast(float, a[0]), __builtin_bit_cast(float, a[1]));
    const auto b = __builtin_amdgcn_permlane32_swap(__builtin_bit_cast(unsigned, m), __builtin_bit_cast(unsigned, m), false, false);
    return fmaxf(__builtin_bit_cast(float, b[0]), __builtin_bit_cast(float, b[1]));
}
DEV float fq_sum(float v) {
    const auto a = __builtin_amdgcn_permlane16_swap(__builtin_bit_cast(unsigned, v), __builtin_bit_cast(unsigned, v), false, false);
    const float m = __builtin_bit_cast(float, a[0]) + __builtin_bit_cast(float, a[1]);
    const auto b = __builtin_amdgcn_permlane32_swap(__builtin_bit_cast(unsigned, m), __builtin_bit_cast(unsigned, m), false, false);
    return __builtin_bit_cast(float, b[0]) + __builtin_bit_cast(float, b[1]);
}
template <bool ROWMASK = false, bool NOSUM = false>
DEV float attn_online(const f32x4 (&s)[4], unsigned vm, float& m, float& l, f32x4 (&p)[4], float boff = 0.f) {
    float mx = fmaxf(fmaxf(fmaxf(s[0][0], s[0][1]), fmaxf(s[0][2], s[0][3])), fmaxf(fmaxf(s[1][0], s[1][1]), fmaxf(s[1][2], s[1][3])));
    mx = fmaxf(mx, fmaxf(fmaxf(fmaxf(s[2][0], s[2][1]), fmaxf(s[2][2], s[2][3])), fmaxf(fmaxf(s[3][0], s[3][1]), fmaxf(s[3][2], s[3][3]))));
    mx += boff;
    float sc = 1.0f;
    if (__ballot(mx - m > 12.0f) != 0ull) {
        mx = fmaxf(mx, shx<16>(mx)); mx = fmaxf(mx, shx<32>(mx));
        const float mn = fmaxf(m, mx); sc = __builtin_amdgcn_exp2f(m - mn); m = mn; l *= sc;
    }
    float rs = 0.f;
    if (ROWMASK) {
        const float mr = vm != 0u ? m - boff : 1e30f;
#pragma unroll
        for (int nt = 0; nt < 4; ++nt)
#pragma unroll
            for (int r = 0; r < 4; ++r) { const float pv = __builtin_amdgcn_exp2f(s[nt][r] - mr); p[nt][r] = pv; rs += pv; }
    } else {
        const float mr = m - boff;
#pragma unroll
        for (int nt = 0; nt < 4; ++nt)
#pragma unroll
            for (int r = 0; r < 4; ++r) { const float pv = ((vm >> (4 * nt + r)) & 1u) ? __builtin_amdgcn_exp2f(s[nt][r] - mr) : 0.f; p[nt][r] = pv; rs += pv; }
    }
    if (!NOSUM) l += rs;
    return sc;
}
DEV void attn_pv_pre(LAS unsigned char* lds, int buf, int lane, u32x4 (&va)[4], u32x4 (&vb)[4]) {
    const LAS bf16* Vt = (const LAS bf16*)(lds + (buf ? AL_VT1 : AL_VT)) + (lane & 15) * 72 + 4 * (lane >> 4);
#pragma unroll
    for (int i = 0; i < 4; ++i) { const u32x2 v0 = *(const LAS u32x2*)(Vt + 16 * i * 72), v1 = *(const LAS u32x2*)(Vt + 16 * i * 72 + 16); va[i].x = v0.x; va[i].y = v0.y; va[i].z = v1.x; va[i].w = v1.y; }
#pragma unroll
    for (int i = 0; i < 4; ++i) { const u32x2 v0 = *(const LAS u32x2*)(Vt + 16 * (4 + i) * 72), v1 = *(const LAS u32x2*)(Vt + 16 * (4 + i) * 72 + 16); vb[i].x = v0.x; vb[i].y = v0.y; vb[i].z = v1.x; vb[i].w = v1.y; }
}
template <bool WITH_L = false>
DEV void attn_pv(LAS unsigned char* lds, int buf, int lane, const f32x4 (&p)[4], f32x4 (&o)[8], u32x4 (&va)[4], u32x4 (&vb)[4], f32x4* lacc = nullptr) {
    const LAS bf16* Vt = (const LAS bf16*)(lds + (buf ? AL_VT1 : AL_VT)) + (lane & 15) * 72 + 4 * (lane >> 4);
    bf16x8 pb[2];
#pragma unroll
    for (int ks = 0; ks < 2; ++ks) {
        u32x4 pw; pw.x = pg8::cvt_pk_bf16(p[2 * ks][0], p[2 * ks][1]); pw.y = pg8::cvt_pk_bf16(p[2 * ks][2], p[2 * ks][3]); pw.z = pg8::cvt_pk_bf16(p[2 * ks + 1][0], p[2 * ks + 1][1]); pw.w = pg8::cvt_pk_bf16(p[2 * ks + 1][2], p[2 * ks + 1][3]);
        pb[ks] = __builtin_bit_cast(bf16x8, pw); }
    if (WITH_L) { const bf16x8 ones = __builtin_bit_cast(bf16x8, (u32x4){0x3f803f80u, 0x3f803f80u, 0x3f803f80u, 0x3f803f80u}); *lacc = mfma16(ones, pb[0], *lacc); *lacc = mfma16(ones, pb[1], *lacc); }
#define AT_LOADV(V_, ks_, d0_) do { _Pragma("unroll") for (int i = 0; i < 4; ++i) { const u32x2 v0 = *(const LAS u32x2*)(Vt + 16 * ((d0_) + i) * 72 + 32 * (ks_)), v1 = *(const LAS u32x2*)(Vt + 16 * ((d0_) + i) * 72 + 32 * (ks_) + 16); \
        V_[i].x = v0.x; V_[i].y = v0.y; V_[i].z = v1.x; V_[i].w = v1.y; } } while (0)
#define AT_MMAV(V_, ks_, d0_) do { __builtin_amdgcn_s_setprio(1); _Pragma("unroll") for (int i = 0; i < 4; ++i) o[(d0_) + i] = mfma16(__builtin_bit_cast(bf16x8, V_[i]), pb[ks_], o[(d0_) + i]); __builtin_amdgcn_s_setprio(0); } while (0)
    AT_PIN4(va); AT_MMAV(va, 0, 0); AT_LOADV(va, 1, 0);
    AT_PIN4(vb); AT_MMAV(vb, 0, 4); AT_LOADV(vb, 1, 4);
    AT_PIN4(va); AT_MMAV(va, 1, 0);
    AT_PIN4(vb); AT_MMAV(vb, 1, 4);
#undef AT_LOADV
#undef AT_MMAV
}
DEV void attn_load_q(Frame& F, int bg, int t0, bf16x8 (&qf)[4]) {
    const bf16* QN = WSP(bf16, WS_QN); const int rho = F.lane & 15;
    const bf16* src = QN + ((size_t)(bg * SEQ + t0 + 8 * F.wave + (rho & 7)) * 2 + (rho >> 3)) * 128 + 8 * (F.lane >> 4);
#pragma unroll
    for (int ks = 0; ks < 4; ++ks) qf[ks] = *(const bf16x8*)(src + 32 * ks);
}

DEV void sel_step(Frame& F, const bf16* KS, const bf16* VS, int j, int jn, int jnn, int qt, int cb, const u32x4 (&st_k)[2], const u32x4 (&st_v)[2], u32x4 (&ld_k)[2], u32x4 (&ld_v)[2],
                  const bf16x8 (&qf)[4], const u32x4& smw, const unsigned (&wum)[4], int tok, int hg, float& m, float& l, f32x4 (&o)[8], f32x4& lacc) {
    const int lane = F.lane;
    { const int jl = jnn <= qt ? jnn : qt;
      attn_load_tile(ld_k, ld_v, KS + (size_t)jl * 64 * 128, VS + (size_t)jl * 128 * 64, 64, F.tid); }
    const unsigned wsel = j < 32 ? wum[0] : (j < 64 ? wum[1] : (j < 96 ? wum[2] : wum[3]));
    if ((wsel >> (j & 31)) & 1u) {
        const unsigned w = j < 32 ? smw.x : (j < 64 ? smw.y : (j < 96 ? smw.z : smw.w)); const unsigned selbit = (w >> (j & 31)) & 1u;
        f32x4 s[4], p[4]; u32x4 va[4], vb[4];
        float sc;
        if (j <= qt - 14) { const unsigned vm = attn_scores<1, 1>(F.lds, cb, qf, lane, 64 * j, tok, hg, selbit, s); attn_pv_pre(F.lds, cb, lane, va, vb); sc = attn_online<true, true>(s, vm, m, l, p, ((const LAS float*)(F.lds + AL_TB))[hg * 792 + 790]); }
        else if (j >= qt - 11 && j < qt) { const unsigned vm = attn_scores<1, 2>(F.lds, cb, qf, lane, 64 * j, tok, hg, selbit, s); attn_pv_pre(F.lds, cb, lane, va, vb); sc = attn_online<true, true>(s, vm, m, l, p); }
        else { const unsigned vm = attn_scores<1, 0>(F.lds, cb, qf, lane, 64 * j, tok, hg, selbit, s); attn_pv_pre(F.lds, cb, lane, va, vb); sc = attn_online<false, true>(s, vm, m, l, p); }
        if (__ballot(sc != 1.0f) != 0ull) {
#pragma unroll
            for (int dt = 0; dt < 8; ++dt) o[dt] = o[dt] * sc;
            lacc = lacc * sc; }
        attn_pv<true>(F.lds, cb, lane, p, o, va, vb, &lacc);
    }
    if (jn <= qt) attn_store_tile(F.lds, cb ^ 1, st_k, st_v, F.tid);
    __syncthreads();
}
DEV int sel_next(int j, int qt, const unsigned (&um)[4]) {
    int jn = j + 1;
    while (jn <= qt) { const unsigned w = jn < 32 ? um[0] : (jn < 64 ? um[1] : (jn < 96 ? um[2] : um[3])); if ((w >> (jn & 31)) & 1u) break; ++jn; }
    return jn;
}
#define NST(k) do { if (DBG_AJOB >= 10 && F.tid == 0) { volatile LAS unsigned* m_ = (volatile LAS unsigned*)(F.lds + MISC_OFF); const unsigned t_ = (unsigned)__builtin_amdgcn_s_memrealtime(); \
        if (DBG_AJOB == (k)) atomicAdd(WSP(unsigned, WS_CTL) + 460000, t_ - m_[70]); m_[70] = t_; } } while (0)
DEV void nsa_job(Frame& F, int job) {
    const int bg = job >> 7, qt = job & 127, b = bg >> 1, g = bg & 1, t0 = 64 * qt, tid = F.tid, lane = F.lane, wave = F.wave;
    const float zf_ = opaque_zero();
    const int fq = lane >> 4, fr = lane & 15, hg = fr >> 3, tok = t0 + 8 * wave + (fr & 7);
    const float* small = WSP(float, WS_SMALL); const size_t row = (size_t)(b * SEQ + tok);
    LAS float* PS = (LAS float*)(F.lds + AL_PS) + wave * (8 * 65); LAS float* IMP = (LAS float*)(F.lds + AL_IMP);
    LAS unsigned* SM = (LAS unsigned*)(F.lds + AL_SM);
    LAS unsigned* UW = (LAS unsigned*)(F.lds + AL_UW);
    __syncthreads();
    NST(0);
    attn_fill_bias(F, g);
    for (int i = tid; i < 64 * 128; i += 512) IMP[i] = 0.f;
    if (lane < 8) PS[lane * 65] = 0.f;
    bf16x8 qf[4]; attn_load_q(F, bg, t0, qf);
    f32x4 tot[8];
    u32x4 rk[2], rv[2];
    NST(10);
    for (int dr_ = 0; dr_ < (DBG_NSA == 1 ? 2 : 1); ++dr_) {
        if (dr_ == 1) { WAVE_SYNC(); if (lane < 8) PS[lane * 65] = 0.f; WAVE_SYNC(); }
        const int ntiles = (4 * qt + 2) / 64 + 1;
        const bf16* KC = WSP(bf16, WS_KCMP) + (size_t)bg * 512 * 128; const bf16* VC = WSP(bf16, WS_VCMPT) + (size_t)bg * 128 * 512;
        float m = -1e30f, l = 0.f;
        attn_load_tile(rk, rv, KC, VC, 512, tid); attn_store_tile(F.lds, 0, rk, rv, tid); __syncthreads();
        for (int j = 0; j < ntiles; ++j) {
            if (j + 1 < ntiles) attn_load_tile(rk, rv, KC + (size_t)(j + 1) * 64 * 128, VC + (j + 1) * 64, 512, tid);
            f32x4 s[4], p[4];
            const unsigned vm = attn_scores<0>(F.lds, j & 1, qf, lane, 64 * j, tok, hg, 0u, s);
            (void)attn_online(s, vm, m, l, p);
            if (j + 1 < ntiles) attn_store_tile(F.lds, (j + 1) & 1, rk, rv, tid);
            __syncthreads();
        }
        l += shx<16>(l); l += shx<32>(l);
        const float il = l > 0.f ? 1.0f / l : 0.f;
        f32x4 o[8];
#pragma unroll
        for (int dt = 0; dt < 8; ++dt) o[dt] = ZERO4;
        attn_load_tile(rk, rv, KC, VC, 512, tid); attn_store_tile(F.lds, 0, rk, rv, tid); __syncthreads();
        for (int j = 0; j < ntiles; ++j) {
            if (j + 1 < ntiles) attn_load_tile(rk, rv, KC + (size_t)(j + 1) * 64 * 128, VC + (j + 1) * 64, 512, tid);
            f32x4 s[4], p[4];
            const unsigned vm = attn_scores<0>(F.lds, j & 1, qf, lane, 64 * j, tok, hg, 0u, s);
#pragma unroll
            for (int nt = 0; nt < 4; ++nt)
#pragma unroll
                for (int r = 0; r < 4; ++r) {
                    const float pv = ((vm >> (4 * nt + r)) & 1u) ? __builtin_amdgcn_exp2f(s[nt][r] - m) * il : 0.f; p[nt][r] = pv;
                    const float ps = pv + shx<8>(pv);
                    if (fr < 8) PS[fr * 65 + 1 + 16 * nt + 4 * fq + r] = ps;
                }
            WAVE_SYNC();
#pragma unroll
            for (int q = 0; q < 2; ++q) { const int idx = lane + 64 * q, tk = idx >> 4, bl = idx & 15; const LAS float* ps = PS + tk * 65 + 4 * bl;
                IMP[(8 * wave + tk) * 128 + 16 * j + bl] = ps[0] + 2.0f * ps[1] + 2.0f * ps[2] + 2.0f * ps[3] + ps[4]; }
            WAVE_SYNC();
            if (lane < 8) PS[lane * 65] = PS[lane * 65 + 64];
            WAVE_SYNC();
            { u32x4 va[4], vb[4]; attn_pv_pre(F.lds, j & 1, lane, va, vb); attn_pv(F.lds, j & 1, lane, p, o, va, vb); }
            if (j + 1 < ntiles) attn_store_tile(F.lds, (j + 1) & 1, rk, rv, tid);
            __syncthreads();
        }
        const float gt = (DBG_NSAZ & 1) ? zf_ : sigmoidf_(small[row * SMW + S_BG + (2 * g + hg) * 3 + 0]);
#pragma unroll
        for (int dt = 0; dt < 8; ++dt) tot[dt] = o[dt] * gt;
    }
    NST(11);
    unsigned wum[4] = {0u, 0u, 0u, 0u};
    for (int dr_ = 0; dr_ < (DBG_NSA == 4 ? 2 : 1); ++dr_) {
        const int cur = qt;
        for (int tk = 0; tk < 8; ++tk) {
            const LAS float* rowp = IMP + (8 * wave + tk) * 128;
            const int b0 = lane, b1 = lane + 64;
            const float s0 = b0 > cur ? -1e4f : ((b0 == 0 || b0 >= cur - 1) ? 1e4f : rowp[b0]);
            const float s1 = b1 > cur ? -1e4f : ((b1 == 0 || b1 >= cur - 1) ? 1e4f : rowp[b1]);
            unsigned k0 = __builtin_bit_cast(unsigned, s0), k1 = __builtin_bit_cast(unsigned, s1);
            k0 = (k0 & 0x80000000u) ? ~k0 : (k0 | 0x80000000u); k1 = (k1 & 0x80000000u) ? ~k1 : (k1 | 0x80000000u);
            unsigned prefix = 0u; int need = 16;
            for (int bit = 31; bit >= 0; --bit) {
                const unsigned cand = (prefix | (1u << bit)) >> bit;
                const int cnt = __builtin_popcountll(__ballot((k0 >> bit) == cand)) + __builtin_popcountll(__ballot((k1 >> bit) == cand));
                if (cnt >= need) prefix |= (1u << bit); else need -= cnt;
            }
            const unsigned long long e0 = __ballot(k0 == prefix), e1 = __ballot(k1 == prefix);
            const int r0 = (int)__builtin_amdgcn_mbcnt_hi((unsigned)(e0 >> 32), __builtin_amdgcn_mbcnt_lo((unsigned)e0, 0u));
            const int r1 = __builtin_popcountll(e0) + (int)__builtin_amdgcn_mbcnt_hi((unsigned)(e1 >> 32), __builtin_amdgcn_mbcnt_lo((unsigned)e1, 0u));
            const bool sel0 = k0 > prefix || (k0 == prefix && r0 < need), sel1 = k1 > prefix || (k1 == prefix && r1 < need);
            const unsigned long long m0 = __ballot(sel0), m1 = __ballot(sel1);
            const unsigned w0 = (unsigned)m0, w1 = (unsigned)(m0 >> 32), w2 = (unsigned)m1, w3 = (unsigned)(m1 >> 32);
            wum[0] |= w0; wum[1] |= w1; wum[2] |= w2; wum[3] |= w3;
            if (lane == 0) { SM[(8 * wave + tk) * 4 + 0] = w0; SM[(8 * wave + tk) * 4 + 1] = w1; SM[(8 * wave + tk) * 4 + 2] = w2; SM[(8 * wave + tk) * 4 + 3] = w3; }
        }
        if (lane == 0) { UW[wave * 4 + 0] = wum[0]; UW[wave * 4 + 1] = wum[1]; UW[wave * 4 + 2] = wum[2]; UW[wave * 4 + 3] = wum[3]; }
    }
    __syncthreads();
    const u32x4 smw = *(const LAS u32x4*)(SM + (8 * wave + (fr & 7)) * 4);
    unsigned um[4];
#pragma unroll
    for (int w = 0; w < 4; ++w) { unsigned v = 0u;
#pragma unroll
        for (int q = 0; q < 8; ++q) v |= UW[q * 4 + w];
        um[w] = __builtin_amdgcn_readfirstlane(v); }
    const bf16* KS = WSP(bf16, WS_KS) + (size_t)bg * SEQ * 128; const bf16* VS = WSP(bf16, WS_VST) + (size_t)bg * 128 * 8192;
    const bf16* KW = WSP(bf16, WS_KW) + (size_t)bg * SEQ * 128; const bf16* VW = WSP(bf16, WS_VWT) + (size_t)bg * 128 * 8192;
    NST(12);
    for (int dr_ = 0; dr_ < (DBG_NSA == 2 ? 2 : 1); ++dr_) {
        float m = -1e30f, l = 0.f; f32x4 o[8]; f32x4 lacc = ZERO4;
#pragma unroll
        for (int dt = 0; dt < 8; ++dt) o[dt] = ZERO4;
        u32x4 rk2[2], rv2[2];
        int j = 0, jn = sel_next(0, qt, um), cb = 0;
        attn_load_tile(rk, rv, KS, VS, 64, tid); attn_store_tile(F.lds, 0, rk, rv, tid);
        if (jn <= qt) attn_load_tile(rk, rv, KS + (size_t)jn * 64 * 128, VS + (size_t)jn * 128 * 64, 64, tid);
        __syncthreads();
        while (j <= qt) {
            int jnn = jn <= qt ? sel_next(jn, qt, um) : jn;
            sel_step(F, KS, VS, j, jn, jnn, qt, cb, rk, rv, rk2, rv2, qf, smw, wum, tok, hg, m, l, o, lacc);
            cb ^= 1; j = jn; jn = jnn;
            if (j > qt) break;
            jnn = jn <= qt ? sel_next(jn, qt, um) : jn;
            sel_step(F, KS, VS, j, jn, jnn, qt, cb, rk2, rv2, rk, rv, qf, smw, wum, tok, hg, m, l, o, lacc);
            cb ^= 1; j = jn; jn = jnn;
        }
        l = lacc[0];
        const float gt = ((DBG_NSA == 2 && dr_ == 0) || (DBG_NSAZ & 2)) ? zf_ * l : sigmoidf_(small[row * SMW + S_BG + (2 * g + hg) * 3 + 1]) / l;
#pragma unroll
        for (int dt = 0; dt < 8; ++dt) tot[dt] = tot[dt] + o[dt] * gt;
    }
    NST(13);
    for (int dr_ = 0; dr_ < (DBG_NSA == 3 ? 2 : 1); ++dr_) {
        float m = -1e30f, l = 0.f; f32x4 o[8]; f32x4 lacc = ZERO4;
#pragma unroll
        for (int dt = 0; dt < 8; ++dt) o[dt] = ZERO4;
        const int j0 = qt >= 8 ? qt - 8 : 0;
        attn_load_tile(rk, rv, KW + (size_t)j0 * 64 * 128, VW + (size_t)j0 * 128 * 64, 64, tid); attn_store_tile(F.lds, 0, rk, rv, tid); __syncthreads();
        for (int j = j0; j <= qt; ++j) {
            const int cb = (j - j0) & 1;
            if (j + 1 <= qt) attn_load_tile(rk, rv, KW + (size_t)(j + 1) * 64 * 128, VW + (size_t)(j + 1) * 128 * 64, 64, tid);
            f32x4 s[4], p[4]; u32x4 va[4], vb[4];
            float sc;
            if (j >= qt - 7 && j < qt) { const unsigned vm = attn_scores<2, 2>(F.lds, cb, qf, lane, 64 * j, tok, hg, 0u, s); attn_pv_pre(F.lds, cb, lane, va, vb); sc = attn_online<true, true>(s, vm, m, l, p); }
            else { const unsigned vm = attn_scores<2, 0>(F.lds, cb, qf, lane, 64 * j, tok, hg, 0u, s); attn_pv_pre(F.lds, cb, lane, va, vb); sc = attn_online<false, true>(s, vm, m, l, p); }
#pragma unroll
            for (int dt = 0; dt < 8; ++dt) o[dt] = o[dt] * sc;
            lacc = lacc * sc;
            attn_pv<true>(F.lds, cb, lane, p, o, va, vb, &lacc);
            if (j + 1 <= qt) attn_store_tile(F.lds, cb ^ 1, rk, rv, tid);
            __syncthreads();
        }
        l = lacc[0];
        const float gt = ((DBG_NSA == 3 && dr_ == 0) || (DBG_NSAZ & 4)) ? zf_ * l : sigmoidf_(small[row * SMW + S_BG + (2 * g + hg) * 3 + 2]) / l;
#pragma unroll
        for (int dt = 0; dt < 8; ++dt) tot[dt] = tot[dt] + o[dt] * gt;
    }
    NST(14);
    {
        bf16* YC = WSP(bf16, WS_YCAT);
#pragma unroll
        for (int dt = 0; dt < 8; ++dt) { const int cidx = (2 * g + hg) * 128 + 16 * dt + 4 * fq;
            f32x4 y = tot[dt]; if (DBG_ZERO & 2) y = ZERO4;
            u32x2 w; w.x = pk2(y[0], y[1]); w.y = pk2(y[2], y[3]); *(u32x2*)(YC + row * 2048 + 512 + cidx) = w; }
    }
    __syncthreads();
    NST(15);
}
#undef NST

DEV void gdn_scan_job(Frame& F, int job) {
    const int bh = job >> 3, sl = job & 7, b = bh >> 2, h = bh & 3, lane = F.lane, wave = F.wave, fq = lane >> 4, fr = lane & 15;
    LAS bf16* St = (LAS bf16*)F.lds;
    LAS bf16* Vn = St + 16 * 136;
    const float* GL = WSP(float, WS_GL); float* GO = WSP(float, WS_GO);
    const float zf_ = opaque_zero();
    __syncthreads();
    for (int i = F.tid; i < 16 * 136 / 2; i += 512) ((LAS unsigned*)St)[i] = 0u;
    f32x4 S = ZERO4;
    const int mt = wave & 3;
    __syncthreads();
    const int o1 = (wave < 4 ? 0 : 8192) + (16 * mt + fr) * 128 + 8 * fq;
    const int oA = 32768 + (16 * mt + fr) * 64 + 8 * fq;
    const int oK = 16384 + (16 * wave + fr) * 64 + 8 * fq;
    const int oU = 24576 + (16 * sl + fr) * 64 + 16 * mt + 4 * fq;
    const bf16* rec = (const bf16*)(F.ws + WS_GW + (size_t)(bh * 128) * GDN_CH_BYTES);
    bf16x8 a1[4], aA[2], aK[2], n1[4], nA[2], nK[2]; u32x2 uu, nu; float gl, ngl;
#define GLOAD(A1, AA, AK, UU, G, c_) do { const bf16* r_ = rec + (size_t)(c_) * (GDN_CH_BYTES / 2); \
        _Pragma("unroll") for (int ks = 0; ks < 4; ++ks) A1[ks] = *(const bf16x8*)(r_ + o1 + 32 * ks); \
        AA[0] = *(const bf16x8*)(r_ + oA); AA[1] = *(const bf16x8*)(r_ + oA + 32); AK[0] = *(const bf16x8*)(r_ + oK); AK[1] = *(const bf16x8*)(r_ + oK + 32); \
        UU = *(const u32x2*)(r_ + oU); G = GL[bh * 128 + (c_)]; } while (0)
    GLOAD(a1, aA, aK, uu, gl, 0);
    for (int c = 0; c < 128; ++c) {
        const int cn = c + 1 < 128 ? c + 1 : c;
        GLOAD(n1, nA, nK, nu, ngl, cn);
        f32x4 d1 = ZERO4;
#pragma unroll
        for (int ks = 0; ks < 4; ++ks) d1 = mfma16(a1[ks], frag_l(St, 136, 0, 32 * ks, lane), d1);
        if (wave < 4) {
            const float v0 = bflo(uu.x) - d1[0], v1 = bfhi(uu.x) - d1[1], v2 = bflo(uu.y) - d1[2], v3 = bfhi(uu.y) - d1[3];
            u32x2 w; w.x = pk2(v0, v1); w.y = pk2(v2, v3);
            *(LAS u32x2*)(Vn + fr * 72 + 16 * mt + 4 * fq) = w;
        }
        LDS_WAIT(); __builtin_amdgcn_s_barrier(); CFENCE();
        const bf16x8 bv0 = frag_l(Vn, 72, 0, 0, lane), bv1 = frag_l(Vn, 72, 0, 32, lane);
        if (wave >= 4) {
            d1 = mfma16(aA[0], bv0, d1); d1 = mfma16(aA[1], bv1, d1);
#pragma unroll
            for (int r = 0; r < 4; ++r) GO[(size_t)(b * SEQ + 64 * c + 16 * mt + 4 * fq + r) * 512 + h * 128 + 16 * sl + fr] = d1[r];
        }
        f32x4 dk = ZERO4;
        dk = mfma16(aK[0], bv0, dk); dk = mfma16(aK[1], bv1, dk);
        S = S * gl + dk;
        { u32x2 w; w.x = pk2(S[0], S[1]); w.y = pk2(S[2], S[3]); *(LAS u32x2*)(St + fr * 136 + 16 * wave + 4 * fq) = w; }
        LDS_WAIT(); __builtin_amdgcn_s_barrier(); CFENCE();
#pragma unroll
        for (int ks = 0; ks < 4; ++ks) a1[ks] = n1[ks];
        aA[0] = nA[0]; aA[1] = nA[1]; aK[0] = nK[0]; aK[1] = nK[1]; uu = nu; gl = ngl;
    }
#undef GLOAD
    __syncthreads();
}

DEV void ssd_scan_part(Frame& F, int part, int nparts) {
    float* __restrict__ SST = WSP(float, WS_SST); const float* __restrict__ SCD = WSP(float, WS_SCD);
    constexpr int PER_B = 16 * 64 * 128;
    for (int e = part * 512 + F.tid; e < 2 * PER_B; e += nparts * 512) {
        const int b = e / PER_B, r = e - b * PER_B, h = r >> 13;
        float* p = SST + (size_t)(b * 64) * PER_B + r; const float* cdp = SCD + (b * 64) * 16 + h;
        float s = 0.f;
#pragma unroll
        for (int hb = 0; hb < 2; ++hb) {
            float v[32], cd[32];
#pragma unroll
            for (int c = 0; c < 32; ++c) { v[c] = p[(size_t)(32 * hb + c) * PER_B]; cd[c] = cdp[(32 * hb + c) * 16]; }
#pragma unroll
            for (int c = 0; c < 32; ++c) { p[(size_t)(32 * hb + c) * PER_B] = s; s = s * cd[c] + v[c]; }
        }
    }
}

DEV void gdn_final_rows(Frame& F, int l, int w0, int nw) {
    const float* GO = WSP(float, WS_GO); const bf16* p1 = WSP(bf16, WS_P1); bf16* YC = WSP(bf16, WS_YCAT); const float* gn = lin(F, I_GNORM, l, 128);
    const int lane = F.lane, dv0 = (lane & 15) * 8;
    float gv[8];
#pragma unroll
    for (int j = 0; j < 8; ++j) gv[j] = gn[dv0 + j];
    for (int row = w0; row < MTOK; row += nw) {
        const f32x4 a = *(const f32x4*)(GO + (size_t)row * 512 + lane * 8), bq = *(const f32x4*)(GO + (size_t)row * 512 + lane * 8 + 4);
        float ss = (a[0] * a[0] + a[1] * a[1]) + (a[2] * a[2] + a[3] * a[3]) + (bq[0] * bq[0] + bq[1] * bq[1]) + (bq[2] * bq[2] + bq[3] * bq[3]);
        ss = sum16(ss);
        const float rs = rsqrtf(ss * (1.0f / 128.0f) + EPS);
        const u32x4 zw = *(const u32x4*)(p1 + (size_t)row * P1W + C_AZ + lane * 8);
        const float z[8] = {bflo(zw.x), bfhi(zw.x), bflo(zw.y), bfhi(zw.y), bflo(zw.z), bfhi(zw.z), bflo(zw.w), bfhi(zw.w)};
        const float o[8] = {a[0], a[1], a[2], a[3], bq[0], bq[1], bq[2], bq[3]};
        float y[8];
#pragma unroll
        for (int j = 0; j < 8; ++j) y[j] = (DBG_ZERO & 1) ? opaque_zero() : o[j] * rs * gv[j] * siluf_(z[j]);
        u32x4 w; w.x = pk2(y[0], y[1]); w.y = pk2(y[2], y[3]); w.z = pk2(y[4], y[5]); w.w = pk2(y[6], y[7]);
        *(u32x4*)(YC + (size_t)row * 2048 + lane * 8) = w;
    }
}

DEV void ssd_out_job(Frame& F, int l, int job) {
    const int b = job >> 7, c = (job >> 1) & 63, g = job & 1, t0 = 128 * c, tid = F.tid, lane = F.lane, wave = F.wave, fq = lane >> 4, fr = lane & 15;
    const bf16* SX = WSP(bf16, WS_SX); const bf16* p1 = WSP(bf16, WS_P1); const float* SDT = WSP(float, WS_SDT); const float* SAC = WSP(float, WS_SAC); const float* SST = WSP(float, WS_SST);
    bf16* YC = WSP(bf16, WS_YCAT); float* RC = WSP(float, WS_SRC);
    const float zf_ = opaque_zero();
    LAS bf16* Cs = (LAS bf16*)F.lds;
    LAS bf16* Bs = Cs + 128 * 136;
    LAS bf16* XdT = Bs + 128 * 136;
    LAS bf16* SiT = XdT + 64 * 136;
    LAS bf16* Pw = SiT + 64 * 136;
    LAS float* acs = (LAS float*)(Pw + 8 * 16 * 136);
    __syncthreads();
    for (int i = tid; i < 2 * 128 * 16; i += 512) { const int v = i >> 11, r = (i >> 4) & 127, c8 = (i & 15) * 8;
        const u32x4 w = *(const u32x4*)(SX + (size_t)(b * SEQ + t0 + r) * 1536 + 1024 + (v ? 256 : 0) + g * 128 + c8);
        *(LAS u32x4*)((v ? Cs : Bs) + r * 136 + c8) = w; }
    for (int i = tid; i < 1024; i += 512) { const size_t row = (size_t)(b * SEQ + t0 + (i >> 3)); acs[i] = SAC[row * 16 + 8 * g + (i & 7)]; }
    __syncthreads();
    f32x4 cb[8];
    {
        bf16x8 ca[4];
#pragma unroll
        for (int ks = 0; ks < 4; ++ks) ca[ks] = frag_l(Cs, 136, 16 * wave, 32 * ks, lane);
#pragma unroll
        for (int nt = 0; nt < 8; ++nt) { cb[nt] = ZERO4;
#pragma unroll
            for (int ks = 0; ks < 4; ++ks) cb[nt] = mfma16(ca[ks], frag_l(Bs, 136, 16 * nt, 32 * ks, lane), cb[nt]); }
    }
    float ssq = 0.f;
    LAS bf16* pw = Pw + wave * 16 * 136;
    const float* dsk = lin(F, I_SD, l, 16);
    const int sp = tid & 7, tp = tid >> 3; const size_t rp0 = (size_t)(b * SEQ + t0 + 2 * tp);
    const size_t rowl = (size_t)(b * SEQ + t0 + 16 * wave + fr);
    u32x4 x0, x1; float d0, d1; f32x4 sv[4];
#define SSD_LOADH(h_) do { x0 = *(const u32x4*)(SX + rp0 * 1536 + (h_) * 64 + 8 * sp); x1 = *(const u32x4*)(SX + (rp0 + 1) * 1536 + (h_) * 64 + 8 * sp); d0 = SDT[rp0 * 16 + (h_)]; d1 = SDT[(rp0 + 1) * 16 + (h_)]; \
        const float* sin_ = SST + ((size_t)((b * 64 + c) * 16 + (h_)) * 64) * 128; _Pragma("unroll") for (int q = 0; q < 4; ++q) sv[q] = *(const f32x4*)(sin_ + (size_t)(tid + 512 * q) * 4); } while (0)
    SSD_LOADH(8 * g);
    for (int hh = 0; hh < 8; ++hh) {
        const int h = 8 * g + hh;
        __syncthreads();
        {
            const unsigned xw0[4] = {x0.x, x0.y, x0.z, x0.w}, xw1[4] = {x1.x, x1.y, x1.z, x1.w};
#pragma unroll
            for (int j = 0; j < 8; ++j) { const float a = ((j & 1) ? bfhi(xw0[j >> 1]) : bflo(xw0[j >> 1])) * d0, bb = ((j & 1) ? bfhi(xw1[j >> 1]) : bflo(xw1[j >> 1])) * d1;
                *(LAS unsigned*)(XdT + (8 * sp + j) * 136 + 2 * tp) = pk2(a, bb); }
#pragma unroll
            for (int q = 0; q < 4; ++q) { const int i = tid + 512 * q, p = i >> 5, n4 = (i & 31) * 4; u32x2 w; w.x = pk2(sv[q][0], sv[q][1]); w.y = pk2(sv[q][2], sv[q][3]); *(LAS u32x2*)(SiT + p * 136 + n4) = w; }
        }
        float al[4];
#pragma unroll
        for (int r = 0; r < 4; ++r) al[r] = acs[(16 * wave + 4 * fq + r) * 8 + hh];
#pragma unroll
        for (int nt = 0; nt < 8; ++nt) { const int s = 16 * nt + fr; const float as = acs[s * 8 + hh];
#pragma unroll
            for (int r = 0; r < 4; ++r) { const int li = 16 * wave + 4 * fq + r; const float v = s <= li ? cb[nt][r] * __expf(al[r] - as) : 0.f; pw[(4 * fq + r) * 136 + s] = (bf16)f2bf(v); } }
        u32x2 xv[4], zv[4];
#pragma unroll
        for (int nt = 0; nt < 4; ++nt) { xv[nt] = *(const u32x2*)(SX + rowl * 1536 + h * 64 + 16 * nt + 4 * fq); zv[nt] = *(const u32x2*)(p1 + rowl * P1W + C_CZ + h * 64 + 16 * nt + 4 * fq); }
        if (hh + 1 < 8) SSD_LOADH(h + 1);
        __syncthreads();
        f32x4 y[4], ys[4];
#pragma unroll
        for (int nt = 0; nt < 4; ++nt) { y[nt] = ZERO4; ys[nt] = ZERO4; }
#pragma unroll
        for (int ks = 0; ks < 4; ++ks) { const bf16x8 pa = frag_l(pw, 136, 0, 32 * ks, lane), cc = frag_l(Cs, 136, 16 * wave, 32 * ks, lane);
#pragma unroll
            for (int nt = 0; nt < 4; ++nt) { y[nt] = mfma16(frag_l(XdT, 136, 16 * nt, 32 * ks, lane), pa, y[nt]); ys[nt] = mfma16(frag_l(SiT, 136, 16 * nt, 32 * ks, lane), cc, ys[nt]); } }
        const float dh = dsk[h], ea = __expf(acs[(16 * wave + fr) * 8 + hh]);
#pragma unroll
        for (int nt = 0; nt < 4; ++nt) {
            const float xs[4] = {bflo(xv[nt].x), bfhi(xv[nt].x), bflo(xv[nt].y), bfhi(xv[nt].y)}, zz[4] = {bflo(zv[nt].x), bfhi(zv[nt].x), bflo(zv[nt].y), bfhi(zv[nt].y)};
            float v[4];
#pragma unroll
            for (int r = 0; r < 4; ++r) { v[r] = (DBG_ZERO & 4) ? zf_ : (y[nt][r] + ea * ys[nt][r] + xs[r] * dh) * siluf_(zz[r]); ssq += v[r] * v[r]; }
            u32x2 w; w.x = pk2(v[0], v[1]); w.y = pk2(v[2], v[3]); *(u32x2*)(YC + rowl * 2048 + 1024 + h * 64 + 16 * nt + 4 * fq) = w;
        }
    }
#undef SSD_LOADH
    { float s = ssq; s += shx<16>(s); s += shx<32>(s); if (fq == 0) RC[rowl * 2 + g] = rsqrtf(s * (1.0f / 512.0f) + EPS); }
    __syncthreads();
}

constexpr int NPH = 12;
#ifndef CPU_EMU
DEV unsigned long long launder64(unsigned long long v) {
    unsigned lo = __builtin_amdgcn_readfirstlane((unsigned)v), hi = __builtin_amdgcn_readfirstlane((unsigned)(v >> 32));
    asm volatile("" : "+s"(lo), "+s"(hi));
    return ((unsigned long long)hi << 32) | lo;
}
DEV bool phase_begin(Frame& F, const Params& prm, int wave0) {
    F.ws = as_global((unsigned char*)launder64((unsigned long long)prm.ws));
    F.p = (KParams)launder64((unsigned long long)__builtin_amdgcn_kernarg_segment_ptr());
    unsigned z = 0u; asm volatile("" : "+v"(z)); const int ln = (int)__builtin_amdgcn_mbcnt_hi(~0u, __builtin_amdgcn_mbcnt_lo(~0u, z));
    int wv = wave0; asm volatile("" : "+s"(wv)); F.wave = wv; F.lane = ln; F.tid = wv * 64 + ln;
    int bi = __builtin_amdgcn_readfirstlane(blockIdx.x); asm volatile("" : "+s"(bi)); F.bid = bi;
    int gg = __builtin_amdgcn_readfirstlane(gridDim.x); asm volatile("" : "+s"(gg)); F.G = gg;
    unsigned la = __builtin_amdgcn_readfirstlane((unsigned)(size_t)F.lds); asm volatile("" : "+s"(la)); F.lds = (LAS unsigned char*)(size_t)la;
    return true;
}
DEV void job_begin(Frame& F) { int t = F.tid; asm volatile("" : "+v"(t)); F.tid = t; F.lane = t & 63; }
__global__ void __launch_bounds__(512, 2) hybrid_fwd(Params prm) {
    extern __shared__ __attribute__((aligned(16))) unsigned char lds_raw[];
    Frame F;
    F.lds = (LAS unsigned char*)lds_raw; F.tid = threadIdx.x; F.lane = F.tid & 63; F.wave = __builtin_amdgcn_readfirstlane(F.tid >> 6);
    const int wave0 = F.wave;
    F.G = gridDim.x; F.bid = blockIdx.x; F.p = (KParams)__builtin_amdgcn_kernarg_segment_ptr(); F.ws = as_global(prm.ws);
    volatile LAS unsigned* MISC = (volatile LAS unsigned*)(F.lds + MISC_OFF);
    if (F.tid < 64) MISC[F.tid] = 0u;
    if (DBG_TMASK && F.tid < 8) MISC[64 + F.tid] = 0u;
    __syncthreads();
    unsigned* ctl = (unsigned*)(F.ws + WS_CTL);
    XcdBarrier bar; bar.bar = ctl + CW_BAR; bar.x = 0; bar.st = nullptr;
    if (prm.use_bar) bar = xcd_barrier_post(ctl + CW_BAR, MISC + 8);
    const int lo = prm.lo, hi = prm.hi;
    for (int l = 0; l < DEPTH; ++l) {
#define IN(k) (lo <= l * NPH + (k) && l * NPH + (k) < hi && phase_begin(F, prm, wave0))
#define REP_BEGIN(k) for (int rep_ = 0; rep_ < ((DBG_REP == (k)) ? 2 : 1); ++rep_) {
#define REP_END(k) if (DBG_REP == (k) && rep_ == 0) { XcdBarrier bb_ = bar; bb_.bar = (unsigned*)launder64((unsigned long long)bar.bar); xcd_barrier(bb_); } }
#define SEAM(k) do { if (l * NPH + (k) + 1 < hi && prm.use_bar) { XcdBarrier bb_ = bar; bb_.bar = (unsigned*)launder64((unsigned long long)bar.bar); { unsigned x_ = __builtin_amdgcn_readfirstlane(bar.x); asm volatile("" : "+s"(x_)); bb_.x = x_; } xcd_barrier(bb_); } } while (0)
#define TB(k) do { if (((DBG_TMASK >> (k)) & 1) && F.bid == 0 && F.tid == 0) { volatile LAS unsigned* m_ = (volatile LAS unsigned*)(F.lds + MISC_OFF); m_[64] = (unsigned)__builtin_amdgcn_s_memrealtime(); m_[68] = 1u; } } while (0)
#define TE(k) do { if (((DBG_TMASK >> (k)) & 1) && F.bid == 0 && F.tid == 0) { volatile LAS unsigned* m_ = (volatile LAS unsigned*)(F.lds + MISC_OFF); if (!DBG_TEPI) m_[66] = m_[66] + ((unsigned)__builtin_amdgcn_s_memrealtime() - m_[64]); m_[68] = 0u; } } while (0)
#define JT(ty, call) do { if (DBG_AJOB == (ty) && F.tid == 0) { volatile LAS unsigned* m_ = (volatile LAS unsigned*)(F.lds + MISC_OFF); m_[70] = (unsigned)__builtin_amdgcn_s_memrealtime(); } \
        call; if (DBG_AJOB == (ty) && F.tid == 0) { volatile LAS unsigned* m_ = (volatile LAS unsigned*)(F.lds + MISC_OFF); atomicAdd(WSP(unsigned, WS_CTL) + 460000, (unsigned)__builtin_amdgcn_s_memrealtime() - m_[70]); } } while (0)
#define RSB(i) (WSP(unsigned long long, WS_CTL) + CW_RS / 2 + (size_t)(3 * l + (i)) * MTOK)
#define XB WSP(bf16, WS_XB)
#define ACT WSP(bf16, WS_ACT)
        if (IN(0)) { TB(0); REP_BEGIN(0) phase_convert(F, l); REP_END(0) SEAM(0); TE(0); }
        if (IN(1)) { TB(1); REP_BEGIN(1) pg8::Gemm g{XB, WSP(bf16, WS_WUP1), MTOK, NUP, DM, DM, DM}; pg8::StaticOrder S; S.init(MTOK, NUP, F.G, F.bid);
            pg8::EpiSwiGLU E{ACT, RSB(0)}; pg8::gemm_phase<pg8::EpiSwiGLU, pg8::StaticOrder>(F.lds, F.tid, g, S, E); REP_END(1) SEAM(1); TE(1); }
        if (IN(2)) { TB(2); pg8::Gemm g{ACT, WSP(bf16, WS_WDN1), MTOK, DM, DFF, DFF, DFF}; pg8::StaticOrder S; S.init(MTOK, DM, F.G, F.bid, 4);
            pg8::EpiResidual E{nullptr, XB, RSB(1), 0.5f}; pg8::gemm_phase<pg8::EpiResidual, pg8::StaticOrder>(F.lds, F.tid, g, S, E); SEAM(2); TE(2); }
        if (IN(3)) { TB(3); REP_BEGIN(3) pg8::Gemm g{XB, WSP(bf16, WS_WIN), MTOK, NINP, DM, DM, DM}; pg8::StaticOrder S; S.init(MTOK, NINP, F.G, F.bid);
            pg8::EpiWin E{WSP(bf16, WS_P1), WSP(float, WS_SMALL), WSP(bf16, WS_GATE), RSB(1)}; pg8::gemm_phase<pg8::EpiWin, pg8::StaticOrder>(F.lds, F.tid, g, S, E); REP_END(3) SEAM(3); TE(3); }
        if (IN(4)) { TB(4);
            REP_BEGIN(4)
            {
                unsigned* ctr = WSP(unsigned, WS_CTL) + CW_WQ + 64 * (8 + l * 2 + rep_);
                LAS unsigned* jslot = (LAS unsigned*)(F.lds + MISC_OFF + 128);
                for (;;) {
                    __syncthreads();
                    if (F.tid == 0) *jslot = __hip_atomic_fetch_add(ctr, 1u, __ATOMIC_RELAXED, __HIP_MEMORY_SCOPE_AGENT);
                    __syncthreads();
                    const int j = (int)*jslot;
                    if (j >= 32 + 1024 + 256 + 512) break;
                    job_begin(F);
                    if (j < 32) JT(1, nsa_compress_job(F, l, j));
                    else if (j < 32 + 256) JT(2, ssd_prep_job(F, l, j - 32));
                    else if (j < 32 + 256 + 1024) JT(3, gdn_prep_job(F, l, j - 32 - 256));
                    else JT(4, nsa_prep_job(F, l, j - 32 - 256 - 1024));
                }
            }
            REP_END(4)
            SEAM(4); TE(4);
        }
        if (IN(5)) { TB(5);
            REP_BEGIN(5)
            if (F.bid < 64) JT(6, gdn_scan_job(F, (F.bid & 7) * 8 + (F.bid >> 3)));
            {
                unsigned* ctr = WSP(unsigned, WS_CTL) + CW_WQ + 64 * (16 + (l * 2 + rep_) * 8);
                LAS unsigned* jslot = (LAS unsigned*)(F.lds + MISC_OFF + 128);
                const unsigned myq = xb_xcc_id() & 7u;
                for (;;) {
                    __syncthreads();
                    if (F.tid == 0) {
                        unsigned got = 0xffffffffu;
                        for (unsigned t = 0; t < 8u && got == 0xffffffffu; ++t) { const unsigned q = (myq + t) & 7u;
                            if (__hip_atomic_load(ctr + 64 * q, __ATOMIC_RELAXED, __HIP_MEMORY_SCOPE_AGENT) >= 64u) continue;
                            const unsigned k = __hip_atomic_fetch_add(ctr + 64 * q, 1u, __ATOMIC_RELAXED, __HIP_MEMORY_SCOPE_AGENT);
                            if (k < 64u) { const unsigned kk = k < 8u ? 63u - k : k - 8u;
                                got = (q >> 1) * 128u + (127u - (2u * kk + (q & 1u))); } }
                        *jslot = got;
                    }
                    __syncthreads();
                    const unsigned j = *jslot;
                    if (j == 0xffffffffu) break;
                    job_begin(F);
                    JT(5, nsa_job(F, (int)j));
                }
                if (rep_ == 0) {
                    unsigned* ctr2 = WSP(unsigned, WS_CTL) + CW_WQ + 64 * (80 + l);
                    for (;;) {
                        __syncthreads();
                        if (F.tid == 0) *jslot = __hip_atomic_fetch_add(ctr2, 1u, __ATOMIC_RELAXED, __HIP_MEMORY_SCOPE_AGENT);
                        __syncthreads();
                        const unsigned s = *jslot;
                        if (s >= 512u) break;
                        JT(7, ssd_scan_part(F, (int)s, 512));
                    }
                }
            }
            REP_END(5)
            SEAM(5); TE(5);
        }
        if (IN(7)) { TB(7);
            REP_BEGIN(7)
            for (int j = F.bid; j < 256; j += F.G) { job_begin(F); JT(8, ssd_out_job(F, l, j)); }
            job_begin(F);
            JT(9, gdn_final_rows(F, l, F.bid * 8 + F.wave, F.G * 8));
            REP_END(7)
            SEAM(7); TE(7);
        }
        if (IN(8)) { TB(8); REP_BEGIN(8) pg8::Gemm g{WSP(bf16, WS_YCAT), WSP(bf16, WS_WPM), MTOK, DM, 512, DM, DM}; pg8::SegOrder S; S.init(MTOK, DM, F.G, F.bid, 512);
            pg8::EpiMergeSeg E{WSP(bf16, WS_MERGED), WSP(bf16, WS_GATE), WSP(float, WS_SRC)}; pg8::gemm_phase<pg8::EpiMergeSeg, pg8::SegOrder>(F.lds, F.tid, g, S, E); REP_END(8) SEAM(8); TE(8); }
        if (IN(9)) { TB(9); pg8::Gemm g{WSP(bf16, WS_MERGED), WSP(bf16, WS_WO), MTOK, DM, DM, DM, DM}; pg8::StaticOrder S; S.init(MTOK, DM, F.G, F.bid, 4);
            pg8::EpiResidual E{nullptr, XB, RSB(2), 1.0f}; pg8::gemm_phase<pg8::EpiResidual, pg8::StaticOrder>(F.lds, F.tid, g, S, E); SEAM(9); TE(9); }
        if (IN(10)) { TB(10); pg8::Gemm g{XB, WSP(bf16, WS_WUP2), MTOK, NUP, DM, DM, DM}; pg8::StaticOrder S; S.init(MTOK, NUP, F.G, F.bid);
            pg8::EpiSwiGLU E{ACT, RSB(2)}; pg8::gemm_phase<pg8::EpiSwiGLU, pg8::StaticOrder>(F.lds, F.tid, g, S, E); SEAM(10); TE(10); }
        if (IN(11)) { TB(11); pg8::Gemm g{ACT, WSP(bf16, WS_WDN2), MTOK, DM, DFF, DFF, DFF}; pg8::StaticOrder S; S.init(MTOK, DM, F.G, F.bid, 4);
            pg8::EpiResidual E{l == DEPTH - 1 ? as_global(prm.out) : nullptr, XB, RSB(3), 0.5f}; pg8::gemm_phase<pg8::EpiResidual, pg8::StaticOrder>(F.lds, F.tid, g, S, E); SEAM(11); TE(11); }
#undef IN
#undef SEAM
#undef TB
#undef JT
#undef TE
#undef REP_BEGIN
#undef REP_END
#undef RSB
#undef XB
#undef ACT
    }
    if (DBG_AJOB) {
        XcdBarrier bb_ = bar; bb_.bar = (unsigned*)launder64((unsigned long long)bar.bar); xcd_barrier(bb_);
        if (blockIdx.x == 0 && wave0 == 0 && __builtin_amdgcn_mbcnt_hi(~0u, __builtin_amdgcn_mbcnt_lo(~0u, 0u)) == 0u) {
            const unsigned a_ = __hip_atomic_load((unsigned*)(prm.ws + WS_CTL) + 460000, __ATOMIC_RELAXED, __HIP_MEMORY_SCOPE_AGENT); const unsigned t0_ = (unsigned)__builtin_amdgcn_s_memrealtime();
            while ((unsigned)__builtin_amdgcn_s_memrealtime() - t0_ < a_ / 32u) __builtin_amdgcn_s_sleep(32);
        }
    }
    if (DBG_TMASK && blockIdx.x == 0 && wave0 == 0 && __builtin_amdgcn_mbcnt_hi(~0u, __builtin_amdgcn_mbcnt_lo(~0u, 0u)) == 0u) {
        volatile LAS unsigned* m_ = (volatile LAS unsigned*)(F.lds + MISC_OFF); const unsigned a_ = m_[66]; const unsigned t0_ = (unsigned)__builtin_amdgcn_s_memrealtime();
        while ((unsigned)__builtin_amdgcn_s_memrealtime() - t0_ < (unsigned)DBG_TAMP * a_) __builtin_amdgcn_s_sleep(32);
    }
}

#ifndef DBG_DUMP
#define DBG_DUMP 0
#endif
#ifndef DBG_STOP
#define DBG_STOP 48
#endif
__global__ void dbg_dump_bf16(const unsigned short* src, size_t n, float* out, size_t nout) {
    for (size_t i = (size_t)blockIdx.x * blockDim.x + threadIdx.x; i < nout; i += (size_t)gridDim.x * blockDim.x) { float s = 0.f; for (size_t k = i; k < n; k += nout) s += __builtin_bit_cast(float, (unsigned)src[k] << 16); out[i] = s; }
}
__global__ void dbg_dump_f32(const float* src, size_t n, float* out, size_t nout) {
    for (size_t i = (size_t)blockIdx.x * blockDim.x + threadIdx.x; i < nout; i += (size_t)gridDim.x * blockDim.x) { float s = 0.f; for (size_t k = i; k < n; k += nout) s += src[k]; out[i] = s; }
}
#ifndef N_LAUNCH_MODE
#define N_LAUNCH_MODE 0
#endif
extern "C" void kernel_launch(void* const* d_in, const int* in_sizes, int n_in, void* d_out, int out_size, void* d_ws, size_t ws_size, hipStream_t stream) {
    static int grid = 0;
    if (grid == 0) {
        if (n_in != 30 || out_size != MTOK * DM || ws_size < WS_END) { fprintf(stderr, "kernel_launch: unexpected shapes (n_in %d out %d ws %zu, need %zu)\n", n_in, out_size, ws_size, (size_t)WS_END); grid = -1; return; }
        int dev = 0, cus = 0, per_cu = 0;
        if (hipGetDevice(&dev) != hipSuccess || hipDeviceGetAttribute(&cus, hipDeviceAttributeMultiprocessorCount, dev) != hipSuccess) { grid = -1; return; }
        if (hipFuncSetAttribute((const void*)hybrid_fwd, hipFuncAttributeMaxDynamicSharedMemorySize, LDS_BYTES) != hipSuccess) { fprintf(stderr, "kernel_launch: hipFuncSetAttribute failed\n"); grid = -1; return; }
        if (hipOccupancyMaxActiveBlocksPerMultiprocessor(&per_cu, (const void*)hybrid_fwd, 512, LDS_BYTES) != hipSuccess || per_cu < 1) { fprintf(stderr, "kernel_launch: occupancy query says %d\n", per_cu); }
        (void)hipGetLastError();
        grid = cus;
    }
    if (grid < 0) return;
    (void)hipMemsetAsync((char*)d_ws + WS_CTL, 0, CTL_BYTES, stream);
    Params p{};
    for (int i = 0; i < 30; ++i) p.in[i] = (const float*)d_in[i];
    p.out = (float*)d_out; p.ws = (unsigned char*)d_ws; p.pad = 0;
    if (N_LAUNCH_MODE == 0) { p.lo = 0; p.hi = DEPTH * NPH; p.use_bar = 1; hipLaunchKernelGGL(hybrid_fwd, dim3(grid), dim3(512), LDS_BYTES, stream, p); }
    else { for (int ph = 0; ph < (DBG_DUMP ? DBG_STOP : DEPTH * NPH); ++ph) { p.lo = ph; p.hi = ph + 1; p.use_bar = 0; hipLaunchKernelGGL(hybrid_fwd, dim3(grid), dim3(512), LDS_BYTES, stream, p); } }
    if (DBG_DUMP) {
        const size_t nout = (size_t)MTOK * DM; char* w = (char*)d_ws;
        if (DBG_DUMP == 1) hipLaunchKernelGGL(dbg_dump_bf16, dim3(2048), dim3(256), 0, stream, (const unsigned short*)(w + WS_P1), (size_t)MTOK * P1W, (float*)d_out, nout);
        if (DBG_DUMP == 2) hipLaunchKernelGGL(dbg_dump_f32, dim3(2048), dim3(256), 0, stream, (const float*)(w + WS_SMALL), (size_t)MTOK * SMW, (float*)d_out, nout);
        if (DBG_DUMP == 3) hipLaunchKernelGGL(dbg_dump_bf16, dim3(2048), dim3(256), 0, stream, (const unsigned short*)(w + WS_GW), (size_t)1024 * GDN_CH_BYTES / 2, (float*)d_out, nout);
        if (DBG_DUMP == 4) hipLaunchKernelGGL(dbg_dump_f32, dim3(2048), dim3(256), 0, stream, (const float*)(w + WS_SST), (size_t)2 * 64 * 16 * 64 * 128, (float*)d_out, nout);
        if (DBG_DUMP == 5) hipLaunchKernelGGL(dbg_dump_f32, dim3(2048), dim3(256), 0, stream, (const float*)(w + WS_GO), (size_t)MTOK * 512, (float*)d_out, nout);
        if (DBG_DUMP == 6) hipLaunchKernelGGL(dbg_dump_bf16, dim3(2048), dim3(256), 0, stream, (const unsigned short*)(w + WS_YCAT), (size_t)MTOK * 2048, (float*)d_out, nout);
        if (DBG_DUMP == 7) hipLaunchKernelGGL(dbg_dump_bf16, dim3(2048), dim3(256), 0, stream, (const unsigned short*)(w + WS_MERGED), (size_t)MTOK * 2048, (float*)d_out, nout);
        if (DBG_DUMP == 8) hipLaunchKernelGGL(dbg_dump_bf16, dim3(2048), dim3(256), 0, stream, (const unsigned short*)(w + WS_SX), (size_t)MTOK * 1536, (float*)d_out, nout);
        if (DBG_DUMP == 9) hipLaunchKernelGGL(dbg_dump_bf16, dim3(2048), dim3(256), 0, stream, (const unsigned short*)(w + WS_GATE), (size_t)MTOK * 6144, (float*)d_out, nout);
        if (DBG_DUMP == 11) hipLaunchKernelGGL(dbg_dump_f32, dim3(2048), dim3(256), 0, stream, (const float*)(w + WS_SRC), (size_t)MTOK * 2, (float*)d_out, nout);
        if (DBG_DUMP == 12) hipLaunchKernelGGL(dbg_dump_bf16, dim3(2048), dim3(256), 0, stream, (const unsigned short*)(w + WS_WPM), (size_t)DM * DM, (float*)d_out, nout);
        if (DBG_DUMP == 13) hipLaunchKernelGGL(dbg_dump_f32, dim3(2048), dim3(256), 0, stream, (const float*)(w + WS_MTMP), (size_t)MTOK * DM, (float*)d_out, nout);
        if (DBG_DUMP == 15) hipLaunchKernelGGL(dbg_dump_bf16, dim3(2048), dim3(256), 0, stream, (const unsigned short*)(w + WS_ACT), (size_t)MTOK * DFF, (float*)d_out, nout);
        if (DBG_DUMP == 16) hipLaunchKernelGGL(dbg_dump_bf16, dim3(2048), dim3(256), 0, stream, (const unsigned short*)(w + WS_XB), (size_t)MTOK * DM, (float*)d_out, nout);
        if (DBG_DUMP == 17) hipLaunchKernelGGL(dbg_dump_bf16, dim3(2048), dim3(256), 0, stream, (const unsigned short*)(w + WS_WIN), (size_t)NINP * DM, (float*)d_out, nout);
        if (DBG_DUMP == 18) hipLaunchKernelGGL(dbg_dump_f32, dim3(2048), dim3(256), 0, stream, (const float*)(w + WS_CTL) + CW_RS, (size_t)NRS * MTOK, (float*)d_out, nout);
        if (DBG_DUMP == 10) hipLaunchKernelGGL(dbg_dump_f32, dim3(2048), dim3(256), 0, stream, (const float*)(w + WS_YB), (size_t)MTOK * 512, (float*)d_out, nout);
    }
}
#endif
```
